# Optimizing an MI355X kernel written in HIP

```python
import math
import jax, jax.numpy as jnp
from jax import lax
import numpy as np

D_MODEL = 1024
BATCH = 8
SEQ = 4096
DEPTH = 1
DEC_BATCH = 16
DEC_SEQ = 2048
PAST_LEN = 128

HEAD_DIM = 64
N_HEADS_A = 8
N_HEADS_B = 4
N_HEADS_TOTAL = N_HEADS_A + N_HEADS_B
DILATED_BRANCHES = ((128, 1), (512, 4), (2048, 16))
A_WIDTH = N_HEADS_A * HEAD_DIM
B_QK_WIDTH = N_HEADS_B * 2 * HEAD_DIM
B_V_WIDTH = N_HEADS_B * 2 * HEAD_DIM
IN_WIDTH = 3 * A_WIDTH + 2 * B_QK_WIDTH + B_V_WIDTH
MIX_WIDTH = A_WIDTH + B_V_WIDTH
NUM_BUCKETS = 32
MAX_DISTANCE = 1024
Q_BLOCK = 128
N_KEYS = 128
N_EXPERTS = N_KEYS * N_KEYS
PEER_HEADS = 8
D_KEY = 256
D_KEY_HALF = D_KEY // 2
PEER_TOPK = 16
TOKEN_CHUNK = 128
NORM_EPS = 1e-6
NEG_INF = -1e30
ATTN_SCALE = HEAD_DIM ** -0.5

kernel_name = 'hymba_dilated_diff_peer_encoder'


def rms_norm(x, g):
    x32 = x.astype(jnp.float32)
    y = x32 * lax.rsqrt(jnp.mean(x32 * x32, axis=-1, keepdims=True) + NORM_EPS)
    return (y * g.astype(jnp.float32)).astype(x.dtype)


def rel_bucket(rel):
    nb = NUM_BUCKETS // 2
    max_exact = nb // 2
    n = jnp.abs(rel)
    large = max_exact + (jnp.log(jnp.maximum(n, 1).astype(jnp.float32) / max_exact)
                         / math.log(MAX_DISTANCE / max_exact) * (nb - max_exact)).astype(jnp.int32)
    large = jnp.minimum(large, nb - 1)
    return (rel > 0).astype(jnp.int32) * nb + jnp.where(n < max_exact, n, large)


def dilated_branch(q, k, v, bias_tab, dilation, half):
    b, s, h, c = q.shape
    blk = half
    n_len = s // dilation
    nb = -(-n_len // blk)
    pad = nb * blk - n_len

    def to_classes(t):
        return t.reshape(b, n_len, dilation, h, t.shape[-1]).transpose(0, 2, 1, 3, 4)

    qc = jnp.pad(to_classes(q), ((0, 0), (0, 0), (0, pad), (0, 0), (0, 0))).reshape(b, dilation, nb, blk, h, c)

    def band(t):
        tp = jnp.pad(to_classes(t), ((0, 0), (0, 0), (blk, blk + pad), (0, 0), (0, 0)))
        tp = tp.reshape(b, dilation, nb + 2, blk, h, t.shape[-1])
        return jnp.concatenate([tp[:, :, :-2], tp[:, :, 1:-1], tp[:, :, 2:]], axis=3)

    kb, vb = band(k), band(v)
    off = jnp.arange(3 * blk)[None, :] - blk - jnp.arange(blk)[:, None]
    key_idx = jnp.arange(nb)[:, None] * blk - blk + jnp.arange(3 * blk)[None, :]
    mask = (jnp.abs(off) <= half)[None] & ((key_idx >= 0) & (key_idx < n_len))[:, None, :]
    bias = bias_tab[rel_bucket(off * dilation)].transpose(2, 0, 1).astype(jnp.float32)
    scores = jnp.einsum('bdnqhc,bdnkhc->bdnhqk', qc, kb).astype(jnp.float32) * ATTN_SCALE + bias
    scores = jnp.where(mask[:, None], scores, NEG_INF)
    lse = jax.nn.logsumexp(scores, axis=-1)
    p = jnp.exp(scores - lse[..., None])
    o = jnp.einsum('bdnhqk,bdnkhc->bdnqhc', p.astype(v.dtype), vb)

    def from_classes(t):
        t = t.reshape(b, dilation, nb * blk, h, t.shape[-1])[:, :, :n_len]
        return t.transpose(0, 2, 1, 3, 4).reshape(b, s, h, t.shape[-1])

    o = from_classes(o)
    lse_t = from_classes(lse.transpose(0, 1, 2, 4, 3)[..., None])[..., 0]
    return o, lse_t


def dilated_attention(q, k, v, bias_tab):
    outs, lses = [], []
    for window, dilation in DILATED_BRANCHES:
        o, l = dilated_branch(q, k, v, bias_tab, dilation, window // dilation // 2)
        outs.append(o)
        lses.append(l)
    w = jax.nn.softmax(jnp.stack(lses, 0), axis=0)
    return jnp.sum(w[..., None] * jnp.stack(outs, 0).astype(jnp.float32), axis=0)


def diff_attention(q1, q2, k1, k2, v, bias_tab, lam):
    b, s, h, c = q1.shape
    nq = s // Q_BLOCK
    qs = jnp.stack([q1, q2], 0).reshape(2, b, nq, Q_BLOCK, h, c).transpose(2, 0, 1, 3, 4, 5)
    kpos = jnp.arange(s)

    def block(args):
        qblk, start = args
        qpos = start + jnp.arange(Q_BLOCK)
        bias = bias_tab[rel_bucket(kpos[None, :] - qpos[:, None])].transpose(2, 0, 1).astype(jnp.float32)
        s1 = jnp.einsum('bqhc,bkhc->bhqk', qblk[0], k1).astype(jnp.float32) * ATTN_SCALE + bias
        s2 = jnp.einsum('bqhc,bkhc->bhqk', qblk[1], k2).astype(jnp.float32) * ATTN_SCALE + bias
        a = jax.nn.softmax(s1, axis=-1) - lam * jax.nn.softmax(s2, axis=-1)
        return jnp.einsum('bhqk,bkhc->bqhc', a.astype(v.dtype), v)

    o = lax.map(block, (qs, jnp.arange(nq) * Q_BLOCK))
    return o.transpose(1, 0, 2, 3, 4).reshape(b, s, h, v.shape[-1])


def peer(h, w_q, sub_keys, u, v):
    b, s, d = h.shape
    hc = h.reshape(-1, TOKEN_CHUNK, d)

    def chunk(xc):
        q = (xc @ w_q).reshape(TOKEN_CHUNK, PEER_HEADS, 2, D_KEY_HALF)
        sc = jnp.einsum('cpzk,znk->cpzn', q, sub_keys).astype(jnp.float32)
        top_v, top_i = lax.top_k(sc, PEER_TOPK)
        cand = (top_v[:, :, 0, :, None] + top_v[:, :, 1, None, :]).reshape(TOKEN_CHUNK, PEER_HEADS, -1)
        cand_idx = (top_i[:, :, 0, :, None] * N_KEYS + top_i[:, :, 1, None, :]).reshape(TOKEN_CHUNK, PEER_HEADS, -1)
        best, pos = lax.top_k(cand, PEER_TOPK)
        eidx = jnp.take_along_axis(cand_idx, pos, axis=-1)
        g = jax.nn.softmax(best, axis=-1)
        act = jax.nn.gelu(jnp.einsum('cd,cpkd->cpk', xc, u[eidx]).astype(jnp.float32), approximate=False)
        return jnp.einsum('cpk,cpkd->cd', (g * act).astype(xc.dtype), v[eidx])

    return lax.map(chunk, hc).reshape(b, s, d)


def encoder(x, rel_bias, attn_norm_g, w_in, q_norm_a, k_norm_a, q_norm_b, k_norm_b,
            lambda_q1, lambda_k1, lambda_q2, lambda_k2, diff_norm_g, w_out, ffn_norm_g,
            peer_w_q, peer_sub_keys, peer_u, peer_v):
    b, s, _ = x.shape
    bias_a = rel_bias[:, :N_HEADS_A]
    bias_b = rel_bias[:, N_HEADS_A:]
    for l in range(DEPTH):
        lambda_init = 0.8 - 0.6 * math.exp(-0.3 * l)
        n = rms_norm(x, attn_norm_g[l])
        proj = n @ w_in[l]
        qa, ka, va, qb, kb, vb = jnp.split(proj, np.cumsum(
            [A_WIDTH, A_WIDTH, A_WIDTH, B_QK_WIDTH, B_QK_WIDTH]).tolist(), axis=-1)
        qa = rms_norm(qa.reshape(b, s, N_HEADS_A, HEAD_DIM), q_norm_a[l])
        ka = rms_norm(ka.reshape(b, s, N_HEADS_A, HEAD_DIM), k_norm_a[l])
        va = va.reshape(b, s, N_HEADS_A, HEAD_DIM)
        o_a = dilated_attention(qa, ka, va, bias_a).reshape(b, s, A_WIDTH).astype(x.dtype)

        qb = rms_norm(qb.reshape(b, s, N_HEADS_B, 2, HEAD_DIM), q_norm_b[l])
        kb = rms_norm(kb.reshape(b, s, N_HEADS_B, 2, HEAD_DIM), k_norm_b[l])
        vb = vb.reshape(b, s, N_HEADS_B, 2 * HEAD_DIM)
        lam = (jnp.exp(jnp.sum(lambda_q1[l].astype(jnp.float32) * lambda_k1[l].astype(jnp.float32)))
               - jnp.exp(jnp.sum(lambda_q2[l].astype(jnp.float32) * lambda_k2[l].astype(jnp.float32)))
               + lambda_init)
        o_b = diff_attention(qb[..., 0, :], qb[..., 1, :], kb[..., 0, :], kb[..., 1, :], vb, bias_b, lam)
        o_b = (rms_norm(o_b, diff_norm_g[l]) * (1.0 - lambda_init)).reshape(b, s, B_V_WIDTH).astype(x.dtype)

        x = x + jnp.concatenate([o_a, o_b], axis=-1) @ w_out[l]
        x = x + peer(rms_norm(x, ffn_norm_g[l]), peer_w_q[l], peer_sub_keys[l], peer_u[l], peer_v[l])
    return x


def setup_inputs(seed: int = 0) -> dict:
    key = jax.random.key(seed)
    ks = jax.random.split(key, 20)
    f32 = jnp.float32

    def gain(k, shape):
        return 1.0 + 0.01 * jax.random.normal(k, shape, f32)

    return {
        'x_prompt': jax.random.normal(ks[0], (BATCH, SEQ, D_MODEL), f32),
        'x_sample': jax.random.normal(ks[1], (DEC_BATCH, DEC_SEQ, D_MODEL), f32),
        'rel_bias': 0.1 * jax.random.normal(ks[2], (NUM_BUCKETS, N_HEADS_TOTAL), f32),
        'attn_norm_g': gain(ks[3], (DEPTH, D_MODEL)),
        'w_in': jax.random.normal(ks[4], (DEPTH, D_MODEL, IN_WIDTH), f32) * D_MODEL ** -0.5,
        'q_norm_a': gain(ks[5], (DEPTH, HEAD_DIM)),
        'k_norm_a': gain(ks[6], (DEPTH, HEAD_DIM)),
        'q_norm_b': gain(ks[7], (DEPTH, HEAD_DIM)),
        'k_norm_b': gain(ks[8], (DEPTH, HEAD_DIM)),
        'lambda_q1': 0.1 * jax.random.normal(ks[9], (DEPTH, HEAD_DIM), f32),
        'lambda_k1': 0.1 * jax.random.normal(ks[10], (DEPTH, HEAD_DIM), f32),
        'lambda_q2': 0.1 * jax.random.normal(ks[11], (DEPTH, HEAD_DIM), f32),
        'lambda_k2': 0.1 * jax.random.normal(ks[12], (DEPTH, HEAD_DIM), f32),
        'diff_norm_g': gain(ks[13], (DEPTH, 2 * HEAD_DIM)),
        'w_out': jax.random.normal(ks[14], (DEPTH, MIX_WIDTH, D_MODEL), f32) * MIX_WIDTH ** -0.5,
        'ffn_norm_g': gain(ks[15], (DEPTH, D_MODEL)),
        'peer_w_q': jax.random.normal(ks[16], (DEPTH, D_MODEL, PEER_HEADS * D_KEY), f32) * D_MODEL ** -0.5,
        'peer_sub_keys': jax.random.normal(ks[17], (DEPTH, 2, N_KEYS, D_KEY_HALF), f32) * D_KEY_HALF ** -0.5,
        'peer_u': jax.random.normal(ks[18], (DEPTH, N_EXPERTS, D_MODEL), f32) * D_MODEL ** -0.5,
        'peer_v': jax.random.normal(ks[19], (DEPTH, N_EXPERTS, D_MODEL), f32) * D_MODEL ** -0.5,
    }


def reference(x_prompt, x_sample, rel_bias, attn_norm_g, w_in, q_norm_a, k_norm_a, q_norm_b, k_norm_b,
              lambda_q1, lambda_k1, lambda_q2, lambda_k2, diff_norm_g, w_out, ffn_norm_g,
              peer_w_q, peer_sub_keys, peer_u, peer_v):
    y_prompt = encoder(x_prompt, rel_bias, attn_norm_g, w_in, q_norm_a, k_norm_a, q_norm_b, k_norm_b,
                       lambda_q1, lambda_k1, lambda_q2, lambda_k2, diff_norm_g, w_out, ffn_norm_g,
                       peer_w_q, peer_sub_keys, peer_u, peer_v)
    y_sample = encoder(x_sample, rel_bias, attn_norm_g, w_in, q_norm_a, k_norm_a, q_norm_b, k_norm_b,
                       lambda_q1, lambda_k1, lambda_q2, lambda_k2, diff_norm_g, w_out, ffn_norm_g,
                       peer_w_q, peer_sub_keys, peer_u, peer_v)
    return (y_prompt, y_sample)
```

```cpp
#include <hip/hip_runtime.h>
#include <hip/hip_cooperative_groups.h>
#include <cstdio>
#include <cstdint>
namespace cg = cooperative_groups;

#ifndef FUSED
#define FUSED 0
#endif

typedef unsigned short u16;
typedef __attribute__((ext_vector_type(8))) short bf16x8;
typedef __attribute__((ext_vector_type(4))) short s16x4;
typedef __attribute__((ext_vector_type(16))) float f32x16;
typedef __attribute__((ext_vector_type(4))) float f32x4;
typedef __attribute__((ext_vector_type(4))) unsigned u32x4;
typedef __attribute__((ext_vector_type(2))) unsigned u32x2;
typedef __attribute__((address_space(3))) unsigned char* ldsp_t;

#define DI __device__ __forceinline__
#define MFMA32(a, b, c) __builtin_amdgcn_mfma_f32_32x32x16_bf16((a), (b), (c), 0, 0, 0)

constexpr int DM = 1024;
constexpr int T_TOK = 65536;
constexpr int T_PROMPT = 32768;
constexpr int NTHR = 512;
constexpr int NPHASE = 8;
constexpr float NORM_EPS = 1e-6f;
constexpr float LOG2E = 1.4426950408889634f;
constexpr float C2 = 0.125f * LOG2E;
constexpr float NEG_BIG = -1.0e30f;

constexpr size_t WS_WIN  = 0;
constexpr size_t WS_WOUT = WS_WIN + (size_t)3072 * 1024 * 2;
constexpr size_t WS_WQ   = WS_WOUT + (size_t)1024 * 1024 * 2;
constexpr size_t WS_SK   = WS_WQ + (size_t)2048 * 1024 * 2;
constexpr size_t WS_U    = WS_SK + (size_t)2 * 128 * 128 * 2;
constexpr size_t WS_V    = WS_U + (size_t)16384 * 1024 * 2;
constexpr size_t WS_MISC = WS_V + (size_t)16384 * 1024 * 2;
constexpr size_t WS_R    = WS_MISC + (size_t)1048576;
constexpr size_t R_REGION = (size_t)T_TOK * 512 * 2;
constexpr size_t WS_X1   = WS_R;
constexpr size_t WS_H    = WS_R + (size_t)T_TOK * 1024 * 4;
constexpr size_t WS_EIDX = WS_R + 6 * R_REGION;
constexpr size_t WS_G    = WS_EIDX + (size_t)T_TOK * 128 * 2;
constexpr size_t WS_END  = WS_G + (size_t)T_TOK * 128 * 4;
static_assert(WS_END <= (size_t)536870912, "workspace map exceeds 512 MiB");
constexpr size_t OUT_N1 = 0, OUT_MIX = 134217728, OUT_TV = 0, OUT_TI = 67108864;

constexpr int LDS_BYTES = 131072;

struct Params {
  const float* x_prompt; const float* x_sample; const float* rel_bias; const float* attn_norm_g; const float* w_in;
  const float* q_norm_a; const float* k_norm_a; const float* q_norm_b; const float* k_norm_b;
  const float* lq1; const float* lk1; const float* lq2; const float* lk2; const float* diff_norm_g; const float* w_out;
  const float* ffn_norm_g; const float* peer_w_q; const float* peer_sub_keys; const float* peer_u; const float* peer_v;
  float* out; unsigned char* ws; int ph_lo; int ph_hi;
};

DI u16 f2bf(float f) { unsigned u = __float_as_uint(f); u += 0x7fffu + ((u >> 16) & 1u); return (u16)(u >> 16); }
DI float bf2f(u16 b) { return __uint_as_float(((unsigned)b) << 16); }
DI unsigned pk2(float lo, float hi) {
  typedef float f2_t __attribute__((ext_vector_type(2)));
  typedef __bf16 b2_t __attribute__((ext_vector_type(2)));
  f2_t v = {lo, hi}; b2_t b = __builtin_convertvector(v, b2_t); return __builtin_bit_cast(unsigned, b);
}
DI int crow(int reg, int h) { return (reg & 3) + 8 * (reg >> 2) + 4 * h; }
DI float wave_sum(float v) {
#pragma unroll
  for (int o = 32; o > 0; o >>= 1) v += __shfl_xor(v, o);
  return v;
}
DI void seq_of(int t, int& seq_start, int& S, int& s) {
  if (t < T_PROMPT) { S = 4096; seq_start = t & ~4095; s = t & 4095; }
  else { S = 2048; seq_start = t & ~2047; s = t & 2047; }
}
DI const float* x_row(const Params& p, int t) {
  return (t < T_PROMPT) ? p.x_prompt + (size_t)t * DM : p.x_sample + (size_t)(t - T_PROMPT) * DM;
}
DI int rel_bucket(int rel) {
  int n = rel < 0 ? -rel : rel;
  int b;
  if (n < 8) b = n;
  else if (n < 15) b = 8; else if (n < 27) b = 9; else if (n < 50) b = 10; else if (n < 91) b = 11;
  else if (n < 166) b = 12; else if (n < 305) b = 13; else if (n < 559) b = 14; else b = 15;
  return (rel > 0 ? 16 : 0) + b;
}
DI s16x4 tr_read(const unsigned char* p) {
  typedef short v4i16_t __attribute__((ext_vector_type(4)));
  return __builtin_bit_cast(s16x4, __builtin_amdgcn_ds_read_tr16_b64_v4i16((__attribute__((address_space(3))) v4i16_t*)p));
}
DI bf16x8 cat8(s16x4 lo, s16x4 hi) { return __builtin_shufflevector(lo, hi, 0, 1, 2, 3, 4, 5, 6, 7); }

DI void transpose_item(const float* __restrict__ src, int K, int N, u16* __restrict__ dst, int k0, int n0, unsigned char* lds) {
  float* tile = (float*)lds;
  const int tid = threadIdx.x;
#pragma unroll
  for (int i = 0; i < 8; ++i) {
    int idx = tid + 512 * i; int r = idx >> 6, c = idx & 63;
    tile[r * 65 + c] = src[(size_t)(k0 + r) * N + n0 + c];
  }
  __syncthreads();
  {
    int n = tid >> 3, kc = tid & 7;
    u32x4 o;
    o[0] = pk2(tile[(kc * 8 + 0) * 65 + n], tile[(kc * 8 + 1) * 65 + n]);
    o[1] = pk2(tile[(kc * 8 + 2) * 65 + n], tile[(kc * 8 + 3) * 65 + n]);
    o[2] = pk2(tile[(kc * 8 + 4) * 65 + n], tile[(kc * 8 + 5) * 65 + n]);
    o[3] = pk2(tile[(kc * 8 + 6) * 65 + n], tile[(kc * 8 + 7) * 65 + n]);
    *(u32x4*)(dst + (size_t)(n0 + n) * K + k0 + kc * 8) = o;
  }
  __syncthreads();
}

DI void convert_item(const float* __restrict__ src, u16* __restrict__ dst, size_t base) {
  size_t i = base + (size_t)threadIdx.x * 8;
  f32x4 a = *(const f32x4*)(src + i), b = *(const f32x4*)(src + i + 4);
  u32x4 o; o[0] = pk2(a[0], a[1]); o[1] = pk2(a[2], a[3]); o[2] = pk2(b[0], b[1]); o[3] = pk2(b[2], b[3]);
  *(u32x4*)(dst + i) = o;
}

DI void norm_row(const float* __restrict__ xr, const float* __restrict__ g, u16* __restrict__ orow, int lane) {
  f32x4 v[4]; float ss = 0.f;
#pragma unroll
  for (int i = 0; i < 4; ++i) { v[i] = *(const f32x4*)(xr + lane * 4 + 256 * i); ss += v[i][0] * v[i][0] + v[i][1] * v[i][1] + v[i][2] * v[i][2] + v[i][3] * v[i][3]; }
  ss = wave_sum(ss);
  const float r = __builtin_amdgcn_rsqf(ss * (1.0f / 1024.0f) + NORM_EPS);
#pragma unroll
  for (int i = 0; i < 4; ++i) {
    f32x4 gg = *(const f32x4*)(g + lane * 4 + 256 * i);
    u32x2 o; o[0] = pk2(v[i][0] * r * gg[0], v[i][1] * r * gg[1]); o[1] = pk2(v[i][2] * r * gg[2], v[i][3] * r * gg[3]);
    *(u32x2*)(orow + lane * 4 + 256 * i) = o;
  }
}

DI void phase_prep(const Params& p, unsigned char* lds) {
  const int nb = gridDim.x, bid = blockIdx.x, tid = threadIdx.x;
  u16* wsb = (u16*)p.ws;
  for (int it = bid; it < 768 + 256 + 512; it += nb) {
    if (it < 768) { int kt = it / 48, nt = it % 48; transpose_item(p.w_in, 1024, 3072, (u16*)(p.ws + WS_WIN), kt * 64, nt * 64, lds); }
    else if (it < 1024) { int j = it - 768; int kt = j / 16, nt = j % 16; transpose_item(p.w_out, 1024, 1024, (u16*)(p.ws + WS_WOUT), kt * 64, nt * 64, lds); }
    else { int j = it - 1024; int kt = j / 32, nt = j % 32; transpose_item(p.peer_w_q, 1024, 2048, (u16*)(p.ws + WS_WQ), kt * 64, nt * 64, lds); }
  }
  for (int it = bid; it < 8 + 4096 + 4096; it += nb) {
    if (it < 8) convert_item(p.peer_sub_keys, (u16*)(p.ws + WS_SK), (size_t)it * 4096);
    else if (it < 8 + 4096) convert_item(p.peer_u, (u16*)(p.ws + WS_U), (size_t)(it - 8) * 4096);
    else convert_item(p.peer_v, (u16*)(p.ws + WS_V), (size_t)(it - 8 - 4096) * 4096);
  }
  const int lane = tid & 63, w = tid >> 6;
  u16* n1 = (u16*)((unsigned char*)p.out + OUT_N1);
  for (int it = bid; it < T_TOK / 8; it += nb) {
    int t = it * 8 + w;
    norm_row(x_row(p, t), p.attn_norm_g, n1 + (size_t)t * DM, lane);
  }
  (void)wsb;
}

template <int PR, int QR>
DI void gemm_mainloop(const u16* __restrict__ P, const u16* __restrict__ Q, int K, int p0, int q0, unsigned char* lds, f32x16 (&acc)[2][2]) {
  static_assert(PR + QR == 384, "tile");
  constexpr int STAGE = 384 * 128;
  constexpr int WC = QR / 64;
  const int tid = threadIdx.x, lane = tid & 63, r32 = lane & 31, h = lane >> 5;
  const int w = __builtin_amdgcn_readfirstlane(tid >> 6);
  const int wr = w / WC, wc = w % WC;
#pragma unroll
  for (int i = 0; i < 2; ++i)
#pragma unroll
    for (int j = 0; j < 2; ++j)
#pragma unroll
      for (int r = 0; r < 16; ++r) acc[i][j][r] = 0.f;
  u32x4 stg[6];
  const u16* src[6]; int loff[6];
#pragma unroll
  for (int i = 0; i < 6; ++i) {
    int c = tid + 512 * i; int row = c >> 3, kc = c & 7;
    src[i] = (row < PR) ? P + (size_t)(p0 + row) * K + kc * 8 : Q + (size_t)(q0 + row - PR) * K + kc * 8;
    loff[i] = row * 128 + ((kc ^ ((row >> 1) & 7)) << 4);
  }
  const int KT = K / 64;
#pragma unroll
  for (int i = 0; i < 6; ++i) stg[i] = *(const u32x4*)(src[i]);
#pragma unroll
  for (int i = 0; i < 6; ++i) *(u32x4*)(lds + loff[i]) = stg[i];
  __syncthreads();
  int aoff[2], boff[2], asw[2], bsw[2];
#pragma unroll
  for (int i = 0; i < 2; ++i) {
    int ra = wr * 64 + i * 32 + r32; aoff[i] = ra * 128; asw[i] = (ra >> 1) & 7;
    int rb = PR + wc * 64 + i * 32 + r32; boff[i] = rb * 128; bsw[i] = (rb >> 1) & 7;
  }
  for (int kt = 0; kt < KT; ++kt) {
    const int buf = (kt & 1) * STAGE;
    if (kt + 1 < KT) {
#pragma unroll
      for (int i = 0; i < 6; ++i) stg[i] = *(const u32x4*)(src[i] + (kt + 1) * 64);
    }
#pragma unroll
    for (int ks = 0; ks < 4; ++ks) {
      bf16x8 a[2], b[2];
#pragma unroll
      for (int i = 0; i < 2; ++i) {
        a[i] = *(const bf16x8*)(lds + buf + aoff[i] + (((2 * ks + h) ^ asw[i]) << 4));
        b[i] = *(const bf16x8*)(lds + buf + boff[i] + (((2 * ks + h) ^ bsw[i]) << 4));
      }
#pragma unroll
      for (int i = 0; i < 2; ++i)
#pragma unroll
        for (int j = 0; j < 2; ++j) acc[i][j] = MFMA32(a[i], b[j], acc[i][j]);
    }
    if (kt + 1 < KT) {
      const int nbuf = ((kt + 1) & 1) * STAGE;
#pragma unroll
      for (int i = 0; i < 6; ++i) *(u32x4*)(lds + nbuf + loff[i]) = stg[i];
    }
    __syncthreads();
  }
}

DI void phase_proj(const Params& p, unsigned char* lds) {
  const u16* Wt = (const u16*)(p.ws + WS_WIN);
  const u16* X = (const u16*)((const unsigned char*)p.out + OUT_N1);
  const int tid = threadIdx.x, lane = tid & 63, r32 = lane & 31, h = lane >> 5;
  const int w = __builtin_amdgcn_readfirstlane(tid >> 6);
  const int wr = w >> 1, wc = w & 1;
  for (int tile = blockIdx.x; tile < 12 * 512; tile += gridDim.x) {
    const int mb = tile / 12, nbk = tile % 12;
    const int p0 = nbk * 256, q0 = mb * 128;
    f32x16 acc[2][2];
    gemm_mainloop<256, 128>(Wt, X, 1024, p0, q0, lds, acc);
    const int nbase = p0 + wr * 64;
    const int region = nbase >> 9, hw = (nbase & 511) >> 6;
    const float* g = (region == 0) ? p.q_norm_a : (region == 1) ? p.k_norm_a : (region == 3) ? p.q_norm_b : p.k_norm_b;
    const bool normed = (region != 2 && region != 5);
    const float qs = (region == 0 || region == 3) ? C2 : 1.0f;
    u16* dstR = (u16*)(p.ws + WS_R + (size_t)region * R_REGION);
#pragma unroll
    for (int j = 0; j < 2; ++j) {
      const int t = q0 + wc * 64 + j * 32 + r32;
      int seq_start, S, s; seq_of(t, seq_start, S, s);
      float scale = 1.0f;
      if (normed) {
        float ss = 0.f;
#pragma unroll
        for (int i = 0; i < 2; ++i)
#pragma unroll
          for (int r = 0; r < 16; ++r) ss += acc[i][j][r] * acc[i][j][r];
        ss += __shfl_xor(ss, 32);
        scale = __builtin_amdgcn_rsqf(ss * (1.0f / 64.0f) + NORM_EPS) * qs;
      }
      u16* dst;
      if (region != 5) dst = dstR + (size_t)seq_start * 512 + ((size_t)hw * S + s) * 64;
      else dst = dstR + (size_t)seq_start * 512 + ((size_t)(hw >> 1) * S + s) * 128 + (hw & 1) * 64;
#pragma unroll
      for (int i = 0; i < 2; ++i)
#pragma unroll
        for (int g4 = 0; g4 < 4; ++g4) {
          const int d0 = i * 32 + 8 * g4 + 4 * h;
          float y0 = acc[i][j][4 * g4 + 0] * scale, y1 = acc[i][j][4 * g4 + 1] * scale, y2 = acc[i][j][4 * g4 + 2] * scale, y3 = acc[i][j][4 * g4 + 3] * scale;
          if (normed) { f32x4 gg = *(const f32x4*)(g + d0); y0 *= gg[0]; y1 *= gg[1]; y2 *= gg[2]; y3 *= gg[3]; }
          u32x2 o; o[0] = pk2(y0, y1); o[1] = pk2(y2, y3);
          *(u32x2*)(dst + d0) = o;
        }
    }
  }
}

constexpr int AL_STAGE = 0;
constexpr int AL_TAB   = 65536;
constexpr int AL_TABA  = 73728;
constexpr int AL_VT    = 90112;
constexpr int AL_XL    = 122880;
constexpr int AL_MISC  = 124928;

DI unsigned voff_b(int row, int ch) { return 256u * row + 16u * (ch ^ (((row & 3) << 2) | ((row >> 2) & 3))); }

DI void diff_unit(const Params& p, unsigned char* lds, int seq_start, int S, int hd, int q0, float lam) {
  const int tid = threadIdx.x, lane = tid & 63, r32 = lane & 31, h = lane >> 5;
  const int w = __builtin_amdgcn_readfirstlane(tid >> 6);
  const int map = w >> 2, wq = w & 3;
  const u16* QBp = (const u16*)(p.ws + WS_R + 3 * R_REGION);
  const u16* KBp = (const u16*)(p.ws + WS_R + 4 * R_REGION);
  const u16* VBp = (const u16*)(p.ws + WS_R + 5 * R_REGION);
  const int qpos = q0 + wq * 32 + r32;
  const u16* Qp = QBp + (size_t)seq_start * 512 + ((size_t)(hd * 2 + map) * S + qpos) * 64;
  bf16x8 qf[4];
#pragma unroll
  for (int ks = 0; ks < 4; ++ks) qf[ks] = *(const bf16x8*)(Qp + ks * 16 + h * 8);
  const u16* K1g = KBp + (size_t)seq_start * 512 + ((size_t)(hd * 2 + 0) * S) * 64;
  const u16* K2g = KBp + (size_t)seq_start * 512 + ((size_t)(hd * 2 + 1) * S) * 64;
  const u16* Vg = VBp + (size_t)seq_start * 512 + ((size_t)hd * S) * 128;
  const float* tab = (const float*)(lds + AL_TAB);
  const float* misc = (const float*)(lds + AL_MISC);
  const float cBefore = misc[8 + hd], cAfter = misc[12 + hd];
  f32x16 O[4];
#pragma unroll
  for (int nb = 0; nb < 4; ++nb)
#pragma unroll
    for (int r = 0; r < 16; ++r) O[nb][r] = 0.f;
  float l = 0.f;
  const int krow = tid >> 3, kkc = tid & 7;
  const int kl_off = krow * 128 + ((kkc ^ ((krow >> 1) & 7)) << 4);
  const u16* k1src = K1g + (size_t)krow * 64 + kkc * 8;
  const u16* k2src = K2g + (size_t)krow * 64 + kkc * 8;
  int vl_off[2]; const u16* vsrc[2];
#pragma unroll
  for (int i = 0; i < 2; ++i) { int c = tid + 512 * i; int row = c >> 4, ch = c & 15; vl_off[i] = (int)voff_b(row, ch); vsrc[i] = Vg + (size_t)row * 128 + ch * 8; }
  u32x4 sk1, sk2, sv0, sv1;
  sk1 = *(const u32x4*)k1src; sk2 = *(const u32x4*)k2src; sv0 = *(const u32x4*)vsrc[0]; sv1 = *(const u32x4*)vsrc[1];
  *(u32x4*)(lds + AL_STAGE + kl_off) = sk1; *(u32x4*)(lds + AL_STAGE + 8192 + kl_off) = sk2;
  *(u32x4*)(lds + AL_STAGE + 16384 + vl_off[0]) = sv0; *(u32x4*)(lds + AL_STAGE + 16384 + vl_off[1]) = sv1;
  __syncthreads();
  const int NKT = S / 64;
  const int i16 = lane & 15, tq = i16 >> 2, tp = i16 & 3, blk = (lane >> 4) & 1;
  for (int kt = 0; kt < NKT; ++kt) {
    const int st = AL_STAGE + (kt & 1) * 32768;
    if (kt + 1 < NKT) {
      const size_t ko = (size_t)(kt + 1) * 64 * 64, vo = (size_t)(kt + 1) * 64 * 128;
      sk1 = *(const u32x4*)(k1src + ko); sk2 = *(const u32x4*)(k2src + ko);
      sv0 = *(const u32x4*)(vsrc[0] + vo); sv1 = *(const u32x4*)(vsrc[1] + vo);
    }
    const unsigned char* Kl = lds + st + map * 8192;
    const unsigned char* Vl = lds + st + 16384;
#pragma unroll
    for (int sub = 0; sub < 2; ++sub) {
      const int kbase = kt * 64 + 32 * sub;
      const int qlo = q0 + wq * 32;
      const int dmin = kbase - (qlo + 31), dmax = kbase + 31 - qlo;
      f32x16 sT;
      if (dmin >= 559) {
#pragma unroll
        for (int r = 0; r < 16; ++r) sT[r] = cAfter;
      } else if (dmax <= -559) {
#pragma unroll
        for (int r = 0; r < 16; ++r) sT[r] = cBefore;
      } else {
        const int base = kbase + 4 * h - qpos + 640;
#pragma unroll
        for (int r = 0; r < 16; ++r) sT[r] = tab[base + (r & 3) + 8 * (r >> 2)];
      }
      const int row = 32 * sub + r32;
#pragma unroll
      for (int ks = 0; ks < 4; ++ks) {
        bf16x8 a = *(const bf16x8*)(Kl + row * 128 + (((2 * ks + h) ^ ((row >> 1) & 7)) << 4));
        sT = MFMA32(a, qf[ks], sT);
      }
      float ls = 0.f;
#pragma unroll
      for (int r = 0; r < 16; ++r) { sT[r] = __builtin_amdgcn_exp2f(sT[r]); ls += sT[r]; }
      l += ls;
      bf16x8 pb[2];
#pragma unroll
      for (int s2 = 0; s2 < 2; ++s2) {
        u32x4 pw; pw[0] = pk2(sT[8 * s2 + 0], sT[8 * s2 + 1]); pw[1] = pk2(sT[8 * s2 + 2], sT[8 * s2 + 3]);
        pw[2] = pk2(sT[8 * s2 + 4], sT[8 * s2 + 5]); pw[3] = pk2(sT[8 * s2 + 6], sT[8 * s2 + 7]);
        pb[s2] = __builtin_bit_cast(bf16x8, pw);
      }
#pragma unroll
      for (int nb = 0; nb < 4; ++nb)
#pragma unroll
        for (int s2 = 0; s2 < 2; ++s2) {
          const int R = 32 * sub + 16 * s2 + 4 * h + tq;
          const int ch = 4 * nb + 2 * blk + (tp >> 1);
          s16x4 lo = tr_read(Vl + voff_b(R, ch) + 8 * (tp & 1));
          s16x4 hi = tr_read(Vl + voff_b(R + 8, ch) + 8 * (tp & 1));
          O[nb] = MFMA32(cat8(lo, hi), pb[s2], O[nb]);
        }
    }
    if (kt + 1 < NKT) {
      const int nst = AL_STAGE + ((kt + 1) & 1) * 32768;
      *(u32x4*)(lds + nst + kl_off) = sk1; *(u32x4*)(lds + nst + 8192 + kl_off) = sk2;
      *(u32x4*)(lds + nst + 16384 + vl_off[0]) = sv0; *(u32x4*)(lds + nst + 16384 + vl_off[1]) = sv1;
    }
    __syncthreads();
  }
  float ltot = l + __shfl_xor(l, 32);
  float* xbuf = (float*)(lds + AL_STAGE);
  if (map == 1) {
    const float inv = 1.0f / ltot;
#pragma unroll
    for (int nb = 0; nb < 4; ++nb)
#pragma unroll
      for (int r = 0; r < 16; ++r) xbuf[((wq * 64 + nb * 16 + r) << 6) + lane] = O[nb][r] * inv;
  }
  __syncthreads();
  if (map == 0) {
    const float inv = 1.0f / ltot;
    float ss = 0.f;
#pragma unroll
    for (int nb = 0; nb < 4; ++nb)
#pragma unroll
      for (int r = 0; r < 16; ++r) {
        float o = O[nb][r] * inv - lam * xbuf[((wq * 64 + nb * 16 + r) << 6) + lane];
        O[nb][r] = o; ss += o * o;
      }
    ss += __shfl_xor(ss, 32);
    const float rn = __builtin_amdgcn_rsqf(ss * (1.0f / 128.0f) + NORM_EPS) * 0.8f;
    u16* mix = (u16*)((unsigned char*)p.out + OUT_MIX) + (size_t)(seq_start + qpos) * 1024 + 512 + hd * 128;
#pragma unroll
    for (int nb = 0; nb < 4; ++nb)
#pragma unroll
      for (int g4 = 0; g4 < 4; ++g4) {
        const int d0 = 32 * nb + 8 * g4 + 4 * h;
        f32x4 gg = *(const f32x4*)(p.diff_norm_g + d0);
        u32x2 o; o[0] = pk2(O[nb][4 * g4 + 0] * rn * gg[0], O[nb][4 * g4 + 1] * rn * gg[1]);
        o[1] = pk2(O[nb][4 * g4 + 2] * rn * gg[2], O[nb][4 * g4 + 3] * rn * gg[3]);
        *(u32x2*)(mix + d0) = o;
      }
  }
  __syncthreads();
}

DI void dilated_item(const Params& p, unsigned char* lds, int seq_start, int S, int hd, int c, int mblk) {
  const int tid = threadIdx.x, lane = tid & 63, r32 = lane & 31, h = lane >> 5;
  const int w = __builtin_amdgcn_readfirstlane(tid >> 6);
  const u16* QAp = (const u16*)(p.ws + WS_R + 0 * R_REGION);
  const u16* KAp = (const u16*)(p.ws + WS_R + 1 * R_REGION);
  const u16* VAp = (const u16*)(p.ws + WS_R + 2 * R_REGION);
  const int qpos = c + 16 * (32 * mblk + r32);
  const u16* Qp = QAp + (size_t)seq_start * 512 + ((size_t)hd * S + qpos) * 64;
  bf16x8 qf[4];
#pragma unroll
  for (int ks = 0; ks < 4; ++ks) qf[ks] = *(const bf16x8*)(Qp + ks * 16 + h * 8);
  const u16* Kg = KAp + (size_t)seq_start * 512 + ((size_t)hd * S) * 64;
  const u16* Vg = VAp + (size_t)seq_start * 512 + ((size_t)hd * S) * 64;
  unsigned char* vt = lds + AL_VT + w * 4096;
  const float* tabA = (const float*)(lds + AL_TABA) + hd * 3 * 132;
  f32x16 O[2];
#pragma unroll
  for (int nb = 0; nb < 2; ++nb)
#pragma unroll
    for (int r = 0; r < 16; ++r) O[nb][r] = 0.f;
  float l = 0.f;
  const int i16 = lane & 15, tq = i16 >> 2, tp = i16 & 3, blk = (lane >> 4) & 1;
  const int wsw = (((r32 >> 1) & 1) << 2) ^ ((r32 >> 2) & 3);
  for (int tau = 0; tau < 33; ++tau) {
    int d, br, tt;
    if (tau < 5) { d = 16; br = 0; tt = tau; } else if (tau < 13) { d = 4; br = 1; tt = tau - 5; } else { d = 1; br = 2; tt = tau - 13; }
    const int ratio = 16 / d;
    const int n0 = ratio * 32 * mblk - 64 + 32 * tt;
    const int kfirst = c + d * n0, klast = c + d * (n0 + 31);
    if (klast < 0 || kfirst >= S) continue;
    int kpos = c + d * (n0 + r32);
    kpos = kpos < 0 ? 0 : (kpos >= S ? S - 1 : kpos);
    bf16x8 kf[4]; u32x4 vc[4];
#pragma unroll
    for (int ks = 0; ks < 4; ++ks) {
      kf[ks] = *(const bf16x8*)(Kg + (size_t)kpos * 64 + ks * 16 + h * 8);
      vc[ks] = *(const u32x4*)(Vg + (size_t)kpos * 64 + (2 * ks + h) * 8);
    }
#pragma unroll
    for (int ks = 0; ks < 4; ++ks) *(u32x4*)(vt + r32 * 128 + (((2 * ks + h) ^ wsw) << 4)) = vc[ks];
    const int nq = ratio * (32 * mblk + r32);
    const int base = n0 + 4 * h - nq;
    const float* tb = tabA + br * 132;
    f32x16 sT;
#pragma unroll
    for (int r = 0; r < 16; ++r) {
      int dl = base + (r & 3) + 8 * (r >> 2);
      dl = dl < -65 ? -65 : (dl > 65 ? 65 : dl);
      sT[r] = tb[dl + 65];
    }
    if (kfirst < 0 || klast >= S) {
#pragma unroll
      for (int r = 0; r < 16; ++r) { int kp = c + d * (n0 + crow(r, h)); if (kp < 0 || kp >= S) sT[r] = NEG_BIG; }
    }
#pragma unroll
    for (int ks = 0; ks < 4; ++ks) sT = MFMA32(kf[ks], qf[ks], sT);
    float ls = 0.f;
#pragma unroll
    for (int r = 0; r < 16; ++r) { sT[r] = __builtin_amdgcn_exp2f(sT[r]); ls += sT[r]; }
    l += ls;
    bf16x8 pb[2];
#pragma unroll
    for (int s2 = 0; s2 < 2; ++s2) {
      u32x4 pw; pw[0] = pk2(sT[8 * s2 + 0], sT[8 * s2 + 1]); pw[1] = pk2(sT[8 * s2 + 2], sT[8 * s2 + 3]);
      pw[2] = pk2(sT[8 * s2 + 4], sT[8 * s2 + 5]); pw[3] = pk2(sT[8 * s2 + 6], sT[8 * s2 + 7]);
      pb[s2] = __builtin_bit_cast(bf16x8, pw);
    }
#pragma unroll
    for (int nb = 0; nb < 2; ++nb)
#pragma unroll
      for (int s2 = 0; s2 < 2; ++s2) {
        const int R = 16 * s2 + 4 * h + tq;
        const int ch = 4 * nb + 2 * blk + (tp >> 1);
        const int sw0 = (((R >> 1) & 1) << 2) ^ ((R >> 2) & 3);
        const int sw1 = ((((R + 8) >> 1) & 1) << 2) ^ (((R + 8) >> 2) & 3);
        s16x4 lo = tr_read(vt + R * 128 + ((ch ^ sw0) << 4) + 8 * (tp & 1));
        s16x4 hi = tr_read(vt + (R + 8) * 128 + ((ch ^ sw1) << 4) + 8 * (tp & 1));
        O[nb] = MFMA32(cat8(lo, hi), pb[s2], O[nb]);
      }
  }
  const float ltot = l + __shfl_xor(l, 32);
  const float inv = 1.0f / ltot;
  u16* mix = (u16*)((unsigned char*)p.out + OUT_MIX) + (size_t)(seq_start + qpos) * 1024 + hd * 64;
#pragma unroll
  for (int nb = 0; nb < 2; ++nb)
#pragma unroll
    for (int g4 = 0; g4 < 4; ++g4) {
      const int d0 = 32 * nb + 8 * g4 + 4 * h;
      u32x2 o; o[0] = pk2(O[nb][4 * g4 + 0] * inv, O[nb][4 * g4 + 1] * inv); o[1] = pk2(O[nb][4 * g4 + 2] * inv, O[nb][4 * g4 + 3] * inv);
      *(u32x2*)(mix + d0) = o;
    }
}

DI void phase_attn(const Params& p, unsigned char* lds) {
  const int tid = threadIdx.x;
  float* misc = (float*)(lds + AL_MISC);
  if (tid == 0) {
    float gqa = 0.f, gka = 0.f, gqb = 0.f, gkb = 0.f, bm = 0.f;
    for (int i = 0; i < 64; ++i) { gqa = fmaxf(gqa, fabsf(p.q_norm_a[i])); gka = fmaxf(gka, fabsf(p.k_norm_a[i])); gqb = fmaxf(gqb, fabsf(p.q_norm_b[i])); gkb = fmaxf(gkb, fabsf(p.k_norm_b[i])); }
    for (int i = 0; i < 32 * 12; ++i) bm = fmaxf(bm, fabsf(p.rel_bias[i]));
    const float M2 = 8.0f * LOG2E * fmaxf(gqa * gka, gqb * gkb) * 1.02f + bm * LOG2E + 0.1f;
    float s1 = 0.f, s2 = 0.f;
    for (int i = 0; i < 64; ++i) { s1 += p.lq1[i] * p.lk1[i]; s2 += p.lq2[i] * p.lk2[i]; }
    misc[0] = M2; misc[1] = expf(s1) - expf(s2) + 0.2f;
    for (int hd = 0; hd < 4; ++hd) { misc[8 + hd] = p.rel_bias[15 * 12 + 8 + hd] * LOG2E - M2; misc[12 + hd] = p.rel_bias[31 * 12 + 8 + hd] * LOG2E - M2; }
  }
  __syncthreads();
  const float M2 = misc[0], lam = misc[1];
  {
    float* tabA = (float*)(lds + AL_TABA);
    for (int i = tid; i < 8 * 3 * 132; i += NTHR) {
      int hd = i / 396, rem = i % 396, br = rem / 132, idx = rem % 132;
      int dl = idx - 65; float v = NEG_BIG;
      if (dl >= -64 && dl <= 64 && idx < 131) { int d = (br == 0) ? 16 : (br == 1) ? 4 : 1; v = p.rel_bias[rel_bucket(dl * d) * 12 + hd] * LOG2E - M2; }
      tabA[i] = v;
    }
  }
  int cur_hd = -1;
  for (int it = blockIdx.x; it < 1024; it += gridDim.x) {
#pragma unroll 1
    for (int half = 0; half < 2; ++half) {
      int seq_start, S, hd, q0;
      if (half == 0) { int up = it; int seq = up >> 7; hd = (up >> 5) & 3; q0 = (up & 31) * 128; S = 4096; seq_start = seq * 4096; }
      else { int us = it; int seq = us >> 6; hd = (us >> 4) & 3; q0 = (us & 15) * 128; S = 2048; seq_start = T_PROMPT + seq * 2048; }
      if (hd != cur_hd) {
        __syncthreads();
        float* tab = (float*)(lds + AL_TAB);
        for (int i = tid; i < 1281; i += NTHR) tab[i] = p.rel_bias[rel_bucket(i - 640) * 12 + 8 + hd] * LOG2E - M2;
        cur_hd = hd;
        __syncthreads();
      }
      diff_unit(p, lds, seq_start, S, hd, q0, lam);
    }
  }
  __syncthreads();
  const int w = tid >> 6;
  for (int it = blockIdx.x * 8 + w; it < 16384; it += gridDim.x * 8) {
    int seq_start, S, hd, c, mblk;
    if (it < 8192) { int seq = it >> 10; hd = (it >> 7) & 7; c = (it >> 3) & 15; mblk = it & 7; S = 4096; seq_start = seq * 4096; }
    else { int j = it - 8192; int seq = j >> 9; hd = (j >> 6) & 7; c = (j >> 2) & 15; mblk = j & 3; S = 2048; seq_start = T_PROMPT + seq * 2048; }
    dilated_item(p, lds, seq_start, S, hd, c, mblk);
  }
}

DI void phase_outproj(const Params& p, unsigned char* lds) {
  const u16* Mx = (const u16*)((const unsigned char*)p.out + OUT_MIX);
  const u16* Wt = (const u16*)(p.ws + WS_WOUT);
  float* x1 = (float*)(p.ws + WS_X1);
  const int tid = threadIdx.x, lane = tid & 63, r32 = lane & 31, h = lane >> 5;
  const int w = __builtin_amdgcn_readfirstlane(tid >> 6);
  const int wr = w >> 1, wc = w & 1;
  for (int tile = blockIdx.x; tile < 256 * 8; tile += gridDim.x) {
    const int mb = tile >> 3, nbk = tile & 7;
    const int p0 = mb * 256, q0 = nbk * 128;
    f32x16 acc[2][2];
    gemm_mainloop<256, 128>(Mx, Wt, 1024, p0, q0, lds, acc);
#pragma unroll
    for (int i = 0; i < 2; ++i)
#pragma unroll
      for (int r = 0; r < 16; ++r) {
        const int m = p0 + wr * 64 + i * 32 + crow(r, h);
        const float* xr = x_row(p, m);
#pragma unroll
        for (int j = 0; j < 2; ++j) {
          const int n = q0 + wc * 64 + j * 32 + r32;
          x1[(size_t)m * DM + n] = xr[n] + acc[i][j][r];
        }
      }
  }
}

DI void phase_norm2(const Params& p) {
  const int tid = threadIdx.x, lane = tid & 63, w = tid >> 6;
  const float* x1 = (const float*)(p.ws + WS_X1);
  u16* hb = (u16*)(p.ws + WS_H);
  for (int it = blockIdx.x; it < T_TOK / 8; it += gridDim.x) {
    int t = it * 8 + w;
    norm_row(x1 + (size_t)t * DM, p.ffn_norm_g, hb + (size_t)t * DM, lane);
  }
}

DI void phase_peer_query(const Params& p, unsigned char* lds) {
  const u16* Wq = (const u16*)(p.ws + WS_WQ);
  const u16* Hb = (const u16*)(p.ws + WS_H);
  const u16* SK = (const u16*)(p.ws + WS_SK);
  float* tv = (float*)((unsigned char*)p.out + OUT_TV);
  unsigned char* ti = (unsigned char*)p.out + OUT_TI;
  const int tid = threadIdx.x, lane = tid & 63, r32 = lane & 31, h = lane >> 5;
  const int w = __builtin_amdgcn_readfirstlane(tid >> 6);
  const int wr = w >> 2, wc = w & 3;
  for (int tile = blockIdx.x; tile < 256 * 16; tile += gridDim.x) {
    const int mb = tile >> 4, c16 = tile & 15;
    const int p0 = c16 * 128, q0 = mb * 256;
    const int z = c16 & 1;
    f32x16 acc[2][2];
    gemm_mainloop<128, 256>(Wq, Hb, 1024, p0, q0, lds, acc);
    unsigned char* QPl = lds;
    unsigned char* SKl = lds + 65536;
#pragma unroll
    for (int j = 0; j < 2; ++j) {
      const int m = wc * 64 + j * 32 + r32;
#pragma unroll
      for (int i = 0; i < 2; ++i)
#pragma unroll
        for (int g4 = 0; g4 < 4; ++g4) {
          const int nl = wr * 64 + i * 32 + 8 * g4 + 4 * h;
          u32x2 o; o[0] = pk2(acc[i][j][4 * g4 + 0], acc[i][j][4 * g4 + 1]); o[1] = pk2(acc[i][j][4 * g4 + 2], acc[i][j][4 * g4 + 3]);
          *(u32x2*)(QPl + m * 256 + (((nl >> 3) ^ (m & 15)) << 4) + (nl & 7) * 2) = o;
        }
    }
#pragma unroll
    for (int i = 0; i < 4; ++i) {
      int c = tid + 512 * i; int row = c >> 4, ch = c & 15;
      u32x4 v = *(const u32x4*)(SK + (size_t)z * 16384 + row * 128 + ch * 8);
      *(u32x4*)(SKl + row * 256 + ((ch ^ (row & 15)) << 4)) = v;
    }
    __syncthreads();
    f32x16 S2[4];
#pragma unroll
    for (int kb = 0; kb < 4; ++kb)
#pragma unroll
      for (int r = 0; r < 16; ++r) S2[kb][r] = 0.f;
    const int m = w * 32 + r32;
#pragma unroll
    for (int ks = 0; ks < 8; ++ks) {
      bf16x8 b = *(const bf16x8*)(QPl + m * 256 + (((2 * ks + h) ^ (m & 15)) << 4));
#pragma unroll
      for (int kb = 0; kb < 4; ++kb) {
        const int key = kb * 32 + r32;
        bf16x8 a = *(const bf16x8*)(SKl + key * 256 + (((2 * ks + h) ^ (key & 15)) << 4));
        S2[kb] = MFMA32(a, b, S2[kb]);
      }
    }
    {
      const size_t o = ((size_t)(q0 + m) * 16 + c16) * 16;
#pragma unroll 1
      for (int rd = 0; rd < 16; ++rd) {
        float best = -3.0e38f; int be = 0;
#pragma unroll
        for (int e = 0; e < 64; ++e) { const float v = S2[e >> 4][e & 15]; if (v > best) { best = v; be = e; } }
        const int bkey = 32 * (be >> 4) + (be & 3) + 8 * ((be & 15) >> 2) + 4 * h;
        const float pbest = __shfl_xor(best, 32); const int pkey = __shfl_xor(bkey, 32);
        const bool mine = (best > pbest) || (best == pbest && bkey < pkey);
        const float wv = mine ? best : pbest; const int wk = mine ? bkey : pkey;
        const int kill = mine ? be : -1;
#pragma unroll
        for (int e = 0; e < 64; ++e) { if (e == kill) S2[e >> 4][e & 15] = -3.0e38f; }
        if (h == 0) { tv[o + rd] = wv; ti[o + rd] = (unsigned char)wk; }
      }
    }
    __syncthreads();
  }
}

DI void phase_peer_combine(const Params& p, unsigned char* lds) {
  const float* tv = (const float*)((const unsigned char*)p.out + OUT_TV);
  const unsigned char* ti = (const unsigned char*)p.out + OUT_TI;
  u16* eidx = (u16*)(p.ws + WS_EIDX);
  float* gg = (float*)(p.ws + WS_G);
  const int tid = threadIdx.x;
  float* v2l = (float*)lds;
  int* i1l = (int*)(lds + 32768);
  int* i2l = (int*)(lds + 65536);
  for (int it = blockIdx.x; it < (T_TOK * 8) / NTHR; it += gridDim.x) {
    const int gid = it * NTHR + tid;
    const size_t o1 = ((size_t)gid * 2) * 16, o2 = o1 + 16;
    float v1[16];
#pragma unroll
    for (int q4 = 0; q4 < 4; ++q4) {
      f32x4 a = *(const f32x4*)(tv + o1 + 4 * q4); v1[4 * q4] = a[0]; v1[4 * q4 + 1] = a[1]; v1[4 * q4 + 2] = a[2]; v1[4 * q4 + 3] = a[3];
      f32x4 b = *(const f32x4*)(tv + o2 + 4 * q4);
      v2l[(4 * q4 + 0) * 512 + tid] = b[0]; v2l[(4 * q4 + 1) * 512 + tid] = b[1]; v2l[(4 * q4 + 2) * 512 + tid] = b[2]; v2l[(4 * q4 + 3) * 512 + tid] = b[3];
    }
    {
      u32x4 a = *(const u32x4*)(ti + o1), b = *(const u32x4*)(ti + o2);
#pragma unroll
      for (int j = 0; j < 16; ++j) { i1l[j * 512 + tid] = (a[j >> 2] >> (8 * (j & 3))) & 255; i2l[j * 512 + tid] = (b[j >> 2] >> (8 * (j & 3))) & 255; }
    }
    unsigned long long pp = 0ull;
    float bestv[16]; int be[16];
#pragma unroll
    for (int rd = 0; rd < 16; ++rd) {
      float best = -3.0e38f; int ab = 0, bb = 0;
#pragma unroll
      for (int a = 0; a < 16; ++a) {
        const int b = (int)((pp >> (4 * a)) & 15ull);
        const float cnd = v1[a] + v2l[b * 512 + tid];
        if (cnd > best) { best = cnd; ab = a; bb = b; }
      }
      bestv[rd] = best; be[rd] = i1l[ab * 512 + tid] * 128 + i2l[bb * 512 + tid];
      pp += 1ull << (4 * ab);
    }
    float ex[16]; float sum = 0.f;
#pragma unroll
    for (int rd = 0; rd < 16; ++rd) { ex[rd] = __expf(bestv[rd] - bestv[0]); sum += ex[rd]; }
    const float inv = 1.0f / sum;
    const size_t oo = (size_t)gid * 16;
#pragma unroll
    for (int q4 = 0; q4 < 4; ++q4) { f32x4 v = {ex[4 * q4] * inv, ex[4 * q4 + 1] * inv, ex[4 * q4 + 2] * inv, ex[4 * q4 + 3] * inv}; *(f32x4*)(gg + oo + 4 * q4) = v; }
    u32x4 e0, e1;
#pragma unroll
    for (int j = 0; j < 4; ++j) { e0[j] = (unsigned)be[2 * j] | ((unsigned)be[2 * j + 1] << 16); e1[j] = (unsigned)be[8 + 2 * j] | ((unsigned)be[8 + 2 * j + 1] << 16); }
    *(u32x4*)(eidx + oo) = e0; *(u32x4*)(eidx + oo + 8) = e1;
  }
}

DI void phase_peer_gather(const Params& p) {
  const u16* U = (const u16*)(p.ws + WS_U);
  const u16* V = (const u16*)(p.ws + WS_V);
  const u16* Hb = (const u16*)(p.ws + WS_H);
  const float* x1 = (const float*)(p.ws + WS_X1);
  const u16* eidx = (const u16*)(p.ws + WS_EIDX);
  const float* gg = (const float*)(p.ws + WS_G);
  const int tid = threadIdx.x, lane = tid & 63, w = tid >> 6;
  for (int it = blockIdx.x; it < T_TOK / 8; it += gridDim.x) {
    const int t = it * 8 + w;
    float hv[16];
    {
      u32x4 a = *(const u32x4*)(Hb + (size_t)t * DM + lane * 8), b = *(const u32x4*)(Hb + (size_t)t * DM + 512 + lane * 8);
#pragma unroll
      for (int j = 0; j < 4; ++j) { hv[2 * j] = __uint_as_float(a[j] << 16); hv[2 * j + 1] = __uint_as_float(a[j] & 0xffff0000u); hv[8 + 2 * j] = __uint_as_float(b[j] << 16); hv[8 + 2 * j + 1] = __uint_as_float(b[j] & 0xffff0000u); }
    }
    const int e_lo = eidx[(size_t)t * 128 + lane], e_hi = eidx[(size_t)t * 128 + 64 + lane];
    const float g_lo = gg[(size_t)t * 128 + lane], g_hi = gg[(size_t)t * 128 + 64 + lane];
    float acc[16];
#pragma unroll
    for (int j = 0; j < 16; ++j) acc[j] = 0.f;
    for (int grp = 0; grp < 32; ++grp) {
      u32x4 ua[4], ub[4], va[4], vb[4]; float gq[4];
#pragma unroll
      for (int q = 0; q < 4; ++q) {
        const int j = grp * 4 + q;
        const int e = (j < 64) ? __builtin_amdgcn_readlane(e_lo, j & 63) : __builtin_amdgcn_readlane(e_hi, j & 63);
        gq[q] = (j < 64) ? __uint_as_float(__builtin_amdgcn_readlane(__float_as_uint(g_lo), j & 63)) : __uint_as_float(__builtin_amdgcn_readlane(__float_as_uint(g_hi), j & 63));
        const u16* ur = U + (size_t)e * DM; const u16* vr = V + (size_t)e * DM;
        ua[q] = *(const u32x4*)(ur + lane * 8); ub[q] = *(const u32x4*)(ur + 512 + lane * 8);
        va[q] = *(const u32x4*)(vr + lane * 8); vb[q] = *(const u32x4*)(vr + 512 + lane * 8);
      }
      float z[4];
#pragma unroll
      for (int q = 0; q < 4; ++q) {
        float s = 0.f;
#pragma unroll
        for (int j = 0; j < 4; ++j) {
          s += hv[2 * j] * __uint_as_float(ua[q][j] << 16) + hv[2 * j + 1] * __uint_as_float(ua[q][j] & 0xffff0000u);
          s += hv[8 + 2 * j] * __uint_as_float(ub[q][j] << 16) + hv[8 + 2 * j + 1] * __uint_as_float(ub[q][j] & 0xffff0000u);
        }
        z[q] = s;
      }
#pragma unroll
      for (int o = 32; o > 0; o >>= 1) {
#pragma unroll
        for (int q = 0; q < 4; ++q) z[q] += __shfl_xor(z[q], o);
      }
#pragma unroll
      for (int q = 0; q < 4; ++q) {
        const float act = 0.5f * z[q] * (1.0f + erff(z[q] * 0.70710678118654752f));
        const float wgt = gq[q] * act;
#pragma unroll
        for (int j = 0; j < 4; ++j) {
          acc[2 * j] += wgt * __uint_as_float(va[q][j] << 16); acc[2 * j + 1] += wgt * __uint_as_float(va[q][j] & 0xffff0000u);
          acc[8 + 2 * j] += wgt * __uint_as_float(vb[q][j] << 16); acc[8 + 2 * j + 1] += wgt * __uint_as_float(vb[q][j] & 0xffff0000u);
        }
      }
    }
    const float* xr = x1 + (size_t)t * DM;
    float* orow = p.out + (size_t)t * DM;
    f32x4 a0 = *(const f32x4*)(xr + lane * 8), a1 = *(const f32x4*)(xr + lane * 8 + 4), b0 = *(const f32x4*)(xr + 512 + lane * 8), b1 = *(const f32x4*)(xr + 512 + lane * 8 + 4);
    f32x4 r0 = {a0[0] + acc[0], a0[1] + acc[1], a0[2] + acc[2], a0[3] + acc[3]};
    f32x4 r1 = {a1[0] + acc[4], a1[1] + acc[5], a1[2] + acc[6], a1[3] + acc[7]};
    f32x4 r2 = {b0[0] + acc[8], b0[1] + acc[9], b0[2] + acc[10], b0[3] + acc[11]};
    f32x4 r3 = {b1[0] + acc[12], b1[1] + acc[13], b1[2] + acc[14], b1[3] + acc[15]};
    *(f32x4*)(orow + lane * 8) = r0; *(f32x4*)(orow + lane * 8 + 4) = r1; *(f32x4*)(orow + 512 + lane * 8) = r2; *(f32x4*)(orow + 512 + lane * 8 + 4) = r3;
  }
}

__global__ void __launch_bounds__(NTHR, 2) fwd_kernel(Params p) {
  extern __shared__ __attribute__((aligned(16))) unsigned char lds[];
  cg::grid_group grid = cg::this_grid();
#ifndef ONLY_PH
#define PHON(k) 1
#else
#define PHON(k) ((k) == ONLY_PH)
#endif
#define RUN_PHASE(k, call) do { if (PHON(k) && lo <= (k) && (k) < hi) { call; } if (lo <= (k) && (k) + 1 < hi) grid.sync(); } while (0)
  const int lo = p.ph_lo, hi = p.ph_hi;
  RUN_PHASE(0, phase_prep(p, lds));
  RUN_PHASE(1, phase_proj(p, lds));
  RUN_PHASE(2, phase_attn(p, lds));
  RUN_PHASE(3, phase_outproj(p, lds));
  RUN_PHASE(4, phase_norm2(p));
  RUN_PHASE(5, phase_peer_query(p, lds));
  RUN_PHASE(6, phase_peer_combine(p, lds));
  RUN_PHASE(7, phase_peer_gather(p));
}

extern "C" void kernel_launch(void* const* d_in, const int* in_sizes, int n_in, void* d_out, int out_size, void* d_ws, size_t ws_size, hipStream_t stream) {
  static int grid_blocks = 0;
  if (grid_blocks == 0) {
    if (n_in != 20 || ws_size < WS_END || out_size != T_TOK * DM) {
      fprintf(stderr, "kernel_launch: unexpected problem shape (n_in %d, ws %zu, out %d)\n", n_in, ws_size, out_size);
      grid_blocks = -1; return;
    }
    int dev = 0, cus = 0, per_cu = 0;
    hipGetDevice(&dev);
    hipDeviceGetAttribute(&cus, hipDeviceAttributeMultiprocessorCount, dev);
    hipFuncSetAttribute((const void*)fwd_kernel, hipFuncAttributeMaxDynamicSharedMemorySize, LDS_BYTES);
    hipOccupancyMaxActiveBlocksPerMultiprocessor(&per_cu, (const void*)fwd_kernel, NTHR, LDS_BYTES);
    if (per_cu < 1) { fprintf(stderr, "kernel_launch: occupancy query says %d blocks/CU\n", per_cu); per_cu = 1; }
    grid_blocks = cus;
    (void)hipGetLastError();
  }
  if (grid_blocks < 0) return;
  Params p{};
  p.x_prompt = (const float*)d_in[0]; p.x_sample = (const float*)d_in[1]; p.rel_bias = (const float*)d_in[2]; p.attn_norm_g = (const float*)d_in[3];
  p.w_in = (const float*)d_in[4]; p.q_norm_a = (const float*)d_in[5]; p.k_norm_a = (const float*)d_in[6]; p.q_norm_b = (const float*)d_in[7];
  p.k_norm_b = (const float*)d_in[8]; p.lq1 = (const float*)d_in[9]; p.lk1 = (const float*)d_in[10]; p.lq2 = (const float*)d_in[11];
  p.lk2 = (const float*)d_in[12]; p.diff_norm_g = (const float*)d_in[13]; p.w_out = (const float*)d_in[14]; p.ffn_norm_g = (const float*)d_in[15];
  p.peer_w_q = (const float*)d_in[16]; p.peer_sub_keys = (const float*)d_in[17]; p.peer_u = (const float*)d_in[18]; p.peer_v = (const float*)d_in[19];
  p.out = (float*)d_out; p.ws = (unsigned char*)d_ws;
#if FUSED
  p.ph_lo = 0; p.ph_hi = NPHASE;
  void* args[] = {&p};
  hipError_t e = hipLaunchCooperativeKernel((const void*)fwd_kernel, dim3(grid_blocks), dim3(NTHR), args, LDS_BYTES, stream);
  if (e != hipSuccess) fprintf(stderr, "cooperative launch failed: %s (grid %d)\n", hipGetErrorString(e), grid_blocks);
#else
  for (int ph = 0; ph < NPHASE; ++ph) {
    p.ph_lo = ph; p.ph_hi = ph + 1;
    hipLaunchKernelGGL(fwd_kernel, dim3(grid_blocks), dim3(NTHR), LDS_BYTES, stream, p);
  }
#endif
}
```

```cpp
#include <hip/hip_runtime.h>
#include <hip/hip_cooperative_groups.h>
#include <cstdio>
#include <cstdint>
namespace cg = cooperative_groups;

#ifndef FUSED
#define FUSED 1
#endif

typedef unsigned short u16;
typedef __attribute__((ext_vector_type(8))) short bf16x8;
typedef __attribute__((ext_vector_type(4))) short s16x4;
typedef __attribute__((ext_vector_type(16))) float f32x16;
typedef __attribute__((ext_vector_type(4))) float f32x4;
typedef __attribute__((ext_vector_type(4))) unsigned u32x4;
typedef __attribute__((ext_vector_type(2))) unsigned u32x2;
typedef __attribute__((address_space(3))) unsigned char* ldsp_t;

#define DI __device__ __forceinline__
#define MFMA32(a, b, c) __builtin_amdgcn_mfma_f32_32x32x16_bf16((a), (b), (c), 0, 0, 0)

constexpr int DM = 1024;
constexpr int T_TOK = 65536;
constexpr int T_PROMPT = 32768;
constexpr int NTHR = 512;
constexpr int NPHASE = 8;
constexpr float NORM_EPS = 1e-6f;
constexpr float LOG2E = 1.4426950408889634f;
constexpr float C2 = 0.125f * LOG2E;
constexpr float NEG_BIG = -1.0e30f;

constexpr size_t WS_WIN  = 0;
constexpr size_t WS_WOUT = WS_WIN + (size_t)3072 * 1024 * 2;
constexpr size_t WS_WQ   = WS_WOUT + (size_t)1024 * 1024 * 2;
constexpr size_t WS_SK   = WS_WQ + (size_t)2048 * 1024 * 2;
constexpr size_t WS_U    = WS_SK + (size_t)2 * 128 * 128 * 2;
constexpr size_t WS_V    = WS_U + (size_t)16384 * 1024 * 2;
constexpr size_t WS_MISC = WS_V + (size_t)16384 * 1024 * 2;
constexpr size_t WS_R    = WS_MISC + (size_t)1048576;
constexpr size_t R_REGION = (size_t)T_TOK * 512 * 2;
constexpr size_t WS_X1   = WS_R;
constexpr size_t WS_H    = WS_R + (size_t)T_TOK * 1024 * 4;
constexpr size_t WS_EIDX = WS_R + 6 * R_REGION;
constexpr size_t WS_G    = WS_EIDX + (size_t)T_TOK * 128 * 2;
constexpr size_t WS_END  = WS_G + (size_t)T_TOK * 128 * 4;
static_assert(WS_END <= (size_t)536870912, "workspace map exceeds 512 MiB");
constexpr size_t OUT_N1 = 0, OUT_MIX = 134217728, OUT_TV = 0, OUT_TI = 67108864;

constexpr int LDS_BYTES = 131072;

struct Params {
  const float* x_prompt; const float* x_sample; const float* rel_bias; const float* attn_norm_g; const float* w_in;
  const float* q_norm_a; const float* k_norm_a; const float* q_norm_b; const float* k_norm_b;
  const float* lq1; const float* lk1; const float* lq2; const float* lk2; const float* diff_norm_g; const float* w_out;
  const float* ffn_norm_g; const float* peer_w_q; const float* peer_sub_keys; const float* peer_u; const float* peer_v;
  float* out; unsigned char* ws; int ph_lo; int ph_hi;
};

DI u16 f2bf(float f) { unsigned u = __float_as_uint(f); u += 0x7fffu + ((u >> 16) & 1u); return (u16)(u >> 16); }
DI float bf2f(u16 b) { return __uint_as_float(((unsigned)b) << 16); }
DI unsigned pk2(float lo, float hi) {
  typedef float f2_t __attribute__((ext_vector_type(2)));
  typedef __bf16 b2_t __attribute__((ext_vector_type(2)));
  f2_t v = {lo, hi}; b2_t b = __builtin_convertvector(v, b2_t); return __builtin_bit_cast(unsigned, b);
}
DI int crow(int reg, int h) { return (reg & 3) + 8 * (reg >> 2) + 4 * h; }
DI float wave_sum(float v) {
#pragma unroll
  for (int o = 32; o > 0; o >>= 1) v += __shfl_xor(v, o);
  return v;
}
DI void seq_of(int t, int& seq_start, int& S, int& s) {
  if (t < T_PROMPT) { S = 4096; seq_start = t & ~4095; s = t & 4095; }
  else { S = 2048; seq_start = t & ~2047; s = t & 2047; }
}
DI const float* x_row(const Params& p, int t) {
  return (t < T_PROMPT) ? p.x_prompt + (size_t)t * DM : p.x_sample + (size_t)(t - T_PROMPT) * DM;
}
DI int rel_bucket(int rel) {
  int n = rel < 0 ? -rel : rel;
  int b;
  if (n < 8) b = n;
  else if (n < 15) b = 8; else if (n < 27) b = 9; else if (n < 50) b = 10; else if (n < 91) b = 11;
  else if (n < 166) b = 12; else if (n < 305) b = 13; else if (n < 559) b = 14; else b = 15;
  return (rel > 0 ? 16 : 0) + b;
}
DI s16x4 tr_read(const unsigned char* p) {
  typedef short v4i16_t __attribute__((ext_vector_type(4)));
  return __builtin_bit_cast(s16x4, __builtin_amdgcn_ds_read_tr16_b64_v4i16((__attribute__((address_space(3))) v4i16_t*)p));
}
DI bf16x8 cat8(s16x4 lo, s16x4 hi) { return __builtin_shufflevector(lo, hi, 0, 1, 2, 3, 4, 5, 6, 7); }

DI void transpose_item(const float* __restrict__ src, int K, int N, u16* __restrict__ dst, int k0, int n0, unsigned char* lds) {
  float* tile = (float*)lds;
  const int tid = threadIdx.x;
#pragma unroll
  for (int i = 0; i < 8; ++i) {
    int idx = tid + 512 * i; int r = idx >> 6, c = idx & 63;
    tile[r * 65 + c] = src[(size_t)(k0 + r) * N + n0 + c];
  }
  __syncthreads();
  {
    int n = tid >> 3, kc = tid & 7;
    u32x4 o;
    o[0] = pk2(tile[(kc * 8 + 0) * 65 + n], tile[(kc * 8 + 1) * 65 + n]);
    o[1] = pk2(tile[(kc * 8 + 2) * 65 + n], tile[(kc * 8 + 3) * 65 + n]);
    o[2] = pk2(tile[(kc * 8 + 4) * 65 + n], tile[(kc * 8 + 5) * 65 + n]);
    o[3] = pk2(tile[(kc * 8 + 6) * 65 + n], tile[(kc * 8 + 7) * 65 + n]);
    *(u32x4*)(dst + (size_t)(n0 + n) * K + k0 + kc * 8) = o;
  }
  __syncthreads();
}

DI void convert_item(const float* __restrict__ src, u16* __restrict__ dst, size_t base) {
  size_t i = base + (size_t)threadIdx.x * 8;
  f32x4 a = *(const f32x4*)(src + i), b = *(const f32x4*)(src + i + 4);
  u32x4 o; o[0] = pk2(a[0], a[1]); o[1] = pk2(a[2], a[3]); o[2] = pk2(b[0], b[1]); o[3] = pk2(b[2], b[3]);
  *(u32x4*)(dst + i) = o;
}

DI void norm_row(const float* __restrict__ xr, const float* __restrict__ g, u16* __restrict__ orow, int lane) {
  f32x4 v[4]; float ss = 0.f;
#pragma unroll
  for (int i = 0; i < 4; ++i) { v[i] = *(const f32x4*)(xr + lane * 4 + 256 * i); ss += v[i][0] * v[i][0] + v[i][1] * v[i][1] + v[i][2] * v[i][2] + v[i][3] * v[i][3]; }
  ss = wave_sum(ss);
  const float r = __builtin_amdgcn_rsqf(ss * (1.0f / 1024.0f) + NORM_EPS);
#pragma unroll
  for (int i = 0; i < 4; ++i) {
    f32x4 gg = *(const f32x4*)(g + lane * 4 + 256 * i);
    u32x2 o; o[0] = pk2(v[i][0] * r * gg[0], v[i][1] * r * gg[1]); o[1] = pk2(v[i][2] * r * gg[2], v[i][3] * r * gg[3]);
    *(u32x2*)(orow + lane * 4 + 256 * i) = o;
  }
}

DI void phase_prep(const Params& p, unsigned char* lds) {
  const int nb = gridDim.x, bid = blockIdx.x, tid = threadIdx.x;
  u16* wsb = (u16*)p.ws;
  for (int it = bid; it < 768 + 256 + 512; it += nb) {
    if (it < 768) { int kt = it / 48, nt = it % 48; transpose_item(p.w_in, 1024, 3072, (u16*)(p.ws + WS_WIN), kt * 64, nt * 64, lds); }
    else if (it < 1024) { int j = it - 768; int kt = j / 16, nt = j % 16; transpose_item(p.w_out, 1024, 1024, (u16*)(p.ws + WS_WOUT), kt * 64, nt * 64, lds); }
    else { int j = it - 1024; int kt = j / 32, nt = j % 32; transpose_item(p.peer_w_q, 1024, 2048, (u16*)(p.ws + WS_WQ), kt * 64, nt * 64, lds); }
  }
  for (int it = bid; it < 8 + 4096 + 4096; it += nb) {
    if (it < 8) convert_item(p.peer_sub_keys, (u16*)(p.ws + WS_SK), (size_t)it * 4096);
    else if (it < 8 + 4096) convert_item(p.peer_u, (u16*)(p.ws + WS_U), (size_t)(it - 8) * 4096);
    else convert_item(p.peer_v, (u16*)(p.ws + WS_V), (size_t)(it - 8 - 4096) * 4096);
  }
  const int lane = tid & 63, w = tid >> 6;
  u16* n1 = (u16*)((unsigned char*)p.out + OUT_N1);
  for (int it = bid; it < T_TOK / 8; it += nb) {
    int t = it * 8 + w;
    norm_row(x_row(p, t), p.attn_norm_g, n1 + (size_t)t * DM, lane);
  }
  (void)wsb;
}

template <int PR, int QR>
DI void gemm_mainloop(const u16* __restrict__ P, const u16* __restrict__ Q, int K, int p0, int q0, unsigned char* lds, f32x16 (&acc)[2][2]) {
  static_assert(PR + QR == 384, "tile");
  constexpr int STAGE = 384 * 128;
  constexpr int WC = QR / 64;
  const int tid = threadIdx.x, lane = tid & 63, r32 = lane & 31, h = lane >> 5;
  const int w = __builtin_amdgcn_readfirstlane(tid >> 6);
  const int wr = w / WC, wc = w % WC;
#pragma unroll
  for (int i = 0; i < 2; ++i)
#pragma unroll
    for (int j = 0; j < 2; ++j)
#pragma unroll
      for (int r = 0; r < 16; ++r) acc[i][j][r] = 0.f;
  u32x4 stg[6];
  const u16* src[6]; int loff[6];
#pragma unroll
  for (int i = 0; i < 6; ++i) {
    int c = tid + 512 * i; int row = c >> 3, kc = c & 7;
    src[i] = (row < PR) ? P + (size_t)(p0 + row) * K + kc * 8 : Q + (size_t)(q0 + row - PR) * K + kc * 8;
    loff[i] = row * 128 + ((kc ^ ((row >> 1) & 7)) << 4);
  }
  const int KT = K / 64;
#pragma unroll
  for (int i = 0; i < 6; ++i) stg[i] = *(const u32x4*)(src[i]);
#pragma unroll
  for (int i = 0; i < 6; ++i) *(u32x4*)(lds + loff[i]) = stg[i];
  __syncthreads();
  int aoff[2], boff[2], asw[2], bsw[2];
#pragma unroll
  for (int i = 0; i < 2; ++i) {
    int ra = wr * 64 + i * 32 + r32; aoff[i] = ra * 128; asw[i] = (ra >> 1) & 7;
    int rb = PR + wc * 64 + i * 32 + r32; boff[i] = rb * 128; bsw[i] = (rb >> 1) & 7;
  }
  for (int kt = 0; kt < KT; ++kt) {
    const int buf = (kt & 1) * STAGE;
    if (kt + 1 < KT) {
#pragma unroll
      for (int i = 0; i < 6; ++i) stg[i] = *(const u32x4*)(src[i] + (kt + 1) * 64);
    }
#pragma unroll
    for (int ks = 0; ks < 4; ++ks) {
      bf16x8 a[2], b[2];
#pragma unroll
      for (int i = 0; i < 2; ++i) {
        a[i] = *(const bf16x8*)(lds + buf + aoff[i] + (((2 * ks + h) ^ asw[i]) << 4));
        b[i] = *(const bf16x8*)(lds + buf + boff[i] + (((2 * ks + h) ^ bsw[i]) << 4));
      }
#pragma unroll
      for (int i = 0; i < 2; ++i)
#pragma unroll
        for (int j = 0; j < 2; ++j) acc[i][j] = MFMA32(a[i], b[j], acc[i][j]);
    }
    if (kt + 1 < KT) {
      const int nbuf = ((kt + 1) & 1) * STAGE;
#pragma unroll
      for (int i = 0; i < 6; ++i) *(u32x4*)(lds + nbuf + loff[i]) = stg[i];
    }
    __syncthreads();
  }
}

DI void phase_proj(const Params& p, unsigned char* lds) {
  const u16* Wt = (const u16*)(p.ws + WS_WIN);
  const u16* X = (const u16*)((const unsigned char*)p.out + OUT_N1);
  const int tid = threadIdx.x, lane = tid & 63, r32 = lane & 31, h = lane >> 5;
  const int w = __builtin_amdgcn_readfirstlane(tid >> 6);
  const int wr = w >> 1, wc = w & 1;
  for (int tile = blockIdx.x; tile < 12 * 512; tile += gridDim.x) {
    const int mb = tile / 12, nbk = tile % 12;
    const int p0 = nbk * 256, q0 = mb * 128;
    f32x16 acc[2][2];
    gemm_mainloop<256, 128>(Wt, X, 1024, p0, q0, lds, acc);
    const int nbase = p0 + wr * 64;
    const int region = nbase >> 9, hw = (nbase & 511) >> 6;
    const float* g = (region == 0) ? p.q_norm_a : (region == 1) ? p.k_norm_a : (region == 3) ? p.q_norm_b : p.k_norm_b;
    const bool normed = (region != 2 && region != 5);
    const float qs = (region == 0 || region == 3) ? C2 : 1.0f;
    u16* dstR = (u16*)(p.ws + WS_R + (size_t)region * R_REGION);
#pragma unroll
    for (int j = 0; j < 2; ++j) {
      const int t = q0 + wc * 64 + j * 32 + r32;
      int seq_start, S, s; seq_of(t, seq_start, S, s);
      float scale = 1.0f;
      if (normed) {
        float ss = 0.f;
#pragma unroll
        for (int i = 0; i < 2; ++i)
#pragma unroll
          for (int r = 0; r < 16; ++r) ss += acc[i][j][r] * acc[i][j][r];
        ss += __shfl_xor(ss, 32);
        scale = __builtin_amdgcn_rsqf(ss * (1.0f / 64.0f) + NORM_EPS) * qs;
      }
      u16* dst;
      if (region != 5) dst = dstR + (size_t)seq_start * 512 + ((size_t)hw * S + s) * 64;
      else dst = dstR + (size_t)seq_start * 512 + ((size_t)(hw >> 1) * S + s) * 128 + (hw & 1) * 64;
#pragma unroll
      for (int i = 0; i < 2; ++i)
#pragma unroll
        for (int g4 = 0; g4 < 4; ++g4) {
          const int d0 = i * 32 + 8 * g4 + 4 * h;
          float y0 = acc[i][j][4 * g4 + 0] * scale, y1 = acc[i][j][4 * g4 + 1] * scale, y2 = acc[i][j][4 * g4 + 2] * scale, y3 = acc[i][j][4 * g4 + 3] * scale;
          if (normed) { f32x4 gg = *(const f32x4*)(g + d0); y0 *= gg[0]; y1 *= gg[1]; y2 *= gg[2]; y3 *= gg[3]; }
          u32x2 o; o[0] = pk2(y0, y1); o[1] = pk2(y2, y3);
          *(u32x2*)(dst + d0) = o;
        }
    }
  }
}

constexpr int AL_STAGE = 0;
constexpr int AL_TAB   = 65536;
constexpr int AL_TABA  = 73728;
constexpr int AL_VT    = 90112;
constexpr int AL_XL    = 122880;
constexpr int AL_MISC  = 124928;

DI unsigned voff_b(int row, int ch) { return 256u * row + 16u * (ch ^ (((row & 3) << 2) | ((row >> 2) & 3))); }

DI void diff_unit(const Params& p, unsigned char* lds, int seq_start, int S, int hd, int q0, float lam) {
  const int tid = threadIdx.x, lane = tid & 63, r32 = lane & 31, h = lane >> 5;
  const int w = __builtin_amdgcn_readfirstlane(tid >> 6);
  const int map = w >> 2, wq = w & 3;
  const u16* QBp = (const u16*)(p.ws + WS_R + 3 * R_REGION);
  const u16* KBp = (const u16*)(p.ws + WS_R + 4 * R_REGION);
  const u16* VBp = (const u16*)(p.ws + WS_R + 5 * R_REGION);
  const int qpos = q0 + wq * 32 + r32;
  const u16* Qp = QBp + (size_t)seq_start * 512 + ((size_t)(hd * 2 + map) * S + qpos) * 64;
  bf16x8 qf[4];
#pragma unroll
  for (int ks = 0; ks < 4; ++ks) qf[ks] = *(const bf16x8*)(Qp + ks * 16 + h * 8);
  const u16* K1g = KBp + (size_t)seq_start * 512 + ((size_t)(hd * 2 + 0) * S) * 64;
  const u16* K2g = KBp + (size_t)seq_start * 512 + ((size_t)(hd * 2 + 1) * S) * 64;
  const u16* Vg = VBp + (size_t)seq_start * 512 + ((size_t)hd * S) * 128;
  const float* tab = (const float*)(lds + AL_TAB);
  const float* misc = (const float*)(lds + AL_MISC);
  const float cBefore = misc[8 + hd], cAfter = misc[12 + hd];
  f32x16 O[4];
#pragma unroll
  for (int nb = 0; nb < 4; ++nb)
#pragma unroll
    for (int r = 0; r < 16; ++r) O[nb][r] = 0.f;
  float l = 0.f;
  const int krow = tid >> 3, kkc = tid & 7;
  const int kl_off = krow * 128 + ((kkc ^ ((krow >> 1) & 7)) << 4);
  const u16* k1src = K1g + (size_t)krow * 64 + kkc * 8;
  const u16* k2src = K2g + (size_t)krow * 64 + kkc * 8;
  int vl_off[2]; const u16* vsrc[2];
#pragma unroll
  for (int i = 0; i < 2; ++i) { int c = tid + 512 * i; int row = c >> 4, ch = c & 15; vl_off[i] = (int)voff_b(row, ch); vsrc[i] = Vg + (size_t)row * 128 + ch * 8; }
  u32x4 sk1, sk2, sv0, sv1;
  sk1 = *(const u32x4*)k1src; sk2 = *(const u32x4*)k2src; sv0 = *(const u32x4*)vsrc[0]; sv1 = *(const u32x4*)vsrc[1];
  *(u32x4*)(lds + AL_STAGE + kl_off) = sk1; *(u32x4*)(lds + AL_STAGE + 8192 + kl_off) = sk2;
  *(u32x4*)(lds + AL_STAGE + 16384 + vl_off[0]) = sv0; *(u32x4*)(lds + AL_STAGE + 16384 + vl_off[1]) = sv1;
  __syncthreads();
  const int NKT = S / 64;
  const int i16 = lane & 15, tq = i16 >> 2, tp = i16 & 3, blk = (lane >> 4) & 1;
  for (int kt = 0; kt < NKT; ++kt) {
    const int st = AL_STAGE + (kt & 1) * 32768;
    if (kt + 1 < NKT) {
      const size_t ko = (size_t)(kt + 1) * 64 * 64, vo = (size_t)(kt + 1) * 64 * 128;
      sk1 = *(const u32x4*)(k1src + ko); sk2 = *(const u32x4*)(k2src + ko);
      sv0 = *(const u32x4*)(vsrc[0] + vo); sv1 = *(const u32x4*)(vsrc[1] + vo);
    }
    const unsigned char* Kl = lds + st + map * 8192;
    const unsigned char* Vl = lds + st + 16384;
#pragma unroll
    for (int sub = 0; sub < 2; ++sub) {
      const int kbase = kt * 64 + 32 * sub;
      const int qlo = q0 + wq * 32;
      const int dmin = kbase - (qlo + 31), dmax = kbase + 31 - qlo;
      f32x16 sT;
      if (dmin >= 559) {
#pragma unroll
        for (int r = 0; r < 16; ++r) sT[r] = cAfter;
      } else if (dmax <= -559) {
#pragma unroll
        for (int r = 0; r < 16; ++r) sT[r] = cBefore;
      } else {
        const int base = kbase + 4 * h - qpos + 640;
#pragma unroll
        for (int r = 0; r < 16; ++r) sT[r] = tab[base + (r & 3) + 8 * (r >> 2)];
      }
      const int row = 32 * sub + r32;
#pragma unroll
      for (int ks = 0; ks < 4; ++ks) {
        bf16x8 a = *(const bf16x8*)(Kl + row * 128 + (((2 * ks + h) ^ ((row >> 1) & 7)) << 4));
        sT = MFMA32(a, qf[ks], sT);
      }
      float ls = 0.f;
#pragma unroll
      for (int r = 0; r < 16; ++r) { sT[r] = __builtin_amdgcn_exp2f(sT[r]); ls += sT[r]; }
      l += ls;
      bf16x8 pb[2];
#pragma unroll
      for (int s2 = 0; s2 < 2; ++s2) {
        u32x4 pw; pw[0] = pk2(sT[8 * s2 + 0], sT[8 * s2 + 1]); pw[1] = pk2(sT[8 * s2 + 2], sT[8 * s2 + 3]);
        pw[2] = pk2(sT[8 * s2 + 4], sT[8 * s2 + 5]); pw[3] = pk2(sT[8 * s2 + 6], sT[8 * s2 + 7]);
        pb[s2] = __builtin_bit_cast(bf16x8, pw);
      }
#pragma unroll
      for (int nb = 0; nb < 4; ++nb)
#pragma unroll
        for (int s2 = 0; s2 < 2; ++s2) {
          const int R = 32 * sub + 16 * s2 + 4 * h + tq;
          const int ch = 4 * nb + 2 * blk + (tp >> 1);
          s16x4 lo = tr_read(Vl + voff_b(R, ch) + 8 * (tp & 1));
          s16x4 hi = tr_read(Vl + voff_b(R + 8, ch) + 8 * (tp & 1));
          O[nb] = MFMA32(cat8(lo, hi), pb[s2], O[nb]);
        }
    }
    if (kt + 1 < NKT) {
      const int nst = AL_STAGE + ((kt + 1) & 1) * 32768;
      *(u32x4*)(lds + nst + kl_off) = sk1; *(u32x4*)(lds + nst + 8192 + kl_off) = sk2;
      *(u32x4*)(lds + nst + 16384 + vl_off[0]) = sv0; *(u32x4*)(lds + nst + 16384 + vl_off[1]) = sv1;
    }
    __syncthreads();
  }
  float ltot = l + __shfl_xor(l, 32);
  float* xbuf = (float*)(lds + AL_STAGE);
  if (map == 1) {
    const float inv = 1.0f / ltot;
#pragma unroll
    for (int nb = 0; nb < 4; ++nb)
#pragma unroll
      for (int r = 0; r < 16; ++r) xbuf[((wq * 64 + nb * 16 + r) << 6) + lane] = O[nb][r] * inv;
  }
  __syncthreads();
  if (map == 0) {
    const float inv = 1.0f / ltot;
    float ss = 0.f;
#pragma unroll
    for (int nb = 0; nb < 4; ++nb)
#pragma unroll
      for (int r = 0; r < 16; ++r) {
        float o = O[nb][r] * inv - lam * xbuf[((wq * 64 + nb * 16 + r) << 6) + lane];
        O[nb][r] = o; ss += o * o;
      }
    ss += __shfl_xor(ss, 32);
    const float rn = __builtin_amdgcn_rsqf(ss * (1.0f / 128.0f) + NORM_EPS) * 0.8f;
    u16* mix = (u16*)((unsigned char*)p.out + OUT_MIX) + (size_t)(seq_start + qpos) * 1024 + 512 + hd * 128;
#pragma unroll
    for (int nb = 0; nb < 4; ++nb)
#pragma unroll
      for (int g4 = 0; g4 < 4; ++g4) {
        const int d0 = 32 * nb + 8 * g4 + 4 * h;
        f32x4 gg = *(const f32x4*)(p.diff_norm_g + d0);
        u32x2 o; o[0] = pk2(O[nb][4 * g4 + 0] * rn * gg[0], O[nb][4 * g4 + 1] * rn * gg[1]);
        o[1] = pk2(O[nb][4 * g4 + 2] * rn * gg[2], O[nb][4 * g4 + 3] * rn * gg[3]);
        *(u32x2*)(mix + d0) = o;
      }
  }
  __syncthreads();
}

DI void dilated_item(const Params& p, unsigned char* lds, int seq_start, int S, int hd, int c, int mblk) {
  const int tid = threadIdx.x, lane = tid & 63, r32 = lane & 31, h = lane >> 5;
  const int w = __builtin_amdgcn_readfirstlane(tid >> 6);
  const u16* QAp = (const u16*)(p.ws + WS_R + 0 * R_REGION);
  const u16* KAp = (const u16*)(p.ws + WS_R + 1 * R_REGION);
  const u16* VAp = (const u16*)(p.ws + WS_R + 2 * R_REGION);
  const int qpos = c + 16 * (32 * mblk + r32);
  const u16* Qp = QAp + (size_t)seq_start * 512 + ((size_t)hd * S + qpos) * 64;
  bf16x8 qf[4];
#pragma unroll
  for (int ks = 0; ks < 4; ++ks) qf[ks] = *(const bf16x8*)(Qp + ks * 16 + h * 8);
  const u16* Kg = KAp + (size_t)seq_start * 512 + ((size_t)hd * S) * 64;
  const u16* Vg = VAp + (size_t)seq_start * 512 + ((size_t)hd * S) * 64;
  unsigned char* vt = lds + AL_VT + w * 4096;
  const float* tabA = (const float*)(lds + AL_TABA) + hd * 3 * 132;
  f32x16 O[2];
#pragma unroll
  for (int nb = 0; nb < 2; ++nb)
#pragma unroll
    for (int r = 0; r < 16; ++r) O[nb][r] = 0.f;
  float l = 0.f;
  const int i16 = lane & 15, tq = i16 >> 2, tp = i16 & 3, blk = (lane >> 4) & 1;
  const int wsw = (((r32 >> 1) & 1) << 2) ^ ((r32 >> 2) & 3);
  for (int tau = 0; tau < 33; ++tau) {
    int d, br, tt;
    if (tau < 5) { d = 16; br = 0; tt = tau; } else if (tau < 13) { d = 4; br = 1; tt = tau - 5; } else { d = 1; br = 2; tt = tau - 13; }
    const int ratio = 16 / d;
    const int n0 = ratio * 32 * mblk - 64 + 32 * tt;
    const int kfirst = c + d * n0, klast = c + d * (n0 + 31);
    if (klast < 0 || kfirst >= S) continue;
    int kpos = c + d * (n0 + r32);
    kpos = kpos < 0 ? 0 : (kpos >= S ? S - 1 : kpos);
    bf16x8 kf[4]; u32x4 vc[4];
#pragma unroll
    for (int ks = 0; ks < 4; ++ks) {
      kf[ks] = *(const bf16x8*)(Kg + (size_t)kpos * 64 + ks * 16 + h * 8);
      vc[ks] = *(const u32x4*)(Vg + (size_t)kpos * 64 + (2 * ks + h) * 8);
    }
#pragma unroll
    for (int ks = 0; ks < 4; ++ks) *(u32x4*)(vt + r32 * 128 + (((2 * ks + h) ^ wsw) << 4)) = vc[ks];
    const int nq = ratio * (32 * mblk + r32);
    const int base = n0 + 4 * h - nq;
    const float* tb = tabA + br * 132;
    f32x16 sT;
#pragma unroll
    for (int r = 0; r < 16; ++r) {
      int dl = base + (r & 3) + 8 * (r >> 2);
      dl = dl < -65 ? -65 : (dl > 65 ? 65 : dl);
      sT[r] = tb[dl + 65];
    }
    if (kfirst < 0 || klast >= S) {
#pragma unroll
      for (int r = 0; r < 16; ++r) { int kp = c + d * (n0 + crow(r, h)); if (kp < 0 || kp >= S) sT[r] = NEG_BIG; }
    }
#pragma unroll
    for (int ks = 0; ks < 4; ++ks) sT = MFMA32(kf[ks], qf[ks], sT);
    float ls = 0.f;
#pragma unroll
    for (int r = 0; r < 16; ++r) { sT[r] = __builtin_amdgcn_exp2f(sT[r]); ls += sT[r]; }
    l += ls;
    bf16x8 pb[2];
#pragma unroll
    for (int s2 = 0; s2 < 2; ++s2) {
      u32x4 pw; pw[0] = pk2(sT[8 * s2 + 0], sT[8 * s2 + 1]); pw[1] = pk2(sT[8 * s2 + 2], sT[8 * s2 + 3]);
      pw[2] = pk2(sT[8 * s2 + 4], sT[8 * s2 + 5]); pw[3] = pk2(sT[8 * s2 + 6], sT[8 * s2 + 7]);
      pb[s2] = __builtin_bit_cast(bf16x8, pw);
    }
#pragma unroll
    for (int nb = 0; nb < 2; ++nb)
#pragma unroll
      for (int s2 = 0; s2 < 2; ++s2) {
        const int R = 16 * s2 + 4 * h + tq;
        const int ch = 4 * nb + 2 * blk + (tp >> 1);
        const int sw0 = (((R >> 1) & 1) << 2) ^ ((R >> 2) & 3);
        const int sw1 = ((((R + 8) >> 1) & 1) << 2) ^ (((R + 8) >> 2) & 3);
        s16x4 lo = tr_read(vt + R * 128 + ((ch ^ sw0) << 4) + 8 * (tp & 1));
        s16x4 hi = tr_read(vt + (R + 8) * 128 + ((ch ^ sw1) << 4) + 8 * (tp & 1));
        O[nb] = MFMA32(cat8(lo, hi), pb[s2], O[nb]);
      }
  }
  const float ltot = l + __shfl_xor(l, 32);
  const float inv = 1.0f / ltot;
  u16* mix = (u16*)((unsigned char*)p.out + OUT_MIX) + (size_t)(seq_start + qpos) * 1024 + hd * 64;
#pragma unroll
  for (int nb = 0; nb < 2; ++nb)
#pragma unroll
    for (int g4 = 0; g4 < 4; ++g4) {
      const int d0 = 32 * nb + 8 * g4 + 4 * h;
      u32x2 o; o[0] = pk2(O[nb][4 * g4 + 0] * inv, O[nb][4 * g4 + 1] * inv); o[1] = pk2(O[nb][4 * g4 + 2] * inv, O[nb][4 * g4 + 3] * inv);
      *(u32x2*)(mix + d0) = o;
    }
}

DI void phase_attn(const Params& p, unsigned char* lds) {
  const int tid = threadIdx.x;
  float* misc = (float*)(lds + AL_MISC);
  if (tid == 0) {
    float gqa = 0.f, gka = 0.f, gqb = 0.f, gkb = 0.f, bm = 0.f;
    for (int i = 0; i < 64; ++i) { gqa = fmaxf(gqa, fabsf(p.q_norm_a[i])); gka = fmaxf(gka, fabsf(p.k_norm_a[i])); gqb = fmaxf(gqb, fabsf(p.q_norm_b[i])); gkb = fmaxf(gkb, fabsf(p.k_norm_b[i])); }
    for (int i = 0; i < 32 * 12; ++i) bm = fmaxf(bm, fabsf(p.rel_bias[i]));
    const float M2 = 8.0f * LOG2E * fmaxf(gqa * gka, gqb * gkb) * 1.02f + bm * LOG2E + 0.1f;
    float s1 = 0.f, s2 = 0.f;
    for (int i = 0; i < 64; ++i) { s1 += p.lq1[i] * p.lk1[i]; s2 += p.lq2[i] * p.lk2[i]; }
    misc[0] = M2; misc[1] = expf(s1) - expf(s2) + 0.2f;
    for (int hd = 0; hd < 4; ++hd) { misc[8 + hd] = p.rel_bias[15 * 12 + 8 + hd] * LOG2E - M2; misc[12 + hd] = p.rel_bias[31 * 12 + 8 + hd] * LOG2E - M2; }
  }
  __syncthreads();
  const float M2 = misc[0], lam = misc[1];
  {
    float* tabA = (float*)(lds + AL_TABA);
    for (int i = tid; i < 8 * 3 * 132; i += NTHR) {
      int hd = i / 396, rem = i % 396, br = rem / 132, idx = rem % 132;
      int dl = idx - 65; float v = NEG_BIG;
      if (dl >= -64 && dl <= 64 && idx < 131) { int d = (br == 0) ? 16 : (br == 1) ? 4 : 1; v = p.rel_bias[rel_bucket(dl * d) * 12 + hd] * LOG2E - M2; }
      tabA[i] = v;
    }
  }
  int cur_hd = -1;
  for (int it = blockIdx.x; it < 1024; it += gridDim.x) {
#pragma unroll 1
    for (int half = 0; half < 2; ++half) {
      int seq_start, S, hd, q0;
      if (half == 0) { int up = it; int seq = up >> 7; hd = (up >> 5) & 3; q0 = (up & 31) * 128; S = 4096; seq_start = seq * 4096; }
      else { int us = it; int seq = us >> 6; hd = (us >> 4) & 3; q0 = (us & 15) * 128; S = 2048; seq_start = T_PROMPT + seq * 2048; }
      if (hd != cur_hd) {
        __syncthreads();
        float* tab = (float*)(lds + AL_TAB);
        for (int i = tid; i < 1281; i += NTHR) tab[i] = p.rel_bias[rel_bucket(i - 640) * 12 + 8 + hd] * LOG2E - M2;
        cur_hd = hd;
        __syncthreads();
      }
      diff_unit(p, lds, seq_start, S, hd, q0, lam);
    }
  }
  __syncthreads();
  const int w = tid >> 6;
  for (int it = blockIdx.x * 8 + w; it < 16384; it += gridDim.x * 8) {
    int seq_start, S, hd, c, mblk;
    if (it < 8192) { int seq = it >> 10; hd = (it >> 7) & 7; c = (it >> 3) & 15; mblk = it & 7; S = 4096; seq_start = seq * 4096; }
    else { int j = it - 8192; int seq = j >> 9; hd = (j >> 6) & 7; c = (j >> 2) & 15; mblk = j & 3; S = 2048; seq_start = T_PROMPT + seq * 2048; }
    dilated_item(p, lds, seq_start, S, hd, c, mblk);
  }
}

DI void phase_outproj(const Params& p, unsigned char* lds) {
  const u16* Mx = (const u16*)((const unsigned char*)p.out + OUT_MIX);
  const u16* Wt = (const u16*)(p.ws + WS_WOUT);
  float* x1 = (float*)(p.ws + WS_X1);
  const int tid = threadIdx.x, lane = tid & 63, r32 = lane & 31, h = lane >> 5;
  const int w = __builtin_amdgcn_readfirstlane(tid >> 6);
  const int wr = w >> 1, wc = w & 1;
  for (int tile = blockIdx.x; tile < 256 * 8; tile += gridDim.x) {
    const int mb = tile >> 3, nbk = tile & 7;
    const int p0 = mb * 256, q0 = nbk * 128;
    f32x16 acc[2][2];
    gemm_mainloop<256, 128>(Mx, Wt, 1024, p0, q0, lds, acc);
#pragma unroll
    for (int i = 0; i < 2; ++i)
#pragma unroll
      for (int r = 0; r < 16; ++r) {
        const int m = p0 + wr * 64 + i * 32 + crow(r, h);
        const float* xr = x_row(p, m);
#pragma unroll
        for (int j = 0; j < 2; ++j) {
          const int n = q0 + wc * 64 + j * 32 + r32;
          x1[(size_t)m * DM + n] = xr[n] + acc[i][j][r];
        }
      }
  }
}

DI void phase_norm2(const Params& p) {
  const int tid = threadIdx.x, lane = tid & 63, w = tid >> 6;
  const float* x1 = (const float*)(p.ws + WS_X1);
  u16* hb = (u16*)(p.ws + WS_H);
  for (int it = blockIdx.x; it < T_TOK / 8; it += gridDim.x) {
    int t = it * 8 + w;
    norm_row(x1 + (size_t)t * DM, p.ffn_norm_g, hb + (size_t)t * DM, lane);
  }
}

DI void phase_peer_query(const Params& p, unsigned char* lds) {
  const u16* Wq = (const u16*)(p.ws + WS_WQ);
  const u16* Hb = (const u16*)(p.ws + WS_H);
  const u16* SK = (const u16*)(p.ws + WS_SK);
  float* tv = (float*)((unsigned char*)p.out + OUT_TV);
  unsigned char* ti = (unsigned char*)p.out + OUT_TI;
  const int tid = threadIdx.x, lane = tid & 63, r32 = lane & 31, h = lane >> 5;
  const int w = __builtin_amdgcn_readfirstlane(tid >> 6);
  const int wr = w >> 2, wc = w & 3;
  for (int tile = blockIdx.x; tile < 256 * 16; tile += gridDim.x) {
    const int mb = tile >> 4, c16 = tile & 15;
    const int p0 = c16 * 128, q0 = mb * 256;
    const int z = c16 & 1;
    f32x16 acc[2][2];
    gemm_mainloop<128, 256>(Wq, Hb, 1024, p0, q0, lds, acc);
    unsigned char* QPl = lds;
    unsigned char* SKl = lds + 65536;
#pragma unroll
    for (int j = 0; j < 2; ++j) {
      const int m = wc * 64 + j * 32 + r32;
#pragma unroll
      for (int i = 0; i < 2; ++i)
#pragma unroll
        for (int g4 = 0; g4 < 4; ++g4) {
          const int nl = wr * 64 + i * 32 + 8 * g4 + 4 * h;
          u32x2 o; o[0] = pk2(acc[i][j][4 * g4 + 0], acc[i][j][4 * g4 + 1]); o[1] = pk2(acc[i][j][4 * g4 + 2], acc[i][j][4 * g4 + 3]);
          *(u32x2*)(QPl + m * 256 + (((nl >> 3) ^ (m & 15)) << 4) + (nl & 7) * 2) = o;
        }
    }
#pragma unroll
    for (int i = 0; i < 4; ++i) {
      int c = tid + 512 * i; int row = c >> 4, ch = c & 15;
      u32x4 v = *(const u32x4*)(SK + (size_t)z * 16384 + row * 128 + ch * 8);
      *(u32x4*)(SKl + row * 256 + ((ch ^ (row & 15)) << 4)) = v;
    }
    __syncthreads();
    f32x16 S2[4];
#pragma unroll
    for (int kb = 0; kb < 4; ++kb)
#pragma unroll
      for (int r = 0; r < 16; ++r) S2[kb][r] = 0.f;
    const int m = w * 32 + r32;
#pragma unroll
    for (int ks = 0; ks < 8; ++ks) {
      bf16x8 b = *(const bf16x8*)(QPl + m * 256 + (((2 * ks + h) ^ (m & 15)) << 4));
#pragma unroll
      for (int kb = 0; kb < 4; ++kb) {
        const int key = kb * 32 + r32;
        bf16x8 a = *(const bf16x8*)(SKl + key * 256 + (((2 * ks + h) ^ (key & 15)) << 4));
        S2[kb] = MFMA32(a, b, S2[kb]);
      }
    }
    {
      const size_t o = ((size_t)(q0 + m) * 16 + c16) * 16;
#pragma unroll 1
      for (int rd = 0; rd < 16; ++rd) {
        float best = -3.0e38f; int be = 0;
#pragma unroll
        for (int e = 0; e < 64; ++e) { const float v = S2[e >> 4][e & 15]; if (v > best) { best = v; be = e; } }
        const int bkey = 32 * (be >> 4) + (be & 3) + 8 * ((be & 15) >> 2) + 4 * h;
        const float pbest = __shfl_xor(best, 32); const int pkey = __shfl_xor(bkey, 32);
        const bool mine = (best > pbest) || (best == pbest && bkey < pkey);
        const float wv = mine ? best : pbest; const int wk = mine ? bkey : pkey;
        const int kill = mine ? be : -1;
#pragma unroll
        for (int e = 0; e < 64; ++e) { if (e == kill) S2[e >> 4][e & 15] = -3.0e38f; }
        if (h == 0) { tv[o + rd] = wv; ti[o + rd] = (unsigned char)wk; }
      }
    }
    __syncthreads();
  }
}

DI void phase_peer_combine(const Params& p, unsigned char* lds) {
  const float* tv = (const float*)((const unsigned char*)p.out + OUT_TV);
  const unsigned char* ti = (const unsigned char*)p.out + OUT_TI;
  u16* eidx = (u16*)(p.ws + WS_EIDX);
  float* gg = (float*)(p.ws + WS_G);
  const int tid = threadIdx.x;
  float* v2l = (float*)lds;
  int* i1l = (int*)(lds + 32768);
  int* i2l = (int*)(lds + 65536);
  for (int it = blockIdx.x; it < (T_TOK * 8) / NTHR; it += gridDim.x) {
    const int gid = it * NTHR + tid;
    const size_t o1 = ((size_t)gid * 2) * 16, o2 = o1 + 16;
    float v1[16];
#pragma unroll
    for (int q4 = 0; q4 < 4; ++q4) {
      f32x4 a = *(const f32x4*)(tv + o1 + 4 * q4); v1[4 * q4] = a[0]; v1[4 * q4 + 1] = a[1]; v1[4 * q4 + 2] = a[2]; v1[4 * q4 + 3] = a[3];
      f32x4 b = *(const f32x4*)(tv + o2 + 4 * q4);
      v2l[(4 * q4 + 0) * 512 + tid] = b[0]; v2l[(4 * q4 + 1) * 512 + tid] = b[1]; v2l[(4 * q4 + 2) * 512 + tid] = b[2]; v2l[(4 * q4 + 3) * 512 + tid] = b[3];
    }
    {
      u32x4 a = *(const u32x4*)(ti + o1), b = *(const u32x4*)(ti + o2);
#pragma unroll
      for (int j = 0; j < 16; ++j) { i1l[j * 512 + tid] = (a[j >> 2] >> (8 * (j & 3))) & 255; i2l[j * 512 + tid] = (b[j >> 2] >> (8 * (j & 3))) & 255; }
    }
    unsigned long long pp = 0ull;
    float bestv[16]; int be[16];
#pragma unroll
    for (int rd = 0; rd < 16; ++rd) {
      float best = -3.0e38f; int ab = 0, bb = 0;
#pragma unroll
      for (int a = 0; a < 16; ++a) {
        const int b = (int)((pp >> (4 * a)) & 15ull);
        const float cnd = v1[a] + v2l[b * 512 + tid];
        if (cnd > best) { best = cnd; ab = a; bb = b; }
      }
      bestv[rd] = best; be[rd] = i1l[ab * 512 + tid] * 128 + i2l[bb * 512 + tid];
      pp += 1ull << (4 * ab);
    }
    float ex[16]; float sum = 0.f;
#pragma unroll
    for (int rd = 0; rd < 16; ++rd) { ex[rd] = __expf(bestv[rd] - bestv[0]); sum += ex[rd]; }
    const float inv = 1.0f / sum;
    const size_t oo = (size_t)gid * 16;
#pragma unroll
    for (int q4 = 0; q4 < 4; ++q4) { f32x4 v = {ex[4 * q4] * inv, ex[4 * q4 + 1] * inv, ex[4 * q4 + 2] * inv, ex[4 * q4 + 3] * inv}; *(f32x4*)(gg + oo + 4 * q4) = v; }
    u32x4 e0, e1;
#pragma unroll
    for (int j = 0; j < 4; ++j) { e0[j] = (unsigned)be[2 * j] | ((unsigned)be[2 * j + 1] << 16); e1[j] = (unsigned)be[8 + 2 * j] | ((unsigned)be[8 + 2 * j + 1] << 16); }
    *(u32x4*)(eidx + oo) = e0; *(u32x4*)(eidx + oo + 8) = e1;
  }
}

DI void phase_peer_gather(const Params& p) {
  const u16* U = (const u16*)(p.ws + WS_U);
  const u16* V = (const u16*)(p.ws + WS_V);
  const u16* Hb = (const u16*)(p.ws + WS_H);
  const float* x1 = (const float*)(p.ws + WS_X1);
  const u16* eidx = (const u16*)(p.ws + WS_EIDX);
  const float* gg = (const float*)(p.ws + WS_G);
  const int tid = threadIdx.x, lane = tid & 63, w = tid >> 6;
  for (int it = blockIdx.x; it < T_TOK / 8; it += gridDim.x) {
    const int t = it * 8 + w;
    float hv[16];
    {
      u32x4 a = *(const u32x4*)(Hb + (size_t)t * DM + lane * 8), b = *(const u32x4*)(Hb + (size_t)t * DM + 512 + lane * 8);
#pragma unroll
      for (int j = 0; j < 4; ++j) { hv[2 * j] = __uint_as_float(a[j] << 16); hv[2 * j + 1] = __uint_as_float(a[j] & 0xffff0000u); hv[8 + 2 * j] = __uint_as_float(b[j] << 16); hv[8 + 2 * j + 1] = __uint_as_float(b[j] & 0xffff0000u); }
    }
    const int e_lo = eidx[(size_t)t * 128 + lane], e_hi = eidx[(size_t)t * 128 + 64 + lane];
    const float g_lo = gg[(size_t)t * 128 + lane], g_hi = gg[(size_t)t * 128 + 64 + lane];
    float acc[16];
#pragma unroll
    for (int j = 0; j < 16; ++j) acc[j] = 0.f;
    for (int grp = 0; grp < 32; ++grp) {
      u32x4 ua[4], ub[4], va[4], vb[4]; float gq[4];
#pragma unroll
      for (int q = 0; q < 4; ++q) {
        const int j = grp * 4 + q;
        const int e = (j < 64) ? __builtin_amdgcn_readlane(e_lo, j & 63) : __builtin_amdgcn_readlane(e_hi, j & 63);
        gq[q] = (j < 64) ? __uint_as_float(__builtin_amdgcn_readlane(__float_as_uint(g_lo), j & 63)) : __uint_as_float(__builtin_amdgcn_readlane(__float_as_uint(g_hi), j & 63));
        const u16* ur = U + (size_t)e * DM; const u16* vr = V + (size_t)e * DM;
        ua[q] = *(const u32x4*)(ur + lane * 8); ub[q] = *(const u32x4*)(ur + 512 + lane * 8);
        va[q] = *(const u32x4*)(vr + lane * 8); vb[q] = *(const u32x4*)(vr + 512 + lane * 8);
      }
      float z[4];
#pragma unroll
      for (int q = 0; q < 4; ++q) {
        float s = 0.f;
#pragma unroll
        for (int j = 0; j < 4; ++j) {
          s += hv[2 * j] * __uint_as_float(ua[q][j] << 16) + hv[2 * j + 1] * __uint_as_float(ua[q][j] & 0xffff0000u);
          s += hv[8 + 2 * j] * __uint_as_float(ub[q][j] << 16) + hv[8 + 2 * j + 1] * __uint_as_float(ub[q][j] & 0xffff0000u);
        }
        z[q] = s;
      }
#pragma unroll
      for (int o = 32; o > 0; o >>= 1) {
#pragma unroll
        for (int q = 0; q < 4; ++q) z[q] += __shfl_xor(z[q], o);
      }
#pragma unroll
      for (int q = 0; q < 4; ++q) {
        const float act = 0.5f * z[q] * (1.0f + erff(z[q] * 0.70710678118654752f));
        const float wgt = gq[q] * act;
#pragma unroll
        for (int j = 0; j < 4; ++j) {
          acc[2 * j] += wgt * __uint_as_float(va[q][j] << 16); acc[2 * j + 1] += wgt * __uint_as_float(va[q][j] & 0xffff0000u);
          acc[8 + 2 * j] += wgt * __uint_as_float(vb[q][j] << 16); acc[8 + 2 * j + 1] += wgt * __uint_as_float(vb[q][j] & 0xffff0000u);
        }
      }
    }
    const float* xr = x1 + (size_t)t * DM;
    float* orow = p.out + (size_t)t * DM;
    f32x4 a0 = *(const f32x4*)(xr + lane * 8), a1 = *(const f32x4*)(xr + lane * 8 + 4), b0 = *(const f32x4*)(xr + 512 + lane * 8), b1 = *(const f32x4*)(xr + 512 + lane * 8 + 4);
    f32x4 r0 = {a0[0] + acc[0], a0[1] + acc[1], a0[2] + acc[2], a0[3] + acc[3]};
    f32x4 r1 = {a1[0] + acc[4], a1[1] + acc[5], a1[2] + acc[6], a1[3] + acc[7]};
    f32x4 r2 = {b0[0] + acc[8], b0[1] + acc[9], b0[2] + acc[10], b0[3] + acc[11]};
    f32x4 r3 = {b1[0] + acc[12], b1[1] + acc[13], b1[2] + acc[14], b1[3] + acc[15]};
    *(f32x4*)(orow + lane * 8) = r0; *(f32x4*)(orow + lane * 8 + 4) = r1; *(f32x4*)(orow + 512 + lane * 8) = r2; *(f32x4*)(orow + 512 + lane * 8 + 4) = r3;
  }
}

__global__ void __launch_bounds__(NTHR, 2) fwd_kernel(Params p) {
  extern __shared__ __attribute__((aligned(16))) unsigned char lds[];
  cg::grid_group grid = cg::this_grid();
#ifndef ONLY_PH
#define PHON(k) 1
#else
#define PHON(k) ((k) == ONLY_PH)
#endif
#define RUN_PHASE(k, call) do { if (PHON(k) && lo <= (k) && (k) < hi) { call; } if (lo <= (k) && (k) + 1 < hi) grid.sync(); } while (0)
  const int lo = p.ph_lo, hi = p.ph_hi;
  RUN_PHASE(0, phase_prep(p, lds));
  RUN_PHASE(1, phase_proj(p, lds));
  RUN_PHASE(2, phase_attn(p, lds));
  RUN_PHASE(3, phase_outproj(p, lds));
  RUN_PHASE(4, phase_norm2(p));
  RUN_PHASE(5, phase_peer_query(p, lds));
  RUN_PHASE(6, phase_peer_combine(p, lds));
  RUN_PHASE(7, phase_peer_gather(p));
}

extern "C" void kernel_launch(void* const* d_in, const int* in_sizes, int n_in, void* d_out, int out_size, void* d_ws, size_t ws_size, hipStream_t stream) {
  static int grid_blocks = 0;
  if (grid_blocks == 0) {
    if (n_in != 20 || ws_size < WS_END || out_size != T_TOK * DM) {
      fprintf(stderr, "kernel_launch: unexpected problem shape (n_in %d, ws %zu, out %d)\n", n_in, ws_size, out_size);
      grid_blocks = -1; return;
    }
    int dev = 0, cus = 0, per_cu = 0;
    hipGetDevice(&dev);
    hipDeviceGetAttribute(&cus, hipDeviceAttributeMultiprocessorCount, dev);
    hipFuncSetAttribute((const void*)fwd_kernel, hipFuncAttributeMaxDynamicSharedMemorySize, LDS_BYTES);
    hipOccupancyMaxActiveBlocksPerMultiprocessor(&per_cu, (const void*)fwd_kernel, NTHR, LDS_BYTES);
    if (per_cu < 1) { fprintf(stderr, "kernel_launch: occupancy query says %d blocks/CU\n", per_cu); per_cu = 1; }
    grid_blocks = cus;
    (void)hipGetLastError();
  }
  if (grid_blocks < 0) return;
  Params p{};
  p.x_prompt = (const float*)d_in[0]; p.x_sample = (const float*)d_in[1]; p.rel_bias = (const float*)d_in[2]; p.attn_norm_g = (const float*)d_in[3];
  p.w_in = (const float*)d_in[4]; p.q_norm_a = (const float*)d_in[5]; p.k_norm_a = (const float*)d_in[6]; p.q_norm_b = (const float*)d_in[7];
  p.k_norm_b = (const float*)d_in[8]; p.lq1 = (const float*)d_in[9]; p.lk1 = (const float*)d_in[10]; p.lq2 = (const float*)d_in[11];
  p.lk2 = (const float*)d_in[12]; p.diff_norm_g = (const float*)d_in[13]; p.w_out = (const float*)d_in[14]; p.ffn_norm_g = (const float*)d_in[15];
  p.peer_w_q = (const float*)d_in[16]; p.peer_sub_keys = (const float*)d_in[17]; p.peer_u = (const float*)d_in[18]; p.peer_v = (const float*)d_in[19];
  p.out = (float*)d_out; p.ws = (unsigned char*)d_ws;
#if FUSED
  p.ph_lo = 0; p.ph_hi = NPHASE;
  void* args[] = {&p};
  hipError_t e = hipLaunchCooperativeKernel((const void*)fwd_kernel, dim3(grid_blocks), dim3(NTHR), args, LDS_BYTES, stream);
  if (e != hipSuccess) fprintf(stderr, "cooperative launch failed: %s (grid %d)\n", hipGetErrorString(e), grid_blocks);
#else
  for (int ph = 0; ph < NPHASE; ++ph) {
    p.ph_lo = ph; p.ph_hi = ph + 1;
    hipLaunchKernelGGL(fwd_kernel, dim3(grid_blocks), dim3(NTHR), LDS_BYTES, stream, p);
  }
#endif
}
```

```cpp
#include <hip/hip_runtime.h>
#include <hip/hip_cooperative_groups.h>
#include <cstdio>
#include <cstdint>
namespace cg = cooperative_groups;

#ifndef FUSED
#define FUSED 1
#endif

typedef unsigned short u16;
typedef __attribute__((ext_vector_type(8))) short bf16x8;
typedef __attribute__((ext_vector_type(4))) short s16x4;
typedef __attribute__((ext_vector_type(16))) float f32x16;
typedef __attribute__((ext_vector_type(4))) float f32x4;
typedef __attribute__((ext_vector_type(4))) unsigned u32x4;
typedef __attribute__((ext_vector_type(2))) unsigned u32x2;
typedef __attribute__((address_space(3))) unsigned char* ldsp_t;

#define DI __device__ __forceinline__
#define MFMA32(a, b, c) __builtin_amdgcn_mfma_f32_32x32x16_bf16((a), (b), (c), 0, 0, 0)

constexpr int DM = 1024;
constexpr int T_TOK = 65536;
constexpr int T_PROMPT = 32768;
constexpr int NTHR = 512;
constexpr int NPHASE = 10;
constexpr float NORM_EPS = 1e-6f;
constexpr float LOG2E = 1.4426950408889634f;
constexpr float C2 = 0.125f * LOG2E;
constexpr float NEG_BIG = -1.0e30f;

constexpr size_t WS_WIN  = 0;
constexpr size_t WS_WOUT = WS_WIN + (size_t)3072 * 1024 * 2;
constexpr size_t WS_WQ   = WS_WOUT + (size_t)1024 * 1024 * 2;
constexpr size_t WS_SK   = WS_WQ + (size_t)2048 * 1024 * 2;
constexpr size_t WS_U    = WS_SK + (size_t)2 * 128 * 128 * 2;
constexpr size_t WS_V    = WS_U + (size_t)16384 * 1024 * 2;
constexpr size_t WS_MISC = WS_V + (size_t)16384 * 1024 * 2;
constexpr size_t MISC_SUINV = 0, MISC_SVINV = 65536, MISC_QCTR = 131072;
constexpr size_t WS_R    = WS_MISC + (size_t)1048576;
constexpr size_t R_REGION = (size_t)T_TOK * 512 * 2;
constexpr size_t WS_X1   = WS_R;
constexpr size_t WS_H    = WS_R + (size_t)T_TOK * 1024 * 4;
constexpr size_t WS_EIDX = WS_R + 6 * R_REGION;
constexpr size_t WS_G    = WS_EIDX + (size_t)T_TOK * 128 * 2;
constexpr size_t WS_END  = WS_G + (size_t)T_TOK * 128 * 4;
static_assert(WS_END <= (size_t)536870912, "workspace map exceeds 512 MiB");
constexpr size_t OUT_N1 = 0, OUT_MIX = 134217728, OUT_TV = 0, OUT_TI = 67108864;

constexpr int LDS_BYTES = 131072;

struct Params {
  const float* x_prompt; const float* x_sample; const float* rel_bias; const float* attn_norm_g; const float* w_in;
  const float* q_norm_a; const float* k_norm_a; const float* q_norm_b; const float* k_norm_b;
  const float* lq1; const float* lk1; const float* lq2; const float* lk2; const float* diff_norm_g; const float* w_out;
  const float* ffn_norm_g; const float* peer_w_q; const float* peer_sub_keys; const float* peer_u; const float* peer_v;
  float* out; unsigned char* ws; int ph_lo; int ph_hi;
};

DI u16 f2bf(float f) { unsigned u = __float_as_uint(f); u += 0x7fffu + ((u >> 16) & 1u); return (u16)(u >> 16); }
DI float bf2f(u16 b) { return __uint_as_float(((unsigned)b) << 16); }
DI unsigned pk2(float lo, float hi) {
  typedef float f2_t __attribute__((ext_vector_type(2)));
  typedef __bf16 b2_t __attribute__((ext_vector_type(2)));
  f2_t v = {lo, hi}; b2_t b = __builtin_convertvector(v, b2_t); return __builtin_bit_cast(unsigned, b);
}
DI int crow(int reg, int h) { return (reg & 3) + 8 * (reg >> 2) + 4 * h; }
DI float wave_sum(float v) {
#pragma unroll
  for (int o = 32; o > 0; o >>= 1) v += __shfl_xor(v, o);
  return v;
}
DI void seq_of(int t, int& seq_start, int& S, int& s) {
  if (t < T_PROMPT) { S = 4096; seq_start = t & ~4095; s = t & 4095; }
  else { S = 2048; seq_start = t & ~2047; s = t & 2047; }
}
DI const float* x_row(const Params& p, int t) {
  return (t < T_PROMPT) ? p.x_prompt + (size_t)t * DM : p.x_sample + (size_t)(t - T_PROMPT) * DM;
}
DI int rel_bucket(int rel) {
  int n = rel < 0 ? -rel : rel;
  int b;
  if (n < 8) b = n;
  else if (n < 15) b = 8; else if (n < 27) b = 9; else if (n < 50) b = 10; else if (n < 91) b = 11;
  else if (n < 166) b = 12; else if (n < 305) b = 13; else if (n < 559) b = 14; else b = 15;
  return (rel > 0 ? 16 : 0) + b;
}
DI s16x4 tr_read(const unsigned char* p) {
  typedef short v4i16_t __attribute__((ext_vector_type(4)));
  return __builtin_bit_cast(s16x4, __builtin_amdgcn_ds_read_tr16_b64_v4i16((__attribute__((address_space(3))) v4i16_t*)p));
}
DI bf16x8 cat8(s16x4 lo, s16x4 hi) { return __builtin_shufflevector(lo, hi, 0, 1, 2, 3, 4, 5, 6, 7); }

DI void transpose_item(const float* __restrict__ src, int K, int N, u16* __restrict__ dst, int k0, int n0, unsigned char* lds) {
  float* tile = (float*)lds;
  const int tid = threadIdx.x;
#pragma unroll
  for (int i = 0; i < 8; ++i) {
    int idx = tid + 512 * i; int r = idx >> 6, c = idx & 63;
    tile[r * 65 + c] = src[(size_t)(k0 + r) * N + n0 + c];
  }
  __syncthreads();
  {
    int n = tid >> 3, kc = tid & 7;
    u32x4 o;
    o[0] = pk2(tile[(kc * 8 + 0) * 65 + n], tile[(kc * 8 + 1) * 65 + n]);
    o[1] = pk2(tile[(kc * 8 + 2) * 65 + n], tile[(kc * 8 + 3) * 65 + n]);
    o[2] = pk2(tile[(kc * 8 + 4) * 65 + n], tile[(kc * 8 + 5) * 65 + n]);
    o[3] = pk2(tile[(kc * 8 + 6) * 65 + n], tile[(kc * 8 + 7) * 65 + n]);
    *(u32x4*)(dst + (size_t)(n0 + n) * K + k0 + kc * 8) = o;
  }
  __syncthreads();
}

DI void convert_item(const float* __restrict__ src, u16* __restrict__ dst, size_t base) {
  size_t i = base + (size_t)threadIdx.x * 8;
  f32x4 a = *(const f32x4*)(src + i), b = *(const f32x4*)(src + i + 4);
  u32x4 o; o[0] = pk2(a[0], a[1]); o[1] = pk2(a[2], a[3]); o[2] = pk2(b[0], b[1]); o[3] = pk2(b[2], b[3]);
  *(u32x4*)(dst + i) = o;
}

DI void norm_row(const float* __restrict__ xr, const float* __restrict__ g, u16* __restrict__ orow, int lane) {
  f32x4 v[4]; float ss = 0.f;
#pragma unroll
  for (int i = 0; i < 4; ++i) { v[i] = *(const f32x4*)(xr + lane * 4 + 256 * i); ss += v[i][0] * v[i][0] + v[i][1] * v[i][1] + v[i][2] * v[i][2] + v[i][3] * v[i][3]; }
  ss = wave_sum(ss);
  const float r = __builtin_amdgcn_rsqf(ss * (1.0f / 1024.0f) + NORM_EPS);
#pragma unroll
  for (int i = 0; i < 4; ++i) {
    f32x4 gg = *(const f32x4*)(g + lane * 4 + 256 * i);
    u32x2 o; o[0] = pk2(v[i][0] * r * gg[0], v[i][1] * r * gg[1]); o[1] = pk2(v[i][2] * r * gg[2], v[i][3] * r * gg[3]);
    *(u32x2*)(orow + lane * 4 + 256 * i) = o;
  }
}

DI void phase_prep(const Params& p, unsigned char* lds) {
  const int nb = gridDim.x, bid = blockIdx.x, tid = threadIdx.x;
  u16* wsb = (u16*)p.ws;
  for (int it = bid; it < 768 + 256 + 512; it += nb) {
    if (it < 768) { int kt = it / 48, nt = it % 48; transpose_item(p.w_in, 1024, 3072, (u16*)(p.ws + WS_WIN), kt * 64, nt * 64, lds); }
    else if (it < 1024) { int j = it - 768; int kt = j / 16, nt = j % 16; transpose_item(p.w_out, 1024, 1024, (u16*)(p.ws + WS_WOUT), kt * 64, nt * 64, lds); }
    else { int j = it - 1024; int kt = j / 32, nt = j % 32; transpose_item(p.peer_w_q, 1024, 2048, (u16*)(p.ws + WS_WQ), kt * 64, nt * 64, lds); }
  }
  for (int it = bid; it < 8; it += nb) convert_item(p.peer_sub_keys, (u16*)(p.ws + WS_SK), (size_t)it * 4096);
  if (bid == 0 && tid < 64) ((unsigned*)(p.ws + WS_MISC + MISC_QCTR))[tid] = 0u;
  {
    const int lane_ = tid & 63, w_ = tid >> 6;
    for (int it = bid; it < 2 * 16384 / 8; it += nb) {
      const int row = it * 8 + w_;
      const int tbl = row >> 14, e = row & 16383;
      const float* src = (tbl ? p.peer_v : p.peer_u) + (size_t)e * DM + lane_ * 16;
      f32x4 a0 = *(const f32x4*)(src), a1 = *(const f32x4*)(src + 4), a2 = *(const f32x4*)(src + 8), a3 = *(const f32x4*)(src + 12);
      float am = 0.f;
#pragma unroll
      for (int j = 0; j < 4; ++j) am = fmaxf(am, fmaxf(fmaxf(fabsf(a0[j]), fabsf(a1[j])), fmaxf(fabsf(a2[j]), fabsf(a3[j]))));
#pragma unroll
      for (int o = 32; o > 0; o >>= 1) am = fmaxf(am, __shfl_xor(am, o));
      const int ex = (int)((__float_as_uint(am) >> 23) & 255u);
      float sc = 1.0f, isc = 1.0f;
      if (ex > 8 && ex < 250) { sc = __uint_as_float((unsigned)(261 - ex) << 23); isc = __uint_as_float((unsigned)(ex - 7) << 23); }
      u32x4 o;
      { int pk = __builtin_amdgcn_cvt_pk_fp8_f32(a0[0] * sc, a0[1] * sc, 0, false); pk = __builtin_amdgcn_cvt_pk_fp8_f32(a0[2] * sc, a0[3] * sc, pk, true); o[0] = (unsigned)pk; }
      { int pk = __builtin_amdgcn_cvt_pk_fp8_f32(a1[0] * sc, a1[1] * sc, 0, false); pk = __builtin_amdgcn_cvt_pk_fp8_f32(a1[2] * sc, a1[3] * sc, pk, true); o[1] = (unsigned)pk; }
      { int pk = __builtin_amdgcn_cvt_pk_fp8_f32(a2[0] * sc, a2[1] * sc, 0, false); pk = __builtin_amdgcn_cvt_pk_fp8_f32(a2[2] * sc, a2[3] * sc, pk, true); o[2] = (unsigned)pk; }
      { int pk = __builtin_amdgcn_cvt_pk_fp8_f32(a3[0] * sc, a3[1] * sc, 0, false); pk = __builtin_amdgcn_cvt_pk_fp8_f32(a3[2] * sc, a3[3] * sc, pk, true); o[3] = (unsigned)pk; }
      unsigned char* dst = p.ws + (tbl ? WS_V : WS_U) + ((size_t)(lane_ >> 3) * 16384 + e) * 128 + (lane_ & 7) * 16;
      *(u32x4*)dst = o;
      if (lane_ == 0) ((float*)(p.ws + WS_MISC + (tbl ? MISC_SVINV : MISC_SUINV)))[e] = isc;
    }
  }
  const int lane = tid & 63, w = tid >> 6;
  u16* n1 = (u16*)((unsigned char*)p.out + OUT_N1);
  for (int it = bid; it < T_TOK / 8; it += nb) {
    int t = it * 8 + w;
    norm_row(x_row(p, t), p.attn_norm_g, n1 + (size_t)t * DM, lane);
  }
  (void)wsb;
}

template <int PR, int QR>
DI void gemm_mainloop(const u16* __restrict__ P, const u16* __restrict__ Q, int K, int p0, int q0, unsigned char* lds, f32x16 (&acc)[2][2]) {
  static_assert(PR + QR == 384, "tile");
  constexpr int STAGE = 384 * 128;
  constexpr int WC = QR / 64;
  const int tid = threadIdx.x, lane = tid & 63, r32 = lane & 31, h = lane >> 5;
  const int w = __builtin_amdgcn_readfirstlane(tid >> 6);
  const int wr = w / WC, wc = w % WC;
#pragma unroll
  for (int i = 0; i < 2; ++i)
#pragma unroll
    for (int j = 0; j < 2; ++j)
#pragma unroll
      for (int r = 0; r < 16; ++r) acc[i][j][r] = 0.f;
  u32x4 stg[6];
  const u16* src[6]; int loff[6];
#pragma unroll
  for (int i = 0; i < 6; ++i) {
    int c = tid + 512 * i; int row = c >> 3, kc = c & 7;
    src[i] = (row < PR) ? P + (size_t)(p0 + row) * K + kc * 8 : Q + (size_t)(q0 + row - PR) * K + kc * 8;
    loff[i] = row * 128 + ((kc ^ ((row >> 1) & 7)) << 4);
  }
  const int KT = K / 64;
#pragma unroll
  for (int i = 0; i < 6; ++i) stg[i] = *(const u32x4*)(src[i]);
#pragma unroll
  for (int i = 0; i < 6; ++i) *(u32x4*)(lds + loff[i]) = stg[i];
  __syncthreads();
  int aoff[2], boff[2], asw[2], bsw[2];
#pragma unroll
  for (int i = 0; i < 2; ++i) {
    int ra = wr * 64 + i * 32 + r32; aoff[i] = ra * 128; asw[i] = (ra >> 1) & 7;
    int rb = PR + wc * 64 + i * 32 + r32; boff[i] = rb * 128; bsw[i] = (rb >> 1) & 7;
  }
  for (int kt = 0; kt < KT; ++kt) {
    const int buf = (kt & 1) * STAGE;
    if (kt + 1 < KT) {
#pragma unroll
      for (int i = 0; i < 6; ++i) stg[i] = *(const u32x4*)(src[i] + (kt + 1) * 64);
    }
#pragma unroll
    for (int ks = 0; ks < 4; ++ks) {
      bf16x8 a[2], b[2];
#pragma unroll
      for (int i = 0; i < 2; ++i) {
        a[i] = *(const bf16x8*)(lds + buf + aoff[i] + (((2 * ks + h) ^ asw[i]) << 4));
        b[i] = *(const bf16x8*)(lds + buf + boff[i] + (((2 * ks + h) ^ bsw[i]) << 4));
      }
#pragma unroll
      for (int i = 0; i < 2; ++i)
#pragma unroll
        for (int j = 0; j < 2; ++j) acc[i][j] = MFMA32(a[i], b[j], acc[i][j]);
    }
    if (kt + 1 < KT) {
      const int nbuf = ((kt + 1) & 1) * STAGE;
#pragma unroll
      for (int i = 0; i < 6; ++i) *(u32x4*)(lds + nbuf + loff[i]) = stg[i];
    }
    __syncthreads();
  }
}

DI void phase_proj(const Params& p, unsigned char* lds) {
  const u16* Wt = (const u16*)(p.ws + WS_WIN);
  const u16* X = (const u16*)((const unsigned char*)p.out + OUT_N1);
  const int tid = threadIdx.x, lane = tid & 63, r32 = lane & 31, h = lane >> 5;
  const int w = __builtin_amdgcn_readfirstlane(tid >> 6);
  const int wr = w >> 1, wc = w & 1;
  for (int tile = blockIdx.x; tile < 12 * 512; tile += gridDim.x) {
    const int mb = tile / 12, nbk = tile % 12;
    const int p0 = nbk * 256, q0 = mb * 128;
    f32x16 acc[2][2];
    gemm_mainloop<256, 128>(Wt, X, 1024, p0, q0, lds, acc);
    const int nbase = p0 + wr * 64;
    const int region = nbase >> 9, hw = (nbase & 511) >> 6;
    const float* g = (region == 0) ? p.q_norm_a : (region == 1) ? p.k_norm_a : (region == 3) ? p.q_norm_b : p.k_norm_b;
    const bool normed = (region != 2 && region != 5);
    const float qs = (region == 0 || region == 3) ? C2 : 1.0f;
    u16* dstR = (u16*)(p.ws + WS_R + (size_t)region * R_REGION);
#pragma unroll
    for (int j = 0; j < 2; ++j) {
      const int t = q0 + wc * 64 + j * 32 + r32;
      int seq_start, S, s; seq_of(t, seq_start, S, s);
      float scale = 1.0f;
      if (normed) {
        float ss = 0.f;
#pragma unroll
        for (int i = 0; i < 2; ++i)
#pragma unroll
          for (int r = 0; r < 16; ++r) ss += acc[i][j][r] * acc[i][j][r];
        ss += __shfl_xor(ss, 32);
        scale = __builtin_amdgcn_rsqf(ss * (1.0f / 64.0f) + NORM_EPS) * qs;
      }
      u16* dst;
      if (region != 5) dst = dstR + (size_t)seq_start * 512 + ((size_t)hw * S + s) * 64;
      else dst = dstR + (size_t)seq_start * 512 + ((size_t)(hw >> 1) * S + s) * 128 + (hw & 1) * 64;
#pragma unroll
      for (int i = 0; i < 2; ++i)
#pragma unroll
        for (int g4 = 0; g4 < 4; ++g4) {
          const int d0 = i * 32 + 8 * g4 + 4 * h;
          float y0 = acc[i][j][4 * g4 + 0] * scale, y1 = acc[i][j][4 * g4 + 1] * scale, y2 = acc[i][j][4 * g4 + 2] * scale, y3 = acc[i][j][4 * g4 + 3] * scale;
          if (normed) { f32x4 gg = *(const f32x4*)(g + d0); y0 *= gg[0]; y1 *= gg[1]; y2 *= gg[2]; y3 *= gg[3]; }
          u32x2 o; o[0] = pk2(y0, y1); o[1] = pk2(y2, y3);
          *(u32x2*)(dst + d0) = o;
        }
    }
  }
}

constexpr int AL_STAGE = 0;
constexpr int AL_TAB   = 65536;
constexpr int AL_TABA  = 73728;
constexpr int AL_VT    = 90112;
constexpr int AL_XL    = 122880;
constexpr int AL_MISC  = 124928;

DI unsigned voff_b(int row, int ch) { return 256u * row + 16u * (ch ^ (((row & 3) << 2) | ((row >> 2) & 3))); }

DI void diff_unit(const Params& p, unsigned char* lds, int seq_start, int S, int hd, int q0, float lam) {
  const int tid = threadIdx.x, lane = tid & 63, r32 = lane & 31, h = lane >> 5;
  const int w = __builtin_amdgcn_readfirstlane(tid >> 6);
  const int map = w >> 2, wq = w & 3;
  const u16* QBp = (const u16*)(p.ws + WS_R + 3 * R_REGION);
  const u16* KBp = (const u16*)(p.ws + WS_R + 4 * R_REGION);
  const u16* VBp = (const u16*)(p.ws + WS_R + 5 * R_REGION);
  const int qpos = q0 + wq * 32 + r32;
  const u16* Qp = QBp + (size_t)seq_start * 512 + ((size_t)(hd * 2 + map) * S + qpos) * 64;
  bf16x8 qf[4];
#pragma unroll
  for (int ks = 0; ks < 4; ++ks) qf[ks] = *(const bf16x8*)(Qp + ks * 16 + h * 8);
  const u16* K1g = KBp + (size_t)seq_start * 512 + ((size_t)(hd * 2 + 0) * S) * 64;
  const u16* K2g = KBp + (size_t)seq_start * 512 + ((size_t)(hd * 2 + 1) * S) * 64;
  const u16* Vg = VBp + (size_t)seq_start * 512 + ((size_t)hd * S) * 128;
  const float* tab = (const float*)(lds + AL_TAB);
  const float* misc = (const float*)(lds + AL_MISC);
  const float cBefore = misc[8 + hd], cAfter = misc[12 + hd];
  f32x16 O[4];
#pragma unroll
  for (int nb = 0; nb < 4; ++nb)
#pragma unroll
    for (int r = 0; r < 16; ++r) O[nb][r] = 0.f;
  float l = 0.f;
  const int krow = tid >> 3, kkc = tid & 7;
  const int kl_off = krow * 128 + ((kkc ^ ((krow >> 1) & 7)) << 4);
  const u16* k1src = K1g + (size_t)krow * 64 + kkc * 8;
  const u16* k2src = K2g + (size_t)krow * 64 + kkc * 8;
  int vl_off[2]; const u16* vsrc[2];
#pragma unroll
  for (int i = 0; i < 2; ++i) { int c = tid + 512 * i; int row = c >> 4, ch = c & 15; vl_off[i] = (int)voff_b(row, ch); vsrc[i] = Vg + (size_t)row * 128 + ch * 8; }
  u32x4 sk1, sk2, sv0, sv1;
  sk1 = *(const u32x4*)k1src; sk2 = *(const u32x4*)k2src; sv0 = *(const u32x4*)vsrc[0]; sv1 = *(const u32x4*)vsrc[1];
  *(u32x4*)(lds + AL_STAGE + kl_off) = sk1; *(u32x4*)(lds + AL_STAGE + 8192 + kl_off) = sk2;
  *(u32x4*)(lds + AL_STAGE + 16384 + vl_off[0]) = sv0; *(u32x4*)(lds + AL_STAGE + 16384 + vl_off[1]) = sv1;
  __syncthreads();
  const int NKT = S / 64;
  const int i16 = lane & 15, tq = i16 >> 2, tp = i16 & 3, blk = (lane >> 4) & 1;
  for (int kt = 0; kt < NKT; ++kt) {
    const int st = AL_STAGE + (kt & 1) * 32768;
    if (kt + 1 < NKT) {
      const size_t ko = (size_t)(kt + 1) * 64 * 64, vo = (size_t)(kt + 1) * 64 * 128;
      sk1 = *(const u32x4*)(k1src + ko); sk2 = *(const u32x4*)(k2src + ko);
      sv0 = *(const u32x4*)(vsrc[0] + vo); sv1 = *(const u32x4*)(vsrc[1] + vo);
    }
    const unsigned char* Kl = lds + st + map * 8192;
    const unsigned char* Vl = lds + st + 16384;
#pragma unroll
    for (int sub = 0; sub < 2; ++sub) {
      const int kbase = kt * 64 + 32 * sub;
      const int qlo = q0 + wq * 32;
      const int dmin = kbase - (qlo + 31), dmax = kbase + 31 - qlo;
      f32x16 sT;
      if (dmin >= 559) {
#pragma unroll
        for (int r = 0; r < 16; ++r) sT[r] = cAfter;
      } else if (dmax <= -559) {
#pragma unroll
        for (int r = 0; r < 16; ++r) sT[r] = cBefore;
      } else {
        const int base = kbase + 4 * h - qpos + 640;
#pragma unroll
        for (int r = 0; r < 16; ++r) sT[r] = tab[base + (r & 3) + 8 * (r >> 2)];
      }
      const int row = 32 * sub + r32;
#pragma unroll
      for (int ks = 0; ks < 4; ++ks) {
        bf16x8 a = *(const bf16x8*)(Kl + row * 128 + (((2 * ks + h) ^ ((row >> 1) & 7)) << 4));
        sT = MFMA32(a, qf[ks], sT);
      }
      float ls = 0.f;
#pragma unroll
      for (int r = 0; r < 16; ++r) { sT[r] = __builtin_amdgcn_exp2f(sT[r]); ls += sT[r]; }
      l += ls;
      bf16x8 pb[2];
#pragma unroll
      for (int s2 = 0; s2 < 2; ++s2) {
        u32x4 pw; pw[0] = pk2(sT[8 * s2 + 0], sT[8 * s2 + 1]); pw[1] = pk2(sT[8 * s2 + 2], sT[8 * s2 + 3]);
        pw[2] = pk2(sT[8 * s2 + 4], sT[8 * s2 + 5]); pw[3] = pk2(sT[8 * s2 + 6], sT[8 * s2 + 7]);
        pb[s2] = __builtin_bit_cast(bf16x8, pw);
      }
#pragma unroll
      for (int nb = 0; nb < 4; ++nb)
#pragma unroll
        for (int s2 = 0; s2 < 2; ++s2) {
          const int R = 32 * sub + 16 * s2 + 4 * h + tq;
          const int ch = 4 * nb + 2 * blk + (tp >> 1);
          s16x4 lo = tr_read(Vl + voff_b(R, ch) + 8 * (tp & 1));
          s16x4 hi = tr_read(Vl + voff_b(R + 8, ch) + 8 * (tp & 1));
          O[nb] = MFMA32(cat8(lo, hi), pb[s2], O[nb]);
        }
    }
    if (kt + 1 < NKT) {
      const int nst = AL_STAGE + ((kt + 1) & 1) * 32768;
      *(u32x4*)(lds + nst + kl_off) = sk1; *(u32x4*)(lds + nst + 8192 + kl_off) = sk2;
      *(u32x4*)(lds + nst + 16384 + vl_off[0]) = sv0; *(u32x4*)(lds + nst + 16384 + vl_off[1]) = sv1;
    }
    __syncthreads();
  }
  float ltot = l + __shfl_xor(l, 32);
  float* xbuf = (float*)(lds + AL_STAGE);
  if (map == 1) {
    const float inv = 1.0f / ltot;
#pragma unroll
    for (int nb = 0; nb < 4; ++nb)
#pragma unroll
      for (int r = 0; r < 16; ++r) xbuf[((wq * 64 + nb * 16 + r) << 6) + lane] = O[nb][r] * inv;
  }
  __syncthreads();
  if (map == 0) {
    const float inv = 1.0f / ltot;
    float ss = 0.f;
#pragma unroll
    for (int nb = 0; nb < 4; ++nb)
#pragma unroll
      for (int r = 0; r < 16; ++r) {
        float o = O[nb][r] * inv - lam * xbuf[((wq * 64 + nb * 16 + r) << 6) + lane];
        O[nb][r] = o; ss += o * o;
      }
    ss += __shfl_xor(ss, 32);
    const float rn = __builtin_amdgcn_rsqf(ss * (1.0f / 128.0f) + NORM_EPS) * 0.8f;
    u16* mix = (u16*)((unsigned char*)p.out + OUT_MIX) + (size_t)(seq_start + qpos) * 1024 + 512 + hd * 128;
#pragma unroll
    for (int nb = 0; nb < 4; ++nb)
#pragma unroll
      for (int g4 = 0; g4 < 4; ++g4) {
        const int d0 = 32 * nb + 8 * g4 + 4 * h;
        f32x4 gg = *(const f32x4*)(p.diff_norm_g + d0);
        u32x2 o; o[0] = pk2(O[nb][4 * g4 + 0] * rn * gg[0], O[nb][4 * g4 + 1] * rn * gg[1]);
        o[1] = pk2(O[nb][4 * g4 + 2] * rn * gg[2], O[nb][4 * g4 + 3] * rn * gg[3]);
        *(u32x2*)(mix + d0) = o;
      }
  }
  __syncthreads();
}

DI void dilated_item(const Params& p, unsigned char* lds, int seq_start, int S, int hd, int c, int mblk) {
  const int tid = threadIdx.x, lane = tid & 63, r32 = lane & 31, h = lane >> 5;
  const int w = __builtin_amdgcn_readfirstlane(tid >> 6);
  const u16* QAp = (const u16*)(p.ws + WS_R + 0 * R_REGION);
  const u16* KAp = (const u16*)(p.ws + WS_R + 1 * R_REGION);
  const u16* VAp = (const u16*)(p.ws + WS_R + 2 * R_REGION);
  const int qpos = c + 16 * (32 * mblk + r32);
  const u16* Qp = QAp + (size_t)seq_start * 512 + ((size_t)hd * S + qpos) * 64;
  bf16x8 qf[4];
#pragma unroll
  for (int ks = 0; ks < 4; ++ks) qf[ks] = *(const bf16x8*)(Qp + ks * 16 + h * 8);
  const u16* Kg = KAp + (size_t)seq_start * 512 + ((size_t)hd * S) * 64;
  const u16* Vg = VAp + (size_t)seq_start * 512 + ((size_t)hd * S) * 64;
  unsigned char* vt = lds + AL_VT + w * 4096;
  const float* tabA = (const float*)(lds + AL_TABA) + hd * 3 * 132;
  f32x16 O[2];
#pragma unroll
  for (int nb = 0; nb < 2; ++nb)
#pragma unroll
    for (int r = 0; r < 16; ++r) O[nb][r] = 0.f;
  float l = 0.f;
  const int i16 = lane & 15, tq = i16 >> 2, tp = i16 & 3, blk = (lane >> 4) & 1;
  const int wsw = (((r32 >> 1) & 1) << 2) ^ ((r32 >> 2) & 3);
  for (int tau = 0; tau < 33; ++tau) {
    int d, br, tt;
    if (tau < 5) { d = 16; br = 0; tt = tau; } else if (tau < 13) { d = 4; br = 1; tt = tau - 5; } else { d = 1; br = 2; tt = tau - 13; }
    const int ratio = 16 / d;
    const int n0 = ratio * 32 * mblk - 64 + 32 * tt;
    const int kfirst = c + d * n0, klast = c + d * (n0 + 31);
    if (klast < 0 || kfirst >= S) continue;
    int kpos = c + d * (n0 + r32);
    kpos = kpos < 0 ? 0 : (kpos >= S ? S - 1 : kpos);
    bf16x8 kf[4]; u32x4 vc[4];
#pragma unroll
    for (int ks = 0; ks < 4; ++ks) {
      kf[ks] = *(const bf16x8*)(Kg + (size_t)kpos * 64 + ks * 16 + h * 8);
      vc[ks] = *(const u32x4*)(Vg + (size_t)kpos * 64 + (2 * ks + h) * 8);
    }
#pragma unroll
    for (int ks = 0; ks < 4; ++ks) *(u32x4*)(vt + r32 * 128 + (((2 * ks + h) ^ wsw) << 4)) = vc[ks];
    const int nq = ratio * (32 * mblk + r32);
    const int base = n0 + 4 * h - nq;
    const float* tb = tabA + br * 132;
    f32x16 sT;
#pragma unroll
    for (int r = 0; r < 16; ++r) {
      int dl = base + (r & 3) + 8 * (r >> 2);
      dl = dl < -65 ? -65 : (dl > 65 ? 65 : dl);
      sT[r] = tb[dl + 65];
    }
    if (kfirst < 0 || klast >= S) {
#pragma unroll
      for (int r = 0; r < 16; ++r) { int kp = c + d * (n0 + crow(r, h)); if (kp < 0 || kp >= S) sT[r] = NEG_BIG; }
    }
#pragma unroll
    for (int ks = 0; ks < 4; ++ks) sT = MFMA32(kf[ks], qf[ks], sT);
    float ls = 0.f;
#pragma unroll
    for (int r = 0; r < 16; ++r) { sT[r] = __builtin_amdgcn_exp2f(sT[r]); ls += sT[r]; }
    l += ls;
    bf16x8 pb[2];
#pragma unroll
    for (int s2 = 0; s2 < 2; ++s2) {
      u32x4 pw; pw[0] = pk2(sT[8 * s2 + 0], sT[8 * s2 + 1]); pw[1] = pk2(sT[8 * s2 + 2], sT[8 * s2 + 3]);
      pw[2] = pk2(sT[8 * s2 + 4], sT[8 * s2 + 5]); pw[3] = pk2(sT[8 * s2 + 6], sT[8 * s2 + 7]);
      pb[s2] = __builtin_bit_cast(bf16x8, pw);
    }
#pragma unroll
    for (int nb = 0; nb < 2; ++nb)
#pragma unroll
      for (int s2 = 0; s2 < 2; ++s2) {
        const int R = 16 * s2 + 4 * h + tq;
        const int ch = 4 * nb + 2 * blk + (tp >> 1);
        const int sw0 = (((R >> 1) & 1) << 2) ^ ((R >> 2) & 3);
        const int sw1 = ((((R + 8) >> 1) & 1) << 2) ^ (((R + 8) >> 2) & 3);
        s16x4 lo = tr_read(vt + R * 128 + ((ch ^ sw0) << 4) + 8 * (tp & 1));
        s16x4 hi = tr_read(vt + (R + 8) * 128 + ((ch ^ sw1) << 4) + 8 * (tp & 1));
        O[nb] = MFMA32(cat8(lo, hi), pb[s2], O[nb]);
      }
  }
  const float ltot = l + __shfl_xor(l, 32);
  const float inv = 1.0f / ltot;
  u16* mix = (u16*)((unsigned char*)p.out + OUT_MIX) + (size_t)(seq_start + qpos) * 1024 + hd * 64;
#pragma unroll
  for (int nb = 0; nb < 2; ++nb)
#pragma unroll
    for (int g4 = 0; g4 < 4; ++g4) {
      const int d0 = 32 * nb + 8 * g4 + 4 * h;
      u32x2 o; o[0] = pk2(O[nb][4 * g4 + 0] * inv, O[nb][4 * g4 + 1] * inv); o[1] = pk2(O[nb][4 * g4 + 2] * inv, O[nb][4 * g4 + 3] * inv);
      *(u32x2*)(mix + d0) = o;
    }
}

DI void phase_attn(const Params& p, unsigned char* lds) {
  const int tid = threadIdx.x;
  float* misc = (float*)(lds + AL_MISC);
  if (tid == 0) {
    float gqa = 0.f, gka = 0.f, gqb = 0.f, gkb = 0.f, bm = 0.f;
    for (int i = 0; i < 64; ++i) { gqa = fmaxf(gqa, fabsf(p.q_norm_a[i])); gka = fmaxf(gka, fabsf(p.k_norm_a[i])); gqb = fmaxf(gqb, fabsf(p.q_norm_b[i])); gkb = fmaxf(gkb, fabsf(p.k_norm_b[i])); }
    for (int i = 0; i < 32 * 12; ++i) bm = fmaxf(bm, fabsf(p.rel_bias[i]));
    const float M2 = 8.0f * LOG2E * fmaxf(gqa * gka, gqb * gkb) * 1.02f + bm * LOG2E + 0.1f;
    float s1 = 0.f, s2 = 0.f;
    for (int i = 0; i < 64; ++i) { s1 += p.lq1[i] * p.lk1[i]; s2 += p.lq2[i] * p.lk2[i]; }
    misc[0] = M2; misc[1] = expf(s1) - expf(s2) + 0.2f;
    for (int hd = 0; hd < 4; ++hd) { misc[8 + hd] = p.rel_bias[15 * 12 + 8 + hd] * LOG2E - M2; misc[12 + hd] = p.rel_bias[31 * 12 + 8 + hd] * LOG2E - M2; }
  }
  __syncthreads();
  const float M2 = misc[0], lam = misc[1];
  {
    float* tabA = (float*)(lds + AL_TABA);
    for (int i = tid; i < 8 * 3 * 132; i += NTHR) {
      int hd = i / 396, rem = i % 396, br = rem / 132, idx = rem % 132;
      int dl = idx - 65; float v = NEG_BIG;
      if (dl >= -64 && dl <= 64 && idx < 131) { int d = (br == 0) ? 16 : (br == 1) ? 4 : 1; v = p.rel_bias[rel_bucket(dl * d) * 12 + hd] * LOG2E - M2; }
      tabA[i] = v;
    }
  }
  int cur_hd = -1;
  for (int it = blockIdx.x; it < 1024; it += gridDim.x) {
#pragma unroll 1
    for (int half = 0; half < 2; ++half) {
      int seq_start, S, hd, q0;
      if (half == 0) { int up = it; int seq = up >> 7; hd = (up >> 5) & 3; q0 = (up & 31) * 128; S = 4096; seq_start = seq * 4096; }
      else { int us = it; int seq = us >> 6; hd = (us >> 4) & 3; q0 = (us & 15) * 128; S = 2048; seq_start = T_PROMPT + seq * 2048; }
      if (hd != cur_hd) {
        __syncthreads();
        float* tab = (float*)(lds + AL_TAB);
        for (int i = tid; i < 1281; i += NTHR) tab[i] = p.rel_bias[rel_bucket(i - 640) * 12 + 8 + hd] * LOG2E - M2;
        cur_hd = hd;
        __syncthreads();
      }
      diff_unit(p, lds, seq_start, S, hd, q0, lam);
    }
  }
  __syncthreads();
  const int w = tid >> 6;
  for (int it = blockIdx.x * 8 + w; it < 16384; it += gridDim.x * 8) {
    int seq_start, S, hd, c, mblk;
    if (it < 8192) { int seq = it >> 10; hd = (it >> 7) & 7; c = (it >> 3) & 15; mblk = it & 7; S = 4096; seq_start = seq * 4096; }
    else { int j = it - 8192; int seq = j >> 9; hd = (j >> 6) & 7; c = (j >> 2) & 15; mblk = j & 3; S = 2048; seq_start = T_PROMPT + seq * 2048; }
    dilated_item(p, lds, seq_start, S, hd, c, mblk);
  }
}

DI void phase_outproj(const Params& p, unsigned char* lds) {
  const u16* Mx = (const u16*)((const unsigned char*)p.out + OUT_MIX);
  const u16* Wt = (const u16*)(p.ws + WS_WOUT);
  float* x1 = (float*)(p.ws + WS_X1);
  const int tid = threadIdx.x, lane = tid & 63, r32 = lane & 31, h = lane >> 5;
  const int w = __builtin_amdgcn_readfirstlane(tid >> 6);
  const int wr = w >> 1, wc = w & 1;
  for (int tile = blockIdx.x; tile < 256 * 8; tile += gridDim.x) {
    const int mb = tile >> 3, nbk = tile & 7;
    const int p0 = mb * 256, q0 = nbk * 128;
    f32x16 acc[2][2];
    gemm_mainloop<256, 128>(Mx, Wt, 1024, p0, q0, lds, acc);
#pragma unroll
    for (int i = 0; i < 2; ++i)
#pragma unroll
      for (int r = 0; r < 16; ++r) {
        const int m = p0 + wr * 64 + i * 32 + crow(r, h);
        const float* xr = x_row(p, m);
#pragma unroll
        for (int j = 0; j < 2; ++j) {
          const int n = q0 + wc * 64 + j * 32 + r32;
          x1[(size_t)m * DM + n] = xr[n] + acc[i][j][r];
        }
      }
  }
}

DI void phase_norm2(const Params& p) {
  const int tid = threadIdx.x, lane = tid & 63, w = tid >> 6;
  const float* x1 = (const float*)(p.ws + WS_X1);
  u16* hb = (u16*)(p.ws + WS_H);
  for (int it = blockIdx.x; it < T_TOK / 8; it += gridDim.x) {
    int t = it * 8 + w;
    norm_row(x1 + (size_t)t * DM, p.ffn_norm_g, hb + (size_t)t * DM, lane);
  }
}

DI void phase_peer_query(const Params& p, unsigned char* lds) {
  const u16* Wq = (const u16*)(p.ws + WS_WQ);
  const u16* Hb = (const u16*)(p.ws + WS_H);
  const u16* SK = (const u16*)(p.ws + WS_SK);
  float* tv = (float*)((unsigned char*)p.out + OUT_TV);
  unsigned char* ti = (unsigned char*)p.out + OUT_TI;
  const int tid = threadIdx.x, lane = tid & 63, r32 = lane & 31, h = lane >> 5;
  const int w = __builtin_amdgcn_readfirstlane(tid >> 6);
  const int wr = w >> 2, wc = w & 3;
  for (int tile = blockIdx.x; tile < 256 * 16; tile += gridDim.x) {
    const int mb = tile >> 4, c16 = tile & 15;
    const int p0 = c16 * 128, q0 = mb * 256;
    const int z = c16 & 1;
    f32x16 acc[2][2];
    gemm_mainloop<128, 256>(Wq, Hb, 1024, p0, q0, lds, acc);
    unsigned char* QPl = lds;
    unsigned char* SKl = lds + 65536;
#pragma unroll
    for (int j = 0; j < 2; ++j) {
      const int m = wc * 64 + j * 32 + r32;
#pragma unroll
      for (int i = 0; i < 2; ++i)
#pragma unroll
        for (int g4 = 0; g4 < 4; ++g4) {
          const int nl = wr * 64 + i * 32 + 8 * g4 + 4 * h;
          u32x2 o; o[0] = pk2(acc[i][j][4 * g4 + 0], acc[i][j][4 * g4 + 1]); o[1] = pk2(acc[i][j][4 * g4 + 2], acc[i][j][4 * g4 + 3]);
          *(u32x2*)(QPl + m * 256 + (((nl >> 3) ^ (m & 15)) << 4) + (nl & 7) * 2) = o;
        }
    }
#pragma unroll
    for (int i = 0; i < 4; ++i) {
      int c = tid + 512 * i; int row = c >> 4, ch = c & 15;
      u32x4 v = *(const u32x4*)(SK + (size_t)z * 16384 + row * 128 + ch * 8);
      *(u32x4*)(SKl + row * 256 + ((ch ^ (row & 15)) << 4)) = v;
    }
    __syncthreads();
    f32x16 S2[4];
#pragma unroll
    for (int kb = 0; kb < 4; ++kb)
#pragma unroll
      for (int r = 0; r < 16; ++r) S2[kb][r] = 0.f;
    const int m = w * 32 + r32;
#pragma unroll
    for (int ks = 0; ks < 8; ++ks) {
      bf16x8 b = *(const bf16x8*)(QPl + m * 256 + (((2 * ks + h) ^ (m & 15)) << 4));
#pragma unroll
      for (int kb = 0; kb < 4; ++kb) {
        const int key = kb * 32 + r32;
        bf16x8 a = *(const bf16x8*)(SKl + key * 256 + (((2 * ks + h) ^ (key & 15)) << 4));
        S2[kb] = MFMA32(a, b, S2[kb]);
      }
    }
    {
      const size_t o = ((size_t)(q0 + m) * 16 + c16) * 16;
#pragma unroll 1
      for (int rd = 0; rd < 16; ++rd) {
        float best = -3.0e38f; int be = 0;
#pragma unroll
        for (int e = 0; e < 64; ++e) { const float v = S2[e >> 4][e & 15]; if (v > best) { best = v; be = e; } }
        const int bkey = 32 * (be >> 4) + (be & 3) + 8 * ((be & 15) >> 2) + 4 * h;
        const float pbest = __shfl_xor(best, 32); const int pkey = __shfl_xor(bkey, 32);
        const bool mine = (best > pbest) || (best == pbest && bkey < pkey);
        const float wv = mine ? best : pbest; const int wk = mine ? bkey : pkey;
        const int kill = mine ? be : -1;
#pragma unroll
        for (int e = 0; e < 64; ++e) { if (e == kill) S2[e >> 4][e & 15] = -3.0e38f; }
        if (h == 0) { tv[o + rd] = wv; ti[o + rd] = (unsigned char)wk; }
      }
    }
    __syncthreads();
  }
}

DI void phase_peer_combine(const Params& p, unsigned char* lds) {
  const float* tv = (const float*)((const unsigned char*)p.out + OUT_TV);
  const unsigned char* ti = (const unsigned char*)p.out + OUT_TI;
  u16* eidx = (u16*)(p.ws + WS_EIDX);
  float* gg = (float*)(p.ws + WS_G);
  const int tid = threadIdx.x;
  float* v2l = (float*)lds;
  int* i1l = (int*)(lds + 32768);
  int* i2l = (int*)(lds + 65536);
  for (int it = blockIdx.x; it < (T_TOK * 8) / NTHR; it += gridDim.x) {
    const int gid = it * NTHR + tid;
    const size_t o1 = ((size_t)gid * 2) * 16, o2 = o1 + 16;
    float v1[16];
#pragma unroll
    for (int q4 = 0; q4 < 4; ++q4) {
      f32x4 a = *(const f32x4*)(tv + o1 + 4 * q4); v1[4 * q4] = a[0]; v1[4 * q4 + 1] = a[1]; v1[4 * q4 + 2] = a[2]; v1[4 * q4 + 3] = a[3];
      f32x4 b = *(const f32x4*)(tv + o2 + 4 * q4);
      v2l[(4 * q4 + 0) * 512 + tid] = b[0]; v2l[(4 * q4 + 1) * 512 + tid] = b[1]; v2l[(4 * q4 + 2) * 512 + tid] = b[2]; v2l[(4 * q4 + 3) * 512 + tid] = b[3];
    }
    {
      u32x4 a = *(const u32x4*)(ti + o1), b = *(const u32x4*)(ti + o2);
#pragma unroll
      for (int j = 0; j < 16; ++j) { i1l[j * 512 + tid] = (a[j >> 2] >> (8 * (j & 3))) & 255; i2l[j * 512 + tid] = (b[j >> 2] >> (8 * (j & 3))) & 255; }
    }
    unsigned long long pp = 0ull;
    float bestv[16]; int be[16];
#pragma unroll
    for (int rd = 0; rd < 16; ++rd) {
      float best = -3.0e38f; int ab = 0, bb = 0;
#pragma unroll
      for (int a = 0; a < 16; ++a) {
        const int b = (int)((pp >> (4 * a)) & 15ull);
        const float cnd = v1[a] + v2l[b * 512 + tid];
        if (cnd > best) { best = cnd; ab = a; bb = b; }
      }
      bestv[rd] = best; be[rd] = i1l[ab * 512 + tid] * 128 + i2l[bb * 512 + tid];
      pp += 1ull << (4 * ab);
    }
    float ex[16]; float sum = 0.f;
#pragma unroll
    for (int rd = 0; rd < 16; ++rd) { ex[rd] = __expf(bestv[rd] - bestv[0]); sum += ex[rd]; }
    const float inv = 1.0f / sum;
    const size_t oo = (size_t)gid * 16;
#pragma unroll
    for (int q4 = 0; q4 < 4; ++q4) { f32x4 v = {ex[4 * q4] * inv, ex[4 * q4 + 1] * inv, ex[4 * q4 + 2] * inv, ex[4 * q4 + 3] * inv}; *(f32x4*)(gg + oo + 4 * q4) = v; }
    u32x4 e0, e1;
#pragma unroll
    for (int j = 0; j < 4; ++j) { e0[j] = (unsigned)be[2 * j] | ((unsigned)be[2 * j + 1] << 16); e1[j] = (unsigned)be[8 + 2 * j] | ((unsigned)be[8 + 2 * j + 1] << 16); }
    *(u32x4*)(eidx + oo) = e0; *(u32x4*)(eidx + oo + 8) = e1;
  }
}

typedef float f2_t __attribute__((ext_vector_type(2)));
DI unsigned xcc_id() { return (unsigned)__builtin_amdgcn_s_getreg((3 << 11) | 20) & 7u; }
constexpr int PG_CHUNK_TOK = 64;
constexpr int PG_NCHUNK = T_TOK / PG_CHUNK_TOK;

DI void dec16(const u32x4& r, f2_t (&v)[8]) {
#pragma unroll
  for (int d = 0; d < 4; ++d) { v[2 * d] = __builtin_amdgcn_cvt_pk_f32_fp8((int)r[d], false); v[2 * d + 1] = __builtin_amdgcn_cvt_pk_f32_fp8((int)r[d], true); }
}

DI void peer_udot_token(const Params& p, int x, int t, int lane) {
  const unsigned char* U8 = p.ws + WS_U + (size_t)x * 16384 * 128;
  const u16* Hb = (const u16*)(p.ws + WS_H);
  const u16* eidx = (const u16*)(p.ws + WS_EIDX);
  float* zpart = (float*)p.out;
  const int r = lane >> 3, c = lane & 7;
  int e[16];
#pragma unroll
  for (int i = 0; i < 16; ++i) e[i] = eidx[(size_t)t * 128 + i * 8 + r];
  u32x4 ha = *(const u32x4*)(Hb + (size_t)t * DM + x * 128 + c * 16), hb = *(const u32x4*)(Hb + (size_t)t * DM + x * 128 + c * 16 + 8);
  u32x4 rows[16];
#pragma unroll
  for (int i = 0; i < 16; ++i) rows[i] = *(const u32x4*)(U8 + (size_t)e[i] * 128 + c * 16);
  f2_t hq[8];
#pragma unroll
  for (int j = 0; j < 4; ++j) {
    hq[j][0] = __uint_as_float(ha[j] << 16); hq[j][1] = __uint_as_float(ha[j] & 0xffff0000u);
    hq[4 + j][0] = __uint_as_float(hb[j] << 16); hq[4 + j][1] = __uint_as_float(hb[j] & 0xffff0000u);
  }
  float sv[16];
#pragma unroll
  for (int i = 0; i < 16; ++i) {
    f2_t v[8]; dec16(rows[i], v);
    f2_t a = v[0] * hq[0];
#pragma unroll
    for (int k = 1; k < 8; ++k) a = __builtin_elementwise_fma(v[k], hq[k], a);
    sv[i] = a[0] + a[1];
  }
#pragma unroll
  for (int o = 1; o < 8; o <<= 1) {
#pragma unroll
    for (int i = 0; i < 16; ++i) sv[i] += __shfl_xor(sv[i], o);
  }
  float o0 = 0.f, o1 = 0.f;
#pragma unroll
  for (int i = 0; i < 8; ++i) { if (c == i) { o0 = sv[i]; o1 = sv[i + 8]; } }
  float* zp = zpart + ((size_t)x * T_TOK + t) * 128;
  zp[c * 8 + r] = o0; zp[(c + 8) * 8 + r] = o1;
}

DI void peer_vacc_token(const Params& p, int x, int t, int lane) {
  const unsigned char* V8 = p.ws + WS_V + (size_t)x * 16384 * 128;
  const u16* eidx = (const u16*)(p.ws + WS_EIDX);
  const float* wg = (const float*)(p.ws + WS_G);
  const float* x1 = (const float*)(p.ws + WS_X1);
  const int r = lane >> 3, c = lane & 7;
  int e[16]; float wj[16];
#pragma unroll
  for (int i = 0; i < 16; ++i) { e[i] = eidx[(size_t)t * 128 + i * 8 + r]; wj[i] = wg[(size_t)t * 128 + i * 8 + r]; }
  u32x4 rows[16];
#pragma unroll
  for (int i = 0; i < 16; ++i) rows[i] = *(const u32x4*)(V8 + (size_t)e[i] * 128 + c * 16);
  f2_t acc[8];
#pragma unroll
  for (int k = 0; k < 8; ++k) { acc[k][0] = 0.f; acc[k][1] = 0.f; }
#pragma unroll
  for (int i = 0; i < 16; ++i) {
    f2_t v[8]; dec16(rows[i], v);
    f2_t ww = {wj[i], wj[i]};
#pragma unroll
    for (int k = 0; k < 8; ++k) acc[k] = __builtin_elementwise_fma(v[k], ww, acc[k]);
  }
  f2_t b4[4];
  {
    const bool up = (lane & 32) != 0;
#pragma unroll
    for (int k = 0; k < 4; ++k) {
      f2_t keep = up ? acc[4 + k] : acc[k], send = up ? acc[k] : acc[4 + k];
      f2_t got; got[0] = __shfl_xor(send[0], 32); got[1] = __shfl_xor(send[1], 32);
      b4[k] = keep + got;
    }
  }
  f2_t b2[2];
  {
    const bool up = (lane & 16) != 0;
#pragma unroll
    for (int k = 0; k < 2; ++k) {
      f2_t keep = up ? b4[2 + k] : b4[k], send = up ? b4[k] : b4[2 + k];
      f2_t got; got[0] = __shfl_xor(send[0], 16); got[1] = __shfl_xor(send[1], 16);
      b2[k] = keep + got;
    }
  }
  f2_t b1;
  {
    const bool up = (lane & 8) != 0;
    f2_t keep = up ? b2[1] : b2[0], send = up ? b2[0] : b2[1];
    f2_t got; got[0] = __shfl_xor(send[0], 8); got[1] = __shfl_xor(send[1], 8);
    b1 = keep + got;
  }
  const size_t o = (size_t)t * DM + x * 128 + c * 16 + 2 * r;
  f2_t xv = *(const f2_t*)(x1 + o);
  f2_t res = xv + b1;
  *(f2_t*)(p.out + o) = res;
}

template <int WHICH>
DI void phase_peer_sliced(const Params& p, unsigned char* lds) {
  const int tid = threadIdx.x, lane = tid & 63, w = tid >> 6;
  unsigned* qctr = (unsigned*)(p.ws + WS_MISC + MISC_QCTR) + WHICH * 8;
  int* bc = (int*)lds;
  const unsigned x0 = xcc_id();
  for (int si = 0; si < 8; ++si) {
    const int x = (int)((x0 + si) & 7u);
    for (;;) {
      __syncthreads();
      if (tid == 0) bc[0] = (int)atomicAdd(&qctr[x], 1u);
      __syncthreads();
      const int ch = bc[0];
      if (ch >= PG_NCHUNK) break;
      const int tb = ch * PG_CHUNK_TOK + w * 8;
#pragma unroll 1
      for (int k = 0; k < 8; ++k) {
        if (WHICH == 0) peer_udot_token(p, x, tb + k, lane); else peer_vacc_token(p, x, tb + k, lane);
      }
    }
  }
}

DI void phase_peer_act(const Params& p) {
  const float* zpart = (const float*)p.out;
  const u16* eidx = (const u16*)(p.ws + WS_EIDX);
  float* wg = (float*)(p.ws + WS_G);
  const float* suinv = (const float*)(p.ws + WS_MISC + MISC_SUINV);
  const float* svinv = (const float*)(p.ws + WS_MISC + MISC_SVINV);
  for (size_t i = (size_t)blockIdx.x * NTHR + threadIdx.x; i < (size_t)T_TOK * 128; i += (size_t)gridDim.x * NTHR) {
    float z = 0.f;
#pragma unroll
    for (int x = 0; x < 8; ++x) z += zpart[(size_t)x * T_TOK * 128 + i];
    const int e = eidx[i];
    z *= suinv[e];
    const float act = 0.5f * z * (1.0f + erff(z * 0.70710678118654752f));
    wg[i] = wg[i] * act * svinv[e];
  }
}

__global__ void __launch_bounds__(NTHR, 2) fwd_kernel(Params p) {
  extern __shared__ __attribute__((aligned(16))) unsigned char lds[];
  cg::grid_group grid = cg::this_grid();
#ifndef ONLY_PH
#define PHON(k) 1
#else
#define PHON(k) ((k) == ONLY_PH)
#endif
#ifndef REPEAT_MASK
#define REPEAT_MASK 0
#endif
#define RUN_PHASE(k, call) do { if (PHON(k) && lo <= (k) && (k) < hi) { call; if ((REPEAT_MASK >> (k)) & 1) { grid.sync(); call; } } if (lo <= (k) && (k) + 1 < hi) grid.sync(); } while (0)
  const int lo = p.ph_lo, hi = p.ph_hi;
  RUN_PHASE(0, phase_prep(p, lds));
  RUN_PHASE(1, phase_proj(p, lds));
  RUN_PHASE(2, phase_attn(p, lds));
  RUN_PHASE(3, phase_outproj(p, lds));
  RUN_PHASE(4, phase_norm2(p));
  RUN_PHASE(5, phase_peer_query(p, lds));
  RUN_PHASE(6, phase_peer_combine(p, lds));
  RUN_PHASE(7, phase_peer_sliced<0>(p, lds));
  RUN_PHASE(8, phase_peer_act(p));
  RUN_PHASE(9, phase_peer_sliced<1>(p, lds));
}

extern "C" void kernel_launch(void* const* d_in, const int* in_sizes, int n_in, void* d_out, int out_size, void* d_ws, size_t ws_size, hipStream_t stream) {
  static int grid_blocks = 0;
  if (grid_blocks == 0) {
    if (n_in != 20 || ws_size < WS_END || out_size != T_TOK * DM) {
      fprintf(stderr, "kernel_launch: unexpected problem shape (n_in %d, ws %zu, out %d)\n", n_in, ws_size, out_size);
      grid_blocks = -1; return;
    }
    int dev = 0, cus = 0, per_cu = 0;
    hipGetDevice(&dev);
    hipDeviceGetAttribute(&cus, hipDeviceAttributeMultiprocessorCount, dev);
    hipFuncSetAttribute((const void*)fwd_kernel, hipFuncAttributeMaxDynamicSharedMemorySize, LDS_BYTES);
    hipOccupancyMaxActiveBlocksPerMultiprocessor(&per_cu, (const void*)fwd_kernel, NTHR, LDS_BYTES);
    if (per_cu < 1) { fprintf(stderr, "kernel_launch: occupancy query says %d blocks/CU\n", per_cu); per_cu = 1; }
    grid_blocks = cus;
    (void)hipGetLastError();
  }
  if (grid_blocks < 0) return;
  Params p{};
  p.x_prompt = (const float*)d_in[0]; p.x_sample = (const float*)d_in[1]; p.rel_bias = (const float*)d_in[2]; p.attn_norm_g = (const float*)d_in[3];
  p.w_in = (const float*)d_in[4]; p.q_norm_a = (const float*)d_in[5]; p.k_norm_a = (const float*)d_in[6]; p.q_norm_b = (const float*)d_in[7];
  p.k_norm_b = (const float*)d_in[8]; p.lq1 = (const float*)d_in[9]; p.lk1 = (const float*)d_in[10]; p.lq2 = (const float*)d_in[11];
  p.lk2 = (const float*)d_in[12]; p.diff_norm_g = (const float*)d_in[13]; p.w_out = (const float*)d_in[14]; p.ffn_norm_g = (const float*)d_in[15];
  p.peer_w_q = (const float*)d_in[16]; p.peer_sub_keys = (const float*)d_in[17]; p.peer_u = (const float*)d_in[18]; p.peer_v = (const float*)d_in[19];
  p.out = (float*)d_out; p.ws = (unsigned char*)d_ws;
#if FUSED
  p.ph_lo = 0; p.ph_hi = NPHASE;
  void* args[] = {&p};
  hipError_t e = hipLaunchCooperativeKernel((const void*)fwd_kernel, dim3(grid_blocks), dim3(NTHR), args, LDS_BYTES, stream);
  if (e != hipSuccess) fprintf(stderr, "cooperative launch failed: %s (grid %d)\n", hipGetErrorString(e), grid_blocks);
#else
  for (int ph = 0; ph < NPHASE; ++ph) {
    p.ph_lo = ph; p.ph_hi = ph + 1;
    hipLaunchKernelGGL(fwd_kernel, dim3(grid_blocks), dim3(NTHR), LDS_BYTES, stream, p);
  }
#endif
}
```

```cpp
#include <hip/hip_runtime.h>
#include <hip/hip_cooperative_groups.h>
#include <cstdio>
#include <cstdint>
namespace cg = cooperative_groups;

#ifndef FUSED
#define FUSED 1
#endif

typedef unsigned short u16;
typedef __attribute__((ext_vector_type(8))) short bf16x8;
typedef __attribute__((ext_vector_type(4))) short s16x4;
typedef __attribute__((ext_vector_type(16))) float f32x16;
typedef __attribute__((ext_vector_type(4))) float f32x4;
typedef __attribute__((ext_vector_type(4))) unsigned u32x4;
typedef __attribute__((ext_vector_type(2))) unsigned u32x2;
typedef __attribute__((address_space(3))) unsigned char* ldsp_t;

#define DI __device__ __forceinline__
#define MFMA32(a, b, c) __builtin_amdgcn_mfma_f32_32x32x16_bf16((a), (b), (c), 0, 0, 0)

constexpr int DM = 1024;
constexpr int T_TOK = 65536;
constexpr int T_PROMPT = 32768;
constexpr int NTHR = 512;
constexpr int NPHASE = 10;
constexpr float NORM_EPS = 1e-6f;
constexpr float LOG2E = 1.4426950408889634f;
constexpr float C2 = 0.125f * LOG2E;
constexpr float NEG_BIG = -1.0e30f;

constexpr size_t WS_WIN  = 0;
constexpr size_t WS_WOUT = WS_WIN + (size_t)3072 * 1024 * 2;
constexpr size_t WS_WQ   = WS_WOUT + (size_t)1024 * 1024 * 2;
constexpr size_t WS_SK   = WS_WQ + (size_t)2048 * 1024 * 2;
constexpr size_t WS_U    = WS_SK + (size_t)2 * 128 * 128 * 2;
constexpr size_t WS_V    = WS_U + (size_t)16384 * 1024 * 2;
constexpr size_t WS_MISC = WS_V + (size_t)16384 * 1024 * 2;
constexpr size_t MISC_SUINV = 0, MISC_SVINV = 65536, MISC_QCTR = 131072;
constexpr size_t WS_R    = WS_MISC + (size_t)1048576;
constexpr size_t R_REGION = (size_t)T_TOK * 512 * 2;
constexpr size_t WS_X1   = WS_R;
constexpr size_t WS_H    = WS_R + (size_t)T_TOK * 1024 * 4;
constexpr size_t WS_EIDX = WS_R + 6 * R_REGION;
constexpr size_t WS_G    = WS_EIDX + (size_t)T_TOK * 128 * 2;
constexpr size_t WS_END  = WS_G + (size_t)T_TOK * 128 * 4;
static_assert(WS_END <= (size_t)536870912, "workspace map exceeds 512 MiB");
constexpr size_t OUT_N1 = 0, OUT_MIX = 134217728, OUT_TV = 0, OUT_TI = 67108864;

constexpr int LDS_BYTES = 131072;

struct Params {
  const float* x_prompt; const float* x_sample; const float* rel_bias; const float* attn_norm_g; const float* w_in;
  const float* q_norm_a; const float* k_norm_a; const float* q_norm_b; const float* k_norm_b;
  const float* lq1; const float* lk1; const float* lq2; const float* lk2; const float* diff_norm_g; const float* w_out;
  const float* ffn_norm_g; const float* peer_w_q; const float* peer_sub_keys; const float* peer_u; const float* peer_v;
  float* out; unsigned char* ws; int ph_lo; int ph_hi;
};

DI u16 f2bf(float f) { unsigned u = __float_as_uint(f); u += 0x7fffu + ((u >> 16) & 1u); return (u16)(u >> 16); }
DI float bf2f(u16 b) { return __uint_as_float(((unsigned)b) << 16); }
DI unsigned pk2(float lo, float hi) {
  typedef float f2_t __attribute__((ext_vector_type(2)));
  typedef __bf16 b2_t __attribute__((ext_vector_type(2)));
  f2_t v = {lo, hi}; b2_t b = __builtin_convertvector(v, b2_t); return __builtin_bit_cast(unsigned, b);
}
DI int crow(int reg, int h) { return (reg & 3) + 8 * (reg >> 2) + 4 * h; }
DI float wave_sum(float v) {
#pragma unroll
  for (int o = 32; o > 0; o >>= 1) v += __shfl_xor(v, o);
  return v;
}
DI void seq_of(int t, int& seq_start, int& S, int& s) {
  if (t < T_PROMPT) { S = 4096; seq_start = t & ~4095; s = t & 4095; }
  else { S = 2048; seq_start = t & ~2047; s = t & 2047; }
}
DI const float* x_row(const Params& p, int t) {
  return (t < T_PROMPT) ? p.x_prompt + (size_t)t * DM : p.x_sample + (size_t)(t - T_PROMPT) * DM;
}
DI int rel_bucket(int rel) {
  int n = rel < 0 ? -rel : rel;
  int b;
  if (n < 8) b = n;
  else if (n < 15) b = 8; else if (n < 27) b = 9; else if (n < 50) b = 10; else if (n < 91) b = 11;
  else if (n < 166) b = 12; else if (n < 305) b = 13; else if (n < 559) b = 14; else b = 15;
  return (rel > 0 ? 16 : 0) + b;
}
DI s16x4 tr_read(const unsigned char* p) {
  typedef short v4i16_t __attribute__((ext_vector_type(4)));
  return __builtin_bit_cast(s16x4, __builtin_amdgcn_ds_read_tr16_b64_v4i16((__attribute__((address_space(3))) v4i16_t*)p));
}
DI bf16x8 cat8(s16x4 lo, s16x4 hi) { return __builtin_shufflevector(lo, hi, 0, 1, 2, 3, 4, 5, 6, 7); }

DI void transpose_item(const float* __restrict__ src, int K, int N, u16* __restrict__ dst, int k0, int n0, unsigned char* lds) {
  float* tile = (float*)lds;
  const int tid = threadIdx.x;
#pragma unroll
  for (int i = 0; i < 8; ++i) {
    int idx = tid + 512 * i; int r = idx >> 6, c = idx & 63;
    tile[r * 65 + c] = src[(size_t)(k0 + r) * N + n0 + c];
  }
  __syncthreads();
  {
    int n = tid >> 3, kc = tid & 7;
    u32x4 o;
    o[0] = pk2(tile[(kc * 8 + 0) * 65 + n], tile[(kc * 8 + 1) * 65 + n]);
    o[1] = pk2(tile[(kc * 8 + 2) * 65 + n], tile[(kc * 8 + 3) * 65 + n]);
    o[2] = pk2(tile[(kc * 8 + 4) * 65 + n], tile[(kc * 8 + 5) * 65 + n]);
    o[3] = pk2(tile[(kc * 8 + 6) * 65 + n], tile[(kc * 8 + 7) * 65 + n]);
    *(u32x4*)(dst + (size_t)(n0 + n) * K + k0 + kc * 8) = o;
  }
  __syncthreads();
}

DI void convert_item(const float* __restrict__ src, u16* __restrict__ dst, size_t base) {
  size_t i = base + (size_t)threadIdx.x * 8;
  f32x4 a = *(const f32x4*)(src + i), b = *(const f32x4*)(src + i + 4);
  u32x4 o; o[0] = pk2(a[0], a[1]); o[1] = pk2(a[2], a[3]); o[2] = pk2(b[0], b[1]); o[3] = pk2(b[2], b[3]);
  *(u32x4*)(dst + i) = o;
}

DI void norm_row(const float* __restrict__ xr, const float* __restrict__ g, u16* __restrict__ orow, int lane) {
  f32x4 v[4]; float ss = 0.f;
#pragma unroll
  for (int i = 0; i < 4; ++i) { v[i] = *(const f32x4*)(xr + lane * 4 + 256 * i); ss += v[i][0] * v[i][0] + v[i][1] * v[i][1] + v[i][2] * v[i][2] + v[i][3] * v[i][3]; }
  ss = wave_sum(ss);
  const float r = __builtin_amdgcn_rsqf(ss * (1.0f / 1024.0f) + NORM_EPS);
#pragma unroll
  for (int i = 0; i < 4; ++i) {
    f32x4 gg = *(const f32x4*)(g + lane * 4 + 256 * i);
    u32x2 o; o[0] = pk2(v[i][0] * r * gg[0], v[i][1] * r * gg[1]); o[1] = pk2(v[i][2] * r * gg[2], v[i][3] * r * gg[3]);
    *(u32x2*)(orow + lane * 4 + 256 * i) = o;
  }
}

DI void phase_prep(const Params& p, unsigned char* lds) {
  const int nb = gridDim.x, bid = blockIdx.x, tid = threadIdx.x;
  u16* wsb = (u16*)p.ws;
  for (int it = bid; it < 768 + 256 + 512; it += nb) {
    if (it < 768) { int kt = it / 48, nt = it % 48; transpose_item(p.w_in, 1024, 3072, (u16*)(p.ws + WS_WIN), kt * 64, nt * 64, lds); }
    else if (it < 1024) { int j = it - 768; int kt = j / 16, nt = j % 16; transpose_item(p.w_out, 1024, 1024, (u16*)(p.ws + WS_WOUT), kt * 64, nt * 64, lds); }
    else { int j = it - 1024; int kt = j / 32, nt = j % 32; transpose_item(p.peer_w_q, 1024, 2048, (u16*)(p.ws + WS_WQ), kt * 64, nt * 64, lds); }
  }
  for (int it = bid; it < 8; it += nb) convert_item(p.peer_sub_keys, (u16*)(p.ws + WS_SK), (size_t)it * 4096);
  if (bid == 0 && tid < 64) ((unsigned*)(p.ws + WS_MISC + MISC_QCTR))[tid] = 0u;
  {
    const int lane_ = tid & 63, w_ = tid >> 6;
    for (int it = bid; it < 2 * 16384 / 8; it += nb) {
      const int row = it * 8 + w_;
      const int tbl = row >> 14, e = row & 16383;
      const float* src = (tbl ? p.peer_v : p.peer_u) + (size_t)e * DM + lane_ * 16;
      f32x4 a0 = *(const f32x4*)(src), a1 = *(const f32x4*)(src + 4), a2 = *(const f32x4*)(src + 8), a3 = *(const f32x4*)(src + 12);
      float am = 0.f;
#pragma unroll
      for (int j = 0; j < 4; ++j) am = fmaxf(am, fmaxf(fmaxf(fabsf(a0[j]), fabsf(a1[j])), fmaxf(fabsf(a2[j]), fabsf(a3[j]))));
#pragma unroll
      for (int o = 32; o > 0; o >>= 1) am = fmaxf(am, __shfl_xor(am, o));
      const int ex = (int)((__float_as_uint(am) >> 23) & 255u);
      float sc = 1.0f, isc = 1.0f;
      if (ex > 8 && ex < 250) { sc = __uint_as_float((unsigned)(261 - ex) << 23); isc = __uint_as_float((unsigned)(ex - 7) << 23); }
      u32x4 o;
      { int pk = __builtin_amdgcn_cvt_pk_fp8_f32(a0[0] * sc, a0[1] * sc, 0, false); pk = __builtin_amdgcn_cvt_pk_fp8_f32(a0[2] * sc, a0[3] * sc, pk, true); o[0] = (unsigned)pk; }
      { int pk = __builtin_amdgcn_cvt_pk_fp8_f32(a1[0] * sc, a1[1] * sc, 0, false); pk = __builtin_amdgcn_cvt_pk_fp8_f32(a1[2] * sc, a1[3] * sc, pk, true); o[1] = (unsigned)pk; }
      { int pk = __builtin_amdgcn_cvt_pk_fp8_f32(a2[0] * sc, a2[1] * sc, 0, false); pk = __builtin_amdgcn_cvt_pk_fp8_f32(a2[2] * sc, a2[3] * sc, pk, true); o[2] = (unsigned)pk; }
      { int pk = __builtin_amdgcn_cvt_pk_fp8_f32(a3[0] * sc, a3[1] * sc, 0, false); pk = __builtin_amdgcn_cvt_pk_fp8_f32(a3[2] * sc, a3[3] * sc, pk, true); o[3] = (unsigned)pk; }
      unsigned char* dst = p.ws + (tbl ? WS_V : WS_U) + ((size_t)(lane_ >> 3) * 16384 + e) * 128 + (lane_ & 7) * 16;
      *(u32x4*)dst = o;
      if (lane_ == 0) ((float*)(p.ws + WS_MISC + (tbl ? MISC_SVINV : MISC_SUINV)))[e] = isc;
    }
  }
  const int lane = tid & 63, w = tid >> 6;
  u16* n1 = (u16*)((unsigned char*)p.out + OUT_N1);
  for (int it = bid; it < T_TOK / 8; it += nb) {
    int t = it * 8 + w;
    norm_row(x_row(p, t), p.attn_norm_g, n1 + (size_t)t * DM, lane);
  }
  (void)wsb;
}

template <int PR, int QR>
DI void gemm_mainloop(const u16* __restrict__ P, const u16* __restrict__ Q, int K, int p0, int q0, unsigned char* lds, f32x16 (&acc)[2][2]) {
  static_assert(PR + QR == 384, "tile");
  constexpr int STAGE = 384 * 128;
  constexpr int WC = QR / 64;
  const int tid = threadIdx.x, lane = tid & 63, r32 = lane & 31, h = lane >> 5;
  const int w = __builtin_amdgcn_readfirstlane(tid >> 6);
  const int wr = w / WC, wc = w % WC;
#pragma unroll
  for (int i = 0; i < 2; ++i)
#pragma unroll
    for (int j = 0; j < 2; ++j)
#pragma unroll
      for (int r = 0; r < 16; ++r) acc[i][j][r] = 0.f;
  u32x4 stg[6];
  const u16* src[6]; int loff[6];
#pragma unroll
  for (int i = 0; i < 6; ++i) {
    int c = tid + 512 * i; int row = c >> 3, kc = c & 7;
    src[i] = (row < PR) ? P + (size_t)(p0 + row) * K + kc * 8 : Q + (size_t)(q0 + row - PR) * K + kc * 8;
    loff[i] = row * 128 + ((kc ^ ((row >> 1) & 7)) << 4);
  }
  const int KT = K / 64;
#pragma unroll
  for (int i = 0; i < 6; ++i) stg[i] = *(const u32x4*)(src[i]);
#pragma unroll
  for (int i = 0; i < 6; ++i) *(u32x4*)(lds + loff[i]) = stg[i];
  __syncthreads();
  int aoff[2], boff[2], asw[2], bsw[2];
#pragma unroll
  for (int i = 0; i < 2; ++i) {
    int ra = wr * 64 + i * 32 + r32; aoff[i] = ra * 128; asw[i] = (ra >> 1) & 7;
    int rb = PR + wc * 64 + i * 32 + r32; boff[i] = rb * 128; bsw[i] = (rb >> 1) & 7;
  }
  for (int kt = 0; kt < KT; ++kt) {
    const int buf = (kt & 1) * STAGE;
    if (kt + 1 < KT) {
#pragma unroll
      for (int i = 0; i < 6; ++i) stg[i] = *(const u32x4*)(src[i] + (kt + 1) * 64);
    }
#pragma unroll
    for (int ks = 0; ks < 4; ++ks) {
      bf16x8 a[2], b[2];
#pragma unroll
      for (int i = 0; i < 2; ++i) {
        a[i] = *(const bf16x8*)(lds + buf + aoff[i] + (((2 * ks + h) ^ asw[i]) << 4));
        b[i] = *(const bf16x8*)(lds + buf + boff[i] + (((2 * ks + h) ^ bsw[i]) << 4));
      }
#pragma unroll
      for (int i = 0; i < 2; ++i)
#pragma unroll
        for (int j = 0; j < 2; ++j) acc[i][j] = MFMA32(a[i], b[j], acc[i][j]);
    }
    if (kt + 1 < KT) {
      const int nbuf = ((kt + 1) & 1) * STAGE;
#pragma unroll
      for (int i = 0; i < 6; ++i) *(u32x4*)(lds + nbuf + loff[i]) = stg[i];
    }
    __syncthreads();
  }
}

namespace pg8 {
#define PG8_LAS __attribute__((address_space(3)))
typedef unsigned short bf16_t;
typedef short bf16x8 __attribute__((ext_vector_type(8)));
typedef float f32x4 __attribute__((ext_vector_type(4)));
typedef unsigned u32x4 __attribute__((ext_vector_type(4)));
constexpr int BM = 256, BK = 64, HALF = 128, HTB = HALF * BK * 2  , STAGE_BYTES = 8 * HTB, NXCD = 8, WGM = 8;

__host__ __device__ __forceinline__ int lds_byte(int r, int c) { const int st = (r >> 4) * 2 + (c >> 5), rr = r & 15, cc = c & 31, ob = rr * 64 + cc * 2; return st * 1024 + (ob ^ (((ob >> 9) & 1) << 5)); }
__host__ __device__ __forceinline__ void stage_rc(int b, int& R, int& C) { const int st = b / 1024, sb = b % 1024, swz = sb ^ (((sb >> 9) & 1) << 5); R = (st >> 1) * 16 + swz / 64; C = (st & 1) * 32 + (swz % 64) / 2; }
__host__ __device__ __forceinline__ int perm32(int rho) { const int n = rho >> 4, i = rho & 15; return 8 * (i >> 2) + 4 * n + (i & 3); }

struct Unit { int pm, pn; };
struct Gemm { const bf16_t* A; const bf16_t* Bt; int M, N, K; };

struct StaticOrder {
    int nM, nN, nwg, G, c;
    __host__ __device__ void init(int M, int N, int G_, int c_) { nM = M / BM; nN = N / BM; nwg = nM * nN; G = G_; c = c_; }
    __host__ __device__ bool next(int i, Unit& u) const {
        const long L = (long)i * G + c; if (L >= nwg) return false;
        int wgid = (int)L; { const int q = nwg / NXCD, r = nwg % NXCD, xcd = wgid % NXCD, off = wgid / NXCD; wgid = (xcd < r ? xcd * (q + 1) : r * (q + 1) + (xcd - r) * q) + off; }
        const int nig = WGM * nN, gid = wgid / nig, fm = gid * WGM, gsz = (nM - fm) < WGM ? (nM - fm) : WGM;
        u.pm = fm + ((wgid % nig) % gsz); u.pn = (wgid % nig) / gsz; return true;
    }
    __device__ __forceinline__ void a_ready(const Unit&) const {}
    __device__ __forceinline__ void done(const Unit&) const {}
};


template <class Epi, class Sched, bool ALIGN_EPI = false, bool SP2 = false>
__device__ __forceinline__ void gemm_phase(PG8_LAS unsigned char* lds, const Gemm g, const Sched& S, const Epi& E) {
    const int tid = threadIdx.x, wid = __builtin_amdgcn_readfirstlane(tid >> 6), lane = tid & 63, wr = wid >> 2, wc = wid & 3, fr = lane & 15, fq = lane >> 4;
    const int K = g.K, nt = K / BK;
    unsigned voffA[2], voffB[2], voffB1[2];
#pragma unroll
    for (int i = 0; i < 2; ++i) { int R, C; stage_rc(tid * 16 + i * 8192, R, C); const int Rb = Epi::PERM ? ((R & ~31) + perm32(R & 31)) : R;
        voffA[i] = (unsigned)(R * K + C) * 2u;
        if (Epi::HEADPERM) { const int Rh = 64 * (R >> 5) + perm32(R & 31); voffB[i] = (unsigned)(Rh * K + C) * 2u; voffB1[i] = (unsigned)((Rh + 32) * K + C) * 2u; }
        else { voffB[i] = (unsigned)(Rb * K + C) * 2u; voffB1[i] = (unsigned)((Rb + HALF) * K + C) * 2u; } }
    const size_t kstep = (size_t)(BK * 2);
    const size_t hstep = (size_t)HALF * K * 2;
    const size_t tstep = 2 * hstep;
    const unsigned ldsw = (unsigned)wid * 1024u;
    const int aoff = lds_byte(wr * 64 + fr, fq * 8), boff = lds_byte(wc * 32 + fr, fq * 8);
#define PG8_SA(b, h) (((b) * 2 + (h)) * HTB)
#define PG8_SB(b, h) ((4 + (b) * 2 + (h)) * HTB)
#define PG8_STAGE(bufoff, gbase, voff) do { _Pragma("unroll") for (int _i = 0; _i < 2; ++_i) \
        __builtin_amdgcn_global_load_lds((const unsigned*)((const char*)(gbase) + (voff)[_i]), (PG8_LAS unsigned*)(lds + (bufoff) + ldsw + _i * 8192), 16, 0, 0); } while (0)
#define PG8_LDA(dst, b, h) do { _Pragma("unroll") for (int m = 0; m < 4; ++m) _Pragma("unroll") for (int k = 0; k < 2; ++k) dst[m][k] = *(const PG8_LAS bf16x8*)(lds + PG8_SA(b, h) + aoff + m * 2048 + k * 1024); } while (0)
#define PG8_LDB(dst, b, h) do { _Pragma("unroll") for (int n = 0; n < 2; ++n) _Pragma("unroll") for (int k = 0; k < 2; ++k) dst[n][k] = *(const PG8_LAS bf16x8*)(lds + PG8_SB(b, h) + boff + n * 2048 + k * 1024); } while (0)
#define PG8_MMA(ai, bj, At, Bt) do { __builtin_amdgcn_s_setprio(1); _Pragma("unroll") for (int m = 0; m < 4; ++m) _Pragma("unroll") for (int n = 0; n < 2; ++n) _Pragma("unroll") for (int k = 0; k < 2; ++k) \
        acc[ai][bj][m][n] = __builtin_amdgcn_mfma_f32_16x16x32_bf16(Bt[n][k], At[m][k], acc[ai][bj][m][n], 0, 0, 0); __builtin_amdgcn_s_setprio(0); } while (0)
#define PG8_WAIT_V(n) asm volatile("s_waitcnt vmcnt(" #n ")" ::: "memory")
#define PG8_WAIT_L(n) asm volatile("s_waitcnt lgkmcnt(" #n ")" ::: "memory")
#define PG8_BAR __builtin_amdgcn_s_barrier()
#define PG8_SCHED __builtin_amdgcn_sched_barrier(0)
    Unit cur, nxt; int ui = 0;
    if (!S.next(0, cur)) return;
    f32x4 acc[2][2][4][2];
#pragma unroll
    for (int a = 0; a < 2; ++a)
#pragma unroll
        for (int b = 0; b < 2; ++b)
#pragma unroll
            for (int m = 0; m < 4; ++m)
#pragma unroll
                for (int n = 0; n < 2; ++n) acc[a][b][m][n] = (f32x4){0.f, 0.f, 0.f, 0.f};
    bf16x8 At[4][2], B0[2][2], B1[2][2];
    const char* cA = (const char*)g.A + (size_t)cur.pm * tstep; const char* cB = (const char*)g.Bt + (size_t)cur.pn * tstep;
    S.a_ready(cur);
    if constexpr (SP2) {
        PG8_STAGE(PG8_SB(0, 0), cB, voffB); PG8_STAGE(PG8_SB(0, 1), cB, voffB1); PG8_STAGE(PG8_SA(0, 0), cA, voffA); PG8_STAGE(PG8_SA(0, 1), cA + hstep, voffA);
        if (wr == 1) PG8_BAR;
        PG8_WAIT_V(2); PG8_BAR;
        PG8_STAGE(PG8_SB(1, 0), cB + kstep, voffB); PG8_STAGE(PG8_SA(1, 0), cA + kstep, voffA); PG8_STAGE(PG8_SB(1, 1), cB + kstep, voffB1);
        PG8_WAIT_V(6); PG8_BAR;
    } else {
        PG8_STAGE(PG8_SB(0, 0), cB, voffB); PG8_STAGE(PG8_SA(0, 0), cA, voffA); PG8_STAGE(PG8_SB(0, 1), cB, voffB1); PG8_STAGE(PG8_SA(0, 1), cA + hstep, voffA);
        if (wr == 1) PG8_BAR;
        PG8_WAIT_V(4); PG8_BAR;
        PG8_STAGE(PG8_SB(1, 0), cB + kstep, voffB); PG8_STAGE(PG8_SA(1, 0), cA + kstep, voffA); PG8_STAGE(PG8_SB(1, 1), cB + kstep, voffB1);
        PG8_WAIT_V(6); PG8_BAR;
    }
    for (;;) {
        const bool has_next = S.next(ui + 1, nxt);
        const char* nA = has_next ? (const char*)g.A + (size_t)nxt.pm * tstep : cA; const char* nB = has_next ? (const char*)g.Bt + (size_t)nxt.pn * tstep : cB;
        for (int t = 0; t < nt; t += 2) {
            const bool last = (t == nt - 2);
            const char* a1 = cA + (size_t)(t + 1) * kstep;
            const char* a2 = last ? nA : cA + (size_t)(t + 2) * kstep; const char* b2 = last ? nB : cB + (size_t)(t + 2) * kstep;
            const char* a3 = a2 + kstep; const char* b3 = b2 + kstep;
            if (last && has_next) S.a_ready(nxt);
            if constexpr (SP2) {
            PG8_LDB(B0, 0, 0); PG8_LDB(B1, 0, 1); PG8_SCHED; PG8_LDA(At, 0, 0); PG8_STAGE(PG8_SA(1, 1), a1 + hstep, voffA);
            PG8_WAIT_V(8); PG8_WAIT_L(0); PG8_BAR; PG8_MMA(0, 0, At, B0); PG8_MMA(0, 1, At, B1); PG8_BAR; PG8_SCHED;
            PG8_LDA(At, 0, 1); PG8_STAGE(PG8_SB(0, 0), b2, voffB); PG8_STAGE(PG8_SB(0, 1), b2, voffB1); PG8_STAGE(PG8_SA(0, 0), a2, voffA);
            PG8_WAIT_V(8); PG8_WAIT_L(0); PG8_BAR; PG8_MMA(1, 0, At, B0); PG8_MMA(1, 1, At, B1); PG8_BAR; PG8_SCHED;
            PG8_LDB(B0, 1, 0); PG8_LDB(B1, 1, 1); PG8_SCHED; PG8_LDA(At, 1, 0); PG8_STAGE(PG8_SA(0, 1), a2 + hstep, voffA);
            PG8_WAIT_V(8); PG8_WAIT_L(0); PG8_BAR; PG8_MMA(0, 0, At, B0); PG8_MMA(0, 1, At, B1); PG8_BAR; PG8_SCHED;
            PG8_LDA(At, 1, 1); PG8_STAGE(PG8_SB(1, 0), b3, voffB); PG8_STAGE(PG8_SB(1, 1), b3, voffB1); PG8_STAGE(PG8_SA(1, 0), a3, voffA);
            PG8_WAIT_V(8); PG8_WAIT_L(0); PG8_BAR; PG8_MMA(1, 0, At, B0); PG8_MMA(1, 1, At, B1); PG8_BAR; PG8_SCHED;
            } else {
            PG8_LDB(B0, 0, 0); PG8_SCHED; PG8_LDA(At, 0, 0); PG8_STAGE(PG8_SA(1, 1), a1 + hstep, voffA);
            PG8_WAIT_L(8); PG8_BAR; PG8_WAIT_L(0); PG8_MMA(0, 0, At, B0); PG8_BAR; PG8_SCHED;
            PG8_LDB(B1, 0, 1); PG8_STAGE(PG8_SB(0, 0), b2, voffB);
            PG8_BAR; PG8_WAIT_L(0); PG8_MMA(0, 1, At, B1); PG8_BAR;
            PG8_LDA(At, 0, 1); PG8_STAGE(PG8_SA(0, 0), a2, voffA);
            PG8_BAR; PG8_WAIT_L(0); PG8_MMA(1, 0, At, B0); PG8_BAR; PG8_SCHED;
            PG8_STAGE(PG8_SB(0, 1), b2, voffB1);
            PG8_WAIT_V(6); PG8_BAR; PG8_MMA(1, 1, At, B1); PG8_BAR;
            PG8_LDB(B0, 1, 0); PG8_SCHED; PG8_LDA(At, 1, 0); PG8_STAGE(PG8_SA(0, 1), a2 + hstep, voffA);
            PG8_WAIT_L(8); PG8_BAR; PG8_WAIT_L(0); PG8_MMA(0, 0, At, B0); PG8_BAR; PG8_SCHED;
            PG8_LDB(B1, 1, 1); PG8_STAGE(PG8_SB(1, 0), b3, voffB);
            PG8_BAR; PG8_WAIT_L(0); PG8_MMA(0, 1, At, B1); PG8_BAR;
            PG8_LDA(At, 1, 1); PG8_STAGE(PG8_SA(1, 0), a3, voffA);
            PG8_BAR; PG8_WAIT_L(0); PG8_MMA(1, 0, At, B0); PG8_BAR; PG8_SCHED;
            PG8_STAGE(PG8_SB(1, 1), b3, voffB1);
            PG8_WAIT_V(6); PG8_BAR; PG8_MMA(1, 1, At, B1); PG8_BAR;
            }
        }
        if constexpr (ALIGN_EPI) { if (wr == 0) PG8_BAR; }
        if constexpr (!Epi::AFTER_DRAIN) { E(acc, cur, wr, wc, fr, fq); S.done(cur); }
        if (!has_next) break;
#pragma unroll
        for (int a = 0; a < 2; ++a)
#pragma unroll
            for (int b = 0; b < 2; ++b)
#pragma unroll
                for (int m = 0; m < 4; ++m)
#pragma unroll
                    for (int n = 0; n < 2; ++n) acc[a][b][m][n] = (f32x4){0.f, 0.f, 0.f, 0.f};
        cur = nxt; cA = nA; cB = nB; ++ui;
        if constexpr (ALIGN_EPI) { if (wr == 1) PG8_BAR; }
    }
    PG8_WAIT_V(0);
    if constexpr (!ALIGN_EPI) { if (wr == 0) PG8_BAR; }
    PG8_BAR;
    if constexpr (Epi::AFTER_DRAIN) { E.fused(acc, cur, wr, wc, fr, fq, lds, wid, lane); S.done(cur); }
#undef PG8_SA
#undef PG8_SB
#undef PG8_STAGE
#undef PG8_LDA
#undef PG8_LDB
#undef PG8_MMA
#undef PG8_WAIT_V
#undef PG8_WAIT_L
#undef PG8_BAR
#undef PG8_SCHED
}
}

struct EpiProj {
  static constexpr bool PERM = true, AFTER_DRAIN = false, HEADPERM = true;
  const float* gqa; const float* gka; const float* gqb; const float* gkb; unsigned char* ws;
  __device__ __forceinline__ void operator()(const pg8::f32x4 (&acc)[2][2][4][2], const pg8::Unit& u, int wr, int wc, int fr, int fq) const {
    const int nbase = u.pn * 256 + wc * 64;
    const int region = nbase >> 9, hw = (nbase & 511) >> 6;
    const float* g = (region == 0) ? gqa : (region == 1) ? gka : (region == 3) ? gqb : gkb;
    const bool normed = (region != 2 && region != 5);
    const float qs = (region == 0 || region == 3) ? C2 : 1.0f;
    u16* dstR = (u16*)(ws + WS_R + (size_t)region * R_REGION);
    f32x4 gv[2][2];
#pragma unroll
    for (int bj = 0; bj < 2; ++bj)
#pragma unroll
      for (int n = 0; n < 2; ++n) gv[bj][n] = normed ? *(const f32x4*)(g + 32 * bj + 8 * fq + 4 * n) : (f32x4){1.f, 1.f, 1.f, 1.f};
#pragma unroll
    for (int ai = 0; ai < 2; ++ai)
#pragma unroll
      for (int m = 0; m < 4; ++m) {
        const int t = u.pm * 256 + ai * 128 + wr * 64 + m * 16 + fr;
        int seq_start, S, sq; seq_of(t, seq_start, S, sq);
        float scale = 1.0f;
        if (normed) {
          float ss = 0.f;
#pragma unroll
          for (int bj = 0; bj < 2; ++bj)
#pragma unroll
            for (int n = 0; n < 2; ++n) { const f32x4 v = acc[ai][bj][m][n]; ss += v[0] * v[0] + v[1] * v[1] + v[2] * v[2] + v[3] * v[3]; }
          ss += __shfl_xor(ss, 16); ss += __shfl_xor(ss, 32);
          scale = __builtin_amdgcn_rsqf(ss * (1.0f / 64.0f) + NORM_EPS) * qs;
        }
        u16* dst;
        if (region != 5) dst = dstR + (size_t)seq_start * 512 + ((size_t)hw * S + sq) * 64;
        else dst = dstR + (size_t)seq_start * 512 + ((size_t)(hw >> 1) * S + sq) * 128 + (hw & 1) * 64;
#pragma unroll
        for (int bj = 0; bj < 2; ++bj) {
          const f32x4 v0 = acc[ai][bj][m][0] * scale * gv[bj][0], v1 = acc[ai][bj][m][1] * scale * gv[bj][1];
          u32x4 o; o[0] = pk2(v0[0], v0[1]); o[1] = pk2(v0[2], v0[3]); o[2] = pk2(v1[0], v1[1]); o[3] = pk2(v1[2], v1[3]);
          *(u32x4*)(dst + 32 * bj + 8 * fq) = o;
        }
      }
  }
};

DI void phase_proj(const Params& p, unsigned char* lds) {
  pg8::Gemm g{(const u16*)((const unsigned char*)p.out + OUT_N1), (const u16*)(p.ws + WS_WIN), T_TOK, 3072, 1024};
  pg8::StaticOrder S; S.init(T_TOK, 3072, (int)gridDim.x, (int)blockIdx.x);
  EpiProj E{p.q_norm_a, p.k_norm_a, p.q_norm_b, p.k_norm_b, p.ws};
  pg8::gemm_phase<EpiProj, pg8::StaticOrder, true, true>((PG8_LAS unsigned char*)lds, g, S, E);
}

constexpr int AL_STAGE = 0;
constexpr int AL_TAB   = 65536;
constexpr int AL_TABA  = 73728;
constexpr int AL_VT    = 90112;
constexpr int AL_XL    = 122880;
constexpr int AL_MISC  = 124928;

DI unsigned voff_b(int row, int ch) { return 256u * row + 16u * (ch ^ (((row & 3) << 2) | ((row >> 2) & 3))); }

DI void diff_unit(const Params& p, unsigned char* lds, int seq_start, int S, int hd, int q0, float lam) {
  const int tid = threadIdx.x, lane = tid & 63, r32 = lane & 31, h = lane >> 5;
  const int w = __builtin_amdgcn_readfirstlane(tid >> 6);
  const int map = w >> 2, wq = w & 3;
  const u16* QBp = (const u16*)(p.ws + WS_R + 3 * R_REGION);
  const u16* KBp = (const u16*)(p.ws + WS_R + 4 * R_REGION);
  const u16* VBp = (const u16*)(p.ws + WS_R + 5 * R_REGION);
  const int qpos = q0 + wq * 32 + r32;
  const u16* Qp = QBp + (size_t)seq_start * 512 + ((size_t)(hd * 2 + map) * S + qpos) * 64;
  bf16x8 qf[4];
#pragma unroll
  for (int ks = 0; ks < 4; ++ks) qf[ks] = *(const bf16x8*)(Qp + ks * 16 + h * 8);
  const u16* K1g = KBp + (size_t)seq_start * 512 + ((size_t)(hd * 2 + 0) * S) * 64;
  const u16* K2g = KBp + (size_t)seq_start * 512 + ((size_t)(hd * 2 + 1) * S) * 64;
  const u16* Vg = VBp + (size_t)seq_start * 512 + ((size_t)hd * S) * 128;
  const float* tab = (const float*)(lds + AL_TAB);
  const float* misc = (const float*)(lds + AL_MISC);
  const float cBefore = misc[8 + hd], cAfter = misc[12 + hd];
  f32x16 O[4];
#pragma unroll
  for (int nb = 0; nb < 4; ++nb)
#pragma unroll
    for (int r = 0; r < 16; ++r) O[nb][r] = 0.f;
  float l = 0.f;
  const int krow = tid >> 3, kkc = tid & 7;
  const int kl_off = krow * 128 + ((kkc ^ ((krow >> 1) & 7)) << 4);
  const u16* k1src = K1g + (size_t)krow * 64 + kkc * 8;
  const u16* k2src = K2g + (size_t)krow * 64 + kkc * 8;
  int vl_off[2]; const u16* vsrc[2];
#pragma unroll
  for (int i = 0; i < 2; ++i) { int c = tid + 512 * i; int row = c >> 4, ch = c & 15; vl_off[i] = (int)voff_b(row, ch); vsrc[i] = Vg + (size_t)row * 128 + ch * 8; }
  u32x4 sk1, sk2, sv0, sv1;
  sk1 = *(const u32x4*)k1src; sk2 = *(const u32x4*)k2src; sv0 = *(const u32x4*)vsrc[0]; sv1 = *(const u32x4*)vsrc[1];
  *(u32x4*)(lds + AL_STAGE + kl_off) = sk1; *(u32x4*)(lds + AL_STAGE + 8192 + kl_off) = sk2;
  *(u32x4*)(lds + AL_STAGE + 16384 + vl_off[0]) = sv0; *(u32x4*)(lds + AL_STAGE + 16384 + vl_off[1]) = sv1;
  __syncthreads();
  const int NKT = S / 64;
  const int i16 = lane & 15, tq = i16 >> 2, tp = i16 & 3, blk = (lane >> 4) & 1;
  for (int kt = 0; kt < NKT; ++kt) {
    const int st = AL_STAGE + (kt & 1) * 32768;
    if (kt + 1 < NKT) {
      const size_t ko = (size_t)(kt + 1) * 64 * 64, vo = (size_t)(kt + 1) * 64 * 128;
      sk1 = *(const u32x4*)(k1src + ko); sk2 = *(const u32x4*)(k2src + ko);
      sv0 = *(const u32x4*)(vsrc[0] + vo); sv1 = *(const u32x4*)(vsrc[1] + vo);
    }
    const unsigned char* Kl = lds + st + map * 8192;
    const unsigned char* Vl = lds + st + 16384;
#pragma unroll
    for (int sub = 0; sub < 2; ++sub) {
      const int kbase = kt * 64 + 32 * sub;
      const int qlo = q0 + wq * 32;
      const int dmin = kbase - (qlo + 31), dmax = kbase + 31 - qlo;
      f32x16 sT;
      if (dmin >= 559) {
#pragma unroll
        for (int r = 0; r < 16; ++r) sT[r] = cAfter;
      } else if (dmax <= -559) {
#pragma unroll
        for (int r = 0; r < 16; ++r) sT[r] = cBefore;
      } else {
        const int base = kbase + 4 * h - qpos + 640;
#pragma unroll
        for (int r = 0; r < 16; ++r) sT[r] = tab[base + (r & 3) + 8 * (r >> 2)];
      }
      const int row = 32 * sub + r32;
#pragma unroll
      for (int ks = 0; ks < 4; ++ks) {
        bf16x8 a = *(const bf16x8*)(Kl + row * 128 + (((2 * ks + h) ^ ((row >> 1) & 7)) << 4));
        sT = MFMA32(a, qf[ks], sT);
      }
      float ls = 0.f;
#pragma unroll
      for (int r = 0; r < 16; ++r) { sT[r] = __builtin_amdgcn_exp2f(sT[r]); ls += sT[r]; }
      l += ls;
      bf16x8 pb[2];
#pragma unroll
      for (int s2 = 0; s2 < 2; ++s2) {
        u32x4 pw; pw[0] = pk2(sT[8 * s2 + 0], sT[8 * s2 + 1]); pw[1] = pk2(sT[8 * s2 + 2], sT[8 * s2 + 3]);
        pw[2] = pk2(sT[8 * s2 + 4], sT[8 * s2 + 5]); pw[3] = pk2(sT[8 * s2 + 6], sT[8 * s2 + 7]);
        pb[s2] = __builtin_bit_cast(bf16x8, pw);
      }
#pragma unroll
      for (int nb = 0; nb < 4; ++nb)
#pragma unroll
        for (int s2 = 0; s2 < 2; ++s2) {
          const int R = 32 * sub + 16 * s2 + 4 * h + tq;
          const int ch = 4 * nb + 2 * blk + (tp >> 1);
          s16x4 lo = tr_read(Vl + voff_b(R, ch) + 8 * (tp & 1));
          s16x4 hi = tr_read(Vl + voff_b(R + 8, ch) + 8 * (tp & 1));
          O[nb] = MFMA32(cat8(lo, hi), pb[s2], O[nb]);
        }
    }
    if (kt + 1 < NKT) {
      const int nst = AL_STAGE + ((kt + 1) & 1) * 32768;
      *(u32x4*)(lds + nst + kl_off) = sk1; *(u32x4*)(lds + nst + 8192 + kl_off) = sk2;
      *(u32x4*)(lds + nst + 16384 + vl_off[0]) = sv0; *(u32x4*)(lds + nst + 16384 + vl_off[1]) = sv1;
    }
    __syncthreads();
  }
  float ltot = l + __shfl_xor(l, 32);
  float* xbuf = (float*)(lds + AL_STAGE);
  if (map == 1) {
    const float inv = 1.0f / ltot;
#pragma unroll
    for (int nb = 0; nb < 4; ++nb)
#pragma unroll
      for (int r = 0; r < 16; ++r) xbuf[((wq * 64 + nb * 16 + r) << 6) + lane] = O[nb][r] * inv;
  }
  __syncthreads();
  if (map == 0) {
    const float inv = 1.0f / ltot;
    float ss = 0.f;
#pragma unroll
    for (int nb = 0; nb < 4; ++nb)
#pragma unroll
      for (int r = 0; r < 16; ++r) {
        float o = O[nb][r] * inv - lam * xbuf[((wq * 64 + nb * 16 + r) << 6) + lane];
        O[nb][r] = o; ss += o * o;
      }
    ss += __shfl_xor(ss, 32);
    const float rn = __builtin_amdgcn_rsqf(ss * (1.0f / 128.0f) + NORM_EPS) * 0.8f;
    u16* mix = (u16*)((unsigned char*)p.out + OUT_MIX) + (size_t)(seq_start + qpos) * 1024 + 512 + hd * 128;
#pragma unroll
    for (int nb = 0; nb < 4; ++nb)
#pragma unroll
      for (int g4 = 0; g4 < 4; ++g4) {
        const int d0 = 32 * nb + 8 * g4 + 4 * h;
        f32x4 gg = *(const f32x4*)(p.diff_norm_g + d0);
        u32x2 o; o[0] = pk2(O[nb][4 * g4 + 0] * rn * gg[0], O[nb][4 * g4 + 1] * rn * gg[1]);
        o[1] = pk2(O[nb][4 * g4 + 2] * rn * gg[2], O[nb][4 * g4 + 3] * rn * gg[3]);
        *(u32x2*)(mix + d0) = o;
      }
  }
  __syncthreads();
}

DI void dilated_item(const Params& p, unsigned char* lds, int seq_start, int S, int hd, int c, int mblk) {
  const int tid = threadIdx.x, lane = tid & 63, r32 = lane & 31, h = lane >> 5;
  const int w = __builtin_amdgcn_readfirstlane(tid >> 6);
  const u16* QAp = (const u16*)(p.ws + WS_R + 0 * R_REGION);
  const u16* KAp = (const u16*)(p.ws + WS_R + 1 * R_REGION);
  const u16* VAp = (const u16*)(p.ws + WS_R + 2 * R_REGION);
  const int qpos = c + 16 * (32 * mblk + r32);
  const u16* Qp = QAp + (size_t)seq_start * 512 + ((size_t)hd * S + qpos) * 64;
  bf16x8 qf[4];
#pragma unroll
  for (int ks = 0; ks < 4; ++ks) qf[ks] = *(const bf16x8*)(Qp + ks * 16 + h * 8);
  const u16* Kg = KAp + (size_t)seq_start * 512 + ((size_t)hd * S) * 64;
  const u16* Vg = VAp + (size_t)seq_start * 512 + ((size_t)hd * S) * 64;
  unsigned char* vt = lds + AL_VT + w * 4096;
  const float* tabA = (const float*)(lds + AL_TABA) + hd * 3 * 132;
  f32x16 O[2];
#pragma unroll
  for (int nb = 0; nb < 2; ++nb)
#pragma unroll
    for (int r = 0; r < 16; ++r) O[nb][r] = 0.f;
  float l = 0.f;
  const int i16 = lane & 15, tq = i16 >> 2, tp = i16 & 3, blk = (lane >> 4) & 1;
  const int wsw = (((r32 >> 1) & 1) << 2) ^ ((r32 >> 2) & 3);
  for (int tau = 0; tau < 33; ++tau) {
    int d, br, tt;
    if (tau < 5) { d = 16; br = 0; tt = tau; } else if (tau < 13) { d = 4; br = 1; tt = tau - 5; } else { d = 1; br = 2; tt = tau - 13; }
    const int ratio = 16 / d;
    const int n0 = ratio * 32 * mblk - 64 + 32 * tt;
    const int kfirst = c + d * n0, klast = c + d * (n0 + 31);
    if (klast < 0 || kfirst >= S) continue;
    int kpos = c + d * (n0 + r32);
    kpos = kpos < 0 ? 0 : (kpos >= S ? S - 1 : kpos);
    bf16x8 kf[4]; u32x4 vc[4];
#pragma unroll
    for (int ks = 0; ks < 4; ++ks) {
      kf[ks] = *(const bf16x8*)(Kg + (size_t)kpos * 64 + ks * 16 + h * 8);
      vc[ks] = *(const u32x4*)(Vg + (size_t)kpos * 64 + (2 * ks + h) * 8);
    }
#pragma unroll
    for (int ks = 0; ks < 4; ++ks) *(u32x4*)(vt + r32 * 128 + (((2 * ks + h) ^ wsw) << 4)) = vc[ks];
    const int nq = ratio * (32 * mblk + r32);
    const int base = n0 + 4 * h - nq;
    const float* tb = tabA + br * 132;
    f32x16 sT;
#pragma unroll
    for (int r = 0; r < 16; ++r) {
      int dl = base + (r & 3) + 8 * (r >> 2);
      dl = dl < -65 ? -65 : (dl > 65 ? 65 : dl);
      sT[r] = tb[dl + 65];
    }
    if (kfirst < 0 || klast >= S) {
#pragma unroll
      for (int r = 0; r < 16; ++r) { int kp = c + d * (n0 + crow(r, h)); if (kp < 0 || kp >= S) sT[r] = NEG_BIG; }
    }
#pragma unroll
    for (int ks = 0; ks < 4; ++ks) sT = MFMA32(kf[ks], qf[ks], sT);
    float ls = 0.f;
#pragma unroll
    for (int r = 0; r < 16; ++r) { sT[r] = __builtin_amdgcn_exp2f(sT[r]); ls += sT[r]; }
    l += ls;
    bf16x8 pb[2];
#pragma unroll
    for (int s2 = 0; s2 < 2; ++s2) {
      u32x4 pw; pw[0] = pk2(sT[8 * s2 + 0], sT[8 * s2 + 1]); pw[1] = pk2(sT[8 * s2 + 2], sT[8 * s2 + 3]);
      pw[2] = pk2(sT[8 * s2 + 4], sT[8 * s2 + 5]); pw[3] = pk2(sT[8 * s2 + 6], sT[8 * s2 + 7]);
      pb[s2] = __builtin_bit_cast(bf16x8, pw);
    }
#pragma unroll
    for (int nb = 0; nb < 2; ++nb)
#pragma unroll
      for (int s2 = 0; s2 < 2; ++s2) {
        const int R = 16 * s2 + 4 * h + tq;
        const int ch = 4 * nb + 2 * blk + (tp >> 1);
        const int sw0 = (((R >> 1) & 1) << 2) ^ ((R >> 2) & 3);
        const int sw1 = ((((R + 8) >> 1) & 1) << 2) ^ (((R + 8) >> 2) & 3);
        s16x4 lo = tr_read(vt + R * 128 + ((ch ^ sw0) << 4) + 8 * (tp & 1));
        s16x4 hi = tr_read(vt + (R + 8) * 128 + ((ch ^ sw1) << 4) + 8 * (tp & 1));
        O[nb] = MFMA32(cat8(lo, hi), pb[s2], O[nb]);
      }
  }
  const float ltot = l + __shfl_xor(l, 32);
  const float inv = 1.0f / ltot;
  u16* mix = (u16*)((unsigned char*)p.out + OUT_MIX) + (size_t)(seq_start + qpos) * 1024 + hd * 64;
#pragma unroll
  for (int nb = 0; nb < 2; ++nb)
#pragma unroll
    for (int g4 = 0; g4 < 4; ++g4) {
      const int d0 = 32 * nb + 8 * g4 + 4 * h;
      u32x2 o; o[0] = pk2(O[nb][4 * g4 + 0] * inv, O[nb][4 * g4 + 1] * inv); o[1] = pk2(O[nb][4 * g4 + 2] * inv, O[nb][4 * g4 + 3] * inv);
      *(u32x2*)(mix + d0) = o;
    }
}

DI void phase_attn(const Params& p, unsigned char* lds) {
  const int tid = threadIdx.x;
  float* misc = (float*)(lds + AL_MISC);
  if (tid == 0) {
    float gqa = 0.f, gka = 0.f, gqb = 0.f, gkb = 0.f, bm = 0.f;
    for (int i = 0; i < 64; ++i) { gqa = fmaxf(gqa, fabsf(p.q_norm_a[i])); gka = fmaxf(gka, fabsf(p.k_norm_a[i])); gqb = fmaxf(gqb, fabsf(p.q_norm_b[i])); gkb = fmaxf(gkb, fabsf(p.k_norm_b[i])); }
    for (int i = 0; i < 32 * 12; ++i) bm = fmaxf(bm, fabsf(p.rel_bias[i]));
    const float M2 = 8.0f * LOG2E * fmaxf(gqa * gka, gqb * gkb) * 1.02f + bm * LOG2E + 0.1f;
    float s1 = 0.f, s2 = 0.f;
    for (int i = 0; i < 64; ++i) { s1 += p.lq1[i] * p.lk1[i]; s2 += p.lq2[i] * p.lk2[i]; }
    misc[0] = M2; misc[1] = expf(s1) - expf(s2) + 0.2f;
    for (int hd = 0; hd < 4; ++hd) { misc[8 + hd] = p.rel_bias[15 * 12 + 8 + hd] * LOG2E - M2; misc[12 + hd] = p.rel_bias[31 * 12 + 8 + hd] * LOG2E - M2; }
  }
  __syncthreads();
  const float M2 = misc[0], lam = misc[1];
  {
    float* tabA = (float*)(lds + AL_TABA);
    for (int i = tid; i < 8 * 3 * 132; i += NTHR) {
      int hd = i / 396, rem = i % 396, br = rem / 132, idx = rem % 132;
      int dl = idx - 65; float v = NEG_BIG;
      if (dl >= -64 && dl <= 64 && idx < 131) { int d = (br == 0) ? 16 : (br == 1) ? 4 : 1; v = p.rel_bias[rel_bucket(dl * d) * 12 + hd] * LOG2E - M2; }
      tabA[i] = v;
    }
  }
  int cur_hd = -1;
  for (int it = blockIdx.x; it < 1024; it += gridDim.x) {
#pragma unroll 1
    for (int half = 0; half < 2; ++half) {
      int seq_start, S, hd, q0;
      if (half == 0) { int up = it; int seq = up >> 7; hd = (up >> 5) & 3; q0 = (up & 31) * 128; S = 4096; seq_start = seq * 4096; }
      else { int us = it; int seq = us >> 6; hd = (us >> 4) & 3; q0 = (us & 15) * 128; S = 2048; seq_start = T_PROMPT + seq * 2048; }
      if (hd != cur_hd) {
        __syncthreads();
        float* tab = (float*)(lds + AL_TAB);
        for (int i = tid; i < 1281; i += NTHR) tab[i] = p.rel_bias[rel_bucket(i - 640) * 12 + 8 + hd] * LOG2E - M2;
        cur_hd = hd;
        __syncthreads();
      }
      diff_unit(p, lds, seq_start, S, hd, q0, lam);
    }
  }
  __syncthreads();
  const int w = tid >> 6;
  for (int it = blockIdx.x * 8 + w; it < 16384; it += gridDim.x * 8) {
    int seq_start, S, hd, c, mblk;
    if (it < 8192) { int seq = it >> 10; hd = (it >> 7) & 7; c = (it >> 3) & 15; mblk = it & 7; S = 4096; seq_start = seq * 4096; }
    else { int j = it - 8192; int seq = j >> 9; hd = (j >> 6) & 7; c = (j >> 2) & 15; mblk = j & 3; S = 2048; seq_start = T_PROMPT + seq * 2048; }
    dilated_item(p, lds, seq_start, S, hd, c, mblk);
  }
}

struct EpiOut {
  static constexpr bool PERM = false, AFTER_DRAIN = false, HEADPERM = false;
  const float* xp; const float* xs; float* x1;
  __device__ __forceinline__ void operator()(const pg8::f32x4 (&acc)[2][2][4][2], const pg8::Unit& u, int wr, int wc, int fr, int fq) const {
    const int col0 = u.pn * 256 + wc * 32 + 4 * fq;
#pragma unroll
    for (int ai = 0; ai < 2; ++ai)
#pragma unroll
      for (int m = 0; m < 4; ++m) {
        const int t = u.pm * 256 + ai * 128 + wr * 64 + m * 16 + fr;
        const float* xr = ((t < T_PROMPT) ? xp + (size_t)t * DM : xs + (size_t)(t - T_PROMPT) * DM) + col0;
        float* orow = x1 + (size_t)t * DM + col0;
#pragma unroll
        for (int bj = 0; bj < 2; ++bj)
#pragma unroll
          for (int n = 0; n < 2; ++n) {
            const f32x4 xv = *(const f32x4*)(xr + bj * 128 + n * 16);
            *(f32x4*)(orow + bj * 128 + n * 16) = xv + acc[ai][bj][m][n];
          }
      }
  }
};

DI void phase_outproj(const Params& p, unsigned char* lds) {
  pg8::Gemm g{(const u16*)((const unsigned char*)p.out + OUT_MIX), (const u16*)(p.ws + WS_WOUT), T_TOK, 1024, 1024};
  pg8::StaticOrder S; S.init(T_TOK, 1024, (int)gridDim.x, (int)blockIdx.x);
  EpiOut E{p.x_prompt, p.x_sample, (float*)(p.ws + WS_X1)};
  pg8::gemm_phase<EpiOut, pg8::StaticOrder, true, true>((PG8_LAS unsigned char*)lds, g, S, E);
}

DI void phase_norm2(const Params& p) {
  const int tid = threadIdx.x, lane = tid & 63, w = tid >> 6;
  const float* x1 = (const float*)(p.ws + WS_X1);
  u16* hb = (u16*)(p.ws + WS_H);
  for (int it = blockIdx.x; it < T_TOK / 8; it += gridDim.x) {
    int t = it * 8 + w;
    norm_row(x1 + (size_t)t * DM, p.ffn_norm_g, hb + (size_t)t * DM, lane);
  }
}

DI void phase_peer_query(const Params& p, unsigned char* lds) {
  const u16* Wq = (const u16*)(p.ws + WS_WQ);
  const u16* Hb = (const u16*)(p.ws + WS_H);
  const u16* SK = (const u16*)(p.ws + WS_SK);
  float* tv = (float*)((unsigned char*)p.out + OUT_TV);
  unsigned char* ti = (unsigned char*)p.out + OUT_TI;
  const int tid = threadIdx.x, lane = tid & 63, r32 = lane & 31, h = lane >> 5;
  const int w = __builtin_amdgcn_readfirstlane(tid >> 6);
  const int wr = w >> 2, wc = w & 3;
  for (int tile = blockIdx.x; tile < 256 * 16; tile += gridDim.x) {
    const int mb = tile >> 4, c16 = tile & 15;
    const int p0 = c16 * 128, q0 = mb * 256;
    const int z = c16 & 1;
    f32x16 acc[2][2];
    gemm_mainloop<128, 256>(Wq, Hb, 1024, p0, q0, lds, acc);
    unsigned char* QPl = lds;
    unsigned char* SKl = lds + 65536;
#pragma unroll
    for (int j = 0; j < 2; ++j) {
      const int m = wc * 64 + j * 32 + r32;
#pragma unroll
      for (int i = 0; i < 2; ++i)
#pragma unroll
        for (int g4 = 0; g4 < 4; ++g4) {
          const int nl = wr * 64 + i * 32 + 8 * g4 + 4 * h;
          u32x2 o; o[0] = pk2(acc[i][j][4 * g4 + 0], acc[i][j][4 * g4 + 1]); o[1] = pk2(acc[i][j][4 * g4 + 2], acc[i][j][4 * g4 + 3]);
          *(u32x2*)(QPl + m * 256 + (((nl >> 3) ^ (m & 15)) << 4) + (nl & 7) * 2) = o;
        }
    }
#pragma unroll
    for (int i = 0; i < 4; ++i) {
      int c = tid + 512 * i; int row = c >> 4, ch = c & 15;
      u32x4 v = *(const u32x4*)(SK + (size_t)z * 16384 + row * 128 + ch * 8);
      *(u32x4*)(SKl + row * 256 + ((ch ^ (row & 15)) << 4)) = v;
    }
    __syncthreads();
    f32x16 S2[4];
#pragma unroll
    for (int kb = 0; kb < 4; ++kb)
#pragma unroll
      for (int r = 0; r < 16; ++r) S2[kb][r] = 0.f;
    const int m = w * 32 + r32;
#pragma unroll
    for (int ks = 0; ks < 8; ++ks) {
      bf16x8 b = *(const bf16x8*)(QPl + m * 256 + (((2 * ks + h) ^ (m & 15)) << 4));
#pragma unroll
      for (int kb = 0; kb < 4; ++kb) {
        const int key = kb * 32 + r32;
        bf16x8 a = *(const bf16x8*)(SKl + key * 256 + (((2 * ks + h) ^ (key & 15)) << 4));
        S2[kb] = MFMA32(a, b, S2[kb]);
      }
    }
    {
      const size_t o = ((size_t)(q0 + m) * 16 + c16) * 16;
#pragma unroll 1
      for (int rd = 0; rd < 16; ++rd) {
        float best = -3.0e38f; int be = 0;
#pragma unroll
        for (int e = 0; e < 64; ++e) { const float v = S2[e >> 4][e & 15]; if (v > best) { best = v; be = e; } }
        const int bkey = 32 * (be >> 4) + (be & 3) + 8 * ((be & 15) >> 2) + 4 * h;
        const float pbest = __shfl_xor(best, 32); const int pkey = __shfl_xor(bkey, 32);
        const bool mine = (best > pbest) || (best == pbest && bkey < pkey);
        const float wv = mine ? best : pbest; const int wk = mine ? bkey : pkey;
        const int kill = mine ? be : -1;
#pragma unroll
        for (int e = 0; e < 64; ++e) { if (e == kill) S2[e >> 4][e & 15] = -3.0e38f; }
        if (h == 0) { tv[o + rd] = wv; ti[o + rd] = (unsigned char)wk; }
      }
    }
    __syncthreads();
  }
}

DI void phase_peer_combine(const Params& p, unsigned char* lds) {
  const float* tv = (const float*)((const unsigned char*)p.out + OUT_TV);
  const unsigned char* ti = (const unsigned char*)p.out + OUT_TI;
  u16* eidx = (u16*)(p.ws + WS_EIDX);
  float* gg = (float*)(p.ws + WS_G);
  const int tid = threadIdx.x;
  float* v2l = (float*)lds;
  int* i1l = (int*)(lds + 32768);
  int* i2l = (int*)(lds + 65536);
  for (int it = blockIdx.x; it < (T_TOK * 8) / NTHR; it += gridDim.x) {
    const int gid = it * NTHR + tid;
    const size_t o1 = ((size_t)gid * 2) * 16, o2 = o1 + 16;
    float v1[16];
#pragma unroll
    for (int q4 = 0; q4 < 4; ++q4) {
      f32x4 a = *(const f32x4*)(tv + o1 + 4 * q4); v1[4 * q4] = a[0]; v1[4 * q4 + 1] = a[1]; v1[4 * q4 + 2] = a[2]; v1[4 * q4 + 3] = a[3];
      f32x4 b = *(const f32x4*)(tv + o2 + 4 * q4);
      v2l[(4 * q4 + 0) * 512 + tid] = b[0]; v2l[(4 * q4 + 1) * 512 + tid] = b[1]; v2l[(4 * q4 + 2) * 512 + tid] = b[2]; v2l[(4 * q4 + 3) * 512 + tid] = b[3];
    }
    {
      u32x4 a = *(const u32x4*)(ti + o1), b = *(const u32x4*)(ti + o2);
#pragma unroll
      for (int j = 0; j < 16; ++j) { i1l[j * 512 + tid] = (a[j >> 2] >> (8 * (j & 3))) & 255; i2l[j * 512 + tid] = (b[j >> 2] >> (8 * (j & 3))) & 255; }
    }
    unsigned long long pp = 0ull;
    float bestv[16]; int be[16];
#pragma unroll
    for (int rd = 0; rd < 16; ++rd) {
      float best = -3.0e38f; int ab = 0, bb = 0;
#pragma unroll
      for (int a = 0; a < 16; ++a) {
        const int b = (int)((pp >> (4 * a)) & 15ull);
        const float cnd = v1[a] + v2l[b * 512 + tid];
        if (cnd > best) { best = cnd; ab = a; bb = b; }
      }
      bestv[rd] = best; be[rd] = i1l[ab * 512 + tid] * 128 + i2l[bb * 512 + tid];
      pp += 1ull << (4 * ab);
    }
    float ex[16]; float sum = 0.f;
#pragma unroll
    for (int rd = 0; rd < 16; ++rd) { ex[rd] = __expf(bestv[rd] - bestv[0]); sum += ex[rd]; }
    const float inv = 1.0f / sum;
    const size_t oo = (size_t)gid * 16;
#pragma unroll
    for (int q4 = 0; q4 < 4; ++q4) { f32x4 v = {ex[4 * q4] * inv, ex[4 * q4 + 1] * inv, ex[4 * q4 + 2] * inv, ex[4 * q4 + 3] * inv}; *(f32x4*)(gg + oo + 4 * q4) = v; }
    u32x4 e0, e1;
#pragma unroll
    for (int j = 0; j < 4; ++j) { e0[j] = (unsigned)be[2 * j] | ((unsigned)be[2 * j + 1] << 16); e1[j] = (unsigned)be[8 + 2 * j] | ((unsigned)be[8 + 2 * j + 1] << 16); }
    *(u32x4*)(eidx + oo) = e0; *(u32x4*)(eidx + oo + 8) = e1;
  }
}

typedef float f2_t __attribute__((ext_vector_type(2)));
DI unsigned xcc_id() { return (unsigned)__builtin_amdgcn_s_getreg((3 << 11) | 20) & 7u; }
constexpr int PG_CHUNK_TOK = 64;
constexpr int PG_NCHUNK = T_TOK / PG_CHUNK_TOK;

DI void dec16(const u32x4& r, f2_t (&v)[8]) {
#pragma unroll
  for (int d = 0; d < 4; ++d) { v[2 * d] = __builtin_amdgcn_cvt_pk_f32_fp8((int)r[d], false); v[2 * d + 1] = __builtin_amdgcn_cvt_pk_f32_fp8((int)r[d], true); }
}

DI void peer_udot_token(const Params& p, int x, int t, int lane) {
  const unsigned char* U8 = p.ws + WS_U + (size_t)x * 16384 * 128;
  const u16* Hb = (const u16*)(p.ws + WS_H);
  const u16* eidx = (const u16*)(p.ws + WS_EIDX);
  float* zpart = (float*)p.out;
  const int r = lane >> 3, c = lane & 7;
  int e[16];
#pragma unroll
  for (int i = 0; i < 16; ++i) e[i] = eidx[(size_t)t * 128 + i * 8 + r];
  u32x4 ha = *(const u32x4*)(Hb + (size_t)t * DM + x * 128 + c * 16), hb = *(const u32x4*)(Hb + (size_t)t * DM + x * 128 + c * 16 + 8);
  u32x4 rows[16];
#pragma unroll
  for (int i = 0; i < 16; ++i) rows[i] = *(const u32x4*)(U8 + (size_t)e[i] * 128 + c * 16);
  f2_t hq[8];
#pragma unroll
  for (int j = 0; j < 4; ++j) {
    hq[j][0] = __uint_as_float(ha[j] << 16); hq[j][1] = __uint_as_float(ha[j] & 0xffff0000u);
    hq[4 + j][0] = __uint_as_float(hb[j] << 16); hq[4 + j][1] = __uint_as_float(hb[j] & 0xffff0000u);
  }
  float sv[16];
#pragma unroll
  for (int i = 0; i < 16; ++i) {
    f2_t v[8]; dec16(rows[i], v);
    f2_t a = v[0] * hq[0];
#pragma unroll
    for (int k = 1; k < 8; ++k) a = __builtin_elementwise_fma(v[k], hq[k], a);
    sv[i] = a[0] + a[1];
  }
#pragma unroll
  for (int o = 1; o < 8; o <<= 1) {
#pragma unroll
    for (int i = 0; i < 16; ++i) sv[i] += __shfl_xor(sv[i], o);
  }
  float o0 = 0.f, o1 = 0.f;
#pragma unroll
  for (int i = 0; i < 8; ++i) { if (c == i) { o0 = sv[i]; o1 = sv[i + 8]; } }
  float* zp = zpart + ((size_t)x * T_TOK + t) * 128;
  zp[c * 8 + r] = o0; zp[(c + 8) * 8 + r] = o1;
}

DI void peer_vacc_token(const Params& p, int x, int t, int lane) {
  const unsigned char* V8 = p.ws + WS_V + (size_t)x * 16384 * 128;
  const u16* eidx = (const u16*)(p.ws + WS_EIDX);
  const float* wg = (const float*)(p.ws + WS_G);
  const float* x1 = (const float*)(p.ws + WS_X1);
  const int r = lane >> 3, c = lane & 7;
  int e[16]; float wj[16];
#pragma unroll
  for (int i = 0; i < 16; ++i) { e[i] = eidx[(size_t)t * 128 + i * 8 + r]; wj[i] = wg[(size_t)t * 128 + i * 8 + r]; }
  u32x4 rows[16];
#pragma unroll
  for (int i = 0; i < 16; ++i) rows[i] = *(const u32x4*)(V8 + (size_t)e[i] * 128 + c * 16);
  f2_t acc[8];
#pragma unroll
  for (int k = 0; k < 8; ++k) { acc[k][0] = 0.f; acc[k][1] = 0.f; }
#pragma unroll
  for (int i = 0; i < 16; ++i) {
    f2_t v[8]; dec16(rows[i], v);
    f2_t ww = {wj[i], wj[i]};
#pragma unroll
    for (int k = 0; k < 8; ++k) acc[k] = __builtin_elementwise_fma(v[k], ww, acc[k]);
  }
  f2_t b4[4];
  {
    const bool up = (lane & 32) != 0;
#pragma unroll
    for (int k = 0; k < 4; ++k) {
      f2_t keep = up ? acc[4 + k] : acc[k], send = up ? acc[k] : acc[4 + k];
      f2_t got; got[0] = __shfl_xor(send[0], 32); got[1] = __shfl_xor(send[1], 32);
      b4[k] = keep + got;
    }
  }
  f2_t b2[2];
  {
    const bool up = (lane & 16) != 0;
#pragma unroll
    for (int k = 0; k < 2; ++k) {
      f2_t keep = up ? b4[2 + k] : b4[k], send = up ? b4[k] : b4[2 + k];
      f2_t got; got[0] = __shfl_xor(send[0], 16); got[1] = __shfl_xor(send[1], 16);
      b2[k] = keep + got;
    }
  }
  f2_t b1;
  {
    const bool up = (lane & 8) != 0;
    f2_t keep = up ? b2[1] : b2[0], send = up ? b2[0] : b2[1];
    f2_t got; got[0] = __shfl_xor(send[0], 8); got[1] = __shfl_xor(send[1], 8);
    b1 = keep + got;
  }
  const size_t o = (size_t)t * DM + x * 128 + c * 16 + 2 * r;
  f2_t xv = *(const f2_t*)(x1 + o);
  f2_t res = xv + b1;
  *(f2_t*)(p.out + o) = res;
}

template <int WHICH>
DI void phase_peer_sliced(const Params& p, unsigned char* lds) {
  const int tid = threadIdx.x, lane = tid & 63, w = tid >> 6;
  unsigned* qctr = (unsigned*)(p.ws + WS_MISC + MISC_QCTR) + WHICH * 8;
  int* bc = (int*)lds;
  const unsigned x0 = xcc_id();
  for (int si = 0; si < 8; ++si) {
    const int x = (int)((x0 + si) & 7u);
    for (;;) {
      __syncthreads();
      if (tid == 0) bc[0] = (int)atomicAdd(&qctr[x], 1u);
      __syncthreads();
      const int ch = bc[0];
      if (ch >= PG_NCHUNK) break;
      const int tb = ch * PG_CHUNK_TOK + w * 8;
#pragma unroll 1
      for (int k = 0; k < 8; ++k) {
        if (WHICH == 0) peer_udot_token(p, x, tb + k, lane); else peer_vacc_token(p, x, tb + k, lane);
      }
    }
  }
}

DI void phase_peer_act(const Params& p) {
  const float* zpart = (const float*)p.out;
  const u16* eidx = (const u16*)(p.ws + WS_EIDX);
  float* wg = (float*)(p.ws + WS_G);
  const float* suinv = (const float*)(p.ws + WS_MISC + MISC_SUINV);
  const float* svinv = (const float*)(p.ws + WS_MISC + MISC_SVINV);
  for (size_t i = (size_t)blockIdx.x * NTHR + threadIdx.x; i < (size_t)T_TOK * 128; i += (size_t)gridDim.x * NTHR) {
    float z = 0.f;
#pragma unroll
    for (int x = 0; x < 8; ++x) z += zpart[(size_t)x * T_TOK * 128 + i];
    const int e = eidx[i];
    z *= suinv[e];
    const float act = 0.5f * z * (1.0f + erff(z * 0.70710678118654752f));
    wg[i] = wg[i] * act * svinv[e];
  }
}

__global__ void __launch_bounds__(NTHR, 2) fwd_kernel(Params p) {
  extern __shared__ __attribute__((aligned(16))) unsigned char lds[];
  cg::grid_group grid = cg::this_grid();
#ifndef ONLY_PH
#define PHON(k) 1
#else
#define PHON(k) ((k) == ONLY_PH)
#endif
#ifndef REPEAT_MASK
#define REPEAT_MASK 0
#endif
#define RUN_PHASE(k, call) do { if (PHON(k) && lo <= (k) && (k) < hi) { call; if ((REPEAT_MASK >> (k)) & 1) { grid.sync(); call; } } if (lo <= (k) && (k) + 1 < hi) grid.sync(); } while (0)
  const int lo = p.ph_lo, hi = p.ph_hi;
  RUN_PHASE(0, phase_prep(p, lds));
  RUN_PHASE(1, phase_proj(p, lds));
  RUN_PHASE(2, phase_attn(p, lds));
  RUN_PHASE(3, phase_outproj(p, lds));
  RUN_PHASE(4, phase_norm2(p));
  RUN_PHASE(5, phase_peer_query(p, lds));
  RUN_PHASE(6, phase_peer_combine(p, lds));
  RUN_PHASE(7, phase_peer_sliced<0>(p, lds));
  RUN_PHASE(8, phase_peer_act(p));
  RUN_PHASE(9, phase_peer_sliced<1>(p, lds));
}

extern "C" void kernel_launch(void* const* d_in, const int* in_sizes, int n_in, void* d_out, int out_size, void* d_ws, size_t ws_size, hipStream_t stream) {
  static int grid_blocks = 0;
  if (grid_blocks == 0) {
    if (n_in != 20 || ws_size < WS_END || out_size != T_TOK * DM) {
      fprintf(stderr, "kernel_launch: unexpected problem shape (n_in %d, ws %zu, out %d)\n", n_in, ws_size, out_size);
      grid_blocks = -1; return;
    }
    int dev = 0, cus = 0, per_cu = 0;
    hipGetDevice(&dev);
    hipDeviceGetAttribute(&cus, hipDeviceAttributeMultiprocessorCount, dev);
    hipFuncSetAttribute((const void*)fwd_kernel, hipFuncAttributeMaxDynamicSharedMemorySize, LDS_BYTES);
    hipOccupancyMaxActiveBlocksPerMultiprocessor(&per_cu, (const void*)fwd_kernel, NTHR, LDS_BYTES);
    if (per_cu < 1) { fprintf(stderr, "kernel_launch: occupancy query says %d blocks/CU\n", per_cu); per_cu = 1; }
    grid_blocks = cus;
    (void)hipGetLastError();
  }
  if (grid_blocks < 0) return;
  Params p{};
  p.x_prompt = (const float*)d_in[0]; p.x_sample = (const float*)d_in[1]; p.rel_bias = (const float*)d_in[2]; p.attn_norm_g = (const float*)d_in[3];
  p.w_in = (const float*)d_in[4]; p.q_norm_a = (const float*)d_in[5]; p.k_norm_a = (const float*)d_in[6]; p.q_norm_b = (const float*)d_in[7];
  p.k_norm_b = (const float*)d_in[8]; p.lq1 = (const float*)d_in[9]; p.lk1 = (const float*)d_in[10]; p.lq2 = (const float*)d_in[11];
  p.lk2 = (const float*)d_in[12]; p.diff_norm_g = (const float*)d_in[13]; p.w_out = (const float*)d_in[14]; p.ffn_norm_g = (const float*)d_in[15];
  p.peer_w_q = (const float*)d_in[16]; p.peer_sub_keys = (const float*)d_in[17]; p.peer_u = (const float*)d_in[18]; p.peer_v = (const float*)d_in[19];
  p.out = (float*)d_out; p.ws = (unsigned char*)d_ws;
#if FUSED
  p.ph_lo = 0; p.ph_hi = NPHASE;
  void* args[] = {&p};
  hipError_t e = hipLaunchCooperativeKernel((const void*)fwd_kernel, dim3(grid_blocks), dim3(NTHR), args, LDS_BYTES, stream);
  if (e != hipSuccess) fprintf(stderr, "cooperative launch failed: %s (grid %d)\n", hipGetErrorString(e), grid_blocks);
#else
  for (int ph = 0; ph < NPHASE; ++ph) {
    p.ph_lo = ph; p.ph_hi = ph + 1;
    hipLaunchKernelGGL(fwd_kernel, dim3(grid_blocks), dim3(NTHR), LDS_BYTES, stream, p);
  }
#endif
}
```

```cpp
#include <hip/hip_runtime.h>
#include <hip/hip_cooperative_groups.h>
#include <cstdio>
#include <cstdint>
namespace cg = cooperative_groups;

#ifndef FUSED
#define FUSED 1
#endif

typedef unsigned short u16;
typedef __attribute__((ext_vector_type(8))) short bf16x8;
typedef __attribute__((ext_vector_type(4))) short s16x4;
typedef __attribute__((ext_vector_type(16))) float f32x16;
typedef __attribute__((ext_vector_type(4))) float f32x4;
typedef __attribute__((ext_vector_type(4))) unsigned u32x4;
typedef __attribute__((ext_vector_type(2))) unsigned u32x2;
typedef __attribute__((address_space(3))) unsigned char* ldsp_t;

#define DI __device__ __forceinline__
#define MFMA32(a, b, c) __builtin_amdgcn_mfma_f32_32x32x16_bf16((a), (b), (c), 0, 0, 0)

constexpr int DM = 1024;
constexpr int T_TOK = 65536;
constexpr int T_PROMPT = 32768;
constexpr int NTHR = 512;
constexpr int NPHASE = 10;
constexpr float NORM_EPS = 1e-6f;
constexpr float LOG2E = 1.4426950408889634f;
constexpr float C2 = 0.125f * LOG2E;
constexpr float NEG_BIG = -1.0e30f;

constexpr size_t WS_WIN  = 0;
constexpr size_t WS_WOUT = WS_WIN + (size_t)3072 * 1024 * 2;
constexpr size_t WS_WQ   = WS_WOUT + (size_t)1024 * 1024 * 2;
constexpr size_t WS_SK   = WS_WQ + (size_t)2048 * 1024 * 2;
constexpr size_t WS_U    = WS_SK + (size_t)2 * 128 * 128 * 2;
constexpr size_t WS_V    = WS_U + (size_t)16384 * 1024 * 2;
constexpr size_t WS_MISC = WS_V + (size_t)16384 * 1024 * 2;
constexpr size_t MISC_SUINV = 0, MISC_SVINV = 65536, MISC_QCTR = 131072;
constexpr size_t WS_R    = WS_MISC + (size_t)1048576;
constexpr size_t R_REGION = (size_t)T_TOK * 512 * 2;
constexpr size_t WS_X1   = WS_R;
constexpr size_t WS_H    = WS_R + (size_t)T_TOK * 1024 * 4;
constexpr size_t WS_EIDX = WS_R + 6 * R_REGION;
constexpr size_t WS_G    = WS_EIDX + (size_t)T_TOK * 128 * 2;
constexpr size_t WS_END  = WS_G + (size_t)T_TOK * 128 * 4;
static_assert(WS_END <= (size_t)536870912, "workspace map exceeds 512 MiB");
constexpr size_t OUT_N1 = 0, OUT_MIX = 134217728, OUT_TV = 0, OUT_TI = 67108864;

constexpr int LDS_BYTES = 131072;

struct Params {
  const float* x_prompt; const float* x_sample; const float* rel_bias; const float* attn_norm_g; const float* w_in;
  const float* q_norm_a; const float* k_norm_a; const float* q_norm_b; const float* k_norm_b;
  const float* lq1; const float* lk1; const float* lq2; const float* lk2; const float* diff_norm_g; const float* w_out;
  const float* ffn_norm_g; const float* peer_w_q; const float* peer_sub_keys; const float* peer_u; const float* peer_v;
  float* out; unsigned char* ws; int ph_lo; int ph_hi;
};

DI u16 f2bf(float f) { unsigned u = __float_as_uint(f); u += 0x7fffu + ((u >> 16) & 1u); return (u16)(u >> 16); }
DI float bf2f(u16 b) { return __uint_as_float(((unsigned)b) << 16); }
DI unsigned pk2(float lo, float hi) {
  typedef float f2_t __attribute__((ext_vector_type(2)));
  typedef __bf16 b2_t __attribute__((ext_vector_type(2)));
  f2_t v = {lo, hi}; b2_t b = __builtin_convertvector(v, b2_t); return __builtin_bit_cast(unsigned, b);
}
DI int crow(int reg, int h) { return (reg & 3) + 8 * (reg >> 2) + 4 * h; }
DI float wave_sum(float v) {
#pragma unroll
  for (int o = 32; o > 0; o >>= 1) v += __shfl_xor(v, o);
  return v;
}
DI void seq_of(int t, int& seq_start, int& S, int& s) {
  if (t < T_PROMPT) { S = 4096; seq_start = t & ~4095; s = t & 4095; }
  else { S = 2048; seq_start = t & ~2047; s = t & 2047; }
}
DI const float* x_row(const Params& p, int t) {
  return (t < T_PROMPT) ? p.x_prompt + (size_t)t * DM : p.x_sample + (size_t)(t - T_PROMPT) * DM;
}
DI int rel_bucket(int rel) {
  int n = rel < 0 ? -rel : rel;
  int b;
  if (n < 8) b = n;
  else if (n < 15) b = 8; else if (n < 27) b = 9; else if (n < 50) b = 10; else if (n < 91) b = 11;
  else if (n < 166) b = 12; else if (n < 305) b = 13; else if (n < 559) b = 14; else b = 15;
  return (rel > 0 ? 16 : 0) + b;
}
DI s16x4 tr_read(const unsigned char* p) {
  typedef short v4i16_t __attribute__((ext_vector_type(4)));
  return __builtin_bit_cast(s16x4, __builtin_amdgcn_ds_read_tr16_b64_v4i16((__attribute__((address_space(3))) v4i16_t*)p));
}
DI bf16x8 cat8(s16x4 lo, s16x4 hi) { return __builtin_shufflevector(lo, hi, 0, 1, 2, 3, 4, 5, 6, 7); }

DI void transpose_item(const float* __restrict__ src, int K, int N, u16* __restrict__ dst, int k0, int n0, unsigned char* lds) {
  float* tile = (float*)lds;
  const int tid = threadIdx.x;
#pragma unroll
  for (int i = 0; i < 8; ++i) {
    int idx = tid + 512 * i; int r = idx >> 6, c = idx & 63;
    tile[r * 65 + c] = src[(size_t)(k0 + r) * N + n0 + c];
  }
  __syncthreads();
  {
    int n = tid >> 3, kc = tid & 7;
    u32x4 o;
    o[0] = pk2(tile[(kc * 8 + 0) * 65 + n], tile[(kc * 8 + 1) * 65 + n]);
    o[1] = pk2(tile[(kc * 8 + 2) * 65 + n], tile[(kc * 8 + 3) * 65 + n]);
    o[2] = pk2(tile[(kc * 8 + 4) * 65 + n], tile[(kc * 8 + 5) * 65 + n]);
    o[3] = pk2(tile[(kc * 8 + 6) * 65 + n], tile[(kc * 8 + 7) * 65 + n]);
    *(u32x4*)(dst + (size_t)(n0 + n) * K + k0 + kc * 8) = o;
  }
  __syncthreads();
}

DI void convert_item(const float* __restrict__ src, u16* __restrict__ dst, size_t base) {
  size_t i = base + (size_t)threadIdx.x * 8;
  f32x4 a = *(const f32x4*)(src + i), b = *(const f32x4*)(src + i + 4);
  u32x4 o; o[0] = pk2(a[0], a[1]); o[1] = pk2(a[2], a[3]); o[2] = pk2(b[0], b[1]); o[3] = pk2(b[2], b[3]);
  *(u32x4*)(dst + i) = o;
}

DI void norm_row(const float* __restrict__ xr, const float* __restrict__ g, u16* __restrict__ orow, int lane) {
  f32x4 v[4]; float ss = 0.f;
#pragma unroll
  for (int i = 0; i < 4; ++i) { v[i] = *(const f32x4*)(xr + lane * 4 + 256 * i); ss += v[i][0] * v[i][0] + v[i][1] * v[i][1] + v[i][2] * v[i][2] + v[i][3] * v[i][3]; }
  ss = wave_sum(ss);
  const float r = __builtin_amdgcn_rsqf(ss * (1.0f / 1024.0f) + NORM_EPS);
#pragma unroll
  for (int i = 0; i < 4; ++i) {
    f32x4 gg = *(const f32x4*)(g + lane * 4 + 256 * i);
    u32x2 o; o[0] = pk2(v[i][0] * r * gg[0], v[i][1] * r * gg[1]); o[1] = pk2(v[i][2] * r * gg[2], v[i][3] * r * gg[3]);
    *(u32x2*)(orow + lane * 4 + 256 * i) = o;
  }
}

DI void phase_prep(const Params& p, unsigned char* lds) {
  const int nb = gridDim.x, bid = blockIdx.x, tid = threadIdx.x;
  u16* wsb = (u16*)p.ws;
  for (int it = bid; it < 768 + 256 + 512; it += nb) {
    if (it < 768) { int kt = it / 48, nt = it % 48; transpose_item(p.w_in, 1024, 3072, (u16*)(p.ws + WS_WIN), kt * 64, nt * 64, lds); }
    else if (it < 1024) { int j = it - 768; int kt = j / 16, nt = j % 16; transpose_item(p.w_out, 1024, 1024, (u16*)(p.ws + WS_WOUT), kt * 64, nt * 64, lds); }
    else { int j = it - 1024; int kt = j / 32, nt = j % 32; transpose_item(p.peer_w_q, 1024, 2048, (u16*)(p.ws + WS_WQ), kt * 64, nt * 64, lds); }
  }
  for (int it = bid; it < 8; it += nb) convert_item(p.peer_sub_keys, (u16*)(p.ws + WS_SK), (size_t)it * 4096);
  if (bid == 0 && tid < 64) ((unsigned*)(p.ws + WS_MISC + MISC_QCTR))[tid] = 0u;
  {
    const int lane_ = tid & 63, w_ = tid >> 6;
    for (int it = bid; it < 2 * 16384 / 8; it += nb) {
      const int row = it * 8 + w_;
      const int tbl = row >> 14, e = row & 16383;
      const float* src = (tbl ? p.peer_v : p.peer_u) + (size_t)e * DM + lane_ * 16;
      f32x4 a0 = *(const f32x4*)(src), a1 = *(const f32x4*)(src + 4), a2 = *(const f32x4*)(src + 8), a3 = *(const f32x4*)(src + 12);
      float am = 0.f;
#pragma unroll
      for (int j = 0; j < 4; ++j) am = fmaxf(am, fmaxf(fmaxf(fabsf(a0[j]), fabsf(a1[j])), fmaxf(fabsf(a2[j]), fabsf(a3[j]))));
#pragma unroll
      for (int o = 32; o > 0; o >>= 1) am = fmaxf(am, __shfl_xor(am, o));
      const int ex = (int)((__float_as_uint(am) >> 23) & 255u);
      float sc = 1.0f, isc = 1.0f;
      if (ex > 8 && ex < 250) { sc = __uint_as_float((unsigned)(261 - ex) << 23); isc = __uint_as_float((unsigned)(ex - 7) << 23); }
      u32x4 o;
      { int pk = __builtin_amdgcn_cvt_pk_fp8_f32(a0[0] * sc, a0[1] * sc, 0, false); pk = __builtin_amdgcn_cvt_pk_fp8_f32(a0[2] * sc, a0[3] * sc, pk, true); o[0] = (unsigned)pk; }
      { int pk = __builtin_amdgcn_cvt_pk_fp8_f32(a1[0] * sc, a1[1] * sc, 0, false); pk = __builtin_amdgcn_cvt_pk_fp8_f32(a1[2] * sc, a1[3] * sc, pk, true); o[1] = (unsigned)pk; }
      { int pk = __builtin_amdgcn_cvt_pk_fp8_f32(a2[0] * sc, a2[1] * sc, 0, false); pk = __builtin_amdgcn_cvt_pk_fp8_f32(a2[2] * sc, a2[3] * sc, pk, true); o[2] = (unsigned)pk; }
      { int pk = __builtin_amdgcn_cvt_pk_fp8_f32(a3[0] * sc, a3[1] * sc, 0, false); pk = __builtin_amdgcn_cvt_pk_fp8_f32(a3[2] * sc, a3[3] * sc, pk, true); o[3] = (unsigned)pk; }
      unsigned char* dst = p.ws + (tbl ? WS_V : WS_U) + ((size_t)(lane_ >> 3) * 16384 + e) * 128 + (lane_ & 7) * 16;
      *(u32x4*)dst = o;
      if (lane_ == 0) ((float*)(p.ws + WS_MISC + (tbl ? MISC_SVINV : MISC_SUINV)))[e] = isc;
    }
  }
  const int lane = tid & 63, w = tid >> 6;
  u16* n1 = (u16*)((unsigned char*)p.out + OUT_N1);
  for (int it = bid; it < T_TOK / 8; it += nb) {
    int t = it * 8 + w;
    norm_row(x_row(p, t), p.attn_norm_g, n1 + (size_t)t * DM, lane);
  }
  (void)wsb;
}

template <int PR, int QR>
DI void gemm_mainloop(const u16* __restrict__ P, const u16* __restrict__ Q, int K, int p0, int q0, unsigned char* lds, f32x16 (&acc)[2][2]) {
  static_assert(PR + QR == 384, "tile");
  constexpr int STAGE = 384 * 128;
  constexpr int WC = QR / 64;
  const int tid = threadIdx.x, lane = tid & 63, r32 = lane & 31, h = lane >> 5;
  const int w = __builtin_amdgcn_readfirstlane(tid >> 6);
  const int wr = w / WC, wc = w % WC;
#pragma unroll
  for (int i = 0; i < 2; ++i)
#pragma unroll
    for (int j = 0; j < 2; ++j)
#pragma unroll
      for (int r = 0; r < 16; ++r) acc[i][j][r] = 0.f;
  u32x4 stg[6];
  const u16* src[6]; int loff[6];
#pragma unroll
  for (int i = 0; i < 6; ++i) {
    int c = tid + 512 * i; int row = c >> 3, kc = c & 7;
    src[i] = (row < PR) ? P + (size_t)(p0 + row) * K + kc * 8 : Q + (size_t)(q0 + row - PR) * K + kc * 8;
    loff[i] = row * 128 + ((kc ^ ((row >> 1) & 7)) << 4);
  }
  const int KT = K / 64;
#pragma unroll
  for (int i = 0; i < 6; ++i) stg[i] = *(const u32x4*)(src[i]);
#pragma unroll
  for (int i = 0; i < 6; ++i) *(u32x4*)(lds + loff[i]) = stg[i];
  __syncthreads();
  int aoff[2], boff[2], asw[2], bsw[2];
#pragma unroll
  for (int i = 0; i < 2; ++i) {
    int ra = wr * 64 + i * 32 + r32; aoff[i] = ra * 128; asw[i] = (ra >> 1) & 7;
    int rb = PR + wc * 64 + i * 32 + r32; boff[i] = rb * 128; bsw[i] = (rb >> 1) & 7;
  }
  for (int kt = 0; kt < KT; ++kt) {
    const int buf = (kt & 1) * STAGE;
    if (kt + 1 < KT) {
#pragma unroll
      for (int i = 0; i < 6; ++i) stg[i] = *(const u32x4*)(src[i] + (kt + 1) * 64);
    }
#pragma unroll
    for (int ks = 0; ks < 4; ++ks) {
      bf16x8 a[2], b[2];
#pragma unroll
      for (int i = 0; i < 2; ++i) {
        a[i] = *(const bf16x8*)(lds + buf + aoff[i] + (((2 * ks + h) ^ asw[i]) << 4));
        b[i] = *(const bf16x8*)(lds + buf + boff[i] + (((2 * ks + h) ^ bsw[i]) << 4));
      }
#pragma unroll
      for (int i = 0; i < 2; ++i)
#pragma unroll
        for (int j = 0; j < 2; ++j) acc[i][j] = MFMA32(a[i], b[j], acc[i][j]);
    }
    if (kt + 1 < KT) {
      const int nbuf = ((kt + 1) & 1) * STAGE;
#pragma unroll
      for (int i = 0; i < 6; ++i) *(u32x4*)(lds + nbuf + loff[i]) = stg[i];
    }
    __syncthreads();
  }
}

namespace pg8 {
#define PG8_LAS __attribute__((address_space(3)))
typedef unsigned short bf16_t;
typedef short bf16x8 __attribute__((ext_vector_type(8)));
typedef float f32x4 __attribute__((ext_vector_type(4)));
typedef unsigned u32x4 __attribute__((ext_vector_type(4)));
constexpr int BM = 256, BK = 64, HALF = 128, HTB = HALF * BK * 2  , STAGE_BYTES = 8 * HTB, NXCD = 8, WGM = 8;

__host__ __device__ __forceinline__ int lds_byte(int r, int c) { const int st = (r >> 4) * 2 + (c >> 5), rr = r & 15, cc = c & 31, ob = rr * 64 + cc * 2; return st * 1024 + (ob ^ (((ob >> 9) & 1) << 5)); }
__host__ __device__ __forceinline__ void stage_rc(int b, int& R, int& C) { const int st = b / 1024, sb = b % 1024, swz = sb ^ (((sb >> 9) & 1) << 5); R = (st >> 1) * 16 + swz / 64; C = (st & 1) * 32 + (swz % 64) / 2; }
__host__ __device__ __forceinline__ int perm32(int rho) { const int n = rho >> 4, i = rho & 15; return 8 * (i >> 2) + 4 * n + (i & 3); }

struct Unit { int pm, pn; };
struct Gemm { const bf16_t* A; const bf16_t* Bt; int M, N, K; };

struct StaticOrder {
    int nM, nN, nwg, G, c;
    __host__ __device__ void init(int M, int N, int G_, int c_) { nM = M / BM; nN = N / BM; nwg = nM * nN; G = G_; c = c_; }
    __host__ __device__ bool next(int i, Unit& u) const {
        const long L = (long)i * G + c; if (L >= nwg) return false;
        int wgid = (int)L; { const int q = nwg / NXCD, r = nwg % NXCD, xcd = wgid % NXCD, off = wgid / NXCD; wgid = (xcd < r ? xcd * (q + 1) : r * (q + 1) + (xcd - r) * q) + off; }
        const int nig = WGM * nN, gid = wgid / nig, fm = gid * WGM, gsz = (nM - fm) < WGM ? (nM - fm) : WGM;
        u.pm = fm + ((wgid % nig) % gsz); u.pn = (wgid % nig) / gsz; return true;
    }
    __device__ __forceinline__ void a_ready(const Unit&) const {}
    __device__ __forceinline__ void done(const Unit&) const {}
};


template <class Epi, class Sched, bool ALIGN_EPI = false, bool SP2 = false>
__device__ __forceinline__ void gemm_phase(PG8_LAS unsigned char* lds, const Gemm g, const Sched& S, const Epi& E) {
    const int tid = threadIdx.x, wid = __builtin_amdgcn_readfirstlane(tid >> 6), lane = tid & 63, wr = wid >> 2, wc = wid & 3, fr = lane & 15, fq = lane >> 4;
    const int K = g.K, nt = K / BK;
    unsigned voffA[2], voffB[2], voffB1[2];
#pragma unroll
    for (int i = 0; i < 2; ++i) { int R, C; stage_rc(tid * 16 + i * 8192, R, C); const int Rb = Epi::PERM ? ((R & ~31) + perm32(R & 31)) : R;
        voffA[i] = (unsigned)(R * K + C) * 2u;
        if (Epi::HEADPERM) { const int Rh = 64 * (R >> 5) + perm32(R & 31); voffB[i] = (unsigned)(Rh * K + C) * 2u; voffB1[i] = (unsigned)((Rh + 32) * K + C) * 2u; }
        else { voffB[i] = (unsigned)(Rb * K + C) * 2u; voffB1[i] = (unsigned)((Rb + HALF) * K + C) * 2u; } }
    const size_t kstep = (size_t)(BK * 2);
    const size_t hstep = (size_t)HALF * K * 2;
    const size_t tstep = 2 * hstep;
    const unsigned ldsw = (unsigned)wid * 1024u;
    const int aoff = lds_byte(wr * 64 + fr, fq * 8), boff = lds_byte(wc * 32 + fr, fq * 8);
#define PG8_SA(b, h) (((b) * 2 + (h)) * HTB)
#define PG8_SB(b, h) ((4 + (b) * 2 + (h)) * HTB)
#define PG8_STAGE(bufoff, gbase, voff) do { _Pragma("unroll") for (int _i = 0; _i < 2; ++_i) \
        __builtin_amdgcn_global_load_lds((const unsigned*)((const char*)(gbase) + (voff)[_i]), (PG8_LAS unsigned*)(lds + (bufoff) + ldsw + _i * 8192), 16, 0, 0); } while (0)
#define PG8_LDA(dst, b, h) do { _Pragma("unroll") for (int m = 0; m < 4; ++m) _Pragma("unroll") for (int k = 0; k < 2; ++k) dst[m][k] = *(const PG8_LAS bf16x8*)(lds + PG8_SA(b, h) + aoff + m * 2048 + k * 1024); } while (0)
#define PG8_LDB(dst, b, h) do { _Pragma("unroll") for (int n = 0; n < 2; ++n) _Pragma("unroll") for (int k = 0; k < 2; ++k) dst[n][k] = *(const PG8_LAS bf16x8*)(lds + PG8_SB(b, h) + boff + n * 2048 + k * 1024); } while (0)
#define PG8_MMA(ai, bj, At, Bt) do { __builtin_amdgcn_s_setprio(1); _Pragma("unroll") for (int m = 0; m < 4; ++m) _Pragma("unroll") for (int n = 0; n < 2; ++n) _Pragma("unroll") for (int k = 0; k < 2; ++k) \
        acc[ai][bj][m][n] = __builtin_amdgcn_mfma_f32_16x16x32_bf16(Bt[n][k], At[m][k], acc[ai][bj][m][n], 0, 0, 0); __builtin_amdgcn_s_setprio(0); } while (0)
#define PG8_WAIT_V(n) asm volatile("s_waitcnt vmcnt(" #n ")" ::: "memory")
#define PG8_WAIT_L(n) asm volatile("s_waitcnt lgkmcnt(" #n ")" ::: "memory")
#define PG8_BAR __builtin_amdgcn_s_barrier()
#define PG8_SCHED __builtin_amdgcn_sched_barrier(0)
    Unit cur, nxt; int ui = 0;
    if (!S.next(0, cur)) return;
    f32x4 acc[2][2][4][2];
#pragma unroll
    for (int a = 0; a < 2; ++a)
#pragma unroll
        for (int b = 0; b < 2; ++b)
#pragma unroll
            for (int m = 0; m < 4; ++m)
#pragma unroll
                for (int n = 0; n < 2; ++n) acc[a][b][m][n] = (f32x4){0.f, 0.f, 0.f, 0.f};
    bf16x8 At[4][2], B0[2][2], B1[2][2];
    const char* cA = (const char*)g.A + (size_t)cur.pm * tstep; const char* cB = (const char*)g.Bt + (size_t)cur.pn * tstep;
    S.a_ready(cur);
    if constexpr (SP2) {
        PG8_STAGE(PG8_SB(0, 0), cB, voffB); PG8_STAGE(PG8_SB(0, 1), cB, voffB1); PG8_STAGE(PG8_SA(0, 0), cA, voffA); PG8_STAGE(PG8_SA(0, 1), cA + hstep, voffA);
        if (wr == 1) PG8_BAR;
        PG8_WAIT_V(2); PG8_BAR;
        PG8_STAGE(PG8_SB(1, 0), cB + kstep, voffB); PG8_STAGE(PG8_SA(1, 0), cA + kstep, voffA); PG8_STAGE(PG8_SB(1, 1), cB + kstep, voffB1);
        PG8_WAIT_V(6); PG8_BAR;
    } else {
        PG8_STAGE(PG8_SB(0, 0), cB, voffB); PG8_STAGE(PG8_SA(0, 0), cA, voffA); PG8_STAGE(PG8_SB(0, 1), cB, voffB1); PG8_STAGE(PG8_SA(0, 1), cA + hstep, voffA);
        if (wr == 1) PG8_BAR;
        PG8_WAIT_V(4); PG8_BAR;
        PG8_STAGE(PG8_SB(1, 0), cB + kstep, voffB); PG8_STAGE(PG8_SA(1, 0), cA + kstep, voffA); PG8_STAGE(PG8_SB(1, 1), cB + kstep, voffB1);
        PG8_WAIT_V(6); PG8_BAR;
    }
    for (;;) {
        const bool has_next = S.next(ui + 1, nxt);
        const char* nA = has_next ? (const char*)g.A + (size_t)nxt.pm * tstep : cA; const char* nB = has_next ? (const char*)g.Bt + (size_t)nxt.pn * tstep : cB;
        for (int t = 0; t < nt; t += 2) {
            const bool last = (t == nt - 2);
            const char* a1 = cA + (size_t)(t + 1) * kstep;
            const char* a2 = last ? nA : cA + (size_t)(t + 2) * kstep; const char* b2 = last ? nB : cB + (size_t)(t + 2) * kstep;
            const char* a3 = a2 + kstep; const char* b3 = b2 + kstep;
            if (last && has_next) S.a_ready(nxt);
            if constexpr (SP2) {
            PG8_LDB(B0, 0, 0); PG8_LDB(B1, 0, 1); PG8_SCHED; PG8_LDA(At, 0, 0); PG8_STAGE(PG8_SA(1, 1), a1 + hstep, voffA);
            PG8_WAIT_V(8); PG8_WAIT_L(0); PG8_BAR; PG8_MMA(0, 0, At, B0); PG8_MMA(0, 1, At, B1); PG8_BAR; PG8_SCHED;
            PG8_LDA(At, 0, 1); PG8_STAGE(PG8_SB(0, 0), b2, voffB); PG8_STAGE(PG8_SB(0, 1), b2, voffB1); PG8_STAGE(PG8_SA(0, 0), a2, voffA);
            PG8_WAIT_V(8); PG8_WAIT_L(0); PG8_BAR; PG8_MMA(1, 0, At, B0); PG8_MMA(1, 1, At, B1); PG8_BAR; PG8_SCHED;
            PG8_LDB(B0, 1, 0); PG8_LDB(B1, 1, 1); PG8_SCHED; PG8_LDA(At, 1, 0); PG8_STAGE(PG8_SA(0, 1), a2 + hstep, voffA);
            PG8_WAIT_V(8); PG8_WAIT_L(0); PG8_BAR; PG8_MMA(0, 0, At, B0); PG8_MMA(0, 1, At, B1); PG8_BAR; PG8_SCHED;
            PG8_LDA(At, 1, 1); PG8_STAGE(PG8_SB(1, 0), b3, voffB); PG8_STAGE(PG8_SB(1, 1), b3, voffB1); PG8_STAGE(PG8_SA(1, 0), a3, voffA);
            PG8_WAIT_V(8); PG8_WAIT_L(0); PG8_BAR; PG8_MMA(1, 0, At, B0); PG8_MMA(1, 1, At, B1); PG8_BAR; PG8_SCHED;
            } else {
            PG8_LDB(B0, 0, 0); PG8_SCHED; PG8_LDA(At, 0, 0); PG8_STAGE(PG8_SA(1, 1), a1 + hstep, voffA);
            PG8_WAIT_L(8); PG8_BAR; PG8_WAIT_L(0); PG8_MMA(0, 0, At, B0); PG8_BAR; PG8_SCHED;
            PG8_LDB(B1, 0, 1); PG8_STAGE(PG8_SB(0, 0), b2, voffB);
            PG8_BAR; PG8_WAIT_L(0); PG8_MMA(0, 1, At, B1); PG8_BAR;
            PG8_LDA(At, 0, 1); PG8_STAGE(PG8_SA(0, 0), a2, voffA);
            PG8_BAR; PG8_WAIT_L(0); PG8_MMA(1, 0, At, B0); PG8_BAR; PG8_SCHED;
            PG8_STAGE(PG8_SB(0, 1), b2, voffB1);
            PG8_WAIT_V(6); PG8_BAR; PG8_MMA(1, 1, At, B1); PG8_BAR;
            PG8_LDB(B0, 1, 0); PG8_SCHED; PG8_LDA(At, 1, 0); PG8_STAGE(PG8_SA(0, 1), a2 + hstep, voffA);
            PG8_WAIT_L(8); PG8_BAR; PG8_WAIT_L(0); PG8_MMA(0, 0, At, B0); PG8_BAR; PG8_SCHED;
            PG8_LDB(B1, 1, 1); PG8_STAGE(PG8_SB(1, 0), b3, voffB);
            PG8_BAR; PG8_WAIT_L(0); PG8_MMA(0, 1, At, B1); PG8_BAR;
            PG8_LDA(At, 1, 1); PG8_STAGE(PG8_SA(1, 0), a3, voffA);
            PG8_BAR; PG8_WAIT_L(0); PG8_MMA(1, 0, At, B0); PG8_BAR; PG8_SCHED;
            PG8_STAGE(PG8_SB(1, 1), b3, voffB1);
            PG8_WAIT_V(6); PG8_BAR; PG8_MMA(1, 1, At, B1); PG8_BAR;
            }
        }
        if constexpr (ALIGN_EPI) { if (wr == 0) PG8_BAR; }
        if constexpr (!Epi::AFTER_DRAIN) { E(acc, cur, wr, wc, fr, fq); S.done(cur); }
        if (!has_next) break;
#pragma unroll
        for (int a = 0; a < 2; ++a)
#pragma unroll
            for (int b = 0; b < 2; ++b)
#pragma unroll
                for (int m = 0; m < 4; ++m)
#pragma unroll
                    for (int n = 0; n < 2; ++n) acc[a][b][m][n] = (f32x4){0.f, 0.f, 0.f, 0.f};
        cur = nxt; cA = nA; cB = nB; ++ui;
        if constexpr (ALIGN_EPI) { if (wr == 1) PG8_BAR; }
    }
    PG8_WAIT_V(0);
    if constexpr (!ALIGN_EPI) { if (wr == 0) PG8_BAR; }
    PG8_BAR;
    if constexpr (Epi::AFTER_DRAIN) { E.fused(acc, cur, wr, wc, fr, fq, lds, wid, lane); S.done(cur); }
#undef PG8_SA
#undef PG8_SB
#undef PG8_STAGE
#undef PG8_LDA
#undef PG8_LDB
#undef PG8_MMA
#undef PG8_WAIT_V
#undef PG8_WAIT_L
#undef PG8_BAR
#undef PG8_SCHED
}
}

struct EpiProj {
  static constexpr bool PERM = true, AFTER_DRAIN = false, HEADPERM = true;
  const float* gqa; const float* gka; const float* gqb; const float* gkb; unsigned char* ws;
  __device__ __forceinline__ void operator()(const pg8::f32x4 (&acc)[2][2][4][2], const pg8::Unit& u, int wr, int wc, int fr, int fq) const {
    const int nbase = u.pn * 256 + wc * 64;
    const int region = nbase >> 9, hw = (nbase & 511) >> 6;
    const float* g = (region == 0) ? gqa : (region == 1) ? gka : (region == 3) ? gqb : gkb;
    const bool normed = (region != 2 && region != 5);
    const float qs = (region == 0 || region == 3) ? C2 : 1.0f;
    u16* dstR = (u16*)(ws + WS_R + (size_t)region * R_REGION);
    f32x4 gv[2][2];
#pragma unroll
    for (int bj = 0; bj < 2; ++bj)
#pragma unroll
      for (int n = 0; n < 2; ++n) gv[bj][n] = normed ? *(const f32x4*)(g + 32 * bj + 8 * fq + 4 * n) : (f32x4){1.f, 1.f, 1.f, 1.f};
#pragma unroll
    for (int ai = 0; ai < 2; ++ai)
#pragma unroll
      for (int m = 0; m < 4; ++m) {
        const int t = u.pm * 256 + ai * 128 + wr * 64 + m * 16 + fr;
        int seq_start, S, sq; seq_of(t, seq_start, S, sq);
        float scale = 1.0f;
        if (normed) {
          float ss = 0.f;
#pragma unroll
          for (int bj = 0; bj < 2; ++bj)
#pragma unroll
            for (int n = 0; n < 2; ++n) { const f32x4 v = acc[ai][bj][m][n]; ss += v[0] * v[0] + v[1] * v[1] + v[2] * v[2] + v[3] * v[3]; }
          ss += __shfl_xor(ss, 16); ss += __shfl_xor(ss, 32);
          scale = __builtin_amdgcn_rsqf(ss * (1.0f / 64.0f) + NORM_EPS) * qs;
        }
        u16* dst;
        if (region != 5) dst = dstR + (size_t)seq_start * 512 + ((size_t)hw * S + sq) * 64;
        else dst = dstR + (size_t)seq_start * 512 + ((size_t)(hw >> 1) * S + sq) * 128 + (hw & 1) * 64;
#pragma unroll
        for (int bj = 0; bj < 2; ++bj) {
          const f32x4 v0 = acc[ai][bj][m][0] * scale * gv[bj][0], v1 = acc[ai][bj][m][1] * scale * gv[bj][1];
          u32x4 o; o[0] = pk2(v0[0], v0[1]); o[1] = pk2(v0[2], v0[3]); o[2] = pk2(v1[0], v1[1]); o[3] = pk2(v1[2], v1[3]);
          *(u32x4*)(dst + 32 * bj + 8 * fq) = o;
        }
      }
  }
};

DI void phase_proj(const Params& p, unsigned char* lds) {
  pg8::Gemm g{(const u16*)((const unsigned char*)p.out + OUT_N1), (const u16*)(p.ws + WS_WIN), T_TOK, 3072, 1024};
  pg8::StaticOrder S; S.init(T_TOK, 3072, (int)gridDim.x, (int)blockIdx.x);
  EpiProj E{p.q_norm_a, p.k_norm_a, p.q_norm_b, p.k_norm_b, p.ws};
  pg8::gemm_phase<EpiProj, pg8::StaticOrder, true, true>((PG8_LAS unsigned char*)lds, g, S, E);
}

constexpr int AL_STAGE = 0;
constexpr int AL_TAB   = 65536;
constexpr int AL_TABA  = 73728;
constexpr int AL_VT    = 90112;
constexpr int AL_XL    = 122880;
constexpr int AL_MISC  = 124928;

DI unsigned voff_b(int row, int ch) { return 256u * row + 16u * (ch ^ (((row & 3) << 2) | ((row >> 2) & 3))); }

DI void diff_unit(const Params& p, unsigned char* lds, int seq_start, int S, int hd, int q0, float lam) {
  const int tid = threadIdx.x, lane = tid & 63, r32 = lane & 31, h = lane >> 5;
  const int w = __builtin_amdgcn_readfirstlane(tid >> 6);
  const int map = w >> 2, wq = w & 3;
  const u16* QBp = (const u16*)(p.ws + WS_R + 3 * R_REGION);
  const u16* KBp = (const u16*)(p.ws + WS_R + 4 * R_REGION);
  const u16* VBp = (const u16*)(p.ws + WS_R + 5 * R_REGION);
  const int qpos = q0 + wq * 32 + r32;
  const u16* Qp = QBp + (size_t)seq_start * 512 + ((size_t)(hd * 2 + map) * S + qpos) * 64;
  bf16x8 qf[4];
#pragma unroll
  for (int ks = 0; ks < 4; ++ks) qf[ks] = *(const bf16x8*)(Qp + ks * 16 + h * 8);
  const u16* K1g = KBp + (size_t)seq_start * 512 + ((size_t)(hd * 2 + 0) * S) * 64;
  const u16* K2g = KBp + (size_t)seq_start * 512 + ((size_t)(hd * 2 + 1) * S) * 64;
  const u16* Vg = VBp + (size_t)seq_start * 512 + ((size_t)hd * S) * 128;
  const float* tab = (const float*)(lds + AL_TAB);
  const float* misc = (const float*)(lds + AL_MISC);
  const float cBefore = misc[8 + hd], cAfter = misc[12 + hd];
  f32x16 O[4];
#pragma unroll
  for (int nb = 0; nb < 4; ++nb)
#pragma unroll
    for (int r = 0; r < 16; ++r) O[nb][r] = 0.f;
  float l = 0.f;
  const int krow = tid >> 3, kkc = tid & 7;
  const int kl_off = krow * 128 + ((kkc ^ ((krow >> 1) & 7)) << 4);
  const u16* k1src = K1g + (size_t)krow * 64 + kkc * 8;
  const u16* k2src = K2g + (size_t)krow * 64 + kkc * 8;
  int vl_off[2]; const u16* vsrc[2];
#pragma unroll
  for (int i = 0; i < 2; ++i) { int c = tid + 512 * i; int row = c >> 4, ch = c & 15; vl_off[i] = (int)voff_b(row, ch); vsrc[i] = Vg + (size_t)row * 128 + ch * 8; }
  u32x4 sk1, sk2, sv0, sv1;
  sk1 = *(const u32x4*)k1src; sk2 = *(const u32x4*)k2src; sv0 = *(const u32x4*)vsrc[0]; sv1 = *(const u32x4*)vsrc[1];
  *(u32x4*)(lds + AL_STAGE + kl_off) = sk1; *(u32x4*)(lds + AL_STAGE + 8192 + kl_off) = sk2;
  *(u32x4*)(lds + AL_STAGE + 16384 + vl_off[0]) = sv0; *(u32x4*)(lds + AL_STAGE + 16384 + vl_off[1]) = sv1;
  __syncthreads();
  const int NKT = S / 64;
  const int i16 = lane & 15, tq = i16 >> 2, tp = i16 & 3, blk = (lane >> 4) & 1;
  for (int kt = 0; kt < NKT; ++kt) {
    const int st = AL_STAGE + (kt & 1) * 32768;
    if (kt + 1 < NKT) {
      const size_t ko = (size_t)(kt + 1) * 64 * 64, vo = (size_t)(kt + 1) * 64 * 128;
      sk1 = *(const u32x4*)(k1src + ko); sk2 = *(const u32x4*)(k2src + ko);
      sv0 = *(const u32x4*)(vsrc[0] + vo); sv1 = *(const u32x4*)(vsrc[1] + vo);
    }
    const unsigned char* Kl = lds + st + map * 8192;
    const unsigned char* Vl = lds + st + 16384;
#pragma unroll
    for (int sub = 0; sub < 2; ++sub) {
      const int kbase = kt * 64 + 32 * sub;
      const int qlo = q0 + wq * 32;
      const int dmin = kbase - (qlo + 31), dmax = kbase + 31 - qlo;
      f32x16 sT;
      if (dmin >= 559) {
#pragma unroll
        for (int r = 0; r < 16; ++r) sT[r] = cAfter;
      } else if (dmax <= -559) {
#pragma unroll
        for (int r = 0; r < 16; ++r) sT[r] = cBefore;
      } else {
        const int base = kbase + 4 * h - qpos + 640;
#pragma unroll
        for (int r = 0; r < 16; ++r) sT[r] = tab[base + (r & 3) + 8 * (r >> 2)];
      }
      const int row = 32 * sub + r32;
#pragma unroll
      for (int ks = 0; ks < 4; ++ks) {
        bf16x8 a = *(const bf16x8*)(Kl + row * 128 + (((2 * ks + h) ^ ((row >> 1) & 7)) << 4));
        sT = MFMA32(a, qf[ks], sT);
      }
      float ls = 0.f;
#pragma unroll
      for (int r = 0; r < 16; ++r) { sT[r] = __builtin_amdgcn_exp2f(sT[r]); ls += sT[r]; }
      l += ls;
      bf16x8 pb[2];
#pragma unroll
      for (int s2 = 0; s2 < 2; ++s2) {
        u32x4 pw; pw[0] = pk2(sT[8 * s2 + 0], sT[8 * s2 + 1]); pw[1] = pk2(sT[8 * s2 + 2], sT[8 * s2 + 3]);
        pw[2] = pk2(sT[8 * s2 + 4], sT[8 * s2 + 5]); pw[3] = pk2(sT[8 * s2 + 6], sT[8 * s2 + 7]);
        pb[s2] = __builtin_bit_cast(bf16x8, pw);
      }
#pragma unroll
      for (int nb = 0; nb < 4; ++nb)
#pragma unroll
        for (int s2 = 0; s2 < 2; ++s2) {
          const int R = 32 * sub + 16 * s2 + 4 * h + tq;
          const int ch = 4 * nb + 2 * blk + (tp >> 1);
          s16x4 lo = tr_read(Vl + voff_b(R, ch) + 8 * (tp & 1));
          s16x4 hi = tr_read(Vl + voff_b(R + 8, ch) + 8 * (tp & 1));
          O[nb] = MFMA32(cat8(lo, hi), pb[s2], O[nb]);
        }
    }
    if (kt + 1 < NKT) {
      const int nst = AL_STAGE + ((kt + 1) & 1) * 32768;
      *(u32x4*)(lds + nst + kl_off) = sk1; *(u32x4*)(lds + nst + 8192 + kl_off) = sk2;
      *(u32x4*)(lds + nst + 16384 + vl_off[0]) = sv0; *(u32x4*)(lds + nst + 16384 + vl_off[1]) = sv1;
    }
    __syncthreads();
  }
  float ltot = l + __shfl_xor(l, 32);
  float* xbuf = (float*)(lds + AL_STAGE);
  if (map == 1) {
    const float inv = 1.0f / ltot;
#pragma unroll
    for (int nb = 0; nb < 4; ++nb)
#pragma unroll
      for (int r = 0; r < 16; ++r) xbuf[((wq * 64 + nb * 16 + r) << 6) + lane] = O[nb][r] * inv;
  }
  __syncthreads();
  if (map == 0) {
    const float inv = 1.0f / ltot;
    float ss = 0.f;
#pragma unroll
    for (int nb = 0; nb < 4; ++nb)
#pragma unroll
      for (int r = 0; r < 16; ++r) {
        float o = O[nb][r] * inv - lam * xbuf[((wq * 64 + nb * 16 + r) << 6) + lane];
        O[nb][r] = o; ss += o * o;
      }
    ss += __shfl_xor(ss, 32);
    const float rn = __builtin_amdgcn_rsqf(ss * (1.0f / 128.0f) + NORM_EPS) * 0.8f;
    u16* mix = (u16*)((unsigned char*)p.out + OUT_MIX) + (size_t)(seq_start + qpos) * 1024 + 512 + hd * 128;
#pragma unroll
    for (int nb = 0; nb < 4; ++nb)
#pragma unroll
      for (int g4 = 0; g4 < 4; ++g4) {
        const int d0 = 32 * nb + 8 * g4 + 4 * h;
        f32x4 gg = *(const f32x4*)(p.diff_norm_g + d0);
        u32x2 o; o[0] = pk2(O[nb][4 * g4 + 0] * rn * gg[0], O[nb][4 * g4 + 1] * rn * gg[1]);
        o[1] = pk2(O[nb][4 * g4 + 2] * rn * gg[2], O[nb][4 * g4 + 3] * rn * gg[3]);
        *(u32x2*)(mix + d0) = o;
      }
  }
  __syncthreads();
}

DI void dilated_item(const Params& p, unsigned char* lds, int seq_start, int S, int hd, int c, int mblk) {
  const int tid = threadIdx.x, lane = tid & 63, r32 = lane & 31, h = lane >> 5;
  const int w = __builtin_amdgcn_readfirstlane(tid >> 6);
  const u16* QAp = (const u16*)(p.ws + WS_R + 0 * R_REGION);
  const u16* KAp = (const u16*)(p.ws + WS_R + 1 * R_REGION);
  const u16* VAp = (const u16*)(p.ws + WS_R + 2 * R_REGION);
  const int qpos = c + 16 * (32 * mblk + r32);
  const u16* Qp = QAp + (size_t)seq_start * 512 + ((size_t)hd * S + qpos) * 64;
  bf16x8 qf[4];
#pragma unroll
  for (int ks = 0; ks < 4; ++ks) qf[ks] = *(const bf16x8*)(Qp + ks * 16 + h * 8);
  const u16* Kg = KAp + (size_t)seq_start * 512 + ((size_t)hd * S) * 64;
  const u16* Vg = VAp + (size_t)seq_start * 512 + ((size_t)hd * S) * 64;
  unsigned char* vt = lds + AL_VT + w * 4096;
  const float* tabA = (const float*)(lds + AL_TABA) + hd * 3 * 132;
  f32x16 O[2];
#pragma unroll
  for (int nb = 0; nb < 2; ++nb)
#pragma unroll
    for (int r = 0; r < 16; ++r) O[nb][r] = 0.f;
  float l = 0.f;
  const int i16 = lane & 15, tq = i16 >> 2, tp = i16 & 3, blk = (lane >> 4) & 1;
  const int wsw = (((r32 >> 1) & 1) << 2) ^ ((r32 >> 2) & 3);
  for (int tau = 0; tau < 33; ++tau) {
    int d, br, tt;
    if (tau < 5) { d = 16; br = 0; tt = tau; } else if (tau < 13) { d = 4; br = 1; tt = tau - 5; } else { d = 1; br = 2; tt = tau - 13; }
    const int ratio = 16 / d;
    const int n0 = ratio * 32 * mblk - 64 + 32 * tt;
    const int kfirst = c + d * n0, klast = c + d * (n0 + 31);
    if (klast < 0 || kfirst >= S) continue;
    int kpos = c + d * (n0 + r32);
    kpos = kpos < 0 ? 0 : (kpos >= S ? S - 1 : kpos);
    bf16x8 kf[4]; u32x4 vc[4];
#pragma unroll
    for (int ks = 0; ks < 4; ++ks) {
      kf[ks] = *(const bf16x8*)(Kg + (size_t)kpos * 64 + ks * 16 + h * 8);
      vc[ks] = *(const u32x4*)(Vg + (size_t)kpos * 64 + (2 * ks + h) * 8);
    }
#pragma unroll
    for (int ks = 0; ks < 4; ++ks) *(u32x4*)(vt + r32 * 128 + (((2 * ks + h) ^ wsw) << 4)) = vc[ks];
    const int nq = ratio * (32 * mblk + r32);
    const int base = n0 + 4 * h - nq;
    const float* tb = tabA + br * 132;
    f32x16 sT;
#pragma unroll
    for (int r = 0; r < 16; ++r) {
      int dl = base + (r & 3) + 8 * (r >> 2);
      dl = dl < -65 ? -65 : (dl > 65 ? 65 : dl);
      sT[r] = tb[dl + 65];
    }
    if (kfirst < 0 || klast >= S) {
#pragma unroll
      for (int r = 0; r < 16; ++r) { int kp = c + d * (n0 + crow(r, h)); if (kp < 0 || kp >= S) sT[r] = NEG_BIG; }
    }
#pragma unroll
    for (int ks = 0; ks < 4; ++ks) sT = MFMA32(kf[ks], qf[ks], sT);
    float ls = 0.f;
#pragma unroll
    for (int r = 0; r < 16; ++r) { sT[r] = __builtin_amdgcn_exp2f(sT[r]); ls += sT[r]; }
    l += ls;
    bf16x8 pb[2];
#pragma unroll
    for (int s2 = 0; s2 < 2; ++s2) {
      u32x4 pw; pw[0] = pk2(sT[8 * s2 + 0], sT[8 * s2 + 1]); pw[1] = pk2(sT[8 * s2 + 2], sT[8 * s2 + 3]);
      pw[2] = pk2(sT[8 * s2 + 4], sT[8 * s2 + 5]); pw[3] = pk2(sT[8 * s2 + 6], sT[8 * s2 + 7]);
      pb[s2] = __builtin_bit_cast(bf16x8, pw);
    }
#pragma unroll
    for (int nb = 0; nb < 2; ++nb)
#pragma unroll
      for (int s2 = 0; s2 < 2; ++s2) {
        const int R = 16 * s2 + 4 * h + tq;
        const int ch = 4 * nb + 2 * blk + (tp >> 1);
        const int sw0 = (((R >> 1) & 1) << 2) ^ ((R >> 2) & 3);
        const int sw1 = ((((R + 8) >> 1) & 1) << 2) ^ (((R + 8) >> 2) & 3);
        s16x4 lo = tr_read(vt + R * 128 + ((ch ^ sw0) << 4) + 8 * (tp & 1));
        s16x4 hi = tr_read(vt + (R + 8) * 128 + ((ch ^ sw1) << 4) + 8 * (tp & 1));
        O[nb] = MFMA32(cat8(lo, hi), pb[s2], O[nb]);
      }
  }
  const float ltot = l + __shfl_xor(l, 32);
  const float inv = 1.0f / ltot;
  u16* mix = (u16*)((unsigned char*)p.out + OUT_MIX) + (size_t)(seq_start + qpos) * 1024 + hd * 64;
#pragma unroll
  for (int nb = 0; nb < 2; ++nb)
#pragma unroll
    for (int g4 = 0; g4 < 4; ++g4) {
      const int d0 = 32 * nb + 8 * g4 + 4 * h;
      u32x2 o; o[0] = pk2(O[nb][4 * g4 + 0] * inv, O[nb][4 * g4 + 1] * inv); o[1] = pk2(O[nb][4 * g4 + 2] * inv, O[nb][4 * g4 + 3] * inv);
      *(u32x2*)(mix + d0) = o;
    }
}

DI void phase_attn(const Params& p, unsigned char* lds) {
  const int tid = threadIdx.x;
  float* misc = (float*)(lds + AL_MISC);
  if (tid == 0) {
    float gqa = 0.f, gka = 0.f, gqb = 0.f, gkb = 0.f, bm = 0.f;
    for (int i = 0; i < 64; ++i) { gqa = fmaxf(gqa, fabsf(p.q_norm_a[i])); gka = fmaxf(gka, fabsf(p.k_norm_a[i])); gqb = fmaxf(gqb, fabsf(p.q_norm_b[i])); gkb = fmaxf(gkb, fabsf(p.k_norm_b[i])); }
    for (int i = 0; i < 32 * 12; ++i) bm = fmaxf(bm, fabsf(p.rel_bias[i]));
    const float M2 = 8.0f * LOG2E * fmaxf(gqa * gka, gqb * gkb) * 1.02f + bm * LOG2E + 0.1f;
    float s1 = 0.f, s2 = 0.f;
    for (int i = 0; i < 64; ++i) { s1 += p.lq1[i] * p.lk1[i]; s2 += p.lq2[i] * p.lk2[i]; }
    misc[0] = M2; misc[1] = expf(s1) - expf(s2) + 0.2f;
    for (int hd = 0; hd < 4; ++hd) { misc[8 + hd] = p.rel_bias[15 * 12 + 8 + hd] * LOG2E - M2; misc[12 + hd] = p.rel_bias[31 * 12 + 8 + hd] * LOG2E - M2; }
  }
  __syncthreads();
  const float M2 = misc[0], lam = misc[1];
  {
    float* tabA = (float*)(lds + AL_TABA);
    for (int i = tid; i < 8 * 3 * 132; i += NTHR) {
      int hd = i / 396, rem = i % 396, br = rem / 132, idx = rem % 132;
      int dl = idx - 65; float v = NEG_BIG;
      if (dl >= -64 && dl <= 64 && idx < 131) { int d = (br == 0) ? 16 : (br == 1) ? 4 : 1; v = p.rel_bias[rel_bucket(dl * d) * 12 + hd] * LOG2E - M2; }
      tabA[i] = v;
    }
  }
  int cur_hd = -1;
  for (int it = blockIdx.x; it < 1024; it += gridDim.x) {
#pragma unroll 1
    for (int half = 0; half < 2; ++half) {
      int seq_start, S, hd, q0;
      if (half == 0) { int up = it; int seq = up >> 7; hd = (up >> 5) & 3; q0 = (up & 31) * 128; S = 4096; seq_start = seq * 4096; }
      else { int us = it; int seq = us >> 6; hd = (us >> 4) & 3; q0 = (us & 15) * 128; S = 2048; seq_start = T_PROMPT + seq * 2048; }
      if (hd != cur_hd) {
        __syncthreads();
        float* tab = (float*)(lds + AL_TAB);
        for (int i = tid; i < 1281; i += NTHR) tab[i] = p.rel_bias[rel_bucket(i - 640) * 12 + 8 + hd] * LOG2E - M2;
        cur_hd = hd;
        __syncthreads();
      }
      diff_unit(p, lds, seq_start, S, hd, q0, lam);
    }
  }
  __syncthreads();
  const int w = tid >> 6;
  for (int it = blockIdx.x * 8 + w; it < 16384; it += gridDim.x * 8) {
    int seq_start, S, hd, c, mblk;
    if (it < 8192) { int seq = it >> 10; hd = (it >> 7) & 7; c = (it >> 3) & 15; mblk = it & 7; S = 4096; seq_start = seq * 4096; }
    else { int j = it - 8192; int seq = j >> 9; hd = (j >> 6) & 7; c = (j >> 2) & 15; mblk = j & 3; S = 2048; seq_start = T_PROMPT + seq * 2048; }
    dilated_item(p, lds, seq_start, S, hd, c, mblk);
  }
}

struct EpiOut {
  static constexpr bool PERM = false, AFTER_DRAIN = false, HEADPERM = false;
  const float* xp; const float* xs; float* x1;
  __device__ __forceinline__ void operator()(const pg8::f32x4 (&acc)[2][2][4][2], const pg8::Unit& u, int wr, int wc, int fr, int fq) const {
    const int col0 = u.pn * 256 + wc * 32 + 4 * fq;
#pragma unroll
    for (int ai = 0; ai < 2; ++ai)
#pragma unroll
      for (int m = 0; m < 4; ++m) {
        const int t = u.pm * 256 + ai * 128 + wr * 64 + m * 16 + fr;
        const float* xr = ((t < T_PROMPT) ? xp + (size_t)t * DM : xs + (size_t)(t - T_PROMPT) * DM) + col0;
        float* orow = x1 + (size_t)t * DM + col0;
#pragma unroll
        for (int bj = 0; bj < 2; ++bj)
#pragma unroll
          for (int n = 0; n < 2; ++n) {
            const f32x4 xv = *(const f32x4*)(xr + bj * 128 + n * 16);
            *(f32x4*)(orow + bj * 128 + n * 16) = xv + acc[ai][bj][m][n];
          }
      }
  }
};

DI void phase_outproj(const Params& p, unsigned char* lds) {
  pg8::Gemm g{(const u16*)((const unsigned char*)p.out + OUT_MIX), (const u16*)(p.ws + WS_WOUT), T_TOK, 1024, 1024};
  pg8::StaticOrder S; S.init(T_TOK, 1024, (int)gridDim.x, (int)blockIdx.x);
  EpiOut E{p.x_prompt, p.x_sample, (float*)(p.ws + WS_X1)};
  pg8::gemm_phase<EpiOut, pg8::StaticOrder, true, true>((PG8_LAS unsigned char*)lds, g, S, E);
}

DI void phase_norm2(const Params& p) {
  const int tid = threadIdx.x, lane = tid & 63, w = tid >> 6;
  const float* x1 = (const float*)(p.ws + WS_X1);
  u16* hb = (u16*)(p.ws + WS_H);
  for (int it = blockIdx.x; it < T_TOK / 8; it += gridDim.x) {
    int t = it * 8 + w;
    norm_row(x1 + (size_t)t * DM, p.ffn_norm_g, hb + (size_t)t * DM, lane);
  }
}

struct EpiQp {
  static constexpr bool PERM = true, AFTER_DRAIN = false, HEADPERM = false;
  u16* O;
  __device__ __forceinline__ void operator()(const pg8::f32x4 (&acc)[2][2][4][2], const pg8::Unit& u, int wr, int wc, int fr, int fq) const {
    const int col0 = u.pn * 256 + wc * 32 + 8 * fq;
#pragma unroll
    for (int ai = 0; ai < 2; ++ai)
#pragma unroll
      for (int m = 0; m < 4; ++m) {
        const int t = u.pm * 256 + ai * 128 + wr * 64 + m * 16 + fr;
        u16* rowp = O + (size_t)t * 2048 + col0;
#pragma unroll
        for (int bj = 0; bj < 2; ++bj) {
          const f32x4 v0 = acc[ai][bj][m][0], v1 = acc[ai][bj][m][1];
          u32x4 o; o[0] = pk2(v0[0], v0[1]); o[1] = pk2(v0[2], v0[3]); o[2] = pk2(v1[0], v1[1]); o[3] = pk2(v1[2], v1[3]);
          *(u32x4*)(rowp + bj * 128) = o;
        }
      }
  }
};

DI void phase_peer_query(const Params& p, unsigned char* lds) {
  pg8::Gemm g{(const u16*)(p.ws + WS_H), (const u16*)(p.ws + WS_WQ), T_TOK, 2048, 1024};
  pg8::StaticOrder S; S.init(T_TOK, 2048, (int)gridDim.x, (int)blockIdx.x);
  EpiQp E{(u16*)p.out};
  pg8::gemm_phase<EpiQp, pg8::StaticOrder, true, true>((PG8_LAS unsigned char*)lds, g, S, E);
}

DI int f2sort(float f) { const int b = __float_as_int(f); return b ^ ((b >> 31) & 0x7fffffff); }
DI float sort2f(int s) { return __int_as_float(s ^ ((s >> 31) & 0x7fffffff)); }
#define CE_DESC(a, b) do { const int mx_ = max((a), (b)), mn_ = min((a), (b)); (a) = mx_; (b) = mn_; } while (0)
#define CE_ASC(a, b) do { const int mx_ = max((a), (b)), mn_ = min((a), (b)); (a) = mn_; (b) = mx_; } while (0)
template <int OFF> DI void sort16_desc(int (&x)[64]) {
#pragma unroll
  for (int k = 2; k <= 16; k <<= 1)
#pragma unroll
    for (int j = k >> 1; j > 0; j >>= 1)
#pragma unroll
      for (int i = 0; i < 16; ++i) {
        const int l = i ^ j;
        if (l > i) { if ((i & k) == 0) CE_DESC(x[OFF + i], x[OFF + l]); else CE_ASC(x[OFF + i], x[OFF + l]); }
      }
}
template <int A, int B> DI void merge16x(int (&x)[64]) {
#pragma unroll
  for (int i = 0; i < 16; ++i) x[A + i] = max(x[A + i], x[B + 15 - i]);
#pragma unroll
  for (int j = 8; j > 0; j >>= 1)
#pragma unroll
    for (int i = 0; i < 16; ++i) { const int l = i ^ j; if (l > i) CE_DESC(x[A + i], x[A + l]); }
}

DI void phase_peer_route(const Params& p, unsigned char* lds) {
  const u16* QP = (const u16*)p.out;
  const u16* SK = (const u16*)(p.ws + WS_SK);
  u16* eidx = (u16*)(p.ws + WS_EIDX);
  float* gg = (float*)(p.ws + WS_G);
  const int tid = threadIdx.x, lane = tid & 63, r32 = lane & 31, h = lane >> 5;
  const int w = __builtin_amdgcn_readfirstlane(tid >> 6);
  unsigned char* SKl = lds;
  float* v2l = (float*)(lds + 65536);
  __syncthreads();
#pragma unroll
  for (int i = 0; i < 8; ++i) {
    const int c = tid + 512 * i; const int zz = c >> 11, row = (c >> 4) & 127, ch = c & 15;
    const u32x4 v = *(const u32x4*)(SK + (size_t)zz * 16384 + row * 128 + ch * 8);
    *(u32x4*)(SKl + zz * 32768 + row * 256 + ((ch ^ (row & 15)) << 4)) = v;
  }
  __syncthreads();
  for (int item = blockIdx.x; item < T_TOK / 256; item += gridDim.x) {
    const int t = item * 256 + w * 32 + r32;
    const u16* qrow = QP + (size_t)t * 2048;
#pragma unroll 1
    for (int pp = 0; pp < 8; ++pp) {
      int lists[2][16];
#pragma unroll
      for (int z = 0; z < 2; ++z) {
        const int c16 = pp * 2 + z;
        int x[64];
        {
          bf16x8 qf[8];
#pragma unroll
          for (int ks = 0; ks < 8; ++ks) qf[ks] = *(const bf16x8*)(qrow + c16 * 128 + ks * 16 + h * 8);
          f32x16 S2[4];
#pragma unroll
          for (int kb = 0; kb < 4; ++kb)
#pragma unroll
            for (int r = 0; r < 16; ++r) S2[kb][r] = 0.f;
#pragma unroll
          for (int ks = 0; ks < 8; ++ks)
#pragma unroll
            for (int kb = 0; kb < 4; ++kb) {
              const int key = kb * 32 + r32;
              const bf16x8 a = *(const bf16x8*)(SKl + z * 32768 + key * 256 + (((2 * ks + h) ^ (key & 15)) << 4));
              S2[kb] = MFMA32(a, qf[ks], S2[kb]);
            }
#pragma unroll
          for (int e = 0; e < 64; ++e) {
            const int kidx = 32 * (e >> 4) + (e & 3) + 8 * ((e & 15) >> 2) + 4 * h;
            x[e] = (f2sort(S2[e >> 4][e & 15]) & ~127) | kidx;
          }
        }
        sort16_desc<0>(x); sort16_desc<16>(x); sort16_desc<32>(x); sort16_desc<48>(x);
        merge16x<0, 16>(x); merge16x<32, 48>(x); merge16x<0, 32>(x);
#pragma unroll
        for (int i = 0; i < 16; ++i) x[16 + i] = __shfl_xor(x[i], 32);
        merge16x<0, 16>(x);
#pragma unroll
        for (int i = 0; i < 16; ++i) lists[z][i] = x[i];
      }
      float v1[16];
#pragma unroll
      for (int i = 0; i < 16; ++i) { v1[i] = sort2f(lists[0][i]); v2l[i * 512 + tid] = sort2f(lists[1][i]); }
      unsigned long long ptrs = 0ull;
      float bestv[16]; int be[16];
#pragma unroll
      for (int rd = 0; rd < 16; ++rd) {
        float best = -3.0e38f, bv1 = 0.f, bv2 = 0.f; int ab = 0;
#pragma unroll
        for (int a = 0; a < 16; ++a) {
          const int b = (int)((ptrs >> (4 * a)) & 15ull);
          const float v2 = v2l[b * 512 + tid];
          const float cnd = v1[a] + v2;
          if (cnd > best) { best = cnd; ab = a; bv1 = v1[a]; bv2 = v2; }
        }
        bestv[rd] = best; be[rd] = (f2sort(bv1) & 127) * 128 + (f2sort(bv2) & 127);
        ptrs += 1ull << (4 * ab);
      }
      if (h == 0) {
        float ex[16]; float sum = 0.f;
#pragma unroll
        for (int rd = 0; rd < 16; ++rd) { ex[rd] = __expf(bestv[rd] - bestv[0]); sum += ex[rd]; }
        const float inv = 1.0f / sum;
        const size_t oo = ((size_t)t * 8 + pp) * 16;
#pragma unroll
        for (int q4 = 0; q4 < 4; ++q4) { f32x4 v = {ex[4 * q4] * inv, ex[4 * q4 + 1] * inv, ex[4 * q4 + 2] * inv, ex[4 * q4 + 3] * inv}; *(f32x4*)(gg + oo + 4 * q4) = v; }
        u32x4 e0, e1;
#pragma unroll
        for (int j = 0; j < 4; ++j) { e0[j] = (unsigned)be[2 * j] | ((unsigned)be[2 * j + 1] << 16); e1[j] = (unsigned)be[8 + 2 * j] | ((unsigned)be[8 + 2 * j + 1] << 16); }
        *(u32x4*)(eidx + oo) = e0; *(u32x4*)(eidx + oo + 8) = e1;
      }
    }
  }
}

typedef float f2_t __attribute__((ext_vector_type(2)));
DI unsigned xcc_id() { return (unsigned)__builtin_amdgcn_s_getreg((3 << 11) | 20) & 7u; }
constexpr int PG_CHUNK_TOK = 64;
constexpr int PG_NCHUNK = T_TOK / PG_CHUNK_TOK;

DI void dec16(const u32x4& r, f2_t (&v)[8]) {
#pragma unroll
  for (int d = 0; d < 4; ++d) { v[2 * d] = __builtin_amdgcn_cvt_pk_f32_fp8((int)r[d], false); v[2 * d + 1] = __builtin_amdgcn_cvt_pk_f32_fp8((int)r[d], true); }
}

DI void peer_udot_token(const Params& p, int x, int t, int lane) {
  const unsigned char* U8 = p.ws + WS_U + (size_t)x * 16384 * 128;
  const u16* Hb = (const u16*)(p.ws + WS_H);
  const u16* eidx = (const u16*)(p.ws + WS_EIDX);
  float* zpart = (float*)p.out;
  const int r = lane >> 3, c = lane & 7;
  int e[16];
#pragma unroll
  for (int i = 0; i < 16; ++i) e[i] = eidx[(size_t)t * 128 + i * 8 + r];
  u32x4 ha = *(const u32x4*)(Hb + (size_t)t * DM + x * 128 + c * 16), hb = *(const u32x4*)(Hb + (size_t)t * DM + x * 128 + c * 16 + 8);
  u32x4 rows[16];
#pragma unroll
  for (int i = 0; i < 16; ++i) rows[i] = *(const u32x4*)(U8 + (size_t)e[i] * 128 + c * 16);
  f2_t hq[8];
#pragma unroll
  for (int j = 0; j < 4; ++j) {
    hq[j][0] = __uint_as_float(ha[j] << 16); hq[j][1] = __uint_as_float(ha[j] & 0xffff0000u);
    hq[4 + j][0] = __uint_as_float(hb[j] << 16); hq[4 + j][1] = __uint_as_float(hb[j] & 0xffff0000u);
  }
  float sv[16];
#pragma unroll
  for (int i = 0; i < 16; ++i) {
    f2_t v[8]; dec16(rows[i], v);
    f2_t a = v[0] * hq[0];
#pragma unroll
    for (int k = 1; k < 8; ++k) a = __builtin_elementwise_fma(v[k], hq[k], a);
    sv[i] = a[0] + a[1];
  }
#pragma unroll
  for (int o = 1; o < 8; o <<= 1) {
#pragma unroll
    for (int i = 0; i < 16; ++i) sv[i] += __shfl_xor(sv[i], o);
  }
  float o0 = 0.f, o1 = 0.f;
#pragma unroll
  for (int i = 0; i < 8; ++i) { if (c == i) { o0 = sv[i]; o1 = sv[i + 8]; } }
  float* zp = zpart + ((size_t)x * T_TOK + t) * 128;
  zp[c * 8 + r] = o0; zp[(c + 8) * 8 + r] = o1;
}

DI void peer_vacc_token(const Params& p, int x, int t, int lane) {
  const unsigned char* V8 = p.ws + WS_V + (size_t)x * 16384 * 128;
  const u16* eidx = (const u16*)(p.ws + WS_EIDX);
  const float* wg = (const float*)(p.ws + WS_G);
  const float* x1 = (const float*)(p.ws + WS_X1);
  const int r = lane >> 3, c = lane & 7;
  int e[16]; float wj[16];
#pragma unroll
  for (int i = 0; i < 16; ++i) { e[i] = eidx[(size_t)t * 128 + i * 8 + r]; wj[i] = wg[(size_t)t * 128 + i * 8 + r]; }
  u32x4 rows[16];
#pragma unroll
  for (int i = 0; i < 16; ++i) rows[i] = *(const u32x4*)(V8 + (size_t)e[i] * 128 + c * 16);
  f2_t acc[8];
#pragma unroll
  for (int k = 0; k < 8; ++k) { acc[k][0] = 0.f; acc[k][1] = 0.f; }
#pragma unroll
  for (int i = 0; i < 16; ++i) {
    f2_t v[8]; dec16(rows[i], v);
    f2_t ww = {wj[i], wj[i]};
#pragma unroll
    for (int k = 0; k < 8; ++k) acc[k] = __builtin_elementwise_fma(v[k], ww, acc[k]);
  }
  f2_t b4[4];
  {
    const bool up = (lane & 32) != 0;
#pragma unroll
    for (int k = 0; k < 4; ++k) {
      f2_t keep = up ? acc[4 + k] : acc[k], send = up ? acc[k] : acc[4 + k];
      f2_t got; got[0] = __shfl_xor(send[0], 32); got[1] = __shfl_xor(send[1], 32);
      b4[k] = keep + got;
    }
  }
  f2_t b2[2];
  {
    const bool up = (lane & 16) != 0;
#pragma unroll
    for (int k = 0; k < 2; ++k) {
      f2_t keep = up ? b4[2 + k] : b4[k], send = up ? b4[k] : b4[2 + k];
      f2_t got; got[0] = __shfl_xor(send[0], 16); got[1] = __shfl_xor(send[1], 16);
      b2[k] = keep + got;
    }
  }
  f2_t b1;
  {
    const bool up = (lane & 8) != 0;
    f2_t keep = up ? b2[1] : b2[0], send = up ? b2[0] : b2[1];
    f2_t got; got[0] = __shfl_xor(send[0], 8); got[1] = __shfl_xor(send[1], 8);
    b1 = keep + got;
  }
  const size_t o = (size_t)t * DM + x * 128 + c * 16 + 2 * r;
  f2_t xv = *(const f2_t*)(x1 + o);
  f2_t res = xv + b1;
  *(f2_t*)(p.out + o) = res;
}

template <int WHICH>
DI void phase_peer_sliced(const Params& p, unsigned char* lds) {
  const int tid = threadIdx.x, lane = tid & 63, w = tid >> 6;
  unsigned* qctr = (unsigned*)(p.ws + WS_MISC + MISC_QCTR) + WHICH * 8;
  int* bc = (int*)lds;
  const unsigned x0 = xcc_id();
  for (int si = 0; si < 8; ++si) {
    const int x = (int)((x0 + si) & 7u);
    for (;;) {
      __syncthreads();
      if (tid == 0) bc[0] = (int)atomicAdd(&qctr[x], 1u);
      __syncthreads();
      const int ch = bc[0];
      if (ch >= PG_NCHUNK) break;
      const int tb = ch * PG_CHUNK_TOK + w * 8;
#pragma unroll 1
      for (int k = 0; k < 8; ++k) {
        if (WHICH == 0) peer_udot_token(p, x, tb + k, lane); else peer_vacc_token(p, x, tb + k, lane);
      }
    }
  }
}

DI void phase_peer_act(const Params& p) {
  const float* zpart = (const float*)p.out;
  const u16* eidx = (const u16*)(p.ws + WS_EIDX);
  float* wg = (float*)(p.ws + WS_G);
  const float* suinv = (const float*)(p.ws + WS_MISC + MISC_SUINV);
  const float* svinv = (const float*)(p.ws + WS_MISC + MISC_SVINV);
  for (size_t i = (size_t)blockIdx.x * NTHR + threadIdx.x; i < (size_t)T_TOK * 128; i += (size_t)gridDim.x * NTHR) {
    float z = 0.f;
#pragma unroll
    for (int x = 0; x < 8; ++x) z += zpart[(size_t)x * T_TOK * 128 + i];
    const int e = eidx[i];
    z *= suinv[e];
    const float act = 0.5f * z * (1.0f + erff(z * 0.70710678118654752f));
    wg[i] = wg[i] * act * svinv[e];
  }
}

__global__ void __launch_bounds__(NTHR, 2) fwd_kernel(Params p) {
  extern __shared__ __attribute__((aligned(16))) unsigned char lds[];
  cg::grid_group grid = cg::this_grid();
#ifndef ONLY_PH
#define PHON(k) 1
#else
#define PHON(k) ((k) == ONLY_PH)
#endif
#ifndef REPEAT_MASK
#define REPEAT_MASK 0
#endif
#define RUN_PHASE(k, call) do { if (PHON(k) && lo <= (k) && (k) < hi) { call; if ((REPEAT_MASK >> (k)) & 1) { grid.sync(); call; } } if (lo <= (k) && (k) + 1 < hi) grid.sync(); } while (0)
  const int lo = p.ph_lo, hi = p.ph_hi;
  RUN_PHASE(0, phase_prep(p, lds));
  RUN_PHASE(1, phase_proj(p, lds));
  RUN_PHASE(2, phase_attn(p, lds));
  RUN_PHASE(3, phase_outproj(p, lds));
  RUN_PHASE(4, phase_norm2(p));
  RUN_PHASE(5, phase_peer_query(p, lds));
  RUN_PHASE(6, phase_peer_route(p, lds));
  RUN_PHASE(7, phase_peer_sliced<0>(p, lds));
  RUN_PHASE(8, phase_peer_act(p));
  RUN_PHASE(9, phase_peer_sliced<1>(p, lds));
}

extern "C" void kernel_launch(void* const* d_in, const int* in_sizes, int n_in, void* d_out, int out_size, void* d_ws, size_t ws_size, hipStream_t stream) {
  static int grid_blocks = 0;
  if (grid_blocks == 0) {
    if (n_in != 20 || ws_size < WS_END || out_size != T_TOK * DM) {
      fprintf(stderr, "kernel_launch: unexpected problem shape (n_in %d, ws %zu, out %d)\n", n_in, ws_size, out_size);
      grid_blocks = -1; return;
    }
    int dev = 0, cus = 0, per_cu = 0;
    hipGetDevice(&dev);
    hipDeviceGetAttribute(&cus, hipDeviceAttributeMultiprocessorCount, dev);
    hipFuncSetAttribute((const void*)fwd_kernel, hipFuncAttributeMaxDynamicSharedMemorySize, LDS_BYTES);
    hipOccupancyMaxActiveBlocksPerMultiprocessor(&per_cu, (const void*)fwd_kernel, NTHR, LDS_BYTES);
    if (per_cu < 1) { fprintf(stderr, "kernel_launch: occupancy query says %d blocks/CU\n", per_cu); per_cu = 1; }
    grid_blocks = cus;
    (void)hipGetLastError();
  }
  if (grid_blocks < 0) return;
  Params p{};
  p.x_prompt = (const float*)d_in[0]; p.x_sample = (const float*)d_in[1]; p.rel_bias = (const float*)d_in[2]; p.attn_norm_g = (const float*)d_in[3];
  p.w_in = (const float*)d_in[4]; p.q_norm_a = (const float*)d_in[5]; p.k_norm_a = (const float*)d_in[6]; p.q_norm_b = (const float*)d_in[7];
  p.k_norm_b = (const float*)d_in[8]; p.lq1 = (const float*)d_in[9]; p.lk1 = (const float*)d_in[10]; p.lq2 = (const float*)d_in[11];
  p.lk2 = (const float*)d_in[12]; p.diff_norm_g = (const float*)d_in[13]; p.w_out = (const float*)d_in[14]; p.ffn_norm_g = (const float*)d_in[15];
  p.peer_w_q = (const float*)d_in[16]; p.peer_sub_keys = (const float*)d_in[17]; p.peer_u = (const float*)d_in[18]; p.peer_v = (const float*)d_in[19];
  p.out = (float*)d_out; p.ws = (unsigned char*)d_ws;
#if FUSED
  p.ph_lo = 0; p.ph_hi = NPHASE;
  void* args[] = {&p};
  hipError_t e = hipLaunchCooperativeKernel((const void*)fwd_kernel, dim3(grid_blocks), dim3(NTHR), args, LDS_BYTES, stream);
  if (e != hipSuccess) fprintf(stderr, "cooperative launch failed: %s (grid %d)\n", hipGetErrorString(e), grid_blocks);
#else
  for (int ph = 0; ph < NPHASE; ++ph) {
    p.ph_lo = ph; p.ph_hi = ph + 1;
    hipLaunchKernelGGL(fwd_kernel, dim3(grid_blocks), dim3(NTHR), LDS_BYTES, stream, p);
  }
#endif
}
```

```cpp
#include <hip/hip_runtime.h>
#include <hip/hip_cooperative_groups.h>
#include <cstdio>
#include <cstdint>
namespace cg = cooperative_groups;

#ifndef FUSED
#define FUSED 1
#endif

typedef unsigned short u16;
typedef __attribute__((ext_vector_type(8))) short bf16x8;
typedef __attribute__((ext_vector_type(4))) short s16x4;
typedef __attribute__((ext_vector_type(16))) float f32x16;
typedef __attribute__((ext_vector_type(4))) float f32x4;
typedef __attribute__((ext_vector_type(4))) unsigned u32x4;
typedef __attribute__((ext_vector_type(2))) unsigned u32x2;
typedef __attribute__((address_space(3))) unsigned char* ldsp_t;

#define DI __device__ __forceinline__
#define MFMA32(a, b, c) __builtin_amdgcn_mfma_f32_32x32x16_bf16((a), (b), (c), 0, 0, 0)

constexpr int DM = 1024;
constexpr int T_TOK = 65536;
constexpr int T_PROMPT = 32768;
constexpr int NTHR = 512;
constexpr int NPHASE = 10;
constexpr float NORM_EPS = 1e-6f;
constexpr float LOG2E = 1.4426950408889634f;
constexpr float C2 = 0.125f * LOG2E;
constexpr float NEG_BIG = -1.0e30f;

constexpr size_t WS_WIN  = 0;
constexpr size_t WS_WOUT = WS_WIN + (size_t)3072 * 1024 * 2;
constexpr size_t WS_WQ   = WS_WOUT + (size_t)1024 * 1024 * 2;
constexpr size_t WS_SK   = WS_WQ + (size_t)2048 * 1024 * 2;
constexpr size_t WS_U    = WS_SK + (size_t)2 * 128 * 128 * 2;
constexpr size_t WS_V    = WS_U + (size_t)16384 * 1024 * 2;
constexpr size_t WS_MISC = WS_V + (size_t)16384 * 1024 * 2;
constexpr size_t MISC_SUINV = 0, MISC_SVINV = 65536, MISC_QCTR = 131072;
constexpr size_t WS_R    = WS_MISC + (size_t)1048576;
constexpr size_t R_REGION = (size_t)T_TOK * 512 * 2;
constexpr size_t WS_X1   = WS_R;
constexpr size_t WS_H    = WS_R + (size_t)T_TOK * 1024 * 4;
constexpr size_t WS_EIDX = WS_R + 6 * R_REGION;
constexpr size_t WS_G    = WS_EIDX + (size_t)T_TOK * 128 * 2;
constexpr size_t WS_END  = WS_G + (size_t)T_TOK * 128 * 4;
static_assert(WS_END <= (size_t)536870912, "workspace map exceeds 512 MiB");
constexpr size_t OUT_N1 = 0, OUT_MIX = 134217728, OUT_TV = 0, OUT_TI = 67108864;

constexpr int LDS_BYTES = 131072;

struct Params {
  const float* x_prompt; const float* x_sample; const float* rel_bias; const float* attn_norm_g; const float* w_in;
  const float* q_norm_a; const float* k_norm_a; const float* q_norm_b; const float* k_norm_b;
  const float* lq1; const float* lk1; const float* lq2; const float* lk2; const float* diff_norm_g; const float* w_out;
  const float* ffn_norm_g; const float* peer_w_q; const float* peer_sub_keys; const float* peer_u; const float* peer_v;
  float* out; unsigned char* ws; int ph_lo; int ph_hi;
};

DI u16 f2bf(float f) { unsigned u = __float_as_uint(f); u += 0x7fffu + ((u >> 16) & 1u); return (u16)(u >> 16); }
DI float bf2f(u16 b) { return __uint_as_float(((unsigned)b) << 16); }
DI unsigned pk2(float lo, float hi) {
  typedef float f2_t __attribute__((ext_vector_type(2)));
  typedef __bf16 b2_t __attribute__((ext_vector_type(2)));
  f2_t v = {lo, hi}; b2_t b = __builtin_convertvector(v, b2_t); return __builtin_bit_cast(unsigned, b);
}
DI int crow(int reg, int h) { return (reg & 3) + 8 * (reg >> 2) + 4 * h; }
DI float wave_sum(float v) {
#pragma unroll
  for (int o = 32; o > 0; o >>= 1) v += __shfl_xor(v, o);
  return v;
}
DI void seq_of(int t, int& seq_start, int& S, int& s) {
  if (t < T_PROMPT) { S = 4096; seq_start = t & ~4095; s = t & 4095; }
  else { S = 2048; seq_start = t & ~2047; s = t & 2047; }
}
DI const float* x_row(const Params& p, int t) {
  return (t < T_PROMPT) ? p.x_prompt + (size_t)t * DM : p.x_sample + (size_t)(t - T_PROMPT) * DM;
}
DI int rel_bucket(int rel) {
  int n = rel < 0 ? -rel : rel;
  int b;
  if (n < 8) b = n;
  else if (n < 15) b = 8; else if (n < 27) b = 9; else if (n < 50) b = 10; else if (n < 91) b = 11;
  else if (n < 166) b = 12; else if (n < 305) b = 13; else if (n < 559) b = 14; else b = 15;
  return (rel > 0 ? 16 : 0) + b;
}
DI s16x4 tr_read(const unsigned char* p) {
  typedef short v4i16_t __attribute__((ext_vector_type(4)));
  return __builtin_bit_cast(s16x4, __builtin_amdgcn_ds_read_tr16_b64_v4i16((__attribute__((address_space(3))) v4i16_t*)p));
}
DI bf16x8 cat8(s16x4 lo, s16x4 hi) { return __builtin_shufflevector(lo, hi, 0, 1, 2, 3, 4, 5, 6, 7); }

DI void transpose_item(const float* __restrict__ src, int K, int N, u16* __restrict__ dst, int k0, int n0, unsigned char* lds) {
  float* tile = (float*)lds;
  const int tid = threadIdx.x;
#pragma unroll
  for (int i = 0; i < 8; ++i) {
    int idx = tid + 512 * i; int r = idx >> 6, c = idx & 63;
    tile[r * 65 + c] = src[(size_t)(k0 + r) * N + n0 + c];
  }
  __syncthreads();
  {
    int n = tid >> 3, kc = tid & 7;
    u32x4 o;
    o[0] = pk2(tile[(kc * 8 + 0) * 65 + n], tile[(kc * 8 + 1) * 65 + n]);
    o[1] = pk2(tile[(kc * 8 + 2) * 65 + n], tile[(kc * 8 + 3) * 65 + n]);
    o[2] = pk2(tile[(kc * 8 + 4) * 65 + n], tile[(kc * 8 + 5) * 65 + n]);
    o[3] = pk2(tile[(kc * 8 + 6) * 65 + n], tile[(kc * 8 + 7) * 65 + n]);
    *(u32x4*)(dst + (size_t)(n0 + n) * K + k0 + kc * 8) = o;
  }
  __syncthreads();
}

DI void convert_item(const float* __restrict__ src, u16* __restrict__ dst, size_t base) {
  size_t i = base + (size_t)threadIdx.x * 8;
  f32x4 a = *(const f32x4*)(src + i), b = *(const f32x4*)(src + i + 4);
  u32x4 o; o[0] = pk2(a[0], a[1]); o[1] = pk2(a[2], a[3]); o[2] = pk2(b[0], b[1]); o[3] = pk2(b[2], b[3]);
  *(u32x4*)(dst + i) = o;
}

DI void norm_row(const float* __restrict__ xr, const float* __restrict__ g, u16* __restrict__ orow, int lane) {
  f32x4 v[4]; float ss = 0.f;
#pragma unroll
  for (int i = 0; i < 4; ++i) { v[i] = *(const f32x4*)(xr + lane * 4 + 256 * i); ss += v[i][0] * v[i][0] + v[i][1] * v[i][1] + v[i][2] * v[i][2] + v[i][3] * v[i][3]; }
  ss = wave_sum(ss);
  const float r = __builtin_amdgcn_rsqf(ss * (1.0f / 1024.0f) + NORM_EPS);
#pragma unroll
  for (int i = 0; i < 4; ++i) {
    f32x4 gg = *(const f32x4*)(g + lane * 4 + 256 * i);
    u32x2 o; o[0] = pk2(v[i][0] * r * gg[0], v[i][1] * r * gg[1]); o[1] = pk2(v[i][2] * r * gg[2], v[i][3] * r * gg[3]);
    *(u32x2*)(orow + lane * 4 + 256 * i) = o;
  }
}

DI void phase_prep(const Params& p, unsigned char* lds) {
  const int nb = gridDim.x, bid = blockIdx.x, tid = threadIdx.x;
  u16* wsb = (u16*)p.ws;
  for (int it = bid; it < 768 + 256 + 512; it += nb) {
    if (it < 768) { int kt = it / 48, nt = it % 48; transpose_item(p.w_in, 1024, 3072, (u16*)(p.ws + WS_WIN), kt * 64, nt * 64, lds); }
    else if (it < 1024) { int j = it - 768; int kt = j / 16, nt = j % 16; transpose_item(p.w_out, 1024, 1024, (u16*)(p.ws + WS_WOUT), kt * 64, nt * 64, lds); }
    else { int j = it - 1024; int kt = j / 32, nt = j % 32; transpose_item(p.peer_w_q, 1024, 2048, (u16*)(p.ws + WS_WQ), kt * 64, nt * 64, lds); }
  }
  for (int it = bid; it < 8; it += nb) convert_item(p.peer_sub_keys, (u16*)(p.ws + WS_SK), (size_t)it * 4096);
  if (bid == 0 && tid < 64) ((unsigned*)(p.ws + WS_MISC + MISC_QCTR))[tid] = 0u;
  {
    const int lane_ = tid & 63, w_ = tid >> 6;
    for (int it = bid; it < 2 * 16384 / 8; it += nb) {
      const int row = it * 8 + w_;
      const int tbl = row >> 14, e = row & 16383;
      const float* src = (tbl ? p.peer_v : p.peer_u) + (size_t)e * DM + lane_ * 16;
      f32x4 a0 = *(const f32x4*)(src), a1 = *(const f32x4*)(src + 4), a2 = *(const f32x4*)(src + 8), a3 = *(const f32x4*)(src + 12);
      float am = 0.f;
#pragma unroll
      for (int j = 0; j < 4; ++j) am = fmaxf(am, fmaxf(fmaxf(fabsf(a0[j]), fabsf(a1[j])), fmaxf(fabsf(a2[j]), fabsf(a3[j]))));
#pragma unroll
      for (int o = 32; o > 0; o >>= 1) am = fmaxf(am, __shfl_xor(am, o));
      const int ex = (int)((__float_as_uint(am) >> 23) & 255u);
      float sc = 1.0f, isc = 1.0f;
      if (ex > 8 && ex < 250) { sc = __uint_as_float((unsigned)(261 - ex) << 23); isc = __uint_as_float((unsigned)(ex - 7) << 23); }
      u32x4 o;
      { int pk = __builtin_amdgcn_cvt_pk_fp8_f32(a0[0] * sc, a0[1] * sc, 0, false); pk = __builtin_amdgcn_cvt_pk_fp8_f32(a0[2] * sc, a0[3] * sc, pk, true); o[0] = (unsigned)pk; }
      { int pk = __builtin_amdgcn_cvt_pk_fp8_f32(a1[0] * sc, a1[1] * sc, 0, false); pk = __builtin_amdgcn_cvt_pk_fp8_f32(a1[2] * sc, a1[3] * sc, pk, true); o[1] = (unsigned)pk; }
      { int pk = __builtin_amdgcn_cvt_pk_fp8_f32(a2[0] * sc, a2[1] * sc, 0, false); pk = __builtin_amdgcn_cvt_pk_fp8_f32(a2[2] * sc, a2[3] * sc, pk, true); o[2] = (unsigned)pk; }
      { int pk = __builtin_amdgcn_cvt_pk_fp8_f32(a3[0] * sc, a3[1] * sc, 0, false); pk = __builtin_amdgcn_cvt_pk_fp8_f32(a3[2] * sc, a3[3] * sc, pk, true); o[3] = (unsigned)pk; }
      unsigned char* dst = p.ws + (tbl ? WS_V : WS_U) + ((size_t)(lane_ >> 3) * 16384 + e) * 128 + (lane_ & 7) * 16;
      *(u32x4*)dst = o;
      if (lane_ == 0) ((float*)(p.ws + WS_MISC + (tbl ? MISC_SVINV : MISC_SUINV)))[e] = isc;
    }
  }
  const int lane = tid & 63, w = tid >> 6;
  u16* n1 = (u16*)((unsigned char*)p.out + OUT_N1);
  for (int it = bid; it < T_TOK / 8; it += nb) {
    int t = it * 8 + w;
    norm_row(x_row(p, t), p.attn_norm_g, n1 + (size_t)t * DM, lane);
  }
  (void)wsb;
}

template <int PR, int QR>
DI void gemm_mainloop(const u16* __restrict__ P, const u16* __restrict__ Q, int K, int p0, int q0, unsigned char* lds, f32x16 (&acc)[2][2]) {
  static_assert(PR + QR == 384, "tile");
  constexpr int STAGE = 384 * 128;
  constexpr int WC = QR / 64;
  const int tid = threadIdx.x, lane = tid & 63, r32 = lane & 31, h = lane >> 5;
  const int w = __builtin_amdgcn_readfirstlane(tid >> 6);
  const int wr = w / WC, wc = w % WC;
#pragma unroll
  for (int i = 0; i < 2; ++i)
#pragma unroll
    for (int j = 0; j < 2; ++j)
#pragma unroll
      for (int r = 0; r < 16; ++r) acc[i][j][r] = 0.f;
  u32x4 stg[6];
  const u16* src[6]; int loff[6];
#pragma unroll
  for (int i = 0; i < 6; ++i) {
    int c = tid + 512 * i; int row = c >> 3, kc = c & 7;
    src[i] = (row < PR) ? P + (size_t)(p0 + row) * K + kc * 8 : Q + (size_t)(q0 + row - PR) * K + kc * 8;
    loff[i] = row * 128 + ((kc ^ ((row >> 1) & 7)) << 4);
  }
  const int KT = K / 64;
#pragma unroll
  for (int i = 0; i < 6; ++i) stg[i] = *(const u32x4*)(src[i]);
#pragma unroll
  for (int i = 0; i < 6; ++i) *(u32x4*)(lds + loff[i]) = stg[i];
  __syncthreads();
  int aoff[2], boff[2], asw[2], bsw[2];
#pragma unroll
  for (int i = 0; i < 2; ++i) {
    int ra = wr * 64 + i * 32 + r32; aoff[i] = ra * 128; asw[i] = (ra >> 1) & 7;
    int rb = PR + wc * 64 + i * 32 + r32; boff[i] = rb * 128; bsw[i] = (rb >> 1) & 7;
  }
  for (int kt = 0; kt < KT; ++kt) {
    const int buf = (kt & 1) * STAGE;
    if (kt + 1 < KT) {
#pragma unroll
      for (int i = 0; i < 6; ++i) stg[i] = *(const u32x4*)(src[i] + (kt + 1) * 64);
    }
#pragma unroll
    for (int ks = 0; ks < 4; ++ks) {
      bf16x8 a[2], b[2];
#pragma unroll
      for (int i = 0; i < 2; ++i) {
        a[i] = *(const bf16x8*)(lds + buf + aoff[i] + (((2 * ks + h) ^ asw[i]) << 4));
        b[i] = *(const bf16x8*)(lds + buf + boff[i] + (((2 * ks + h) ^ bsw[i]) << 4));
      }
#pragma unroll
      for (int i = 0; i < 2; ++i)
#pragma unroll
        for (int j = 0; j < 2; ++j) acc[i][j] = MFMA32(a[i], b[j], acc[i][j]);
    }
    if (kt + 1 < KT) {
      const int nbuf = ((kt + 1) & 1) * STAGE;
#pragma unroll
      for (int i = 0; i < 6; ++i) *(u32x4*)(lds + nbuf + loff[i]) = stg[i];
    }
    __syncthreads();
  }
}

namespace pg8 {
#define PG8_LAS __attribute__((address_space(3)))
typedef unsigned short bf16_t;
typedef short bf16x8 __attribute__((ext_vector_type(8)));
typedef float f32x4 __attribute__((ext_vector_type(4)));
typedef unsigned u32x4 __attribute__((ext_vector_type(4)));
constexpr int BM = 256, BK = 64, HALF = 128, HTB = HALF * BK * 2  , STAGE_BYTES = 8 * HTB, NXCD = 8, WGM = 8;

__host__ __device__ __forceinline__ int lds_byte(int r, int c) { const int st = (r >> 4) * 2 + (c >> 5), rr = r & 15, cc = c & 31, ob = rr * 64 + cc * 2; return st * 1024 + (ob ^ (((ob >> 9) & 1) << 5)); }
__host__ __device__ __forceinline__ void stage_rc(int b, int& R, int& C) { const int st = b / 1024, sb = b % 1024, swz = sb ^ (((sb >> 9) & 1) << 5); R = (st >> 1) * 16 + swz / 64; C = (st & 1) * 32 + (swz % 64) / 2; }
__host__ __device__ __forceinline__ int perm32(int rho) { const int n = rho >> 4, i = rho & 15; return 8 * (i >> 2) + 4 * n + (i & 3); }

struct Unit { int pm, pn; };
struct Gemm { const bf16_t* A; const bf16_t* Bt; int M, N, K; };

struct StaticOrder {
    int nM, nN, nwg, G, c;
    __host__ __device__ void init(int M, int N, int G_, int c_) { nM = M / BM; nN = N / BM; nwg = nM * nN; G = G_; c = c_; }
    __host__ __device__ bool next(int i, Unit& u) const {
        const long L = (long)i * G + c; if (L >= nwg) return false;
        int wgid = (int)L; { const int q = nwg / NXCD, r = nwg % NXCD, xcd = wgid % NXCD, off = wgid / NXCD; wgid = (xcd < r ? xcd * (q + 1) : r * (q + 1) + (xcd - r) * q) + off; }
        const int nig = WGM * nN, gid = wgid / nig, fm = gid * WGM, gsz = (nM - fm) < WGM ? (nM - fm) : WGM;
        u.pm = fm + ((wgid % nig) % gsz); u.pn = (wgid % nig) / gsz; return true;
    }
    __device__ __forceinline__ void a_ready(const Unit&) const {}
    __device__ __forceinline__ void done(const Unit&) const {}
};


template <class Epi, class Sched, bool ALIGN_EPI = false, bool SP2 = false>
__device__ __forceinline__ void gemm_phase(PG8_LAS unsigned char* lds, const Gemm g, const Sched& S, const Epi& E) {
    const int tid = threadIdx.x, wid = __builtin_amdgcn_readfirstlane(tid >> 6), lane = tid & 63, wr = wid >> 2, wc = wid & 3, fr = lane & 15, fq = lane >> 4;
    const int K = g.K, nt = K / BK;
    unsigned voffA[2], voffB[2], voffB1[2];
#pragma unroll
    for (int i = 0; i < 2; ++i) { int R, C; stage_rc(tid * 16 + i * 8192, R, C); const int Rb = Epi::PERM ? ((R & ~31) + perm32(R & 31)) : R;
        voffA[i] = (unsigned)(R * K + C) * 2u;
        if (Epi::HEADPERM) { const int Rh = 64 * (R >> 5) + perm32(R & 31); voffB[i] = (unsigned)(Rh * K + C) * 2u; voffB1[i] = (unsigned)((Rh + 32) * K + C) * 2u; }
        else { voffB[i] = (unsigned)(Rb * K + C) * 2u; voffB1[i] = (unsigned)((Rb + HALF) * K + C) * 2u; } }
    const size_t kstep = (size_t)(BK * 2);
    const size_t hstep = (size_t)HALF * K * 2;
    const size_t tstep = 2 * hstep;
    const unsigned ldsw = (unsigned)wid * 1024u;
    const int aoff = lds_byte(wr * 64 + fr, fq * 8), boff = lds_byte(wc * 32 + fr, fq * 8);
#define PG8_SA(b, h) (((b) * 2 + (h)) * HTB)
#define PG8_SB(b, h) ((4 + (b) * 2 + (h)) * HTB)
#define PG8_STAGE(bufoff, gbase, voff) do { _Pragma("unroll") for (int _i = 0; _i < 2; ++_i) \
        __builtin_amdgcn_global_load_lds((const unsigned*)((const char*)(gbase) + (voff)[_i]), (PG8_LAS unsigned*)(lds + (bufoff) + ldsw + _i * 8192), 16, 0, 0); } while (0)
#define PG8_LDA(dst, b, h) do { _Pragma("unroll") for (int m = 0; m < 4; ++m) _Pragma("unroll") for (int k = 0; k < 2; ++k) dst[m][k] = *(const PG8_LAS bf16x8*)(lds + PG8_SA(b, h) + aoff + m * 2048 + k * 1024); } while (0)
#define PG8_LDB(dst, b, h) do { _Pragma("unroll") for (int n = 0; n < 2; ++n) _Pragma("unroll") for (int k = 0; k < 2; ++k) dst[n][k] = *(const PG8_LAS bf16x8*)(lds + PG8_SB(b, h) + boff + n * 2048 + k * 1024); } while (0)
#define PG8_MMA(ai, bj, At, Bt) do { __builtin_amdgcn_s_setprio(1); _Pragma("unroll") for (int m = 0; m < 4; ++m) _Pragma("unroll") for (int n = 0; n < 2; ++n) _Pragma("unroll") for (int k = 0; k < 2; ++k) \
        acc[ai][bj][m][n] = __builtin_amdgcn_mfma_f32_16x16x32_bf16(Bt[n][k], At[m][k], acc[ai][bj][m][n], 0, 0, 0); __builtin_amdgcn_s_setprio(0); } while (0)
#define PG8_WAIT_V(n) asm volatile("s_waitcnt vmcnt(" #n ")" ::: "memory")
#define PG8_WAIT_L(n) asm volatile("s_waitcnt lgkmcnt(" #n ")" ::: "memory")
#define PG8_BAR __builtin_amdgcn_s_barrier()
#define PG8_SCHED __builtin_amdgcn_sched_barrier(0)
    Unit cur, nxt; int ui = 0;
    if (!S.next(0, cur)) return;
    f32x4 acc[2][2][4][2];
#pragma unroll
    for (int a = 0; a < 2; ++a)
#pragma unroll
        for (int b = 0; b < 2; ++b)
#pragma unroll
            for (int m = 0; m < 4; ++m)
#pragma unroll
                for (int n = 0; n < 2; ++n) acc[a][b][m][n] = (f32x4){0.f, 0.f, 0.f, 0.f};
    bf16x8 At[4][2], B0[2][2], B1[2][2];
    const char* cA = (const char*)g.A + (size_t)cur.pm * tstep; const char* cB = (const char*)g.Bt + (size_t)cur.pn * tstep;
    S.a_ready(cur);
    if constexpr (SP2) {
        PG8_STAGE(PG8_SB(0, 0), cB, voffB); PG8_STAGE(PG8_SB(0, 1), cB, voffB1); PG8_STAGE(PG8_SA(0, 0), cA, voffA); PG8_STAGE(PG8_SA(0, 1), cA + hstep, voffA);
        if (wr == 1) PG8_BAR;
        PG8_WAIT_V(2); PG8_BAR;
        PG8_STAGE(PG8_SB(1, 0), cB + kstep, voffB); PG8_STAGE(PG8_SA(1, 0), cA + kstep, voffA); PG8_STAGE(PG8_SB(1, 1), cB + kstep, voffB1);
        PG8_WAIT_V(6); PG8_BAR;
    } else {
        PG8_STAGE(PG8_SB(0, 0), cB, voffB); PG8_STAGE(PG8_SA(0, 0), cA, voffA); PG8_STAGE(PG8_SB(0, 1), cB, voffB1); PG8_STAGE(PG8_SA(0, 1), cA + hstep, voffA);
        if (wr == 1) PG8_BAR;
        PG8_WAIT_V(4); PG8_BAR;
        PG8_STAGE(PG8_SB(1, 0), cB + kstep, voffB); PG8_STAGE(PG8_SA(1, 0), cA + kstep, voffA); PG8_STAGE(PG8_SB(1, 1), cB + kstep, voffB1);
        PG8_WAIT_V(6); PG8_BAR;
    }
    for (;;) {
        const bool has_next = S.next(ui + 1, nxt);
        const char* nA = has_next ? (const char*)g.A + (size_t)nxt.pm * tstep : cA; const char* nB = has_next ? (const char*)g.Bt + (size_t)nxt.pn * tstep : cB;
        for (int t = 0; t < nt; t += 2) {
            const bool last = (t == nt - 2);
            const char* a1 = cA + (size_t)(t + 1) * kstep;
            const char* a2 = last ? nA : cA + (size_t)(t + 2) * kstep; const char* b2 = last ? nB : cB + (size_t)(t + 2) * kstep;
            const char* a3 = a2 + kstep; const char* b3 = b2 + kstep;
            if (last && has_next) S.a_ready(nxt);
            if constexpr (SP2) {
            PG8_LDB(B0, 0, 0); PG8_LDB(B1, 0, 1); PG8_SCHED; PG8_LDA(At, 0, 0); PG8_STAGE(PG8_SA(1, 1), a1 + hstep, voffA);
            PG8_WAIT_V(8); PG8_WAIT_L(0); PG8_BAR; PG8_MMA(0, 0, At, B0); PG8_MMA(0, 1, At, B1); PG8_BAR; PG8_SCHED;
            PG8_LDA(At, 0, 1); PG8_STAGE(PG8_SB(0, 0), b2, voffB); PG8_STAGE(PG8_SB(0, 1), b2, voffB1); PG8_STAGE(PG8_SA(0, 0), a2, voffA);
            PG8_WAIT_V(8); PG8_WAIT_L(0); PG8_BAR; PG8_MMA(1, 0, At, B0); PG8_MMA(1, 1, At, B1); PG8_BAR; PG8_SCHED;
            PG8_LDB(B0, 1, 0); PG8_LDB(B1, 1, 1); PG8_SCHED; PG8_LDA(At, 1, 0); PG8_STAGE(PG8_SA(0, 1), a2 + hstep, voffA);
            PG8_WAIT_V(8); PG8_WAIT_L(0); PG8_BAR; PG8_MMA(0, 0, At, B0); PG8_MMA(0, 1, At, B1); PG8_BAR; PG8_SCHED;
            PG8_LDA(At, 1, 1); PG8_STAGE(PG8_SB(1, 0), b3, voffB); PG8_STAGE(PG8_SB(1, 1), b3, voffB1); PG8_STAGE(PG8_SA(1, 0), a3, voffA);
            PG8_WAIT_V(8); PG8_WAIT_L(0); PG8_BAR; PG8_MMA(1, 0, At, B0); PG8_MMA(1, 1, At, B1); PG8_BAR; PG8_SCHED;
            } else {
            PG8_LDB(B0, 0, 0); PG8_SCHED; PG8_LDA(At, 0, 0); PG8_STAGE(PG8_SA(1, 1), a1 + hstep, voffA);
            PG8_WAIT_L(8); PG8_BAR; PG8_WAIT_L(0); PG8_MMA(0, 0, At, B0); PG8_BAR; PG8_SCHED;
            PG8_LDB(B1, 0, 1); PG8_STAGE(PG8_SB(0, 0), b2, voffB);
            PG8_BAR; PG8_WAIT_L(0); PG8_MMA(0, 1, At, B1); PG8_BAR;
            PG8_LDA(At, 0, 1); PG8_STAGE(PG8_SA(0, 0), a2, voffA);
            PG8_BAR; PG8_WAIT_L(0); PG8_MMA(1, 0, At, B0); PG8_BAR; PG8_SCHED;
            PG8_STAGE(PG8_SB(0, 1), b2, voffB1);
            PG8_WAIT_V(6); PG8_BAR; PG8_MMA(1, 1, At, B1); PG8_BAR;
            PG8_LDB(B0, 1, 0); PG8_SCHED; PG8_LDA(At, 1, 0); PG8_STAGE(PG8_SA(0, 1), a2 + hstep, voffA);
            PG8_WAIT_L(8); PG8_BAR; PG8_WAIT_L(0); PG8_MMA(0, 0, At, B0); PG8_BAR; PG8_SCHED;
            PG8_LDB(B1, 1, 1); PG8_STAGE(PG8_SB(1, 0), b3, voffB);
            PG8_BAR; PG8_WAIT_L(0); PG8_MMA(0, 1, At, B1); PG8_BAR;
            PG8_LDA(At, 1, 1); PG8_STAGE(PG8_SA(1, 0), a3, voffA);
            PG8_BAR; PG8_WAIT_L(0); PG8_MMA(1, 0, At, B0); PG8_BAR; PG8_SCHED;
            PG8_STAGE(PG8_SB(1, 1), b3, voffB1);
            PG8_WAIT_V(6); PG8_BAR; PG8_MMA(1, 1, At, B1); PG8_BAR;
            }
        }
        if constexpr (ALIGN_EPI) { if (wr == 0) PG8_BAR; }
        if constexpr (!Epi::AFTER_DRAIN) { E(acc, cur, wr, wc, fr, fq); S.done(cur); }
        if (!has_next) break;
#pragma unroll
        for (int a = 0; a < 2; ++a)
#pragma unroll
            for (int b = 0; b < 2; ++b)
#pragma unroll
                for (int m = 0; m < 4; ++m)
#pragma unroll
                    for (int n = 0; n < 2; ++n) acc[a][b][m][n] = (f32x4){0.f, 0.f, 0.f, 0.f};
        cur = nxt; cA = nA; cB = nB; ++ui;
        if constexpr (ALIGN_EPI) { if (wr == 1) PG8_BAR; }
    }
    PG8_WAIT_V(0);
    if constexpr (!ALIGN_EPI) { if (wr == 0) PG8_BAR; }
    PG8_BAR;
    if constexpr (Epi::AFTER_DRAIN) { E.fused(acc, cur, wr, wc, fr, fq, lds, wid, lane); S.done(cur); }
#undef PG8_SA
#undef PG8_SB
#undef PG8_STAGE
#undef PG8_LDA
#undef PG8_LDB
#undef PG8_MMA
#undef PG8_WAIT_V
#undef PG8_WAIT_L
#undef PG8_BAR
#undef PG8_SCHED
}
}

struct EpiProj {
  static constexpr bool PERM = true, AFTER_DRAIN = false, HEADPERM = true;
  const float* gqa; const float* gka; const float* gqb; const float* gkb; unsigned char* ws;
  __device__ __forceinline__ void operator()(const pg8::f32x4 (&acc)[2][2][4][2], const pg8::Unit& u, int wr, int wc, int fr, int fq) const {
    const int nbase = u.pn * 256 + wc * 64;
    const int region = nbase >> 9, hw = (nbase & 511) >> 6;
    const float* g = (region == 0) ? gqa : (region == 1) ? gka : (region == 3) ? gqb : gkb;
    const bool normed = (region != 2 && region != 5);
    const float qs = (region == 0 || region == 3) ? C2 : 1.0f;
    u16* dstR = (u16*)(ws + WS_R + (size_t)region * R_REGION);
    f32x4 gv[2][2];
#pragma unroll
    for (int bj = 0; bj < 2; ++bj)
#pragma unroll
      for (int n = 0; n < 2; ++n) gv[bj][n] = normed ? *(const f32x4*)(g + 32 * bj + 8 * fq + 4 * n) : (f32x4){1.f, 1.f, 1.f, 1.f};
#pragma unroll
    for (int ai = 0; ai < 2; ++ai)
#pragma unroll
      for (int m = 0; m < 4; ++m) {
        const int t = u.pm * 256 + ai * 128 + wr * 64 + m * 16 + fr;
        int seq_start, S, sq; seq_of(t, seq_start, S, sq);
        float scale = 1.0f;
        if (normed) {
          float ss = 0.f;
#pragma unroll
          for (int bj = 0; bj < 2; ++bj)
#pragma unroll
            for (int n = 0; n < 2; ++n) { const f32x4 v = acc[ai][bj][m][n]; ss += v[0] * v[0] + v[1] * v[1] + v[2] * v[2] + v[3] * v[3]; }
          ss += __shfl_xor(ss, 16); ss += __shfl_xor(ss, 32);
          scale = __builtin_amdgcn_rsqf(ss * (1.0f / 64.0f) + NORM_EPS) * qs;
        }
        u16* dst;
        if (region != 5) dst = dstR + (size_t)seq_start * 512 + ((size_t)hw * S + sq) * 64;
        else dst = dstR + (size_t)seq_start * 512 + ((size_t)(hw >> 1) * S + sq) * 128 + (hw & 1) * 64;
#pragma unroll
        for (int bj = 0; bj < 2; ++bj) {
          const f32x4 v0 = acc[ai][bj][m][0] * scale * gv[bj][0], v1 = acc[ai][bj][m][1] * scale * gv[bj][1];
          u32x4 o; o[0] = pk2(v0[0], v0[1]); o[1] = pk2(v0[2], v0[3]); o[2] = pk2(v1[0], v1[1]); o[3] = pk2(v1[2], v1[3]);
          *(u32x4*)(dst + 32 * bj + 8 * fq) = o;
        }
      }
  }
};

DI void phase_proj(const Params& p, unsigned char* lds) {
  pg8::Gemm g{(const u16*)((const unsigned char*)p.out + OUT_N1), (const u16*)(p.ws + WS_WIN), T_TOK, 3072, 1024};
  pg8::StaticOrder S; S.init(T_TOK, 3072, (int)gridDim.x, (int)blockIdx.x);
  EpiProj E{p.q_norm_a, p.k_norm_a, p.q_norm_b, p.k_norm_b, p.ws};
  pg8::gemm_phase<EpiProj, pg8::StaticOrder, true, true>((PG8_LAS unsigned char*)lds, g, S, E);
}

constexpr int AL_STAGE = 0;
constexpr int AL_VT    = 0;
constexpr int AL_TAB   = 98304;
constexpr int AL_TABA  = 104448;
constexpr int AL_XL    = 118784;
constexpr int AL_MISC  = 120832;

DI unsigned voff_b(int row, int ch) { return 256u * row + 16u * (ch ^ (((row & 3) << 2) | ((row >> 2) & 3))); }

template <int VAR>
DI void diff_unit(const Params& p, unsigned char* lds, int seq_start, int S, int hd, int q0, float lam) {
  const int tid = threadIdx.x, lane = tid & 63, r32 = lane & 31, h = lane >> 5;
  const int w = __builtin_amdgcn_readfirstlane(tid >> 6);
  const int map = w >> 2, wq = w & 3;
  const u16* QBp = (const u16*)(p.ws + WS_R + 3 * R_REGION);
  const u16* KBp = (const u16*)(p.ws + WS_R + 4 * R_REGION);
  const u16* VBp = (const u16*)(p.ws + WS_R + 5 * R_REGION);
  const int qpos = q0 + wq * 32 + r32;
  const int qlo = q0 + wq * 32;
  const u16* Qp = QBp + (size_t)seq_start * 512 + ((size_t)(hd * 2 + map) * S + qpos) * 64;
  bf16x8 qf[4];
#pragma unroll
  for (int ks = 0; ks < 4; ++ks) qf[ks] = *(const bf16x8*)(Qp + ks * 16 + h * 8);
  const u16* K1g = KBp + (size_t)seq_start * 512 + ((size_t)(hd * 2 + 0) * S) * 64;
  const u16* K2g = KBp + (size_t)seq_start * 512 + ((size_t)(hd * 2 + 1) * S) * 64;
  const u16* Vg = VBp + (size_t)seq_start * 512 + ((size_t)hd * S) * 128;
  const float* tab = (const float*)(lds + AL_TAB);
  const float* misc = (const float*)(lds + AL_MISC);
  const float cAfter = misc[12 + hd];
  f32x16 O[4];
#pragma unroll
  for (int nb = 0; nb < 4; ++nb)
#pragma unroll
    for (int r = 0; r < 16; ++r) O[nb][r] = 0.f;
  float l = 0.f;
  const int kr_ = 8 * w + (lane >> 3), kc_ = (lane & 7) ^ ((kr_ >> 1) & 7);
  const u16* k1src = K1g + (size_t)kr_ * 64 + kc_ * 8;
  const u16* k2src = K2g + (size_t)kr_ * 64 + kc_ * 8;
  const u16* vsrc[2];
#pragma unroll
  for (int i = 0; i < 2; ++i) { const int row = 8 * w + 4 * i + (lane >> 4); const int pc = (lane & 15) ^ (((row & 3) << 2) | ((row >> 2) & 3)); vsrc[i] = Vg + (size_t)row * 128 + pc * 8; }
  const int NKT = S / 64;
  const int i16 = lane & 15, tq = i16 >> 2, tp = i16 & 3, blk = (lane >> 4) & 1;
  int kbase4[4], vbase[4][2];
#pragma unroll
  for (int ks = 0; ks < 4; ++ks) kbase4[ks] = r32 * 128 + (((2 * ks + h) ^ ((r32 >> 1) & 7)) << 4);
#pragma unroll
  for (int nb = 0; nb < 4; ++nb)
#pragma unroll
    for (int hi = 0; hi < 2; ++hi) vbase[nb][hi] = (int)voff_b(4 * h + tq + 8 * hi, 4 * nb + 2 * blk + (tp >> 1)) + 8 * (tp & 1);
#define DU_GLDS(gsrc_, ldsoff_) do { unsigned keep_; const unsigned dst_ = (unsigned)__builtin_amdgcn_readfirstlane((int)(ldsoff_)); \
    asm volatile("s_mov_b32 %0, m0\n\ts_mov_b32 m0, %2\n\ts_nop 0\n\tglobal_load_lds_dwordx4 %1, off\n\ts_mov_b32 m0, %0" : "=&s"(keep_) : "v"(gsrc_), "s"(dst_) : "memory"); } while (0)
#define DU_DMA(kt_, st_) do { const size_t ko_ = (size_t)(kt_) * 64 * 64, vo_ = (size_t)(kt_) * 64 * 128; const unsigned b_ = lds_base + AL_STAGE + (st_) * 32768; \
    DU_GLDS(k1src + ko_, b_ + w * 1024); DU_GLDS(k2src + ko_, b_ + 8192 + w * 1024); \
    DU_GLDS(vsrc[0] + vo_, b_ + 16384 + w * 2048); DU_GLDS(vsrc[1] + vo_, b_ + 16384 + w * 2048 + 1024); } while (0)
  const unsigned lds_base = (unsigned)(uintptr_t)lds;
#define SBAR() __builtin_amdgcn_sched_barrier(0)
#define DU_VRD(slot, f, so_) do { vlo[slot] = tr_read(vp[(f) >> 1][0] + (so_) + ((f) & 1) * 4096); vhi[slot] = tr_read(vp[(f) >> 1][1] + (so_) + ((f) & 1) * 4096); } while (0)
#define DU_SUB(A, B, kq2, kso2_, has_next2_, vso_, knext_, has_next_) do { \
    SBAR(); \
    s16x4 vlo[4], vhi[4]; \
    if (VAR != 2 && VAR != 4) { DU_VRD(0, 0, vso_); DU_VRD(1, 1, vso_); DU_VRD(2, 2, vso_); DU_VRD(3, 3, vso_); } \
    if (has_next_ && VAR != 3 && VAR != 4) { \
      f32x16 z_; _Pragma("unroll") for (int r = 0; r < 16; ++r) z_[r] = 0.f; \
      B = MFMA32(kf[0], qf[0], z_); B = MFMA32(kf[1], qf[1], B); B = MFMA32(kf[2], qf[2], B); B = MFMA32(kf[3], qf[3], B); } \
    float ls = 0.f; \
    _Pragma("unroll") for (int r = 0; r < 16; ++r) ls += A[r]; \
    l += ls; \
    bf16x8 pb[2]; \
    _Pragma("unroll") for (int s2 = 0; s2 < 2; ++s2) { \
      u32x4 pw; pw[0] = pk2(A[8 * s2 + 0], A[8 * s2 + 1]); pw[1] = pk2(A[8 * s2 + 2], A[8 * s2 + 3]); \
      pw[2] = pk2(A[8 * s2 + 4], A[8 * s2 + 5]); pw[3] = pk2(A[8 * s2 + 6], A[8 * s2 + 7]); \
      pb[s2] = __builtin_bit_cast(bf16x8, pw); } \
    SBAR(); \
    if ((has_next2_) && VAR != 3 && VAR != 4) { _Pragma("unroll") for (int ks = 0; ks < 4; ++ks) kf[ks] = *(const bf16x8*)(kq2[ks] + (kso2_)); } \
    if (has_next_) { \
      const int dmin_ = (knext_) - (qlo + 31), dmax_ = (knext_) + 31 - qlo; \
      if (dmin_ < 559) { \
        if (in_after) { in_after = false; _Pragma("unroll") for (int nb = 0; nb < 4; ++nb) _Pragma("unroll") for (int r = 0; r < 16; ++r) O[nb][r] *= fAfter; l *= fAfter; \
                        _Pragma("unroll") for (int s2 = 0; s2 < 2; ++s2) {   \
                          u32x4 pw; pw[0] = pk2(A[8 * s2 + 0] * fAfter, A[8 * s2 + 1] * fAfter); pw[1] = pk2(A[8 * s2 + 2] * fAfter, A[8 * s2 + 3] * fAfter); \
                          pw[2] = pk2(A[8 * s2 + 4] * fAfter, A[8 * s2 + 5] * fAfter); pw[3] = pk2(A[8 * s2 + 6] * fAfter, A[8 * s2 + 7] * fAfter); \
                          pb[s2] = __builtin_bit_cast(bf16x8, pw); } } \
        if (dmax_ > -559) { const int base_ = (knext_) + 4 * h - qpos + 640; \
          _Pragma("unroll") for (int r = 0; r < 16; ++r) B[r] += tab[base_ + (r & 3) + 8 * (r >> 2)]; } } } \
    _Pragma("unroll") for (int f = 0; f < 8; ++f) { \
      if (VAR != 2 && VAR != 4) { O[f >> 1] = MFMA32(cat8(vlo[f & 3], vhi[f & 3]), pb[f & 1], O[f >> 1]); \
      if (f + 4 < 8) DU_VRD(f & 3, f + 4, vso_); } \
      if (VAR != 1 && VAR != 4) { B[2 * f] = __builtin_amdgcn_exp2f(B[2 * f]); B[2 * f + 1] = __builtin_amdgcn_exp2f(B[2 * f + 1]); } } \
  } while (0)
  f32x16 X, Y; bf16x8 kf[4];
  const float fAfter = __builtin_amdgcn_exp2f(cAfter);
  bool in_after = true;
  const int KT1 = NKT - 1;
  DU_DMA(KT1, 0);
  if (NKT > 1) DU_DMA(KT1 - 1, 1);
  asm volatile("s_waitcnt vmcnt(0)" ::: "memory");
  __syncthreads();
  {
    const unsigned char* kb_ = lds + AL_STAGE + map * 8192 + 4096;
    f32x16 z_;
#pragma unroll
    for (int r = 0; r < 16; ++r) z_[r] = 0.f;
    X = MFMA32(*(const bf16x8*)(kb_ + kbase4[0]), qf[0], z_); X = MFMA32(*(const bf16x8*)(kb_ + kbase4[1]), qf[1], X);
    X = MFMA32(*(const bf16x8*)(kb_ + kbase4[2]), qf[2], X); X = MFMA32(*(const bf16x8*)(kb_ + kbase4[3]), qf[3], X);
    const int knext = 64 * KT1 + 32;
    const int dmin_ = knext - (qlo + 31), dmax_ = knext + 31 - qlo;
    if (dmin_ < 559) {
      in_after = false;
      if (dmax_ > -559) { const int base_ = knext + 4 * h - qpos + 640;
#pragma unroll
        for (int r = 0; r < 16; ++r) X[r] += tab[base_ + (r & 3) + 8 * (r >> 2)]; }
    }
#pragma unroll
    for (int r = 0; r < 16; ++r) X[r] = __builtin_amdgcn_exp2f(X[r]);
#pragma unroll
    for (int ks = 0; ks < 4; ++ks) kf[ks] = *(const bf16x8*)(lds + AL_STAGE + map * 8192 + kbase4[ks]);
  }
  int st_cur = 0, st_nxt = 32768, st_free = 65536;
  for (int i = 0; i < NKT; ++i) {
    const int kt = KT1 - i;
    asm volatile("s_waitcnt vmcnt(0)" ::: "memory");
    __syncthreads();
    if (i + 2 < NKT) DU_DMA(kt - 2, st_free / 32768);
    const unsigned char* knx[4]; const unsigned char* vp[4][2];
#pragma unroll
    for (int ks = 0; ks < 4; ++ks) knx[ks] = lds + AL_STAGE + st_nxt + map * 8192 + kbase4[ks];
#pragma unroll
    for (int nb = 0; nb < 4; ++nb) { vp[nb][0] = lds + AL_STAGE + st_cur + 16384 + vbase[nb][0]; vp[nb][1] = lds + AL_STAGE + st_cur + 16384 + vbase[nb][1]; }
    DU_SUB(X, Y, knx, 4096, (i + 1 < NKT), 8192, 64 * kt, true);
    DU_SUB(Y, X, knx, 0, (i + 1 < NKT), 0, 64 * kt - 32, (i + 1 < NKT));
    { const int t_ = st_cur; st_cur = st_nxt; st_nxt = st_free; st_free = t_; }
  }
#undef DU_DMA
#undef DU_GLDS
#undef DU_VRD
#undef DU_SUB
#undef SBAR
  if (in_after) {
#pragma unroll
    for (int nb = 0; nb < 4; ++nb)
#pragma unroll
      for (int r = 0; r < 16; ++r) O[nb][r] *= fAfter;
    l *= fAfter;
  }
  if (VAR != 0) {
#pragma unroll
    for (int nb = 0; nb < 4; ++nb) asm volatile("" :: "v"(O[nb]));
    asm volatile("" :: "v"(l), "v"(X), "v"(Y));
    __syncthreads();
    return;
  }
  __syncthreads();
  float ltot = l + __shfl_xor(l, 32);
  float* xbuf = (float*)(lds + AL_STAGE);
  if (map == 1) {
    const float inv = 1.0f / ltot;
#pragma unroll
    for (int nb = 0; nb < 4; ++nb)
#pragma unroll
      for (int r = 0; r < 16; ++r) xbuf[((wq * 64 + nb * 16 + r) << 6) + lane] = O[nb][r] * inv;
  }
  __syncthreads();
  if (map == 0) {
    const float inv = 1.0f / ltot;
    float ss = 0.f;
#pragma unroll
    for (int nb = 0; nb < 4; ++nb)
#pragma unroll
      for (int r = 0; r < 16; ++r) {
        float o = O[nb][r] * inv - lam * xbuf[((wq * 64 + nb * 16 + r) << 6) + lane];
        O[nb][r] = o; ss += o * o;
      }
    ss += __shfl_xor(ss, 32);
    const float rn = __builtin_amdgcn_rsqf(ss * (1.0f / 128.0f) + NORM_EPS) * 0.8f;
    u16* mix = (u16*)((unsigned char*)p.out + OUT_MIX) + (size_t)(seq_start + qpos) * 1024 + 512 + hd * 128;
#pragma unroll
    for (int nb = 0; nb < 4; ++nb)
#pragma unroll
      for (int g4 = 0; g4 < 4; ++g4) {
        const int d0 = 32 * nb + 8 * g4 + 4 * h;
        f32x4 gg = *(const f32x4*)(p.diff_norm_g + d0);
        u32x2 o; o[0] = pk2(O[nb][4 * g4 + 0] * rn * gg[0], O[nb][4 * g4 + 1] * rn * gg[1]);
        o[1] = pk2(O[nb][4 * g4 + 2] * rn * gg[2], O[nb][4 * g4 + 3] * rn * gg[3]);
        *(u32x2*)(mix + d0) = o;
      }
  }
  __syncthreads();
}

DI void dilated_item(const Params& p, unsigned char* lds, int seq_start, int S, int hd, int c, int mblk) {
  const int tid = threadIdx.x, lane = tid & 63, r32 = lane & 31, h = lane >> 5;
  const int w = __builtin_amdgcn_readfirstlane(tid >> 6);
  const u16* QAp = (const u16*)(p.ws + WS_R + 0 * R_REGION);
  const u16* KAp = (const u16*)(p.ws + WS_R + 1 * R_REGION);
  const u16* VAp = (const u16*)(p.ws + WS_R + 2 * R_REGION);
  const int qpos = c + 16 * (32 * mblk + r32);
  const u16* Qp = QAp + (size_t)seq_start * 512 + ((size_t)hd * S + qpos) * 64;
  bf16x8 qf[4];
#pragma unroll
  for (int ks = 0; ks < 4; ++ks) qf[ks] = *(const bf16x8*)(Qp + ks * 16 + h * 8);
  const u16* Kg = KAp + (size_t)seq_start * 512 + ((size_t)hd * S) * 64;
  const u16* Vg = VAp + (size_t)seq_start * 512 + ((size_t)hd * S) * 64;
  unsigned char* vt = lds + AL_VT + w * 4096;
  const float* tabA = (const float*)(lds + AL_TABA) + hd * 3 * 132;
  f32x16 O[2];
#pragma unroll
  for (int nb = 0; nb < 2; ++nb)
#pragma unroll
    for (int r = 0; r < 16; ++r) O[nb][r] = 0.f;
  float l = 0.f;
  const int i16 = lane & 15, tq = i16 >> 2, tp = i16 & 3, blk = (lane >> 4) & 1;
  const int wsw = (((r32 >> 1) & 1) << 2) ^ ((r32 >> 2) & 3);
  int vrb[2][2];
#pragma unroll
  for (int nb = 0; nb < 2; ++nb)
#pragma unroll
    for (int hi = 0; hi < 2; ++hi) {
      const int R = 4 * h + tq + 8 * hi; const int ch = 4 * nb + 2 * blk + (tp >> 1);
      const int sw = (((R >> 1) & 1) << 2) ^ ((R >> 2) & 3);
      vrb[nb][hi] = R * 128 + ((ch ^ sw) << 4) + 8 * (tp & 1);
    }
  bf16x8 kfb[3][4]; u32x4 vcb[3][4];
#define DL_PARAMS(tau_) \
    const int d_ = ((tau_) < 5) ? 16 : ((tau_) < 13) ? 4 : 1; const int br_ = ((tau_) < 5) ? 0 : ((tau_) < 13) ? 1 : 2; \
    const int tt_ = ((tau_) < 5) ? (tau_) : ((tau_) < 13) ? (tau_) - 5 : (tau_) - 13; const int ratio_ = 16 / d_; \
    const int n0_ = ratio_ * 32 * mblk - 64 + 32 * tt_;
#define DL_LOAD(buf, tau_) do { DL_PARAMS(tau_) int kpos_ = c + d_ * (n0_ + r32); kpos_ = kpos_ < 0 ? 0 : (kpos_ >= S ? S - 1 : kpos_); \
    _Pragma("unroll") for (int ks = 0; ks < 4; ++ks) { kfb[buf][ks] = *(const bf16x8*)(Kg + (size_t)kpos_ * 64 + ks * 16 + h * 8); \
      vcb[buf][ks] = *(const u32x4*)(Vg + (size_t)kpos_ * 64 + (2 * ks + h) * 8); } (void)br_; } while (0)
#define DL_COMPUTE(buf, tau_) do { DL_PARAMS(tau_) \
    const int kfirst_ = c + d_ * n0_, klast_ = c + d_ * (n0_ + 31); \
    _Pragma("unroll") for (int ks = 0; ks < 4; ++ks) *(u32x4*)(vt + r32 * 128 + (((2 * ks + h) ^ wsw) << 4)) = vcb[buf][ks]; \
    const int nq_ = ratio_ * (32 * mblk + r32); const int base_ = n0_ + 4 * h - nq_; const float* tb_ = tabA + br_ * 132; \
    f32x16 sT; \
    _Pragma("unroll") for (int r = 0; r < 16; ++r) { int dl = base_ + (r & 3) + 8 * (r >> 2); dl = dl < -65 ? -65 : (dl > 65 ? 65 : dl); sT[r] = tb_[dl + 65]; } \
    if (kfirst_ < 0 || klast_ >= S) { _Pragma("unroll") for (int r = 0; r < 16; ++r) { const int kp = c + d_ * (n0_ + crow(r, h)); if (kp < 0 || kp >= S) sT[r] = NEG_BIG; } } \
    _Pragma("unroll") for (int ks = 0; ks < 4; ++ks) sT = MFMA32(kfb[buf][ks], qf[ks], sT); \
    float ls = 0.f; \
    _Pragma("unroll") for (int r = 0; r < 16; ++r) { sT[r] = __builtin_amdgcn_exp2f(sT[r]); ls += sT[r]; } \
    l += ls; \
    bf16x8 pb[2]; \
    _Pragma("unroll") for (int s2 = 0; s2 < 2; ++s2) { \
      u32x4 pw; pw[0] = pk2(sT[8 * s2 + 0], sT[8 * s2 + 1]); pw[1] = pk2(sT[8 * s2 + 2], sT[8 * s2 + 3]); \
      pw[2] = pk2(sT[8 * s2 + 4], sT[8 * s2 + 5]); pw[3] = pk2(sT[8 * s2 + 6], sT[8 * s2 + 7]); \
      pb[s2] = __builtin_bit_cast(bf16x8, pw); } \
    _Pragma("unroll") for (int nb = 0; nb < 2; ++nb) _Pragma("unroll") for (int s2 = 0; s2 < 2; ++s2) { \
        const s16x4 lo = tr_read(vt + vrb[nb][0] + s2 * 2048); const s16x4 hi = tr_read(vt + vrb[nb][1] + s2 * 2048); \
        O[nb] = MFMA32(cat8(lo, hi), pb[s2], O[nb]); } \
  } while (0)
  DL_LOAD(0, 0); DL_LOAD(1, 1);
#pragma unroll 1
  for (int t3 = 0; t3 < 33; t3 += 3) {
    { const int tn = (t3 + 2 < 33) ? t3 + 2 : 32; DL_LOAD(2, tn); }
    DL_COMPUTE(0, t3);
    { const int tn = (t3 + 3 < 33) ? t3 + 3 : 32; DL_LOAD(0, tn); }
    DL_COMPUTE(1, t3 + 1);
    { const int tn = (t3 + 4 < 33) ? t3 + 4 : 32; DL_LOAD(1, tn); }
    DL_COMPUTE(2, t3 + 2);
  }
#undef DL_PARAMS
#undef DL_LOAD
#undef DL_COMPUTE
  const float ltot = l + __shfl_xor(l, 32);
  const float inv = 1.0f / ltot;
  u16* mix = (u16*)((unsigned char*)p.out + OUT_MIX) + (size_t)(seq_start + qpos) * 1024 + hd * 64;
#pragma unroll
  for (int nb = 0; nb < 2; ++nb)
#pragma unroll
    for (int g4 = 0; g4 < 4; ++g4) {
      const int d0 = 32 * nb + 8 * g4 + 4 * h;
      u32x2 o; o[0] = pk2(O[nb][4 * g4 + 0] * inv, O[nb][4 * g4 + 1] * inv); o[1] = pk2(O[nb][4 * g4 + 2] * inv, O[nb][4 * g4 + 3] * inv);
      *(u32x2*)(mix + d0) = o;
    }
}

DI void phase_attn(const Params& p, unsigned char* lds) {
  const int tid = threadIdx.x;
  float* misc = (float*)(lds + AL_MISC);
  if (tid == 0) {
    float gqa = 0.f, gka = 0.f, gqb = 0.f, gkb = 0.f, bm = 0.f;
    for (int i = 0; i < 64; ++i) { gqa = fmaxf(gqa, fabsf(p.q_norm_a[i])); gka = fmaxf(gka, fabsf(p.k_norm_a[i])); gqb = fmaxf(gqb, fabsf(p.q_norm_b[i])); gkb = fmaxf(gkb, fabsf(p.k_norm_b[i])); }
    for (int i = 0; i < 32 * 12; ++i) bm = fmaxf(bm, fabsf(p.rel_bias[i]));
    const float M2 = 8.0f * LOG2E * fmaxf(gqa * gka, gqb * gkb) * 1.02f + bm * LOG2E + 0.1f;
    float s1 = 0.f, s2 = 0.f;
    for (int i = 0; i < 64; ++i) { s1 += p.lq1[i] * p.lk1[i]; s2 += p.lq2[i] * p.lk2[i]; }
    misc[0] = M2; misc[1] = expf(s1) - expf(s2) + 0.2f;
    for (int hd = 0; hd < 4; ++hd) { misc[8 + hd] = p.rel_bias[15 * 12 + 8 + hd] * LOG2E; misc[12 + hd] = (p.rel_bias[31 * 12 + 8 + hd] - p.rel_bias[15 * 12 + 8 + hd]) * LOG2E; }
  }
  __syncthreads();
  const float M2 = misc[0], lam = misc[1];
  {
    float* tabA = (float*)(lds + AL_TABA);
    for (int i = tid; i < 8 * 3 * 132; i += NTHR) {
      int hd = i / 396, rem = i % 396, br = rem / 132, idx = rem % 132;
      int dl = idx - 65; float v = NEG_BIG;
      if (dl >= -64 && dl <= 64 && idx < 131) { int d = (br == 0) ? 16 : (br == 1) ? 4 : 1; v = p.rel_bias[rel_bucket(dl * d) * 12 + hd] * LOG2E - M2; }
      tabA[i] = v;
    }
  }
#ifndef REP_DIFF
#define REP_DIFF 1
#endif
#ifndef REP_DIL
#define REP_DIL 1
#endif
  int cur_hd = -1;
  for (int rep_ = 0; rep_ < REP_DIFF; ++rep_)
  for (int vb = blockIdx.x; vb < 256; vb += gridDim.x) {
    const int xl = vb & 7, rk = vb >> 3;
#pragma unroll 1
    for (int rnd = 0; rnd < 8; ++rnd) {
      int seq_start, S, hd, q0;
      if (rnd < 4) { const int pair = xl + 8 * rnd; hd = pair & 3; S = 4096; seq_start = (pair >> 2) * 4096; q0 = rk * 128; }
      else { const int pair = 8 * xl + 2 * (rnd - 4) + (rk >> 4); hd = pair & 3; S = 2048; seq_start = T_PROMPT + (pair >> 2) * 2048; q0 = (rk & 15) * 128; }
      if (hd != cur_hd) {
        __syncthreads();
        float* tab = (float*)(lds + AL_TAB);
        for (int i = tid; i < 1281; i += NTHR) tab[i] = p.rel_bias[rel_bucket(i - 640) * 12 + 8 + hd] * LOG2E - misc[8 + hd];
        cur_hd = hd;
        __syncthreads();
      }
#ifndef PROBE_VAR
#define PROBE_VAR 0
#endif
      if (rep_ == 0) diff_unit<0>(p, lds, seq_start, S, hd, q0, lam); else diff_unit<PROBE_VAR>(p, lds, seq_start, S, hd, q0, lam);
    }
  }
  __syncthreads();
  const int w = tid >> 6;
  for (int rep_ = 0; rep_ < REP_DIL; ++rep_)
  for (int vb = blockIdx.x; vb < 256; vb += gridDim.x)
#pragma unroll 1
  for (int rnd = 0; rnd < 8; ++rnd) {
    const int xl = vb & 7, wv = (vb >> 3) * 8 + w;
    int seq_start, S, hd, c, mblk;
    if (rnd < 4) { const int pair = xl * 8 + rnd * 2 + (wv >> 7); const int itm = wv & 127; hd = pair & 7; S = 4096; seq_start = (pair >> 3) * 4096; c = itm >> 3; mblk = itm & 7; }
    else { const int pair = xl * 16 + (rnd - 4) * 4 + (wv >> 6); const int itm = wv & 63; hd = pair & 7; S = 2048; seq_start = T_PROMPT + (pair >> 3) * 2048; c = itm >> 2; mblk = itm & 3; }
    dilated_item(p, lds, seq_start, S, hd, c, mblk);
  }
}

struct EpiOut {
  static constexpr bool PERM = false, AFTER_DRAIN = false, HEADPERM = false;
  const float* xp; const float* xs; float* x1;
  __device__ __forceinline__ void operator()(const pg8::f32x4 (&acc)[2][2][4][2], const pg8::Unit& u, int wr, int wc, int fr, int fq) const {
    const int col0 = u.pn * 256 + wc * 32 + 4 * fq;
#pragma unroll
    for (int ai = 0; ai < 2; ++ai)
#pragma unroll
      for (int m = 0; m < 4; ++m) {
        const int t = u.pm * 256 + ai * 128 + wr * 64 + m * 16 + fr;
        const float* xr = ((t < T_PROMPT) ? xp + (size_t)t * DM : xs + (size_t)(t - T_PROMPT) * DM) + col0;
        float* orow = x1 + (size_t)t * DM + col0;
#pragma unroll
        for (int bj = 0; bj < 2; ++bj)
#pragma unroll
          for (int n = 0; n < 2; ++n) {
            const f32x4 xv = *(const f32x4*)(xr + bj * 128 + n * 16);
            *(f32x4*)(orow + bj * 128 + n * 16) = xv + acc[ai][bj][m][n];
          }
      }
  }
};

DI void phase_outproj(const Params& p, unsigned char* lds) {
  pg8::Gemm g{(const u16*)((const unsigned char*)p.out + OUT_MIX), (const u16*)(p.ws + WS_WOUT), T_TOK, 1024, 1024};
  pg8::StaticOrder S; S.init(T_TOK, 1024, (int)gridDim.x, (int)blockIdx.x);
  EpiOut E{p.x_prompt, p.x_sample, (float*)(p.ws + WS_X1)};
  pg8::gemm_phase<EpiOut, pg8::StaticOrder, true, true>((PG8_LAS unsigned char*)lds, g, S, E);
}

DI void phase_norm2(const Params& p) {
  const int tid = threadIdx.x, lane = tid & 63, w = tid >> 6;
  const float* x1 = (const float*)(p.ws + WS_X1);
  u16* hb = (u16*)(p.ws + WS_H);
  for (int it = blockIdx.x; it < T_TOK / 8; it += gridDim.x) {
    int t = it * 8 + w;
    norm_row(x1 + (size_t)t * DM, p.ffn_norm_g, hb + (size_t)t * DM, lane);
  }
}

struct EpiQp {
  static constexpr bool PERM = true, AFTER_DRAIN = false, HEADPERM = false;
  u16* O;
  __device__ __forceinline__ void operator()(const pg8::f32x4 (&acc)[2][2][4][2], const pg8::Unit& u, int wr, int wc, int fr, int fq) const {
    const int col0 = u.pn * 256 + wc * 32 + 8 * fq;
#pragma unroll
    for (int ai = 0; ai < 2; ++ai)
#pragma unroll
      for (int m = 0; m < 4; ++m) {
        const int t = u.pm * 256 + ai * 128 + wr * 64 + m * 16 + fr;
        u16* rowp = O + (size_t)t * 2048 + col0;
#pragma unroll
        for (int bj = 0; bj < 2; ++bj) {
          const f32x4 v0 = acc[ai][bj][m][0], v1 = acc[ai][bj][m][1];
          u32x4 o; o[0] = pk2(v0[0], v0[1]); o[1] = pk2(v0[2], v0[3]); o[2] = pk2(v1[0], v1[1]); o[3] = pk2(v1[2], v1[3]);
          *(u32x4*)(rowp + bj * 128) = o;
        }
      }
  }
};

DI void phase_peer_query(const Params& p, unsigned char* lds) {
  pg8::Gemm g{(const u16*)(p.ws + WS_H), (const u16*)(p.ws + WS_WQ), T_TOK, 2048, 1024};
  pg8::StaticOrder S; S.init(T_TOK, 2048, (int)gridDim.x, (int)blockIdx.x);
  EpiQp E{(u16*)p.out};
  pg8::gemm_phase<EpiQp, pg8::StaticOrder, true, true>((PG8_LAS unsigned char*)lds, g, S, E);
}

DI int f2sort(float f) { const int b = __float_as_int(f); return b ^ ((b >> 31) & 0x7fffffff); }
DI float sort2f(int s) { return __int_as_float(s ^ ((s >> 31) & 0x7fffffff)); }
#define CE_DESC(a, b) do { const int mx_ = max((a), (b)), mn_ = min((a), (b)); (a) = mx_; (b) = mn_; } while (0)
#define CE_ASC(a, b) do { const int mx_ = max((a), (b)), mn_ = min((a), (b)); (a) = mn_; (b) = mx_; } while (0)
template <int OFF> DI void sort16_desc(int (&x)[64]) {
#pragma unroll
  for (int k = 2; k <= 16; k <<= 1)
#pragma unroll
    for (int j = k >> 1; j > 0; j >>= 1)
#pragma unroll
      for (int i = 0; i < 16; ++i) {
        const int l = i ^ j;
        if (l > i) { if ((i & k) == 0) CE_DESC(x[OFF + i], x[OFF + l]); else CE_ASC(x[OFF + i], x[OFF + l]); }
      }
}
template <int A, int B> DI void merge16x(int (&x)[64]) {
#pragma unroll
  for (int i = 0; i < 16; ++i) x[A + i] = max(x[A + i], x[B + 15 - i]);
#pragma unroll
  for (int j = 8; j > 0; j >>= 1)
#pragma unroll
    for (int i = 0; i < 16; ++i) { const int l = i ^ j; if (l > i) CE_DESC(x[A + i], x[A + l]); }
}

DI void phase_peer_route(const Params& p, unsigned char* lds) {
  const u16* QP = (const u16*)p.out;
  const u16* SK = (const u16*)(p.ws + WS_SK);
  u16* eidx = (u16*)(p.ws + WS_EIDX);
  float* gg = (float*)(p.ws + WS_G);
  const int tid = threadIdx.x, lane = tid & 63, r32 = lane & 31, h = lane >> 5;
  const int w = __builtin_amdgcn_readfirstlane(tid >> 6);
  unsigned char* SKl = lds;
  float* v2l = (float*)(lds + 65536);
  __syncthreads();
#pragma unroll
  for (int i = 0; i < 8; ++i) {
    const int c = tid + 512 * i; const int zz = c >> 11, row = (c >> 4) & 127, ch = c & 15;
    const u32x4 v = *(const u32x4*)(SK + (size_t)zz * 16384 + row * 128 + ch * 8);
    *(u32x4*)(SKl + zz * 32768 + row * 256 + ((ch ^ (row & 15)) << 4)) = v;
  }
  __syncthreads();
  for (int item = blockIdx.x; item < T_TOK / 256; item += gridDim.x) {
    const int t = item * 256 + w * 32 + r32;
    const u16* qrow = QP + (size_t)t * 2048;
#pragma unroll 1
    for (int pp = 0; pp < 8; ++pp) {
      int lists[2][16];
#pragma unroll
      for (int z = 0; z < 2; ++z) {
        const int c16 = pp * 2 + z;
        int x[64];
        {
          bf16x8 qf[8];
#pragma unroll
          for (int ks = 0; ks < 8; ++ks) qf[ks] = *(const bf16x8*)(qrow + c16 * 128 + ks * 16 + h * 8);
          f32x16 S2[4];
#pragma unroll
          for (int kb = 0; kb < 4; ++kb)
#pragma unroll
            for (int r = 0; r < 16; ++r) S2[kb][r] = 0.f;
#pragma unroll
          for (int ks = 0; ks < 8; ++ks)
#pragma unroll
            for (int kb = 0; kb < 4; ++kb) {
              const int key = kb * 32 + r32;
              const bf16x8 a = *(const bf16x8*)(SKl + z * 32768 + key * 256 + (((2 * ks + h) ^ (key & 15)) << 4));
              S2[kb] = MFMA32(a, qf[ks], S2[kb]);
            }
#pragma unroll
          for (int e = 0; e < 64; ++e) {
            const int kidx = 32 * (e >> 4) + (e & 3) + 8 * ((e & 15) >> 2) + 4 * h;
            x[e] = (f2sort(S2[e >> 4][e & 15]) & ~127) | kidx;
          }
        }
        sort16_desc<0>(x); sort16_desc<16>(x); sort16_desc<32>(x); sort16_desc<48>(x);
        merge16x<0, 16>(x); merge16x<32, 48>(x); merge16x<0, 32>(x);
#pragma unroll
        for (int i = 0; i < 16; ++i) x[16 + i] = __shfl_xor(x[i], 32);
        merge16x<0, 16>(x);
#pragma unroll
        for (int i = 0; i < 16; ++i) lists[z][i] = x[i];
      }
      float v1[16];
#pragma unroll
      for (int i = 0; i < 16; ++i) { v1[i] = sort2f(lists[0][i]); v2l[i * 512 + tid] = sort2f(lists[1][i]); }
      unsigned long long ptrs = 0ull;
      float bestv[16]; int be[16];
#pragma unroll
      for (int rd = 0; rd < 16; ++rd) {
        float best = -3.0e38f, bv1 = 0.f, bv2 = 0.f; int ab = 0;
#pragma unroll
        for (int a = 0; a < 16; ++a) {
          const int b = (int)((ptrs >> (4 * a)) & 15ull);
          const float v2 = v2l[b * 512 + tid];
          const float cnd = v1[a] + v2;
          if (cnd > best) { best = cnd; ab = a; bv1 = v1[a]; bv2 = v2; }
        }
        bestv[rd] = best; be[rd] = (f2sort(bv1) & 127) * 128 + (f2sort(bv2) & 127);
        ptrs += 1ull << (4 * ab);
      }
      if (h == 0) {
        float ex[16]; float sum = 0.f;
#pragma unroll
        for (int rd = 0; rd < 16; ++rd) { ex[rd] = __expf(bestv[rd] - bestv[0]); sum += ex[rd]; }
        const float inv = 1.0f / sum;
        const size_t oo = ((size_t)t * 8 + pp) * 16;
#pragma unroll
        for (int q4 = 0; q4 < 4; ++q4) { f32x4 v = {ex[4 * q4] * inv, ex[4 * q4 + 1] * inv, ex[4 * q4 + 2] * inv, ex[4 * q4 + 3] * inv}; *(f32x4*)(gg + oo + 4 * q4) = v; }
        u32x4 e0, e1;
#pragma unroll
        for (int j = 0; j < 4; ++j) { e0[j] = (unsigned)be[2 * j] | ((unsigned)be[2 * j + 1] << 16); e1[j] = (unsigned)be[8 + 2 * j] | ((unsigned)be[8 + 2 * j + 1] << 16); }
        *(u32x4*)(eidx + oo) = e0; *(u32x4*)(eidx + oo + 8) = e1;
      }
    }
  }
}

typedef float f2_t __attribute__((ext_vector_type(2)));
DI unsigned xcc_id() { return (unsigned)__builtin_amdgcn_s_getreg((3 << 11) | 20) & 7u; }
constexpr int PG_CHUNK_TOK = 64;
constexpr int PG_NCHUNK = T_TOK / PG_CHUNK_TOK;

DI void dec16(const u32x4& r, f2_t (&v)[8]) {
#pragma unroll
  for (int d = 0; d < 4; ++d) { v[2 * d] = __builtin_amdgcn_cvt_pk_f32_fp8((int)r[d], false); v[2 * d + 1] = __builtin_amdgcn_cvt_pk_f32_fp8((int)r[d], true); }
}

template <int WHICH>
DI void peer_wave_tokens(const Params& p, int x, int tb, int lane) {
  const unsigned char* TBL = p.ws + (WHICH ? WS_V : WS_U) + (size_t)x * 16384 * 128;
  const u16* Hb = (const u16*)(p.ws + WS_H);
  const u16* eidx = (const u16*)(p.ws + WS_EIDX);
  const float* wg = (const float*)(p.ws + WS_G);
  const float* x1 = (const float*)(p.ws + WS_X1);
  float* zpart = (float*)p.out;
  const int r = lane >> 3, c = lane & 7;
  int elo[8], ehi[8]; float wlo[8], whi[8];
#pragma unroll
  for (int k = 0; k < 8; ++k) {
    elo[k] = eidx[(size_t)(tb + k) * 128 + lane]; ehi[k] = eidx[(size_t)(tb + k) * 128 + 64 + lane];
    if (WHICH) { wlo[k] = wg[(size_t)(tb + k) * 128 + lane]; whi[k] = wg[(size_t)(tb + k) * 128 + 64 + lane]; }
  }
  u32x4 rows[2][16];
#define PEER_LOAD_ROWS(buf, k) do { _Pragma("unroll") for (int i = 0; i < 16; ++i) { \
      const int e_ = __shfl((i < 8) ? elo[k] : ehi[k], (i & 7) * 8 + r); \
      rows[buf][i] = *(const u32x4*)(TBL + (size_t)e_ * 128 + c * 16); } } while (0)
  PEER_LOAD_ROWS(0, 0);
#pragma unroll
  for (int k = 0; k < 8; ++k) {
    const int t = tb + k;
    if (k + 1 < 8) PEER_LOAD_ROWS((k + 1) & 1, k + 1);
    if (WHICH == 0) {
      u32x4 ha = *(const u32x4*)(Hb + (size_t)t * DM + x * 128 + c * 16), hb = *(const u32x4*)(Hb + (size_t)t * DM + x * 128 + c * 16 + 8);
      f2_t hq[8];
#pragma unroll
      for (int j = 0; j < 4; ++j) {
        hq[j][0] = __uint_as_float(ha[j] << 16); hq[j][1] = __uint_as_float(ha[j] & 0xffff0000u);
        hq[4 + j][0] = __uint_as_float(hb[j] << 16); hq[4 + j][1] = __uint_as_float(hb[j] & 0xffff0000u);
      }
      float sv[16];
#pragma unroll
      for (int i = 0; i < 16; ++i) {
        f2_t v[8]; dec16(rows[k & 1][i], v);
        f2_t a = v[0] * hq[0];
#pragma unroll
        for (int q = 1; q < 8; ++q) a = __builtin_elementwise_fma(v[q], hq[q], a);
        sv[i] = a[0] + a[1];
      }
#pragma unroll
      for (int o = 1; o < 8; o <<= 1) {
#pragma unroll
        for (int i = 0; i < 16; ++i) sv[i] += __shfl_xor(sv[i], o);
      }
      float o0 = 0.f, o1 = 0.f;
#pragma unroll
      for (int i = 0; i < 8; ++i) { if (c == i) { o0 = sv[i]; o1 = sv[i + 8]; } }
      float* zp = zpart + ((size_t)x * T_TOK + t) * 128;
      zp[c * 8 + r] = o0; zp[(c + 8) * 8 + r] = o1;
    } else {
      f2_t acc[8];
#pragma unroll
      for (int q = 0; q < 8; ++q) { acc[q][0] = 0.f; acc[q][1] = 0.f; }
#pragma unroll
      for (int i = 0; i < 16; ++i) {
        f2_t v[8]; dec16(rows[k & 1][i], v);
        const float wj = __shfl((i < 8) ? wlo[k] : whi[k], (i & 7) * 8 + r);
        f2_t ww = {wj, wj};
#pragma unroll
        for (int q = 0; q < 8; ++q) acc[q] = __builtin_elementwise_fma(v[q], ww, acc[q]);
      }
      f2_t b4[4];
      {
        const bool up = (lane & 32) != 0;
#pragma unroll
        for (int q = 0; q < 4; ++q) {
          f2_t keep = up ? acc[4 + q] : acc[q], send = up ? acc[q] : acc[4 + q];
          f2_t got; got[0] = __shfl_xor(send[0], 32); got[1] = __shfl_xor(send[1], 32);
          b4[q] = keep + got;
        }
      }
      f2_t b2[2];
      {
        const bool up = (lane & 16) != 0;
#pragma unroll
        for (int q = 0; q < 2; ++q) {
          f2_t keep = up ? b4[2 + q] : b4[q], send = up ? b4[q] : b4[2 + q];
          f2_t got; got[0] = __shfl_xor(send[0], 16); got[1] = __shfl_xor(send[1], 16);
          b2[q] = keep + got;
        }
      }
      f2_t b1;
      {
        const bool up = (lane & 8) != 0;
        f2_t keep = up ? b2[1] : b2[0], send = up ? b2[0] : b2[1];
        f2_t got; got[0] = __shfl_xor(send[0], 8); got[1] = __shfl_xor(send[1], 8);
        b1 = keep + got;
      }
      const size_t o = (size_t)t * DM + x * 128 + c * 16 + 2 * r;
      f2_t xv = *(const f2_t*)(x1 + o);
      f2_t res = xv + b1;
      *(f2_t*)(p.out + o) = res;
    }
  }
#undef PEER_LOAD_ROWS
}

template <int WHICH>
DI void phase_peer_sliced(const Params& p, unsigned char* lds) {
  const int tid = threadIdx.x, lane = tid & 63, w = tid >> 6;
  unsigned* qctr = (unsigned*)(p.ws + WS_MISC + MISC_QCTR) + WHICH * 8;
  int* bc = (int*)lds;
  const unsigned x0 = xcc_id();
  for (int si = 0; si < 8; ++si) {
    const int x = (int)((x0 + si) & 7u);
    for (;;) {
      __syncthreads();
      if (tid == 0) bc[0] = (int)atomicAdd(&qctr[x], 1u);
      __syncthreads();
      const int ch = bc[0];
      if (ch >= PG_NCHUNK) break;
      peer_wave_tokens<WHICH>(p, x, ch * PG_CHUNK_TOK + w * 8, lane);
    }
  }
}

DI void phase_peer_act(const Params& p) {
  const float* zpart = (const float*)p.out;
  const u16* eidx = (const u16*)(p.ws + WS_EIDX);
  float* wg = (float*)(p.ws + WS_G);
  const float* suinv = (const float*)(p.ws + WS_MISC + MISC_SUINV);
  const float* svinv = (const float*)(p.ws + WS_MISC + MISC_SVINV);
  for (size_t i = (size_t)blockIdx.x * NTHR + threadIdx.x; i < (size_t)T_TOK * 128; i += (size_t)gridDim.x * NTHR) {
    float z = 0.f;
#pragma unroll
    for (int x = 0; x < 8; ++x) z += zpart[(size_t)x * T_TOK * 128 + i];
    const int e = eidx[i];
    z *= suinv[e];
    const float act = 0.5f * z * (1.0f + erff(z * 0.70710678118654752f));
    wg[i] = wg[i] * act * svinv[e];
  }
}

__global__ void __launch_bounds__(NTHR, 2) fwd_kernel(Params p) {
  extern __shared__ __attribute__((aligned(16))) unsigned char lds[];
  cg::grid_group grid = cg::this_grid();
#ifndef ONLY_PH
#define PHON(k) 1
#else
#define PHON(k) ((k) == ONLY_PH)
#endif
#ifndef REPEAT_MASK
#define REPEAT_MASK 0
#endif
#define RUN_PHASE(k, call) do { if (PHON(k) && lo <= (k) && (k) < hi) { call; if ((REPEAT_MASK >> (k)) & 1) { grid.sync(); call; } } if (lo <= (k) && (k) + 1 < hi) grid.sync(); } while (0)
  const int lo = p.ph_lo, hi = p.ph_hi;
  RUN_PHASE(0, phase_prep(p, lds));
  RUN_PHASE(1, phase_proj(p, lds));
  RUN_PHASE(2, phase_attn(p, lds));
  RUN_PHASE(3, phase_outproj(p, lds));
  RUN_PHASE(4, phase_norm2(p));
  RUN_PHASE(5, phase_peer_query(p, lds));
  RUN_PHASE(6, phase_peer_route(p, lds));
  RUN_PHASE(7, phase_peer_sliced<0>(p, lds));
  RUN_PHASE(8, phase_peer_act(p));
  RUN_PHASE(9, phase_peer_sliced<1>(p, lds));
}

extern "C" void kernel_launch(void* const* d_in, const int* in_sizes, int n_in, void* d_out, int out_size, void* d_ws, size_t ws_size, hipStream_t stream) {
  static int grid_blocks = 0;
  if (grid_blocks == 0) {
    if (n_in != 20 || ws_size < WS_END || out_size != T_TOK * DM) {
      fprintf(stderr, "kernel_launch: unexpected problem shape (n_in %d, ws %zu, out %d)\n", n_in, ws_size, out_size);
      grid_blocks = -1; return;
    }
    int dev = 0, cus = 0, per_cu = 0;
    hipGetDevice(&dev);
    hipDeviceGetAttribute(&cus, hipDeviceAttributeMultiprocessorCount, dev);
    hipFuncSetAttribute((const void*)fwd_kernel, hipFuncAttributeMaxDynamicSharedMemorySize, LDS_BYTES);
    hipOccupancyMaxActiveBlocksPerMultiprocessor(&per_cu, (const void*)fwd_kernel, NTHR, LDS_BYTES);
    if (per_cu < 1) { fprintf(stderr, "kernel_launch: occupancy query says %d blocks/CU\n", per_cu); per_cu = 1; }
    grid_blocks = cus;
    (void)hipGetLastError();
  }
  if (grid_blocks < 0) return;
  Params p{};
  p.x_prompt = (const float*)d_in[0]; p.x_sample = (const float*)d_in[1]; p.rel_bias = (const float*)d_in[2]; p.attn_norm_g = (const float*)d_in[3];
  p.w_in = (const float*)d_in[4]; p.q_norm_a = (const float*)d_in[5]; p.k_norm_a = (const float*)d_in[6]; p.q_norm_b = (const float*)d_in[7];
  p.k_norm_b = (const float*)d_in[8]; p.lq1 = (const float*)d_in[9]; p.lk1 = (const float*)d_in[10]; p.lq2 = (const float*)d_in[11];
  p.lk2 = (const float*)d_in[12]; p.diff_norm_g = (const float*)d_in[13]; p.w_out = (const float*)d_in[14]; p.ffn_norm_g = (const float*)d_in[15];
  p.peer_w_q = (const float*)d_in[16]; p.peer_sub_keys = (const float*)d_in[17]; p.peer_u = (const float*)d_in[18]; p.peer_v = (const float*)d_in[19];
  p.out = (float*)d_out; p.ws = (unsigned char*)d_ws;
#if FUSED
  p.ph_lo = 0; p.ph_hi = NPHASE;
  void* args[] = {&p};
  hipError_t e = hipLaunchCooperativeKernel((const void*)fwd_kernel, dim3(grid_blocks), dim3(NTHR), args, LDS_BYTES, stream);
  if (e != hipSuccess) fprintf(stderr, "cooperative launch failed: %s (grid %d)\n", hipGetErrorString(e), grid_blocks);
#else
  for (int ph = 0; ph < NPHASE; ++ph) {
    p.ph_lo = ph; p.ph_hi = ph + 1;
    hipLaunchKernelGGL(fwd_kernel, dim3(grid_blocks), dim3(NTHR), LDS_BYTES, stream, p);
  }
#endif
}
```

```cpp
#include <hip/hip_runtime.h>
#include <hip/hip_cooperative_groups.h>
#include <cstdio>
#include <cstdint>
namespace cg = cooperative_groups;

#ifndef FUSED
#define FUSED 1
#endif

typedef unsigned short u16;
typedef __attribute__((ext_vector_type(8))) short bf16x8;
typedef __attribute__((ext_vector_type(4))) short s16x4;
typedef __attribute__((ext_vector_type(16))) float f32x16;
typedef __attribute__((ext_vector_type(4))) float f32x4;
typedef __attribute__((ext_vector_type(4))) unsigned u32x4;
typedef __attribute__((ext_vector_type(2))) unsigned u32x2;
typedef __attribute__((address_space(3))) unsigned char* ldsp_t;

#define DI __device__ __forceinline__
#define MFMA32(a, b, c) __builtin_amdgcn_mfma_f32_32x32x16_bf16((a), (b), (c), 0, 0, 0)

constexpr int DM = 1024;
constexpr int T_TOK = 65536;
constexpr int T_PROMPT = 32768;
constexpr int NTHR = 512;
constexpr int NPHASE = 10;
constexpr float NORM_EPS = 1e-6f;
constexpr float LOG2E = 1.4426950408889634f;
constexpr float C2 = 0.125f * LOG2E;
constexpr float NEG_BIG = -1.0e30f;

constexpr size_t WS_WIN  = 0;
constexpr size_t WS_WOUT = WS_WIN + (size_t)3072 * 1024 * 2;
constexpr size_t WS_WQ   = WS_WOUT + (size_t)1024 * 1024 * 2;
constexpr size_t WS_SK   = WS_WQ + (size_t)2048 * 1024 * 2;
constexpr size_t WS_U    = WS_SK + (size_t)2 * 128 * 128 * 2;
constexpr size_t WS_V    = WS_U + (size_t)16384 * 1024 * 2;
constexpr size_t WS_MISC = WS_V + (size_t)16384 * 1024 * 2;
constexpr size_t MISC_SUINV = 0, MISC_SVINV = 65536, MISC_QCTR = 131072, MISC_BAR = 196608;
constexpr size_t WS_R    = WS_MISC + (size_t)1048576;
constexpr size_t R_REGION = (size_t)T_TOK * 512 * 2;
constexpr size_t WS_X1   = WS_R;
constexpr size_t WS_H    = WS_R + (size_t)T_TOK * 1024 * 4;
constexpr size_t WS_EIDX = WS_R + 6 * R_REGION;
constexpr size_t WS_G    = WS_EIDX + (size_t)T_TOK * 128 * 2;
constexpr size_t WS_END  = WS_G + (size_t)T_TOK * 128 * 4;
static_assert(WS_END <= (size_t)536870912, "workspace map exceeds 512 MiB");
constexpr size_t OUT_N1 = 0, OUT_MIX = 134217728, OUT_TV = 0, OUT_TI = 67108864;

constexpr int LDS_BYTES = 163840;
constexpr int LDS_BARST = 163840 - 256;

struct Params {
  const float* x_prompt; const float* x_sample; const float* rel_bias; const float* attn_norm_g; const float* w_in;
  const float* q_norm_a; const float* k_norm_a; const float* q_norm_b; const float* k_norm_b;
  const float* lq1; const float* lk1; const float* lq2; const float* lk2; const float* diff_norm_g; const float* w_out;
  const float* ffn_norm_g; const float* peer_w_q; const float* peer_sub_keys; const float* peer_u; const float* peer_v;
  float* out; unsigned char* ws; int ph_lo; int ph_hi;
};

DI u16 f2bf(float f) { unsigned u = __float_as_uint(f); u += 0x7fffu + ((u >> 16) & 1u); return (u16)(u >> 16); }
DI float bf2f(u16 b) { return __uint_as_float(((unsigned)b) << 16); }
DI unsigned pk2(float lo, float hi) {
  typedef float f2_t __attribute__((ext_vector_type(2)));
  typedef __bf16 b2_t __attribute__((ext_vector_type(2)));
  f2_t v = {lo, hi}; b2_t b = __builtin_convertvector(v, b2_t); return __builtin_bit_cast(unsigned, b);
}
DI int crow(int reg, int h) { return (reg & 3) + 8 * (reg >> 2) + 4 * h; }
DI float wave_sum(float v) {
#pragma unroll
  for (int o = 32; o > 0; o >>= 1) v += __shfl_xor(v, o);
  return v;
}
DI void seq_of(int t, int& seq_start, int& S, int& s) {
  if (t < T_PROMPT) { S = 4096; seq_start = t & ~4095; s = t & 4095; }
  else { S = 2048; seq_start = t & ~2047; s = t & 2047; }
}
DI const float* x_row(const Params& p, int t) {
  return (t < T_PROMPT) ? p.x_prompt + (size_t)t * DM : p.x_sample + (size_t)(t - T_PROMPT) * DM;
}
DI int rel_bucket(int rel) {
  int n = rel < 0 ? -rel : rel;
  int b;
  if (n < 8) b = n;
  else if (n < 15) b = 8; else if (n < 27) b = 9; else if (n < 50) b = 10; else if (n < 91) b = 11;
  else if (n < 166) b = 12; else if (n < 305) b = 13; else if (n < 559) b = 14; else b = 15;
  return (rel > 0 ? 16 : 0) + b;
}
DI s16x4 tr_read(const unsigned char* p) {
  typedef short v4i16_t __attribute__((ext_vector_type(4)));
  return __builtin_bit_cast(s16x4, __builtin_amdgcn_ds_read_tr16_b64_v4i16((__attribute__((address_space(3))) v4i16_t*)p));
}
DI bf16x8 cat8(s16x4 lo, s16x4 hi) { return __builtin_shufflevector(lo, hi, 0, 1, 2, 3, 4, 5, 6, 7); }

DI void transpose_item(const float* __restrict__ src, int K, int N, u16* __restrict__ dst, int k0, int n0, unsigned char* lds) {
  float* tile = (float*)lds;
  const int tid = threadIdx.x;
#pragma unroll
  for (int i = 0; i < 8; ++i) {
    int idx = tid + 512 * i; int r = idx >> 6, c = idx & 63;
    tile[r * 65 + c] = src[(size_t)(k0 + r) * N + n0 + c];
  }
  __syncthreads();
  {
    int n = tid >> 3, kc = tid & 7;
    u32x4 o;
    o[0] = pk2(tile[(kc * 8 + 0) * 65 + n], tile[(kc * 8 + 1) * 65 + n]);
    o[1] = pk2(tile[(kc * 8 + 2) * 65 + n], tile[(kc * 8 + 3) * 65 + n]);
    o[2] = pk2(tile[(kc * 8 + 4) * 65 + n], tile[(kc * 8 + 5) * 65 + n]);
    o[3] = pk2(tile[(kc * 8 + 6) * 65 + n], tile[(kc * 8 + 7) * 65 + n]);
    *(u32x4*)(dst + (size_t)(n0 + n) * K + k0 + kc * 8) = o;
  }
  __syncthreads();
}

DI void convert_item(const float* __restrict__ src, u16* __restrict__ dst, size_t base) {
  size_t i = base + (size_t)threadIdx.x * 8;
  f32x4 a = *(const f32x4*)(src + i), b = *(const f32x4*)(src + i + 4);
  u32x4 o; o[0] = pk2(a[0], a[1]); o[1] = pk2(a[2], a[3]); o[2] = pk2(b[0], b[1]); o[3] = pk2(b[2], b[3]);
  *(u32x4*)(dst + i) = o;
}

DI void norm_row(const float* __restrict__ xr, const float* __restrict__ g, u16* __restrict__ orow, int lane) {
  f32x4 v[4]; float ss = 0.f;
#pragma unroll
  for (int i = 0; i < 4; ++i) { v[i] = *(const f32x4*)(xr + lane * 4 + 256 * i); ss += v[i][0] * v[i][0] + v[i][1] * v[i][1] + v[i][2] * v[i][2] + v[i][3] * v[i][3]; }
  ss = wave_sum(ss);
  const float r = __builtin_amdgcn_rsqf(ss * (1.0f / 1024.0f) + NORM_EPS);
#pragma unroll
  for (int i = 0; i < 4; ++i) {
    f32x4 gg = *(const f32x4*)(g + lane * 4 + 256 * i);
    u32x2 o; o[0] = pk2(v[i][0] * r * gg[0], v[i][1] * r * gg[1]); o[1] = pk2(v[i][2] * r * gg[2], v[i][3] * r * gg[3]);
    *(u32x2*)(orow + lane * 4 + 256 * i) = o;
  }
}

DI void phase_prep(const Params& p, unsigned char* lds) {
  const int nb = gridDim.x, bid = blockIdx.x, tid = threadIdx.x;
  u16* wsb = (u16*)p.ws;
  for (int it = bid; it < 768 + 256 + 512; it += nb) {
    if (it < 768) { int kt = it / 48, nt = it % 48; transpose_item(p.w_in, 1024, 3072, (u16*)(p.ws + WS_WIN), kt * 64, nt * 64, lds); }
    else if (it < 1024) { int j = it - 768; int kt = j / 16, nt = j % 16; transpose_item(p.w_out, 1024, 1024, (u16*)(p.ws + WS_WOUT), kt * 64, nt * 64, lds); }
    else { int j = it - 1024; int kt = j / 32, nt = j % 32; transpose_item(p.peer_w_q, 1024, 2048, (u16*)(p.ws + WS_WQ), kt * 64, nt * 64, lds); }
  }
  for (int it = bid; it < 8; it += nb) convert_item(p.peer_sub_keys, (u16*)(p.ws + WS_SK), (size_t)it * 4096);
  if (bid == 0 && tid < 64) ((unsigned*)(p.ws + WS_MISC + MISC_QCTR))[tid] = 0u;
  if (bid == 0) for (int i = tid; i < 3456; i += NTHR) ((unsigned*)(p.ws + WS_MISC + MISC_BAR))[i] = 0u;
  {
    const int lane_ = tid & 63, w_ = tid >> 6;
    for (int it = bid; it < 2 * 16384 / 8; it += nb) {
      const int row = it * 8 + w_;
      const int tbl = row >> 14, e = row & 16383;
      const float* src = (tbl ? p.peer_v : p.peer_u) + (size_t)e * DM + lane_ * 16;
      f32x4 a0 = *(const f32x4*)(src), a1 = *(const f32x4*)(src + 4), a2 = *(const f32x4*)(src + 8), a3 = *(const f32x4*)(src + 12);
      float am = 0.f;
#pragma unroll
      for (int j = 0; j < 4; ++j) am = fmaxf(am, fmaxf(fmaxf(fabsf(a0[j]), fabsf(a1[j])), fmaxf(fabsf(a2[j]), fabsf(a3[j]))));
#pragma unroll
      for (int o = 32; o > 0; o >>= 1) am = fmaxf(am, __shfl_xor(am, o));
      const int ex = (int)((__float_as_uint(am) >> 23) & 255u);
      float sc = 1.0f, isc = 1.0f;
      if (ex > 8 && ex < 250) { sc = __uint_as_float((unsigned)(261 - ex) << 23); isc = __uint_as_float((unsigned)(ex - 7) << 23); }
      u32x4 o;
      { int pk = __builtin_amdgcn_cvt_pk_fp8_f32(a0[0] * sc, a0[1] * sc, 0, false); pk = __builtin_amdgcn_cvt_pk_fp8_f32(a0[2] * sc, a0[3] * sc, pk, true); o[0] = (unsigned)pk; }
      { int pk = __builtin_amdgcn_cvt_pk_fp8_f32(a1[0] * sc, a1[1] * sc, 0, false); pk = __builtin_amdgcn_cvt_pk_fp8_f32(a1[2] * sc, a1[3] * sc, pk, true); o[1] = (unsigned)pk; }
      { int pk = __builtin_amdgcn_cvt_pk_fp8_f32(a2[0] * sc, a2[1] * sc, 0, false); pk = __builtin_amdgcn_cvt_pk_fp8_f32(a2[2] * sc, a2[3] * sc, pk, true); o[2] = (unsigned)pk; }
      { int pk = __builtin_amdgcn_cvt_pk_fp8_f32(a3[0] * sc, a3[1] * sc, 0, false); pk = __builtin_amdgcn_cvt_pk_fp8_f32(a3[2] * sc, a3[3] * sc, pk, true); o[3] = (unsigned)pk; }
      unsigned char* dst = p.ws + (tbl ? WS_V : WS_U) + ((size_t)(lane_ >> 3) * 16384 + e) * 128 + (lane_ & 7) * 16;
      *(u32x4*)dst = o;
      if (lane_ == 0) ((float*)(p.ws + WS_MISC + (tbl ? MISC_SVINV : MISC_SUINV)))[e] = isc;
    }
  }
  const int lane = tid & 63, w = tid >> 6;
  u16* n1 = (u16*)((unsigned char*)p.out + OUT_N1);
  for (int it = bid; it < T_TOK / 8; it += nb) {
    int t = it * 8 + w;
    norm_row(x_row(p, t), p.attn_norm_g, n1 + (size_t)t * DM, lane);
  }
  (void)wsb;
}

template <int PR, int QR>
DI void gemm_mainloop(const u16* __restrict__ P, const u16* __restrict__ Q, int K, int p0, int q0, unsigned char* lds, f32x16 (&acc)[2][2]) {
  static_assert(PR + QR == 384, "tile");
  constexpr int STAGE = 384 * 128;
  constexpr int WC = QR / 64;
  const int tid = threadIdx.x, lane = tid & 63, r32 = lane & 31, h = lane >> 5;
  const int w = __builtin_amdgcn_readfirstlane(tid >> 6);
  const int wr = w / WC, wc = w % WC;
#pragma unroll
  for (int i = 0; i < 2; ++i)
#pragma unroll
    for (int j = 0; j < 2; ++j)
#pragma unroll
      for (int r = 0; r < 16; ++r) acc[i][j][r] = 0.f;
  u32x4 stg[6];
  const u16* src[6]; int loff[6];
#pragma unroll
  for (int i = 0; i < 6; ++i) {
    int c = tid + 512 * i; int row = c >> 3, kc = c & 7;
    src[i] = (row < PR) ? P + (size_t)(p0 + row) * K + kc * 8 : Q + (size_t)(q0 + row - PR) * K + kc * 8;
    loff[i] = row * 128 + ((kc ^ ((row >> 1) & 7)) << 4);
  }
  const int KT = K / 64;
#pragma unroll
  for (int i = 0; i < 6; ++i) stg[i] = *(const u32x4*)(src[i]);
#pragma unroll
  for (int i = 0; i < 6; ++i) *(u32x4*)(lds + loff[i]) = stg[i];
  __syncthreads();
  int aoff[2], boff[2], asw[2], bsw[2];
#pragma unroll
  for (int i = 0; i < 2; ++i) {
    int ra = wr * 64 + i * 32 + r32; aoff[i] = ra * 128; asw[i] = (ra >> 1) & 7;
    int rb = PR + wc * 64 + i * 32 + r32; boff[i] = rb * 128; bsw[i] = (rb >> 1) & 7;
  }
  for (int kt = 0; kt < KT; ++kt) {
    const int buf = (kt & 1) * STAGE;
    if (kt + 1 < KT) {
#pragma unroll
      for (int i = 0; i < 6; ++i) stg[i] = *(const u32x4*)(src[i] + (kt + 1) * 64);
    }
#pragma unroll
    for (int ks = 0; ks < 4; ++ks) {
      bf16x8 a[2], b[2];
#pragma unroll
      for (int i = 0; i < 2; ++i) {
        a[i] = *(const bf16x8*)(lds + buf + aoff[i] + (((2 * ks + h) ^ asw[i]) << 4));
        b[i] = *(const bf16x8*)(lds + buf + boff[i] + (((2 * ks + h) ^ bsw[i]) << 4));
      }
#pragma unroll
      for (int i = 0; i < 2; ++i)
#pragma unroll
        for (int j = 0; j < 2; ++j) acc[i][j] = MFMA32(a[i], b[j], acc[i][j]);
    }
    if (kt + 1 < KT) {
      const int nbuf = ((kt + 1) & 1) * STAGE;
#pragma unroll
      for (int i = 0; i < 6; ++i) *(u32x4*)(lds + nbuf + loff[i]) = stg[i];
    }
    __syncthreads();
  }
}

namespace pg8 {
#define PG8_LAS __attribute__((address_space(3)))
typedef unsigned short bf16_t;
typedef short bf16x8 __attribute__((ext_vector_type(8)));
typedef float f32x4 __attribute__((ext_vector_type(4)));
typedef unsigned u32x4 __attribute__((ext_vector_type(4)));
constexpr int BM = 256, BK = 64, HALF = 128, HTB = HALF * BK * 2  , STAGE_BYTES = 8 * HTB, NXCD = 8, WGM = 8;

__host__ __device__ __forceinline__ int lds_byte(int r, int c) { const int st = (r >> 4) * 2 + (c >> 5), rr = r & 15, cc = c & 31, ob = rr * 64 + cc * 2; return st * 1024 + (ob ^ (((ob >> 9) & 1) << 5)); }
__host__ __device__ __forceinline__ void stage_rc(int b, int& R, int& C) { const int st = b / 1024, sb = b % 1024, swz = sb ^ (((sb >> 9) & 1) << 5); R = (st >> 1) * 16 + swz / 64; C = (st & 1) * 32 + (swz % 64) / 2; }
__host__ __device__ __forceinline__ int perm32(int rho) { const int n = rho >> 4, i = rho & 15; return 8 * (i >> 2) + 4 * n + (i & 3); }

struct Unit { int pm, pn; };
struct Gemm { const bf16_t* A; const bf16_t* Bt; int M, N, K; };

struct StaticOrder {
    int nM, nN, nwg, G, c;
    __host__ __device__ void init(int M, int N, int G_, int c_) { nM = M / BM; nN = N / BM; nwg = nM * nN; G = G_; c = c_; }
    __host__ __device__ bool next(int i, Unit& u) const {
        const long L = (long)i * G + c; if (L >= nwg) return false;
        int wgid = (int)L; { const int q = nwg / NXCD, r = nwg % NXCD, xcd = wgid % NXCD, off = wgid / NXCD; wgid = (xcd < r ? xcd * (q + 1) : r * (q + 1) + (xcd - r) * q) + off; }
        const int nig = WGM * nN, gid = wgid / nig, fm = gid * WGM, gsz = (nM - fm) < WGM ? (nM - fm) : WGM;
        u.pm = fm + ((wgid % nig) % gsz); u.pn = (wgid % nig) / gsz; return true;
    }
    __device__ __forceinline__ void a_ready(const Unit&) const {}
    __device__ __forceinline__ void done(const Unit&) const {}
};


template <class Epi, class Sched, bool ALIGN_EPI = false, bool SP2 = false>
__device__ __forceinline__ void gemm_phase(PG8_LAS unsigned char* lds, const Gemm g, const Sched& S, const Epi& E) {
    const int tid = threadIdx.x, wid = __builtin_amdgcn_readfirstlane(tid >> 6), lane = tid & 63, wr = wid >> 2, wc = wid & 3, fr = lane & 15, fq = lane >> 4;
    const int K = g.K, nt = K / BK;
    unsigned voffA[2], voffB[2], voffB1[2];
#pragma unroll
    for (int i = 0; i < 2; ++i) { int R, C; stage_rc(tid * 16 + i * 8192, R, C); const int Rb = Epi::PERM ? ((R & ~31) + perm32(R & 31)) : R;
        voffA[i] = (unsigned)(R * K + C) * 2u;
        if (Epi::HEADPERM) { const int Rh = 64 * (R >> 5) + perm32(R & 31); voffB[i] = (unsigned)(Rh * K + C) * 2u; voffB1[i] = (unsigned)((Rh + 32) * K + C) * 2u; }
        else { voffB[i] = (unsigned)(Rb * K + C) * 2u; voffB1[i] = (unsigned)((Rb + HALF) * K + C) * 2u; } }
    const size_t kstep = (size_t)(BK * 2);
    const size_t hstep = (size_t)HALF * K * 2;
    const size_t tstep = 2 * hstep;
    const unsigned ldsw = (unsigned)wid * 1024u;
    const int aoff = lds_byte(wr * 64 + fr, fq * 8), boff = lds_byte(wc * 32 + fr, fq * 8);
#define PG8_SA(b, h) (((b) * 2 + (h)) * HTB)
#define PG8_SB(b, h) ((4 + (b) * 2 + (h)) * HTB)
#define PG8_STAGE(bufoff, gbase, voff) do { _Pragma("unroll") for (int _i = 0; _i < 2; ++_i) \
        __builtin_amdgcn_global_load_lds((const unsigned*)((const char*)(gbase) + (voff)[_i]), (PG8_LAS unsigned*)(lds + (bufoff) + ldsw + _i * 8192), 16, 0, 0); } while (0)
#define PG8_LDA(dst, b, h) do { _Pragma("unroll") for (int m = 0; m < 4; ++m) _Pragma("unroll") for (int k = 0; k < 2; ++k) dst[m][k] = *(const PG8_LAS bf16x8*)(lds + PG8_SA(b, h) + aoff + m * 2048 + k * 1024); } while (0)
#define PG8_LDB(dst, b, h) do { _Pragma("unroll") for (int n = 0; n < 2; ++n) _Pragma("unroll") for (int k = 0; k < 2; ++k) dst[n][k] = *(const PG8_LAS bf16x8*)(lds + PG8_SB(b, h) + boff + n * 2048 + k * 1024); } while (0)
#define PG8_MMA(ai, bj, At, Bt) do { __builtin_amdgcn_s_setprio(1); _Pragma("unroll") for (int m = 0; m < 4; ++m) _Pragma("unroll") for (int n = 0; n < 2; ++n) _Pragma("unroll") for (int k = 0; k < 2; ++k) \
        acc[ai][bj][m][n] = __builtin_amdgcn_mfma_f32_16x16x32_bf16(Bt[n][k], At[m][k], acc[ai][bj][m][n], 0, 0, 0); __builtin_amdgcn_s_setprio(0); } while (0)
#define PG8_WAIT_V(n) asm volatile("s_waitcnt vmcnt(" #n ")" ::: "memory")
#define PG8_WAIT_L(n) asm volatile("s_waitcnt lgkmcnt(" #n ")" ::: "memory")
#define PG8_BAR __builtin_amdgcn_s_barrier()
#define PG8_SCHED __builtin_amdgcn_sched_barrier(0)
    Unit cur, nxt; int ui = 0;
    if (!S.next(0, cur)) return;
    f32x4 acc[2][2][4][2];
#pragma unroll
    for (int a = 0; a < 2; ++a)
#pragma unroll
        for (int b = 0; b < 2; ++b)
#pragma unroll
            for (int m = 0; m < 4; ++m)
#pragma unroll
                for (int n = 0; n < 2; ++n) acc[a][b][m][n] = (f32x4){0.f, 0.f, 0.f, 0.f};
    bf16x8 At[4][2], B0[2][2], B1[2][2];
    const char* cA = (const char*)g.A + (size_t)cur.pm * tstep; const char* cB = (const char*)g.Bt + (size_t)cur.pn * tstep;
    S.a_ready(cur);
    if constexpr (SP2) {
        PG8_STAGE(PG8_SB(0, 0), cB, voffB); PG8_STAGE(PG8_SB(0, 1), cB, voffB1); PG8_STAGE(PG8_SA(0, 0), cA, voffA); PG8_STAGE(PG8_SA(0, 1), cA + hstep, voffA);
        if (wr == 1) PG8_BAR;
        PG8_WAIT_V(2); PG8_BAR;
        PG8_STAGE(PG8_SB(1, 0), cB + kstep, voffB); PG8_STAGE(PG8_SA(1, 0), cA + kstep, voffA); PG8_STAGE(PG8_SB(1, 1), cB + kstep, voffB1);
        PG8_WAIT_V(6); PG8_BAR;
    } else {
        PG8_STAGE(PG8_SB(0, 0), cB, voffB); PG8_STAGE(PG8_SA(0, 0), cA, voffA); PG8_STAGE(PG8_SB(0, 1), cB, voffB1); PG8_STAGE(PG8_SA(0, 1), cA + hstep, voffA);
        if (wr == 1) PG8_BAR;
        PG8_WAIT_V(4); PG8_BAR;
        PG8_STAGE(PG8_SB(1, 0), cB + kstep, voffB); PG8_STAGE(PG8_SA(1, 0), cA + kstep, voffA); PG8_STAGE(PG8_SB(1, 1), cB + kstep, voffB1);
        PG8_WAIT_V(6); PG8_BAR;
    }
    for (;;) {
        const bool has_next = S.next(ui + 1, nxt);
        const char* nA = has_next ? (const char*)g.A + (size_t)nxt.pm * tstep : cA; const char* nB = has_next ? (const char*)g.Bt + (size_t)nxt.pn * tstep : cB;
        for (int t = 0; t < nt; t += 2) {
            const bool last = (t == nt - 2);
            const char* a1 = cA + (size_t)(t + 1) * kstep;
            const char* a2 = last ? nA : cA + (size_t)(t + 2) * kstep; const char* b2 = last ? nB : cB + (size_t)(t + 2) * kstep;
            const char* a3 = a2 + kstep; const char* b3 = b2 + kstep;
            if (last && has_next) S.a_ready(nxt);
            if constexpr (SP2) {
            PG8_LDB(B0, 0, 0); PG8_LDB(B1, 0, 1); PG8_SCHED; PG8_LDA(At, 0, 0); PG8_STAGE(PG8_SA(1, 1), a1 + hstep, voffA);
            PG8_WAIT_V(8); PG8_WAIT_L(0); PG8_BAR; PG8_MMA(0, 0, At, B0); PG8_MMA(0, 1, At, B1); PG8_BAR; PG8_SCHED;
            PG8_LDA(At, 0, 1); PG8_STAGE(PG8_SB(0, 0), b2, voffB); PG8_STAGE(PG8_SB(0, 1), b2, voffB1); PG8_STAGE(PG8_SA(0, 0), a2, voffA);
            PG8_WAIT_V(8); PG8_WAIT_L(0); PG8_BAR; PG8_MMA(1, 0, At, B0); PG8_MMA(1, 1, At, B1); PG8_BAR; PG8_SCHED;
            PG8_LDB(B0, 1, 0); PG8_LDB(B1, 1, 1); PG8_SCHED; PG8_LDA(At, 1, 0); PG8_STAGE(PG8_SA(0, 1), a2 + hstep, voffA);
            PG8_WAIT_V(8); PG8_WAIT_L(0); PG8_BAR; PG8_MMA(0, 0, At, B0); PG8_MMA(0, 1, At, B1); PG8_BAR; PG8_SCHED;
            PG8_LDA(At, 1, 1); PG8_STAGE(PG8_SB(1, 0), b3, voffB); PG8_STAGE(PG8_SB(1, 1), b3, voffB1); PG8_STAGE(PG8_SA(1, 0), a3, voffA);
            PG8_WAIT_V(8); PG8_WAIT_L(0); PG8_BAR; PG8_MMA(1, 0, At, B0); PG8_MMA(1, 1, At, B1); PG8_BAR; PG8_SCHED;
            } else {
            PG8_LDB(B0, 0, 0); PG8_SCHED; PG8_LDA(At, 0, 0); PG8_STAGE(PG8_SA(1, 1), a1 + hstep, voffA);
            PG8_WAIT_L(8); PG8_BAR; PG8_WAIT_L(0); PG8_MMA(0, 0, At, B0); PG8_BAR; PG8_SCHED;
            PG8_LDB(B1, 0, 1); PG8_STAGE(PG8_SB(0, 0), b2, voffB);
            PG8_BAR; PG8_WAIT_L(0); PG8_MMA(0, 1, At, B1); PG8_BAR;
            PG8_LDA(At, 0, 1); PG8_STAGE(PG8_SA(0, 0), a2, voffA);
            PG8_BAR; PG8_WAIT_L(0); PG8_MMA(1, 0, At, B0); PG8_BAR; PG8_SCHED;
            PG8_STAGE(PG8_SB(0, 1), b2, voffB1);
            PG8_WAIT_V(6); PG8_BAR; PG8_MMA(1, 1, At, B1); PG8_BAR;
            PG8_LDB(B0, 1, 0); PG8_SCHED; PG8_LDA(At, 1, 0); PG8_STAGE(PG8_SA(0, 1), a2 + hstep, voffA);
            PG8_WAIT_L(8); PG8_BAR; PG8_WAIT_L(0); PG8_MMA(0, 0, At, B0); PG8_BAR; PG8_SCHED;
            PG8_LDB(B1, 1, 1); PG8_STAGE(PG8_SB(1, 0), b3, voffB);
            PG8_BAR; PG8_WAIT_L(0); PG8_MMA(0, 1, At, B1); PG8_BAR;
            PG8_LDA(At, 1, 1); PG8_STAGE(PG8_SA(1, 0), a3, voffA);
            PG8_BAR; PG8_WAIT_L(0); PG8_MMA(1, 0, At, B0); PG8_BAR; PG8_SCHED;
            PG8_STAGE(PG8_SB(1, 1), b3, voffB1);
            PG8_WAIT_V(6); PG8_BAR; PG8_MMA(1, 1, At, B1); PG8_BAR;
            }
        }
        if constexpr (ALIGN_EPI) { if (wr == 0) PG8_BAR; }
        if constexpr (!Epi::AFTER_DRAIN) { E(acc, cur, wr, wc, fr, fq); S.done(cur); }
        if (!has_next) break;
#pragma unroll
        for (int a = 0; a < 2; ++a)
#pragma unroll
            for (int b = 0; b < 2; ++b)
#pragma unroll
                for (int m = 0; m < 4; ++m)
#pragma unroll
                    for (int n = 0; n < 2; ++n) acc[a][b][m][n] = (f32x4){0.f, 0.f, 0.f, 0.f};
        cur = nxt; cA = nA; cB = nB; ++ui;
        if constexpr (ALIGN_EPI) { if (wr == 1) PG8_BAR; }
    }
    PG8_WAIT_V(0);
    if constexpr (!ALIGN_EPI) { if (wr == 0) PG8_BAR; }
    PG8_BAR;
    if constexpr (Epi::AFTER_DRAIN) { E.fused(acc, cur, wr, wc, fr, fq, lds, wid, lane); S.done(cur); }
#undef PG8_SA
#undef PG8_SB
#undef PG8_STAGE
#undef PG8_LDA
#undef PG8_LDB
#undef PG8_MMA
#undef PG8_WAIT_V
#undef PG8_WAIT_L
#undef PG8_BAR
#undef PG8_SCHED
}
}

struct EpiProj {
  static constexpr bool PERM = true, AFTER_DRAIN = false, HEADPERM = true;
  const float* gqa; const float* gka; const float* gqb; const float* gkb; unsigned char* ws;
  __device__ __forceinline__ void operator()(const pg8::f32x4 (&acc)[2][2][4][2], const pg8::Unit& u, int wr, int wc, int fr, int fq) const {
    const int nbase = u.pn * 256 + wc * 64;
    const int region = nbase >> 9, hw = (nbase & 511) >> 6;
    const float* g = (region == 0) ? gqa : (region == 1) ? gka : (region == 3) ? gqb : gkb;
    const bool normed = (region != 2 && region != 5);
    const float qs = (region == 0 || region == 3) ? C2 : 1.0f;
    u16* dstR = (u16*)(ws + WS_R + (size_t)region * R_REGION);
    f32x4 gv[2][2];
#pragma unroll
    for (int bj = 0; bj < 2; ++bj)
#pragma unroll
      for (int n = 0; n < 2; ++n) gv[bj][n] = normed ? *(const f32x4*)(g + 32 * bj + 8 * fq + 4 * n) : (f32x4){1.f, 1.f, 1.f, 1.f};
#pragma unroll
    for (int ai = 0; ai < 2; ++ai)
#pragma unroll
      for (int m = 0; m < 4; ++m) {
        const int t = u.pm * 256 + ai * 128 + wr * 64 + m * 16 + fr;
        int seq_start, S, sq; seq_of(t, seq_start, S, sq);
        float scale = 1.0f;
        if (normed) {
          float ss = 0.f;
#pragma unroll
          for (int bj = 0; bj < 2; ++bj)
#pragma unroll
            for (int n = 0; n < 2; ++n) { const f32x4 v = acc[ai][bj][m][n]; ss += v[0] * v[0] + v[1] * v[1] + v[2] * v[2] + v[3] * v[3]; }
          ss += __shfl_xor(ss, 16); ss += __shfl_xor(ss, 32);
          scale = __builtin_amdgcn_rsqf(ss * (1.0f / 64.0f) + NORM_EPS) * qs;
        }
        u16* dst;
        if (region != 5) dst = dstR + (size_t)seq_start * 512 + ((size_t)hw * S + sq) * 64;
        else dst = dstR + (size_t)seq_start * 512 + ((size_t)(hw >> 1) * S + sq) * 128 + (hw & 1) * 64;
#pragma unroll
        for (int bj = 0; bj < 2; ++bj) {
          const f32x4 v0 = acc[ai][bj][m][0] * scale * gv[bj][0], v1 = acc[ai][bj][m][1] * scale * gv[bj][1];
          u32x4 o; o[0] = pk2(v0[0], v0[1]); o[1] = pk2(v0[2], v0[3]); o[2] = pk2(v1[0], v1[1]); o[3] = pk2(v1[2], v1[3]);
          *(u32x4*)(dst + 32 * bj + 8 * fq) = o;
        }
      }
  }
};

DI void phase_proj(const Params& p, unsigned char* lds) {
  pg8::Gemm g{(const u16*)((const unsigned char*)p.out + OUT_N1), (const u16*)(p.ws + WS_WIN), T_TOK, 3072, 1024};
  pg8::StaticOrder S; S.init(T_TOK, 3072, (int)gridDim.x, (int)blockIdx.x);
  EpiProj E{p.q_norm_a, p.k_norm_a, p.q_norm_b, p.k_norm_b, p.ws};
  pg8::gemm_phase<EpiProj, pg8::StaticOrder, true, true>((PG8_LAS unsigned char*)lds, g, S, E);
}

constexpr int AL_STAGE = 0;
constexpr int AL_VT    = 0;
constexpr int AL_TAB   = 131072;
constexpr int AL_TABA  = 137216;
constexpr int AL_XL    = 150016;
constexpr int AL_MISC  = 151552;

DI unsigned voff_b(int row, int ch) { return 256u * row + 16u * (ch ^ (((row & 3) << 2) | ((row >> 2) & 3))); }

template <int VAR>
DI void diff_unit(const Params& p, unsigned char* lds, int seq_start, int S, int hd, int q0, float lam) {
  const int tid = threadIdx.x, lane = tid & 63, r32 = lane & 31, h = lane >> 5;
  const int w = __builtin_amdgcn_readfirstlane(tid >> 6);
  const int map = w >> 2, wq = w & 3;
  const u16* QBp = (const u16*)(p.ws + WS_R + 3 * R_REGION);
  const u16* KBp = (const u16*)(p.ws + WS_R + 4 * R_REGION);
  const u16* VBp = (const u16*)(p.ws + WS_R + 5 * R_REGION);
  const int qpos = q0 + wq * 32 + r32;
  const int qlo = q0 + wq * 32;
  const u16* Qp = QBp + (size_t)seq_start * 512 + ((size_t)(hd * 2 + map) * S + qpos) * 64;
  bf16x8 qf[4];
#pragma unroll
  for (int ks = 0; ks < 4; ++ks) qf[ks] = *(const bf16x8*)(Qp + ks * 16 + h * 8);
  const u16* K1g = KBp + (size_t)seq_start * 512 + ((size_t)(hd * 2 + 0) * S) * 64;
  const u16* K2g = KBp + (size_t)seq_start * 512 + ((size_t)(hd * 2 + 1) * S) * 64;
  const u16* Vg = VBp + (size_t)seq_start * 512 + ((size_t)hd * S) * 128;
  const float* tab = (const float*)(lds + AL_TAB);
  const float* misc = (const float*)(lds + AL_MISC);
  const float cAfter = misc[12 + hd];
  f32x16 O[4];
#pragma unroll
  for (int nb = 0; nb < 4; ++nb)
#pragma unroll
    for (int r = 0; r < 16; ++r) O[nb][r] = 0.f;
  float l = 0.f;
  const int kr_ = 8 * w + (lane >> 3), kc_ = (lane & 7) ^ ((kr_ >> 1) & 7);
  const u16* k1src = K1g + (size_t)kr_ * 64 + kc_ * 8;
  const u16* k2src = K2g + (size_t)kr_ * 64 + kc_ * 8;
  const u16* vsrc[2];
#pragma unroll
  for (int i = 0; i < 2; ++i) { const int row = 8 * w + 4 * i + (lane >> 4); const int pc = (lane & 15) ^ (((row & 3) << 2) | ((row >> 2) & 3)); vsrc[i] = Vg + (size_t)row * 128 + pc * 8; }
  const int NKT = S / 64;
  const int i16 = lane & 15, tq = i16 >> 2, tp = i16 & 3, blk = (lane >> 4) & 1;
  int kbase4[4], vbase[4][2];
#pragma unroll
  for (int ks = 0; ks < 4; ++ks) kbase4[ks] = r32 * 128 + (((2 * ks + h) ^ ((r32 >> 1) & 7)) << 4);
#pragma unroll
  for (int nb = 0; nb < 4; ++nb)
#pragma unroll
    for (int hi = 0; hi < 2; ++hi) vbase[nb][hi] = (int)voff_b(4 * h + tq + 8 * hi, 4 * nb + 2 * blk + (tp >> 1)) + 8 * (tp & 1);
#define DU_GLDS(gsrc_, ldsoff_) do { unsigned keep_; const unsigned dst_ = (unsigned)__builtin_amdgcn_readfirstlane((int)(ldsoff_)); \
    asm volatile("s_mov_b32 %0, m0\n\ts_mov_b32 m0, %2\n\ts_nop 0\n\tglobal_load_lds_dwordx4 %1, off\n\ts_mov_b32 m0, %0" : "=&s"(keep_) : "v"(gsrc_), "s"(dst_) : "memory"); } while (0)
#define DU_DMA(kt_, st_) do { const size_t ko_ = (size_t)(kt_) * 64 * 64, vo_ = (size_t)(kt_) * 64 * 128; const unsigned b_ = lds_base + AL_STAGE + (st_) * 32768; \
    DU_GLDS(k1src + ko_, b_ + w * 1024); DU_GLDS(k2src + ko_, b_ + 8192 + w * 1024); \
    DU_GLDS(vsrc[0] + vo_, b_ + 16384 + w * 2048); DU_GLDS(vsrc[1] + vo_, b_ + 16384 + w * 2048 + 1024); } while (0)
  const unsigned lds_base = (unsigned)(uintptr_t)lds;
#define SBAR() __builtin_amdgcn_sched_barrier(0)
#define DU_VRD(slot, f, so_) do { vlo[slot] = tr_read(vp[(f) >> 1][0] + (so_) + ((f) & 1) * 4096); vhi[slot] = tr_read(vp[(f) >> 1][1] + (so_) + ((f) & 1) * 4096); } while (0)
#define DU_SUB(A, B, kq2, kso2_, has_next2_, vso_, knext_, has_next_) do { \
    SBAR(); \
    s16x4 vlo[4], vhi[4]; \
    if (VAR != 2 && VAR != 4) { DU_VRD(0, 0, vso_); DU_VRD(1, 1, vso_); DU_VRD(2, 2, vso_); DU_VRD(3, 3, vso_); } \
    if (has_next_ && VAR != 3 && VAR != 4) { \
      f32x16 z_; _Pragma("unroll") for (int r = 0; r < 16; ++r) z_[r] = 0.f; \
      B = MFMA32(kf[0], qf[0], z_); B = MFMA32(kf[1], qf[1], B); B = MFMA32(kf[2], qf[2], B); B = MFMA32(kf[3], qf[3], B); } \
    float ls = 0.f; \
    _Pragma("unroll") for (int r = 0; r < 16; ++r) ls += A[r]; \
    l += ls; \
    bf16x8 pb[2]; \
    _Pragma("unroll") for (int s2 = 0; s2 < 2; ++s2) { \
      u32x4 pw; pw[0] = pk2(A[8 * s2 + 0], A[8 * s2 + 1]); pw[1] = pk2(A[8 * s2 + 2], A[8 * s2 + 3]); \
      pw[2] = pk2(A[8 * s2 + 4], A[8 * s2 + 5]); pw[3] = pk2(A[8 * s2 + 6], A[8 * s2 + 7]); \
      pb[s2] = __builtin_bit_cast(bf16x8, pw); } \
    SBAR(); \
    if ((has_next2_) && VAR != 3 && VAR != 4) { _Pragma("unroll") for (int ks = 0; ks < 4; ++ks) kf[ks] = *(const bf16x8*)(kq2[ks] + (kso2_)); } \
    if (has_next_) { \
      const int dmin_ = (knext_) - (qlo + 31), dmax_ = (knext_) + 31 - qlo; \
      if (dmin_ < 559) { \
        if (in_after) { in_after = false; _Pragma("unroll") for (int nb = 0; nb < 4; ++nb) _Pragma("unroll") for (int r = 0; r < 16; ++r) O[nb][r] *= fAfter; l *= fAfter; \
                        _Pragma("unroll") for (int s2 = 0; s2 < 2; ++s2) {   \
                          u32x4 pw; pw[0] = pk2(A[8 * s2 + 0] * fAfter, A[8 * s2 + 1] * fAfter); pw[1] = pk2(A[8 * s2 + 2] * fAfter, A[8 * s2 + 3] * fAfter); \
                          pw[2] = pk2(A[8 * s2 + 4] * fAfter, A[8 * s2 + 5] * fAfter); pw[3] = pk2(A[8 * s2 + 6] * fAfter, A[8 * s2 + 7] * fAfter); \
                          pb[s2] = __builtin_bit_cast(bf16x8, pw); } } \
        if (dmax_ > -559) { const int base_ = (knext_) + 4 * h - qpos + 640; \
          _Pragma("unroll") for (int r = 0; r < 16; ++r) B[r] += tab[base_ + (r & 3) + 8 * (r >> 2)]; } } } \
    _Pragma("unroll") for (int f = 0; f < 8; ++f) { \
      if (VAR != 2 && VAR != 4) { O[f >> 1] = MFMA32(cat8(vlo[f & 3], vhi[f & 3]), pb[f & 1], O[f >> 1]); \
      if (f + 4 < 8) DU_VRD(f & 3, f + 4, vso_); } \
      if (VAR != 1 && VAR != 4) { B[2 * f] = __builtin_amdgcn_exp2f(B[2 * f]); B[2 * f + 1] = __builtin_amdgcn_exp2f(B[2 * f + 1]); } } \
  } while (0)
  f32x16 X, Y; bf16x8 kf[4];
  const float fAfter = __builtin_amdgcn_exp2f(cAfter);
  bool in_after = true;
  const int KT1 = NKT - 1;
  DU_DMA(KT1, 0);
  if (NKT > 1) DU_DMA(KT1 - 1, 1);
  asm volatile("s_waitcnt vmcnt(0)" ::: "memory");
  __syncthreads();
  {
    const unsigned char* kb_ = lds + AL_STAGE + map * 8192 + 4096;
    f32x16 z_;
#pragma unroll
    for (int r = 0; r < 16; ++r) z_[r] = 0.f;
    X = MFMA32(*(const bf16x8*)(kb_ + kbase4[0]), qf[0], z_); X = MFMA32(*(const bf16x8*)(kb_ + kbase4[1]), qf[1], X);
    X = MFMA32(*(const bf16x8*)(kb_ + kbase4[2]), qf[2], X); X = MFMA32(*(const bf16x8*)(kb_ + kbase4[3]), qf[3], X);
    const int knext = 64 * KT1 + 32;
    const int dmin_ = knext - (qlo + 31), dmax_ = knext + 31 - qlo;
    if (dmin_ < 559) {
      in_after = false;
      if (dmax_ > -559) { const int base_ = knext + 4 * h - qpos + 640;
#pragma unroll
        for (int r = 0; r < 16; ++r) X[r] += tab[base_ + (r & 3) + 8 * (r >> 2)]; }
    }
#pragma unroll
    for (int r = 0; r < 16; ++r) X[r] = __builtin_amdgcn_exp2f(X[r]);
#pragma unroll
    for (int ks = 0; ks < 4; ++ks) kf[ks] = *(const bf16x8*)(lds + AL_STAGE + map * 8192 + kbase4[ks]);
  }
  int st_cur = 0, st_nxt = 32768, st_free = 65536;
  for (int i = 0; i < NKT; ++i) {
    const int kt = KT1 - i;
    asm volatile("s_waitcnt vmcnt(0)" ::: "memory");
    __syncthreads();
    if (i + 2 < NKT) DU_DMA(kt - 2, st_free / 32768);
    const unsigned char* knx[4]; const unsigned char* vp[4][2];
#pragma unroll
    for (int ks = 0; ks < 4; ++ks) knx[ks] = lds + AL_STAGE + st_nxt + map * 8192 + kbase4[ks];
#pragma unroll
    for (int nb = 0; nb < 4; ++nb) { vp[nb][0] = lds + AL_STAGE + st_cur + 16384 + vbase[nb][0]; vp[nb][1] = lds + AL_STAGE + st_cur + 16384 + vbase[nb][1]; }
    DU_SUB(X, Y, knx, 4096, (i + 1 < NKT), 8192, 64 * kt, true);
    DU_SUB(Y, X, knx, 0, (i + 1 < NKT), 0, 64 * kt - 32, (i + 1 < NKT));
    { const int t_ = st_cur; st_cur = st_nxt; st_nxt = st_free; st_free = t_; }
  }
#undef DU_DMA
#undef DU_GLDS
#undef DU_VRD
#undef DU_SUB
#undef SBAR
  if (in_after) {
#pragma unroll
    for (int nb = 0; nb < 4; ++nb)
#pragma unroll
      for (int r = 0; r < 16; ++r) O[nb][r] *= fAfter;
    l *= fAfter;
  }
  if (VAR != 0) {
#pragma unroll
    for (int nb = 0; nb < 4; ++nb) asm volatile("" :: "v"(O[nb]));
    asm volatile("" :: "v"(l), "v"(X), "v"(Y));
    __syncthreads();
    return;
  }
  __syncthreads();
  float ltot = l + __shfl_xor(l, 32);
  float* xbuf = (float*)(lds + AL_STAGE);
  if (map == 1) {
    const float inv = 1.0f / ltot;
#pragma unroll
    for (int nb = 0; nb < 4; ++nb)
#pragma unroll
      for (int r = 0; r < 16; ++r) xbuf[((wq * 64 + nb * 16 + r) << 6) + lane] = O[nb][r] * inv;
  }
  __syncthreads();
  if (map == 0) {
    const float inv = 1.0f / ltot;
    float ss = 0.f;
#pragma unroll
    for (int nb = 0; nb < 4; ++nb)
#pragma unroll
      for (int r = 0; r < 16; ++r) {
        float o = O[nb][r] * inv - lam * xbuf[((wq * 64 + nb * 16 + r) << 6) + lane];
        O[nb][r] = o; ss += o * o;
      }
    ss += __shfl_xor(ss, 32);
    const float rn = __builtin_amdgcn_rsqf(ss * (1.0f / 128.0f) + NORM_EPS) * 0.8f;
    u16* mix = (u16*)((unsigned char*)p.out + OUT_MIX) + (size_t)(seq_start + qpos) * 1024 + 512 + hd * 128;
#pragma unroll
    for (int nb = 0; nb < 4; ++nb)
#pragma unroll
      for (int g4 = 0; g4 < 4; ++g4) {
        const int d0 = 32 * nb + 8 * g4 + 4 * h;
        f32x4 gg = *(const f32x4*)(p.diff_norm_g + d0);
        u32x2 o; o[0] = pk2(O[nb][4 * g4 + 0] * rn * gg[0], O[nb][4 * g4 + 1] * rn * gg[1]);
        o[1] = pk2(O[nb][4 * g4 + 2] * rn * gg[2], O[nb][4 * g4 + 3] * rn * gg[3]);
        *(u32x2*)(mix + d0) = o;
      }
  }
  __syncthreads();
}

constexpr int AL_DPART = 65536;
constexpr int AL_DL    = AL_TAB;
template <int PASS>
DI void dil_wave_item(const Params& p, unsigned char* lds, int seq_start, int S, int hd, int i0, int sel) {
  const int tid = threadIdx.x, lane = tid & 63, r32 = lane & 31, h = lane >> 5;
  const int w = __builtin_amdgcn_readfirstlane(tid >> 6);
  const u16* QAp = (const u16*)(p.ws + WS_R + 0 * R_REGION);
  const u16* KAp = (const u16*)(p.ws + WS_R + 1 * R_REGION);
  const u16* VAp = (const u16*)(p.ws + WS_R + 2 * R_REGION);
  constexpr int QSTR = (PASS == 1) ? 1 : 16;
  constexpr int NTILE = (PASS == 1) ? 5 : 13;
  const int qbase = (PASS == 1) ? i0 + 32 * sel : i0 + sel;
  const int qpos = qbase + QSTR * r32;
  const int tl = qpos - i0;
  const u16* Qp = QAp + (size_t)seq_start * 512 + ((size_t)hd * S + qpos) * 64;
  bf16x8 qf[4];
#pragma unroll
  for (int ks = 0; ks < 4; ++ks) qf[ks] = *(const bf16x8*)(Qp + ks * 16 + h * 8);
  const u16* Kg = KAp + (size_t)seq_start * 512 + ((size_t)hd * S) * 64;
  const u16* Vg = VAp + (size_t)seq_start * 512 + ((size_t)hd * S) * 64;
  unsigned char* vt = lds + AL_VT + w * 8192;
  unsigned char* ktl = vt + 4096;
  const float* tabA = (const float*)(lds + AL_TABA) + hd * 3 * 132;
  unsigned char* dpart = lds + AL_DPART;
  float* dl = (float*)(lds + AL_DL);
  const int psw = ((tl >> 4) ^ tl) & 15;
  f32x16 O[2];
  float l = 0.f;
  if (PASS == 1) {
#pragma unroll
    for (int nb = 0; nb < 2; ++nb)
#pragma unroll
      for (int r = 0; r < 16; ++r) O[nb][r] = 0.f;
  } else {
#pragma unroll
    for (int nb = 0; nb < 2; ++nb)
#pragma unroll
      for (int g4 = 0; g4 < 4; ++g4) {
        const int ch = 8 * nb + 2 * g4 + h;
        const u32x2 v = *(const u32x2*)(dpart + tl * 128 + ((ch ^ psw) << 3));
        O[nb][4 * g4 + 0] = __uint_as_float(v[0] << 16); O[nb][4 * g4 + 1] = __uint_as_float(v[0] & 0xffff0000u);
        O[nb][4 * g4 + 2] = __uint_as_float(v[1] << 16); O[nb][4 * g4 + 3] = __uint_as_float(v[1] & 0xffff0000u);
      }
    if (h == 0) l = dl[tl];
  }
  const int i16 = lane & 15, tq = i16 >> 2, tp = i16 & 3, blk = (lane >> 4) & 1;
  int vrb[2][2];
#pragma unroll
  for (int nb = 0; nb < 2; ++nb)
#pragma unroll
    for (int hi = 0; hi < 2; ++hi) {
      const int R = 4 * h + tq + 8 * hi; const int ch = 4 * nb + 2 * blk + (tp >> 1);
      const int sw = (((R >> 1) & 1) << 2) ^ ((R >> 2) & 3);
      vrb[nb][hi] = R * 128 + ((ch ^ sw) << 4) + 8 * (tp & 1);
    }
  bf16x8 kfb[1][4]; u32x4 vcb[1][4];
  const int lrow = lane >> 3, lch = lane & 7;
#define DL_PARAMS(tau_) \
    const int d_ = (PASS == 1) ? 1 : (((tau_) < 5) ? 16 : 4); const int br_ = (PASS == 1) ? 2 : (((tau_) < 5) ? 0 : 1); \
    const int tt_ = (PASS == 1) ? (tau_) : (((tau_) < 5) ? (tau_) : (tau_) - 5); const int ratio_ = QSTR / d_; \
    const int n0_ = -64 + 32 * tt_;
#define DL_LOAD(buf, tau_) do { DL_PARAMS(tau_) \
    _Pragma("unroll") for (int i4 = 0; i4 < 4; ++i4) { int kpos_ = qbase + d_ * (n0_ + 8 * i4 + lrow); kpos_ = kpos_ < 0 ? 0 : (kpos_ >= S ? S - 1 : kpos_); \
      kfb[buf][i4] = *(const bf16x8*)(Kg + (size_t)kpos_ * 64 + lch * 8); vcb[buf][i4] = *(const u32x4*)(Vg + (size_t)kpos_ * 64 + lch * 8); } (void)br_; (void)ratio_; } while (0)
#define DL_STORE(buf) do { \
    _Pragma("unroll") for (int i4 = 0; i4 < 4; ++i4) { const int row_ = 8 * i4 + lrow; const int sw_ = (((row_ >> 1) & 1) << 2) ^ ((row_ >> 2) & 3); \
      *(u32x4*)(vt + row_ * 128 + ((lch ^ sw_) << 4)) = vcb[buf][i4]; \
      *(bf16x8*)(ktl + row_ * 128 + ((lch ^ ((row_ >> 1) & 7)) << 4)) = kfb[buf][i4]; } } while (0)
#define DL_COMPUTE(buf, tau_) do { DL_PARAMS(tau_) \
    const int kfirst_ = qbase + d_ * n0_, klast_ = qbase + d_ * (n0_ + 31); \
    const int base_ = n0_ + 4 * h - ratio_ * r32; const float* tb_ = tabA + br_ * 132; \
    f32x16 sT; \
    _Pragma("unroll") for (int r = 0; r < 16; ++r) { int dd = base_ + (r & 3) + 8 * (r >> 2); dd = dd < -65 ? -65 : (dd > 65 ? 65 : dd); sT[r] = tb_[dd + 65]; } \
    if (kfirst_ < 0 || klast_ >= S) { _Pragma("unroll") for (int r = 0; r < 16; ++r) { const int kp = qbase + d_ * (n0_ + crow(r, h)); if (kp < 0 || kp >= S) sT[r] = NEG_BIG; } } \
    _Pragma("unroll") for (int ks = 0; ks < 4; ++ks) { const bf16x8 ka_ = *(const bf16x8*)(ktl + r32 * 128 + (((2 * ks + h) ^ ((r32 >> 1) & 7)) << 4)); sT = MFMA32(ka_, qf[ks], sT); } \
    float ls = 0.f; \
    _Pragma("unroll") for (int r = 0; r < 16; ++r) { sT[r] = __builtin_amdgcn_exp2f(sT[r]); ls += sT[r]; } \
    l += ls; \
    bf16x8 pb[2]; \
    _Pragma("unroll") for (int s2 = 0; s2 < 2; ++s2) { \
      u32x4 pw; pw[0] = pk2(sT[8 * s2 + 0], sT[8 * s2 + 1]); pw[1] = pk2(sT[8 * s2 + 2], sT[8 * s2 + 3]); \
      pw[2] = pk2(sT[8 * s2 + 4], sT[8 * s2 + 5]); pw[3] = pk2(sT[8 * s2 + 6], sT[8 * s2 + 7]); \
      pb[s2] = __builtin_bit_cast(bf16x8, pw); } \
    _Pragma("unroll") for (int nb = 0; nb < 2; ++nb) _Pragma("unroll") for (int s2 = 0; s2 < 2; ++s2) { \
        const s16x4 lo = tr_read(vt + vrb[nb][0] + s2 * 2048); const s16x4 hi = tr_read(vt + vrb[nb][1] + s2 * 2048); \
        O[nb] = MFMA32(cat8(lo, hi), pb[s2], O[nb]); } \
  } while (0)
  DL_LOAD(0, 0);
#pragma unroll 1
  for (int tau = 0; tau < NTILE; ++tau) {
    DL_STORE(0);
    { const int tn = (tau + 1 < NTILE) ? tau + 1 : tau; DL_LOAD(0, tn); }
    DL_COMPUTE(0, tau);
  }
#undef DL_PARAMS
#undef DL_LOAD
#undef DL_STORE
#undef DL_COMPUTE
  const float ltot = l + __shfl_xor(l, 32);
  if (PASS == 1) {
#pragma unroll
    for (int nb = 0; nb < 2; ++nb)
#pragma unroll
      for (int g4 = 0; g4 < 4; ++g4) {
        const int ch = 8 * nb + 2 * g4 + h;
        u32x2 o; o[0] = pk2(O[nb][4 * g4 + 0], O[nb][4 * g4 + 1]); o[1] = pk2(O[nb][4 * g4 + 2], O[nb][4 * g4 + 3]);
        *(u32x2*)(dpart + tl * 128 + ((ch ^ psw) << 3)) = o;
      }
    if (h == 0) dl[tl] = ltot;
  } else {
    const float inv = 1.0f / ltot;
    u16* mix = (u16*)((unsigned char*)p.out + OUT_MIX) + (size_t)(seq_start + qpos) * 1024 + hd * 64;
#pragma unroll
    for (int nb = 0; nb < 2; ++nb)
#pragma unroll
      for (int g4 = 0; g4 < 4; ++g4) {
        const int d0 = 32 * nb + 8 * g4 + 4 * h;
        u32x2 o; o[0] = pk2(O[nb][4 * g4 + 0] * inv, O[nb][4 * g4 + 1] * inv); o[1] = pk2(O[nb][4 * g4 + 2] * inv, O[nb][4 * g4 + 3] * inv);
        *(u32x2*)(mix + d0) = o;
      }
  }
}

DI void phase_attn(const Params& p, unsigned char* lds) {
  const int tid = threadIdx.x;
  float* misc = (float*)(lds + AL_MISC);
  if (tid == 0) {
    float gqa = 0.f, gka = 0.f, gqb = 0.f, gkb = 0.f, bm = 0.f;
    for (int i = 0; i < 64; ++i) { gqa = fmaxf(gqa, fabsf(p.q_norm_a[i])); gka = fmaxf(gka, fabsf(p.k_norm_a[i])); gqb = fmaxf(gqb, fabsf(p.q_norm_b[i])); gkb = fmaxf(gkb, fabsf(p.k_norm_b[i])); }
    for (int i = 0; i < 32 * 12; ++i) bm = fmaxf(bm, fabsf(p.rel_bias[i]));
    const float M2 = 8.0f * LOG2E * fmaxf(gqa * gka, gqb * gkb) * 1.02f + bm * LOG2E + 0.1f;
    float s1 = 0.f, s2 = 0.f;
    for (int i = 0; i < 64; ++i) { s1 += p.lq1[i] * p.lk1[i]; s2 += p.lq2[i] * p.lk2[i]; }
    misc[0] = M2; misc[1] = expf(s1) - expf(s2) + 0.2f;
    for (int hd = 0; hd < 4; ++hd) { misc[8 + hd] = p.rel_bias[15 * 12 + 8 + hd] * LOG2E; misc[12 + hd] = (p.rel_bias[31 * 12 + 8 + hd] - p.rel_bias[15 * 12 + 8 + hd]) * LOG2E; }
  }
  __syncthreads();
  const float M2 = misc[0], lam = misc[1];
  {
    float* tabA = (float*)(lds + AL_TABA);
    for (int i = tid; i < 8 * 3 * 132; i += NTHR) {
      int hd = i / 396, rem = i % 396, br = rem / 132, idx = rem % 132;
      int dl = idx - 65; float v = NEG_BIG;
      if (dl >= -64 && dl <= 64 && idx < 131) { int d = (br == 0) ? 16 : (br == 1) ? 4 : 1; v = p.rel_bias[rel_bucket(dl * d) * 12 + hd] * LOG2E - M2; }
      tabA[i] = v;
    }
  }
#ifndef REP_DIFF
#define REP_DIFF 1
#endif
#ifndef REP_DIL
#define REP_DIL 1
#endif
  int cur_hd = -1;
  for (int rep_ = 0; rep_ < REP_DIFF; ++rep_)
  for (int vb = blockIdx.x; vb < 256; vb += gridDim.x) {
    const int xl = vb & 7, rk = vb >> 3;
#pragma unroll 1
    for (int rnd = 0; rnd < 8; ++rnd) {
      int seq_start, S, hd, q0;
      if (rnd < 4) { const int pair = xl + 8 * rnd; hd = pair & 3; S = 4096; seq_start = (pair >> 2) * 4096; q0 = rk * 128; }
      else { const int pair = 8 * xl + 2 * (rnd - 4) + (rk >> 4); hd = pair & 3; S = 2048; seq_start = T_PROMPT + (pair >> 2) * 2048; q0 = (rk & 15) * 128; }
      if (hd != cur_hd) {
        __syncthreads();
        float* tab = (float*)(lds + AL_TAB);
        for (int i = tid; i < 1281; i += NTHR) tab[i] = p.rel_bias[rel_bucket(i - 640) * 12 + 8 + hd] * LOG2E - misc[8 + hd];
        cur_hd = hd;
        __syncthreads();
      }
#ifndef PROBE_VAR
#define PROBE_VAR 0
#endif
      if (rep_ == 0) diff_unit<0>(p, lds, seq_start, S, hd, q0, lam); else diff_unit<PROBE_VAR>(p, lds, seq_start, S, hd, q0, lam);
    }
  }
  __syncthreads();
  const int w = tid >> 6;
  for (int rep_ = 0; rep_ < REP_DIL; ++rep_)
  for (int vb = blockIdx.x; vb < 256; vb += gridDim.x)
#pragma unroll 1
  for (int rnd = 0; rnd < 4; ++rnd) {
    const int xl = vb & 7, rk = vb >> 3;
    int seq_start, S, hd, i0;
    if (rnd < 2) { const int pair = xl * 8 + rnd * 4 + (rk >> 3); hd = pair & 7; S = 4096; seq_start = (pair >> 3) * 4096; i0 = (rk & 7) * 512; }
    else { const int pair = xl * 16 + (rnd - 2) * 8 + (rk >> 2); hd = pair & 7; S = 2048; seq_start = T_PROMPT + (pair >> 3) * 2048; i0 = (rk & 3) * 512; }
    __syncthreads();
#pragma unroll 1
    for (int u2 = 0; u2 < 2; ++u2) dil_wave_item<1>(p, lds, seq_start, S, hd, i0, w + 8 * u2);
    __syncthreads();
#pragma unroll 1
    for (int u2 = 0; u2 < 2; ++u2) dil_wave_item<2>(p, lds, seq_start, S, hd, i0, w + 8 * u2);
  }
}

struct EpiOut {
  static constexpr bool PERM = false, AFTER_DRAIN = false, HEADPERM = false;
  const float* xp; const float* xs; float* x1;
  __device__ __forceinline__ void operator()(const pg8::f32x4 (&acc)[2][2][4][2], const pg8::Unit& u, int wr, int wc, int fr, int fq) const {
    const int col0 = u.pn * 256 + wc * 32 + 4 * fq;
#pragma unroll
    for (int ai = 0; ai < 2; ++ai)
#pragma unroll
      for (int m = 0; m < 4; ++m) {
        const int t = u.pm * 256 + ai * 128 + wr * 64 + m * 16 + fr;
        const float* xr = ((t < T_PROMPT) ? xp + (size_t)t * DM : xs + (size_t)(t - T_PROMPT) * DM) + col0;
        float* orow = x1 + (size_t)t * DM + col0;
#pragma unroll
        for (int bj = 0; bj < 2; ++bj)
#pragma unroll
          for (int n = 0; n < 2; ++n) {
            const f32x4 xv = *(const f32x4*)(xr + bj * 128 + n * 16);
            *(f32x4*)(orow + bj * 128 + n * 16) = xv + acc[ai][bj][m][n];
          }
      }
  }
};

DI void phase_outproj(const Params& p, unsigned char* lds) {
  pg8::Gemm g{(const u16*)((const unsigned char*)p.out + OUT_MIX), (const u16*)(p.ws + WS_WOUT), T_TOK, 1024, 1024};
  pg8::StaticOrder S; S.init(T_TOK, 1024, (int)gridDim.x, (int)blockIdx.x);
  EpiOut E{p.x_prompt, p.x_sample, (float*)(p.ws + WS_X1)};
  pg8::gemm_phase<EpiOut, pg8::StaticOrder, true, true>((PG8_LAS unsigned char*)lds, g, S, E);
}

DI void phase_norm2(const Params& p) {
  const int tid = threadIdx.x, lane = tid & 63, w = tid >> 6;
  const float* x1 = (const float*)(p.ws + WS_X1);
  u16* hb = (u16*)(p.ws + WS_H);
  for (int it = blockIdx.x; it < T_TOK / 8; it += gridDim.x) {
    int t = it * 8 + w;
    norm_row(x1 + (size_t)t * DM, p.ffn_norm_g, hb + (size_t)t * DM, lane);
  }
}

struct EpiQp {
  static constexpr bool PERM = true, AFTER_DRAIN = false, HEADPERM = false;
  u16* O;
  __device__ __forceinline__ void operator()(const pg8::f32x4 (&acc)[2][2][4][2], const pg8::Unit& u, int wr, int wc, int fr, int fq) const {
    const int col0 = u.pn * 256 + wc * 32 + 8 * fq;
#pragma unroll
    for (int ai = 0; ai < 2; ++ai)
#pragma unroll
      for (int m = 0; m < 4; ++m) {
        const int t = u.pm * 256 + ai * 128 + wr * 64 + m * 16 + fr;
        u16* rowp = O + (size_t)t * 2048 + col0;
#pragma unroll
        for (int bj = 0; bj < 2; ++bj) {
          const f32x4 v0 = acc[ai][bj][m][0], v1 = acc[ai][bj][m][1];
          u32x4 o; o[0] = pk2(v0[0], v0[1]); o[1] = pk2(v0[2], v0[3]); o[2] = pk2(v1[0], v1[1]); o[3] = pk2(v1[2], v1[3]);
          *(u32x4*)(rowp + bj * 128) = o;
        }
      }
  }
};

DI void phase_peer_query(const Params& p, unsigned char* lds) {
  pg8::Gemm g{(const u16*)(p.ws + WS_H), (const u16*)(p.ws + WS_WQ), T_TOK, 2048, 1024};
  pg8::StaticOrder S; S.init(T_TOK, 2048, (int)gridDim.x, (int)blockIdx.x);
  EpiQp E{(u16*)p.out};
  pg8::gemm_phase<EpiQp, pg8::StaticOrder, true, true>((PG8_LAS unsigned char*)lds, g, S, E);
}

DI int f2sort(float f) { const int b = __float_as_int(f); return b ^ ((b >> 31) & 0x7fffffff); }
DI float sort2f(int s) { return __int_as_float(s ^ ((s >> 31) & 0x7fffffff)); }
#define CE_DESC(a, b) do { const int mx_ = max((a), (b)), mn_ = min((a), (b)); (a) = mx_; (b) = mn_; } while (0)
#define CE_ASC(a, b) do { const int mx_ = max((a), (b)), mn_ = min((a), (b)); (a) = mn_; (b) = mx_; } while (0)
template <int OFF> DI void sort16_desc(int (&x)[64]) {
#pragma unroll
  for (int k = 2; k <= 16; k <<= 1)
#pragma unroll
    for (int j = k >> 1; j > 0; j >>= 1)
#pragma unroll
      for (int i = 0; i < 16; ++i) {
        const int l = i ^ j;
        if (l > i) { if ((i & k) == 0) CE_DESC(x[OFF + i], x[OFF + l]); else CE_ASC(x[OFF + i], x[OFF + l]); }
      }
}
template <int A, int B> DI void merge16x(int (&x)[64]) {
#pragma unroll
  for (int i = 0; i < 16; ++i) x[A + i] = max(x[A + i], x[B + 15 - i]);
#pragma unroll
  for (int j = 8; j > 0; j >>= 1)
#pragma unroll
    for (int i = 0; i < 16; ++i) { const int l = i ^ j; if (l > i) CE_DESC(x[A + i], x[A + l]); }
}

DI void phase_peer_route(const Params& p, unsigned char* lds) {
  const u16* QP = (const u16*)p.out;
  const u16* SK = (const u16*)(p.ws + WS_SK);
  u16* eidx = (u16*)(p.ws + WS_EIDX);
  float* gg = (float*)(p.ws + WS_G);
  const int tid = threadIdx.x, lane = tid & 63, r32 = lane & 31, h = lane >> 5;
  const int w = __builtin_amdgcn_readfirstlane(tid >> 6);
  unsigned char* SKl = lds;
  float* v2l = (float*)(lds + 65536);
  __syncthreads();
#pragma unroll
  for (int i = 0; i < 8; ++i) {
    const int c = tid + 512 * i; const int zz = c >> 11, row = (c >> 4) & 127, ch = c & 15;
    const u32x4 v = *(const u32x4*)(SK + (size_t)zz * 16384 + row * 128 + ch * 8);
    *(u32x4*)(SKl + zz * 32768 + row * 256 + ((ch ^ (row & 15)) << 4)) = v;
  }
  __syncthreads();
  for (int item = blockIdx.x; item < T_TOK / 256; item += gridDim.x) {
    const int t = item * 256 + w * 32 + r32;
    const u16* qrow = QP + (size_t)t * 2048;
#pragma unroll 1
    for (int pp = 0; pp < 8; ++pp) {
      int lists[2][16];
#pragma unroll
      for (int z = 0; z < 2; ++z) {
        const int c16 = pp * 2 + z;
        int x[64];
        {
          bf16x8 qf[8];
#pragma unroll
          for (int ks = 0; ks < 8; ++ks) qf[ks] = *(const bf16x8*)(qrow + c16 * 128 + ks * 16 + h * 8);
          f32x16 S2[4];
#pragma unroll
          for (int kb = 0; kb < 4; ++kb)
#pragma unroll
            for (int r = 0; r < 16; ++r) S2[kb][r] = 0.f;
#pragma unroll
          for (int ks = 0; ks < 8; ++ks)
#pragma unroll
            for (int kb = 0; kb < 4; ++kb) {
              const int key = kb * 32 + r32;
              const bf16x8 a = *(const bf16x8*)(SKl + z * 32768 + key * 256 + (((2 * ks + h) ^ (key & 15)) << 4));
              S2[kb] = MFMA32(a, qf[ks], S2[kb]);
            }
#pragma unroll
          for (int e = 0; e < 64; ++e) {
            const int kidx = 32 * (e >> 4) + (e & 3) + 8 * ((e & 15) >> 2) + 4 * h;
            x[e] = (f2sort(S2[e >> 4][e & 15]) & ~127) | kidx;
          }
        }
        sort16_desc<0>(x); sort16_desc<16>(x); sort16_desc<32>(x); sort16_desc<48>(x);
        merge16x<0, 16>(x); merge16x<32, 48>(x); merge16x<0, 32>(x);
#pragma unroll
        for (int i = 0; i < 16; ++i) x[16 + i] = __shfl_xor(x[i], 32);
        merge16x<0, 16>(x);
#pragma unroll
        for (int i = 0; i < 16; ++i) lists[z][i] = x[i];
      }
      float v1[16];
#pragma unroll
      for (int i = 0; i < 16; ++i) { v1[i] = sort2f(lists[0][i]); v2l[i * 512 + tid] = sort2f(lists[1][i]); }
      unsigned long long ptrs = 0ull;
      float bestv[16]; int be[16];
#pragma unroll
      for (int rd = 0; rd < 16; ++rd) {
        float best = -3.0e38f, bv1 = 0.f, bv2 = 0.f; int ab = 0;
#pragma unroll
        for (int a = 0; a < 16; ++a) {
          const int b = (int)((ptrs >> (4 * a)) & 15ull);
          const float v2 = v2l[b * 512 + tid];
          const float cnd = v1[a] + v2;
          if (cnd > best) { best = cnd; ab = a; bv1 = v1[a]; bv2 = v2; }
        }
        bestv[rd] = best; be[rd] = (f2sort(bv1) & 127) * 128 + (f2sort(bv2) & 127);
        ptrs += 1ull << (4 * ab);
      }
      if (h == 0) {
        float ex[16]; float sum = 0.f;
#pragma unroll
        for (int rd = 0; rd < 16; ++rd) { ex[rd] = __expf(bestv[rd] - bestv[0]); sum += ex[rd]; }
        const float inv = 1.0f / sum;
        const size_t oo = ((size_t)t * 8 + pp) * 16;
#pragma unroll
        for (int q4 = 0; q4 < 4; ++q4) { f32x4 v = {ex[4 * q4] * inv, ex[4 * q4 + 1] * inv, ex[4 * q4 + 2] * inv, ex[4 * q4 + 3] * inv}; *(f32x4*)(gg + oo + 4 * q4) = v; }
        u32x4 e0, e1;
#pragma unroll
        for (int j = 0; j < 4; ++j) { e0[j] = (unsigned)be[2 * j] | ((unsigned)be[2 * j + 1] << 16); e1[j] = (unsigned)be[8 + 2 * j] | ((unsigned)be[8 + 2 * j + 1] << 16); }
        *(u32x4*)(eidx + oo) = e0; *(u32x4*)(eidx + oo + 8) = e1;
      }
    }
  }
}

typedef float f2_t __attribute__((ext_vector_type(2)));
DI unsigned xcc_id() { return (unsigned)__builtin_amdgcn_s_getreg((3 << 11) | 20) & 7u; }
constexpr int PG_CHUNK_TOK = 64;
constexpr int PG_NCHUNK = T_TOK / PG_CHUNK_TOK;

DI void dec16(const u32x4& r, f2_t (&v)[8]) {
#pragma unroll
  for (int d = 0; d < 4; ++d) { v[2 * d] = __builtin_amdgcn_cvt_pk_f32_fp8((int)r[d], false); v[2 * d + 1] = __builtin_amdgcn_cvt_pk_f32_fp8((int)r[d], true); }
}

template <int WHICH>
DI void peer_wave_tokens(const Params& p, int x, int tb, int lane) {
  const unsigned char* TBL = p.ws + (WHICH ? WS_V : WS_U) + (size_t)x * 16384 * 128;
  const u16* Hb = (const u16*)(p.ws + WS_H);
  const u16* eidx = (const u16*)(p.ws + WS_EIDX);
  const float* wg = (const float*)(p.ws + WS_G);
  const float* x1 = (const float*)(p.ws + WS_X1);
  float* zpart = (float*)p.out;
  const int r = lane >> 3, c = lane & 7;
  int elo[8], ehi[8]; float wlo[8], whi[8];
#pragma unroll
  for (int k = 0; k < 8; ++k) {
    elo[k] = eidx[(size_t)(tb + k) * 128 + lane]; ehi[k] = eidx[(size_t)(tb + k) * 128 + 64 + lane];
    if (WHICH) { wlo[k] = wg[(size_t)(tb + k) * 128 + lane]; whi[k] = wg[(size_t)(tb + k) * 128 + 64 + lane]; }
  }
  u32x4 rows[2][16];
#define PEER_LOAD_ROWS(buf, k) do { _Pragma("unroll") for (int i = 0; i < 16; ++i) { \
      const int e_ = __shfl((i < 8) ? elo[k] : ehi[k], (i & 7) * 8 + r); \
      rows[buf][i] = *(const u32x4*)(TBL + (size_t)e_ * 128 + c * 16); } } while (0)
  PEER_LOAD_ROWS(0, 0);
#pragma unroll
  for (int k = 0; k < 8; ++k) {
    const int t = tb + k;
    if (k + 1 < 8) PEER_LOAD_ROWS((k + 1) & 1, k + 1);
    if (WHICH == 0) {
      u32x4 ha = *(const u32x4*)(Hb + (size_t)t * DM + x * 128 + c * 16), hb = *(const u32x4*)(Hb + (size_t)t * DM + x * 128 + c * 16 + 8);
      f2_t hq[8];
#pragma unroll
      for (int j = 0; j < 4; ++j) {
        hq[j][0] = __uint_as_float(ha[j] << 16); hq[j][1] = __uint_as_float(ha[j] & 0xffff0000u);
        hq[4 + j][0] = __uint_as_float(hb[j] << 16); hq[4 + j][1] = __uint_as_float(hb[j] & 0xffff0000u);
      }
      float sv[16];
#pragma unroll
      for (int i = 0; i < 16; ++i) {
        f2_t v[8]; dec16(rows[k & 1][i], v);
        f2_t a = v[0] * hq[0];
#pragma unroll
        for (int q = 1; q < 8; ++q) a = __builtin_elementwise_fma(v[q], hq[q], a);
        sv[i] = a[0] + a[1];
      }
#pragma unroll
      for (int o = 1; o < 8; o <<= 1) {
#pragma unroll
        for (int i = 0; i < 16; ++i) sv[i] += __shfl_xor(sv[i], o);
      }
      float o0 = 0.f, o1 = 0.f;
#pragma unroll
      for (int i = 0; i < 8; ++i) { if (c == i) { o0 = sv[i]; o1 = sv[i + 8]; } }
      float* zp = zpart + ((size_t)x * T_TOK + t) * 128;
      zp[c * 8 + r] = o0; zp[(c + 8) * 8 + r] = o1;
    } else {
      f2_t acc[8];
#pragma unroll
      for (int q = 0; q < 8; ++q) { acc[q][0] = 0.f; acc[q][1] = 0.f; }
#pragma unroll
      for (int i = 0; i < 16; ++i) {
        f2_t v[8]; dec16(rows[k & 1][i], v);
        const float wj = __shfl((i < 8) ? wlo[k] : whi[k], (i & 7) * 8 + r);
        f2_t ww = {wj, wj};
#pragma unroll
        for (int q = 0; q < 8; ++q) acc[q] = __builtin_elementwise_fma(v[q], ww, acc[q]);
      }
      f2_t b4[4];
      {
        const bool up = (lane & 32) != 0;
#pragma unroll
        for (int q = 0; q < 4; ++q) {
          f2_t keep = up ? acc[4 + q] : acc[q], send = up ? acc[q] : acc[4 + q];
          f2_t got; got[0] = __shfl_xor(send[0], 32); got[1] = __shfl_xor(send[1], 32);
          b4[q] = keep + got;
        }
      }
      f2_t b2[2];
      {
        const bool up = (lane & 16) != 0;
#pragma unroll
        for (int q = 0; q < 2; ++q) {
          f2_t keep = up ? b4[2 + q] : b4[q], send = up ? b4[q] : b4[2 + q];
          f2_t got; got[0] = __shfl_xor(send[0], 16); got[1] = __shfl_xor(send[1], 16);
          b2[q] = keep + got;
        }
      }
      f2_t b1;
      {
        const bool up = (lane & 8) != 0;
        f2_t keep = up ? b2[1] : b2[0], send = up ? b2[0] : b2[1];
        f2_t got; got[0] = __shfl_xor(send[0], 8); got[1] = __shfl_xor(send[1], 8);
        b1 = keep + got;
      }
      const size_t o = (size_t)t * DM + x * 128 + c * 16 + 2 * r;
      f2_t xv = *(const f2_t*)(x1 + o);
      f2_t res = xv + b1;
      *(f2_t*)(p.out + o) = res;
    }
  }
#undef PEER_LOAD_ROWS
}

template <int WHICH>
DI void phase_peer_sliced(const Params& p, unsigned char* lds) {
  const int tid = threadIdx.x, lane = tid & 63, w = tid >> 6;
  unsigned* qctr = (unsigned*)(p.ws + WS_MISC + MISC_QCTR) + WHICH * 8;
  int* bc = (int*)lds;
  const unsigned x0 = xcc_id();
  for (int si = 0; si < 8; ++si) {
    const int x = (int)((x0 + si) & 7u);
    for (;;) {
      __syncthreads();
      if (tid == 0) bc[0] = (int)atomicAdd(&qctr[x], 1u);
      __syncthreads();
      const int ch = bc[0];
      if (ch >= PG_NCHUNK) break;
      peer_wave_tokens<WHICH>(p, x, ch * PG_CHUNK_TOK + w * 8, lane);
    }
  }
}

DI void phase_peer_act(const Params& p) {
  const float* zpart = (const float*)p.out;
  const u16* eidx = (const u16*)(p.ws + WS_EIDX);
  float* wg = (float*)(p.ws + WS_G);
  const float* suinv = (const float*)(p.ws + WS_MISC + MISC_SUINV);
  const float* svinv = (const float*)(p.ws + WS_MISC + MISC_SVINV);
  for (size_t i = (size_t)blockIdx.x * NTHR + threadIdx.x; i < (size_t)T_TOK * 128; i += (size_t)gridDim.x * NTHR) {
    float z = 0.f;
#pragma unroll
    for (int x = 0; x < 8; ++x) z += zpart[(size_t)x * T_TOK * 128 + i];
    const int e = eidx[i];
    z *= suinv[e];
    const float act = 0.5f * z * (1.0f + erff(z * 0.70710678118654752f));
    wg[i] = wg[i] * act * svinv[e];
  }
}

#define XB_TMO      128
#define XB_XCNT(j)  (256  + 64 * (j))
#define XB_XSUB(j)  (1280 + 64 * (j))
#define XB_XGEN(j)  (2304 + 64 * (j))
#define XB_TOP      3328
#define XB_TOPGEN   3392
#define XCD_BAR_WORDS 3456
#define XB_SPIN_CAP (1u << 18)
#define LAS __attribute__((address_space(3)))

__device__ __forceinline__ unsigned xb_ld(unsigned* p)              { return __hip_atomic_load(p, __ATOMIC_RELAXED, __HIP_MEMORY_SCOPE_AGENT); }
__device__ __forceinline__ unsigned xb_add(unsigned* p, unsigned v) { return __hip_atomic_fetch_add(p, v, __ATOMIC_RELAXED, __HIP_MEMORY_SCOPE_AGENT); }
__device__ __forceinline__ unsigned xb_xcc_id() { return (unsigned)__builtin_amdgcn_s_getreg((3 << 11) | 20) & 0xFu; }
#define XB_SPIN(cond, bar) do { unsigned _sp = 0; while (cond) { __builtin_amdgcn_s_sleep(1); \
    if ((++_sp & 255u) == 0u) { if (xb_ld(&(bar)[XB_TMO])) break; if (_sp > XB_SPIN_CAP) { atomicAdd(&(bar)[XB_TMO], 1u); break; } } } } while (0)

struct XcdBarrier {
    unsigned* bar; unsigned x;
    volatile LAS unsigned* st;
};

__device__ __forceinline__ XcdBarrier xcd_barrier_post(unsigned* bar, volatile LAS unsigned* st) {
    XcdBarrier b; b.bar = bar; b.x = xb_xcc_id(); b.st = st;
    if (threadIdx.x == 0) (void)xb_add(&bar[XB_XCNT(b.x)], 1u);
    return b;
}
__device__ __forceinline__ void xcd_barrier_complete(unsigned* bar, unsigned x, unsigned& nloc, unsigned& nx) {
    const unsigned G = gridDim.x * gridDim.y * gridDim.z;
    unsigned sum, cnt, mine, sp = 0u;
    for (;;) {
        sum = 0u; cnt = 0u; mine = 0u;
#pragma unroll
        for (unsigned j = 0; j < 16; ++j) { const unsigned c = xb_ld(&bar[XB_XCNT(j)]); sum += c; cnt += (c > 0u) ? 1u : 0u; mine = (j == x) ? c : mine; }
        if (sum == G) break;
        __builtin_amdgcn_s_sleep(1);
        if ((++sp & 255u) == 0u) { if (xb_ld(&bar[XB_TMO])) break; if (sp > XB_SPIN_CAP) { atomicAdd(&bar[XB_TMO], 1u); break; } }
    }
    nloc = mine > 0u ? mine : 1u; nx = cnt > 0u ? cnt : 1u;
}

__device__ __forceinline__ void xcd_barrier(const XcdBarrier& b) {
    asm volatile("s_waitcnt vmcnt(0)" ::: "memory");
    __syncthreads();
    if (threadIdx.x == 0) {
        unsigned* bar = b.bar;
        __builtin_amdgcn_s_waitcnt(0);
        unsigned nloc = b.st[0], nx = b.st[1];
        if (nloc == 0u) { xcd_barrier_complete(bar, b.x, nloc, nx); b.st[0] = nloc; b.st[1] = nx; }
        const unsigned old = xb_add(&bar[XB_XSUB(b.x)], 1u);
        const unsigned gen = old / nloc;
        if (old + 1u == (gen + 1u) * nloc) {
            __builtin_amdgcn_fence(__ATOMIC_RELEASE, "agent");
            asm volatile("s_waitcnt vmcnt(0)" ::: "memory");
            const unsigned og = xb_add(&bar[XB_TOP], 1u);
            const unsigned tg = og / nx;
            if (og + 1u == (tg + 1u) * nx) xb_add(&bar[XB_TOPGEN], 1u);
            else XB_SPIN(xb_ld(&bar[XB_TOPGEN]) == tg, bar);
            __builtin_amdgcn_fence(__ATOMIC_ACQUIRE, "agent");
            xb_add(&bar[XB_XGEN(b.x)], 1u);
            asm volatile("s_waitcnt vmcnt(0)" ::: "memory");
        } else {
            XB_SPIN(xb_ld(&bar[XB_XGEN(b.x)]) == gen, bar);
            __builtin_amdgcn_fence(__ATOMIC_ACQUIRE, "agent");
            asm volatile("s_waitcnt vmcnt(0)" ::: "memory");
        }
    }
    __syncthreads();
}


__global__ void __launch_bounds__(NTHR, 2) fwd_kernel(Params p) {
  extern __shared__ __attribute__((aligned(16))) unsigned char lds[];
  cg::grid_group grid = cg::this_grid();
#ifndef ONLY_PH
#define PHON(k) 1
#else
#define PHON(k) ((k) == ONLY_PH)
#endif
#ifndef REPEAT_MASK
#define REPEAT_MASK 0
#endif
#define GSYNC(k) do { if ((k) == 0) { grid.sync(); xbar = xcd_barrier_post((unsigned*)(p.ws + WS_MISC + MISC_BAR), (volatile LAS unsigned*)(lds + LDS_BARST)); } else xcd_barrier(xbar); } while (0)
#define RUN_PHASE(k, call) do { if (PHON(k) && lo <= (k) && (k) < hi) { call; if ((REPEAT_MASK >> (k)) & 1) { grid.sync(); call; } } if (lo <= (k) && (k) + 1 < hi) GSYNC(k); } while (0)
  const int lo = p.ph_lo, hi = p.ph_hi;
  if (threadIdx.x < 4) ((volatile LAS unsigned*)(lds + LDS_BARST))[threadIdx.x] = 0u;
  __syncthreads();
  XcdBarrier xbar; xbar.bar = (unsigned*)(p.ws + WS_MISC + MISC_BAR); xbar.x = 0; xbar.st = (volatile LAS unsigned*)(lds + LDS_BARST);
  RUN_PHASE(0, phase_prep(p, lds));
  RUN_PHASE(1, phase_proj(p, lds));
  RUN_PHASE(2, phase_attn(p, lds));
  RUN_PHASE(3, phase_outproj(p, lds));
  RUN_PHASE(4, phase_norm2(p));
  RUN_PHASE(5, phase_peer_query(p, lds));
  RUN_PHASE(6, phase_peer_route(p, lds));
  RUN_PHASE(7, phase_peer_sliced<0>(p, lds));
  RUN_PHASE(8, phase_peer_act(p));
  RUN_PHASE(9, phase_peer_sliced<1>(p, lds));
}

extern "C" void kernel_launch(void* const* d_in, const int* in_sizes, int n_in, void* d_out, int out_size, void* d_ws, size_t ws_size, hipStream_t stream) {
  static int grid_blocks = 0;
  if (grid_blocks == 0) {
    if (n_in != 20 || ws_size < WS_END || out_size != T_TOK * DM) {
      fprintf(stderr, "kernel_launch: unexpected problem shape (n_in %d, ws %zu, out %d)\n", n_in, ws_size, out_size);
      grid_blocks = -1; return;
    }
    int dev = 0, cus = 0, per_cu = 0;
    hipGetDevice(&dev);
    hipDeviceGetAttribute(&cus, hipDeviceAttributeMultiprocessorCount, dev);
    hipFuncSetAttribute((const void*)fwd_kernel, hipFuncAttributeMaxDynamicSharedMemorySize, LDS_BYTES);
    hipOccupancyMaxActiveBlocksPerMultiprocessor(&per_cu, (const void*)fwd_kernel, NTHR, LDS_BYTES);
    if (per_cu < 1) { fprintf(stderr, "kernel_launch: occupancy query says %d blocks/CU\n", per_cu); per_cu = 1; }
    grid_blocks = cus;
    (void)hipGetLastError();
  }
  if (grid_blocks < 0) return;
  Params p{};
  p.x_prompt = (const float*)d_in[0]; p.x_sample = (const float*)d_in[1]; p.rel_bias = (const float*)d_in[2]; p.attn_norm_g = (const float*)d_in[3];
  p.w_in = (const float*)d_in[4]; p.q_norm_a = (const float*)d_in[5]; p.k_norm_a = (const float*)d_in[6]; p.q_norm_b = (const float*)d_in[7];
  p.k_norm_b = (const float*)d_in[8]; p.lq1 = (const float*)d_in[9]; p.lk1 = (const float*)d_in[10]; p.lq2 = (const float*)d_in[11];
  p.lk2 = (const float*)d_in[12]; p.diff_norm_g = (const float*)d_in[13]; p.w_out = (const float*)d_in[14]; p.ffn_norm_g = (const float*)d_in[15];
  p.peer_w_q = (const float*)d_in[16]; p.peer_sub_keys = (const float*)d_in[17]; p.peer_u = (const float*)d_in[18]; p.peer_v = (const float*)d_in[19];
  p.out = (float*)d_out; p.ws = (unsigned char*)d_ws;
#if FUSED
  p.ph_lo = 0; p.ph_hi = NPHASE;
  void* args[] = {&p};
  hipError_t e = hipLaunchCooperativeKernel((const void*)fwd_kernel, dim3(grid_blocks), dim3(NTHR), args, LDS_BYTES, stream);
  if (e != hipSuccess) fprintf(stderr, "cooperative launch failed: %s (grid %d)\n", hipGetErrorString(e), grid_blocks);
#else
  for (int ph = 0; ph < NPHASE; ++ph) {
    p.ph_lo = ph; p.ph_hi = ph + 1;
    hipLaunchKernelGGL(fwd_kernel, dim3(grid_blocks), dim3(NTHR), LDS_BYTES, stream, p);
  }
#endif
}
```

```cpp
#include <hip/hip_runtime.h>
#include <hip/hip_cooperative_groups.h>
#include <cstdio>
#include <cstdint>
namespace cg = cooperative_groups;

#ifndef FUSED
#define FUSED 1
#endif

typedef unsigned short u16;
typedef __attribute__((ext_vector_type(8))) short bf16x8;
typedef __attribute__((ext_vector_type(4))) short s16x4;
typedef __attribute__((ext_vector_type(16))) float f32x16;
typedef __attribute__((ext_vector_type(4))) float f32x4;
typedef __attribute__((ext_vector_type(4))) unsigned u32x4;
typedef __attribute__((ext_vector_type(2))) unsigned u32x2;
typedef __attribute__((address_space(3))) unsigned char* ldsp_t;

#define DI __device__ __forceinline__
#define MFMA32(a, b, c) __builtin_amdgcn_mfma_f32_32x32x16_bf16((a), (b), (c), 0, 0, 0)

constexpr int DM = 1024;
constexpr int T_TOK = 65536;
constexpr int T_PROMPT = 32768;
constexpr int NTHR = 512;
constexpr int NPHASE = 10;
constexpr float NORM_EPS = 1e-6f;
constexpr float LOG2E = 1.4426950408889634f;
constexpr float C2 = 0.125f * LOG2E;
constexpr float NEG_BIG = -1.0e30f;

constexpr size_t WS_WIN  = 0;
constexpr size_t WS_WOUT = WS_WIN + (size_t)3072 * 1024 * 2;
constexpr size_t WS_WQ   = WS_WOUT + (size_t)1024 * 1024 * 2;
constexpr size_t WS_SK   = WS_WQ + (size_t)2048 * 1024 * 2;
constexpr size_t WS_U    = WS_SK + (size_t)2 * 128 * 128 * 2;
constexpr size_t WS_V    = WS_U + (size_t)16384 * 1024 * 2;
constexpr size_t WS_MISC = WS_V + (size_t)16384 * 1024 * 2;
constexpr size_t MISC_SUINV = 0, MISC_SVINV = 65536, MISC_QCTR = 131072, MISC_BAR = 196608;
constexpr size_t WS_R    = WS_MISC + (size_t)1048576;
constexpr size_t R_REGION = (size_t)T_TOK * 512 * 2;
constexpr size_t WS_X1   = WS_R;
constexpr size_t WS_H    = WS_R + (size_t)T_TOK * 1024 * 4;
constexpr size_t WS_EIDX = WS_R + 6 * R_REGION;
constexpr size_t WS_G    = WS_EIDX + (size_t)T_TOK * 128 * 2;
constexpr size_t WS_END  = WS_G + (size_t)T_TOK * 128 * 4;
static_assert(WS_END <= (size_t)536870912, "workspace map exceeds 512 MiB");
constexpr size_t OUT_N1 = 0, OUT_MIX = 134217728, OUT_TV = 0, OUT_TI = 67108864;

constexpr int LDS_BYTES = 163840;
constexpr int LDS_BARST = 163840 - 256;

struct Params {
  const float* x_prompt; const float* x_sample; const float* rel_bias; const float* attn_norm_g; const float* w_in;
  const float* q_norm_a; const float* k_norm_a; const float* q_norm_b; const float* k_norm_b;
  const float* lq1; const float* lk1; const float* lq2; const float* lk2; const float* diff_norm_g; const float* w_out;
  const float* ffn_norm_g; const float* peer_w_q; const float* peer_sub_keys; const float* peer_u; const float* peer_v;
  float* out; unsigned char* ws; int ph_lo; int ph_hi;
};

DI u16 f2bf(float f) { unsigned u = __float_as_uint(f); u += 0x7fffu + ((u >> 16) & 1u); return (u16)(u >> 16); }
DI float bf2f(u16 b) { return __uint_as_float(((unsigned)b) << 16); }
DI unsigned pk2(float lo, float hi) {
  typedef float f2_t __attribute__((ext_vector_type(2)));
  typedef __bf16 b2_t __attribute__((ext_vector_type(2)));
  f2_t v = {lo, hi}; b2_t b = __builtin_convertvector(v, b2_t); return __builtin_bit_cast(unsigned, b);
}
DI int crow(int reg, int h) { return (reg & 3) + 8 * (reg >> 2) + 4 * h; }
DI float wave_sum(float v) {
#pragma unroll
  for (int o = 32; o > 0; o >>= 1) v += __shfl_xor(v, o);
  return v;
}
DI void seq_of(int t, int& seq_start, int& S, int& s) {
  if (t < T_PROMPT) { S = 4096; seq_start = t & ~4095; s = t & 4095; }
  else { S = 2048; seq_start = t & ~2047; s = t & 2047; }
}
DI const float* x_row(const Params& p, int t) {
  return (t < T_PROMPT) ? p.x_prompt + (size_t)t * DM : p.x_sample + (size_t)(t - T_PROMPT) * DM;
}
DI int rel_bucket(int rel) {
  int n = rel < 0 ? -rel : rel;
  int b;
  if (n < 8) b = n;
  else if (n < 15) b = 8; else if (n < 27) b = 9; else if (n < 50) b = 10; else if (n < 91) b = 11;
  else if (n < 166) b = 12; else if (n < 305) b = 13; else if (n < 559) b = 14; else b = 15;
  return (rel > 0 ? 16 : 0) + b;
}
DI s16x4 tr_read(const unsigned char* p) {
  typedef short v4i16_t __attribute__((ext_vector_type(4)));
  return __builtin_bit_cast(s16x4, __builtin_amdgcn_ds_read_tr16_b64_v4i16((__attribute__((address_space(3))) v4i16_t*)p));
}
DI bf16x8 cat8(s16x4 lo, s16x4 hi) { return __builtin_shufflevector(lo, hi, 0, 1, 2, 3, 4, 5, 6, 7); }

DI void transpose_item(const float* __restrict__ src, int K, int N, u16* __restrict__ dst, int k0, int n0, unsigned char* lds) {
  float* tile = (float*)lds;
  const int tid = threadIdx.x;
#pragma unroll
  for (int i = 0; i < 8; ++i) {
    int idx = tid + 512 * i; int r = idx >> 6, c = idx & 63;
    tile[r * 65 + c] = src[(size_t)(k0 + r) * N + n0 + c];
  }
  __syncthreads();
  {
    int n = tid >> 3, kc = tid & 7;
    u32x4 o;
    o[0] = pk2(tile[(kc * 8 + 0) * 65 + n], tile[(kc * 8 + 1) * 65 + n]);
    o[1] = pk2(tile[(kc * 8 + 2) * 65 + n], tile[(kc * 8 + 3) * 65 + n]);
    o[2] = pk2(tile[(kc * 8 + 4) * 65 + n], tile[(kc * 8 + 5) * 65 + n]);
    o[3] = pk2(tile[(kc * 8 + 6) * 65 + n], tile[(kc * 8 + 7) * 65 + n]);
    *(u32x4*)(dst + (size_t)(n0 + n) * K + k0 + kc * 8) = o;
  }
  __syncthreads();
}

DI void convert_item(const float* __restrict__ src, u16* __restrict__ dst, size_t base) {
  size_t i = base + (size_t)threadIdx.x * 8;
  f32x4 a = *(const f32x4*)(src + i), b = *(const f32x4*)(src + i + 4);
  u32x4 o; o[0] = pk2(a[0], a[1]); o[1] = pk2(a[2], a[3]); o[2] = pk2(b[0], b[1]); o[3] = pk2(b[2], b[3]);
  *(u32x4*)(dst + i) = o;
}

DI void norm_row(const float* __restrict__ xr, const float* __restrict__ g, u16* __restrict__ orow, int lane) {
  f32x4 v[4]; float ss = 0.f;
#pragma unroll
  for (int i = 0; i < 4; ++i) { v[i] = *(const f32x4*)(xr + lane * 4 + 256 * i); ss += v[i][0] * v[i][0] + v[i][1] * v[i][1] + v[i][2] * v[i][2] + v[i][3] * v[i][3]; }
  ss = wave_sum(ss);
  const float r = __builtin_amdgcn_rsqf(ss * (1.0f / 1024.0f) + NORM_EPS);
#pragma unroll
  for (int i = 0; i < 4; ++i) {
    f32x4 gg = *(const f32x4*)(g + lane * 4 + 256 * i);
    u32x2 o; o[0] = pk2(v[i][0] * r * gg[0], v[i][1] * r * gg[1]); o[1] = pk2(v[i][2] * r * gg[2], v[i][3] * r * gg[3]);
    *(u32x2*)(orow + lane * 4 + 256 * i) = o;
  }
}

DI void phase_prep(const Params& p, unsigned char* lds) {
  const int nb = gridDim.x, bid = blockIdx.x, tid = threadIdx.x;
  u16* wsb = (u16*)p.ws;
  for (int it = bid; it < 768 + 256 + 512; it += nb) {
    if (it < 768) { int kt = it / 48, nt = it % 48; transpose_item(p.w_in, 1024, 3072, (u16*)(p.ws + WS_WIN), kt * 64, nt * 64, lds); }
    else if (it < 1024) { int j = it - 768; int kt = j / 16, nt = j % 16; transpose_item(p.w_out, 1024, 1024, (u16*)(p.ws + WS_WOUT), kt * 64, nt * 64, lds); }
    else { int j = it - 1024; int kt = j / 32, nt = j % 32; transpose_item(p.peer_w_q, 1024, 2048, (u16*)(p.ws + WS_WQ), kt * 64, nt * 64, lds); }
  }
  for (int it = bid; it < 8; it += nb) convert_item(p.peer_sub_keys, (u16*)(p.ws + WS_SK), (size_t)it * 4096);
  if (bid == 0 && tid < 64) ((unsigned*)(p.ws + WS_MISC + MISC_QCTR))[tid] = 0u;
  if (bid == 0) for (int i = tid; i < 3456; i += NTHR) ((unsigned*)(p.ws + WS_MISC + MISC_BAR))[i] = 0u;
  {
    const int lane_ = tid & 63, w_ = tid >> 6;
    for (int it = bid; it < 2 * 16384 / 8; it += nb) {
      const int row = it * 8 + w_;
      const int tbl = row >> 14, e = row & 16383;
      const float* src = (tbl ? p.peer_v : p.peer_u) + (size_t)e * DM + lane_ * 16;
      f32x4 a0 = *(const f32x4*)(src), a1 = *(const f32x4*)(src + 4), a2 = *(const f32x4*)(src + 8), a3 = *(const f32x4*)(src + 12);
      float am = 0.f;
#pragma unroll
      for (int j = 0; j < 4; ++j) am = fmaxf(am, fmaxf(fmaxf(fabsf(a0[j]), fabsf(a1[j])), fmaxf(fabsf(a2[j]), fabsf(a3[j]))));
#pragma unroll
      for (int o = 32; o > 0; o >>= 1) am = fmaxf(am, __shfl_xor(am, o));
      const int ex = (int)((__float_as_uint(am) >> 23) & 255u);
      float sc = 1.0f, isc = 1.0f;
      if (ex > 8 && ex < 250) { sc = __uint_as_float((unsigned)(261 - ex) << 23); isc = __uint_as_float((unsigned)(ex - 7) << 23); }
      u32x4 o;
      { int pk = __builtin_amdgcn_cvt_pk_fp8_f32(a0[0] * sc, a0[1] * sc, 0, false); pk = __builtin_amdgcn_cvt_pk_fp8_f32(a0[2] * sc, a0[3] * sc, pk, true); o[0] = (unsigned)pk; }
      { int pk = __builtin_amdgcn_cvt_pk_fp8_f32(a1[0] * sc, a1[1] * sc, 0, false); pk = __builtin_amdgcn_cvt_pk_fp8_f32(a1[2] * sc, a1[3] * sc, pk, true); o[1] = (unsigned)pk; }
      { int pk = __builtin_amdgcn_cvt_pk_fp8_f32(a2[0] * sc, a2[1] * sc, 0, false); pk = __builtin_amdgcn_cvt_pk_fp8_f32(a2[2] * sc, a2[3] * sc, pk, true); o[2] = (unsigned)pk; }
      { int pk = __builtin_amdgcn_cvt_pk_fp8_f32(a3[0] * sc, a3[1] * sc, 0, false); pk = __builtin_amdgcn_cvt_pk_fp8_f32(a3[2] * sc, a3[3] * sc, pk, true); o[3] = (unsigned)pk; }
      unsigned char* dst = p.ws + (tbl ? WS_V : WS_U) + ((size_t)(lane_ >> 3) * 16384 + e) * 128 + (lane_ & 7) * 16;
      *(u32x4*)dst = o;
      if (lane_ == 0) ((float*)(p.ws + WS_MISC + (tbl ? MISC_SVINV : MISC_SUINV)))[e] = isc;
    }
  }
  const int lane = tid & 63, w = tid >> 6;
  u16* n1 = (u16*)((unsigned char*)p.out + OUT_N1);
  for (int it = bid; it < T_TOK / 8; it += nb) {
    int t = it * 8 + w;
    norm_row(x_row(p, t), p.attn_norm_g, n1 + (size_t)t * DM, lane);
  }
  (void)wsb;
}

template <int PR, int QR>
DI void gemm_mainloop(const u16* __restrict__ P, const u16* __restrict__ Q, int K, int p0, int q0, unsigned char* lds, f32x16 (&acc)[2][2]) {
  static_assert(PR + QR == 384, "tile");
  constexpr int STAGE = 384 * 128;
  constexpr int WC = QR / 64;
  const int tid = threadIdx.x, lane = tid & 63, r32 = lane & 31, h = lane >> 5;
  const int w = __builtin_amdgcn_readfirstlane(tid >> 6);
  const int wr = w / WC, wc = w % WC;
#pragma unroll
  for (int i = 0; i < 2; ++i)
#pragma unroll
    for (int j = 0; j < 2; ++j)
#pragma unroll
      for (int r = 0; r < 16; ++r) acc[i][j][r] = 0.f;
  u32x4 stg[6];
  const u16* src[6]; int loff[6];
#pragma unroll
  for (int i = 0; i < 6; ++i) {
    int c = tid + 512 * i; int row = c >> 3, kc = c & 7;
    src[i] = (row < PR) ? P + (size_t)(p0 + row) * K + kc * 8 : Q + (size_t)(q0 + row - PR) * K + kc * 8;
    loff[i] = row * 128 + ((kc ^ ((row >> 1) & 7)) << 4);
  }
  const int KT = K / 64;
#pragma unroll
  for (int i = 0; i < 6; ++i) stg[i] = *(const u32x4*)(src[i]);
#pragma unroll
  for (int i = 0; i < 6; ++i) *(u32x4*)(lds + loff[i]) = stg[i];
  __syncthreads();
  int aoff[2], boff[2], asw[2], bsw[2];
#pragma unroll
  for (int i = 0; i < 2; ++i) {
    int ra = wr * 64 + i * 32 + r32; aoff[i] = ra * 128; asw[i] = (ra >> 1) & 7;
    int rb = PR + wc * 64 + i * 32 + r32; boff[i] = rb * 128; bsw[i] = (rb >> 1) & 7;
  }
  for (int kt = 0; kt < KT; ++kt) {
    const int buf = (kt & 1) * STAGE;
    if (kt + 1 < KT) {
#pragma unroll
      for (int i = 0; i < 6; ++i) stg[i] = *(const u32x4*)(src[i] + (kt + 1) * 64);
    }
#pragma unroll
    for (int ks = 0; ks < 4; ++ks) {
      bf16x8 a[2], b[2];
#pragma unroll
      for (int i = 0; i < 2; ++i) {
        a[i] = *(const bf16x8*)(lds + buf + aoff[i] + (((2 * ks + h) ^ asw[i]) << 4));
        b[i] = *(const bf16x8*)(lds + buf + boff[i] + (((2 * ks + h) ^ bsw[i]) << 4));
      }
#pragma unroll
      for (int i = 0; i < 2; ++i)
#pragma unroll
        for (int j = 0; j < 2; ++j) acc[i][j] = MFMA32(a[i], b[j], acc[i][j]);
    }
    if (kt + 1 < KT) {
      const int nbuf = ((kt + 1) & 1) * STAGE;
#pragma unroll
      for (int i = 0; i < 6; ++i) *(u32x4*)(lds + nbuf + loff[i]) = stg[i];
    }
    __syncthreads();
  }
}

namespace pg8 {
#define PG8_LAS __attribute__((address_space(3)))
typedef unsigned short bf16_t;
typedef short bf16x8 __attribute__((ext_vector_type(8)));
typedef float f32x4 __attribute__((ext_vector_type(4)));
typedef unsigned u32x4 __attribute__((ext_vector_type(4)));
constexpr int BM = 256, BK = 64, HALF = 128, HTB = HALF * BK * 2  , STAGE_BYTES = 8 * HTB, NXCD = 8, WGM = 8;

__host__ __device__ __forceinline__ int lds_byte(int r, int c) { const int st = (r >> 4) * 2 + (c >> 5), rr = r & 15, cc = c & 31, ob = rr * 64 + cc * 2; return st * 1024 + (ob ^ (((ob >> 9) & 1) << 5)); }
__host__ __device__ __forceinline__ void stage_rc(int b, int& R, int& C) { const int st = b / 1024, sb = b % 1024, swz = sb ^ (((sb >> 9) & 1) << 5); R = (st >> 1) * 16 + swz / 64; C = (st & 1) * 32 + (swz % 64) / 2; }
__host__ __device__ __forceinline__ int perm32(int rho) { const int n = rho >> 4, i = rho & 15; return 8 * (i >> 2) + 4 * n + (i & 3); }

struct Unit { int pm, pn; };
struct Gemm { const bf16_t* A; const bf16_t* Bt; int M, N, K; };

struct StaticOrder {
    int nM, nN, nwg, G, c;
    __host__ __device__ void init(int M, int N, int G_, int c_) { nM = M / BM; nN = N / BM; nwg = nM * nN; G = G_; c = c_; }
    __host__ __device__ bool next(int i, Unit& u) const {
        const long L = (long)i * G + c; if (L >= nwg) return false;
        int wgid = (int)L; { const int q = nwg / NXCD, r = nwg % NXCD, xcd = wgid % NXCD, off = wgid / NXCD; wgid = (xcd < r ? xcd * (q + 1) : r * (q + 1) + (xcd - r) * q) + off; }
        const int nig = WGM * nN, gid = wgid / nig, fm = gid * WGM, gsz = (nM - fm) < WGM ? (nM - fm) : WGM;
        u.pm = fm + ((wgid % nig) % gsz); u.pn = (wgid % nig) / gsz; return true;
    }
    __device__ __forceinline__ void a_ready(const Unit&) const {}
    __device__ __forceinline__ void done(const Unit&) const {}
};


template <class Epi, class Sched, bool ALIGN_EPI = false, bool SP2 = false>
__device__ __forceinline__ void gemm_phase(PG8_LAS unsigned char* lds, const Gemm g, const Sched& S, const Epi& E) {
    const int tid = threadIdx.x, wid = __builtin_amdgcn_readfirstlane(tid >> 6), lane = tid & 63, wr = wid >> 2, wc = wid & 3, fr = lane & 15, fq = lane >> 4;
    const int K = g.K, nt = K / BK;
    unsigned voffA[2], voffB[2], voffB1[2];
#pragma unroll
    for (int i = 0; i < 2; ++i) { int R, C; stage_rc(tid * 16 + i * 8192, R, C); const int Rb = Epi::PERM ? ((R & ~31) + perm32(R & 31)) : R;
        voffA[i] = (unsigned)(R * K + C) * 2u;
        if (Epi::HEADPERM) { const int Rh = 64 * (R >> 5) + perm32(R & 31); voffB[i] = (unsigned)(Rh * K + C) * 2u; voffB1[i] = (unsigned)((Rh + 32) * K + C) * 2u; }
        else { voffB[i] = (unsigned)(Rb * K + C) * 2u; voffB1[i] = (unsigned)((Rb + HALF) * K + C) * 2u; } }
    const size_t kstep = (size_t)(BK * 2);
    const size_t hstep = (size_t)HALF * K * 2;
    const size_t tstep = 2 * hstep;
    const unsigned ldsw = (unsigned)wid * 1024u;
    const int aoff = lds_byte(wr * 64 + fr, fq * 8), boff = lds_byte(wc * 32 + fr, fq * 8);
#define PG8_SA(b, h) (((b) * 2 + (h)) * HTB)
#define PG8_SB(b, h) ((4 + (b) * 2 + (h)) * HTB)
#define PG8_STAGE(bufoff, gbase, voff) do { _Pragma("unroll") for (int _i = 0; _i < 2; ++_i) \
        __builtin_amdgcn_global_load_lds((const unsigned*)((const char*)(gbase) + (voff)[_i]), (PG8_LAS unsigned*)(lds + (bufoff) + ldsw + _i * 8192), 16, 0, 0); } while (0)
#define PG8_LDA(dst, b, h) do { _Pragma("unroll") for (int m = 0; m < 4; ++m) _Pragma("unroll") for (int k = 0; k < 2; ++k) dst[m][k] = *(const PG8_LAS bf16x8*)(lds + PG8_SA(b, h) + aoff + m * 2048 + k * 1024); } while (0)
#define PG8_LDB(dst, b, h) do { _Pragma("unroll") for (int n = 0; n < 2; ++n) _Pragma("unroll") for (int k = 0; k < 2; ++k) dst[n][k] = *(const PG8_LAS bf16x8*)(lds + PG8_SB(b, h) + boff + n * 2048 + k * 1024); } while (0)
#define PG8_MMA(ai, bj, At, Bt) do { __builtin_amdgcn_s_setprio(1); _Pragma("unroll") for (int m = 0; m < 4; ++m) _Pragma("unroll") for (int n = 0; n < 2; ++n) _Pragma("unroll") for (int k = 0; k < 2; ++k) \
        acc[ai][bj][m][n] = __builtin_amdgcn_mfma_f32_16x16x32_bf16(Bt[n][k], At[m][k], acc[ai][bj][m][n], 0, 0, 0); __builtin_amdgcn_s_setprio(0); } while (0)
#define PG8_WAIT_V(n) asm volatile("s_waitcnt vmcnt(" #n ")" ::: "memory")
#define PG8_WAIT_L(n) asm volatile("s_waitcnt lgkmcnt(" #n ")" ::: "memory")
#define PG8_BAR __builtin_amdgcn_s_barrier()
#define PG8_SCHED __builtin_amdgcn_sched_barrier(0)
    Unit cur, nxt; int ui = 0;
    if (!S.next(0, cur)) return;
    f32x4 acc[2][2][4][2];
#pragma unroll
    for (int a = 0; a < 2; ++a)
#pragma unroll
        for (int b = 0; b < 2; ++b)
#pragma unroll
            for (int m = 0; m < 4; ++m)
#pragma unroll
                for (int n = 0; n < 2; ++n) acc[a][b][m][n] = (f32x4){0.f, 0.f, 0.f, 0.f};
    bf16x8 At[4][2], B0[2][2], B1[2][2];
    const char* cA = (const char*)g.A + (size_t)cur.pm * tstep; const char* cB = (const char*)g.Bt + (size_t)cur.pn * tstep;
    S.a_ready(cur);
    if constexpr (SP2) {
        PG8_STAGE(PG8_SB(0, 0), cB, voffB); PG8_STAGE(PG8_SB(0, 1), cB, voffB1); PG8_STAGE(PG8_SA(0, 0), cA, voffA); PG8_STAGE(PG8_SA(0, 1), cA + hstep, voffA);
        if (wr == 1) PG8_BAR;
        PG8_WAIT_V(2); PG8_BAR;
        PG8_STAGE(PG8_SB(1, 0), cB + kstep, voffB); PG8_STAGE(PG8_SA(1, 0), cA + kstep, voffA); PG8_STAGE(PG8_SB(1, 1), cB + kstep, voffB1);
        PG8_WAIT_V(6); PG8_BAR;
    } else {
        PG8_STAGE(PG8_SB(0, 0), cB, voffB); PG8_STAGE(PG8_SA(0, 0), cA, voffA); PG8_STAGE(PG8_SB(0, 1), cB, voffB1); PG8_STAGE(PG8_SA(0, 1), cA + hstep, voffA);
        if (wr == 1) PG8_BAR;
        PG8_WAIT_V(4); PG8_BAR;
        PG8_STAGE(PG8_SB(1, 0), cB + kstep, voffB); PG8_STAGE(PG8_SA(1, 0), cA + kstep, voffA); PG8_STAGE(PG8_SB(1, 1), cB + kstep, voffB1);
        PG8_WAIT_V(6); PG8_BAR;
    }
    for (;;) {
        const bool has_next = S.next(ui + 1, nxt);
        const char* nA = has_next ? (const char*)g.A + (size_t)nxt.pm * tstep : cA; const char* nB = has_next ? (const char*)g.Bt + (size_t)nxt.pn * tstep : cB;
        for (int t = 0; t < nt; t += 2) {
            const bool last = (t == nt - 2);
            const char* a1 = cA + (size_t)(t + 1) * kstep;
            const char* a2 = last ? nA : cA + (size_t)(t + 2) * kstep; const char* b2 = last ? nB : cB + (size_t)(t + 2) * kstep;
            const char* a3 = a2 + kstep; const char* b3 = b2 + kstep;
            if (last && has_next) S.a_ready(nxt);
            if constexpr (SP2) {
            PG8_LDB(B0, 0, 0); PG8_LDB(B1, 0, 1); PG8_SCHED; PG8_LDA(At, 0, 0); PG8_STAGE(PG8_SA(1, 1), a1 + hstep, voffA);
            PG8_WAIT_V(8); PG8_WAIT_L(0); PG8_BAR; PG8_MMA(0, 0, At, B0); PG8_MMA(0, 1, At, B1); PG8_BAR; PG8_SCHED;
            PG8_LDA(At, 0, 1); PG8_STAGE(PG8_SB(0, 0), b2, voffB); PG8_STAGE(PG8_SB(0, 1), b2, voffB1); PG8_STAGE(PG8_SA(0, 0), a2, voffA);
            PG8_WAIT_V(8); PG8_WAIT_L(0); PG8_BAR; PG8_MMA(1, 0, At, B0); PG8_MMA(1, 1, At, B1); PG8_BAR; PG8_SCHED;
            PG8_LDB(B0, 1, 0); PG8_LDB(B1, 1, 1); PG8_SCHED; PG8_LDA(At, 1, 0); PG8_STAGE(PG8_SA(0, 1), a2 + hstep, voffA);
            PG8_WAIT_V(8); PG8_WAIT_L(0); PG8_BAR; PG8_MMA(0, 0, At, B0); PG8_MMA(0, 1, At, B1); PG8_BAR; PG8_SCHED;
            PG8_LDA(At, 1, 1); PG8_STAGE(PG8_SB(1, 0), b3, voffB); PG8_STAGE(PG8_SB(1, 1), b3, voffB1); PG8_STAGE(PG8_SA(1, 0), a3, voffA);
            PG8_WAIT_V(8); PG8_WAIT_L(0); PG8_BAR; PG8_MMA(1, 0, At, B0); PG8_MMA(1, 1, At, B1); PG8_BAR; PG8_SCHED;
            } else {
            PG8_LDB(B0, 0, 0); PG8_SCHED; PG8_LDA(At, 0, 0); PG8_STAGE(PG8_SA(1, 1), a1 + hstep, voffA);
            PG8_WAIT_L(8); PG8_BAR; PG8_WAIT_L(0); PG8_MMA(0, 0, At, B0); PG8_BAR; PG8_SCHED;
            PG8_LDB(B1, 0, 1); PG8_STAGE(PG8_SB(0, 0), b2, voffB);
            PG8_BAR; PG8_WAIT_L(0); PG8_MMA(0, 1, At, B1); PG8_BAR;
            PG8_LDA(At, 0, 1); PG8_STAGE(PG8_SA(0, 0), a2, voffA);
            PG8_BAR; PG8_WAIT_L(0); PG8_MMA(1, 0, At, B0); PG8_BAR; PG8_SCHED;
            PG8_STAGE(PG8_SB(0, 1), b2, voffB1);
            PG8_WAIT_V(6); PG8_BAR; PG8_MMA(1, 1, At, B1); PG8_BAR;
            PG8_LDB(B0, 1, 0); PG8_SCHED; PG8_LDA(At, 1, 0); PG8_STAGE(PG8_SA(0, 1), a2 + hstep, voffA);
            PG8_WAIT_L(8); PG8_BAR; PG8_WAIT_L(0); PG8_MMA(0, 0, At, B0); PG8_BAR; PG8_SCHED;
            PG8_LDB(B1, 1, 1); PG8_STAGE(PG8_SB(1, 0), b3, voffB);
            PG8_BAR; PG8_WAIT_L(0); PG8_MMA(0, 1, At, B1); PG8_BAR;
            PG8_LDA(At, 1, 1); PG8_STAGE(PG8_SA(1, 0), a3, voffA);
            PG8_BAR; PG8_WAIT_L(0); PG8_MMA(1, 0, At, B0); PG8_BAR; PG8_SCHED;
            PG8_STAGE(PG8_SB(1, 1), b3, voffB1);
            PG8_WAIT_V(6); PG8_BAR; PG8_MMA(1, 1, At, B1); PG8_BAR;
            }
        }
        if constexpr (ALIGN_EPI) { if (wr == 0) PG8_BAR; }
        if constexpr (!Epi::AFTER_DRAIN) { E(acc, cur, wr, wc, fr, fq); S.done(cur); }
        if (!has_next) break;
#pragma unroll
        for (int a = 0; a < 2; ++a)
#pragma unroll
            for (int b = 0; b < 2; ++b)
#pragma unroll
                for (int m = 0; m < 4; ++m)
#pragma unroll
                    for (int n = 0; n < 2; ++n) acc[a][b][m][n] = (f32x4){0.f, 0.f, 0.f, 0.f};
        cur = nxt; cA = nA; cB = nB; ++ui;
        if constexpr (ALIGN_EPI) { if (wr == 1) PG8_BAR; }
    }
    PG8_WAIT_V(0);
    if constexpr (!ALIGN_EPI) { if (wr == 0) PG8_BAR; }
    PG8_BAR;
    if constexpr (Epi::AFTER_DRAIN) { E.fused(acc, cur, wr, wc, fr, fq, lds, wid, lane); S.done(cur); }
#undef PG8_SA
#undef PG8_SB
#undef PG8_STAGE
#undef PG8_LDA
#undef PG8_LDB
#undef PG8_MMA
#undef PG8_WAIT_V
#undef PG8_WAIT_L
#undef PG8_BAR
#undef PG8_SCHED
}
}

struct EpiProj {
  static constexpr bool PERM = true, AFTER_DRAIN = false, HEADPERM = true;
  const float* gqa; const float* gka; const float* gqb; const float* gkb; unsigned char* ws;
  __device__ __forceinline__ void operator()(const pg8::f32x4 (&acc)[2][2][4][2], const pg8::Unit& u, int wr, int wc, int fr, int fq) const {
    const int nbase = u.pn * 256 + wc * 64;
    const int region = nbase >> 9, hw = (nbase & 511) >> 6;
    const float* g = (region == 0) ? gqa : (region == 1) ? gka : (region == 3) ? gqb : gkb;
    const bool normed = (region != 2 && region != 5);
    const float qs = (region == 0 || region == 3) ? C2 : 1.0f;
    u16* dstR = (u16*)(ws + WS_R + (size_t)region * R_REGION);
    f32x4 gv[2][2];
#pragma unroll
    for (int bj = 0; bj < 2; ++bj)
#pragma unroll
      for (int n = 0; n < 2; ++n) gv[bj][n] = normed ? *(const f32x4*)(g + 32 * bj + 8 * fq + 4 * n) : (f32x4){1.f, 1.f, 1.f, 1.f};
#pragma unroll
    for (int ai = 0; ai < 2; ++ai)
#pragma unroll
      for (int m = 0; m < 4; ++m) {
        const int t = u.pm * 256 + ai * 128 + wr * 64 + m * 16 + fr;
        int seq_start, S, sq; seq_of(t, seq_start, S, sq);
        float scale = 1.0f;
        if (normed) {
          float ss = 0.f;
#pragma unroll
          for (int bj = 0; bj < 2; ++bj)
#pragma unroll
            for (int n = 0; n < 2; ++n) { const f32x4 v = acc[ai][bj][m][n]; ss += v[0] * v[0] + v[1] * v[1] + v[2] * v[2] + v[3] * v[3]; }
          ss += __shfl_xor(ss, 16); ss += __shfl_xor(ss, 32);
          scale = __builtin_amdgcn_rsqf(ss * (1.0f / 64.0f) + NORM_EPS) * qs;
        }
        u16* dst;
        if (region != 5) dst = dstR + (size_t)seq_start * 512 + ((size_t)hw * S + sq) * 64;
        else dst = dstR + (size_t)seq_start * 512 + ((size_t)(hw >> 1) * S + sq) * 128 + (hw & 1) * 64;
#pragma unroll
        for (int bj = 0; bj < 2; ++bj) {
          const f32x4 v0 = acc[ai][bj][m][0] * scale * gv[bj][0], v1 = acc[ai][bj][m][1] * scale * gv[bj][1];
          u32x4 o; o[0] = pk2(v0[0], v0[1]); o[1] = pk2(v0[2], v0[3]); o[2] = pk2(v1[0], v1[1]); o[3] = pk2(v1[2], v1[3]);
          *(u32x4*)(dst + 32 * bj + 8 * fq) = o;
        }
      }
  }
};

DI void phase_proj(const Params& p, unsigned char* lds) {
  pg8::Gemm g{(const u16*)((const unsigned char*)p.out + OUT_N1), (const u16*)(p.ws + WS_WIN), T_TOK, 3072, 1024};
  pg8::StaticOrder S; S.init(T_TOK, 3072, (int)gridDim.x, (int)blockIdx.x);
  EpiProj E{p.q_norm_a, p.k_norm_a, p.q_norm_b, p.k_norm_b, p.ws};
  pg8::gemm_phase<EpiProj, pg8::StaticOrder, true, true>((PG8_LAS unsigned char*)lds, g, S, E);
}

constexpr int AL_STAGE = 0;
constexpr int AL_VT    = 0;
constexpr int AL_TAB   = 131072;
constexpr int AL_TABA  = 137216;
constexpr int AL_XL    = 150016;
constexpr int AL_MISC  = 151552;

DI unsigned voff_b(int row, int ch) { return 256u * row + 16u * (ch ^ (((row & 3) << 2) | ((row >> 2) & 3))); }

template <int VAR>
DI void diff_unit(const Params& p, unsigned char* lds, int seq_start, int S, int hd, int q0, float lam) {
  const int tid = threadIdx.x, lane = tid & 63, r32 = lane & 31, h = lane >> 5;
  const int w = __builtin_amdgcn_readfirstlane(tid >> 6);
  const int map = w >> 2, wq = w & 3;
  const u16* QBp = (const u16*)(p.ws + WS_R + 3 * R_REGION);
  const u16* KBp = (const u16*)(p.ws + WS_R + 4 * R_REGION);
  const u16* VBp = (const u16*)(p.ws + WS_R + 5 * R_REGION);
  const int qpos = q0 + wq * 32 + r32;
  const int qlo = q0 + wq * 32;
  const u16* Qp = QBp + (size_t)seq_start * 512 + ((size_t)(hd * 2 + map) * S + qpos) * 64;
  bf16x8 qf[4];
#pragma unroll
  for (int ks = 0; ks < 4; ++ks) qf[ks] = *(const bf16x8*)(Qp + ks * 16 + h * 8);
  const u16* K1g = KBp + (size_t)seq_start * 512 + ((size_t)(hd * 2 + 0) * S) * 64;
  const u16* K2g = KBp + (size_t)seq_start * 512 + ((size_t)(hd * 2 + 1) * S) * 64;
  const u16* Vg = VBp + (size_t)seq_start * 512 + ((size_t)hd * S) * 128;
  const float* tab = (const float*)(lds + AL_TAB);
  const float* misc = (const float*)(lds + AL_MISC);
  const float cAfter = misc[12 + hd];
  f32x16 O[4];
#pragma unroll
  for (int nb = 0; nb < 4; ++nb)
#pragma unroll
    for (int r = 0; r < 16; ++r) O[nb][r] = 0.f;
  float l = 0.f;
  const int kr_ = 8 * w + (lane >> 3), kc_ = (lane & 7) ^ ((kr_ >> 1) & 7);
  const u16* k1src = K1g + (size_t)kr_ * 64 + kc_ * 8;
  const u16* k2src = K2g + (size_t)kr_ * 64 + kc_ * 8;
  const u16* vsrc[2];
#pragma unroll
  for (int i = 0; i < 2; ++i) { const int row = 8 * w + 4 * i + (lane >> 4); const int pc = (lane & 15) ^ (((row & 3) << 2) | ((row >> 2) & 3)); vsrc[i] = Vg + (size_t)row * 128 + pc * 8; }
  const int NKT = S / 64;
  const int i16 = lane & 15, tq = i16 >> 2, tp = i16 & 3, blk = (lane >> 4) & 1;
  int kbase4[4], vbase[4][2];
#pragma unroll
  for (int ks = 0; ks < 4; ++ks) kbase4[ks] = r32 * 128 + (((2 * ks + h) ^ ((r32 >> 1) & 7)) << 4);
#pragma unroll
  for (int nb = 0; nb < 4; ++nb)
#pragma unroll
    for (int hi = 0; hi < 2; ++hi) vbase[nb][hi] = (int)voff_b(4 * h + tq + 8 * hi, 4 * nb + 2 * blk + (tp >> 1)) + 8 * (tp & 1);
#define DU_GLDS(gsrc_, ldsoff_) do { unsigned keep_; const unsigned dst_ = (unsigned)__builtin_amdgcn_readfirstlane((int)(ldsoff_)); \
    asm volatile("s_mov_b32 %0, m0\n\ts_mov_b32 m0, %2\n\ts_nop 0\n\tglobal_load_lds_dwordx4 %1, off\n\ts_mov_b32 m0, %0" : "=&s"(keep_) : "v"(gsrc_), "s"(dst_) : "memory"); } while (0)
#define DU_DMA(kt_, st_) do { const size_t ko_ = (size_t)(kt_) * 64 * 64, vo_ = (size_t)(kt_) * 64 * 128; const unsigned b_ = lds_base + AL_STAGE + (st_) * 32768; \
    DU_GLDS(k1src + ko_, b_ + w * 1024); DU_GLDS(k2src + ko_, b_ + 8192 + w * 1024); \
    DU_GLDS(vsrc[0] + vo_, b_ + 16384 + w * 2048); DU_GLDS(vsrc[1] + vo_, b_ + 16384 + w * 2048 + 1024); } while (0)
  const unsigned lds_base = (unsigned)(uintptr_t)lds;
#define SBAR() __builtin_amdgcn_sched_barrier(0)
#define DU_VRD(slot, f, so_) do { vlo[slot] = tr_read(vp[(f) >> 1][0] + (so_) + ((f) & 1) * 4096); vhi[slot] = tr_read(vp[(f) >> 1][1] + (so_) + ((f) & 1) * 4096); } while (0)
#define DU_SUB(A, B, kq2, kso2_, has_next2_, vso_, knext_, has_next_) do { \
    SBAR(); \
    s16x4 vlo[4], vhi[4]; \
    if (VAR != 2 && VAR != 4) { DU_VRD(0, 0, vso_); DU_VRD(1, 1, vso_); DU_VRD(2, 2, vso_); DU_VRD(3, 3, vso_); } \
    if (has_next_ && VAR != 3 && VAR != 4) { \
      f32x16 z_; _Pragma("unroll") for (int r = 0; r < 16; ++r) z_[r] = 0.f; \
      B = MFMA32(kf[0], qf[0], z_); B = MFMA32(kf[1], qf[1], B); B = MFMA32(kf[2], qf[2], B); B = MFMA32(kf[3], qf[3], B); } \
    float ls = 0.f; \
    _Pragma("unroll") for (int r = 0; r < 16; ++r) ls += A[r]; \
    l += ls; \
    bf16x8 pb[2]; \
    _Pragma("unroll") for (int s2 = 0; s2 < 2; ++s2) { \
      u32x4 pw; pw[0] = pk2(A[8 * s2 + 0], A[8 * s2 + 1]); pw[1] = pk2(A[8 * s2 + 2], A[8 * s2 + 3]); \
      pw[2] = pk2(A[8 * s2 + 4], A[8 * s2 + 5]); pw[3] = pk2(A[8 * s2 + 6], A[8 * s2 + 7]); \
      pb[s2] = __builtin_bit_cast(bf16x8, pw); } \
    SBAR(); \
    if ((has_next2_) && VAR != 3 && VAR != 4) { _Pragma("unroll") for (int ks = 0; ks < 4; ++ks) kf[ks] = *(const bf16x8*)(kq2[ks] + (kso2_)); } \
    if (has_next_) { \
      const int dmin_ = (knext_) - (qlo + 31), dmax_ = (knext_) + 31 - qlo; \
      if (dmin_ < 559) { \
        if (in_after) { in_after = false; _Pragma("unroll") for (int nb = 0; nb < 4; ++nb) _Pragma("unroll") for (int r = 0; r < 16; ++r) O[nb][r] *= fAfter; l *= fAfter; \
                        _Pragma("unroll") for (int s2 = 0; s2 < 2; ++s2) {   \
                          u32x4 pw; pw[0] = pk2(A[8 * s2 + 0] * fAfter, A[8 * s2 + 1] * fAfter); pw[1] = pk2(A[8 * s2 + 2] * fAfter, A[8 * s2 + 3] * fAfter); \
                          pw[2] = pk2(A[8 * s2 + 4] * fAfter, A[8 * s2 + 5] * fAfter); pw[3] = pk2(A[8 * s2 + 6] * fAfter, A[8 * s2 + 7] * fAfter); \
                          pb[s2] = __builtin_bit_cast(bf16x8, pw); } } \
        if (dmax_ > -559) { const int base_ = (knext_) + 4 * h - qpos + 640; \
          _Pragma("unroll") for (int r = 0; r < 16; ++r) B[r] += tab[base_ + (r & 3) + 8 * (r >> 2)]; } } } \
    _Pragma("unroll") for (int f = 0; f < 8; ++f) { \
      if (VAR != 2 && VAR != 4) { O[f >> 1] = MFMA32(cat8(vlo[f & 3], vhi[f & 3]), pb[f & 1], O[f >> 1]); \
      if (f + 4 < 8) DU_VRD(f & 3, f + 4, vso_); } \
      if (VAR != 1 && VAR != 4) { B[2 * f] = __builtin_amdgcn_exp2f(B[2 * f]); B[2 * f + 1] = __builtin_amdgcn_exp2f(B[2 * f + 1]); } } \
  } while (0)
  f32x16 X, Y; bf16x8 kf[4];
  const float fAfter = __builtin_amdgcn_exp2f(cAfter);
  bool in_after = true;
  const int KT1 = NKT - 1;
  DU_DMA(KT1, 0);
  if (NKT > 1) DU_DMA(KT1 - 1, 1);
  asm volatile("s_waitcnt vmcnt(0)" ::: "memory");
  __syncthreads();
  {
    const unsigned char* kb_ = lds + AL_STAGE + map * 8192 + 4096;
    f32x16 z_;
#pragma unroll
    for (int r = 0; r < 16; ++r) z_[r] = 0.f;
    X = MFMA32(*(const bf16x8*)(kb_ + kbase4[0]), qf[0], z_); X = MFMA32(*(const bf16x8*)(kb_ + kbase4[1]), qf[1], X);
    X = MFMA32(*(const bf16x8*)(kb_ + kbase4[2]), qf[2], X); X = MFMA32(*(const bf16x8*)(kb_ + kbase4[3]), qf[3], X);
    const int knext = 64 * KT1 + 32;
    const int dmin_ = knext - (qlo + 31), dmax_ = knext + 31 - qlo;
    if (dmin_ < 559) {
      in_after = false;
      if (dmax_ > -559) { const int base_ = knext + 4 * h - qpos + 640;
#pragma unroll
        for (int r = 0; r < 16; ++r) X[r] += tab[base_ + (r & 3) + 8 * (r >> 2)]; }
    }
#pragma unroll
    for (int r = 0; r < 16; ++r) X[r] = __builtin_amdgcn_exp2f(X[r]);
#pragma unroll
    for (int ks = 0; ks < 4; ++ks) kf[ks] = *(const bf16x8*)(lds + AL_STAGE + map * 8192 + kbase4[ks]);
  }
  int st_cur = 0, st_nxt = 32768, st_free = 65536;
  for (int i = 0; i < NKT; ++i) {
    const int kt = KT1 - i;
    asm volatile("s_waitcnt vmcnt(0)" ::: "memory");
    __syncthreads();
    if (i + 2 < NKT) DU_DMA(kt - 2, st_free / 32768);
    const unsigned char* knx[4]; const unsigned char* vp[4][2];
#pragma unroll
    for (int ks = 0; ks < 4; ++ks) knx[ks] = lds + AL_STAGE + st_nxt + map * 8192 + kbase4[ks];
#pragma unroll
    for (int nb = 0; nb < 4; ++nb) { vp[nb][0] = lds + AL_STAGE + st_cur + 16384 + vbase[nb][0]; vp[nb][1] = lds + AL_STAGE + st_cur + 16384 + vbase[nb][1]; }
    DU_SUB(X, Y, knx, 4096, (i + 1 < NKT), 8192, 64 * kt, true);
    DU_SUB(Y, X, knx, 0, (i + 1 < NKT), 0, 64 * kt - 32, (i + 1 < NKT));
    { const int t_ = st_cur; st_cur = st_nxt; st_nxt = st_free; st_free = t_; }
  }
#undef DU_DMA
#undef DU_GLDS
#undef DU_VRD
#undef DU_SUB
#undef SBAR
  if (in_after) {
#pragma unroll
    for (int nb = 0; nb < 4; ++nb)
#pragma unroll
      for (int r = 0; r < 16; ++r) O[nb][r] *= fAfter;
    l *= fAfter;
  }
  if (VAR != 0) {
#pragma unroll
    for (int nb = 0; nb < 4; ++nb) asm volatile("" :: "v"(O[nb]));
    asm volatile("" :: "v"(l), "v"(X), "v"(Y));
    __syncthreads();
    return;
  }
  __syncthreads();
  float ltot = l + __shfl_xor(l, 32);
  float* xbuf = (float*)(lds + AL_STAGE);
  if (map == 1) {
    const float inv = 1.0f / ltot;
#pragma unroll
    for (int nb = 0; nb < 4; ++nb)
#pragma unroll
      for (int r = 0; r < 16; ++r) xbuf[((wq * 64 + nb * 16 + r) << 6) + lane] = O[nb][r] * inv;
  }
  __syncthreads();
  if (map == 0) {
    const float inv = 1.0f / ltot;
    float ss = 0.f;
#pragma unroll
    for (int nb = 0; nb < 4; ++nb)
#pragma unroll
      for (int r = 0; r < 16; ++r) {
        float o = O[nb][r] * inv - lam * xbuf[((wq * 64 + nb * 16 + r) << 6) + lane];
        O[nb][r] = o; ss += o * o;
      }
    ss += __shfl_xor(ss, 32);
    const float rn = __builtin_amdgcn_rsqf(ss * (1.0f / 128.0f) + NORM_EPS) * 0.8f;
    u16* mix = (u16*)((unsigned char*)p.out + OUT_MIX) + (size_t)(seq_start + qpos) * 1024 + 512 + hd * 128;
#pragma unroll
    for (int nb = 0; nb < 4; ++nb)
#pragma unroll
      for (int g4 = 0; g4 < 4; ++g4) {
        const int d0 = 32 * nb + 8 * g4 + 4 * h;
        f32x4 gg = *(const f32x4*)(p.diff_norm_g + d0);
        u32x2 o; o[0] = pk2(O[nb][4 * g4 + 0] * rn * gg[0], O[nb][4 * g4 + 1] * rn * gg[1]);
        o[1] = pk2(O[nb][4 * g4 + 2] * rn * gg[2], O[nb][4 * g4 + 3] * rn * gg[3]);
        *(u32x2*)(mix + d0) = o;
      }
  }
  __syncthreads();
}

constexpr int AL_DPART = 65536;
constexpr int AL_DL    = AL_TAB;
template <int PASS>
DI void dil_wave_item(const Params& p, unsigned char* lds, int seq_start, int S, int hd, int i0, int sel) {
  const int tid = threadIdx.x, lane = tid & 63, r32 = lane & 31, h = lane >> 5;
  const int w = __builtin_amdgcn_readfirstlane(tid >> 6);
  const u16* QAp = (const u16*)(p.ws + WS_R + 0 * R_REGION);
  const u16* KAp = (const u16*)(p.ws + WS_R + 1 * R_REGION);
  const u16* VAp = (const u16*)(p.ws + WS_R + 2 * R_REGION);
  constexpr int QSTR = (PASS == 1) ? 1 : 16;
  constexpr int NTILE = (PASS == 1) ? 5 : 13;
  const int qbase = (PASS == 1) ? i0 + 32 * sel : i0 + sel;
  const int qpos = qbase + QSTR * r32;
  const int tl = qpos - i0;
  const u16* Qp = QAp + (size_t)seq_start * 512 + ((size_t)hd * S + qpos) * 64;
  bf16x8 qf[4];
#pragma unroll
  for (int ks = 0; ks < 4; ++ks) qf[ks] = *(const bf16x8*)(Qp + ks * 16 + h * 8);
  const u16* Kg = KAp + (size_t)seq_start * 512 + ((size_t)hd * S) * 64;
  const u16* Vg = VAp + (size_t)seq_start * 512 + ((size_t)hd * S) * 64;
  unsigned char* vt = lds + AL_VT + w * 8192;
  unsigned char* ktl = vt + 4096;
  const float* tabA = (const float*)(lds + AL_TABA) + hd * 3 * 132;
  unsigned char* dpart = lds + AL_DPART;
  float* dl = (float*)(lds + AL_DL);
  const int psw = ((tl >> 4) ^ tl) & 15;
  f32x16 O[2];
  float l = 0.f;
  if (PASS == 1) {
#pragma unroll
    for (int nb = 0; nb < 2; ++nb)
#pragma unroll
      for (int r = 0; r < 16; ++r) O[nb][r] = 0.f;
  } else {
#pragma unroll
    for (int nb = 0; nb < 2; ++nb)
#pragma unroll
      for (int g4 = 0; g4 < 4; ++g4) {
        const int ch = 8 * nb + 2 * g4 + h;
        const u32x2 v = *(const u32x2*)(dpart + tl * 128 + ((ch ^ psw) << 3));
        O[nb][4 * g4 + 0] = __uint_as_float(v[0] << 16); O[nb][4 * g4 + 1] = __uint_as_float(v[0] & 0xffff0000u);
        O[nb][4 * g4 + 2] = __uint_as_float(v[1] << 16); O[nb][4 * g4 + 3] = __uint_as_float(v[1] & 0xffff0000u);
      }
    if (h == 0) l = dl[tl];
  }
  const int i16 = lane & 15, tq = i16 >> 2, tp = i16 & 3, blk = (lane >> 4) & 1;
  int vrb[2][2];
#pragma unroll
  for (int nb = 0; nb < 2; ++nb)
#pragma unroll
    for (int hi = 0; hi < 2; ++hi) {
      const int R = 4 * h + tq + 8 * hi; const int ch = 4 * nb + 2 * blk + (tp >> 1);
      const int sw = (((R >> 1) & 1) << 2) ^ ((R >> 2) & 3);
      vrb[nb][hi] = R * 128 + ((ch ^ sw) << 4) + 8 * (tp & 1);
    }
  bf16x8 kfb[1][4]; u32x4 vcb[1][4];
  const int lrow = lane >> 3, lch = lane & 7;
#define DL_PARAMS(tau_) \
    const int d_ = (PASS == 1) ? 1 : (((tau_) < 5) ? 16 : 4); const int br_ = (PASS == 1) ? 2 : (((tau_) < 5) ? 0 : 1); \
    const int tt_ = (PASS == 1) ? (tau_) : (((tau_) < 5) ? (tau_) : (tau_) - 5); const int ratio_ = QSTR / d_; \
    const int n0_ = -64 + 32 * tt_;
#define DL_LOAD(buf, tau_) do { DL_PARAMS(tau_) \
    _Pragma("unroll") for (int i4 = 0; i4 < 4; ++i4) { int kpos_ = qbase + d_ * (n0_ + 8 * i4 + lrow); kpos_ = kpos_ < 0 ? 0 : (kpos_ >= S ? S - 1 : kpos_); \
      kfb[buf][i4] = *(const bf16x8*)(Kg + (size_t)kpos_ * 64 + lch * 8); vcb[buf][i4] = *(const u32x4*)(Vg + (size_t)kpos_ * 64 + lch * 8); } (void)br_; (void)ratio_; } while (0)
#define DL_STORE(buf) do { \
    _Pragma("unroll") for (int i4 = 0; i4 < 4; ++i4) { const int row_ = 8 * i4 + lrow; const int sw_ = (((row_ >> 1) & 1) << 2) ^ ((row_ >> 2) & 3); \
      *(u32x4*)(vt + row_ * 128 + ((lch ^ sw_) << 4)) = vcb[buf][i4]; \
      *(bf16x8*)(ktl + row_ * 128 + ((lch ^ ((row_ >> 1) & 7)) << 4)) = kfb[buf][i4]; } } while (0)
#define DL_COMPUTE(buf, tau_) do { DL_PARAMS(tau_) \
    const int kfirst_ = qbase + d_ * n0_, klast_ = qbase + d_ * (n0_ + 31); \
    const int base_ = n0_ + 4 * h - ratio_ * r32; const float* tb_ = tabA + br_ * 132; \
    f32x16 sT; \
    _Pragma("unroll") for (int r = 0; r < 16; ++r) { int dd = base_ + (r & 3) + 8 * (r >> 2); dd = dd < -65 ? -65 : (dd > 65 ? 65 : dd); sT[r] = tb_[dd + 65]; } \
    if (kfirst_ < 0 || klast_ >= S) { _Pragma("unroll") for (int r = 0; r < 16; ++r) { const int kp = qbase + d_ * (n0_ + crow(r, h)); if (kp < 0 || kp >= S) sT[r] = NEG_BIG; } } \
    _Pragma("unroll") for (int ks = 0; ks < 4; ++ks) { const bf16x8 ka_ = *(const bf16x8*)(ktl + r32 * 128 + (((2 * ks + h) ^ ((r32 >> 1) & 7)) << 4)); sT = MFMA32(ka_, qf[ks], sT); } \
    float ls = 0.f; \
    _Pragma("unroll") for (int r = 0; r < 16; ++r) { sT[r] = __builtin_amdgcn_exp2f(sT[r]); ls += sT[r]; } \
    l += ls; \
    bf16x8 pb[2]; \
    _Pragma("unroll") for (int s2 = 0; s2 < 2; ++s2) { \
      u32x4 pw; pw[0] = pk2(sT[8 * s2 + 0], sT[8 * s2 + 1]); pw[1] = pk2(sT[8 * s2 + 2], sT[8 * s2 + 3]); \
      pw[2] = pk2(sT[8 * s2 + 4], sT[8 * s2 + 5]); pw[3] = pk2(sT[8 * s2 + 6], sT[8 * s2 + 7]); \
      pb[s2] = __builtin_bit_cast(bf16x8, pw); } \
    _Pragma("unroll") for (int nb = 0; nb < 2; ++nb) _Pragma("unroll") for (int s2 = 0; s2 < 2; ++s2) { \
        const s16x4 lo = tr_read(vt + vrb[nb][0] + s2 * 2048); const s16x4 hi = tr_read(vt + vrb[nb][1] + s2 * 2048); \
        O[nb] = MFMA32(cat8(lo, hi), pb[s2], O[nb]); } \
  } while (0)
  DL_LOAD(0, 0);
#pragma unroll 1
  for (int tau = 0; tau < NTILE; ++tau) {
    DL_STORE(0);
    { const int tn = (tau + 1 < NTILE) ? tau + 1 : tau; DL_LOAD(0, tn); }
    DL_COMPUTE(0, tau);
  }
#undef DL_PARAMS
#undef DL_LOAD
#undef DL_STORE
#undef DL_COMPUTE
  const float ltot = l + __shfl_xor(l, 32);
  if (PASS == 1) {
#pragma unroll
    for (int nb = 0; nb < 2; ++nb)
#pragma unroll
      for (int g4 = 0; g4 < 4; ++g4) {
        const int ch = 8 * nb + 2 * g4 + h;
        u32x2 o; o[0] = pk2(O[nb][4 * g4 + 0], O[nb][4 * g4 + 1]); o[1] = pk2(O[nb][4 * g4 + 2], O[nb][4 * g4 + 3]);
        *(u32x2*)(dpart + tl * 128 + ((ch ^ psw) << 3)) = o;
      }
    if (h == 0) dl[tl] = ltot;
  } else {
    const float inv = 1.0f / ltot;
    u16* mix = (u16*)((unsigned char*)p.out + OUT_MIX) + (size_t)(seq_start + qpos) * 1024 + hd * 64;
#pragma unroll
    for (int nb = 0; nb < 2; ++nb)
#pragma unroll
      for (int g4 = 0; g4 < 4; ++g4) {
        const int d0 = 32 * nb + 8 * g4 + 4 * h;
        u32x2 o; o[0] = pk2(O[nb][4 * g4 + 0] * inv, O[nb][4 * g4 + 1] * inv); o[1] = pk2(O[nb][4 * g4 + 2] * inv, O[nb][4 * g4 + 3] * inv);
        *(u32x2*)(mix + d0) = o;
      }
  }
}

DI void phase_attn(const Params& p, unsigned char* lds) {
  const int tid = threadIdx.x;
  float* misc = (float*)(lds + AL_MISC);
  if (tid == 0) {
    float gqa = 0.f, gka = 0.f, gqb = 0.f, gkb = 0.f, bm = 0.f;
    for (int i = 0; i < 64; ++i) { gqa = fmaxf(gqa, fabsf(p.q_norm_a[i])); gka = fmaxf(gka, fabsf(p.k_norm_a[i])); gqb = fmaxf(gqb, fabsf(p.q_norm_b[i])); gkb = fmaxf(gkb, fabsf(p.k_norm_b[i])); }
    for (int i = 0; i < 32 * 12; ++i) bm = fmaxf(bm, fabsf(p.rel_bias[i]));
    const float M2 = 8.0f * LOG2E * fmaxf(gqa * gka, gqb * gkb) * 1.02f + bm * LOG2E + 0.1f;
    float s1 = 0.f, s2 = 0.f;
    for (int i = 0; i < 64; ++i) { s1 += p.lq1[i] * p.lk1[i]; s2 += p.lq2[i] * p.lk2[i]; }
    misc[0] = M2; misc[1] = expf(s1) - expf(s2) + 0.2f;
    for (int hd = 0; hd < 4; ++hd) { misc[8 + hd] = p.rel_bias[15 * 12 + 8 + hd] * LOG2E; misc[12 + hd] = (p.rel_bias[31 * 12 + 8 + hd] - p.rel_bias[15 * 12 + 8 + hd]) * LOG2E; }
  }
  __syncthreads();
  const float M2 = misc[0], lam = misc[1];
  {
    float* tabA = (float*)(lds + AL_TABA);
    for (int i = tid; i < 8 * 3 * 132; i += NTHR) {
      int hd = i / 396, rem = i % 396, br = rem / 132, idx = rem % 132;
      int dl = idx - 65; float v = NEG_BIG;
      if (dl >= -64 && dl <= 64 && idx < 131) { int d = (br == 0) ? 16 : (br == 1) ? 4 : 1; v = p.rel_bias[rel_bucket(dl * d) * 12 + hd] * LOG2E - M2; }
      tabA[i] = v;
    }
  }
#ifndef REP_DIFF
#define REP_DIFF 1
#endif
#ifndef REP_DIL
#define REP_DIL 1
#endif
  int cur_hd = -1;
  for (int rep_ = 0; rep_ < REP_DIFF; ++rep_)
  for (int vb = blockIdx.x; vb < 256; vb += gridDim.x) {
    const int xl = vb & 7, rk = vb >> 3;
#pragma unroll 1
    for (int rnd = 0; rnd < 8; ++rnd) {
      int seq_start, S, hd, q0;
      if (rnd < 4) { const int pair = xl + 8 * rnd; hd = pair & 3; S = 4096; seq_start = (pair >> 2) * 4096; q0 = rk * 128; }
      else { const int pair = 8 * xl + 2 * (rnd - 4) + (rk >> 4); hd = pair & 3; S = 2048; seq_start = T_PROMPT + (pair >> 2) * 2048; q0 = (rk & 15) * 128; }
      if (hd != cur_hd) {
        __syncthreads();
        float* tab = (float*)(lds + AL_TAB);
        for (int i = tid; i < 1281; i += NTHR) tab[i] = p.rel_bias[rel_bucket(i - 640) * 12 + 8 + hd] * LOG2E - misc[8 + hd];
        cur_hd = hd;
        __syncthreads();
      }
#ifndef PROBE_VAR
#define PROBE_VAR 0
#endif
      if (rep_ == 0) diff_unit<0>(p, lds, seq_start, S, hd, q0, lam); else diff_unit<PROBE_VAR>(p, lds, seq_start, S, hd, q0, lam);
    }
  }
  __syncthreads();
  const int w = tid >> 6;
  for (int rep_ = 0; rep_ < REP_DIL; ++rep_)
  for (int vb = blockIdx.x; vb < 256; vb += gridDim.x)
#pragma unroll 1
  for (int rnd = 0; rnd < 4; ++rnd) {
    const int xl = vb & 7, rk = vb >> 3;
    int seq_start, S, hd, i0;
    if (rnd < 2) { const int pair = xl * 8 + rnd * 4 + (rk >> 3); hd = pair & 7; S = 4096; seq_start = (pair >> 3) * 4096; i0 = (rk & 7) * 512; }
    else { const int pair = xl * 16 + (rnd - 2) * 8 + (rk >> 2); hd = pair & 7; S = 2048; seq_start = T_PROMPT + (pair >> 3) * 2048; i0 = (rk & 3) * 512; }
    __syncthreads();
#pragma unroll 1
    for (int u2 = 0; u2 < 2; ++u2) dil_wave_item<1>(p, lds, seq_start, S, hd, i0, w + 8 * u2);
    __syncthreads();
#pragma unroll 1
    for (int u2 = 0; u2 < 2; ++u2) dil_wave_item<2>(p, lds, seq_start, S, hd, i0, w + 8 * u2);
  }
}

struct EpiOut {
  static constexpr bool PERM = false, AFTER_DRAIN = false, HEADPERM = false;
  const float* xp; const float* xs; float* x1;
  __device__ __forceinline__ void operator()(const pg8::f32x4 (&acc)[2][2][4][2], const pg8::Unit& u, int wr, int wc, int fr, int fq) const {
    const int col0 = u.pn * 256 + wc * 32 + 4 * fq;
#pragma unroll
    for (int ai = 0; ai < 2; ++ai)
#pragma unroll
      for (int m = 0; m < 4; ++m) {
        const int t = u.pm * 256 + ai * 128 + wr * 64 + m * 16 + fr;
        const float* xr = ((t < T_PROMPT) ? xp + (size_t)t * DM : xs + (size_t)(t - T_PROMPT) * DM) + col0;
        float* orow = x1 + (size_t)t * DM + col0;
#pragma unroll
        for (int bj = 0; bj < 2; ++bj)
#pragma unroll
          for (int n = 0; n < 2; ++n) {
            const f32x4 xv = *(const f32x4*)(xr + bj * 128 + n * 16);
            *(f32x4*)(orow + bj * 128 + n * 16) = xv + acc[ai][bj][m][n];
          }
      }
  }
};

DI void phase_outproj(const Params& p, unsigned char* lds) {
  pg8::Gemm g{(const u16*)((const unsigned char*)p.out + OUT_MIX), (const u16*)(p.ws + WS_WOUT), T_TOK, 1024, 1024};
  pg8::StaticOrder S; S.init(T_TOK, 1024, (int)gridDim.x, (int)blockIdx.x);
  EpiOut E{p.x_prompt, p.x_sample, (float*)(p.ws + WS_X1)};
  pg8::gemm_phase<EpiOut, pg8::StaticOrder, true, true>((PG8_LAS unsigned char*)lds, g, S, E);
}

DI void phase_norm2(const Params& p) {
  const int tid = threadIdx.x, lane = tid & 63, w = tid >> 6;
  const float* x1 = (const float*)(p.ws + WS_X1);
  u16* hb = (u16*)(p.ws + WS_H);
  for (int it = blockIdx.x; it < T_TOK / 8; it += gridDim.x) {
    int t = it * 8 + w;
    norm_row(x1 + (size_t)t * DM, p.ffn_norm_g, hb + (size_t)t * DM, lane);
  }
}

struct EpiQp {
  static constexpr bool PERM = true, AFTER_DRAIN = false, HEADPERM = false;
  u16* O;
  __device__ __forceinline__ void operator()(const pg8::f32x4 (&acc)[2][2][4][2], const pg8::Unit& u, int wr, int wc, int fr, int fq) const {
    const int col0 = u.pn * 256 + wc * 32 + 8 * fq;
#pragma unroll
    for (int ai = 0; ai < 2; ++ai)
#pragma unroll
      for (int m = 0; m < 4; ++m) {
        const int t = u.pm * 256 + ai * 128 + wr * 64 + m * 16 + fr;
        u16* rowp = O + (size_t)t * 2048 + col0;
#pragma unroll
        for (int bj = 0; bj < 2; ++bj) {
          const f32x4 v0 = acc[ai][bj][m][0], v1 = acc[ai][bj][m][1];
          u32x4 o; o[0] = pk2(v0[0], v0[1]); o[1] = pk2(v0[2], v0[3]); o[2] = pk2(v1[0], v1[1]); o[3] = pk2(v1[2], v1[3]);
          *(u32x4*)(rowp + bj * 128) = o;
        }
      }
  }
};

DI void phase_peer_query(const Params& p, unsigned char* lds) {
  pg8::Gemm g{(const u16*)(p.ws + WS_H), (const u16*)(p.ws + WS_WQ), T_TOK, 2048, 1024};
  pg8::StaticOrder S; S.init(T_TOK, 2048, (int)gridDim.x, (int)blockIdx.x);
  EpiQp E{(u16*)p.out};
  pg8::gemm_phase<EpiQp, pg8::StaticOrder, true, true>((PG8_LAS unsigned char*)lds, g, S, E);
}

DI int f2sort(float f) { const int b = __float_as_int(f); return b ^ ((b >> 31) & 0x7fffffff); }
DI float sort2f(int s) { return __int_as_float(s ^ ((s >> 31) & 0x7fffffff)); }
#define CE_DESC(a, b) do { const int mx_ = max((a), (b)), mn_ = min((a), (b)); (a) = mx_; (b) = mn_; } while (0)
#define CE_ASC(a, b) do { const int mx_ = max((a), (b)), mn_ = min((a), (b)); (a) = mn_; (b) = mx_; } while (0)
template <int OFF> DI void sort16_desc(int (&x)[64]) {
#pragma unroll
  for (int k = 2; k <= 16; k <<= 1)
#pragma unroll
    for (int j = k >> 1; j > 0; j >>= 1)
#pragma unroll
      for (int i = 0; i < 16; ++i) {
        const int l = i ^ j;
        if (l > i) { if ((i & k) == 0) CE_DESC(x[OFF + i], x[OFF + l]); else CE_ASC(x[OFF + i], x[OFF + l]); }
      }
}
template <int A, int B> DI void merge16x(int (&x)[64]) {
#pragma unroll
  for (int i = 0; i < 16; ++i) x[A + i] = max(x[A + i], x[B + 15 - i]);
#pragma unroll
  for (int j = 8; j > 0; j >>= 1)
#pragma unroll
    for (int i = 0; i < 16; ++i) { const int l = i ^ j; if (l > i) CE_DESC(x[A + i], x[A + l]); }
}

DI void phase_peer_route(const Params& p, unsigned char* lds) {
  const u16* QP = (const u16*)p.out;
  const u16* SK = (const u16*)(p.ws + WS_SK);
  u16* eidx = (u16*)(p.ws + WS_EIDX);
  float* gg = (float*)(p.ws + WS_G);
  const int tid = threadIdx.x, lane = tid & 63, r32 = lane & 31, h = lane >> 5;
  const int w = __builtin_amdgcn_readfirstlane(tid >> 6);
  unsigned char* SKl = lds;
  float* v2l = (float*)(lds + 65536);
  __syncthreads();
#pragma unroll
  for (int i = 0; i < 8; ++i) {
    const int c = tid + 512 * i; const int zz = c >> 11, row = (c >> 4) & 127, ch = c & 15;
    const u32x4 v = *(const u32x4*)(SK + (size_t)zz * 16384 + row * 128 + ch * 8);
    *(u32x4*)(SKl + zz * 32768 + row * 256 + ((ch ^ (row & 15)) << 4)) = v;
  }
  __syncthreads();
  for (int item = blockIdx.x; item < T_TOK / 256; item += gridDim.x) {
    const int t = item * 256 + w * 32 + r32;
    const u16* qrow = QP + (size_t)t * 2048;
#pragma unroll 1
    for (int pp = 0; pp < 8; ++pp) {
      int lists[2][16];
#pragma unroll
      for (int z = 0; z < 2; ++z) {
        const int c16 = pp * 2 + z;
        int x[64];
        {
          bf16x8 qf[8];
#pragma unroll
          for (int ks = 0; ks < 8; ++ks) qf[ks] = *(const bf16x8*)(qrow + c16 * 128 + ks * 16 + h * 8);
          f32x16 S2[4];
#pragma unroll
          for (int kb = 0; kb < 4; ++kb)
#pragma unroll
            for (int r = 0; r < 16; ++r) S2[kb][r] = 0.f;
#pragma unroll
          for (int ks = 0; ks < 8; ++ks)
#pragma unroll
            for (int kb = 0; kb < 4; ++kb) {
              const int key = kb * 32 + r32;
              const bf16x8 a = *(const bf16x8*)(SKl + z * 32768 + key * 256 + (((2 * ks + h) ^ (key & 15)) << 4));
              S2[kb] = MFMA32(a, qf[ks], S2[kb]);
            }
#pragma unroll
          for (int e = 0; e < 64; ++e) {
            const int kidx = 32 * (e >> 4) + (e & 3) + 8 * ((e & 15) >> 2) + 4 * h;
            x[e] = (f2sort(S2[e >> 4][e & 15]) & ~127) | kidx;
          }
        }
        sort16_desc<0>(x); sort16_desc<16>(x); sort16_desc<32>(x); sort16_desc<48>(x);
        merge16x<0, 16>(x); merge16x<32, 48>(x); merge16x<0, 32>(x);
#pragma unroll
        for (int i = 0; i < 16; ++i) x[16 + i] = __shfl_xor(x[i], 32);
        merge16x<0, 16>(x);
#pragma unroll
        for (int i = 0; i < 16; ++i) lists[z][i] = x[i];
      }
      float v1[16];
#pragma unroll
      for (int i = 0; i < 16; ++i) { v1[i] = sort2f(lists[0][i]); v2l[i * 512 + tid] = sort2f(lists[1][i]); }
      unsigned long long ptrs = 0ull;
      float bestv[16]; int be[16];
#pragma unroll
      for (int rd = 0; rd < 16; ++rd) {
        float best = -3.0e38f, bv1 = 0.f, bv2 = 0.f; int ab = 0;
#pragma unroll
        for (int a = 0; a < 16; ++a) {
          const int b = (int)((ptrs >> (4 * a)) & 15ull);
          const float v2 = v2l[b * 512 + tid];
          const float cnd = v1[a] + v2;
          if (cnd > best) { best = cnd; ab = a; bv1 = v1[a]; bv2 = v2; }
        }
        bestv[rd] = best; be[rd] = (f2sort(bv1) & 127) * 128 + (f2sort(bv2) & 127);
        ptrs += 1ull << (4 * ab);
      }
      if (h == 0) {
        float ex[16]; float sum = 0.f;
#pragma unroll
        for (int rd = 0; rd < 16; ++rd) { ex[rd] = __expf(bestv[rd] - bestv[0]); sum += ex[rd]; }
        const float inv = 1.0f / sum;
        const size_t oo = ((size_t)t * 8 + pp) * 16;
#pragma unroll
        for (int q4 = 0; q4 < 4; ++q4) { f32x4 v = {ex[4 * q4] * inv, ex[4 * q4 + 1] * inv, ex[4 * q4 + 2] * inv, ex[4 * q4 + 3] * inv}; *(f32x4*)(gg + oo + 4 * q4) = v; }
        u32x4 e0, e1;
#pragma unroll
        for (int j = 0; j < 4; ++j) { e0[j] = (unsigned)be[2 * j] | ((unsigned)be[2 * j + 1] << 16); e1[j] = (unsigned)be[8 + 2 * j] | ((unsigned)be[8 + 2 * j + 1] << 16); }
        *(u32x4*)(eidx + oo) = e0; *(u32x4*)(eidx + oo + 8) = e1;
      }
    }
  }
}

typedef float f2_t __attribute__((ext_vector_type(2)));
DI unsigned xcc_id() { return (unsigned)__builtin_amdgcn_s_getreg((3 << 11) | 20) & 7u; }
constexpr int PG_CHUNK_TOK = 64;
constexpr int PG_NCHUNK = T_TOK / PG_CHUNK_TOK;

DI void dec16(const u32x4& r, f2_t (&v)[8]) {
#pragma unroll
  for (int d = 0; d < 4; ++d) { v[2 * d] = __builtin_amdgcn_cvt_pk_f32_fp8((int)r[d], false); v[2 * d + 1] = __builtin_amdgcn_cvt_pk_f32_fp8((int)r[d], true); }
}

template <int CTRL> DI float dpp_f(float x) { return __int_as_float(__builtin_amdgcn_update_dpp(0, __float_as_int(x), CTRL, 0xf, 0xf, true)); }
DI int idx16(const u32x4& a, const u32x4& b, int i) { const unsigned wd = (i < 8) ? a[(i & 7) >> 1] : b[(i & 7) >> 1]; return (i & 1) ? (int)(wd >> 16) : (int)(wd & 0xffffu); }
template <int WHICH>
DI void peer_wave_tokens(const Params& p, int x, int tb, int lane) {
  const unsigned char* TBL = p.ws + (WHICH ? WS_V : WS_U) + (size_t)x * 16384 * 128;
  const u16* Hb = (const u16*)(p.ws + WS_H);
  const u16* eidx = (const u16*)(p.ws + WS_EIDX);
  const float* wg = (const float*)(p.ws + WS_G);
  const float* x1 = (const float*)(p.ws + WS_X1);
  float* zpart = (float*)p.out;
  const int r = lane >> 3, c = lane & 7;
  u32x4 ei[2][2]; f32x4 wv[2][4]; u32x4 rows[2][16];
#define PEER_LOAD_IDX(buf, k) do { const size_t o_ = (size_t)(tb + (k)) * 128 + r * 16; \
    ei[buf][0] = *(const u32x4*)(eidx + o_); ei[buf][1] = *(const u32x4*)(eidx + o_ + 8); \
    if (WHICH) { _Pragma("unroll") for (int q = 0; q < 4; ++q) wv[buf][q] = *(const f32x4*)(wg + o_ + 4 * q); } } while (0)
#define PEER_LOAD_ROWS(buf, ibuf) do { _Pragma("unroll") for (int i = 0; i < 16; ++i) { \
      const unsigned off_ = (unsigned)idx16(ei[ibuf][0], ei[ibuf][1], i) * 128u + (unsigned)c * 16u; \
      rows[buf][i] = *(const u32x4*)(TBL + off_); } } while (0)
  PEER_LOAD_IDX(0, 0); PEER_LOAD_IDX(1, 1);
  PEER_LOAD_ROWS(0, 0);
#pragma unroll
  for (int k = 0; k < 8; ++k) {
    const int t = tb + k;
    if (k + 1 < 8) PEER_LOAD_ROWS((k + 1) & 1, (k + 1) & 1);
    f32x4 wcur[4];
    if (WHICH) {
#pragma unroll
      for (int q = 0; q < 4; ++q) wcur[q] = wv[k & 1][q];
    }
    if (k + 2 < 8) PEER_LOAD_IDX(k & 1, k + 2);
    if (WHICH == 0) {
      u32x4 ha = *(const u32x4*)(Hb + (size_t)t * DM + x * 128 + c * 16), hb = *(const u32x4*)(Hb + (size_t)t * DM + x * 128 + c * 16 + 8);
      f2_t hq[8];
#pragma unroll
      for (int j = 0; j < 4; ++j) {
        hq[j][0] = __uint_as_float(ha[j] << 16); hq[j][1] = __uint_as_float(ha[j] & 0xffff0000u);
        hq[4 + j][0] = __uint_as_float(hb[j] << 16); hq[4 + j][1] = __uint_as_float(hb[j] & 0xffff0000u);
      }
      float sv[16];
#pragma unroll
      for (int i = 0; i < 16; ++i) {
        f2_t v[8]; dec16(rows[k & 1][i], v);
        f2_t a = v[0] * hq[0];
#pragma unroll
        for (int q = 1; q < 8; ++q) a = __builtin_elementwise_fma(v[q], hq[q], a);
        float sx = a[0] + a[1];
        sx += dpp_f<0xB1>(sx);
        sx += dpp_f<0x4E>(sx);
        sx += dpp_f<0x141>(sx);
        sv[i] = sx;
      }
      float o0 = 0.f, o1 = 0.f;
#pragma unroll
      for (int i = 0; i < 8; ++i) { if (c == i) { o0 = sv[i]; o1 = sv[i + 8]; } }
      float* zp = zpart + ((size_t)x * T_TOK + t) * 128 + r * 16;
      zp[c] = o0; zp[c + 8] = o1;
    } else {
      f2_t acc[8];
#pragma unroll
      for (int q = 0; q < 8; ++q) { acc[q][0] = 0.f; acc[q][1] = 0.f; }
#pragma unroll
      for (int i = 0; i < 16; ++i) {
        f2_t v[8]; dec16(rows[k & 1][i], v);
        const float wj = wcur[i >> 2][i & 3];
        f2_t ww = {wj, wj};
#pragma unroll
        for (int q = 0; q < 8; ++q) acc[q] = __builtin_elementwise_fma(v[q], ww, acc[q]);
      }
      f2_t b4[4];
      {
        const bool up = (lane & 32) != 0;
#pragma unroll
        for (int q = 0; q < 4; ++q) {
          f2_t keep = up ? acc[4 + q] : acc[q], send = up ? acc[q] : acc[4 + q];
          f2_t got; got[0] = __shfl_xor(send[0], 32); got[1] = __shfl_xor(send[1], 32);
          b4[q] = keep + got;
        }
      }
      f2_t b2[2];
      {
        const bool up = (lane & 16) != 0;
#pragma unroll
        for (int q = 0; q < 2; ++q) {
          f2_t keep = up ? b4[2 + q] : b4[q], send = up ? b4[q] : b4[2 + q];
          f2_t got; got[0] = __shfl_xor(send[0], 16); got[1] = __shfl_xor(send[1], 16);
          b2[q] = keep + got;
        }
      }
      f2_t b1;
      {
        const bool up = (lane & 8) != 0;
        f2_t keep = up ? b2[1] : b2[0], send = up ? b2[0] : b2[1];
        f2_t got; got[0] = dpp_f<0x128>(send[0]); got[1] = dpp_f<0x128>(send[1]);
        b1 = keep + got;
      }
      const size_t o = (size_t)t * DM + x * 128 + c * 16 + 2 * r;
      f2_t xv = *(const f2_t*)(x1 + o);
      f2_t res = xv + b1;
      *(f2_t*)(p.out + o) = res;
    }
  }
#undef PEER_LOAD_IDX
#undef PEER_LOAD_ROWS
}

template <int WHICH>
DI void phase_peer_sliced(const Params& p, unsigned char* lds) {
  const int tid = threadIdx.x, lane = tid & 63, w = tid >> 6;
  unsigned* qctr = (unsigned*)(p.ws + WS_MISC + MISC_QCTR) + WHICH * 8;
  int* bc = (int*)lds;
  const unsigned x0 = xcc_id();
  for (int si = 0; si < 8; ++si) {
    const int x = (int)((x0 + si) & 7u);
    __syncthreads();
    if (tid == 0) bc[0] = (int)atomicAdd(&qctr[x], 1u);
    __syncthreads();
    int ch = bc[0];
    while (ch < PG_NCHUNK) {
      int nxt = 0;
      if (tid == 0) nxt = (int)atomicAdd(&qctr[x], 1u);
      peer_wave_tokens<WHICH>(p, x, ch * PG_CHUNK_TOK + w * 8, lane);
      __syncthreads();
      if (tid == 0) bc[0] = nxt;
      __syncthreads();
      ch = bc[0];
    }
  }
}

DI void phase_peer_act(const Params& p) {
  const float* zpart = (const float*)p.out;
  const u16* eidx = (const u16*)(p.ws + WS_EIDX);
  float* wg = (float*)(p.ws + WS_G);
  const float* suinv = (const float*)(p.ws + WS_MISC + MISC_SUINV);
  const float* svinv = (const float*)(p.ws + WS_MISC + MISC_SVINV);
  for (size_t i = (size_t)blockIdx.x * NTHR + threadIdx.x; i < (size_t)T_TOK * 128; i += (size_t)gridDim.x * NTHR) {
    float z = 0.f;
#pragma unroll
    for (int x = 0; x < 8; ++x) z += zpart[(size_t)x * T_TOK * 128 + i];
    const int e = eidx[i];
    z *= suinv[e];
    const float act = 0.5f * z * (1.0f + erff(z * 0.70710678118654752f));
    wg[i] = wg[i] * act * svinv[e];
  }
}

#define XB_TMO      128
#define XB_XCNT(j)  (256  + 64 * (j))
#define XB_XSUB(j)  (1280 + 64 * (j))
#define XB_XGEN(j)  (2304 + 64 * (j))
#define XB_TOP      3328
#define XB_TOPGEN   3392
#define XCD_BAR_WORDS 3456
#define XB_SPIN_CAP (1u << 18)
#define LAS __attribute__((address_space(3)))

__device__ __forceinline__ unsigned xb_ld(unsigned* p)              { return __hip_atomic_load(p, __ATOMIC_RELAXED, __HIP_MEMORY_SCOPE_AGENT); }
__device__ __forceinline__ unsigned xb_add(unsigned* p, unsigned v) { return __hip_atomic_fetch_add(p, v, __ATOMIC_RELAXED, __HIP_MEMORY_SCOPE_AGENT); }
__device__ __forceinline__ unsigned xb_xcc_id() { return (unsigned)__builtin_amdgcn_s_getreg((3 << 11) | 20) & 0xFu; }
#define XB_SPIN(cond, bar) do { unsigned _sp = 0; while (cond) { __builtin_amdgcn_s_sleep(1); \
    if ((++_sp & 255u) == 0u) { if (xb_ld(&(bar)[XB_TMO])) break; if (_sp > XB_SPIN_CAP) { atomicAdd(&(bar)[XB_TMO], 1u); break; } } } } while (0)

struct XcdBarrier {
    unsigned* bar; unsigned x;
    volatile LAS unsigned* st;
};

__device__ __forceinline__ XcdBarrier xcd_barrier_post(unsigned* bar, volatile LAS unsigned* st) {
    XcdBarrier b; b.bar = bar; b.x = xb_xcc_id(); b.st = st;
    if (threadIdx.x == 0) (void)xb_add(&bar[XB_XCNT(b.x)], 1u);
    return b;
}
__device__ __forceinline__ void xcd_barrier_complete(unsigned* bar, unsigned x, unsigned& nloc, unsigned& nx) {
    const unsigned G = gridDim.x * gridDim.y * gridDim.z;
    unsigned sum, cnt, mine, sp = 0u;
    for (;;) {
        sum = 0u; cnt = 0u; mine = 0u;
#pragma unroll
        for (unsigned j = 0; j < 16; ++j) { const unsigned c = xb_ld(&bar[XB_XCNT(j)]); sum += c; cnt += (c > 0u) ? 1u : 0u; mine = (j == x) ? c : mine; }
        if (sum == G) break;
        __builtin_amdgcn_s_sleep(1);
        if ((++sp & 255u) == 0u) { if (xb_ld(&bar[XB_TMO])) break; if (sp > XB_SPIN_CAP) { atomicAdd(&bar[XB_TMO], 1u); break; } }
    }
    nloc = mine > 0u ? mine : 1u; nx = cnt > 0u ? cnt : 1u;
}

__device__ __forceinline__ void xcd_barrier(const XcdBarrier& b) {
    asm volatile("s_waitcnt vmcnt(0)" ::: "memory");
    __syncthreads();
    if (threadIdx.x == 0) {
        unsigned* bar = b.bar;
        __builtin_amdgcn_s_waitcnt(0);
        unsigned nloc = b.st[0], nx = b.st[1];
        if (nloc == 0u) { xcd_barrier_complete(bar, b.x, nloc, nx); b.st[0] = nloc; b.st[1] = nx; }
        const unsigned old = xb_add(&bar[XB_XSUB(b.x)], 1u);
        const unsigned gen = old / nloc;
        if (old + 1u == (gen + 1u) * nloc) {
            __builtin_amdgcn_fence(__ATOMIC_RELEASE, "agent");
            asm volatile("s_waitcnt vmcnt(0)" ::: "memory");
            const unsigned og = xb_add(&bar[XB_TOP], 1u);
            const unsigned tg = og / nx;
            if (og + 1u == (tg + 1u) * nx) xb_add(&bar[XB_TOPGEN], 1u);
            else XB_SPIN(xb_ld(&bar[XB_TOPGEN]) == tg, bar);
            __builtin_amdgcn_fence(__ATOMIC_ACQUIRE, "agent");
            xb_add(&bar[XB_XGEN(b.x)], 1u);
            asm volatile("s_waitcnt vmcnt(0)" ::: "memory");
        } else {
            XB_SPIN(xb_ld(&bar[XB_XGEN(b.x)]) == gen, bar);
            __builtin_amdgcn_fence(__ATOMIC_ACQUIRE, "agent");
            asm volatile("s_waitcnt vmcnt(0)" ::: "memory");
        }
    }
    __syncthreads();
}


__global__ void __launch_bounds__(NTHR, 2) fwd_kernel(Params p) {
  extern __shared__ __attribute__((aligned(16))) unsigned char lds[];
  cg::grid_group grid = cg::this_grid();
#ifndef ONLY_PH
#define PHON(k) 1
#else
#define PHON(k) ((k) == ONLY_PH)
#endif
#ifndef REPEAT_MASK
#define REPEAT_MASK 0
#endif
#define GSYNC(k) do { if ((k) == 0) { grid.sync(); xbar = xcd_barrier_post((unsigned*)(p.ws + WS_MISC + MISC_BAR), (volatile LAS unsigned*)(lds + LDS_BARST)); } else xcd_barrier(xbar); } while (0)
#define RUN_PHASE(k, call) do { if (PHON(k) && lo <= (k) && (k) < hi) { call; if ((REPEAT_MASK >> (k)) & 1) { grid.sync(); call; } } if (lo <= (k) && (k) + 1 < hi) GSYNC(k); } while (0)
  const int lo = p.ph_lo, hi = p.ph_hi;
  if (threadIdx.x < 4) ((volatile LAS unsigned*)(lds + LDS_BARST))[threadIdx.x] = 0u;
  __syncthreads();
  XcdBarrier xbar; xbar.bar = (unsigned*)(p.ws + WS_MISC + MISC_BAR); xbar.x = 0; xbar.st = (volatile LAS unsigned*)(lds + LDS_BARST);
  RUN_PHASE(0, phase_prep(p, lds));
  RUN_PHASE(1, phase_proj(p, lds));
  RUN_PHASE(2, phase_attn(p, lds));
  RUN_PHASE(3, phase_outproj(p, lds));
  RUN_PHASE(4, phase_norm2(p));
  RUN_PHASE(5, phase_peer_query(p, lds));
  RUN_PHASE(6, phase_peer_route(p, lds));
  RUN_PHASE(7, phase_peer_sliced<0>(p, lds));
#ifndef PROBE_PEER
#define PROBE_PEER 0
#endif
  if (PROBE_PEER & 1) { if (blockIdx.x == 0 && threadIdx.x < 8) ((unsigned*)(p.ws + WS_MISC + MISC_QCTR))[threadIdx.x] = 0u; xcd_barrier(xbar); phase_peer_sliced<0>(p, lds); xcd_barrier(xbar); }
  RUN_PHASE(8, phase_peer_act(p));
  RUN_PHASE(9, phase_peer_sliced<1>(p, lds));
  if (PROBE_PEER & 2) { xcd_barrier(xbar); if (blockIdx.x == 0 && threadIdx.x < 8) ((unsigned*)(p.ws + WS_MISC + MISC_QCTR))[8 + threadIdx.x] = 0u; xcd_barrier(xbar); phase_peer_sliced<1>(p, lds); }
}

extern "C" void kernel_launch(void* const* d_in, const int* in_sizes, int n_in, void* d_out, int out_size, void* d_ws, size_t ws_size, hipStream_t stream) {
  static int grid_blocks = 0;
  if (grid_blocks == 0) {
    if (n_in != 20 || ws_size < WS_END || out_size != T_TOK * DM) {
      fprintf(stderr, "kernel_launch: unexpected problem shape (n_in %d, ws %zu, out %d)\n", n_in, ws_size, out_size);
      grid_blocks = -1; return;
    }
    int dev = 0, cus = 0, per_cu = 0;
    hipGetDevice(&dev);
    hipDeviceGetAttribute(&cus, hipDeviceAttributeMultiprocessorCount, dev);
    hipFuncSetAttribute((const void*)fwd_kernel, hipFuncAttributeMaxDynamicSharedMemorySize, LDS_BYTES);
    hipOccupancyMaxActiveBlocksPerMultiprocessor(&per_cu, (const void*)fwd_kernel, NTHR, LDS_BYTES);
    if (per_cu < 1) { fprintf(stderr, "kernel_launch: occupancy query says %d blocks/CU\n", per_cu); per_cu = 1; }
    grid_blocks = cus;
    (void)hipGetLastError();
  }
  if (grid_blocks < 0) return;
  Params p{};
  p.x_prompt = (const float*)d_in[0]; p.x_sample = (const float*)d_in[1]; p.rel_bias = (const float*)d_in[2]; p.attn_norm_g = (const float*)d_in[3];
  p.w_in = (const float*)d_in[4]; p.q_norm_a = (const float*)d_in[5]; p.k_norm_a = (const float*)d_in[6]; p.q_norm_b = (const float*)d_in[7];
  p.k_norm_b = (const float*)d_in[8]; p.lq1 = (const float*)d_in[9]; p.lk1 = (const float*)d_in[10]; p.lq2 = (const float*)d_in[11];
  p.lk2 = (const float*)d_in[12]; p.diff_norm_g = (const float*)d_in[13]; p.w_out = (const float*)d_in[14]; p.ffn_norm_g = (const float*)d_in[15];
  p.peer_w_q = (const float*)d_in[16]; p.peer_sub_keys = (const float*)d_in[17]; p.peer_u = (const float*)d_in[18]; p.peer_v = (const float*)d_in[19];
  p.out = (float*)d_out; p.ws = (unsigned char*)d_ws;
#if FUSED
  p.ph_lo = 0; p.ph_hi = NPHASE;
  void* args[] = {&p};
  hipError_t e = hipLaunchCooperativeKernel((const void*)fwd_kernel, dim3(grid_blocks), dim3(NTHR), args, LDS_BYTES, stream);
  if (e != hipSuccess) fprintf(stderr, "cooperative launch failed: %s (grid %d)\n", hipGetErrorString(e), grid_blocks);
#else
  for (int ph = 0; ph < NPHASE; ++ph) {
    p.ph_lo = ph; p.ph_hi = ph + 1;
    hipLaunchKernelGGL(fwd_kernel, dim3(grid_blocks), dim3(NTHR), LDS_BYTES, stream, p);
  }
#endif
}
```

```cpp
#include <hip/hip_runtime.h>
#include <hip/hip_cooperative_groups.h>
#include <cstdio>
#include <cstdint>
namespace cg = cooperative_groups;

#ifndef FUSED
#define FUSED 1
#endif

typedef unsigned short u16;
typedef __attribute__((ext_vector_type(8))) short bf16x8;
typedef __attribute__((ext_vector_type(4))) short s16x4;
typedef __attribute__((ext_vector_type(16))) float f32x16;
typedef __attribute__((ext_vector_type(4))) float f32x4;
typedef __attribute__((ext_vector_type(4))) unsigned u32x4;
typedef __attribute__((ext_vector_type(2))) unsigned u32x2;
typedef __attribute__((address_space(3))) unsigned char* ldsp_t;

#define DI __device__ __forceinline__
#define MFMA32(a, b, c) __builtin_amdgcn_mfma_f32_32x32x16_bf16((a), (b), (c), 0, 0, 0)

constexpr int DM = 1024;
constexpr int T_TOK = 65536;
constexpr int T_PROMPT = 32768;
constexpr int NTHR = 512;
constexpr int NPHASE = 10;
constexpr float NORM_EPS = 1e-6f;
constexpr float LOG2E = 1.4426950408889634f;
constexpr float C2 = 0.125f * LOG2E;
constexpr float NEG_BIG = -1.0e30f;

constexpr size_t WS_WIN  = 0;
constexpr size_t WS_WOUT = WS_WIN + (size_t)3072 * 1024 * 2;
constexpr size_t WS_WQ   = WS_WOUT + (size_t)1024 * 1024 * 2;
constexpr size_t WS_SK   = WS_WQ + (size_t)2048 * 1024 * 2;
constexpr size_t WS_U    = WS_SK + (size_t)2 * 128 * 128 * 2;
constexpr size_t WS_V    = WS_U + (size_t)16384 * 1024 * 2;
constexpr size_t WS_MISC = WS_V + (size_t)16384 * 1024 * 2;
constexpr size_t MISC_SUINV = 0, MISC_SVINV = 65536, MISC_QCTR = 131072, MISC_BAR = 196608;
constexpr size_t WS_R    = WS_MISC + (size_t)1048576;
constexpr size_t R_REGION = (size_t)T_TOK * 512 * 2;
constexpr size_t WS_X1   = WS_R;
constexpr size_t WS_H    = WS_R + (size_t)T_TOK * 1024 * 4;
constexpr size_t WS_EIDX = WS_R + 6 * R_REGION;
constexpr size_t WS_G    = WS_EIDX + (size_t)T_TOK * 128 * 2;
constexpr size_t WS_END  = WS_G + (size_t)T_TOK * 128 * 4;
static_assert(WS_END <= (size_t)536870912, "workspace map exceeds 512 MiB");
constexpr size_t OUT_N1 = 0, OUT_MIX = 134217728, OUT_TV = 0, OUT_TI = 67108864;

constexpr int LDS_BYTES = 163840;
constexpr int LDS_BARST = 163840 - 256;

struct Params {
  const float* x_prompt; const float* x_sample; const float* rel_bias; const float* attn_norm_g; const float* w_in;
  const float* q_norm_a; const float* k_norm_a; const float* q_norm_b; const float* k_norm_b;
  const float* lq1; const float* lk1; const float* lq2; const float* lk2; const float* diff_norm_g; const float* w_out;
  const float* ffn_norm_g; const float* peer_w_q; const float* peer_sub_keys; const float* peer_u; const float* peer_v;
  float* out; unsigned char* ws; int ph_lo; int ph_hi;
};

DI u16 f2bf(float f) { unsigned u = __float_as_uint(f); u += 0x7fffu + ((u >> 16) & 1u); return (u16)(u >> 16); }
DI float bf2f(u16 b) { return __uint_as_float(((unsigned)b) << 16); }
DI unsigned pk2(float lo, float hi) {
  typedef float f2_t __attribute__((ext_vector_type(2)));
  typedef __bf16 b2_t __attribute__((ext_vector_type(2)));
  f2_t v = {lo, hi}; b2_t b = __builtin_convertvector(v, b2_t); return __builtin_bit_cast(unsigned, b);
}
DI int crow(int reg, int h) { return (reg & 3) + 8 * (reg >> 2) + 4 * h; }
DI float wave_sum(float v) {
#pragma unroll
  for (int o = 32; o > 0; o >>= 1) v += __shfl_xor(v, o);
  return v;
}
DI void seq_of(int t, int& seq_start, int& S, int& s) {
  if (t < T_PROMPT) { S = 4096; seq_start = t & ~4095; s = t & 4095; }
  else { S = 2048; seq_start = t & ~2047; s = t & 2047; }
}
DI const float* x_row(const Params& p, int t) {
  return (t < T_PROMPT) ? p.x_prompt + (size_t)t * DM : p.x_sample + (size_t)(t - T_PROMPT) * DM;
}
DI int rel_bucket(int rel) {
  int n = rel < 0 ? -rel : rel;
  int b;
  if (n < 8) b = n;
  else if (n < 15) b = 8; else if (n < 27) b = 9; else if (n < 50) b = 10; else if (n < 91) b = 11;
  else if (n < 166) b = 12; else if (n < 305) b = 13; else if (n < 559) b = 14; else b = 15;
  return (rel > 0 ? 16 : 0) + b;
}
DI s16x4 tr_read(const unsigned char* p) {
  typedef short v4i16_t __attribute__((ext_vector_type(4)));
  return __builtin_bit_cast(s16x4, __builtin_amdgcn_ds_read_tr16_b64_v4i16((__attribute__((address_space(3))) v4i16_t*)p));
}
DI bf16x8 cat8(s16x4 lo, s16x4 hi) { return __builtin_shufflevector(lo, hi, 0, 1, 2, 3, 4, 5, 6, 7); }

DI void transpose_item(const float* __restrict__ src, int K, int N, u16* __restrict__ dst, int k0, int n0, unsigned char* lds) {
  float* tile = (float*)lds;
  const int tid = threadIdx.x;
#pragma unroll
  for (int i = 0; i < 8; ++i) {
    int idx = tid + 512 * i; int r = idx >> 6, c = idx & 63;
    tile[r * 65 + c] = src[(size_t)(k0 + r) * N + n0 + c];
  }
  __syncthreads();
  {
    int n = tid >> 3, kc = tid & 7;
    u32x4 o;
    o[0] = pk2(tile[(kc * 8 + 0) * 65 + n], tile[(kc * 8 + 1) * 65 + n]);
    o[1] = pk2(tile[(kc * 8 + 2) * 65 + n], tile[(kc * 8 + 3) * 65 + n]);
    o[2] = pk2(tile[(kc * 8 + 4) * 65 + n], tile[(kc * 8 + 5) * 65 + n]);
    o[3] = pk2(tile[(kc * 8 + 6) * 65 + n], tile[(kc * 8 + 7) * 65 + n]);
    *(u32x4*)(dst + (size_t)(n0 + n) * K + k0 + kc * 8) = o;
  }
  __syncthreads();
}

DI void convert_item(const float* __restrict__ src, u16* __restrict__ dst, size_t base) {
  size_t i = base + (size_t)threadIdx.x * 8;
  f32x4 a = *(const f32x4*)(src + i), b = *(const f32x4*)(src + i + 4);
  u32x4 o; o[0] = pk2(a[0], a[1]); o[1] = pk2(a[2], a[3]); o[2] = pk2(b[0], b[1]); o[3] = pk2(b[2], b[3]);
  *(u32x4*)(dst + i) = o;
}

DI void norm_row(const float* __restrict__ xr, const float* __restrict__ g, u16* __restrict__ orow, int lane) {
  f32x4 v[4]; float ss = 0.f;
#pragma unroll
  for (int i = 0; i < 4; ++i) { v[i] = *(const f32x4*)(xr + lane * 4 + 256 * i); ss += v[i][0] * v[i][0] + v[i][1] * v[i][1] + v[i][2] * v[i][2] + v[i][3] * v[i][3]; }
  ss = wave_sum(ss);
  const float r = __builtin_amdgcn_rsqf(ss * (1.0f / 1024.0f) + NORM_EPS);
#pragma unroll
  for (int i = 0; i < 4; ++i) {
    f32x4 gg = *(const f32x4*)(g + lane * 4 + 256 * i);
    u32x2 o; o[0] = pk2(v[i][0] * r * gg[0], v[i][1] * r * gg[1]); o[1] = pk2(v[i][2] * r * gg[2], v[i][3] * r * gg[3]);
    *(u32x2*)(orow + lane * 4 + 256 * i) = o;
  }
}

DI void phase_prep(const Params& p, unsigned char* lds) {
  const int nb = gridDim.x, bid = blockIdx.x, tid = threadIdx.x;
  u16* wsb = (u16*)p.ws;
  for (int it = bid; it < 768 + 256 + 512; it += nb) {
    if (it < 768) { int kt = it / 48, nt = it % 48; transpose_item(p.w_in, 1024, 3072, (u16*)(p.ws + WS_WIN), kt * 64, nt * 64, lds); }
    else if (it < 1024) { int j = it - 768; int kt = j / 16, nt = j % 16; transpose_item(p.w_out, 1024, 1024, (u16*)(p.ws + WS_WOUT), kt * 64, nt * 64, lds); }
    else { int j = it - 1024; int kt = j / 32, nt = j % 32; transpose_item(p.peer_w_q, 1024, 2048, (u16*)(p.ws + WS_WQ), kt * 64, nt * 64, lds); }
  }
  for (int it = bid; it < 8; it += nb) convert_item(p.peer_sub_keys, (u16*)(p.ws + WS_SK), (size_t)it * 4096);
  if (bid == 0 && tid < 64) ((unsigned*)(p.ws + WS_MISC + MISC_QCTR))[tid] = 0u;
  if (bid == 0) for (int i = tid; i < 3456; i += NTHR) ((unsigned*)(p.ws + WS_MISC + MISC_BAR))[i] = 0u;
  {
    const int lane_ = tid & 63, w_ = tid >> 6;
    for (int it = bid; it < 2 * 16384 / 8; it += nb) {
      const int row = it * 8 + w_;
      const int tbl = row >> 14, e = row & 16383;
      const float* src = (tbl ? p.peer_v : p.peer_u) + (size_t)e * DM + lane_ * 16;
      f32x4 a0 = *(const f32x4*)(src), a1 = *(const f32x4*)(src + 4), a2 = *(const f32x4*)(src + 8), a3 = *(const f32x4*)(src + 12);
      float am = 0.f;
#pragma unroll
      for (int j = 0; j < 4; ++j) am = fmaxf(am, fmaxf(fmaxf(fabsf(a0[j]), fabsf(a1[j])), fmaxf(fabsf(a2[j]), fabsf(a3[j]))));
#pragma unroll
      for (int o = 32; o > 0; o >>= 1) am = fmaxf(am, __shfl_xor(am, o));
      const int ex = (int)((__float_as_uint(am) >> 23) & 255u);
      float sc = 1.0f, isc = 1.0f;
      if (ex > 8 && ex < 250) { sc = __uint_as_float((unsigned)(261 - ex) << 23); isc = __uint_as_float((unsigned)(ex - 7) << 23); }
      u32x4 o;
      { int pk = __builtin_amdgcn_cvt_pk_fp8_f32(a0[0] * sc, a0[1] * sc, 0, false); pk = __builtin_amdgcn_cvt_pk_fp8_f32(a0[2] * sc, a0[3] * sc, pk, true); o[0] = (unsigned)pk; }
      { int pk = __builtin_amdgcn_cvt_pk_fp8_f32(a1[0] * sc, a1[1] * sc, 0, false); pk = __builtin_amdgcn_cvt_pk_fp8_f32(a1[2] * sc, a1[3] * sc, pk, true); o[1] = (unsigned)pk; }
      { int pk = __builtin_amdgcn_cvt_pk_fp8_f32(a2[0] * sc, a2[1] * sc, 0, false); pk = __builtin_amdgcn_cvt_pk_fp8_f32(a2[2] * sc, a2[3] * sc, pk, true); o[2] = (unsigned)pk; }
      { int pk = __builtin_amdgcn_cvt_pk_fp8_f32(a3[0] * sc, a3[1] * sc, 0, false); pk = __builtin_amdgcn_cvt_pk_fp8_f32(a3[2] * sc, a3[3] * sc, pk, true); o[3] = (unsigned)pk; }
      unsigned char* dst = p.ws + (tbl ? WS_V : WS_U) + ((size_t)(lane_ >> 3) * 16384 + e) * 128 + (lane_ & 7) * 16;
      *(u32x4*)dst = o;
      if (lane_ == 0) ((float*)(p.ws + WS_MISC + (tbl ? MISC_SVINV : MISC_SUINV)))[e] = isc;
    }
  }
  const int lane = tid & 63, w = tid >> 6;
  u16* n1 = (u16*)((unsigned char*)p.out + OUT_N1);
  for (int it = bid; it < T_TOK / 8; it += nb) {
    int t = it * 8 + w;
    norm_row(x_row(p, t), p.attn_norm_g, n1 + (size_t)t * DM, lane);
  }
  (void)wsb;
}

template <int PR, int QR>
DI void gemm_mainloop(const u16* __restrict__ P, const u16* __restrict__ Q, int K, int p0, int q0, unsigned char* lds, f32x16 (&acc)[2][2]) {
  static_assert(PR + QR == 384, "tile");
  constexpr int STAGE = 384 * 128;
  constexpr int WC = QR / 64;
  const int tid = threadIdx.x, lane = tid & 63, r32 = lane & 31, h = lane >> 5;
  const int w = __builtin_amdgcn_readfirstlane(tid >> 6);
  const int wr = w / WC, wc = w % WC;
#pragma unroll
  for (int i = 0; i < 2; ++i)
#pragma unroll
    for (int j = 0; j < 2; ++j)
#pragma unroll
      for (int r = 0; r < 16; ++r) acc[i][j][r] = 0.f;
  u32x4 stg[6];
  const u16* src[6]; int loff[6];
#pragma unroll
  for (int i = 0; i < 6; ++i) {
    int c = tid + 512 * i; int row = c >> 3, kc = c & 7;
    src[i] = (row < PR) ? P + (size_t)(p0 + row) * K + kc * 8 : Q + (size_t)(q0 + row - PR) * K + kc * 8;
    loff[i] = row * 128 + ((kc ^ ((row >> 1) & 7)) << 4);
  }
  const int KT = K / 64;
#pragma unroll
  for (int i = 0; i < 6; ++i) stg[i] = *(const u32x4*)(src[i]);
#pragma unroll
  for (int i = 0; i < 6; ++i) *(u32x4*)(lds + loff[i]) = stg[i];
  __syncthreads();
  int aoff[2], boff[2], asw[2], bsw[2];
#pragma unroll
  for (int i = 0; i < 2; ++i) {
    int ra = wr * 64 + i * 32 + r32; aoff[i] = ra * 128; asw[i] = (ra >> 1) & 7;
    int rb = PR + wc * 64 + i * 32 + r32; boff[i] = rb * 128; bsw[i] = (rb >> 1) & 7;
  }
  for (int kt = 0; kt < KT; ++kt) {
    const int buf = (kt & 1) * STAGE;
    if (kt + 1 < KT) {
#pragma unroll
      for (int i = 0; i < 6; ++i) stg[i] = *(const u32x4*)(src[i] + (kt + 1) * 64);
    }
#pragma unroll
    for (int ks = 0; ks < 4; ++ks) {
      bf16x8 a[2], b[2];
#pragma unroll
      for (int i = 0; i < 2; ++i) {
        a[i] = *(const bf16x8*)(lds + buf + aoff[i] + (((2 * ks + h) ^ asw[i]) << 4));
        b[i] = *(const bf16x8*)(lds + buf + boff[i] + (((2 * ks + h) ^ bsw[i]) << 4));
      }
#pragma unroll
      for (int i = 0; i < 2; ++i)
#pragma unroll
        for (int j = 0; j < 2; ++j) acc[i][j] = MFMA32(a[i], b[j], acc[i][j]);
    }
    if (kt + 1 < KT) {
      const int nbuf = ((kt + 1) & 1) * STAGE;
#pragma unroll
      for (int i = 0; i < 6; ++i) *(u32x4*)(lds + nbuf + loff[i]) = stg[i];
    }
    __syncthreads();
  }
}

namespace pg8 {
#define PG8_LAS __attribute__((address_space(3)))
typedef unsigned short bf16_t;
typedef short bf16x8 __attribute__((ext_vector_type(8)));
typedef float f32x4 __attribute__((ext_vector_type(4)));
typedef unsigned u32x4 __attribute__((ext_vector_type(4)));
constexpr int BM = 256, BK = 64, HALF = 128, HTB = HALF * BK * 2  , STAGE_BYTES = 8 * HTB, NXCD = 8, WGM = 8;

__host__ __device__ __forceinline__ int lds_byte(int r, int c) { const int st = (r >> 4) * 2 + (c >> 5), rr = r & 15, cc = c & 31, ob = rr * 64 + cc * 2; return st * 1024 + (ob ^ (((ob >> 9) & 1) << 5)); }
__host__ __device__ __forceinline__ void stage_rc(int b, int& R, int& C) { const int st = b / 1024, sb = b % 1024, swz = sb ^ (((sb >> 9) & 1) << 5); R = (st >> 1) * 16 + swz / 64; C = (st & 1) * 32 + (swz % 64) / 2; }
__host__ __device__ __forceinline__ int perm32(int rho) { const int n = rho >> 4, i = rho & 15; return 8 * (i >> 2) + 4 * n + (i & 3); }

struct Unit { int pm, pn; };
struct Gemm { const bf16_t* A; const bf16_t* Bt; int M, N, K; };

struct StaticOrder {
    int nM, nN, nwg, G, c;
    __host__ __device__ void init(int M, int N, int G_, int c_) { nM = M / BM; nN = N / BM; nwg = nM * nN; G = G_; c = c_; }
    __host__ __device__ bool next(int i, Unit& u) const {
        const long L = (long)i * G + c; if (L >= nwg) return false;
        int wgid = (int)L; { const int q = nwg / NXCD, r = nwg % NXCD, xcd = wgid % NXCD, off = wgid / NXCD; wgid = (xcd < r ? xcd * (q + 1) : r * (q + 1) + (xcd - r) * q) + off; }
        const int nig = WGM * nN, gid = wgid / nig, fm = gid * WGM, gsz = (nM - fm) < WGM ? (nM - fm) : WGM;
        u.pm = fm + ((wgid % nig) % gsz); u.pn = (wgid % nig) / gsz; return true;
    }
    __device__ __forceinline__ void a_ready(const Unit&) const {}
    __device__ __forceinline__ void done(const Unit&) const {}
};


template <class Epi, class Sched, bool ALIGN_EPI = false, bool SP2 = false>
__device__ __forceinline__ void gemm_phase(PG8_LAS unsigned char* lds, const Gemm g, const Sched& S, const Epi& E) {
    const int tid = threadIdx.x, wid = __builtin_amdgcn_readfirstlane(tid >> 6), lane = tid & 63, wr = wid >> 2, wc = wid & 3, fr = lane & 15, fq = lane >> 4;
    const int K = g.K, nt = K / BK;
    unsigned voffA[2], voffB[2], voffB1[2];
#pragma unroll
    for (int i = 0; i < 2; ++i) { int R, C; stage_rc(tid * 16 + i * 8192, R, C); const int Rb = Epi::PERM ? ((R & ~31) + perm32(R & 31)) : R;
        voffA[i] = (unsigned)(R * K + C) * 2u;
        if (Epi::HEADPERM) { const int Rh = 64 * (R >> 5) + perm32(R & 31); voffB[i] = (unsigned)(Rh * K + C) * 2u; voffB1[i] = (unsigned)((Rh + 32) * K + C) * 2u; }
        else { voffB[i] = (unsigned)(Rb * K + C) * 2u; voffB1[i] = (unsigned)((Rb + HALF) * K + C) * 2u; } }
    const size_t kstep = (size_t)(BK * 2);
    const size_t hstep = (size_t)HALF * K * 2;
    const size_t tstep = 2 * hstep;
    const unsigned ldsw = (unsigned)wid * 1024u;
    const int aoff = lds_byte(wr * 64 + fr, fq * 8), boff = lds_byte(wc * 32 + fr, fq * 8);
#define PG8_SA(b, h) (((b) * 2 + (h)) * HTB)
#define PG8_SB(b, h) ((4 + (b) * 2 + (h)) * HTB)
#define PG8_STAGE(bufoff, gbase, voff) do { _Pragma("unroll") for (int _i = 0; _i < 2; ++_i) \
        __builtin_amdgcn_global_load_lds((const unsigned*)((const char*)(gbase) + (voff)[_i]), (PG8_LAS unsigned*)(lds + (bufoff) + ldsw + _i * 8192), 16, 0, 0); } while (0)
#define PG8_LDA(dst, b, h) do { _Pragma("unroll") for (int m = 0; m < 4; ++m) _Pragma("unroll") for (int k = 0; k < 2; ++k) dst[m][k] = *(const PG8_LAS bf16x8*)(lds + PG8_SA(b, h) + aoff + m * 2048 + k * 1024); } while (0)
#define PG8_LDB(dst, b, h) do { _Pragma("unroll") for (int n = 0; n < 2; ++n) _Pragma("unroll") for (int k = 0; k < 2; ++k) dst[n][k] = *(const PG8_LAS bf16x8*)(lds + PG8_SB(b, h) + boff + n * 2048 + k * 1024); } while (0)
#define PG8_MMA(ai, bj, At, Bt) do { __builtin_amdgcn_s_setprio(1); _Pragma("unroll") for (int m = 0; m < 4; ++m) _Pragma("unroll") for (int n = 0; n < 2; ++n) _Pragma("unroll") for (int k = 0; k < 2; ++k) \
        acc[ai][bj][m][n] = __builtin_amdgcn_mfma_f32_16x16x32_bf16(Bt[n][k], At[m][k], acc[ai][bj][m][n], 0, 0, 0); __builtin_amdgcn_s_setprio(0); } while (0)
#define PG8_WAIT_V(n) asm volatile("s_waitcnt vmcnt(" #n ")" ::: "memory")
#define PG8_WAIT_L(n) asm volatile("s_waitcnt lgkmcnt(" #n ")" ::: "memory")
#define PG8_BAR __builtin_amdgcn_s_barrier()
#define PG8_SCHED __builtin_amdgcn_sched_barrier(0)
    Unit cur, nxt; int ui = 0;
    if (!S.next(0, cur)) return;
    f32x4 acc[2][2][4][2];
#pragma unroll
    for (int a = 0; a < 2; ++a)
#pragma unroll
        for (int b = 0; b < 2; ++b)
#pragma unroll
            for (int m = 0; m < 4; ++m)
#pragma unroll
                for (int n = 0; n < 2; ++n) acc[a][b][m][n] = (f32x4){0.f, 0.f, 0.f, 0.f};
    bf16x8 At[4][2], B0[2][2], B1[2][2];
    const char* cA = (const char*)g.A + (size_t)cur.pm * tstep; const char* cB = (const char*)g.Bt + (size_t)cur.pn * tstep;
    S.a_ready(cur);
    if constexpr (SP2) {
        PG8_STAGE(PG8_SB(0, 0), cB, voffB); PG8_STAGE(PG8_SB(0, 1), cB, voffB1); PG8_STAGE(PG8_SA(0, 0), cA, voffA); PG8_STAGE(PG8_SA(0, 1), cA + hstep, voffA);
        if (wr == 1) PG8_BAR;
        PG8_WAIT_V(2); PG8_BAR;
        PG8_STAGE(PG8_SB(1, 0), cB + kstep, voffB); PG8_STAGE(PG8_SA(1, 0), cA + kstep, voffA); PG8_STAGE(PG8_SB(1, 1), cB + kstep, voffB1);
        PG8_WAIT_V(6); PG8_BAR;
    } else {
        PG8_STAGE(PG8_SB(0, 0), cB, voffB); PG8_STAGE(PG8_SA(0, 0), cA, voffA); PG8_STAGE(PG8_SB(0, 1), cB, voffB1); PG8_STAGE(PG8_SA(0, 1), cA + hstep, voffA);
        if (wr == 1) PG8_BAR;
        PG8_WAIT_V(4); PG8_BAR;
        PG8_STAGE(PG8_SB(1, 0), cB + kstep, voffB); PG8_STAGE(PG8_SA(1, 0), cA + kstep, voffA); PG8_STAGE(PG8_SB(1, 1), cB + kstep, voffB1);
        PG8_WAIT_V(6); PG8_BAR;
    }
    for (;;) {
        const bool has_next = S.next(ui + 1, nxt);
        const char* nA = has_next ? (const char*)g.A + (size_t)nxt.pm * tstep : cA; const char* nB = has_next ? (const char*)g.Bt + (size_t)nxt.pn * tstep : cB;
        for (int t = 0; t < nt; t += 2) {
            const bool last = (t == nt - 2);
            const char* a1 = cA + (size_t)(t + 1) * kstep;
            const char* a2 = last ? nA : cA + (size_t)(t + 2) * kstep; const char* b2 = last ? nB : cB + (size_t)(t + 2) * kstep;
            const char* a3 = a2 + kstep; const char* b3 = b2 + kstep;
            if (last && has_next) S.a_ready(nxt);
            if constexpr (SP2) {
            PG8_LDB(B0, 0, 0); PG8_LDB(B1, 0, 1); PG8_SCHED; PG8_LDA(At, 0, 0); PG8_STAGE(PG8_SA(1, 1), a1 + hstep, voffA);
            PG8_WAIT_V(8); PG8_WAIT_L(0); PG8_BAR; PG8_MMA(0, 0, At, B0); PG8_MMA(0, 1, At, B1); PG8_BAR; PG8_SCHED;
            PG8_LDA(At, 0, 1); PG8_STAGE(PG8_SB(0, 0), b2, voffB); PG8_STAGE(PG8_SB(0, 1), b2, voffB1); PG8_STAGE(PG8_SA(0, 0), a2, voffA);
            PG8_WAIT_V(8); PG8_WAIT_L(0); PG8_BAR; PG8_MMA(1, 0, At, B0); PG8_MMA(1, 1, At, B1); PG8_BAR; PG8_SCHED;
            PG8_LDB(B0, 1, 0); PG8_LDB(B1, 1, 1); PG8_SCHED; PG8_LDA(At, 1, 0); PG8_STAGE(PG8_SA(0, 1), a2 + hstep, voffA);
            PG8_WAIT_V(8); PG8_WAIT_L(0); PG8_BAR; PG8_MMA(0, 0, At, B0); PG8_MMA(0, 1, At, B1); PG8_BAR; PG8_SCHED;
            PG8_LDA(At, 1, 1); PG8_STAGE(PG8_SB(1, 0), b3, voffB); PG8_STAGE(PG8_SB(1, 1), b3, voffB1); PG8_STAGE(PG8_SA(1, 0), a3, voffA);
            PG8_WAIT_V(8); PG8_WAIT_L(0); PG8_BAR; PG8_MMA(1, 0, At, B0); PG8_MMA(1, 1, At, B1); PG8_BAR; PG8_SCHED;
            } else {
            PG8_LDB(B0, 0, 0); PG8_SCHED; PG8_LDA(At, 0, 0); PG8_STAGE(PG8_SA(1, 1), a1 + hstep, voffA);
            PG8_WAIT_L(8); PG8_BAR; PG8_WAIT_L(0); PG8_MMA(0, 0, At, B0); PG8_BAR; PG8_SCHED;
            PG8_LDB(B1, 0, 1); PG8_STAGE(PG8_SB(0, 0), b2, voffB);
            PG8_BAR; PG8_WAIT_L(0); PG8_MMA(0, 1, At, B1); PG8_BAR;
            PG8_LDA(At, 0, 1); PG8_STAGE(PG8_SA(0, 0), a2, voffA);
            PG8_BAR; PG8_WAIT_L(0); PG8_MMA(1, 0, At, B0); PG8_BAR; PG8_SCHED;
            PG8_STAGE(PG8_SB(0, 1), b2, voffB1);
            PG8_WAIT_V(6); PG8_BAR; PG8_MMA(1, 1, At, B1); PG8_BAR;
            PG8_LDB(B0, 1, 0); PG8_SCHED; PG8_LDA(At, 1, 0); PG8_STAGE(PG8_SA(0, 1), a2 + hstep, voffA);
            PG8_WAIT_L(8); PG8_BAR; PG8_WAIT_L(0); PG8_MMA(0, 0, At, B0); PG8_BAR; PG8_SCHED;
            PG8_LDB(B1, 1, 1); PG8_STAGE(PG8_SB(1, 0), b3, voffB);
            PG8_BAR; PG8_WAIT_L(0); PG8_MMA(0, 1, At, B1); PG8_BAR;
            PG8_LDA(At, 1, 1); PG8_STAGE(PG8_SA(1, 0), a3, voffA);
            PG8_BAR; PG8_WAIT_L(0); PG8_MMA(1, 0, At, B0); PG8_BAR; PG8_SCHED;
            PG8_STAGE(PG8_SB(1, 1), b3, voffB1);
            PG8_WAIT_V(6); PG8_BAR; PG8_MMA(1, 1, At, B1); PG8_BAR;
            }
        }
        if constexpr (ALIGN_EPI) { if (wr == 0) PG8_BAR; }
        if constexpr (!Epi::AFTER_DRAIN) { E(acc, cur, wr, wc, fr, fq); S.done(cur); }
        if (!has_next) break;
#pragma unroll
        for (int a = 0; a < 2; ++a)
#pragma unroll
            for (int b = 0; b < 2; ++b)
#pragma unroll
                for (int m = 0; m < 4; ++m)
#pragma unroll
                    for (int n = 0; n < 2; ++n) acc[a][b][m][n] = (f32x4){0.f, 0.f, 0.f, 0.f};
        cur = nxt; cA = nA; cB = nB; ++ui;
        if constexpr (ALIGN_EPI) { if (wr == 1) PG8_BAR; }
    }
    PG8_WAIT_V(0);
    if constexpr (!ALIGN_EPI) { if (wr == 0) PG8_BAR; }
    PG8_BAR;
    if constexpr (Epi::AFTER_DRAIN) { E.fused(acc, cur, wr, wc, fr, fq, lds, wid, lane); S.done(cur); }
#undef PG8_SA
#undef PG8_SB
#undef PG8_STAGE
#undef PG8_LDA
#undef PG8_LDB
#undef PG8_MMA
#undef PG8_WAIT_V
#undef PG8_WAIT_L
#undef PG8_BAR
#undef PG8_SCHED
}
}

struct EpiProj {
  static constexpr bool PERM = true, AFTER_DRAIN = false, HEADPERM = true;
  const float* gqa; const float* gka; const float* gqb; const float* gkb; unsigned char* ws;
  __device__ __forceinline__ void operator()(const pg8::f32x4 (&acc)[2][2][4][2], const pg8::Unit& u, int wr, int wc, int fr, int fq) const {
    const int nbase = u.pn * 256 + wc * 64;
    const int region = nbase >> 9, hw = (nbase & 511) >> 6;
    const float* g = (region == 0) ? gqa : (region == 1) ? gka : (region == 3) ? gqb : gkb;
    const bool normed = (region != 2 && region != 5);
    const float qs = (region == 0 || region == 3) ? C2 : 1.0f;
    u16* dstR = (u16*)(ws + WS_R + (size_t)region * R_REGION);
    f32x4 gv[2][2];
#pragma unroll
    for (int bj = 0; bj < 2; ++bj)
#pragma unroll
      for (int n = 0; n < 2; ++n) gv[bj][n] = normed ? *(const f32x4*)(g + 32 * bj + 8 * fq + 4 * n) : (f32x4){1.f, 1.f, 1.f, 1.f};
#pragma unroll
    for (int ai = 0; ai < 2; ++ai)
#pragma unroll
      for (int m = 0; m < 4; ++m) {
        const int t = u.pm * 256 + ai * 128 + wr * 64 + m * 16 + fr;
        int seq_start, S, sq; seq_of(t, seq_start, S, sq);
        float scale = 1.0f;
        if (normed) {
          float ss = 0.f;
#pragma unroll
          for (int bj = 0; bj < 2; ++bj)
#pragma unroll
            for (int n = 0; n < 2; ++n) { const f32x4 v = acc[ai][bj][m][n]; ss += v[0] * v[0] + v[1] * v[1] + v[2] * v[2] + v[3] * v[3]; }
          ss += __shfl_xor(ss, 16); ss += __shfl_xor(ss, 32);
          scale = __builtin_amdgcn_rsqf(ss * (1.0f / 64.0f) + NORM_EPS) * qs;
        }
        u16* dst;
        if (region != 5) dst = dstR + (size_t)seq_start * 512 + ((size_t)hw * S + sq) * 64;
        else dst = dstR + (size_t)seq_start * 512 + ((size_t)(hw >> 1) * S + sq) * 128 + (hw & 1) * 64;
#pragma unroll
        for (int bj = 0; bj < 2; ++bj) {
          const f32x4 v0 = acc[ai][bj][m][0] * scale * gv[bj][0], v1 = acc[ai][bj][m][1] * scale * gv[bj][1];
          u32x4 o; o[0] = pk2(v0[0], v0[1]); o[1] = pk2(v0[2], v0[3]); o[2] = pk2(v1[0], v1[1]); o[3] = pk2(v1[2], v1[3]);
          *(u32x4*)(dst + 32 * bj + 8 * fq) = o;
        }
      }
  }
};

DI void phase_proj(const Params& p, unsigned char* lds) {
  pg8::Gemm g{(const u16*)((const unsigned char*)p.out + OUT_N1), (const u16*)(p.ws + WS_WIN), T_TOK, 3072, 1024};
  pg8::StaticOrder S; S.init(T_TOK, 3072, (int)gridDim.x, (int)blockIdx.x);
  EpiProj E{p.q_norm_a, p.k_norm_a, p.q_norm_b, p.k_norm_b, p.ws};
  pg8::gemm_phase<EpiProj, pg8::StaticOrder, true, true>((PG8_LAS unsigned char*)lds, g, S, E);
}

constexpr int AL_STAGE = 0;
constexpr int AL_VT    = 0;
constexpr int AL_TAB   = 131072;
constexpr int AL_TABA  = 137216;
constexpr int AL_XL    = 150016;
constexpr int AL_MISC  = 151552;

DI unsigned voff_b(int row, int ch) { return 256u * row + 16u * (ch ^ (((row & 3) << 2) | ((row >> 2) & 3))); }

template <int VAR>
DI void diff_unit(const Params& p, unsigned char* lds, int seq_start, int S, int hd, int q0, float lam) {
  const int tid = threadIdx.x, lane = tid & 63, r32 = lane & 31, h = lane >> 5;
  const int w = __builtin_amdgcn_readfirstlane(tid >> 6);
  const int map = w >> 2, wq = w & 3;
  const u16* QBp = (const u16*)(p.ws + WS_R + 3 * R_REGION);
  const u16* KBp = (const u16*)(p.ws + WS_R + 4 * R_REGION);
  const u16* VBp = (const u16*)(p.ws + WS_R + 5 * R_REGION);
  const int qpos = q0 + wq * 32 + r32;
  const int qlo = q0 + wq * 32;
  const u16* Qp = QBp + (size_t)seq_start * 512 + ((size_t)(hd * 2 + map) * S + qpos) * 64;
  bf16x8 qf[4];
#pragma unroll
  for (int ks = 0; ks < 4; ++ks) qf[ks] = *(const bf16x8*)(Qp + ks * 16 + h * 8);
  const u16* K1g = KBp + (size_t)seq_start * 512 + ((size_t)(hd * 2 + 0) * S) * 64;
  const u16* K2g = KBp + (size_t)seq_start * 512 + ((size_t)(hd * 2 + 1) * S) * 64;
  const u16* Vg = VBp + (size_t)seq_start * 512 + ((size_t)hd * S) * 128;
  const float* tab = (const float*)(lds + AL_TAB);
  const float* misc = (const float*)(lds + AL_MISC);
  const float cAfter = misc[12 + hd];
  f32x16 O[4];
#pragma unroll
  for (int nb = 0; nb < 4; ++nb)
#pragma unroll
    for (int r = 0; r < 16; ++r) O[nb][r] = 0.f;
  float l = 0.f;
  const int kr_ = 8 * w + (lane >> 3), kc_ = (lane & 7) ^ ((kr_ >> 1) & 7);
  const u16* k1src = K1g + (size_t)kr_ * 64 + kc_ * 8;
  const u16* k2src = K2g + (size_t)kr_ * 64 + kc_ * 8;
  const u16* vsrc[2];
#pragma unroll
  for (int i = 0; i < 2; ++i) { const int row = 8 * w + 4 * i + (lane >> 4); const int pc = (lane & 15) ^ (((row & 3) << 2) | ((row >> 2) & 3)); vsrc[i] = Vg + (size_t)row * 128 + pc * 8; }
  const int NKT = S / 64;
  const int i16 = lane & 15, tq = i16 >> 2, tp = i16 & 3, blk = (lane >> 4) & 1;
  int kbase4[4], vbase[4][2];
#pragma unroll
  for (int ks = 0; ks < 4; ++ks) kbase4[ks] = r32 * 128 + (((2 * ks + h) ^ ((r32 >> 1) & 7)) << 4);
#pragma unroll
  for (int nb = 0; nb < 4; ++nb)
#pragma unroll
    for (int hi = 0; hi < 2; ++hi) vbase[nb][hi] = (int)voff_b(4 * h + tq + 8 * hi, 4 * nb + 2 * blk + (tp >> 1)) + 8 * (tp & 1);
#define DU_GLDS(gsrc_, ldsoff_) do { unsigned keep_; const unsigned dst_ = (unsigned)__builtin_amdgcn_readfirstlane((int)(ldsoff_)); \
    asm volatile("s_mov_b32 %0, m0\n\ts_mov_b32 m0, %2\n\ts_nop 0\n\tglobal_load_lds_dwordx4 %1, off\n\ts_mov_b32 m0, %0" : "=&s"(keep_) : "v"(gsrc_), "s"(dst_) : "memory"); } while (0)
#define DU_DMA(kt_, st_) do { const size_t ko_ = (size_t)(kt_) * 64 * 64, vo_ = (size_t)(kt_) * 64 * 128; const unsigned b_ = lds_base + AL_STAGE + (st_) * 32768; \
    DU_GLDS(k1src + ko_, b_ + w * 1024); DU_GLDS(k2src + ko_, b_ + 8192 + w * 1024); \
    DU_GLDS(vsrc[0] + vo_, b_ + 16384 + w * 2048); DU_GLDS(vsrc[1] + vo_, b_ + 16384 + w * 2048 + 1024); } while (0)
  const unsigned lds_base = (unsigned)(uintptr_t)lds;
#define SBAR() __builtin_amdgcn_sched_barrier(0)
#define DU_VRD(slot, f, so_) do { vlo[slot] = tr_read(vp[(f) >> 1][0] + (so_) + ((f) & 1) * 4096); vhi[slot] = tr_read(vp[(f) >> 1][1] + (so_) + ((f) & 1) * 4096); } while (0)
#define DU_SUB(A, B, kq2, kso2_, has_next2_, vso_, knext_, has_next_) do { \
    SBAR(); \
    s16x4 vlo[4], vhi[4]; \
    if (VAR != 2 && VAR != 4) { DU_VRD(0, 0, vso_); DU_VRD(1, 1, vso_); DU_VRD(2, 2, vso_); DU_VRD(3, 3, vso_); } \
    if (has_next_ && VAR != 3 && VAR != 4) { \
      f32x16 z_; _Pragma("unroll") for (int r = 0; r < 16; ++r) z_[r] = 0.f; \
      B = MFMA32(kf[0], qf[0], z_); B = MFMA32(kf[1], qf[1], B); B = MFMA32(kf[2], qf[2], B); B = MFMA32(kf[3], qf[3], B); } \
    float ls = 0.f; \
    _Pragma("unroll") for (int r = 0; r < 16; ++r) ls += A[r]; \
    l += ls; \
    bf16x8 pb[2]; \
    _Pragma("unroll") for (int s2 = 0; s2 < 2; ++s2) { \
      u32x4 pw; pw[0] = pk2(A[8 * s2 + 0], A[8 * s2 + 1]); pw[1] = pk2(A[8 * s2 + 2], A[8 * s2 + 3]); \
      pw[2] = pk2(A[8 * s2 + 4], A[8 * s2 + 5]); pw[3] = pk2(A[8 * s2 + 6], A[8 * s2 + 7]); \
      pb[s2] = __builtin_bit_cast(bf16x8, pw); } \
    SBAR(); \
    if ((has_next2_) && VAR != 3 && VAR != 4) { _Pragma("unroll") for (int ks = 0; ks < 4; ++ks) kf[ks] = *(const bf16x8*)(kq2[ks] + (kso2_)); } \
    if (has_next_) { \
      const int dmin_ = (knext_) - (qlo + 31), dmax_ = (knext_) + 31 - qlo; \
      if (dmin_ < 559) { \
        if (in_after) { in_after = false; _Pragma("unroll") for (int nb = 0; nb < 4; ++nb) _Pragma("unroll") for (int r = 0; r < 16; ++r) O[nb][r] *= fAfter; l *= fAfter; \
                        _Pragma("unroll") for (int s2 = 0; s2 < 2; ++s2) {   \
                          u32x4 pw; pw[0] = pk2(A[8 * s2 + 0] * fAfter, A[8 * s2 + 1] * fAfter); pw[1] = pk2(A[8 * s2 + 2] * fAfter, A[8 * s2 + 3] * fAfter); \
                          pw[2] = pk2(A[8 * s2 + 4] * fAfter, A[8 * s2 + 5] * fAfter); pw[3] = pk2(A[8 * s2 + 6] * fAfter, A[8 * s2 + 7] * fAfter); \
                          pb[s2] = __builtin_bit_cast(bf16x8, pw); } } \
        if (dmax_ > -559) { const int base_ = (knext_) + 4 * h - qpos + 640; \
          _Pragma("unroll") for (int r = 0; r < 16; ++r) B[r] += tab[base_ + (r & 3) + 8 * (r >> 2)]; } } } \
    __builtin_amdgcn_s_setprio(1); \
    _Pragma("unroll") for (int f = 0; f < 8; ++f) { \
      if (VAR != 2 && VAR != 4) { O[f >> 1] = MFMA32(cat8(vlo[f & 3], vhi[f & 3]), pb[f & 1], O[f >> 1]); \
      if (f + 4 < 8) DU_VRD(f & 3, f + 4, vso_); } \
      if (VAR != 1 && VAR != 4) { B[2 * f] = __builtin_amdgcn_exp2f(B[2 * f]); B[2 * f + 1] = __builtin_amdgcn_exp2f(B[2 * f + 1]); } } \
    __builtin_amdgcn_s_setprio(0); \
  } while (0)
  f32x16 X, Y; bf16x8 kf[4];
  const float fAfter = __builtin_amdgcn_exp2f(cAfter);
  bool in_after = true;
  const int KT1 = NKT - 1;
  DU_DMA(KT1, 0);
  if (NKT > 1) DU_DMA(KT1 - 1, 1);
  asm volatile("s_waitcnt vmcnt(0)" ::: "memory");
  __syncthreads();
  {
    const unsigned char* kb_ = lds + AL_STAGE + map * 8192 + 4096;
    f32x16 z_;
#pragma unroll
    for (int r = 0; r < 16; ++r) z_[r] = 0.f;
    X = MFMA32(*(const bf16x8*)(kb_ + kbase4[0]), qf[0], z_); X = MFMA32(*(const bf16x8*)(kb_ + kbase4[1]), qf[1], X);
    X = MFMA32(*(const bf16x8*)(kb_ + kbase4[2]), qf[2], X); X = MFMA32(*(const bf16x8*)(kb_ + kbase4[3]), qf[3], X);
    const int knext = 64 * KT1 + 32;
    const int dmin_ = knext - (qlo + 31), dmax_ = knext + 31 - qlo;
    if (dmin_ < 559) {
      in_after = false;
      if (dmax_ > -559) { const int base_ = knext + 4 * h - qpos + 640;
#pragma unroll
        for (int r = 0; r < 16; ++r) X[r] += tab[base_ + (r & 3) + 8 * (r >> 2)]; }
    }
#pragma unroll
    for (int r = 0; r < 16; ++r) X[r] = __builtin_amdgcn_exp2f(X[r]);
#pragma unroll
    for (int ks = 0; ks < 4; ++ks) kf[ks] = *(const bf16x8*)(lds + AL_STAGE + map * 8192 + kbase4[ks]);
  }
  int st_cur = 0, st_nxt = 32768, st_free = 65536;
  for (int i = 0; i < NKT; ++i) {
    const int kt = KT1 - i;
    asm volatile("s_waitcnt vmcnt(0)" ::: "memory");
    __syncthreads();
    if (i + 2 < NKT) DU_DMA(kt - 2, st_free / 32768);
    const unsigned char* knx[4]; const unsigned char* vp[4][2];
#pragma unroll
    for (int ks = 0; ks < 4; ++ks) knx[ks] = lds + AL_STAGE + st_nxt + map * 8192 + kbase4[ks];
#pragma unroll
    for (int nb = 0; nb < 4; ++nb) { vp[nb][0] = lds + AL_STAGE + st_cur + 16384 + vbase[nb][0]; vp[nb][1] = lds + AL_STAGE + st_cur + 16384 + vbase[nb][1]; }
    DU_SUB(X, Y, knx, 4096, (i + 1 < NKT), 8192, 64 * kt, true);
    DU_SUB(Y, X, knx, 0, (i + 1 < NKT), 0, 64 * kt - 32, (i + 1 < NKT));
    { const int t_ = st_cur; st_cur = st_nxt; st_nxt = st_free; st_free = t_; }
  }
#undef DU_DMA
#undef DU_GLDS
#undef DU_VRD
#undef DU_SUB
#undef SBAR
  if (in_after) {
#pragma unroll
    for (int nb = 0; nb < 4; ++nb)
#pragma unroll
      for (int r = 0; r < 16; ++r) O[nb][r] *= fAfter;
    l *= fAfter;
  }
  if (VAR != 0) {
#pragma unroll
    for (int nb = 0; nb < 4; ++nb) asm volatile("" :: "v"(O[nb]));
    asm volatile("" :: "v"(l), "v"(X), "v"(Y));
    __syncthreads();
    return;
  }
  __syncthreads();
  float ltot = l + __shfl_xor(l, 32);
  float* xbuf = (float*)(lds + AL_STAGE);
  if (map == 1) {
    const float inv = 1.0f / ltot;
#pragma unroll
    for (int nb = 0; nb < 4; ++nb)
#pragma unroll
      for (int r = 0; r < 16; ++r) xbuf[((wq * 64 + nb * 16 + r) << 6) + lane] = O[nb][r] * inv;
  }
  __syncthreads();
  if (map == 0) {
    const float inv = 1.0f / ltot;
    float ss = 0.f;
#pragma unroll
    for (int nb = 0; nb < 4; ++nb)
#pragma unroll
      for (int r = 0; r < 16; ++r) {
        float o = O[nb][r] * inv - lam * xbuf[((wq * 64 + nb * 16 + r) << 6) + lane];
        O[nb][r] = o; ss += o * o;
      }
    ss += __shfl_xor(ss, 32);
    const float rn = __builtin_amdgcn_rsqf(ss * (1.0f / 128.0f) + NORM_EPS) * 0.8f;
    u16* mix = (u16*)((unsigned char*)p.out + OUT_MIX) + (size_t)(seq_start + qpos) * 1024 + 512 + hd * 128;
#pragma unroll
    for (int nb = 0; nb < 4; ++nb)
#pragma unroll
      for (int g4 = 0; g4 < 4; ++g4) {
        const int d0 = 32 * nb + 8 * g4 + 4 * h;
        f32x4 gg = *(const f32x4*)(p.diff_norm_g + d0);
        u32x2 o; o[0] = pk2(O[nb][4 * g4 + 0] * rn * gg[0], O[nb][4 * g4 + 1] * rn * gg[1]);
        o[1] = pk2(O[nb][4 * g4 + 2] * rn * gg[2], O[nb][4 * g4 + 3] * rn * gg[3]);
        *(u32x2*)(mix + d0) = o;
      }
  }
  __syncthreads();
}

constexpr int AL_DPART = 65536;
constexpr int AL_DL    = AL_TAB;
template <int PASS>
DI void dil_wave_item(const Params& p, unsigned char* lds, int seq_start, int S, int hd, int i0, int sel) {
  const int tid = threadIdx.x, lane = tid & 63, r32 = lane & 31, h = lane >> 5;
  const int w = __builtin_amdgcn_readfirstlane(tid >> 6);
  const u16* QAp = (const u16*)(p.ws + WS_R + 0 * R_REGION);
  const u16* KAp = (const u16*)(p.ws + WS_R + 1 * R_REGION);
  const u16* VAp = (const u16*)(p.ws + WS_R + 2 * R_REGION);
  constexpr int QSTR = (PASS == 1) ? 1 : 16;
  constexpr int NTILE = (PASS == 1) ? 5 : 13;
  const int qbase = (PASS == 1) ? i0 + 32 * sel : i0 + sel;
  const int qpos = qbase + QSTR * r32;
  const int tl = qpos - i0;
  const u16* Qp = QAp + (size_t)seq_start * 512 + ((size_t)hd * S + qpos) * 64;
  bf16x8 qf[4];
#pragma unroll
  for (int ks = 0; ks < 4; ++ks) qf[ks] = *(const bf16x8*)(Qp + ks * 16 + h * 8);
  const u16* Kg = KAp + (size_t)seq_start * 512 + ((size_t)hd * S) * 64;
  const u16* Vg = VAp + (size_t)seq_start * 512 + ((size_t)hd * S) * 64;
  unsigned char* vt = lds + AL_VT + w * 8192;
  unsigned char* ktl = vt + 4096;
  const float* tabA = (const float*)(lds + AL_TABA) + hd * 3 * 132;
  unsigned char* dpart = lds + AL_DPART;
  float* dl = (float*)(lds + AL_DL);
  const int psw = ((tl >> 4) ^ tl) & 15;
  f32x16 O[2];
  float l = 0.f;
  if (PASS == 1) {
#pragma unroll
    for (int nb = 0; nb < 2; ++nb)
#pragma unroll
      for (int r = 0; r < 16; ++r) O[nb][r] = 0.f;
  } else {
#pragma unroll
    for (int nb = 0; nb < 2; ++nb)
#pragma unroll
      for (int g4 = 0; g4 < 4; ++g4) {
        const int ch = 8 * nb + 2 * g4 + h;
        const u32x2 v = *(const u32x2*)(dpart + tl * 128 + ((ch ^ psw) << 3));
        O[nb][4 * g4 + 0] = __uint_as_float(v[0] << 16); O[nb][4 * g4 + 1] = __uint_as_float(v[0] & 0xffff0000u);
        O[nb][4 * g4 + 2] = __uint_as_float(v[1] << 16); O[nb][4 * g4 + 3] = __uint_as_float(v[1] & 0xffff0000u);
      }
    if (h == 0) l = dl[tl];
  }
  const int i16 = lane & 15, tq = i16 >> 2, tp = i16 & 3, blk = (lane >> 4) & 1;
  int vrb[2][2];
#pragma unroll
  for (int nb = 0; nb < 2; ++nb)
#pragma unroll
    for (int hi = 0; hi < 2; ++hi) {
      const int R = 4 * h + tq + 8 * hi; const int ch = 4 * nb + 2 * blk + (tp >> 1);
      const int sw = (((R >> 1) & 1) << 2) ^ ((R >> 2) & 3);
      vrb[nb][hi] = R * 128 + ((ch ^ sw) << 4) + 8 * (tp & 1);
    }
  bf16x8 kfb[1][4]; u32x4 vcb[1][4];
  const int lrow = lane >> 3, lch = lane & 7;
#define DL_PARAMS(tau_) \
    const int d_ = (PASS == 1) ? 1 : (((tau_) < 5) ? 16 : 4); const int br_ = (PASS == 1) ? 2 : (((tau_) < 5) ? 0 : 1); \
    const int tt_ = (PASS == 1) ? (tau_) : (((tau_) < 5) ? (tau_) : (tau_) - 5); const int ratio_ = QSTR / d_; \
    const int n0_ = -64 + 32 * tt_;
#define DL_LOAD(buf, tau_) do { DL_PARAMS(tau_) \
    _Pragma("unroll") for (int i4 = 0; i4 < 4; ++i4) { int kpos_ = qbase + d_ * (n0_ + 8 * i4 + lrow); kpos_ = kpos_ < 0 ? 0 : (kpos_ >= S ? S - 1 : kpos_); \
      kfb[buf][i4] = *(const bf16x8*)(Kg + (size_t)kpos_ * 64 + lch * 8); vcb[buf][i4] = *(const u32x4*)(Vg + (size_t)kpos_ * 64 + lch * 8); } (void)br_; (void)ratio_; } while (0)
#define DL_STORE(buf) do { \
    _Pragma("unroll") for (int i4 = 0; i4 < 4; ++i4) { const int row_ = 8 * i4 + lrow; const int sw_ = (((row_ >> 1) & 1) << 2) ^ ((row_ >> 2) & 3); \
      *(u32x4*)(vt + row_ * 128 + ((lch ^ sw_) << 4)) = vcb[buf][i4]; \
      *(bf16x8*)(ktl + row_ * 128 + ((lch ^ ((row_ >> 1) & 7)) << 4)) = kfb[buf][i4]; } } while (0)
#define DL_COMPUTE(buf, tau_) do { DL_PARAMS(tau_) \
    const int kfirst_ = qbase + d_ * n0_, klast_ = qbase + d_ * (n0_ + 31); \
    const int base_ = n0_ + 4 * h - ratio_ * r32; const float* tb_ = tabA + br_ * 132; \
    f32x16 sT; \
    _Pragma("unroll") for (int r = 0; r < 16; ++r) { int dd = base_ + (r & 3) + 8 * (r >> 2); dd = dd < -65 ? -65 : (dd > 65 ? 65 : dd); sT[r] = tb_[dd + 65]; } \
    if (kfirst_ < 0 || klast_ >= S) { _Pragma("unroll") for (int r = 0; r < 16; ++r) { const int kp = qbase + d_ * (n0_ + crow(r, h)); if (kp < 0 || kp >= S) sT[r] = NEG_BIG; } } \
    _Pragma("unroll") for (int ks = 0; ks < 4; ++ks) { const bf16x8 ka_ = *(const bf16x8*)(ktl + r32 * 128 + (((2 * ks + h) ^ ((r32 >> 1) & 7)) << 4)); sT = MFMA32(ka_, qf[ks], sT); } \
    float ls = 0.f; \
    _Pragma("unroll") for (int r = 0; r < 16; ++r) { sT[r] = __builtin_amdgcn_exp2f(sT[r]); ls += sT[r]; } \
    l += ls; \
    bf16x8 pb[2]; \
    _Pragma("unroll") for (int s2 = 0; s2 < 2; ++s2) { \
      u32x4 pw; pw[0] = pk2(sT[8 * s2 + 0], sT[8 * s2 + 1]); pw[1] = pk2(sT[8 * s2 + 2], sT[8 * s2 + 3]); \
      pw[2] = pk2(sT[8 * s2 + 4], sT[8 * s2 + 5]); pw[3] = pk2(sT[8 * s2 + 6], sT[8 * s2 + 7]); \
      pb[s2] = __builtin_bit_cast(bf16x8, pw); } \
    _Pragma("unroll") for (int nb = 0; nb < 2; ++nb) _Pragma("unroll") for (int s2 = 0; s2 < 2; ++s2) { \
        const s16x4 lo = tr_read(vt + vrb[nb][0] + s2 * 2048); const s16x4 hi = tr_read(vt + vrb[nb][1] + s2 * 2048); \
        O[nb] = MFMA32(cat8(lo, hi), pb[s2], O[nb]); } \
  } while (0)
  DL_LOAD(0, 0);
#pragma unroll 1
  for (int tau = 0; tau < NTILE; ++tau) {
    DL_STORE(0);
    { const int tn = (tau + 1 < NTILE) ? tau + 1 : tau; DL_LOAD(0, tn); }
    DL_COMPUTE(0, tau);
  }
#undef DL_PARAMS
#undef DL_LOAD
#undef DL_STORE
#undef DL_COMPUTE
  const float ltot = l + __shfl_xor(l, 32);
  if (PASS == 1) {
#pragma unroll
    for (int nb = 0; nb < 2; ++nb)
#pragma unroll
      for (int g4 = 0; g4 < 4; ++g4) {
        const int ch = 8 * nb + 2 * g4 + h;
        u32x2 o; o[0] = pk2(O[nb][4 * g4 + 0], O[nb][4 * g4 + 1]); o[1] = pk2(O[nb][4 * g4 + 2], O[nb][4 * g4 + 3]);
        *(u32x2*)(dpart + tl * 128 + ((ch ^ psw) << 3)) = o;
      }
    if (h == 0) dl[tl] = ltot;
  } else {
    const float inv = 1.0f / ltot;
    u16* mix = (u16*)((unsigned char*)p.out + OUT_MIX) + (size_t)(seq_start + qpos) * 1024 + hd * 64;
#pragma unroll
    for (int nb = 0; nb < 2; ++nb)
#pragma unroll
      for (int g4 = 0; g4 < 4; ++g4) {
        const int d0 = 32 * nb + 8 * g4 + 4 * h;
        u32x2 o; o[0] = pk2(O[nb][4 * g4 + 0] * inv, O[nb][4 * g4 + 1] * inv); o[1] = pk2(O[nb][4 * g4 + 2] * inv, O[nb][4 * g4 + 3] * inv);
        *(u32x2*)(mix + d0) = o;
      }
  }
}

DI void phase_attn(const Params& p, unsigned char* lds) {
  const int tid = threadIdx.x;
  float* misc = (float*)(lds + AL_MISC);
  if (tid == 0) {
    float gqa = 0.f, gka = 0.f, gqb = 0.f, gkb = 0.f, bm = 0.f;
    for (int i = 0; i < 64; ++i) { gqa = fmaxf(gqa, fabsf(p.q_norm_a[i])); gka = fmaxf(gka, fabsf(p.k_norm_a[i])); gqb = fmaxf(gqb, fabsf(p.q_norm_b[i])); gkb = fmaxf(gkb, fabsf(p.k_norm_b[i])); }
    for (int i = 0; i < 32 * 12; ++i) bm = fmaxf(bm, fabsf(p.rel_bias[i]));
    const float M2 = 8.0f * LOG2E * fmaxf(gqa * gka, gqb * gkb) * 1.02f + bm * LOG2E + 0.1f;
    float s1 = 0.f, s2 = 0.f;
    for (int i = 0; i < 64; ++i) { s1 += p.lq1[i] * p.lk1[i]; s2 += p.lq2[i] * p.lk2[i]; }
    misc[0] = M2; misc[1] = expf(s1) - expf(s2) + 0.2f;
    for (int hd = 0; hd < 4; ++hd) { misc[8 + hd] = p.rel_bias[15 * 12 + 8 + hd] * LOG2E; misc[12 + hd] = (p.rel_bias[31 * 12 + 8 + hd] - p.rel_bias[15 * 12 + 8 + hd]) * LOG2E; }
  }
  __syncthreads();
  const float M2 = misc[0], lam = misc[1];
  {
    float* tabA = (float*)(lds + AL_TABA);
    for (int i = tid; i < 8 * 3 * 132; i += NTHR) {
      int hd = i / 396, rem = i % 396, br = rem / 132, idx = rem % 132;
      int dl = idx - 65; float v = NEG_BIG;
      if (dl >= -64 && dl <= 64 && idx < 131) { int d = (br == 0) ? 16 : (br == 1) ? 4 : 1; v = p.rel_bias[rel_bucket(dl * d) * 12 + hd] * LOG2E - M2; }
      tabA[i] = v;
    }
  }
#ifndef REP_DIFF
#define REP_DIFF 1
#endif
#ifndef REP_DIL
#define REP_DIL 1
#endif
  int cur_hd = -1;
  for (int rep_ = 0; rep_ < REP_DIFF; ++rep_)
  for (int vb = blockIdx.x; vb < 256; vb += gridDim.x) {
    const int xl = vb & 7, rk = vb >> 3;
#pragma unroll 1
    for (int rnd = 0; rnd < 8; ++rnd) {
      int seq_start, S, hd, q0;
      if (rnd < 4) { const int pair = xl + 8 * rnd; hd = pair & 3; S = 4096; seq_start = (pair >> 2) * 4096; q0 = rk * 128; }
      else { const int pair = 8 * xl + 2 * (rnd - 4) + (rk >> 4); hd = pair & 3; S = 2048; seq_start = T_PROMPT + (pair >> 2) * 2048; q0 = (rk & 15) * 128; }
      if (hd != cur_hd) {
        __syncthreads();
        float* tab = (float*)(lds + AL_TAB);
        for (int i = tid; i < 1281; i += NTHR) tab[i] = p.rel_bias[rel_bucket(i - 640) * 12 + 8 + hd] * LOG2E - misc[8 + hd];
        cur_hd = hd;
        __syncthreads();
      }
#ifndef PROBE_VAR
#define PROBE_VAR 0
#endif
      if (rep_ == 0) diff_unit<0>(p, lds, seq_start, S, hd, q0, lam); else diff_unit<PROBE_VAR>(p, lds, seq_start, S, hd, q0, lam);
    }
  }
  __syncthreads();
  const int w = tid >> 6;
  for (int rep_ = 0; rep_ < REP_DIL; ++rep_)
  for (int vb = blockIdx.x; vb < 256; vb += gridDim.x)
#pragma unroll 1
  for (int rnd = 0; rnd < 4; ++rnd) {
    const int xl = vb & 7, rk = vb >> 3;
    int seq_start, S, hd, i0;
    if (rnd < 2) { const int pair = xl * 8 + rnd * 4 + (rk >> 3); hd = pair & 7; S = 4096; seq_start = (pair >> 3) * 4096; i0 = (rk & 7) * 512; }
    else { const int pair = xl * 16 + (rnd - 2) * 8 + (rk >> 2); hd = pair & 7; S = 2048; seq_start = T_PROMPT + (pair >> 3) * 2048; i0 = (rk & 3) * 512; }
    __syncthreads();
#pragma unroll 1
    for (int u2 = 0; u2 < 2; ++u2) dil_wave_item<1>(p, lds, seq_start, S, hd, i0, w + 8 * u2);
    __syncthreads();
#pragma unroll 1
    for (int u2 = 0; u2 < 2; ++u2) dil_wave_item<2>(p, lds, seq_start, S, hd, i0, w + 8 * u2);
  }
}

struct EpiOut {
  static constexpr bool PERM = false, AFTER_DRAIN = false, HEADPERM = false;
  const float* xp; const float* xs; float* x1;
  __device__ __forceinline__ void operator()(const pg8::f32x4 (&acc)[2][2][4][2], const pg8::Unit& u, int wr, int wc, int fr, int fq) const {
    const int col0 = u.pn * 256 + wc * 32 + 4 * fq;
#pragma unroll
    for (int ai = 0; ai < 2; ++ai)
#pragma unroll
      for (int m = 0; m < 4; ++m) {
        const int t = u.pm * 256 + ai * 128 + wr * 64 + m * 16 + fr;
        const float* xr = ((t < T_PROMPT) ? xp + (size_t)t * DM : xs + (size_t)(t - T_PROMPT) * DM) + col0;
        float* orow = x1 + (size_t)t * DM + col0;
#pragma unroll
        for (int bj = 0; bj < 2; ++bj)
#pragma unroll
          for (int n = 0; n < 2; ++n) {
            const f32x4 xv = *(const f32x4*)(xr + bj * 128 + n * 16);
            *(f32x4*)(orow + bj * 128 + n * 16) = xv + acc[ai][bj][m][n];
          }
      }
  }
};

DI void phase_outproj(const Params& p, unsigned char* lds) {
  pg8::Gemm g{(const u16*)((const unsigned char*)p.out + OUT_MIX), (const u16*)(p.ws + WS_WOUT), T_TOK, 1024, 1024};
  pg8::StaticOrder S; S.init(T_TOK, 1024, (int)gridDim.x, (int)blockIdx.x);
  EpiOut E{p.x_prompt, p.x_sample, (float*)(p.ws + WS_X1)};
  pg8::gemm_phase<EpiOut, pg8::StaticOrder, true, true>((PG8_LAS unsigned char*)lds, g, S, E);
}

DI void phase_norm2(const Params& p) {
  const int tid = threadIdx.x, lane = tid & 63, w = tid >> 6;
  const float* x1 = (const float*)(p.ws + WS_X1);
  u16* hb = (u16*)(p.ws + WS_H);
  for (int it = blockIdx.x; it < T_TOK / 8; it += gridDim.x) {
    int t = it * 8 + w;
    norm_row(x1 + (size_t)t * DM, p.ffn_norm_g, hb + (size_t)t * DM, lane);
  }
}

struct EpiQp {
  static constexpr bool PERM = true, AFTER_DRAIN = false, HEADPERM = false;
  u16* O;
  __device__ __forceinline__ void operator()(const pg8::f32x4 (&acc)[2][2][4][2], const pg8::Unit& u, int wr, int wc, int fr, int fq) const {
    const int col0 = u.pn * 256 + wc * 32 + 8 * fq;
#pragma unroll
    for (int ai = 0; ai < 2; ++ai)
#pragma unroll
      for (int m = 0; m < 4; ++m) {
        const int t = u.pm * 256 + ai * 128 + wr * 64 + m * 16 + fr;
        u16* rowp = O + (size_t)t * 2048 + col0;
#pragma unroll
        for (int bj = 0; bj < 2; ++bj) {
          const f32x4 v0 = acc[ai][bj][m][0], v1 = acc[ai][bj][m][1];
          u32x4 o; o[0] = pk2(v0[0], v0[1]); o[1] = pk2(v0[2], v0[3]); o[2] = pk2(v1[0], v1[1]); o[3] = pk2(v1[2], v1[3]);
          *(u32x4*)(rowp + bj * 128) = o;
        }
      }
  }
};

DI void phase_peer_query(const Params& p, unsigned char* lds) {
  pg8::Gemm g{(const u16*)(p.ws + WS_H), (const u16*)(p.ws + WS_WQ), T_TOK, 2048, 1024};
  pg8::StaticOrder S; S.init(T_TOK, 2048, (int)gridDim.x, (int)blockIdx.x);
  EpiQp E{(u16*)p.out};
  pg8::gemm_phase<EpiQp, pg8::StaticOrder, true, true>((PG8_LAS unsigned char*)lds, g, S, E);
}

DI int f2sort(float f) { const int b = __float_as_int(f); return b ^ ((b >> 31) & 0x7fffffff); }
DI float sort2f(int s) { return __int_as_float(s ^ ((s >> 31) & 0x7fffffff)); }
#define CE_DESC(a, b) do { const int mx_ = max((a), (b)), mn_ = min((a), (b)); (a) = mx_; (b) = mn_; } while (0)
#define CE_ASC(a, b) do { const int mx_ = max((a), (b)), mn_ = min((a), (b)); (a) = mn_; (b) = mx_; } while (0)
template <int OFF> DI void sort16_desc(int (&x)[64]) {
#pragma unroll
  for (int k = 2; k <= 16; k <<= 1)
#pragma unroll
    for (int j = k >> 1; j > 0; j >>= 1)
#pragma unroll
      for (int i = 0; i < 16; ++i) {
        const int l = i ^ j;
        if (l > i) { if ((i & k) == 0) CE_DESC(x[OFF + i], x[OFF + l]); else CE_ASC(x[OFF + i], x[OFF + l]); }
      }
}
template <int A, int B> DI void merge16x(int (&x)[64]) {
#pragma unroll
  for (int i = 0; i < 16; ++i) x[A + i] = max(x[A + i], x[B + 15 - i]);
#pragma unroll
  for (int j = 8; j > 0; j >>= 1)
#pragma unroll
    for (int i = 0; i < 16; ++i) { const int l = i ^ j; if (l > i) CE_DESC(x[A + i], x[A + l]); }
}

DI void phase_peer_route(const Params& p, unsigned char* lds) {
  const u16* QP = (const u16*)p.out;
  const u16* SK = (const u16*)(p.ws + WS_SK);
  u16* eidx = (u16*)(p.ws + WS_EIDX);
  float* gg = (float*)(p.ws + WS_G);
  const int tid = threadIdx.x, lane = tid & 63, r32 = lane & 31, h = lane >> 5;
  const int w = __builtin_amdgcn_readfirstlane(tid >> 6);
  unsigned char* SKl = lds;
  float* v2l = (float*)(lds + 65536);
  __syncthreads();
#pragma unroll
  for (int i = 0; i < 8; ++i) {
    const int c = tid + 512 * i; const int zz = c >> 11, row = (c >> 4) & 127, ch = c & 15;
    const u32x4 v = *(const u32x4*)(SK + (size_t)zz * 16384 + row * 128 + ch * 8);
    *(u32x4*)(SKl + zz * 32768 + row * 256 + ((ch ^ (row & 15)) << 4)) = v;
  }
  __syncthreads();
  for (int item = blockIdx.x; item < T_TOK / 256; item += gridDim.x) {
    const int t = item * 256 + w * 32 + r32;
    const u16* qrow = QP + (size_t)t * 2048;
    bf16x8 qf[8];
#pragma unroll
    for (int ks = 0; ks < 8; ++ks) qf[ks] = *(const bf16x8*)(qrow + ks * 16 + h * 8);
#pragma unroll 1
    for (int pp = 0; pp < 8; ++pp) {
      int lists[2][16];
#pragma unroll
      for (int z = 0; z < 2; ++z) {
        const int c16 = pp * 2 + z;
        int x[64];
        {
          f32x16 S2[4];
#pragma unroll
          for (int kb = 0; kb < 4; ++kb)
#pragma unroll
            for (int r = 0; r < 16; ++r) S2[kb][r] = 0.f;
#pragma unroll
          for (int ks = 0; ks < 8; ++ks)
#pragma unroll
            for (int kb = 0; kb < 4; ++kb) {
              const int key = kb * 32 + r32;
              const bf16x8 a = *(const bf16x8*)(SKl + z * 32768 + key * 256 + (((2 * ks + h) ^ (key & 15)) << 4));
              S2[kb] = MFMA32(a, qf[ks], S2[kb]);
            }
          {
            const int cn = (c16 + 1 < 16) ? c16 + 1 : 15;
#pragma unroll
            for (int ks = 0; ks < 8; ++ks) qf[ks] = *(const bf16x8*)(qrow + cn * 128 + ks * 16 + h * 8);
          }
#pragma unroll
          for (int e = 0; e < 64; ++e) {
            const int kidx = 32 * (e >> 4) + (e & 3) + 8 * ((e & 15) >> 2) + 4 * h;
            x[e] = (f2sort(S2[e >> 4][e & 15]) & ~127) | kidx;
          }
        }
        sort16_desc<0>(x); sort16_desc<16>(x); sort16_desc<32>(x); sort16_desc<48>(x);
        merge16x<0, 16>(x); merge16x<32, 48>(x); merge16x<0, 32>(x);
#pragma unroll
        for (int i = 0; i < 16; ++i) x[16 + i] = __shfl_xor(x[i], 32);
        merge16x<0, 16>(x);
#pragma unroll
        for (int i = 0; i < 16; ++i) lists[z][i] = x[i];
      }
      float v1h[8];
#pragma unroll
      for (int i = 0; i < 8; ++i) { const int a0_ = lists[0][i], a1_ = lists[0][8 + i]; v1h[i] = sort2f(a0_ ^ ((a0_ ^ a1_) & -h)); }
#pragma unroll
      for (int i = 0; i < 16; ++i) v2l[i * 512 + tid] = sort2f(lists[1][i]);
      unsigned ptrs = 0u;
      float bestv[16]; int be[16];
#pragma unroll
      for (int rd = 0; rd < 16; ++rd) {
        float best = -3.0e38f, bv1 = 0.f, bv2 = 0.f; int ab = 0;
#pragma unroll
        for (int a = 0; a < 8; ++a) {
          const int b = (int)((ptrs >> (4 * a)) & 15u);
          const float v2 = v2l[b * 512 + tid];
          const float cnd = v1h[a] + v2;
          if (cnd > best) { best = cnd; ab = a; bv1 = v1h[a]; bv2 = v2; }
        }
        const float obest = __shfl_xor(best, 32), obv1 = __shfl_xor(bv1, 32), obv2 = __shfl_xor(bv2, 32);
        const bool mine = h ? (best > obest) : (best >= obest);
        const float wbest = mine ? best : obest, w1 = mine ? bv1 : obv1, w2 = mine ? bv2 : obv2;
        bestv[rd] = wbest; be[rd] = (f2sort(w1) & 127) * 128 + (f2sort(w2) & 127);
        if (mine) ptrs += 1u << (4 * ab);
      }
      if (h == 0) {
        float ex[16]; float sum = 0.f;
#pragma unroll
        for (int rd = 0; rd < 16; ++rd) { ex[rd] = __expf(bestv[rd] - bestv[0]); sum += ex[rd]; }
        const float inv = 1.0f / sum;
        const size_t oo = ((size_t)t * 8 + pp) * 16;
#pragma unroll
        for (int q4 = 0; q4 < 4; ++q4) { f32x4 v = {ex[4 * q4] * inv, ex[4 * q4 + 1] * inv, ex[4 * q4 + 2] * inv, ex[4 * q4 + 3] * inv}; *(f32x4*)(gg + oo + 4 * q4) = v; }
        u32x4 e0, e1;
#pragma unroll
        for (int j = 0; j < 4; ++j) { e0[j] = (unsigned)be[2 * j] | ((unsigned)be[2 * j + 1] << 16); e1[j] = (unsigned)be[8 + 2 * j] | ((unsigned)be[8 + 2 * j + 1] << 16); }
        *(u32x4*)(eidx + oo) = e0; *(u32x4*)(eidx + oo + 8) = e1;
      }
    }
  }
}

typedef float f2_t __attribute__((ext_vector_type(2)));
DI unsigned xcc_id() { return (unsigned)__builtin_amdgcn_s_getreg((3 << 11) | 20) & 7u; }
constexpr int PG_CHUNK_TOK = 64;
constexpr int PG_NCHUNK = T_TOK / PG_CHUNK_TOK;

DI void dec16(const u32x4& r, f2_t (&v)[8]) {
#pragma unroll
  for (int d = 0; d < 4; ++d) { v[2 * d] = __builtin_amdgcn_cvt_pk_f32_fp8((int)r[d], false); v[2 * d + 1] = __builtin_amdgcn_cvt_pk_f32_fp8((int)r[d], true); }
}

template <int CTRL> DI float dpp_f(float x) { return __int_as_float(__builtin_amdgcn_update_dpp(0, __float_as_int(x), CTRL, 0xf, 0xf, true)); }
DI int idx16(const u32x4& a, const u32x4& b, int i) { const unsigned wd = (i < 8) ? a[(i & 7) >> 1] : b[(i & 7) >> 1]; return (i & 1) ? (int)(wd >> 16) : (int)(wd & 0xffffu); }
template <int WHICH>
DI void peer_wave_tokens(const Params& p, int x, int tb, int lane) {
  const unsigned char* TBL = p.ws + (WHICH ? WS_V : WS_U) + (size_t)x * 16384 * 128;
  const u16* Hb = (const u16*)(p.ws + WS_H);
  const u16* eidx = (const u16*)(p.ws + WS_EIDX);
  const float* wg = (const float*)(p.ws + WS_G);
  const float* x1 = (const float*)(p.ws + WS_X1);
  float* zpart = (float*)p.out;
  const int r = lane >> 3, c = lane & 7;
  u32x4 ei[2][2]; f32x4 wv[2][4]; u32x4 rows[2][16];
#define PEER_LOAD_IDX(buf, k) do { const size_t o_ = (size_t)(tb + (k)) * 128 + r * 16; \
    ei[buf][0] = *(const u32x4*)(eidx + o_); ei[buf][1] = *(const u32x4*)(eidx + o_ + 8); \
    if (WHICH) { _Pragma("unroll") for (int q = 0; q < 4; ++q) wv[buf][q] = *(const f32x4*)(wg + o_ + 4 * q); } } while (0)
#define PEER_LOAD_ROWS(buf, ibuf) do { _Pragma("unroll") for (int i = 0; i < 16; ++i) { \
      const unsigned off_ = (unsigned)idx16(ei[ibuf][0], ei[ibuf][1], i) * 128u + (unsigned)c * 16u; \
      rows[buf][i] = *(const u32x4*)(TBL + off_); } } while (0)
  PEER_LOAD_IDX(0, 0); PEER_LOAD_IDX(1, 1);
  PEER_LOAD_ROWS(0, 0);
#pragma unroll
  for (int k = 0; k < 8; ++k) {
    const int t = tb + k;
    if (k + 1 < 8) PEER_LOAD_ROWS((k + 1) & 1, (k + 1) & 1);
    f32x4 wcur[4];
    if (WHICH) {
#pragma unroll
      for (int q = 0; q < 4; ++q) wcur[q] = wv[k & 1][q];
    }
    if (k + 2 < 8) PEER_LOAD_IDX(k & 1, k + 2);
    if (WHICH == 0) {
      u32x4 ha = *(const u32x4*)(Hb + (size_t)t * DM + x * 128 + c * 16), hb = *(const u32x4*)(Hb + (size_t)t * DM + x * 128 + c * 16 + 8);
      f2_t hq[8];
#pragma unroll
      for (int j = 0; j < 4; ++j) {
        hq[j][0] = __uint_as_float(ha[j] << 16); hq[j][1] = __uint_as_float(ha[j] & 0xffff0000u);
        hq[4 + j][0] = __uint_as_float(hb[j] << 16); hq[4 + j][1] = __uint_as_float(hb[j] & 0xffff0000u);
      }
      float sv[16];
#pragma unroll
      for (int i = 0; i < 16; ++i) {
        f2_t v[8]; dec16(rows[k & 1][i], v);
        f2_t a = v[0] * hq[0];
#pragma unroll
        for (int q = 1; q < 8; ++q) a = __builtin_elementwise_fma(v[q], hq[q], a);
        float sx = a[0] + a[1];
        sx += dpp_f<0xB1>(sx);
        sx += dpp_f<0x4E>(sx);
        sx += dpp_f<0x141>(sx);
        sv[i] = sx;
      }
      float o0 = 0.f, o1 = 0.f;
#pragma unroll
      for (int i = 0; i < 8; ++i) { if (c == i) { o0 = sv[i]; o1 = sv[i + 8]; } }
      float* zp = zpart + ((size_t)x * T_TOK + t) * 128 + r * 16;
      zp[c] = o0; zp[c + 8] = o1;
    } else {
      f2_t acc[8];
#pragma unroll
      for (int q = 0; q < 8; ++q) { acc[q][0] = 0.f; acc[q][1] = 0.f; }
#pragma unroll
      for (int i = 0; i < 16; ++i) {
        f2_t v[8]; dec16(rows[k & 1][i], v);
        const float wj = wcur[i >> 2][i & 3];
        f2_t ww = {wj, wj};
#pragma unroll
        for (int q = 0; q < 8; ++q) acc[q] = __builtin_elementwise_fma(v[q], ww, acc[q]);
      }
      f2_t b4[4];
      {
        const bool up = (lane & 32) != 0;
#pragma unroll
        for (int q = 0; q < 4; ++q) {
          f2_t keep = up ? acc[4 + q] : acc[q], send = up ? acc[q] : acc[4 + q];
          f2_t got; got[0] = __shfl_xor(send[0], 32); got[1] = __shfl_xor(send[1], 32);
          b4[q] = keep + got;
        }
      }
      f2_t b2[2];
      {
        const bool up = (lane & 16) != 0;
#pragma unroll
        for (int q = 0; q < 2; ++q) {
          f2_t keep = up ? b4[2 + q] : b4[q], send = up ? b4[q] : b4[2 + q];
          f2_t got; got[0] = __shfl_xor(send[0], 16); got[1] = __shfl_xor(send[1], 16);
          b2[q] = keep + got;
        }
      }
      f2_t b1;
      {
        const bool up = (lane & 8) != 0;
        f2_t keep = up ? b2[1] : b2[0], send = up ? b2[0] : b2[1];
        f2_t got; got[0] = dpp_f<0x128>(send[0]); got[1] = dpp_f<0x128>(send[1]);
        b1 = keep + got;
      }
      const size_t o = (size_t)t * DM + x * 128 + c * 16 + 2 * r;
      f2_t xv = *(const f2_t*)(x1 + o);
      f2_t res = xv + b1;
      *(f2_t*)(p.out + o) = res;
    }
  }
#undef PEER_LOAD_IDX
#undef PEER_LOAD_ROWS
}

template <int WHICH>
DI void phase_peer_sliced(const Params& p, unsigned char* lds) {
  const int tid = threadIdx.x, lane = tid & 63, w = tid >> 6;
  unsigned* qctr = (unsigned*)(p.ws + WS_MISC + MISC_QCTR) + WHICH * 8;
  int* bc = (int*)lds;
  const unsigned x0 = xcc_id();
  for (int si = 0; si < 8; ++si) {
    const int x = (int)((x0 + si) & 7u);
    __syncthreads();
    if (tid == 0) bc[0] = (int)atomicAdd(&qctr[x], 1u);
    __syncthreads();
    int ch = bc[0];
    while (ch < PG_NCHUNK) {
      int nxt = 0;
      if (tid == 0) nxt = (int)atomicAdd(&qctr[x], 1u);
      peer_wave_tokens<WHICH>(p, x, ch * PG_CHUNK_TOK + w * 8, lane);
      __syncthreads();
      if (tid == 0) bc[0] = nxt;
      __syncthreads();
      ch = bc[0];
    }
  }
}

DI void phase_peer_act(const Params& p) {
  const float* zpart = (const float*)p.out;
  const u16* eidx = (const u16*)(p.ws + WS_EIDX);
  float* wg = (float*)(p.ws + WS_G);
  const float* suinv = (const float*)(p.ws + WS_MISC + MISC_SUINV);
  const float* svinv = (const float*)(p.ws + WS_MISC + MISC_SVINV);
  for (size_t i = (size_t)blockIdx.x * NTHR + threadIdx.x; i < (size_t)T_TOK * 128; i += (size_t)gridDim.x * NTHR) {
    float z = 0.f;
#pragma unroll
    for (int x = 0; x < 8; ++x) z += zpart[(size_t)x * T_TOK * 128 + i];
    const int e = eidx[i];
    z *= suinv[e];
    const float act = 0.5f * z * (1.0f + erff(z * 0.70710678118654752f));
    wg[i] = wg[i] * act * svinv[e];
  }
}

#define XB_TMO      128
#define XB_XCNT(j)  (256  + 64 * (j))
#define XB_XSUB(j)  (1280 + 64 * (j))
#define XB_XGEN(j)  (2304 + 64 * (j))
#define XB_TOP      3328
#define XB_TOPGEN   3392
#define XCD_BAR_WORDS 3456
#define XB_SPIN_CAP (1u << 18)
#define LAS __attribute__((address_space(3)))

__device__ __forceinline__ unsigned xb_ld(unsigned* p)              { return __hip_atomic_load(p, __ATOMIC_RELAXED, __HIP_MEMORY_SCOPE_AGENT); }
__device__ __forceinline__ unsigned xb_add(unsigned* p, unsigned v) { return __hip_atomic_fetch_add(p, v, __ATOMIC_RELAXED, __HIP_MEMORY_SCOPE_AGENT); }
__device__ __forceinline__ unsigned xb_xcc_id() { return (unsigned)__builtin_amdgcn_s_getreg((3 << 11) | 20) & 0xFu; }
#define XB_SPIN(cond, bar) do { unsigned _sp = 0; while (cond) { __builtin_amdgcn_s_sleep(1); \
    if ((++_sp & 255u) == 0u) { if (xb_ld(&(bar)[XB_TMO])) break; if (_sp > XB_SPIN_CAP) { atomicAdd(&(bar)[XB_TMO], 1u); break; } } } } while (0)

struct XcdBarrier {
    unsigned* bar; unsigned x;
    volatile LAS unsigned* st;
};

__device__ __forceinline__ XcdBarrier xcd_barrier_post(unsigned* bar, volatile LAS unsigned* st) {
    XcdBarrier b; b.bar = bar; b.x = xb_xcc_id(); b.st = st;
    if (threadIdx.x == 0) (void)xb_add(&bar[XB_XCNT(b.x)], 1u);
    return b;
}
__device__ __forceinline__ void xcd_barrier_complete(unsigned* bar, unsigned x, unsigned& nloc, unsigned& nx) {
    const unsigned G = gridDim.x * gridDim.y * gridDim.z;
    unsigned sum, cnt, mine, sp = 0u;
    for (;;) {
        sum = 0u; cnt = 0u; mine = 0u;
#pragma unroll
        for (unsigned j = 0; j < 16; ++j) { const unsigned c = xb_ld(&bar[XB_XCNT(j)]); sum += c; cnt += (c > 0u) ? 1u : 0u; mine = (j == x) ? c : mine; }
        if (sum == G) break;
        __builtin_amdgcn_s_sleep(1);
        if ((++sp & 255u) == 0u) { if (xb_ld(&bar[XB_TMO])) break; if (sp > XB_SPIN_CAP) { atomicAdd(&bar[XB_TMO], 1u); break; } }
    }
    nloc = mine > 0u ? mine : 1u; nx = cnt > 0u ? cnt : 1u;
}

__device__ __forceinline__ void xcd_barrier(const XcdBarrier& b) {
    asm volatile("s_waitcnt vmcnt(0)" ::: "memory");
    __syncthreads();
    if (threadIdx.x == 0) {
        unsigned* bar = b.bar;
        __builtin_amdgcn_s_waitcnt(0);
        unsigned nloc = b.st[0], nx = b.st[1];
        if (nloc == 0u) { xcd_barrier_complete(bar, b.x, nloc, nx); b.st[0] = nloc; b.st[1] = nx; }
        const unsigned old = xb_add(&bar[XB_XSUB(b.x)], 1u);
        const unsigned gen = old / nloc;
        if (old + 1u == (gen + 1u) * nloc) {
            __builtin_amdgcn_fence(__ATOMIC_RELEASE, "agent");
            asm volatile("s_waitcnt vmcnt(0)" ::: "memory");
            const unsigned og = xb_add(&bar[XB_TOP], 1u);
            const unsigned tg = og / nx;
            if (og + 1u == (tg + 1u) * nx) xb_add(&bar[XB_TOPGEN], 1u);
            else XB_SPIN(xb_ld(&bar[XB_TOPGEN]) == tg, bar);
            __builtin_amdgcn_fence(__ATOMIC_ACQUIRE, "agent");
            xb_add(&bar[XB_XGEN(b.x)], 1u);
            asm volatile("s_waitcnt vmcnt(0)" ::: "memory");
        } else {
            XB_SPIN(xb_ld(&bar[XB_XGEN(b.x)]) == gen, bar);
            __builtin_amdgcn_fence(__ATOMIC_ACQUIRE, "agent");
            asm volatile("s_waitcnt vmcnt(0)" ::: "memory");
        }
    }
    __syncthreads();
}


__global__ void __launch_bounds__(NTHR, 2) fwd_kernel(Params p) {
  extern __shared__ __attribute__((aligned(16))) unsigned char lds[];
  cg::grid_group grid = cg::this_grid();
#ifndef ONLY_PH
#define PHON(k) 1
#else
#define PHON(k) ((k) == ONLY_PH)
#endif
#ifndef REPEAT_MASK
#define REPEAT_MASK 0
#endif
#define GSYNC(k) do { if ((k) == 0) { grid.sync(); xbar = xcd_barrier_post((unsigned*)(p.ws + WS_MISC + MISC_BAR), (volatile LAS unsigned*)(lds + LDS_BARST)); } else xcd_barrier(xbar); } while (0)
#define RUN_PHASE(k, call) do { if (PHON(k) && lo <= (k) && (k) < hi) { call; if ((REPEAT_MASK >> (k)) & 1) { grid.sync(); call; } } if (lo <= (k) && (k) + 1 < hi) GSYNC(k); } while (0)
  const int lo = p.ph_lo, hi = p.ph_hi;
  if (threadIdx.x < 4) ((volatile LAS unsigned*)(lds + LDS_BARST))[threadIdx.x] = 0u;
  __syncthreads();
  XcdBarrier xbar; xbar.bar = (unsigned*)(p.ws + WS_MISC + MISC_BAR); xbar.x = 0; xbar.st = (volatile LAS unsigned*)(lds + LDS_BARST);
  RUN_PHASE(0, phase_prep(p, lds));
  RUN_PHASE(1, phase_proj(p, lds));
  RUN_PHASE(2, phase_attn(p, lds));
  RUN_PHASE(3, phase_outproj(p, lds));
  RUN_PHASE(4, phase_norm2(p));
  RUN_PHASE(5, phase_peer_query(p, lds));
  RUN_PHASE(6, phase_peer_route(p, lds));
  RUN_PHASE(7, phase_peer_sliced<0>(p, lds));
#ifndef PROBE_PEER
#define PROBE_PEER 0
#endif
  if (PROBE_PEER & 1) { if (blockIdx.x == 0 && threadIdx.x < 8) ((unsigned*)(p.ws + WS_MISC + MISC_QCTR))[threadIdx.x] = 0u; xcd_barrier(xbar); phase_peer_sliced<0>(p, lds); xcd_barrier(xbar); }
  RUN_PHASE(8, phase_peer_act(p));
  RUN_PHASE(9, phase_peer_sliced<1>(p, lds));
  if (PROBE_PEER & 2) { xcd_barrier(xbar); if (blockIdx.x == 0 && threadIdx.x < 8) ((unsigned*)(p.ws + WS_MISC + MISC_QCTR))[8 + threadIdx.x] = 0u; xcd_barrier(xbar); phase_peer_sliced<1>(p, lds); }
}

extern "C" void kernel_launch(void* const* d_in, const int* in_sizes, int n_in, void* d_out, int out_size, void* d_ws, size_t ws_size, hipStream_t stream) {
  static int grid_blocks = 0;
  if (grid_blocks == 0) {
    if (n_in != 20 || ws_size < WS_END || out_size != T_TOK * DM) {
      fprintf(stderr, "kernel_launch: unexpected problem shape (n_in %d, ws %zu, out %d)\n", n_in, ws_size, out_size);
      grid_blocks = -1; return;
    }
    int dev = 0, cus = 0, per_cu = 0;
    hipGetDevice(&dev);
    hipDeviceGetAttribute(&cus, hipDeviceAttributeMultiprocessorCount, dev);
    hipFuncSetAttribute((const void*)fwd_kernel, hipFuncAttributeMaxDynamicSharedMemorySize, LDS_BYTES);
    hipOccupancyMaxActiveBlocksPerMultiprocessor(&per_cu, (const void*)fwd_kernel, NTHR, LDS_BYTES);
    if (per_cu < 1) { fprintf(stderr, "kernel_launch: occupancy query says %d blocks/CU\n", per_cu); per_cu = 1; }
    grid_blocks = cus;
    (void)hipGetLastError();
  }
  if (grid_blocks < 0) return;
  Params p{};
  p.x_prompt = (const float*)d_in[0]; p.x_sample = (const float*)d_in[1]; p.rel_bias = (const float*)d_in[2]; p.attn_norm_g = (const float*)d_in[3];
  p.w_in = (const float*)d_in[4]; p.q_norm_a = (const float*)d_in[5]; p.k_norm_a = (const float*)d_in[6]; p.q_norm_b = (const float*)d_in[7];
  p.k_norm_b = (const float*)d_in[8]; p.lq1 = (const float*)d_in[9]; p.lk1 = (const float*)d_in[10]; p.lq2 = (const float*)d_in[11];
  p.lk2 = (const float*)d_in[12]; p.diff_norm_g = (const float*)d_in[13]; p.w_out = (const float*)d_in[14]; p.ffn_norm_g = (const float*)d_in[15];
  p.peer_w_q = (const float*)d_in[16]; p.peer_sub_keys = (const float*)d_in[17]; p.peer_u = (const float*)d_in[18]; p.peer_v = (const float*)d_in[19];
  p.out = (float*)d_out; p.ws = (unsigned char*)d_ws;
#if FUSED
  p.ph_lo = 0; p.ph_hi = NPHASE;
  void* args[] = {&p};
  hipError_t e = hipLaunchCooperativeKernel((const void*)fwd_kernel, dim3(grid_blocks), dim3(NTHR), args, LDS_BYTES, stream);
  if (e != hipSuccess) fprintf(stderr, "cooperative launch failed: %s (grid %d)\n", hipGetErrorString(e), grid_blocks);
#else
  for (int ph = 0; ph < NPHASE; ++ph) {
    p.ph_lo = ph; p.ph_hi = ph + 1;
    hipLaunchKernelGGL(fwd_kernel, dim3(grid_blocks), dim3(NTHR), LDS_BYTES, stream, p);
  }
#endif
}
```

```cpp
#include <hip/hip_runtime.h>
#include <hip/hip_cooperative_groups.h>
#include <cstdio>
#include <cstdint>
namespace cg = cooperative_groups;

#ifndef FUSED
#define FUSED 1
#endif

typedef unsigned short u16;
typedef __attribute__((ext_vector_type(8))) short bf16x8;
typedef __attribute__((ext_vector_type(4))) short s16x4;
typedef __attribute__((ext_vector_type(16))) float f32x16;
typedef __attribute__((ext_vector_type(4))) float f32x4;
typedef __attribute__((ext_vector_type(4))) unsigned u32x4;
typedef __attribute__((ext_vector_type(2))) unsigned u32x2;
typedef __attribute__((address_space(3))) unsigned char* ldsp_t;

#define DI __device__ __forceinline__
#define MFMA32(a, b, c) __builtin_amdgcn_mfma_f32_32x32x16_bf16((a), (b), (c), 0, 0, 0)

constexpr int DM = 1024;
constexpr int T_TOK = 65536;
constexpr int T_PROMPT = 32768;
constexpr int NTHR = 512;
constexpr int NPHASE = 10;
constexpr float NORM_EPS = 1e-6f;
constexpr float LOG2E = 1.4426950408889634f;
constexpr float C2 = 0.125f * LOG2E;
constexpr float NEG_BIG = -1.0e30f;

constexpr size_t WS_WIN  = 0;
constexpr size_t WS_WOUT = WS_WIN + (size_t)3072 * 1024 * 2;
constexpr size_t WS_WQ   = WS_WOUT + (size_t)1024 * 1024 * 2;
constexpr size_t WS_SK   = WS_WQ + (size_t)2048 * 1024 * 2;
constexpr size_t WS_U    = WS_SK + (size_t)2 * 128 * 128 * 2;
constexpr size_t WS_V    = WS_U + (size_t)16384 * 1024 * 2;
constexpr size_t WS_MISC = WS_V + (size_t)16384 * 1024 * 2;
constexpr size_t MISC_SUINV = 0, MISC_SVINV = 65536, MISC_QCTR = 131072, MISC_BAR = 196608;
constexpr size_t WS_R    = WS_MISC + (size_t)1048576;
constexpr size_t R_REGION = (size_t)T_TOK * 512 * 2;
constexpr size_t WS_X1   = WS_R;
constexpr size_t WS_H    = WS_R + (size_t)T_TOK * 1024 * 4;
constexpr size_t WS_EIDX = WS_R + 6 * R_REGION;
constexpr size_t WS_G    = WS_EIDX + (size_t)T_TOK * 128 * 2;
constexpr size_t WS_END  = WS_G + (size_t)T_TOK * 128 * 4;
static_assert(WS_END <= (size_t)536870912, "workspace map exceeds 512 MiB");
constexpr size_t OUT_N1 = 0, OUT_MIX = 134217728, OUT_TV = 0, OUT_TI = 67108864;

constexpr int LDS_BYTES = 163840;
constexpr int LDS_BARST = 163840 - 256;

struct Params {
  const float* x_prompt; const float* x_sample; const float* rel_bias; const float* attn_norm_g; const float* w_in;
  const float* q_norm_a; const float* k_norm_a; const float* q_norm_b; const float* k_norm_b;
  const float* lq1; const float* lk1; const float* lq2; const float* lk2; const float* diff_norm_g; const float* w_out;
  const float* ffn_norm_g; const float* peer_w_q; const float* peer_sub_keys; const float* peer_u; const float* peer_v;
  float* out; unsigned char* ws; int ph_lo; int ph_hi;
};

DI u16 f2bf(float f) { unsigned u = __float_as_uint(f); u += 0x7fffu + ((u >> 16) & 1u); return (u16)(u >> 16); }
DI float bf2f(u16 b) { return __uint_as_float(((unsigned)b) << 16); }
DI unsigned pk2(float lo, float hi) {
  typedef float f2_t __attribute__((ext_vector_type(2)));
  typedef __bf16 b2_t __attribute__((ext_vector_type(2)));
  f2_t v = {lo, hi}; b2_t b = __builtin_convertvector(v, b2_t); return __builtin_bit_cast(unsigned, b);
}
DI int crow(int reg, int h) { return (reg & 3) + 8 * (reg >> 2) + 4 * h; }
DI float wave_sum(float v) {
#pragma unroll
  for (int o = 32; o > 0; o >>= 1) v += __shfl_xor(v, o);
  return v;
}
DI void seq_of(int t, int& seq_start, int& S, int& s) {
  if (t < T_PROMPT) { S = 4096; seq_start = t & ~4095; s = t & 4095; }
  else { S = 2048; seq_start = t & ~2047; s = t & 2047; }
}
DI const float* x_row(const Params& p, int t) {
  return (t < T_PROMPT) ? p.x_prompt + (size_t)t * DM : p.x_sample + (size_t)(t - T_PROMPT) * DM;
}
DI int rel_bucket(int rel) {
  int n = rel < 0 ? -rel : rel;
  int b;
  if (n < 8) b = n;
  else if (n < 15) b = 8; else if (n < 27) b = 9; else if (n < 50) b = 10; else if (n < 91) b = 11;
  else if (n < 166) b = 12; else if (n < 305) b = 13; else if (n < 559) b = 14; else b = 15;
  return (rel > 0 ? 16 : 0) + b;
}
DI s16x4 tr_read(const unsigned char* p) {
  typedef short v4i16_t __attribute__((ext_vector_type(4)));
  return __builtin_bit_cast(s16x4, __builtin_amdgcn_ds_read_tr16_b64_v4i16((__attribute__((address_space(3))) v4i16_t*)p));
}
DI bf16x8 cat8(s16x4 lo, s16x4 hi) { return __builtin_shufflevector(lo, hi, 0, 1, 2, 3, 4, 5, 6, 7); }

DI void transpose_item(const float* __restrict__ src, int K, int N, u16* __restrict__ dst, int k0, int n0, unsigned char* lds) {
  float* tile = (float*)lds;
  const int tid = threadIdx.x;
#pragma unroll
  for (int i = 0; i < 8; ++i) {
    int idx = tid + 512 * i; int r = idx >> 6, c = idx & 63;
    tile[r * 65 + c] = src[(size_t)(k0 + r) * N + n0 + c];
  }
  __syncthreads();
  {
    int n = tid >> 3, kc = tid & 7;
    u32x4 o;
    o[0] = pk2(tile[(kc * 8 + 0) * 65 + n], tile[(kc * 8 + 1) * 65 + n]);
    o[1] = pk2(tile[(kc * 8 + 2) * 65 + n], tile[(kc * 8 + 3) * 65 + n]);
    o[2] = pk2(tile[(kc * 8 + 4) * 65 + n], tile[(kc * 8 + 5) * 65 + n]);
    o[3] = pk2(tile[(kc * 8 + 6) * 65 + n], tile[(kc * 8 + 7) * 65 + n]);
    *(u32x4*)(dst + (size_t)(n0 + n) * K + k0 + kc * 8) = o;
  }
  __syncthreads();
}

DI void convert_item(const float* __restrict__ src, u16* __restrict__ dst, size_t base) {
  size_t i = base + (size_t)threadIdx.x * 8;
  f32x4 a = *(const f32x4*)(src + i), b = *(const f32x4*)(src + i + 4);
  u32x4 o; o[0] = pk2(a[0], a[1]); o[1] = pk2(a[2], a[3]); o[2] = pk2(b[0], b[1]); o[3] = pk2(b[2], b[3]);
  *(u32x4*)(dst + i) = o;
}

DI void norm_row(const float* __restrict__ xr, const float* __restrict__ g, u16* __restrict__ orow, int lane) {
  f32x4 v[4]; float ss = 0.f;
#pragma unroll
  for (int i = 0; i < 4; ++i) { v[i] = *(const f32x4*)(xr + lane * 4 + 256 * i); ss += v[i][0] * v[i][0] + v[i][1] * v[i][1] + v[i][2] * v[i][2] + v[i][3] * v[i][3]; }
  ss = wave_sum(ss);
  const float r = __builtin_amdgcn_rsqf(ss * (1.0f / 1024.0f) + NORM_EPS);
#pragma unroll
  for (int i = 0; i < 4; ++i) {
    f32x4 gg = *(const f32x4*)(g + lane * 4 + 256 * i);
    u32x2 o; o[0] = pk2(v[i][0] * r * gg[0], v[i][1] * r * gg[1]); o[1] = pk2(v[i][2] * r * gg[2], v[i][3] * r * gg[3]);
    *(u32x2*)(orow + lane * 4 + 256 * i) = o;
  }
}

DI void phase_prep(const Params& p, unsigned char* lds) {
  const int nb = gridDim.x, bid = blockIdx.x, tid = threadIdx.x;
  u16* wsb = (u16*)p.ws;
  for (int it = bid; it < 768 + 256 + 512; it += nb) {
    if (it < 768) { int kt = it / 48, nt = it % 48; transpose_item(p.w_in, 1024, 3072, (u16*)(p.ws + WS_WIN), kt * 64, nt * 64, lds); }
    else if (it < 1024) { int j = it - 768; int kt = j / 16, nt = j % 16; transpose_item(p.w_out, 1024, 1024, (u16*)(p.ws + WS_WOUT), kt * 64, nt * 64, lds); }
    else { int j = it - 1024; int kt = j / 32, nt = j % 32; transpose_item(p.peer_w_q, 1024, 2048, (u16*)(p.ws + WS_WQ), kt * 64, nt * 64, lds); }
  }
  for (int it = bid; it < 8; it += nb) convert_item(p.peer_sub_keys, (u16*)(p.ws + WS_SK), (size_t)it * 4096);
  if (bid == 0 && tid < 64) ((unsigned*)(p.ws + WS_MISC + MISC_QCTR))[tid] = 0u;
  if (bid == 0) for (int i = tid; i < 3456; i += NTHR) ((unsigned*)(p.ws + WS_MISC + MISC_BAR))[i] = 0u;
  {
    const int lane_ = tid & 63, w_ = tid >> 6;
    for (int it = bid; it < 2 * 16384 / 8; it += nb) {
      const int row = it * 8 + w_;
      const int tbl = row >> 14, e = row & 16383;
      const float* src = (tbl ? p.peer_v : p.peer_u) + (size_t)e * DM + lane_ * 16;
      f32x4 a0 = *(const f32x4*)(src), a1 = *(const f32x4*)(src + 4), a2 = *(const f32x4*)(src + 8), a3 = *(const f32x4*)(src + 12);
      float am = 0.f;
#pragma unroll
      for (int j = 0; j < 4; ++j) am = fmaxf(am, fmaxf(fmaxf(fabsf(a0[j]), fabsf(a1[j])), fmaxf(fabsf(a2[j]), fabsf(a3[j]))));
#pragma unroll
      for (int o = 32; o > 0; o >>= 1) am = fmaxf(am, __shfl_xor(am, o));
      const int ex = (int)((__float_as_uint(am) >> 23) & 255u);
      float sc = 1.0f, isc = 1.0f;
      if (ex > 8 && ex < 250) { sc = __uint_as_float((unsigned)(261 - ex) << 23); isc = __uint_as_float((unsigned)(ex - 7) << 23); }
      u32x4 o;
      { int pk = __builtin_amdgcn_cvt_pk_fp8_f32(a0[0] * sc, a0[1] * sc, 0, false); pk = __builtin_amdgcn_cvt_pk_fp8_f32(a0[2] * sc, a0[3] * sc, pk, true); o[0] = (unsigned)pk; }
      { int pk = __builtin_amdgcn_cvt_pk_fp8_f32(a1[0] * sc, a1[1] * sc, 0, false); pk = __builtin_amdgcn_cvt_pk_fp8_f32(a1[2] * sc, a1[3] * sc, pk, true); o[1] = (unsigned)pk; }
      { int pk = __builtin_amdgcn_cvt_pk_fp8_f32(a2[0] * sc, a2[1] * sc, 0, false); pk = __builtin_amdgcn_cvt_pk_fp8_f32(a2[2] * sc, a2[3] * sc, pk, true); o[2] = (unsigned)pk; }
      { int pk = __builtin_amdgcn_cvt_pk_fp8_f32(a3[0] * sc, a3[1] * sc, 0, false); pk = __builtin_amdgcn_cvt_pk_fp8_f32(a3[2] * sc, a3[3] * sc, pk, true); o[3] = (unsigned)pk; }
      unsigned char* dst = p.ws + (tbl ? WS_V : WS_U) + ((size_t)(lane_ >> 3) * 16384 + e) * 128 + (lane_ & 7) * 16;
      *(u32x4*)dst = o;
      if (lane_ == 0) ((float*)(p.ws + WS_MISC + (tbl ? MISC_SVINV : MISC_SUINV)))[e] = isc;
    }
  }
  const int lane = tid & 63, w = tid >> 6;
  u16* n1 = (u16*)((unsigned char*)p.out + OUT_N1);
  for (int it = bid; it < T_TOK / 8; it += nb) {
    int t = it * 8 + w;
    norm_row(x_row(p, t), p.attn_norm_g, n1 + (size_t)t * DM, lane);
  }
  (void)wsb;
}

template <int PR, int QR>
DI void gemm_mainloop(const u16* __restrict__ P, const u16* __restrict__ Q, int K, int p0, int q0, unsigned char* lds, f32x16 (&acc)[2][2]) {
  static_assert(PR + QR == 384, "tile");
  constexpr int STAGE = 384 * 128;
  constexpr int WC = QR / 64;
  const int tid = threadIdx.x, lane = tid & 63, r32 = lane & 31, h = lane >> 5;
  const int w = __builtin_amdgcn_readfirstlane(tid >> 6);
  const int wr = w / WC, wc = w % WC;
#pragma unroll
  for (int i = 0; i < 2; ++i)
#pragma unroll
    for (int j = 0; j < 2; ++j)
#pragma unroll
      for (int r = 0; r < 16; ++r) acc[i][j][r] = 0.f;
  u32x4 stg[6];
  const u16* src[6]; int loff[6];
#pragma unroll
  for (int i = 0; i < 6; ++i) {
    int c = tid + 512 * i; int row = c >> 3, kc = c & 7;
    src[i] = (row < PR) ? P + (size_t)(p0 + row) * K + kc * 8 : Q + (size_t)(q0 + row - PR) * K + kc * 8;
    loff[i] = row * 128 + ((kc ^ ((row >> 1) & 7)) << 4);
  }
  const int KT = K / 64;
#pragma unroll
  for (int i = 0; i < 6; ++i) stg[i] = *(const u32x4*)(src[i]);
#pragma unroll
  for (int i = 0; i < 6; ++i) *(u32x4*)(lds + loff[i]) = stg[i];
  __syncthreads();
  int aoff[2], boff[2], asw[2], bsw[2];
#pragma unroll
  for (int i = 0; i < 2; ++i) {
    int ra = wr * 64 + i * 32 + r32; aoff[i] = ra * 128; asw[i] = (ra >> 1) & 7;
    int rb = PR + wc * 64 + i * 32 + r32; boff[i] = rb * 128; bsw[i] = (rb >> 1) & 7;
  }
  for (int kt = 0; kt < KT; ++kt) {
    const int buf = (kt & 1) * STAGE;
    if (kt + 1 < KT) {
#pragma unroll
      for (int i = 0; i < 6; ++i) stg[i] = *(const u32x4*)(src[i] + (kt + 1) * 64);
    }
#pragma unroll
    for (int ks = 0; ks < 4; ++ks) {
      bf16x8 a[2], b[2];
#pragma unroll
      for (int i = 0; i < 2; ++i) {
        a[i] = *(const bf16x8*)(lds + buf + aoff[i] + (((2 * ks + h) ^ asw[i]) << 4));
        b[i] = *(const bf16x8*)(lds + buf + boff[i] + (((2 * ks + h) ^ bsw[i]) << 4));
      }
#pragma unroll
      for (int i = 0; i < 2; ++i)
#pragma unroll
        for (int j = 0; j < 2; ++j) acc[i][j] = MFMA32(a[i], b[j], acc[i][j]);
    }
    if (kt + 1 < KT) {
      const int nbuf = ((kt + 1) & 1) * STAGE;
#pragma unroll
      for (int i = 0; i < 6; ++i) *(u32x4*)(lds + nbuf + loff[i]) = stg[i];
    }
    __syncthreads();
  }
}

namespace pg8 {
#define PG8_LAS __attribute__((address_space(3)))
typedef unsigned short bf16_t;
typedef short bf16x8 __attribute__((ext_vector_type(8)));
typedef float f32x4 __attribute__((ext_vector_type(4)));
typedef unsigned u32x4 __attribute__((ext_vector_type(4)));
constexpr int BM = 256, BK = 64, HALF = 128, HTB = HALF * BK * 2  , STAGE_BYTES = 8 * HTB, NXCD = 8, WGM = 8;

__host__ __device__ __forceinline__ int lds_byte(int r, int c) { const int st = (r >> 4) * 2 + (c >> 5), rr = r & 15, cc = c & 31, ob = rr * 64 + cc * 2; return st * 1024 + (ob ^ (((ob >> 9) & 1) << 5)); }
__host__ __device__ __forceinline__ void stage_rc(int b, int& R, int& C) { const int st = b / 1024, sb = b % 1024, swz = sb ^ (((sb >> 9) & 1) << 5); R = (st >> 1) * 16 + swz / 64; C = (st & 1) * 32 + (swz % 64) / 2; }
__host__ __device__ __forceinline__ int perm32(int rho) { const int n = rho >> 4, i = rho & 15; return 8 * (i >> 2) + 4 * n + (i & 3); }

struct Unit { int pm, pn; };
struct Gemm { const bf16_t* A; const bf16_t* Bt; int M, N, K; };

struct StaticOrder {
    int nM, nN, nwg, G, c;
    __host__ __device__ void init(int M, int N, int G_, int c_) { nM = M / BM; nN = N / BM; nwg = nM * nN; G = G_; c = c_; }
    __host__ __device__ bool next(int i, Unit& u) const {
        const long L = (long)i * G + c; if (L >= nwg) return false;
        int wgid = (int)L; { const int q = nwg / NXCD, r = nwg % NXCD, xcd = wgid % NXCD, off = wgid / NXCD; wgid = (xcd < r ? xcd * (q + 1) : r * (q + 1) + (xcd - r) * q) + off; }
        const int nig = WGM * nN, gid = wgid / nig, fm = gid * WGM, gsz = (nM - fm) < WGM ? (nM - fm) : WGM;
        u.pm = fm + ((wgid % nig) % gsz); u.pn = (wgid % nig) / gsz; return true;
    }
    __device__ __forceinline__ void a_ready(const Unit&) const {}
    __device__ __forceinline__ void done(const Unit&) const {}
};


template <class Epi, class Sched, bool ALIGN_EPI = false, bool SP2 = false>
__device__ __forceinline__ void gemm_phase(PG8_LAS unsigned char* lds, const Gemm g, const Sched& S, const Epi& E) {
    const int tid = threadIdx.x, wid = __builtin_amdgcn_readfirstlane(tid >> 6), lane = tid & 63, wr = wid >> 2, wc = wid & 3, fr = lane & 15, fq = lane >> 4;
    const int K = g.K, nt = K / BK;
    unsigned voffA[2], voffB[2], voffB1[2];
#pragma unroll
    for (int i = 0; i < 2; ++i) { int R, C; stage_rc(tid * 16 + i * 8192, R, C); const int Rb = Epi::PERM ? ((R & ~31) + perm32(R & 31)) : R;
        voffA[i] = (unsigned)(R * K + C) * 2u;
        if (Epi::HEADPERM) { const int Rh = 64 * (R >> 5) + perm32(R & 31); voffB[i] = (unsigned)(Rh * K + C) * 2u; voffB1[i] = (unsigned)((Rh + 32) * K + C) * 2u; }
        else { voffB[i] = (unsigned)(Rb * K + C) * 2u; voffB1[i] = (unsigned)((Rb + HALF) * K + C) * 2u; } }
    const size_t kstep = (size_t)(BK * 2);
    const size_t hstep = (size_t)HALF * K * 2;
    const size_t tstep = 2 * hstep;
    const unsigned ldsw = (unsigned)wid * 1024u;
    const int aoff = lds_byte(wr * 64 + fr, fq * 8), boff = lds_byte(wc * 32 + fr, fq * 8);
#define PG8_SA(b, h) (((b) * 2 + (h)) * HTB)
#define PG8_SB(b, h) ((4 + (b) * 2 + (h)) * HTB)
#define PG8_STAGE(bufoff, gbase, voff) do { _Pragma("unroll") for (int _i = 0; _i < 2; ++_i) \
        __builtin_amdgcn_global_load_lds((const unsigned*)((const char*)(gbase) + (voff)[_i]), (PG8_LAS unsigned*)(lds + (bufoff) + ldsw + _i * 8192), 16, 0, 0); } while (0)
#define PG8_LDA(dst, b, h) do { _Pragma("unroll") for (int m = 0; m < 4; ++m) _Pragma("unroll") for (int k = 0; k < 2; ++k) dst[m][k] = *(const PG8_LAS bf16x8*)(lds + PG8_SA(b, h) + aoff + m * 2048 + k * 1024); } while (0)
#define PG8_LDB(dst, b, h) do { _Pragma("unroll") for (int n = 0; n < 2; ++n) _Pragma("unroll") for (int k = 0; k < 2; ++k) dst[n][k] = *(const PG8_LAS bf16x8*)(lds + PG8_SB(b, h) + boff + n * 2048 + k * 1024); } while (0)
#define PG8_MMA(ai, bj, At, Bt) do { __builtin_amdgcn_s_setprio(1); _Pragma("unroll") for (int m = 0; m < 4; ++m) _Pragma("unroll") for (int n = 0; n < 2; ++n) _Pragma("unroll") for (int k = 0; k < 2; ++k) \
        acc[ai][bj][m][n] = __builtin_amdgcn_mfma_f32_16x16x32_bf16(Bt[n][k], At[m][k], acc[ai][bj][m][n], 0, 0, 0); __builtin_amdgcn_s_setprio(0); } while (0)
#define PG8_WAIT_V(n) asm volatile("s_waitcnt vmcnt(" #n ")" ::: "memory")
#define PG8_WAIT_L(n) asm volatile("s_waitcnt lgkmcnt(" #n ")" ::: "memory")
#define PG8_BAR __builtin_amdgcn_s_barrier()
#define PG8_SCHED __builtin_amdgcn_sched_barrier(0)
    Unit cur, nxt; int ui = 0;
    if (!S.next(0, cur)) return;
    f32x4 acc[2][2][4][2];
#pragma unroll
    for (int a = 0; a < 2; ++a)
#pragma unroll
        for (int b = 0; b < 2; ++b)
#pragma unroll
            for (int m = 0; m < 4; ++m)
#pragma unroll
                for (int n = 0; n < 2; ++n) acc[a][b][m][n] = (f32x4){0.f, 0.f, 0.f, 0.f};
    bf16x8 At[4][2], B0[2][2], B1[2][2];
    const char* cA = (const char*)g.A + (size_t)cur.pm * tstep; const char* cB = (const char*)g.Bt + (size_t)cur.pn * tstep;
    S.a_ready(cur);
    if constexpr (SP2) {
        PG8_STAGE(PG8_SB(0, 0), cB, voffB); PG8_STAGE(PG8_SB(0, 1), cB, voffB1); PG8_STAGE(PG8_SA(0, 0), cA, voffA); PG8_STAGE(PG8_SA(0, 1), cA + hstep, voffA);
        if (wr == 1) PG8_BAR;
        PG8_WAIT_V(2); PG8_BAR;
        PG8_STAGE(PG8_SB(1, 0), cB + kstep, voffB); PG8_STAGE(PG8_SA(1, 0), cA + kstep, voffA); PG8_STAGE(PG8_SB(1, 1), cB + kstep, voffB1);
        PG8_WAIT_V(6); PG8_BAR;
    } else {
        PG8_STAGE(PG8_SB(0, 0), cB, voffB); PG8_STAGE(PG8_SA(0, 0), cA, voffA); PG8_STAGE(PG8_SB(0, 1), cB, voffB1); PG8_STAGE(PG8_SA(0, 1), cA + hstep, voffA);
        if (wr == 1) PG8_BAR;
        PG8_WAIT_V(4); PG8_BAR;
        PG8_STAGE(PG8_SB(1, 0), cB + kstep, voffB); PG8_STAGE(PG8_SA(1, 0), cA + kstep, voffA); PG8_STAGE(PG8_SB(1, 1), cB + kstep, voffB1);
        PG8_WAIT_V(6); PG8_BAR;
    }
    for (;;) {
        const bool has_next = S.next(ui + 1, nxt);
        const char* nA = has_next ? (const char*)g.A + (size_t)nxt.pm * tstep : cA; const char* nB = has_next ? (const char*)g.Bt + (size_t)nxt.pn * tstep : cB;
        for (int t = 0; t < nt; t += 2) {
            const bool last = (t == nt - 2);
            const char* a1 = cA + (size_t)(t + 1) * kstep;
            const char* a2 = last ? nA : cA + (size_t)(t + 2) * kstep; const char* b2 = last ? nB : cB + (size_t)(t + 2) * kstep;
            const char* a3 = a2 + kstep; const char* b3 = b2 + kstep;
            if (last && has_next) S.a_ready(nxt);
            if constexpr (SP2) {
            PG8_LDB(B0, 0, 0); PG8_LDB(B1, 0, 1); PG8_SCHED; PG8_LDA(At, 0, 0); PG8_STAGE(PG8_SA(1, 1), a1 + hstep, voffA);
            PG8_WAIT_V(8); PG8_WAIT_L(0); PG8_BAR; PG8_MMA(0, 0, At, B0); PG8_MMA(0, 1, At, B1); PG8_BAR; PG8_SCHED;
            PG8_LDA(At, 0, 1); PG8_STAGE(PG8_SB(0, 0), b2, voffB); PG8_STAGE(PG8_SB(0, 1), b2, voffB1); PG8_STAGE(PG8_SA(0, 0), a2, voffA);
            PG8_WAIT_V(8); PG8_WAIT_L(0); PG8_BAR; PG8_MMA(1, 0, At, B0); PG8_MMA(1, 1, At, B1); PG8_BAR; PG8_SCHED;
            PG8_LDB(B0, 1, 0); PG8_LDB(B1, 1, 1); PG8_SCHED; PG8_LDA(At, 1, 0); PG8_STAGE(PG8_SA(0, 1), a2 + hstep, voffA);
            PG8_WAIT_V(8); PG8_WAIT_L(0); PG8_BAR; PG8_MMA(0, 0, At, B0); PG8_MMA(0, 1, At, B1); PG8_BAR; PG8_SCHED;
            PG8_LDA(At, 1, 1); PG8_STAGE(PG8_SB(1, 0), b3, voffB); PG8_STAGE(PG8_SB(1, 1), b3, voffB1); PG8_STAGE(PG8_SA(1, 0), a3, voffA);
            PG8_WAIT_V(8); PG8_WAIT_L(0); PG8_BAR; PG8_MMA(1, 0, At, B0); PG8_MMA(1, 1, At, B1); PG8_BAR; PG8_SCHED;
            } else {
            PG8_LDB(B0, 0, 0); PG8_SCHED; PG8_LDA(At, 0, 0); PG8_STAGE(PG8_SA(1, 1), a1 + hstep, voffA);
            PG8_WAIT_L(8); PG8_BAR; PG8_WAIT_L(0); PG8_MMA(0, 0, At, B0); PG8_BAR; PG8_SCHED;
            PG8_LDB(B1, 0, 1); PG8_STAGE(PG8_SB(0, 0), b2, voffB);
            PG8_BAR; PG8_WAIT_L(0); PG8_MMA(0, 1, At, B1); PG8_BAR;
            PG8_LDA(At, 0, 1); PG8_STAGE(PG8_SA(0, 0), a2, voffA);
            PG8_BAR; PG8_WAIT_L(0); PG8_MMA(1, 0, At, B0); PG8_BAR; PG8_SCHED;
            PG8_STAGE(PG8_SB(0, 1), b2, voffB1);
            PG8_WAIT_V(6); PG8_BAR; PG8_MMA(1, 1, At, B1); PG8_BAR;
            PG8_LDB(B0, 1, 0); PG8_SCHED; PG8_LDA(At, 1, 0); PG8_STAGE(PG8_SA(0, 1), a2 + hstep, voffA);
            PG8_WAIT_L(8); PG8_BAR; PG8_WAIT_L(0); PG8_MMA(0, 0, At, B0); PG8_BAR; PG8_SCHED;
            PG8_LDB(B1, 1, 1); PG8_STAGE(PG8_SB(1, 0), b3, voffB);
            PG8_BAR; PG8_WAIT_L(0); PG8_MMA(0, 1, At, B1); PG8_BAR;
            PG8_LDA(At, 1, 1); PG8_STAGE(PG8_SA(1, 0), a3, voffA);
            PG8_BAR; PG8_WAIT_L(0); PG8_MMA(1, 0, At, B0); PG8_BAR; PG8_SCHED;
            PG8_STAGE(PG8_SB(1, 1), b3, voffB1);
            PG8_WAIT_V(6); PG8_BAR; PG8_MMA(1, 1, At, B1); PG8_BAR;
            }
        }
        if constexpr (ALIGN_EPI) { if (wr == 0) PG8_BAR; }
        if constexpr (!Epi::AFTER_DRAIN) { E(acc, cur, wr, wc, fr, fq); S.done(cur); }
        if (!has_next) break;
#pragma unroll
        for (int a = 0; a < 2; ++a)
#pragma unroll
            for (int b = 0; b < 2; ++b)
#pragma unroll
                for (int m = 0; m < 4; ++m)
#pragma unroll
                    for (int n = 0; n < 2; ++n) acc[a][b][m][n] = (f32x4){0.f, 0.f, 0.f, 0.f};
        cur = nxt; cA = nA; cB = nB; ++ui;
        if constexpr (ALIGN_EPI) { if (wr == 1) PG8_BAR; }
    }
    PG8_WAIT_V(0);
    if constexpr (!ALIGN_EPI) { if (wr == 0) PG8_BAR; }
    PG8_BAR;
    if constexpr (Epi::AFTER_DRAIN) { E.fused(acc, cur, wr, wc, fr, fq, lds, wid, lane); S.done(cur); }
#undef PG8_SA
#undef PG8_SB
#undef PG8_STAGE
#undef PG8_LDA
#undef PG8_LDB
#undef PG8_MMA
#undef PG8_WAIT_V
#undef PG8_WAIT_L
#undef PG8_BAR
#undef PG8_SCHED
}
}

struct EpiProj {
  static constexpr bool PERM = true, AFTER_DRAIN = false, HEADPERM = true;
  const float* gqa; const float* gka; const float* gqb; const float* gkb; unsigned char* ws;
  __device__ __forceinline__ void operator()(const pg8::f32x4 (&acc)[2][2][4][2], const pg8::Unit& u, int wr, int wc, int fr, int fq) const {
    const int nbase = u.pn * 256 + wc * 64;
    const int region = nbase >> 9, hw = (nbase & 511) >> 6;
    const float* g = (region == 0) ? gqa : (region == 1) ? gka : (region == 3) ? gqb : gkb;
    const bool normed = (region != 2 && region != 5);
    const float qs = (region == 0 || region == 3) ? C2 : 1.0f;
    u16* dstR = (u16*)(ws + WS_R + (size_t)region * R_REGION);
    f32x4 gv[2][2];
#pragma unroll
    for (int bj = 0; bj < 2; ++bj)
#pragma unroll
      for (int n = 0; n < 2; ++n) gv[bj][n] = normed ? *(const f32x4*)(g + 32 * bj + 8 * fq + 4 * n) : (f32x4){1.f, 1.f, 1.f, 1.f};
#pragma unroll
    for (int ai = 0; ai < 2; ++ai)
#pragma unroll
      for (int m = 0; m < 4; ++m) {
        const int t = u.pm * 256 + ai * 128 + wr * 64 + m * 16 + fr;
        int seq_start, S, sq; seq_of(t, seq_start, S, sq);
        float scale = 1.0f;
        if (normed) {
          float ss = 0.f;
#pragma unroll
          for (int bj = 0; bj < 2; ++bj)
#pragma unroll
            for (int n = 0; n < 2; ++n) { const f32x4 v = acc[ai][bj][m][n]; ss += v[0] * v[0] + v[1] * v[1] + v[2] * v[2] + v[3] * v[3]; }
          ss += __shfl_xor(ss, 16); ss += __shfl_xor(ss, 32);
          scale = __builtin_amdgcn_rsqf(ss * (1.0f / 64.0f) + NORM_EPS) * qs;
        }
        u16* dst;
        if (region != 5) dst = dstR + (size_t)seq_start * 512 + ((size_t)hw * S + sq) * 64;
        else dst = dstR + (size_t)seq_start * 512 + ((size_t)(hw >> 1) * S + sq) * 128 + (hw & 1) * 64;
#pragma unroll
        for (int bj = 0; bj < 2; ++bj) {
          const f32x4 v0 = acc[ai][bj][m][0] * scale * gv[bj][0], v1 = acc[ai][bj][m][1] * scale * gv[bj][1];
          u32x4 o; o[0] = pk2(v0[0], v0[1]); o[1] = pk2(v0[2], v0[3]); o[2] = pk2(v1[0], v1[1]); o[3] = pk2(v1[2], v1[3]);
          *(u32x4*)(dst + 32 * bj + 8 * fq) = o;
        }
      }
  }
};

DI void phase_proj(const Params& p, unsigned char* lds) {
  pg8::Gemm g{(const u16*)((const unsigned char*)p.out + OUT_N1), (const u16*)(p.ws + WS_WIN), T_TOK, 3072, 1024};
  pg8::StaticOrder S; S.init(T_TOK, 3072, (int)gridDim.x, (int)blockIdx.x);
  EpiProj E{p.q_norm_a, p.k_norm_a, p.q_norm_b, p.k_norm_b, p.ws};
  pg8::gemm_phase<EpiProj, pg8::StaticOrder, true, true>((PG8_LAS unsigned char*)lds, g, S, E);
}

constexpr int AL_STAGE = 0;
constexpr int AL_VT    = 0;
constexpr int AL_TAB   = 131072;
constexpr int AL_TABA  = 137216;
constexpr int AL_XL    = 150016;
constexpr int AL_MISC  = 151552;

DI unsigned voff_b(int row, int ch) { return 256u * row + 16u * (ch ^ (((row & 3) << 2) | ((row >> 2) & 3))); }

template <int VAR>
DI void diff_unit(const Params& p, unsigned char* lds, int seq_start, int S, int hd, int q0, float lam) {
  const int tid = threadIdx.x, lane = tid & 63, r32 = lane & 31, h = lane >> 5;
  const int w = __builtin_amdgcn_readfirstlane(tid >> 6);
  const int map = w >> 2, wq = w & 3;
  const u16* QBp = (const u16*)(p.ws + WS_R + 3 * R_REGION);
  const u16* KBp = (const u16*)(p.ws + WS_R + 4 * R_REGION);
  const u16* VBp = (const u16*)(p.ws + WS_R + 5 * R_REGION);
  const int qpos = q0 + wq * 32 + r32;
  const int qlo = q0 + wq * 32;
  const u16* Qp = QBp + (size_t)seq_start * 512 + ((size_t)(hd * 2 + map) * S + qpos) * 64;
  bf16x8 qf[4];
#pragma unroll
  for (int ks = 0; ks < 4; ++ks) qf[ks] = *(const bf16x8*)(Qp + ks * 16 + h * 8);
  const u16* K1g = KBp + (size_t)seq_start * 512 + ((size_t)(hd * 2 + 0) * S) * 64;
  const u16* K2g = KBp + (size_t)seq_start * 512 + ((size_t)(hd * 2 + 1) * S) * 64;
  const u16* Vg = VBp + (size_t)seq_start * 512 + ((size_t)hd * S) * 128;
  const float* tab = (const float*)(lds + AL_TAB);
  const float* misc = (const float*)(lds + AL_MISC);
  const float cAfter = misc[12 + hd];
  f32x16 O[4];
#pragma unroll
  for (int nb = 0; nb < 4; ++nb)
#pragma unroll
    for (int r = 0; r < 16; ++r) O[nb][r] = 0.f;
  float l = 0.f;
  const int kr_ = 8 * w + (lane >> 3), kc_ = (lane & 7) ^ ((kr_ >> 1) & 7);
  const u16* k1src = K1g + (size_t)kr_ * 64 + kc_ * 8;
  const u16* k2src = K2g + (size_t)kr_ * 64 + kc_ * 8;
  const u16* vsrc[2];
#pragma unroll
  for (int i = 0; i < 2; ++i) { const int row = 8 * w + 4 * i + (lane >> 4); const int pc = (lane & 15) ^ (((row & 3) << 2) | ((row >> 2) & 3)); vsrc[i] = Vg + (size_t)row * 128 + pc * 8; }
  const int NKT = S / 64;
  const int i16 = lane & 15, tq = i16 >> 2, tp = i16 & 3, blk = (lane >> 4) & 1;
  int kbase4[4], vbase[4][2];
#pragma unroll
  for (int ks = 0; ks < 4; ++ks) kbase4[ks] = r32 * 128 + (((2 * ks + h) ^ ((r32 >> 1) & 7)) << 4);
#pragma unroll
  for (int nb = 0; nb < 4; ++nb)
#pragma unroll
    for (int hi = 0; hi < 2; ++hi) vbase[nb][hi] = (int)voff_b(4 * h + tq + 8 * hi, 4 * nb + 2 * blk + (tp >> 1)) + 8 * (tp & 1);
#define DU_GLDS(gsrc_, ldsoff_) do { unsigned keep_; const unsigned dst_ = (unsigned)__builtin_amdgcn_readfirstlane((int)(ldsoff_)); \
    asm volatile("s_mov_b32 %0, m0\n\ts_mov_b32 m0, %2\n\ts_nop 0\n\tglobal_load_lds_dwordx4 %1, off\n\ts_mov_b32 m0, %0" : "=&s"(keep_) : "v"(gsrc_), "s"(dst_) : "memory"); } while (0)
#define DU_DMA(kt_, st_) do { const size_t ko_ = (size_t)(kt_) * 64 * 64, vo_ = (size_t)(kt_) * 64 * 128; const unsigned b_ = lds_base + AL_STAGE + (st_) * 32768; \
    DU_GLDS(k1src + ko_, b_ + w * 1024); DU_GLDS(k2src + ko_, b_ + 8192 + w * 1024); \
    DU_GLDS(vsrc[0] + vo_, b_ + 16384 + w * 2048); DU_GLDS(vsrc[1] + vo_, b_ + 16384 + w * 2048 + 1024); } while (0)
  const unsigned lds_base = (unsigned)(uintptr_t)lds;
#define SBAR() __builtin_amdgcn_sched_barrier(0)
#define DU_VRD(slot, f, so_) do { vlo[slot] = tr_read(vp[(f) >> 1][0] + (so_) + ((f) & 1) * 4096); vhi[slot] = tr_read(vp[(f) >> 1][1] + (so_) + ((f) & 1) * 4096); } while (0)
#define DU_SUB(A, B, kq2, kso2_, has_next2_, vso_, knext_, has_next_) do { \
    SBAR(); \
    s16x4 vlo[4], vhi[4]; \
    if (VAR != 2 && VAR != 4) { DU_VRD(0, 0, vso_); DU_VRD(1, 1, vso_); DU_VRD(2, 2, vso_); DU_VRD(3, 3, vso_); } \
    if (has_next_ && VAR != 3 && VAR != 4) { \
      f32x16 z_; _Pragma("unroll") for (int r = 0; r < 16; ++r) z_[r] = 0.f; \
      B = MFMA32(kf[0], qf[0], z_); B = MFMA32(kf[1], qf[1], B); B = MFMA32(kf[2], qf[2], B); B = MFMA32(kf[3], qf[3], B); } \
    float ls = 0.f; \
    _Pragma("unroll") for (int r = 0; r < 16; ++r) ls += A[r]; \
    l += ls; \
    bf16x8 pb[2]; \
    _Pragma("unroll") for (int s2 = 0; s2 < 2; ++s2) { \
      u32x4 pw; pw[0] = pk2(A[8 * s2 + 0], A[8 * s2 + 1]); pw[1] = pk2(A[8 * s2 + 2], A[8 * s2 + 3]); \
      pw[2] = pk2(A[8 * s2 + 4], A[8 * s2 + 5]); pw[3] = pk2(A[8 * s2 + 6], A[8 * s2 + 7]); \
      pb[s2] = __builtin_bit_cast(bf16x8, pw); } \
    SBAR(); \
    if ((has_next2_) && VAR != 3 && VAR != 4) { _Pragma("unroll") for (int ks = 0; ks < 4; ++ks) kf[ks] = *(const bf16x8*)(kq2[ks] + (kso2_)); } \
    if (has_next_) { \
      const int dmin_ = (knext_) - (qlo + 31), dmax_ = (knext_) + 31 - qlo; \
      if (dmin_ < 559) { \
        if (in_after) { in_after = false; _Pragma("unroll") for (int nb = 0; nb < 4; ++nb) _Pragma("unroll") for (int r = 0; r < 16; ++r) O[nb][r] *= fAfter; l *= fAfter; \
                        _Pragma("unroll") for (int s2 = 0; s2 < 2; ++s2) {   \
                          u32x4 pw; pw[0] = pk2(A[8 * s2 + 0] * fAfter, A[8 * s2 + 1] * fAfter); pw[1] = pk2(A[8 * s2 + 2] * fAfter, A[8 * s2 + 3] * fAfter); \
                          pw[2] = pk2(A[8 * s2 + 4] * fAfter, A[8 * s2 + 5] * fAfter); pw[3] = pk2(A[8 * s2 + 6] * fAfter, A[8 * s2 + 7] * fAfter); \
                          pb[s2] = __builtin_bit_cast(bf16x8, pw); } } \
        if (dmax_ > -559) { const int base_ = (knext_) + 4 * h - qpos + 640; \
          _Pragma("unroll") for (int r = 0; r < 16; ++r) B[r] += tab[base_ + (r & 3) + 8 * (r >> 2)]; } } } \
    __builtin_amdgcn_s_setprio(1); \
    _Pragma("unroll") for (int f = 0; f < 8; ++f) { \
      if (VAR != 2 && VAR != 4) { O[f >> 1] = MFMA32(cat8(vlo[f & 3], vhi[f & 3]), pb[f & 1], O[f >> 1]); \
      if (f + 4 < 8) DU_VRD(f & 3, f + 4, vso_); } \
      if (VAR != 1 && VAR != 4) { B[2 * f] = __builtin_amdgcn_exp2f(B[2 * f]); B[2 * f + 1] = __builtin_amdgcn_exp2f(B[2 * f + 1]); } } \
    __builtin_amdgcn_s_setprio(0); \
  } while (0)
  f32x16 X, Y; bf16x8 kf[4];
  const float fAfter = __builtin_amdgcn_exp2f(cAfter);
  bool in_after = true;
  const int KT1 = NKT - 1;
  DU_DMA(KT1, 0);
  if (NKT > 1) DU_DMA(KT1 - 1, 1);
  asm volatile("s_waitcnt vmcnt(0)" ::: "memory");
  __syncthreads();
  {
    const unsigned char* kb_ = lds + AL_STAGE + map * 8192 + 4096;
    f32x16 z_;
#pragma unroll
    for (int r = 0; r < 16; ++r) z_[r] = 0.f;
    X = MFMA32(*(const bf16x8*)(kb_ + kbase4[0]), qf[0], z_); X = MFMA32(*(const bf16x8*)(kb_ + kbase4[1]), qf[1], X);
    X = MFMA32(*(const bf16x8*)(kb_ + kbase4[2]), qf[2], X); X = MFMA32(*(const bf16x8*)(kb_ + kbase4[3]), qf[3], X);
    const int knext = 64 * KT1 + 32;
    const int dmin_ = knext - (qlo + 31), dmax_ = knext + 31 - qlo;
    if (dmin_ < 559) {
      in_after = false;
      if (dmax_ > -559) { const int base_ = knext + 4 * h - qpos + 640;
#pragma unroll
        for (int r = 0; r < 16; ++r) X[r] += tab[base_ + (r & 3) + 8 * (r >> 2)]; }
    }
#pragma unroll
    for (int r = 0; r < 16; ++r) X[r] = __builtin_amdgcn_exp2f(X[r]);
#pragma unroll
    for (int ks = 0; ks < 4; ++ks) kf[ks] = *(const bf16x8*)(lds + AL_STAGE + map * 8192 + kbase4[ks]);
  }
  int st_cur = 0, st_nxt = 32768, st_free = 65536;
  for (int i = 0; i < NKT; ++i) {
    const int kt = KT1 - i;
    asm volatile("s_waitcnt vmcnt(0)" ::: "memory");
    __syncthreads();
    if (i + 2 < NKT) DU_DMA(kt - 2, st_free / 32768);
    const unsigned char* knx[4]; const unsigned char* vp[4][2];
#pragma unroll
    for (int ks = 0; ks < 4; ++ks) knx[ks] = lds + AL_STAGE + st_nxt + map * 8192 + kbase4[ks];
#pragma unroll
    for (int nb = 0; nb < 4; ++nb) { vp[nb][0] = lds + AL_STAGE + st_cur + 16384 + vbase[nb][0]; vp[nb][1] = lds + AL_STAGE + st_cur + 16384 + vbase[nb][1]; }
    DU_SUB(X, Y, knx, 4096, (i + 1 < NKT), 8192, 64 * kt, true);
    DU_SUB(Y, X, knx, 0, (i + 1 < NKT), 0, 64 * kt - 32, (i + 1 < NKT));
    { const int t_ = st_cur; st_cur = st_nxt; st_nxt = st_free; st_free = t_; }
  }
#undef DU_DMA
#undef DU_GLDS
#undef DU_VRD
#undef DU_SUB
#undef SBAR
  if (in_after) {
#pragma unroll
    for (int nb = 0; nb < 4; ++nb)
#pragma unroll
      for (int r = 0; r < 16; ++r) O[nb][r] *= fAfter;
    l *= fAfter;
  }
  if (VAR != 0) {
#pragma unroll
    for (int nb = 0; nb < 4; ++nb) asm volatile("" :: "v"(O[nb]));
    asm volatile("" :: "v"(l), "v"(X), "v"(Y));
    __syncthreads();
    return;
  }
  __syncthreads();
  float ltot = l + __shfl_xor(l, 32);
  float* xbuf = (float*)(lds + AL_STAGE);
  if (map == 1) {
    const float inv = 1.0f / ltot;
#pragma unroll
    for (int nb = 0; nb < 4; ++nb)
#pragma unroll
      for (int r = 0; r < 16; ++r) xbuf[((wq * 64 + nb * 16 + r) << 6) + lane] = O[nb][r] * inv;
  }
  __syncthreads();
  if (map == 0) {
    const float inv = 1.0f / ltot;
    float ss = 0.f;
#pragma unroll
    for (int nb = 0; nb < 4; ++nb)
#pragma unroll
      for (int r = 0; r < 16; ++r) {
        float o = O[nb][r] * inv - lam * xbuf[((wq * 64 + nb * 16 + r) << 6) + lane];
        O[nb][r] = o; ss += o * o;
      }
    ss += __shfl_xor(ss, 32);
    const float rn = __builtin_amdgcn_rsqf(ss * (1.0f / 128.0f) + NORM_EPS) * 0.8f;
    u16* mix = (u16*)((unsigned char*)p.out + OUT_MIX) + (size_t)(seq_start + qpos) * 1024 + 512 + hd * 128;
#pragma unroll
    for (int nb = 0; nb < 4; ++nb)
#pragma unroll
      for (int g4 = 0; g4 < 4; ++g4) {
        const int d0 = 32 * nb + 8 * g4 + 4 * h;
        f32x4 gg = *(const f32x4*)(p.diff_norm_g + d0);
        u32x2 o; o[0] = pk2(O[nb][4 * g4 + 0] * rn * gg[0], O[nb][4 * g4 + 1] * rn * gg[1]);
        o[1] = pk2(O[nb][4 * g4 + 2] * rn * gg[2], O[nb][4 * g4 + 3] * rn * gg[3]);
        *(u32x2*)(mix + d0) = o;
      }
  }
  __syncthreads();
}

constexpr int AL_DPART = 65536;
constexpr int AL_DL    = AL_TAB;
template <int PASS>
DI void dil_wave_item(const Params& p, unsigned char* lds, int seq_start, int S, int hd, int i0, int sel) {
  const int tid = threadIdx.x, lane = tid & 63, r32 = lane & 31, h = lane >> 5;
  const int w = __builtin_amdgcn_readfirstlane(tid >> 6);
  const u16* QAp = (const u16*)(p.ws + WS_R + 0 * R_REGION);
  const u16* KAp = (const u16*)(p.ws + WS_R + 1 * R_REGION);
  const u16* VAp = (const u16*)(p.ws + WS_R + 2 * R_REGION);
  constexpr int QSTR = (PASS == 1) ? 1 : 16;
  constexpr int NTILE = (PASS == 1) ? 5 : 13;
  const int qbase = (PASS == 1) ? i0 + 32 * sel : i0 + sel;
  const int qpos = qbase + QSTR * r32;
  const int tl = qpos - i0;
  const u16* Qp = QAp + (size_t)seq_start * 512 + ((size_t)hd * S + qpos) * 64;
  bf16x8 qf[4];
#pragma unroll
  for (int ks = 0; ks < 4; ++ks) qf[ks] = *(const bf16x8*)(Qp + ks * 16 + h * 8);
  const u16* Kg = KAp + (size_t)seq_start * 512 + ((size_t)hd * S) * 64;
  const u16* Vg = VAp + (size_t)seq_start * 512 + ((size_t)hd * S) * 64;
  unsigned char* vt = lds + AL_VT + w * 8192;
  unsigned char* ktl = vt + 4096;
  const float* tabA = (const float*)(lds + AL_TABA) + hd * 3 * 132;
  unsigned char* dpart = lds + AL_DPART;
  float* dl = (float*)(lds + AL_DL);
  const int psw = ((tl >> 4) ^ tl) & 15;
  f32x16 O[2];
  float l = 0.f;
  if (PASS == 1) {
#pragma unroll
    for (int nb = 0; nb < 2; ++nb)
#pragma unroll
      for (int r = 0; r < 16; ++r) O[nb][r] = 0.f;
  } else {
#pragma unroll
    for (int nb = 0; nb < 2; ++nb)
#pragma unroll
      for (int g4 = 0; g4 < 4; ++g4) {
        const int ch = 8 * nb + 2 * g4 + h;
        const u32x2 v = *(const u32x2*)(dpart + tl * 128 + ((ch ^ psw) << 3));
        O[nb][4 * g4 + 0] = __uint_as_float(v[0] << 16); O[nb][4 * g4 + 1] = __uint_as_float(v[0] & 0xffff0000u);
        O[nb][4 * g4 + 2] = __uint_as_float(v[1] << 16); O[nb][4 * g4 + 3] = __uint_as_float(v[1] & 0xffff0000u);
      }
    if (h == 0) l = dl[tl];
  }
  const int i16 = lane & 15, tq = i16 >> 2, tp = i16 & 3, blk = (lane >> 4) & 1;
  int vrb[2][2];
#pragma unroll
  for (int nb = 0; nb < 2; ++nb)
#pragma unroll
    for (int hi = 0; hi < 2; ++hi) {
      const int R = 4 * h + tq + 8 * hi; const int ch = 4 * nb + 2 * blk + (tp >> 1);
      const int sw = (((R >> 1) & 1) << 2) ^ ((R >> 2) & 3);
      vrb[nb][hi] = R * 128 + ((ch ^ sw) << 4) + 8 * (tp & 1);
    }
  bf16x8 kfb[1][4]; u32x4 vcb[1][4];
  const int lrow = lane >> 3, lch = lane & 7;
#define DL_PARAMS(tau_) \
    const int d_ = (PASS == 1) ? 1 : (((tau_) < 5) ? 16 : 4); const int br_ = (PASS == 1) ? 2 : (((tau_) < 5) ? 0 : 1); \
    const int tt_ = (PASS == 1) ? (tau_) : (((tau_) < 5) ? (tau_) : (tau_) - 5); const int ratio_ = QSTR / d_; \
    const int n0_ = -64 + 32 * tt_;
#define DL_LOAD(buf, tau_) do { DL_PARAMS(tau_) \
    _Pragma("unroll") for (int i4 = 0; i4 < 4; ++i4) { int kpos_ = qbase + d_ * (n0_ + 8 * i4 + lrow); kpos_ = kpos_ < 0 ? 0 : (kpos_ >= S ? S - 1 : kpos_); \
      kfb[buf][i4] = *(const bf16x8*)(Kg + (size_t)kpos_ * 64 + lch * 8); vcb[buf][i4] = *(const u32x4*)(Vg + (size_t)kpos_ * 64 + lch * 8); } (void)br_; (void)ratio_; } while (0)
#define DL_STORE(buf) do { \
    _Pragma("unroll") for (int i4 = 0; i4 < 4; ++i4) { const int row_ = 8 * i4 + lrow; const int sw_ = (((row_ >> 1) & 1) << 2) ^ ((row_ >> 2) & 3); \
      *(u32x4*)(vt + row_ * 128 + ((lch ^ sw_) << 4)) = vcb[buf][i4]; \
      *(bf16x8*)(ktl + row_ * 128 + ((lch ^ ((row_ >> 1) & 7)) << 4)) = kfb[buf][i4]; } } while (0)
#define DL_COMPUTE(buf, tau_) do { DL_PARAMS(tau_) \
    const int kfirst_ = qbase + d_ * n0_, klast_ = qbase + d_ * (n0_ + 31); \
    const int base_ = n0_ + 4 * h - ratio_ * r32; const float* tb_ = tabA + br_ * 132; \
    f32x16 sT; \
    _Pragma("unroll") for (int r = 0; r < 16; ++r) { int dd = base_ + (r & 3) + 8 * (r >> 2); dd = dd < -65 ? -65 : (dd > 65 ? 65 : dd); sT[r] = tb_[dd + 65]; } \
    if (kfirst_ < 0 || klast_ >= S) { _Pragma("unroll") for (int r = 0; r < 16; ++r) { const int kp = qbase + d_ * (n0_ + crow(r, h)); if (kp < 0 || kp >= S) sT[r] = NEG_BIG; } } \
    _Pragma("unroll") for (int ks = 0; ks < 4; ++ks) { const bf16x8 ka_ = *(const bf16x8*)(ktl + r32 * 128 + (((2 * ks + h) ^ ((r32 >> 1) & 7)) << 4)); sT = MFMA32(ka_, qf[ks], sT); } \
    float ls = 0.f; \
    _Pragma("unroll") for (int r = 0; r < 16; ++r) { sT[r] = __builtin_amdgcn_exp2f(sT[r]); ls += sT[r]; } \
    l += ls; \
    bf16x8 pb[2]; \
    _Pragma("unroll") for (int s2 = 0; s2 < 2; ++s2) { \
      u32x4 pw; pw[0] = pk2(sT[8 * s2 + 0], sT[8 * s2 + 1]); pw[1] = pk2(sT[8 * s2 + 2], sT[8 * s2 + 3]); \
      pw[2] = pk2(sT[8 * s2 + 4], sT[8 * s2 + 5]); pw[3] = pk2(sT[8 * s2 + 6], sT[8 * s2 + 7]); \
      pb[s2] = __builtin_bit_cast(bf16x8, pw); } \
    _Pragma("unroll") for (int nb = 0; nb < 2; ++nb) _Pragma("unroll") for (int s2 = 0; s2 < 2; ++s2) { \
        const s16x4 lo = tr_read(vt + vrb[nb][0] + s2 * 2048); const s16x4 hi = tr_read(vt + vrb[nb][1] + s2 * 2048); \
        O[nb] = MFMA32(cat8(lo, hi), pb[s2], O[nb]); } \
  } while (0)
  DL_LOAD(0, 0);
#pragma unroll 1
  for (int tau = 0; tau < NTILE; ++tau) {
    DL_STORE(0);
    { const int tn = (tau + 1 < NTILE) ? tau + 1 : tau; DL_LOAD(0, tn); }
    DL_COMPUTE(0, tau);
  }
#undef DL_PARAMS
#undef DL_LOAD
#undef DL_STORE
#undef DL_COMPUTE
  const float ltot = l + __shfl_xor(l, 32);
  if (PASS == 1) {
#pragma unroll
    for (int nb = 0; nb < 2; ++nb)
#pragma unroll
      for (int g4 = 0; g4 < 4; ++g4) {
        const int ch = 8 * nb + 2 * g4 + h;
        u32x2 o; o[0] = pk2(O[nb][4 * g4 + 0], O[nb][4 * g4 + 1]); o[1] = pk2(O[nb][4 * g4 + 2], O[nb][4 * g4 + 3]);
        *(u32x2*)(dpart + tl * 128 + ((ch ^ psw) << 3)) = o;
      }
    if (h == 0) dl[tl] = ltot;
  } else {
    const float inv = 1.0f / ltot;
    u16* mix = (u16*)((unsigned char*)p.out + OUT_MIX) + (size_t)(seq_start + qpos) * 1024 + hd * 64;
#pragma unroll
    for (int nb = 0; nb < 2; ++nb)
#pragma unroll
      for (int g4 = 0; g4 < 4; ++g4) {
        const int d0 = 32 * nb + 8 * g4 + 4 * h;
        u32x2 o; o[0] = pk2(O[nb][4 * g4 + 0] * inv, O[nb][4 * g4 + 1] * inv); o[1] = pk2(O[nb][4 * g4 + 2] * inv, O[nb][4 * g4 + 3] * inv);
        *(u32x2*)(mix + d0) = o;
      }
  }
}

DI void phase_attn(const Params& p, unsigned char* lds) {
  const int tid = threadIdx.x;
  float* misc = (float*)(lds + AL_MISC);
  if (tid == 0) {
    float gqa = 0.f, gka = 0.f, gqb = 0.f, gkb = 0.f, bm = 0.f;
    for (int i = 0; i < 64; ++i) { gqa = fmaxf(gqa, fabsf(p.q_norm_a[i])); gka = fmaxf(gka, fabsf(p.k_norm_a[i])); gqb = fmaxf(gqb, fabsf(p.q_norm_b[i])); gkb = fmaxf(gkb, fabsf(p.k_norm_b[i])); }
    for (int i = 0; i < 32 * 12; ++i) bm = fmaxf(bm, fabsf(p.rel_bias[i]));
    const float M2 = 8.0f * LOG2E * fmaxf(gqa * gka, gqb * gkb) * 1.02f + bm * LOG2E + 0.1f;
    float s1 = 0.f, s2 = 0.f;
    for (int i = 0; i < 64; ++i) { s1 += p.lq1[i] * p.lk1[i]; s2 += p.lq2[i] * p.lk2[i]; }
    misc[0] = M2; misc[1] = expf(s1) - expf(s2) + 0.2f;
    for (int hd = 0; hd < 4; ++hd) { misc[8 + hd] = p.rel_bias[15 * 12 + 8 + hd] * LOG2E; misc[12 + hd] = (p.rel_bias[31 * 12 + 8 + hd] - p.rel_bias[15 * 12 + 8 + hd]) * LOG2E; }
  }
  __syncthreads();
  const float M2 = misc[0], lam = misc[1];
  {
    float* tabA = (float*)(lds + AL_TABA);
    for (int i = tid; i < 8 * 3 * 132; i += NTHR) {
      int hd = i / 396, rem = i % 396, br = rem / 132, idx = rem % 132;
      int dl = idx - 65; float v = NEG_BIG;
      if (dl >= -64 && dl <= 64 && idx < 131) { int d = (br == 0) ? 16 : (br == 1) ? 4 : 1; v = p.rel_bias[rel_bucket(dl * d) * 12 + hd] * LOG2E - M2; }
      tabA[i] = v;
    }
  }
#ifndef REP_DIFF
#define REP_DIFF 1
#endif
#ifndef REP_DIL
#define REP_DIL 1
#endif
  int cur_hd = -1;
  for (int rep_ = 0; rep_ < REP_DIFF; ++rep_)
  for (int vb = blockIdx.x; vb < 256; vb += gridDim.x) {
    const int xl = vb & 7, rk = vb >> 3;
#pragma unroll 1
    for (int rnd = 0; rnd < 8; ++rnd) {
      int seq_start, S, hd, q0;
      if (rnd < 4) { const int pair = xl + 8 * rnd; hd = pair & 3; S = 4096; seq_start = (pair >> 2) * 4096; q0 = rk * 128; }
      else { const int pair = 8 * xl + 2 * (rnd - 4) + (rk >> 4); hd = pair & 3; S = 2048; seq_start = T_PROMPT + (pair >> 2) * 2048; q0 = (rk & 15) * 128; }
      if (hd != cur_hd) {
        __syncthreads();
        float* tab = (float*)(lds + AL_TAB);
        for (int i = tid; i < 1281; i += NTHR) tab[i] = p.rel_bias[rel_bucket(i - 640) * 12 + 8 + hd] * LOG2E - misc[8 + hd];
        cur_hd = hd;
        __syncthreads();
      }
#ifndef PROBE_VAR
#define PROBE_VAR 0
#endif
      if (rep_ == 0) diff_unit<0>(p, lds, seq_start, S, hd, q0, lam); else diff_unit<PROBE_VAR>(p, lds, seq_start, S, hd, q0, lam);
    }
  }
  __syncthreads();
  const int w = tid >> 6;
  for (int rep_ = 0; rep_ < REP_DIL; ++rep_)
  for (int vb = blockIdx.x; vb < 256; vb += gridDim.x)
#pragma unroll 1
  for (int rnd = 0; rnd < 4; ++rnd) {
    const int xl = vb & 7, rk = vb >> 3;
    int seq_start, S, hd, i0;
    if (rnd < 2) { const int pair = xl * 8 + rnd * 4 + (rk >> 3); hd = pair & 7; S = 4096; seq_start = (pair >> 3) * 4096; i0 = (rk & 7) * 512; }
    else { const int pair = xl * 16 + (rnd - 2) * 8 + (rk >> 2); hd = pair & 7; S = 2048; seq_start = T_PROMPT + (pair >> 3) * 2048; i0 = (rk & 3) * 512; }
    __syncthreads();
#pragma unroll 1
    for (int u2 = 0; u2 < 2; ++u2) dil_wave_item<1>(p, lds, seq_start, S, hd, i0, w + 8 * u2);
    __syncthreads();
#pragma unroll 1
    for (int u2 = 0; u2 < 2; ++u2) dil_wave_item<2>(p, lds, seq_start, S, hd, i0, w + 8 * u2);
  }
}

struct EpiOut {
  static constexpr bool PERM = false, AFTER_DRAIN = false, HEADPERM = false;
  const float* xp; const float* xs; float* x1;
  __device__ __forceinline__ void operator()(const pg8::f32x4 (&acc)[2][2][4][2], const pg8::Unit& u, int wr, int wc, int fr, int fq) const {
    const int col0 = u.pn * 256 + wc * 32 + 4 * fq;
#pragma unroll
    for (int ai = 0; ai < 2; ++ai)
#pragma unroll
      for (int m = 0; m < 4; ++m) {
        const int t = u.pm * 256 + ai * 128 + wr * 64 + m * 16 + fr;
        const float* xr = ((t < T_PROMPT) ? xp + (size_t)t * DM : xs + (size_t)(t - T_PROMPT) * DM) + col0;
        float* orow = x1 + (size_t)t * DM + col0;
#pragma unroll
        for (int bj = 0; bj < 2; ++bj)
#pragma unroll
          for (int n = 0; n < 2; ++n) {
            const f32x4 xv = *(const f32x4*)(xr + bj * 128 + n * 16);
            *(f32x4*)(orow + bj * 128 + n * 16) = xv + acc[ai][bj][m][n];
          }
      }
  }
};

DI void phase_outproj(const Params& p, unsigned char* lds) {
  pg8::Gemm g{(const u16*)((const unsigned char*)p.out + OUT_MIX), (const u16*)(p.ws + WS_WOUT), T_TOK, 1024, 1024};
  pg8::StaticOrder S; S.init(T_TOK, 1024, (int)gridDim.x, (int)blockIdx.x);
  EpiOut E{p.x_prompt, p.x_sample, (float*)(p.ws + WS_X1)};
  pg8::gemm_phase<EpiOut, pg8::StaticOrder, true, true>((PG8_LAS unsigned char*)lds, g, S, E);
}

DI void phase_norm2(const Params& p) {
  const int tid = threadIdx.x, lane = tid & 63, w = tid >> 6;
  const float* x1 = (const float*)(p.ws + WS_X1);
  u16* hb = (u16*)(p.ws + WS_H);
  for (int it = blockIdx.x; it < T_TOK / 8; it += gridDim.x) {
    int t = it * 8 + w;
    norm_row(x1 + (size_t)t * DM, p.ffn_norm_g, hb + (size_t)t * DM, lane);
  }
}

struct EpiQp {
  static constexpr bool PERM = true, AFTER_DRAIN = false, HEADPERM = false;
  u16* O;
  __device__ __forceinline__ void operator()(const pg8::f32x4 (&acc)[2][2][4][2], const pg8::Unit& u, int wr, int wc, int fr, int fq) const {
    const int col0 = u.pn * 256 + wc * 32 + 8 * fq;
#pragma unroll
    for (int ai = 0; ai < 2; ++ai)
#pragma unroll
      for (int m = 0; m < 4; ++m) {
        const int t = u.pm * 256 + ai * 128 + wr * 64 + m * 16 + fr;
        u16* rowp = O + (size_t)t * 2048 + col0;
#pragma unroll
        for (int bj = 0; bj < 2; ++bj) {
          const f32x4 v0 = acc[ai][bj][m][0], v1 = acc[ai][bj][m][1];
          u32x4 o; o[0] = pk2(v0[0], v0[1]); o[1] = pk2(v0[2], v0[3]); o[2] = pk2(v1[0], v1[1]); o[3] = pk2(v1[2], v1[3]);
          *(u32x4*)(rowp + bj * 128) = o;
        }
      }
  }
};

DI void phase_peer_query(const Params& p, unsigned char* lds) {
  pg8::Gemm g{(const u16*)(p.ws + WS_H), (const u16*)(p.ws + WS_WQ), T_TOK, 2048, 1024};
  pg8::StaticOrder S; S.init(T_TOK, 2048, (int)gridDim.x, (int)blockIdx.x);
  EpiQp E{(u16*)p.out};
  pg8::gemm_phase<EpiQp, pg8::StaticOrder, true, true>((PG8_LAS unsigned char*)lds, g, S, E);
}

DI int f2sort(float f) { const int b = __float_as_int(f); return b ^ ((b >> 31) & 0x7fffffff); }
DI float sort2f(int s) { return __int_as_float(s ^ ((s >> 31) & 0x7fffffff)); }
#define CE_DESC(a, b) do { const int mx_ = max((a), (b)), mn_ = min((a), (b)); (a) = mx_; (b) = mn_; } while (0)
#define CE_ASC(a, b) do { const int mx_ = max((a), (b)), mn_ = min((a), (b)); (a) = mn_; (b) = mx_; } while (0)
template <int OFF> DI void sort16_desc(int (&x)[64]) {
#pragma unroll
  for (int k = 2; k <= 16; k <<= 1)
#pragma unroll
    for (int j = k >> 1; j > 0; j >>= 1)
#pragma unroll
      for (int i = 0; i < 16; ++i) {
        const int l = i ^ j;
        if (l > i) { if ((i & k) == 0) CE_DESC(x[OFF + i], x[OFF + l]); else CE_ASC(x[OFF + i], x[OFF + l]); }
      }
}
template <int A, int B> DI void merge16x(int (&x)[64]) {
#pragma unroll
  for (int i = 0; i < 16; ++i) x[A + i] = max(x[A + i], x[B + 15 - i]);
#pragma unroll
  for (int j = 8; j > 0; j >>= 1)
#pragma unroll
    for (int i = 0; i < 16; ++i) { const int l = i ^ j; if (l > i) CE_DESC(x[A + i], x[A + l]); }
}

DI void phase_peer_route(const Params& p, unsigned char* lds) {
  const u16* QP = (const u16*)p.out;
  const u16* SK = (const u16*)(p.ws + WS_SK);
  u16* eidx = (u16*)(p.ws + WS_EIDX);
  float* gg = (float*)(p.ws + WS_G);
  const int tid = threadIdx.x, lane = tid & 63, r32 = lane & 31, h = lane >> 5;
  const int w = __builtin_amdgcn_readfirstlane(tid >> 6);
  unsigned char* SKl = lds;
  float* v2l = (float*)(lds + 65536);
  __syncthreads();
#pragma unroll
  for (int i = 0; i < 8; ++i) {
    const int c = tid + 512 * i; const int zz = c >> 11, row = (c >> 4) & 127, ch = c & 15;
    const u32x4 v = *(const u32x4*)(SK + (size_t)zz * 16384 + row * 128 + ch * 8);
    *(u32x4*)(SKl + zz * 32768 + row * 256 + ((ch ^ (row & 15)) << 4)) = v;
  }
  __syncthreads();
  for (int item = blockIdx.x; item < T_TOK / 256; item += gridDim.x) {
    const int t = item * 256 + w * 32 + r32;
    const u16* qrow = QP + (size_t)t * 2048;
    bf16x8 qf[8];
#pragma unroll
    for (int ks = 0; ks < 8; ++ks) qf[ks] = *(const bf16x8*)(qrow + ks * 16 + h * 8);
#pragma unroll 1
    for (int pp = 0; pp < 8; ++pp) {
      int lists[2][16];
#pragma unroll
      for (int z = 0; z < 2; ++z) {
        const int c16 = pp * 2 + z;
        int x[64];
        {
          f32x16 S2[4];
#pragma unroll
          for (int kb = 0; kb < 4; ++kb)
#pragma unroll
            for (int r = 0; r < 16; ++r) S2[kb][r] = 0.f;
#pragma unroll
          for (int ks = 0; ks < 8; ++ks)
#pragma unroll
            for (int kb = 0; kb < 4; ++kb) {
              const int key = kb * 32 + r32;
              const bf16x8 a = *(const bf16x8*)(SKl + z * 32768 + key * 256 + (((2 * ks + h) ^ (key & 15)) << 4));
              S2[kb] = MFMA32(a, qf[ks], S2[kb]);
            }
          {
            const int cn = (c16 + 1 < 16) ? c16 + 1 : 15;
#pragma unroll
            for (int ks = 0; ks < 8; ++ks) qf[ks] = *(const bf16x8*)(qrow + cn * 128 + ks * 16 + h * 8);
          }
#pragma unroll
          for (int e = 0; e < 64; ++e) {
            const int kidx = 32 * (e >> 4) + (e & 3) + 8 * ((e & 15) >> 2) + 4 * h;
            x[e] = (f2sort(S2[e >> 4][e & 15]) & ~127) | kidx;
          }
        }
        sort16_desc<0>(x); sort16_desc<16>(x); sort16_desc<32>(x); sort16_desc<48>(x);
        merge16x<0, 16>(x); merge16x<32, 48>(x); merge16x<0, 32>(x);
#pragma unroll
        for (int i = 0; i < 16; ++i) x[16 + i] = __shfl_xor(x[i], 32);
        merge16x<0, 16>(x);
#pragma unroll
        for (int i = 0; i < 16; ++i) lists[z][i] = x[i];
      }
      float v1h[8];
#pragma unroll
      for (int i = 0; i < 8; ++i) { const int a0_ = lists[0][i], a1_ = lists[0][8 + i]; v1h[i] = sort2f(a0_ ^ ((a0_ ^ a1_) & -h)); }
#pragma unroll
      for (int i = 0; i < 16; ++i) v2l[i * 512 + tid] = sort2f(lists[1][i]);
      unsigned ptrs = 0u;
      float bestv[16]; int be[16];
#pragma unroll
      for (int rd = 0; rd < 16; ++rd) {
        float best = -3.0e38f, bv1 = 0.f, bv2 = 0.f; int ab = 0;
#pragma unroll
        for (int a = 0; a < 8; ++a) {
          const int b = (int)((ptrs >> (4 * a)) & 15u);
          const float v2 = v2l[b * 512 + tid];
          const float cnd = v1h[a] + v2;
          if (cnd > best) { best = cnd; ab = a; bv1 = v1h[a]; bv2 = v2; }
        }
        const float obest = __shfl_xor(best, 32), obv1 = __shfl_xor(bv1, 32), obv2 = __shfl_xor(bv2, 32);
        const bool mine = h ? (best > obest) : (best >= obest);
        const float wbest = mine ? best : obest, w1 = mine ? bv1 : obv1, w2 = mine ? bv2 : obv2;
        bestv[rd] = wbest; be[rd] = (f2sort(w1) & 127) * 128 + (f2sort(w2) & 127);
        if (mine) ptrs += 1u << (4 * ab);
      }
      if (h == 0) {
        float ex[16]; float sum = 0.f;
#pragma unroll
        for (int rd = 0; rd < 16; ++rd) { ex[rd] = __expf(bestv[rd] - bestv[0]); sum += ex[rd]; }
        const float inv = 1.0f / sum;
        const size_t oo = ((size_t)t * 8 + pp) * 16;
#pragma unroll
        for (int q4 = 0; q4 < 4; ++q4) { f32x4 v = {ex[4 * q4] * inv, ex[4 * q4 + 1] * inv, ex[4 * q4 + 2] * inv, ex[4 * q4 + 3] * inv}; *(f32x4*)(gg + oo + 4 * q4) = v; }
        u32x4 e0, e1;
#pragma unroll
        for (int j = 0; j < 4; ++j) { e0[j] = (unsigned)be[2 * j] | ((unsigned)be[2 * j + 1] << 16); e1[j] = (unsigned)be[8 + 2 * j] | ((unsigned)be[8 + 2 * j + 1] << 16); }
        *(u32x4*)(eidx + oo) = e0; *(u32x4*)(eidx + oo + 8) = e1;
      }
    }
  }
}

typedef float f2_t __attribute__((ext_vector_type(2)));
DI unsigned xcc_id() { return (unsigned)__builtin_amdgcn_s_getreg((3 << 11) | 20) & 7u; }
constexpr int PG_CHUNK_TOK = 64;
constexpr int PG_NCHUNK = T_TOK / PG_CHUNK_TOK;

DI void dec16(const u32x4& r, f2_t (&v)[8]) {
#pragma unroll
  for (int d = 0; d < 4; ++d) { v[2 * d] = __builtin_amdgcn_cvt_pk_f32_fp8((int)r[d], false); v[2 * d + 1] = __builtin_amdgcn_cvt_pk_f32_fp8((int)r[d], true); }
}

template <int CTRL> DI float dpp_f(float x) { return __int_as_float(__builtin_amdgcn_update_dpp(0, __float_as_int(x), CTRL, 0xf, 0xf, true)); }
DI int idx16(const u32x4& a, const u32x4& b, int i) { const unsigned wd = (i < 8) ? a[(i & 7) >> 1] : b[(i & 7) >> 1]; return (i & 1) ? (int)(wd >> 16) : (int)(wd & 0xffffu); }
template <int WHICH>
DI void peer_wave_tokens(const Params& p, int x, int tb, int lane) {
  const unsigned char* TBL = p.ws + (WHICH ? WS_V : WS_U) + (size_t)x * 16384 * 128;
  const u16* Hb = (const u16*)(p.ws + WS_H);
  const u16* eidx = (const u16*)(p.ws + WS_EIDX);
  const float* wg = (const float*)(p.ws + WS_G);
  const float* x1 = (const float*)(p.ws + WS_X1);
  float* zpart = (float*)p.out;
  const int r = lane >> 3, c = lane & 7;
  u32x4 ei[2][2]; f32x4 wv[2][4]; u32x4 rows[2][16];
#define PEER_LOAD_IDX(buf, k) do { const size_t o_ = (size_t)(tb + (k)) * 128 + r * 16; \
    ei[buf][0] = *(const u32x4*)(eidx + o_); ei[buf][1] = *(const u32x4*)(eidx + o_ + 8); \
    if (WHICH) { _Pragma("unroll") for (int q = 0; q < 4; ++q) wv[buf][q] = *(const f32x4*)(wg + o_ + 4 * q); } } while (0)
#define PEER_LOAD_ROWS4(buf, ibuf, g) do { _Pragma("unroll") for (int ii_ = 0; ii_ < 4; ++ii_) { \
      const unsigned off_ = (unsigned)idx16(ei[ibuf][0], ei[ibuf][1], 4 * (g) + ii_) * 128u + (unsigned)c * 16u; \
      rows[buf][4 * (g) + ii_] = *(const u32x4*)(TBL + off_); } } while (0)
#define PEER_LOAD_ROWS(buf, ibuf) do { PEER_LOAD_ROWS4(buf, ibuf, 0); PEER_LOAD_ROWS4(buf, ibuf, 1); PEER_LOAD_ROWS4(buf, ibuf, 2); PEER_LOAD_ROWS4(buf, ibuf, 3); } while (0)
#define PEER_NEXT4(g) do { __builtin_amdgcn_sched_barrier(0); if (k + 1 < 8) PEER_LOAD_ROWS4((k + 1) & 1, (k + 1) & 1, g); __builtin_amdgcn_sched_barrier(0); } while (0)
  PEER_LOAD_IDX(0, 0); PEER_LOAD_IDX(1, 1);
  PEER_LOAD_ROWS(0, 0);
#pragma unroll
  for (int k = 0; k < 8; ++k) {
    const int t = tb + k;
    f32x4 wcur[4];
    if (WHICH) {
#pragma unroll
      for (int q = 0; q < 4; ++q) wcur[q] = wv[k & 1][q];
    }
    if (k + 2 < 8) PEER_LOAD_IDX(k & 1, k + 2);
    if (WHICH == 0) {
      u32x4 ha = *(const u32x4*)(Hb + (size_t)t * DM + x * 128 + c * 16), hb = *(const u32x4*)(Hb + (size_t)t * DM + x * 128 + c * 16 + 8);
      f2_t hq[8];
#pragma unroll
      for (int j = 0; j < 4; ++j) {
        hq[j][0] = __uint_as_float(ha[j] << 16); hq[j][1] = __uint_as_float(ha[j] & 0xffff0000u);
        hq[4 + j][0] = __uint_as_float(hb[j] << 16); hq[4 + j][1] = __uint_as_float(hb[j] & 0xffff0000u);
      }
      float sv[16];
#pragma unroll
      for (int i = 0; i < 16; ++i) {
        if ((i & 3) == 0) PEER_NEXT4(i >> 2);
        f2_t v[8]; dec16(rows[k & 1][i], v);
        f2_t a = v[0] * hq[0];
#pragma unroll
        for (int q = 1; q < 8; ++q) a = __builtin_elementwise_fma(v[q], hq[q], a);
        float sx = a[0] + a[1];
        sx += dpp_f<0xB1>(sx);
        sx += dpp_f<0x4E>(sx);
        sx += dpp_f<0x141>(sx);
        sv[i] = sx;
      }
      float o0 = 0.f, o1 = 0.f;
#pragma unroll
      for (int i = 0; i < 8; ++i) { if (c == i) { o0 = sv[i]; o1 = sv[i + 8]; } }
      float* zp = zpart + ((size_t)x * T_TOK + t) * 128 + r * 16;
      zp[c] = o0; zp[c + 8] = o1;
    } else {
      f2_t acc[8];
#pragma unroll
      for (int q = 0; q < 8; ++q) { acc[q][0] = 0.f; acc[q][1] = 0.f; }
#pragma unroll
      for (int i = 0; i < 16; ++i) {
        if ((i & 3) == 0) PEER_NEXT4(i >> 2);
        f2_t v[8]; dec16(rows[k & 1][i], v);
        const float wj = wcur[i >> 2][i & 3];
        f2_t ww = {wj, wj};
#pragma unroll
        for (int q = 0; q < 8; ++q) acc[q] = __builtin_elementwise_fma(v[q], ww, acc[q]);
      }
      f2_t b4[4];
      {
        const bool up = (lane & 32) != 0;
#pragma unroll
        for (int q = 0; q < 4; ++q) {
          f2_t keep = up ? acc[4 + q] : acc[q], send = up ? acc[q] : acc[4 + q];
          f2_t got; got[0] = __shfl_xor(send[0], 32); got[1] = __shfl_xor(send[1], 32);
          b4[q] = keep + got;
        }
      }
      f2_t b2[2];
      {
        const bool up = (lane & 16) != 0;
#pragma unroll
        for (int q = 0; q < 2; ++q) {
          f2_t keep = up ? b4[2 + q] : b4[q], send = up ? b4[q] : b4[2 + q];
          f2_t got; got[0] = __shfl_xor(send[0], 16); got[1] = __shfl_xor(send[1], 16);
          b2[q] = keep + got;
        }
      }
      f2_t b1;
      {
        const bool up = (lane & 8) != 0;
        f2_t keep = up ? b2[1] : b2[0], send = up ? b2[0] : b2[1];
        f2_t got; got[0] = dpp_f<0x128>(send[0]); got[1] = dpp_f<0x128>(send[1]);
        b1 = keep + got;
      }
      const size_t o = (size_t)t * DM + x * 128 + c * 16 + 2 * r;
      f2_t xv = *(const f2_t*)(x1 + o);
      f2_t res = xv + b1;
      *(f2_t*)(p.out + o) = res;
    }
  }
#undef PEER_LOAD_IDX
#undef PEER_LOAD_ROWS
#undef PEER_LOAD_ROWS4
#undef PEER_NEXT4
}

template <int WHICH>
DI void phase_peer_sliced(const Params& p, unsigned char* lds) {
  const int tid = threadIdx.x, lane = tid & 63, w = tid >> 6;
  const unsigned* rankctr = (const unsigned*)(p.ws + WS_MISC + MISC_QCTR) + 16;
  volatile PG8_LAS unsigned* st = (volatile PG8_LAS unsigned*)(lds + LDS_BARST);
  int myx = (int)st[9], myr = (int)st[8];
  int n[8]; int tot = 0;
#pragma unroll
  for (int j = 0; j < 8; ++j) { n[j] = (int)__hip_atomic_load(rankctr + j, __ATOMIC_RELAXED, __HIP_MEMORY_SCOPE_AGENT); tot += n[j]; }
  if (tot != (int)gridDim.x || st[10] != 1u) {
    myx = blockIdx.x & 7; myr = blockIdx.x >> 3;
#pragma unroll
    for (int j = 0; j < 8; ++j) n[j] = ((int)gridDim.x + 7 - j) >> 3;
  }
#pragma unroll 1
  for (int s = 0; s < 8; ++s) {
    int owner = s;
#pragma unroll
    for (int d = 0; d < 8; ++d) { if (n[owner & 7] == 0) owner = (owner + 1) & 7; }
    owner &= 7;
    if (owner != myx) continue;
    int nblk = 0;
#pragma unroll
    for (int j = 0; j < 8; ++j) nblk = (j == myx) ? n[j] : nblk;
    const int nw = nblk * 8, wr = myr * 8 + w;
    const int u0 = (int)(((long long)wr * 8192) / nw), u1 = (int)(((long long)(wr + 1) * 8192) / nw);
#pragma unroll 1
    for (int u = u0; u < u1; ++u) peer_wave_tokens<WHICH>(p, s, u * 8, lane);
  }
}

DI void phase_peer_act(const Params& p) {
  const float* zpart = (const float*)p.out;
  const u16* eidx = (const u16*)(p.ws + WS_EIDX);
  float* wg = (float*)(p.ws + WS_G);
  const float* suinv = (const float*)(p.ws + WS_MISC + MISC_SUINV);
  const float* svinv = (const float*)(p.ws + WS_MISC + MISC_SVINV);
  for (size_t i = (size_t)blockIdx.x * NTHR + threadIdx.x; i < (size_t)T_TOK * 128; i += (size_t)gridDim.x * NTHR) {
    float z = 0.f;
#pragma unroll
    for (int x = 0; x < 8; ++x) z += zpart[(size_t)x * T_TOK * 128 + i];
    const int e = eidx[i];
    z *= suinv[e];
    const float act = 0.5f * z * (1.0f + erff(z * 0.70710678118654752f));
    wg[i] = wg[i] * act * svinv[e];
  }
}

#define XB_TMO      128
#define XB_XCNT(j)  (256  + 64 * (j))
#define XB_XSUB(j)  (1280 + 64 * (j))
#define XB_XGEN(j)  (2304 + 64 * (j))
#define XB_TOP      3328
#define XB_TOPGEN   3392
#define XCD_BAR_WORDS 3456
#define XB_SPIN_CAP (1u << 18)
#define LAS __attribute__((address_space(3)))

__device__ __forceinline__ unsigned xb_ld(unsigned* p)              { return __hip_atomic_load(p, __ATOMIC_RELAXED, __HIP_MEMORY_SCOPE_AGENT); }
__device__ __forceinline__ unsigned xb_add(unsigned* p, unsigned v) { return __hip_atomic_fetch_add(p, v, __ATOMIC_RELAXED, __HIP_MEMORY_SCOPE_AGENT); }
__device__ __forceinline__ unsigned xb_xcc_id() { return (unsigned)__builtin_amdgcn_s_getreg((3 << 11) | 20) & 0xFu; }
#define XB_SPIN(cond, bar) do { unsigned _sp = 0; while (cond) { __builtin_amdgcn_s_sleep(1); \
    if ((++_sp & 255u) == 0u) { if (xb_ld(&(bar)[XB_TMO])) break; if (_sp > XB_SPIN_CAP) { atomicAdd(&(bar)[XB_TMO], 1u); break; } } } } while (0)

struct XcdBarrier {
    unsigned* bar; unsigned x;
    volatile LAS unsigned* st;
};

__device__ __forceinline__ XcdBarrier xcd_barrier_post(unsigned* bar, volatile LAS unsigned* st) {
    XcdBarrier b; b.bar = bar; b.x = xb_xcc_id(); b.st = st;
    if (threadIdx.x == 0) (void)xb_add(&bar[XB_XCNT(b.x)], 1u);
    return b;
}
__device__ __forceinline__ void xcd_barrier_complete(unsigned* bar, unsigned x, unsigned& nloc, unsigned& nx) {
    const unsigned G = gridDim.x * gridDim.y * gridDim.z;
    unsigned sum, cnt, mine, sp = 0u;
    for (;;) {
        sum = 0u; cnt = 0u; mine = 0u;
#pragma unroll
        for (unsigned j = 0; j < 16; ++j) { const unsigned c = xb_ld(&bar[XB_XCNT(j)]); sum += c; cnt += (c > 0u) ? 1u : 0u; mine = (j == x) ? c : mine; }
        if (sum == G) break;
        __builtin_amdgcn_s_sleep(1);
        if ((++sp & 255u) == 0u) { if (xb_ld(&bar[XB_TMO])) break; if (sp > XB_SPIN_CAP) { atomicAdd(&bar[XB_TMO], 1u); break; } }
    }
    nloc = mine > 0u ? mine : 1u; nx = cnt > 0u ? cnt : 1u;
}

__device__ __forceinline__ void xcd_barrier(const XcdBarrier& b) {
    asm volatile("s_waitcnt vmcnt(0)" ::: "memory");
    __syncthreads();
    if (threadIdx.x == 0) {
        unsigned* bar = b.bar;
        __builtin_amdgcn_s_waitcnt(0);
        unsigned nloc = b.st[0], nx = b.st[1];
        if (nloc == 0u) { xcd_barrier_complete(bar, b.x, nloc, nx); b.st[0] = nloc; b.st[1] = nx; }
        const unsigned old = xb_add(&bar[XB_XSUB(b.x)], 1u);
        const unsigned gen = old / nloc;
        if (old + 1u == (gen + 1u) * nloc) {
            __builtin_amdgcn_fence(__ATOMIC_RELEASE, "agent");
            asm volatile("s_waitcnt vmcnt(0)" ::: "memory");
            const unsigned og = xb_add(&bar[XB_TOP], 1u);
            const unsigned tg = og / nx;
            if (og + 1u == (tg + 1u) * nx) xb_add(&bar[XB_TOPGEN], 1u);
            else XB_SPIN(xb_ld(&bar[XB_TOPGEN]) == tg, bar);
            __builtin_amdgcn_fence(__ATOMIC_ACQUIRE, "agent");
            xb_add(&bar[XB_XGEN(b.x)], 1u);
            asm volatile("s_waitcnt vmcnt(0)" ::: "memory");
        } else {
            XB_SPIN(xb_ld(&bar[XB_XGEN(b.x)]) == gen, bar);
            __builtin_amdgcn_fence(__ATOMIC_ACQUIRE, "agent");
            asm volatile("s_waitcnt vmcnt(0)" ::: "memory");
        }
    }
    __syncthreads();
}


__global__ void __launch_bounds__(NTHR, 2) fwd_kernel(Params p) {
  extern __shared__ __attribute__((aligned(16))) unsigned char lds[];
  cg::grid_group grid = cg::this_grid();
#ifndef ONLY_PH
#define PHON(k) 1
#else
#define PHON(k) ((k) == ONLY_PH)
#endif
#ifndef REPEAT_MASK
#define REPEAT_MASK 0
#endif
#define GSYNC(k) do { if ((k) == 0) { grid.sync(); xbar = xcd_barrier_post((unsigned*)(p.ws + WS_MISC + MISC_BAR), (volatile LAS unsigned*)(lds + LDS_BARST)); \
    if (threadIdx.x == 0) { volatile LAS unsigned* st_ = (volatile LAS unsigned*)(lds + LDS_BARST); const unsigned x_ = xcc_id(); \
      st_[8] = atomicAdd((unsigned*)(p.ws + WS_MISC + MISC_QCTR) + 16 + x_, 1u); st_[9] = x_; st_[10] = 1u; } \
    __syncthreads(); } else xcd_barrier(xbar); } while (0)
#define RUN_PHASE(k, call) do { if (PHON(k) && lo <= (k) && (k) < hi) { call; if ((REPEAT_MASK >> (k)) & 1) { grid.sync(); call; } } if (lo <= (k) && (k) + 1 < hi) GSYNC(k); } while (0)
  const int lo = p.ph_lo, hi = p.ph_hi;
  if (threadIdx.x < 16) ((volatile LAS unsigned*)(lds + LDS_BARST))[threadIdx.x] = 0u;
  __syncthreads();
  XcdBarrier xbar; xbar.bar = (unsigned*)(p.ws + WS_MISC + MISC_BAR); xbar.x = 0; xbar.st = (volatile LAS unsigned*)(lds + LDS_BARST);
  RUN_PHASE(0, phase_prep(p, lds));
  RUN_PHASE(1, phase_proj(p, lds));
  RUN_PHASE(2, phase_attn(p, lds));
  RUN_PHASE(3, phase_outproj(p, lds));
  RUN_PHASE(4, phase_norm2(p));
  RUN_PHASE(5, phase_peer_query(p, lds));
  RUN_PHASE(6, phase_peer_route(p, lds));
  RUN_PHASE(7, phase_peer_sliced<0>(p, lds));
#ifndef PROBE_PEER
#define PROBE_PEER 0
#endif
  if (PROBE_PEER & 1) { xcd_barrier(xbar); phase_peer_sliced<0>(p, lds); xcd_barrier(xbar); }
  RUN_PHASE(8, phase_peer_act(p));
  RUN_PHASE(9, phase_peer_sliced<1>(p, lds));
  if (PROBE_PEER & 2) { xcd_barrier(xbar); phase_peer_sliced<1>(p, lds); }
}

extern "C" void kernel_launch(void* const* d_in, const int* in_sizes, int n_in, void* d_out, int out_size, void* d_ws, size_t ws_size, hipStream_t stream) {
  static int grid_blocks = 0;
  if (grid_blocks == 0) {
    if (n_in != 20 || ws_size < WS_END || out_size != T_TOK * DM) {
      fprintf(stderr, "kernel_launch: unexpected problem shape (n_in %d, ws %zu, out %d)\n", n_in, ws_size, out_size);
      grid_blocks = -1; return;
    }
    int dev = 0, cus = 0, per_cu = 0;
    hipGetDevice(&dev);
    hipDeviceGetAttribute(&cus, hipDeviceAttributeMultiprocessorCount, dev);
    hipFuncSetAttribute((const void*)fwd_kernel, hipFuncAttributeMaxDynamicSharedMemorySize, LDS_BYTES);
    hipOccupancyMaxActiveBlocksPerMultiprocessor(&per_cu, (const void*)fwd_kernel, NTHR, LDS_BYTES);
    if (per_cu < 1) { fprintf(stderr, "kernel_launch: occupancy query says %d blocks/CU\n", per_cu); per_cu = 1; }
    grid_blocks = cus;
    (void)hipGetLastError();
  }
  if (grid_blocks < 0) return;
  Params p{};
  p.x_prompt = (const float*)d_in[0]; p.x_sample = (const float*)d_in[1]; p.rel_bias = (const float*)d_in[2]; p.attn_norm_g = (const float*)d_in[3];
  p.w_in = (const float*)d_in[4]; p.q_norm_a = (const float*)d_in[5]; p.k_norm_a = (const float*)d_in[6]; p.q_norm_b = (const float*)d_in[7];
  p.k_norm_b = (const float*)d_in[8]; p.lq1 = (const float*)d_in[9]; p.lk1 = (const float*)d_in[10]; p.lq2 = (const float*)d_in[11];
  p.lk2 = (const float*)d_in[12]; p.diff_norm_g = (const float*)d_in[13]; p.w_out = (const float*)d_in[14]; p.ffn_norm_g = (const float*)d_in[15];
  p.peer_w_q = (const float*)d_in[16]; p.peer_sub_keys = (const float*)d_in[17]; p.peer_u = (const float*)d_in[18]; p.peer_v = (const float*)d_in[19];
  p.out = (float*)d_out; p.ws = (unsigned char*)d_ws;
#if FUSED
  p.ph_lo = 0; p.ph_hi = NPHASE;
  void* args[] = {&p};
  hipError_t e = hipLaunchCooperativeKernel((const void*)fwd_kernel, dim3(grid_blocks), dim3(NTHR), args, LDS_BYTES, stream);
  if (e != hipSuccess) fprintf(stderr, "cooperative launch failed: %s (grid %d)\n", hipGetErrorString(e), grid_blocks);
#else
  for (int ph = 0; ph < NPHASE; ++ph) {
    p.ph_lo = ph; p.ph_hi = ph + 1;
    hipLaunchKernelGGL(fwd_kernel, dim3(grid_blocks), dim3(NTHR), LDS_BYTES, stream, p);
  }
#endif
}
```

```cpp
#include <hip/hip_runtime.h>
#include <hip/hip_cooperative_groups.h>
#include <cstdio>
#include <cstdint>
namespace cg = cooperative_groups;

#ifndef FUSED
#define FUSED 1
#endif

typedef unsigned short u16;
typedef __attribute__((ext_vector_type(8))) short bf16x8;
typedef __attribute__((ext_vector_type(4))) short s16x4;
typedef __attribute__((ext_vector_type(16))) float f32x16;
typedef __attribute__((ext_vector_type(4))) float f32x4;
typedef __attribute__((ext_vector_type(4))) unsigned u32x4;
typedef __attribute__((ext_vector_type(2))) unsigned u32x2;
typedef __attribute__((address_space(3))) unsigned char* ldsp_t;

#define DI __device__ __forceinline__
#define MFMA32(a, b, c) __builtin_amdgcn_mfma_f32_32x32x16_bf16((a), (b), (c), 0, 0, 0)

constexpr int DM = 1024;
constexpr int T_TOK = 65536;
constexpr int T_PROMPT = 32768;
constexpr int NTHR = 512;
constexpr int NPHASE = 10;
constexpr float NORM_EPS = 1e-6f;
constexpr float LOG2E = 1.4426950408889634f;
constexpr float C2 = 0.125f * LOG2E;
constexpr float NEG_BIG = -1.0e30f;

constexpr size_t WS_WIN  = 0;
constexpr size_t WS_WOUT = WS_WIN + (size_t)3072 * 1024 * 2;
constexpr size_t WS_WQ   = WS_WOUT + (size_t)1024 * 1024 * 2;
constexpr size_t WS_SK   = WS_WQ + (size_t)2048 * 1024 * 2;
constexpr size_t WS_U    = WS_SK + (size_t)2 * 128 * 128 * 2;
constexpr size_t WS_V    = WS_U + (size_t)16384 * 1024 * 2;
constexpr size_t WS_W16  = WS_V + (size_t)16384 * 1024;
constexpr size_t WS_MISC = WS_V + (size_t)16384 * 1024 * 2;
constexpr size_t MISC_SUINV = 0, MISC_SVINV = 65536, MISC_QCTR = 131072, MISC_BAR = 196608, MISC_HAMAX = 524288;
constexpr size_t WS_R    = WS_MISC + (size_t)1048576;
constexpr size_t R_REGION = (size_t)T_TOK * 512 * 2;
constexpr size_t WS_X1   = WS_R;
constexpr size_t WS_ZP   = WS_R + (size_t)T_TOK * 1024 * 2;
constexpr size_t WS_H    = WS_R + (size_t)T_TOK * 1024 * 4;
constexpr size_t WS_EIDX = WS_R + 6 * R_REGION;
constexpr size_t WS_G    = WS_EIDX + (size_t)T_TOK * 128 * 2;
constexpr size_t WS_END  = WS_G + (size_t)T_TOK * 128 * 4;
static_assert(WS_END <= (size_t)536870912, "workspace map exceeds 512 MiB");
constexpr size_t OUT_N1 = 0, OUT_MIX = 134217728, OUT_TV = 0, OUT_TI = 67108864;

constexpr int LDS_BYTES = 163840;
constexpr int LDS_BARST = 163840 - 256;

struct Params {
  const float* x_prompt; const float* x_sample; const float* rel_bias; const float* attn_norm_g; const float* w_in;
  const float* q_norm_a; const float* k_norm_a; const float* q_norm_b; const float* k_norm_b;
  const float* lq1; const float* lk1; const float* lq2; const float* lk2; const float* diff_norm_g; const float* w_out;
  const float* ffn_norm_g; const float* peer_w_q; const float* peer_sub_keys; const float* peer_u; const float* peer_v;
  float* out; unsigned char* ws; int ph_lo; int ph_hi;
};

DI u16 f2bf(float f) { unsigned u = __float_as_uint(f); u += 0x7fffu + ((u >> 16) & 1u); return (u16)(u >> 16); }
DI float bf2f(u16 b) { return __uint_as_float(((unsigned)b) << 16); }
DI unsigned pk2(float lo, float hi) {
  typedef float f2_t __attribute__((ext_vector_type(2)));
  typedef __bf16 b2_t __attribute__((ext_vector_type(2)));
  f2_t v = {lo, hi}; b2_t b = __builtin_convertvector(v, b2_t); return __builtin_bit_cast(unsigned, b);
}
DI int crow(int reg, int h) { return (reg & 3) + 8 * (reg >> 2) + 4 * h; }
DI float wave_sum(float v) {
#pragma unroll
  for (int o = 32; o > 0; o >>= 1) v += __shfl_xor(v, o);
  return v;
}
DI void seq_of(int t, int& seq_start, int& S, int& s) {
  if (t < T_PROMPT) { S = 4096; seq_start = t & ~4095; s = t & 4095; }
  else { S = 2048; seq_start = t & ~2047; s = t & 2047; }
}
DI const float* x_row(const Params& p, int t) {
  return (t < T_PROMPT) ? p.x_prompt + (size_t)t * DM : p.x_sample + (size_t)(t - T_PROMPT) * DM;
}
DI int rel_bucket(int rel) {
  int n = rel < 0 ? -rel : rel;
  int b;
  if (n < 8) b = n;
  else if (n < 15) b = 8; else if (n < 27) b = 9; else if (n < 50) b = 10; else if (n < 91) b = 11;
  else if (n < 166) b = 12; else if (n < 305) b = 13; else if (n < 559) b = 14; else b = 15;
  return (rel > 0 ? 16 : 0) + b;
}
DI s16x4 tr_read(const unsigned char* p) {
  typedef short v4i16_t __attribute__((ext_vector_type(4)));
  return __builtin_bit_cast(s16x4, __builtin_amdgcn_ds_read_tr16_b64_v4i16((__attribute__((address_space(3))) v4i16_t*)p));
}
DI bf16x8 cat8(s16x4 lo, s16x4 hi) { return __builtin_shufflevector(lo, hi, 0, 1, 2, 3, 4, 5, 6, 7); }

DI void transpose_item(const float* __restrict__ src, int K, int N, u16* __restrict__ dst, int k0, int n0, unsigned char* lds) {
  float* tile = (float*)lds;
  const int tid = threadIdx.x;
#pragma unroll
  for (int i = 0; i < 8; ++i) {
    int idx = tid + 512 * i; int r = idx >> 6, c = idx & 63;
    tile[r * 65 + c] = src[(size_t)(k0 + r) * N + n0 + c];
  }
  __syncthreads();
  {
    int n = tid >> 3, kc = tid & 7;
    u32x4 o;
    o[0] = pk2(tile[(kc * 8 + 0) * 65 + n], tile[(kc * 8 + 1) * 65 + n]);
    o[1] = pk2(tile[(kc * 8 + 2) * 65 + n], tile[(kc * 8 + 3) * 65 + n]);
    o[2] = pk2(tile[(kc * 8 + 4) * 65 + n], tile[(kc * 8 + 5) * 65 + n]);
    o[3] = pk2(tile[(kc * 8 + 6) * 65 + n], tile[(kc * 8 + 7) * 65 + n]);
    *(u32x4*)(dst + (size_t)(n0 + n) * K + k0 + kc * 8) = o;
  }
  __syncthreads();
}

DI void convert_item(const float* __restrict__ src, u16* __restrict__ dst, size_t base) {
  size_t i = base + (size_t)threadIdx.x * 8;
  f32x4 a = *(const f32x4*)(src + i), b = *(const f32x4*)(src + i + 4);
  u32x4 o; o[0] = pk2(a[0], a[1]); o[1] = pk2(a[2], a[3]); o[2] = pk2(b[0], b[1]); o[3] = pk2(b[2], b[3]);
  *(u32x4*)(dst + i) = o;
}

template <bool BF16IN = false>
DI void norm_row(const void* __restrict__ xr_, const float* __restrict__ g, u16* __restrict__ orow, int lane, float* amax_out = nullptr) {
  f32x4 v[4]; float ss = 0.f, am = 0.f;
#pragma unroll
  for (int i = 0; i < 4; ++i) {
    if (BF16IN) { const u32x2 r_ = *(const u32x2*)((const u16*)xr_ + lane * 4 + 256 * i); v[i][0] = __uint_as_float(r_[0] << 16); v[i][1] = __uint_as_float(r_[0] & 0xffff0000u); v[i][2] = __uint_as_float(r_[1] << 16); v[i][3] = __uint_as_float(r_[1] & 0xffff0000u); }
    else v[i] = *(const f32x4*)((const float*)xr_ + lane * 4 + 256 * i);
    ss += v[i][0] * v[i][0] + v[i][1] * v[i][1] + v[i][2] * v[i][2] + v[i][3] * v[i][3]; }
  ss = wave_sum(ss);
  const float r = __builtin_amdgcn_rsqf(ss * (1.0f / 1024.0f) + NORM_EPS);
#pragma unroll
  for (int i = 0; i < 4; ++i) {
    f32x4 gg = *(const f32x4*)(g + lane * 4 + 256 * i);
    u32x2 o; o[0] = pk2(v[i][0] * r * gg[0], v[i][1] * r * gg[1]); o[1] = pk2(v[i][2] * r * gg[2], v[i][3] * r * gg[3]);
    *(u32x2*)(orow + lane * 4 + 256 * i) = o;
    if (amax_out) {
      am = fmaxf(am, fmaxf(fmaxf(fabsf(__uint_as_float(o[0] << 16)), fabsf(__uint_as_float(o[0] & 0xffff0000u))), fmaxf(fabsf(__uint_as_float(o[1] << 16)), fabsf(__uint_as_float(o[1] & 0xffff0000u)))));
    }
  }
  if (amax_out) {
#pragma unroll
    for (int o = 32; o > 0; o >>= 1) am = fmaxf(am, __shfl_xor(am, o));
    if (lane == 0) *amax_out = am;
  }
}

DI void convert_tables(const Params& p) {
  const int nb = gridDim.x, bid = blockIdx.x, tid = threadIdx.x;
    const int lane_ = tid & 63, w_ = tid >> 6;
    for (int it = bid; it < 2 * 16384 / 8; it += nb) {
      const int row = it * 8 + w_;
      const int tbl = row >> 14, e = row & 16383;
      const float* src = (tbl ? p.peer_v : p.peer_u) + (size_t)e * DM + lane_ * 16;
      f32x4 a0 = *(const f32x4*)(src), a1 = *(const f32x4*)(src + 4), a2 = *(const f32x4*)(src + 8), a3 = *(const f32x4*)(src + 12);
      float am = 0.f;
#pragma unroll
      for (int j = 0; j < 4; ++j) am = fmaxf(am, fmaxf(fmaxf(fabsf(a0[j]), fabsf(a1[j])), fmaxf(fabsf(a2[j]), fabsf(a3[j]))));
#pragma unroll
      for (int o = 32; o > 0; o >>= 1) am = fmaxf(am, __shfl_xor(am, o));
      float isc; u32x2 o;
      if (tbl == 0) {
        const float sc = (am > 0.f) ? 7.0f / am : 0.f; isc = am * (1.0f / 7.0f);
#define Q4(x_) ((unsigned)((int)__builtin_rintf((x_) * sc)) & 15u)
        o[0] = Q4(a0[0]) | (Q4(a0[1]) << 8) | (Q4(a0[2]) << 16) | (Q4(a0[3]) << 24) | (Q4(a1[0]) << 4) | (Q4(a1[1]) << 12) | (Q4(a1[2]) << 20) | (Q4(a1[3]) << 28);
        o[1] = Q4(a2[0]) | (Q4(a2[1]) << 8) | (Q4(a2[2]) << 16) | (Q4(a2[3]) << 24) | (Q4(a3[0]) << 4) | (Q4(a3[1]) << 12) | (Q4(a3[2]) << 20) | (Q4(a3[3]) << 28);
#undef Q4
      } else {
        const float sc = (am > 0.f) ? 6.0f / am : 0.f; isc = am * (1.0f / 6.0f);
        unsigned pk = 0u;
        pk = __builtin_amdgcn_cvt_scalef32_pk_fp4_f32(pk, a0[0] * sc, a0[1] * sc, 1.0f, 0);
        pk = __builtin_amdgcn_cvt_scalef32_pk_fp4_f32(pk, a0[2] * sc, a0[3] * sc, 1.0f, 1);
        pk = __builtin_amdgcn_cvt_scalef32_pk_fp4_f32(pk, a1[0] * sc, a1[1] * sc, 1.0f, 2);
        pk = __builtin_amdgcn_cvt_scalef32_pk_fp4_f32(pk, a1[2] * sc, a1[3] * sc, 1.0f, 3);
        o[0] = pk; pk = 0u;
        pk = __builtin_amdgcn_cvt_scalef32_pk_fp4_f32(pk, a2[0] * sc, a2[1] * sc, 1.0f, 0);
        pk = __builtin_amdgcn_cvt_scalef32_pk_fp4_f32(pk, a2[2] * sc, a2[3] * sc, 1.0f, 1);
        pk = __builtin_amdgcn_cvt_scalef32_pk_fp4_f32(pk, a3[0] * sc, a3[1] * sc, 1.0f, 2);
        pk = __builtin_amdgcn_cvt_scalef32_pk_fp4_f32(pk, a3[2] * sc, a3[3] * sc, 1.0f, 3);
        o[1] = pk;
      }
      unsigned char* dst = tbl ? p.ws + WS_V + (size_t)e * 512 + lane_ * 8
                               : p.ws + WS_U + ((size_t)(lane_ >> 4) * 16384 + e) * 128 + (lane_ & 15) * 8;
      *(u32x2*)dst = o;
      if (lane_ == 0) ((float*)(p.ws + WS_MISC + (tbl ? MISC_SVINV : MISC_SUINV)))[e] = isc;
    }
}

DI void phase_prep(const Params& p, unsigned char* lds) {
  const int nb = gridDim.x, bid = blockIdx.x, tid = threadIdx.x;
  u16* wsb = (u16*)p.ws;
  for (int it = bid; it < 768 + 256 + 512; it += nb) {
    if (it < 768) { int kt = it / 48, nt = it % 48; transpose_item(p.w_in, 1024, 3072, (u16*)(p.ws + WS_WIN), kt * 64, nt * 64, lds); }
    else if (it < 1024) { int j = it - 768; int kt = j / 16, nt = j % 16; transpose_item(p.w_out, 1024, 1024, (u16*)(p.ws + WS_WOUT), kt * 64, nt * 64, lds); }
    else { int j = it - 1024; int kt = j / 32, nt = j % 32; transpose_item(p.peer_w_q, 1024, 2048, (u16*)(p.ws + WS_WQ), kt * 64, nt * 64, lds); }
  }
  for (int it = bid; it < 8; it += nb) convert_item(p.peer_sub_keys, (u16*)(p.ws + WS_SK), (size_t)it * 4096);
  if (bid == 0 && tid < 64) ((unsigned*)(p.ws + WS_MISC + MISC_QCTR))[tid] = 0u;
  if (bid == 0) for (int i = tid; i < 3456; i += NTHR) ((unsigned*)(p.ws + WS_MISC + MISC_BAR))[i] = 0u;
  convert_tables(p);
  const int lane = tid & 63, w = tid >> 6;
  u16* n1 = (u16*)((unsigned char*)p.out + OUT_N1);
  for (int it = bid; it < T_TOK / 8; it += nb) {
    int t = it * 8 + w;
    norm_row(x_row(p, t), p.attn_norm_g, n1 + (size_t)t * DM, lane);
  }
  (void)wsb;
}

template <int PR, int QR>
DI void gemm_mainloop(const u16* __restrict__ P, const u16* __restrict__ Q, int K, int p0, int q0, unsigned char* lds, f32x16 (&acc)[2][2]) {
  static_assert(PR + QR == 384, "tile");
  constexpr int STAGE = 384 * 128;
  constexpr int WC = QR / 64;
  const int tid = threadIdx.x, lane = tid & 63, r32 = lane & 31, h = lane >> 5;
  const int w = __builtin_amdgcn_readfirstlane(tid >> 6);
  const int wr = w / WC, wc = w % WC;
#pragma unroll
  for (int i = 0; i < 2; ++i)
#pragma unroll
    for (int j = 0; j < 2; ++j)
#pragma unroll
      for (int r = 0; r < 16; ++r) acc[i][j][r] = 0.f;
  u32x4 stg[6];
  const u16* src[6]; int loff[6];
#pragma unroll
  for (int i = 0; i < 6; ++i) {
    int c = tid + 512 * i; int row = c >> 3, kc = c & 7;
    src[i] = (row < PR) ? P + (size_t)(p0 + row) * K + kc * 8 : Q + (size_t)(q0 + row - PR) * K + kc * 8;
    loff[i] = row * 128 + ((kc ^ ((row >> 1) & 7)) << 4);
  }
  const int KT = K / 64;
#pragma unroll
  for (int i = 0; i < 6; ++i) stg[i] = *(const u32x4*)(src[i]);
#pragma unroll
  for (int i = 0; i < 6; ++i) *(u32x4*)(lds + loff[i]) = stg[i];
  __syncthreads();
  int aoff[2], boff[2], asw[2], bsw[2];
#pragma unroll
  for (int i = 0; i < 2; ++i) {
    int ra = wr * 64 + i * 32 + r32; aoff[i] = ra * 128; asw[i] = (ra >> 1) & 7;
    int rb = PR + wc * 64 + i * 32 + r32; boff[i] = rb * 128; bsw[i] = (rb >> 1) & 7;
  }
  for (int kt = 0; kt < KT; ++kt) {
    const int buf = (kt & 1) * STAGE;
    if (kt + 1 < KT) {
#pragma unroll
      for (int i = 0; i < 6; ++i) stg[i] = *(const u32x4*)(src[i] + (kt + 1) * 64);
    }
#pragma unroll
    for (int ks = 0; ks < 4; ++ks) {
      bf16x8 a[2], b[2];
#pragma unroll
      for (int i = 0; i < 2; ++i) {
        a[i] = *(const bf16x8*)(lds + buf + aoff[i] + (((2 * ks + h) ^ asw[i]) << 4));
        b[i] = *(const bf16x8*)(lds + buf + boff[i] + (((2 * ks + h) ^ bsw[i]) << 4));
      }
#pragma unroll
      for (int i = 0; i < 2; ++i)
#pragma unroll
        for (int j = 0; j < 2; ++j) acc[i][j] = MFMA32(a[i], b[j], acc[i][j]);
    }
    if (kt + 1 < KT) {
      const int nbuf = ((kt + 1) & 1) * STAGE;
#pragma unroll
      for (int i = 0; i < 6; ++i) *(u32x4*)(lds + nbuf + loff[i]) = stg[i];
    }
    __syncthreads();
  }
}

namespace pg8 {
#define PG8_LAS __attribute__((address_space(3)))
typedef unsigned short bf16_t;
typedef short bf16x8 __attribute__((ext_vector_type(8)));
typedef float f32x4 __attribute__((ext_vector_type(4)));
typedef unsigned u32x4 __attribute__((ext_vector_type(4)));
constexpr int BM = 256, BK = 64, HALF = 128, HTB = HALF * BK * 2  , STAGE_BYTES = 8 * HTB, NXCD = 8, WGM = 8;

__host__ __device__ __forceinline__ int lds_byte(int r, int c) { const int st = (r >> 4) * 2 + (c >> 5), rr = r & 15, cc = c & 31, ob = rr * 64 + cc * 2; return st * 1024 + (ob ^ (((ob >> 9) & 1) << 5)); }
__host__ __device__ __forceinline__ void stage_rc(int b, int& R, int& C) { const int st = b / 1024, sb = b % 1024, swz = sb ^ (((sb >> 9) & 1) << 5); R = (st >> 1) * 16 + swz / 64; C = (st & 1) * 32 + (swz % 64) / 2; }
__host__ __device__ __forceinline__ int perm32(int rho) { const int n = rho >> 4, i = rho & 15; return 8 * (i >> 2) + 4 * n + (i & 3); }

struct Unit { int pm, pn; };
struct Gemm { const bf16_t* A; const bf16_t* Bt; int M, N, K; };

struct StaticOrder {
    int nM, nN, nwg, G, c;
    __host__ __device__ void init(int M, int N, int G_, int c_) { nM = M / BM; nN = N / BM; nwg = nM * nN; G = G_; c = c_; }
    __host__ __device__ bool next(int i, Unit& u) const {
        const long L = (long)i * G + c; if (L >= nwg) return false;
        int wgid = (int)L; { const int q = nwg / NXCD, r = nwg % NXCD, xcd = wgid % NXCD, off = wgid / NXCD; wgid = (xcd < r ? xcd * (q + 1) : r * (q + 1) + (xcd - r) * q) + off; }
        const int nig = WGM * nN, gid = wgid / nig, fm = gid * WGM, gsz = (nM - fm) < WGM ? (nM - fm) : WGM;
        u.pm = fm + ((wgid % nig) % gsz); u.pn = (wgid % nig) / gsz; return true;
    }
    __device__ __forceinline__ void a_ready(const Unit&) const {}
    __device__ __forceinline__ void done(const Unit&) const {}
};


template <class Epi, class Sched, bool ALIGN_EPI = false, bool SP2 = false>
__device__ __forceinline__ void gemm_phase(PG8_LAS unsigned char* lds, const Gemm g, const Sched& S, const Epi& E) {
    const int tid = threadIdx.x, wid = __builtin_amdgcn_readfirstlane(tid >> 6), lane = tid & 63, wr = wid >> 2, wc = wid & 3, fr = lane & 15, fq = lane >> 4;
    const int K = g.K, nt = K / BK;
    unsigned voffA[2], voffB[2], voffB1[2];
#pragma unroll
    for (int i = 0; i < 2; ++i) { int R, C; stage_rc(tid * 16 + i * 8192, R, C); const int Rb = Epi::PERM ? ((R & ~31) + perm32(R & 31)) : R;
        voffA[i] = (unsigned)(R * K + C) * 2u;
        if (Epi::HEADPERM) { const int Rh = 64 * (R >> 5) + perm32(R & 31); voffB[i] = (unsigned)(Rh * K + C) * 2u; voffB1[i] = (unsigned)((Rh + 32) * K + C) * 2u; }
        else { voffB[i] = (unsigned)(Rb * K + C) * 2u; voffB1[i] = (unsigned)((Rb + HALF) * K + C) * 2u; } }
    const size_t kstep = (size_t)(BK * 2);
    const size_t hstep = (size_t)HALF * K * 2;
    const size_t tstep = 2 * hstep;
    const unsigned ldsw = (unsigned)wid * 1024u;
    const int aoff = lds_byte(wr * 64 + fr, fq * 8), boff = lds_byte(wc * 32 + fr, fq * 8);
#define PG8_SA(b, h) (((b) * 2 + (h)) * HTB)
#define PG8_SB(b, h) ((4 + (b) * 2 + (h)) * HTB)
#define PG8_STAGE(bufoff, gbase, voff) do { _Pragma("unroll") for (int _i = 0; _i < 2; ++_i) \
        __builtin_amdgcn_global_load_lds((const unsigned*)((const char*)(gbase) + (voff)[_i]), (PG8_LAS unsigned*)(lds + (bufoff) + ldsw + _i * 8192), 16, 0, 0); } while (0)
#define PG8_LDA(dst, b, h) do { _Pragma("unroll") for (int m = 0; m < 4; ++m) _Pragma("unroll") for (int k = 0; k < 2; ++k) dst[m][k] = *(const PG8_LAS bf16x8*)(lds + PG8_SA(b, h) + aoff + m * 2048 + k * 1024); } while (0)
#define PG8_LDB(dst, b, h) do { _Pragma("unroll") for (int n = 0; n < 2; ++n) _Pragma("unroll") for (int k = 0; k < 2; ++k) dst[n][k] = *(const PG8_LAS bf16x8*)(lds + PG8_SB(b, h) + boff + n * 2048 + k * 1024); } while (0)
#define PG8_MMA(ai, bj, At, Bt) do { __builtin_amdgcn_s_setprio(1); _Pragma("unroll") for (int m = 0; m < 4; ++m) _Pragma("unroll") for (int n = 0; n < 2; ++n) _Pragma("unroll") for (int k = 0; k < 2; ++k) \
        acc[ai][bj][m][n] = __builtin_amdgcn_mfma_f32_16x16x32_bf16(Bt[n][k], At[m][k], acc[ai][bj][m][n], 0, 0, 0); __builtin_amdgcn_s_setprio(0); } while (0)
#define PG8_WAIT_V(n) asm volatile("s_waitcnt vmcnt(" #n ")" ::: "memory")
#define PG8_WAIT_L(n) asm volatile("s_waitcnt lgkmcnt(" #n ")" ::: "memory")
#define PG8_BAR __builtin_amdgcn_s_barrier()
#define PG8_SCHED __builtin_amdgcn_sched_barrier(0)
    Unit cur, nxt; int ui = 0;
    if (!S.next(0, cur)) return;
    f32x4 acc[2][2][4][2];
#pragma unroll
    for (int a = 0; a < 2; ++a)
#pragma unroll
        for (int b = 0; b < 2; ++b)
#pragma unroll
            for (int m = 0; m < 4; ++m)
#pragma unroll
                for (int n = 0; n < 2; ++n) acc[a][b][m][n] = (f32x4){0.f, 0.f, 0.f, 0.f};
    bf16x8 At[4][2], B0[2][2], B1[2][2];
    const char* cA = (const char*)g.A + (size_t)cur.pm * tstep; const char* cB = (const char*)g.Bt + (size_t)cur.pn * tstep;
    S.a_ready(cur);
    if constexpr (SP2) {
        PG8_STAGE(PG8_SB(0, 0), cB, voffB); PG8_STAGE(PG8_SB(0, 1), cB, voffB1); PG8_STAGE(PG8_SA(0, 0), cA, voffA); PG8_STAGE(PG8_SA(0, 1), cA + hstep, voffA);
        if (wr == 1) PG8_BAR;
        PG8_WAIT_V(2); PG8_BAR;
        PG8_STAGE(PG8_SB(1, 0), cB + kstep, voffB); PG8_STAGE(PG8_SA(1, 0), cA + kstep, voffA); PG8_STAGE(PG8_SB(1, 1), cB + kstep, voffB1);
        PG8_WAIT_V(6); PG8_BAR;
    } else {
        PG8_STAGE(PG8_SB(0, 0), cB, voffB); PG8_STAGE(PG8_SA(0, 0), cA, voffA); PG8_STAGE(PG8_SB(0, 1), cB, voffB1); PG8_STAGE(PG8_SA(0, 1), cA + hstep, voffA);
        if (wr == 1) PG8_BAR;
        PG8_WAIT_V(4); PG8_BAR;
        PG8_STAGE(PG8_SB(1, 0), cB + kstep, voffB); PG8_STAGE(PG8_SA(1, 0), cA + kstep, voffA); PG8_STAGE(PG8_SB(1, 1), cB + kstep, voffB1);
        PG8_WAIT_V(6); PG8_BAR;
    }
    for (;;) {
        const bool has_next = S.next(ui + 1, nxt);
        const char* nA = has_next ? (const char*)g.A + (size_t)nxt.pm * tstep : cA; const char* nB = has_next ? (const char*)g.Bt + (size_t)nxt.pn * tstep : cB;
        for (int t = 0; t < nt; t += 2) {
            const bool last = (t == nt - 2);
            const char* a1 = cA + (size_t)(t + 1) * kstep;
            const char* a2 = last ? nA : cA + (size_t)(t + 2) * kstep; const char* b2 = last ? nB : cB + (size_t)(t + 2) * kstep;
            const char* a3 = a2 + kstep; const char* b3 = b2 + kstep;
            if (last && has_next) S.a_ready(nxt);
            if constexpr (SP2) {
            PG8_LDB(B0, 0, 0); PG8_LDB(B1, 0, 1); PG8_SCHED; PG8_LDA(At, 0, 0); PG8_STAGE(PG8_SA(1, 1), a1 + hstep, voffA);
            PG8_WAIT_V(8); PG8_WAIT_L(0); PG8_BAR; PG8_MMA(0, 0, At, B0); PG8_MMA(0, 1, At, B1); PG8_BAR; PG8_SCHED;
            PG8_LDA(At, 0, 1); PG8_STAGE(PG8_SB(0, 0), b2, voffB); PG8_STAGE(PG8_SB(0, 1), b2, voffB1); PG8_STAGE(PG8_SA(0, 0), a2, voffA);
            PG8_WAIT_V(8); PG8_WAIT_L(0); PG8_BAR; PG8_MMA(1, 0, At, B0); PG8_MMA(1, 1, At, B1); PG8_BAR; PG8_SCHED;
            PG8_LDB(B0, 1, 0); PG8_LDB(B1, 1, 1); PG8_SCHED; PG8_LDA(At, 1, 0); PG8_STAGE(PG8_SA(0, 1), a2 + hstep, voffA);
            PG8_WAIT_V(8); PG8_WAIT_L(0); PG8_BAR; PG8_MMA(0, 0, At, B0); PG8_MMA(0, 1, At, B1); PG8_BAR; PG8_SCHED;
            PG8_LDA(At, 1, 1); PG8_STAGE(PG8_SB(1, 0), b3, voffB); PG8_STAGE(PG8_SB(1, 1), b3, voffB1); PG8_STAGE(PG8_SA(1, 0), a3, voffA);
            PG8_WAIT_V(8); PG8_WAIT_L(0); PG8_BAR; PG8_MMA(1, 0, At, B0); PG8_MMA(1, 1, At, B1); PG8_BAR; PG8_SCHED;
            } else {
            PG8_LDB(B0, 0, 0); PG8_SCHED; PG8_LDA(At, 0, 0); PG8_STAGE(PG8_SA(1, 1), a1 + hstep, voffA);
            PG8_WAIT_L(8); PG8_BAR; PG8_WAIT_L(0); PG8_MMA(0, 0, At, B0); PG8_BAR; PG8_SCHED;
            PG8_LDB(B1, 0, 1); PG8_STAGE(PG8_SB(0, 0), b2, voffB);
            PG8_BAR; PG8_WAIT_L(0); PG8_MMA(0, 1, At, B1); PG8_BAR;
            PG8_LDA(At, 0, 1); PG8_STAGE(PG8_SA(0, 0), a2, voffA);
            PG8_BAR; PG8_WAIT_L(0); PG8_MMA(1, 0, At, B0); PG8_BAR; PG8_SCHED;
            PG8_STAGE(PG8_SB(0, 1), b2, voffB1);
            PG8_WAIT_V(6); PG8_BAR; PG8_MMA(1, 1, At, B1); PG8_BAR;
            PG8_LDB(B0, 1, 0); PG8_SCHED; PG8_LDA(At, 1, 0); PG8_STAGE(PG8_SA(0, 1), a2 + hstep, voffA);
            PG8_WAIT_L(8); PG8_BAR; PG8_WAIT_L(0); PG8_MMA(0, 0, At, B0); PG8_BAR; PG8_SCHED;
            PG8_LDB(B1, 1, 1); PG8_STAGE(PG8_SB(1, 0), b3, voffB);
            PG8_BAR; PG8_WAIT_L(0); PG8_MMA(0, 1, At, B1); PG8_BAR;
            PG8_LDA(At, 1, 1); PG8_STAGE(PG8_SA(1, 0), a3, voffA);
            PG8_BAR; PG8_WAIT_L(0); PG8_MMA(1, 0, At, B0); PG8_BAR; PG8_SCHED;
            PG8_STAGE(PG8_SB(1, 1), b3, voffB1);
            PG8_WAIT_V(6); PG8_BAR; PG8_MMA(1, 1, At, B1); PG8_BAR;
            }
        }
        if constexpr (ALIGN_EPI) { if (wr == 0) PG8_BAR; }
        if constexpr (!Epi::AFTER_DRAIN) { E(acc, cur, wr, wc, fr, fq); S.done(cur); }
        if (!has_next) break;
#pragma unroll
        for (int a = 0; a < 2; ++a)
#pragma unroll
            for (int b = 0; b < 2; ++b)
#pragma unroll
                for (int m = 0; m < 4; ++m)
#pragma unroll
                    for (int n = 0; n < 2; ++n) acc[a][b][m][n] = (f32x4){0.f, 0.f, 0.f, 0.f};
        cur = nxt; cA = nA; cB = nB; ++ui;
        if constexpr (ALIGN_EPI) { if (wr == 1) PG8_BAR; }
    }
    PG8_WAIT_V(0);
    if constexpr (!ALIGN_EPI) { if (wr == 0) PG8_BAR; }
    PG8_BAR;
    if constexpr (Epi::AFTER_DRAIN) { E.fused(acc, cur, wr, wc, fr, fq, lds, wid, lane); S.done(cur); }
#undef PG8_SA
#undef PG8_SB
#undef PG8_STAGE
#undef PG8_LDA
#undef PG8_LDB
#undef PG8_MMA
#undef PG8_WAIT_V
#undef PG8_WAIT_L
#undef PG8_BAR
#undef PG8_SCHED
}
}

struct EpiProj {
  static constexpr bool PERM = true, AFTER_DRAIN = false, HEADPERM = true;
  const float* gqa; const float* gka; const float* gqb; const float* gkb; unsigned char* ws;
  __device__ __forceinline__ void operator()(const pg8::f32x4 (&acc)[2][2][4][2], const pg8::Unit& u, int wr, int wc, int fr, int fq) const {
    const int nbase = u.pn * 256 + wc * 64;
    const int region = nbase >> 9, hw = (nbase & 511) >> 6;
    const float* g = (region == 0) ? gqa : (region == 1) ? gka : (region == 3) ? gqb : gkb;
    const bool normed = (region != 2 && region != 5);
    const float qs = (region == 0 || region == 3) ? C2 : 1.0f;
    u16* dstR = (u16*)(ws + WS_R + (size_t)region * R_REGION);
    f32x4 gv[2][2];
#pragma unroll
    for (int bj = 0; bj < 2; ++bj)
#pragma unroll
      for (int n = 0; n < 2; ++n) gv[bj][n] = normed ? *(const f32x4*)(g + 32 * bj + 8 * fq + 4 * n) : (f32x4){1.f, 1.f, 1.f, 1.f};
#pragma unroll
    for (int ai = 0; ai < 2; ++ai)
#pragma unroll
      for (int m = 0; m < 4; ++m) {
        const int t = u.pm * 256 + ai * 128 + wr * 64 + m * 16 + fr;
        int seq_start, S, sq; seq_of(t, seq_start, S, sq);
        float scale = 1.0f;
        if (normed) {
          float ss = 0.f;
#pragma unroll
          for (int bj = 0; bj < 2; ++bj)
#pragma unroll
            for (int n = 0; n < 2; ++n) { const f32x4 v = acc[ai][bj][m][n]; ss += v[0] * v[0] + v[1] * v[1] + v[2] * v[2] + v[3] * v[3]; }
          ss += __shfl_xor(ss, 16); ss += __shfl_xor(ss, 32);
          scale = __builtin_amdgcn_rsqf(ss * (1.0f / 64.0f) + NORM_EPS) * qs;
        }
        u16* dst;
        if (region != 5) dst = dstR + (size_t)seq_start * 512 + ((size_t)hw * S + sq) * 64;
        else dst = dstR + (size_t)seq_start * 512 + ((size_t)(hw >> 1) * S + sq) * 128 + (hw & 1) * 64;
#pragma unroll
        for (int bj = 0; bj < 2; ++bj) {
          const f32x4 v0 = acc[ai][bj][m][0] * scale * gv[bj][0], v1 = acc[ai][bj][m][1] * scale * gv[bj][1];
          u32x4 o; o[0] = pk2(v0[0], v0[1]); o[1] = pk2(v0[2], v0[3]); o[2] = pk2(v1[0], v1[1]); o[3] = pk2(v1[2], v1[3]);
          *(u32x4*)(dst + 32 * bj + 8 * fq) = o;
        }
      }
  }
};

DI void phase_proj(const Params& p, unsigned char* lds) {
  pg8::Gemm g{(const u16*)((const unsigned char*)p.out + OUT_N1), (const u16*)(p.ws + WS_WIN), T_TOK, 3072, 1024};
  pg8::StaticOrder S; S.init(T_TOK, 3072, (int)gridDim.x, (int)blockIdx.x);
  EpiProj E{p.q_norm_a, p.k_norm_a, p.q_norm_b, p.k_norm_b, p.ws};
  pg8::gemm_phase<EpiProj, pg8::StaticOrder, true, true>((PG8_LAS unsigned char*)lds, g, S, E);
}

constexpr int AL_STAGE = 0;
constexpr int AL_VT    = 0;
constexpr int AL_TAB   = 131072;
constexpr int AL_TABA  = 137216;
constexpr int AL_XL    = 150016;
constexpr int AL_MISC  = 151552;

DI unsigned voff_b(int row, int ch) { return 256u * row + 16u * (ch ^ (((row & 3) << 2) | ((row >> 2) & 3))); }

template <int VAR>
DI void diff_unit(const Params& p, unsigned char* lds, int seq_start, int S, int hd, int q0, float lam) {
  const int tid = threadIdx.x, lane = tid & 63, r32 = lane & 31, h = lane >> 5;
  const int w = __builtin_amdgcn_readfirstlane(tid >> 6);
  const int map = w >> 2, wq = w & 3;
  const u16* QBp = (const u16*)(p.ws + WS_R + 3 * R_REGION);
  const u16* KBp = (const u16*)(p.ws + WS_R + 4 * R_REGION);
  const u16* VBp = (const u16*)(p.ws + WS_R + 5 * R_REGION);
  const int qpos = q0 + wq * 32 + r32;
  const int qlo = q0 + wq * 32;
  const u16* Qp = QBp + (size_t)seq_start * 512 + ((size_t)(hd * 2 + map) * S + qpos) * 64;
  bf16x8 qf[4];
#pragma unroll
  for (int ks = 0; ks < 4; ++ks) qf[ks] = *(const bf16x8*)(Qp + ks * 16 + h * 8);
  const u16* K1g = KBp + (size_t)seq_start * 512 + ((size_t)(hd * 2 + 0) * S) * 64;
  const u16* K2g = KBp + (size_t)seq_start * 512 + ((size_t)(hd * 2 + 1) * S) * 64;
  const u16* Vg = VBp + (size_t)seq_start * 512 + ((size_t)hd * S) * 128;
  const float* tab = (const float*)(lds + AL_TAB);
  const float* misc = (const float*)(lds + AL_MISC);
  const float cAfter = misc[12 + hd];
  f32x16 O[4];
#pragma unroll
  for (int nb = 0; nb < 4; ++nb)
#pragma unroll
    for (int r = 0; r < 16; ++r) O[nb][r] = 0.f;
  float l = 0.f;
  const int kr_ = 8 * w + (lane >> 3), kc_ = (lane & 7) ^ ((kr_ >> 1) & 7);
  const u16* k1src = K1g + (size_t)kr_ * 64 + kc_ * 8;
  const u16* k2src = K2g + (size_t)kr_ * 64 + kc_ * 8;
  const u16* vsrc[2];
#pragma unroll
  for (int i = 0; i < 2; ++i) { const int row = 8 * w + 4 * i + (lane >> 4); const int pc = (lane & 15) ^ (((row & 3) << 2) | ((row >> 2) & 3)); vsrc[i] = Vg + (size_t)row * 128 + pc * 8; }
  const int NKT = S / 64;
  const int i16 = lane & 15, tq = i16 >> 2, tp = i16 & 3, blk = (lane >> 4) & 1;
  int kbase4[4], vbase[4][2];
#pragma unroll
  for (int ks = 0; ks < 4; ++ks) kbase4[ks] = r32 * 128 + (((2 * ks + h) ^ ((r32 >> 1) & 7)) << 4);
#pragma unroll
  for (int nb = 0; nb < 4; ++nb)
#pragma unroll
    for (int hi = 0; hi < 2; ++hi) vbase[nb][hi] = (int)voff_b(4 * h + tq + 8 * hi, 4 * nb + 2 * blk + (tp >> 1)) + 8 * (tp & 1);
#define DU_GLDS(gsrc_, ldsoff_) do { unsigned keep_; const unsigned dst_ = (unsigned)__builtin_amdgcn_readfirstlane((int)(ldsoff_)); \
    asm volatile("s_mov_b32 %0, m0\n\ts_mov_b32 m0, %2\n\ts_nop 0\n\tglobal_load_lds_dwordx4 %1, off\n\ts_mov_b32 m0, %0" : "=&s"(keep_) : "v"(gsrc_), "s"(dst_) : "memory"); } while (0)
#define DU_DMA(kt_, st_) do { const size_t ko_ = (size_t)(kt_) * 64 * 64, vo_ = (size_t)(kt_) * 64 * 128; const unsigned b_ = lds_base + AL_STAGE + (st_) * 32768; \
    DU_GLDS(k1src + ko_, b_ + w * 1024); DU_GLDS(k2src + ko_, b_ + 8192 + w * 1024); \
    DU_GLDS(vsrc[0] + vo_, b_ + 16384 + w * 2048); DU_GLDS(vsrc[1] + vo_, b_ + 16384 + w * 2048 + 1024); } while (0)
  const unsigned lds_base = (unsigned)(uintptr_t)lds;
#define SBAR() __builtin_amdgcn_sched_barrier(0)
#define DU_VRD(slot, f, so_) do { vlo[slot] = tr_read(vp[(f) >> 1][0] + (so_) + ((f) & 1) * 4096); vhi[slot] = tr_read(vp[(f) >> 1][1] + (so_) + ((f) & 1) * 4096); } while (0)
#define DU_SUB(A, B, kq2, kso2_, has_next2_, vso_, knext_, has_next_) do { \
    SBAR(); \
    s16x4 vlo[4], vhi[4]; \
    if (VAR != 2 && VAR != 4) { DU_VRD(0, 0, vso_); DU_VRD(1, 1, vso_); DU_VRD(2, 2, vso_); DU_VRD(3, 3, vso_); } \
    if (has_next_ && VAR != 3 && VAR != 4) { \
      f32x16 z_; _Pragma("unroll") for (int r = 0; r < 16; ++r) z_[r] = 0.f; \
      B = MFMA32(kf[0], qf[0], z_); B = MFMA32(kf[1], qf[1], B); B = MFMA32(kf[2], qf[2], B); B = MFMA32(kf[3], qf[3], B); } \
    float ls = 0.f; \
    _Pragma("unroll") for (int r = 0; r < 16; ++r) ls += A[r]; \
    l += ls; \
    bf16x8 pb[2]; \
    _Pragma("unroll") for (int s2 = 0; s2 < 2; ++s2) { \
      u32x4 pw; pw[0] = pk2(A[8 * s2 + 0], A[8 * s2 + 1]); pw[1] = pk2(A[8 * s2 + 2], A[8 * s2 + 3]); \
      pw[2] = pk2(A[8 * s2 + 4], A[8 * s2 + 5]); pw[3] = pk2(A[8 * s2 + 6], A[8 * s2 + 7]); \
      pb[s2] = __builtin_bit_cast(bf16x8, pw); } \
    SBAR(); \
    if ((has_next2_) && VAR != 3 && VAR != 4) { _Pragma("unroll") for (int ks = 0; ks < 4; ++ks) kf[ks] = *(const bf16x8*)(kq2[ks] + (kso2_)); } \
    if (has_next_) { \
      const int dmin_ = (knext_) - (qlo + 31), dmax_ = (knext_) + 31 - qlo; \
      if (dmin_ < 559) { \
        if (in_after) { in_after = false; _Pragma("unroll") for (int nb = 0; nb < 4; ++nb) _Pragma("unroll") for (int r = 0; r < 16; ++r) O[nb][r] *= fAfter; l *= fAfter; \
                        _Pragma("unroll") for (int s2 = 0; s2 < 2; ++s2) {   \
                          u32x4 pw; pw[0] = pk2(A[8 * s2 + 0] * fAfter, A[8 * s2 + 1] * fAfter); pw[1] = pk2(A[8 * s2 + 2] * fAfter, A[8 * s2 + 3] * fAfter); \
                          pw[2] = pk2(A[8 * s2 + 4] * fAfter, A[8 * s2 + 5] * fAfter); pw[3] = pk2(A[8 * s2 + 6] * fAfter, A[8 * s2 + 7] * fAfter); \
                          pb[s2] = __builtin_bit_cast(bf16x8, pw); } } \
        if (dmax_ > -559) { const int base_ = (knext_) + 4 * h - qpos + 640; \
          _Pragma("unroll") for (int r = 0; r < 16; ++r) B[r] += tab[base_ + (r & 3) + 8 * (r >> 2)]; } } } \
    _Pragma("unroll") for (int f = 0; f < 8; ++f) { \
      if (VAR != 2 && VAR != 4) { O[f >> 1] = MFMA32(cat8(vlo[f & 3], vhi[f & 3]), pb[f & 1], O[f >> 1]); \
      if (f + 4 < 8) DU_VRD(f & 3, f + 4, vso_); } \
      if (VAR != 1 && VAR != 4) { B[2 * f] = __builtin_amdgcn_exp2f(B[2 * f]); B[2 * f + 1] = __builtin_amdgcn_exp2f(B[2 * f + 1]); } } \
  } while (0)
  f32x16 X, Y; bf16x8 kf[4];
  const float fAfter = __builtin_amdgcn_exp2f(cAfter);
  bool in_after = true;
  const int KT1 = NKT - 1;
  DU_DMA(KT1, 0);
  if (NKT > 1) DU_DMA(KT1 - 1, 1);
  if (NKT > 2) DU_DMA(KT1 - 2, 2);
  if (NKT > 2) asm volatile("s_waitcnt vmcnt(8)" ::: "memory"); else asm volatile("s_waitcnt vmcnt(0)" ::: "memory");
  __syncthreads();
  {
    const unsigned char* kb_ = lds + AL_STAGE + map * 8192 + 4096;
    f32x16 z_;
#pragma unroll
    for (int r = 0; r < 16; ++r) z_[r] = 0.f;
    X = MFMA32(*(const bf16x8*)(kb_ + kbase4[0]), qf[0], z_); X = MFMA32(*(const bf16x8*)(kb_ + kbase4[1]), qf[1], X);
    X = MFMA32(*(const bf16x8*)(kb_ + kbase4[2]), qf[2], X); X = MFMA32(*(const bf16x8*)(kb_ + kbase4[3]), qf[3], X);
    const int knext = 64 * KT1 + 32;
    const int dmin_ = knext - (qlo + 31), dmax_ = knext + 31 - qlo;
    if (dmin_ < 559) {
      in_after = false;
      if (dmax_ > -559) { const int base_ = knext + 4 * h - qpos + 640;
#pragma unroll
        for (int r = 0; r < 16; ++r) X[r] += tab[base_ + (r & 3) + 8 * (r >> 2)]; }
    }
#pragma unroll
    for (int r = 0; r < 16; ++r) X[r] = __builtin_amdgcn_exp2f(X[r]);
#pragma unroll
    for (int ks = 0; ks < 4; ++ks) kf[ks] = *(const bf16x8*)(lds + AL_STAGE + map * 8192 + kbase4[ks]);
  }
  if (map == 1) __builtin_amdgcn_s_setprio(1);
  int st_cur = 0, st_nxt = 32768, st_nx2 = 65536, st_free = 98304;
  for (int i = 0; i < NKT; ++i) {
    const int kt = KT1 - i;
    if (i + 2 < NKT) asm volatile("s_waitcnt vmcnt(4)" ::: "memory"); else asm volatile("s_waitcnt vmcnt(0)" ::: "memory");
    __syncthreads();
    if (i + 3 < NKT) DU_DMA(kt - 3, st_free / 32768);
    const unsigned char* knx[4]; const unsigned char* vp[4][2];
#pragma unroll
    for (int ks = 0; ks < 4; ++ks) knx[ks] = lds + AL_STAGE + st_nxt + map * 8192 + kbase4[ks];
#pragma unroll
    for (int nb = 0; nb < 4; ++nb) { vp[nb][0] = lds + AL_STAGE + st_cur + 16384 + vbase[nb][0]; vp[nb][1] = lds + AL_STAGE + st_cur + 16384 + vbase[nb][1]; }
    DU_SUB(X, Y, knx, 4096, (i + 1 < NKT), 8192, 64 * kt, true);
    DU_SUB(Y, X, knx, 0, (i + 1 < NKT), 0, 64 * kt - 32, (i + 1 < NKT));
    { const int t_ = st_cur; st_cur = st_nxt; st_nxt = st_nx2; st_nx2 = st_free; st_free = t_; }
  }
  __builtin_amdgcn_s_setprio(0);
#undef DU_DMA
#undef DU_GLDS
#undef DU_VRD
#undef DU_SUB
#undef SBAR
  if (in_after) {
#pragma unroll
    for (int nb = 0; nb < 4; ++nb)
#pragma unroll
      for (int r = 0; r < 16; ++r) O[nb][r] *= fAfter;
    l *= fAfter;
  }
  if (VAR != 0) {
#pragma unroll
    for (int nb = 0; nb < 4; ++nb) asm volatile("" :: "v"(O[nb]));
    asm volatile("" :: "v"(l), "v"(X), "v"(Y));
    __syncthreads();
    return;
  }
  __syncthreads();
  float ltot = l + __shfl_xor(l, 32);
  float* xbuf = (float*)(lds + AL_STAGE);
  if (map == 1) {
    const float inv = 1.0f / ltot;
#pragma unroll
    for (int nb = 0; nb < 4; ++nb)
#pragma unroll
      for (int r = 0; r < 16; ++r) xbuf[((wq * 64 + nb * 16 + r) << 6) + lane] = O[nb][r] * inv;
  }
  __syncthreads();
  if (map == 0) {
    const float inv = 1.0f / ltot;
    float ss = 0.f;
#pragma unroll
    for (int nb = 0; nb < 4; ++nb)
#pragma unroll
      for (int r = 0; r < 16; ++r) {
        float o = O[nb][r] * inv - lam * xbuf[((wq * 64 + nb * 16 + r) << 6) + lane];
        O[nb][r] = o; ss += o * o;
      }
    ss += __shfl_xor(ss, 32);
    const float rn = __builtin_amdgcn_rsqf(ss * (1.0f / 128.0f) + NORM_EPS) * 0.8f;
    u16* mix = (u16*)((unsigned char*)p.out + OUT_MIX) + (size_t)(seq_start + qpos) * 1024 + 512 + hd * 128;
#pragma unroll
    for (int nb = 0; nb < 4; ++nb)
#pragma unroll
      for (int g4 = 0; g4 < 4; ++g4) {
        const int d0 = 32 * nb + 8 * g4 + 4 * h;
        f32x4 gg = *(const f32x4*)(p.diff_norm_g + d0);
        u32x2 o; o[0] = pk2(O[nb][4 * g4 + 0] * rn * gg[0], O[nb][4 * g4 + 1] * rn * gg[1]);
        o[1] = pk2(O[nb][4 * g4 + 2] * rn * gg[2], O[nb][4 * g4 + 3] * rn * gg[3]);
        *(u32x2*)(mix + d0) = o;
      }
  }
  __syncthreads();
}

constexpr int AL_DPART = 65536;
constexpr int AL_DL    = AL_TAB;
template <int PASS>
DI void dil_wave_item(const Params& p, unsigned char* lds, int seq_start, int S, int hd, int i0, int sel) {
  const int tid = threadIdx.x, lane = tid & 63, r32 = lane & 31, h = lane >> 5;
  const int w = __builtin_amdgcn_readfirstlane(tid >> 6);
  const u16* QAp = (const u16*)(p.ws + WS_R + 0 * R_REGION);
  const u16* KAp = (const u16*)(p.ws + WS_R + 1 * R_REGION);
  const u16* VAp = (const u16*)(p.ws + WS_R + 2 * R_REGION);
  constexpr int QSTR = (PASS == 1) ? 1 : 16;
  constexpr int NTILE = (PASS == 1) ? 5 : 13;
  const int qbase = (PASS == 1) ? i0 + 32 * sel : i0 + sel;
  const int qpos = qbase + QSTR * r32;
  const int tl = qpos - i0;
  const u16* Qp = QAp + (size_t)seq_start * 512 + ((size_t)hd * S + qpos) * 64;
  bf16x8 qf[4];
#pragma unroll
  for (int ks = 0; ks < 4; ++ks) qf[ks] = *(const bf16x8*)(Qp + ks * 16 + h * 8);
  const u16* Kg = KAp + (size_t)seq_start * 512 + ((size_t)hd * S) * 64;
  const u16* Vg = VAp + (size_t)seq_start * 512 + ((size_t)hd * S) * 64;
  unsigned char* vt = lds + AL_VT + w * 8192;
  unsigned char* ktl = vt + 4096;
  const float* tabA = (const float*)(lds + AL_TABA) + hd * 3 * 132;
  unsigned char* dpart = lds + AL_DPART;
  float* dl = (float*)(lds + AL_DL);
  const int psw = ((tl >> 4) ^ tl) & 15;
  f32x16 O[2];
  float l = 0.f;
  if (PASS == 1) {
#pragma unroll
    for (int nb = 0; nb < 2; ++nb)
#pragma unroll
      for (int r = 0; r < 16; ++r) O[nb][r] = 0.f;
  } else {
#pragma unroll
    for (int nb = 0; nb < 2; ++nb)
#pragma unroll
      for (int g4 = 0; g4 < 4; ++g4) {
        const int ch = 8 * nb + 2 * g4 + h;
        const u32x2 v = *(const u32x2*)(dpart + tl * 128 + ((ch ^ psw) << 3));
        O[nb][4 * g4 + 0] = __uint_as_float(v[0] << 16); O[nb][4 * g4 + 1] = __uint_as_float(v[0] & 0xffff0000u);
        O[nb][4 * g4 + 2] = __uint_as_float(v[1] << 16); O[nb][4 * g4 + 3] = __uint_as_float(v[1] & 0xffff0000u);
      }
    if (h == 0) l = dl[tl];
  }
  const int i16 = lane & 15, tq = i16 >> 2, tp = i16 & 3, blk = (lane >> 4) & 1;
  int vrb[2][2];
#pragma unroll
  for (int nb = 0; nb < 2; ++nb)
#pragma unroll
    for (int hi = 0; hi < 2; ++hi) {
      const int R = 4 * h + tq + 8 * hi; const int ch = 4 * nb + 2 * blk + (tp >> 1);
      const int sw = (((R >> 1) & 1) << 2) ^ ((R >> 2) & 3);
      vrb[nb][hi] = R * 128 + ((ch ^ sw) << 4) + 8 * (tp & 1);
    }
  bf16x8 kfb[1][4]; u32x4 vcb[1][4];
  const int lrow = lane >> 3, lch = lane & 7;
#define DL_PARAMS(tau_) \
    const int d_ = (PASS == 1) ? 1 : (((tau_) < 5) ? 16 : 4); const int br_ = (PASS == 1) ? 2 : (((tau_) < 5) ? 0 : 1); \
    const int tt_ = (PASS == 1) ? (tau_) : (((tau_) < 5) ? (tau_) : (tau_) - 5); const int ratio_ = QSTR / d_; \
    const int n0_ = -64 + 32 * tt_;
#define DL_LOAD(buf, tau_) do { DL_PARAMS(tau_) \
    _Pragma("unroll") for (int i4 = 0; i4 < 4; ++i4) { int kpos_ = qbase + d_ * (n0_ + 8 * i4 + lrow); kpos_ = kpos_ < 0 ? 0 : (kpos_ >= S ? S - 1 : kpos_); \
      kfb[buf][i4] = *(const bf16x8*)(Kg + (size_t)kpos_ * 64 + lch * 8); vcb[buf][i4] = *(const u32x4*)(Vg + (size_t)kpos_ * 64 + lch * 8); } (void)br_; (void)ratio_; } while (0)
#define DL_STORE(buf) do { \
    _Pragma("unroll") for (int i4 = 0; i4 < 4; ++i4) { const int row_ = 8 * i4 + lrow; const int sw_ = (((row_ >> 1) & 1) << 2) ^ ((row_ >> 2) & 3); \
      *(u32x4*)(vt + row_ * 128 + ((lch ^ sw_) << 4)) = vcb[buf][i4]; \
      *(bf16x8*)(ktl + row_ * 128 + ((lch ^ ((row_ >> 1) & 7)) << 4)) = kfb[buf][i4]; } } while (0)
#define DL_COMPUTE(buf, tau_) do { DL_PARAMS(tau_) \
    const int kfirst_ = qbase + d_ * n0_, klast_ = qbase + d_ * (n0_ + 31); \
    const int base_ = n0_ + 4 * h - ratio_ * r32; const float* tb_ = tabA + br_ * 132; \
    f32x16 sT; \
    _Pragma("unroll") for (int r = 0; r < 16; ++r) { int dd = base_ + (r & 3) + 8 * (r >> 2); dd = dd < -65 ? -65 : (dd > 65 ? 65 : dd); sT[r] = tb_[dd + 65]; } \
    if (kfirst_ < 0 || klast_ >= S) { _Pragma("unroll") for (int r = 0; r < 16; ++r) { const int kp = qbase + d_ * (n0_ + crow(r, h)); if (kp < 0 || kp >= S) sT[r] = NEG_BIG; } } \
    _Pragma("unroll") for (int ks = 0; ks < 4; ++ks) { const bf16x8 ka_ = *(const bf16x8*)(ktl + r32 * 128 + (((2 * ks + h) ^ ((r32 >> 1) & 7)) << 4)); sT = MFMA32(ka_, qf[ks], sT); } \
    float ls = 0.f; \
    _Pragma("unroll") for (int r = 0; r < 16; ++r) { sT[r] = __builtin_amdgcn_exp2f(sT[r]); ls += sT[r]; } \
    l += ls; \
    bf16x8 pb[2]; \
    _Pragma("unroll") for (int s2 = 0; s2 < 2; ++s2) { \
      u32x4 pw; pw[0] = pk2(sT[8 * s2 + 0], sT[8 * s2 + 1]); pw[1] = pk2(sT[8 * s2 + 2], sT[8 * s2 + 3]); \
      pw[2] = pk2(sT[8 * s2 + 4], sT[8 * s2 + 5]); pw[3] = pk2(sT[8 * s2 + 6], sT[8 * s2 + 7]); \
      pb[s2] = __builtin_bit_cast(bf16x8, pw); } \
    _Pragma("unroll") for (int nb = 0; nb < 2; ++nb) _Pragma("unroll") for (int s2 = 0; s2 < 2; ++s2) { \
        const s16x4 lo = tr_read(vt + vrb[nb][0] + s2 * 2048); const s16x4 hi = tr_read(vt + vrb[nb][1] + s2 * 2048); \
        O[nb] = MFMA32(cat8(lo, hi), pb[s2], O[nb]); } \
  } while (0)
  DL_LOAD(0, 0);
#pragma unroll 1
  for (int tau = 0; tau < NTILE; ++tau) {
    DL_STORE(0);
    { const int tn = (tau + 1 < NTILE) ? tau + 1 : tau; DL_LOAD(0, tn); }
    DL_COMPUTE(0, tau);
  }
#undef DL_PARAMS
#undef DL_LOAD
#undef DL_STORE
#undef DL_COMPUTE
  const float ltot = l + __shfl_xor(l, 32);
  if (PASS == 1) {
#pragma unroll
    for (int nb = 0; nb < 2; ++nb)
#pragma unroll
      for (int g4 = 0; g4 < 4; ++g4) {
        const int ch = 8 * nb + 2 * g4 + h;
        u32x2 o; o[0] = pk2(O[nb][4 * g4 + 0], O[nb][4 * g4 + 1]); o[1] = pk2(O[nb][4 * g4 + 2], O[nb][4 * g4 + 3]);
        *(u32x2*)(dpart + tl * 128 + ((ch ^ psw) << 3)) = o;
      }
    if (h == 0) dl[tl] = ltot;
  } else {
    const float inv = 1.0f / ltot;
    u16* mix = (u16*)((unsigned char*)p.out + OUT_MIX) + (size_t)(seq_start + qpos) * 1024 + hd * 64;
#pragma unroll
    for (int nb = 0; nb < 2; ++nb)
#pragma unroll
      for (int g4 = 0; g4 < 4; ++g4) {
        const int d0 = 32 * nb + 8 * g4 + 4 * h;
        u32x2 o; o[0] = pk2(O[nb][4 * g4 + 0] * inv, O[nb][4 * g4 + 1] * inv); o[1] = pk2(O[nb][4 * g4 + 2] * inv, O[nb][4 * g4 + 3] * inv);
        *(u32x2*)(mix + d0) = o;
      }
  }
}

DI void phase_attn(const Params& p, unsigned char* lds) {
  const int tid = threadIdx.x;
  float* misc = (float*)(lds + AL_MISC);
  if (tid == 0) {
    float gqa = 0.f, gka = 0.f, gqb = 0.f, gkb = 0.f, bm = 0.f;
    for (int i = 0; i < 64; ++i) { gqa = fmaxf(gqa, fabsf(p.q_norm_a[i])); gka = fmaxf(gka, fabsf(p.k_norm_a[i])); gqb = fmaxf(gqb, fabsf(p.q_norm_b[i])); gkb = fmaxf(gkb, fabsf(p.k_norm_b[i])); }
    for (int i = 0; i < 32 * 12; ++i) bm = fmaxf(bm, fabsf(p.rel_bias[i]));
    const float M2 = 8.0f * LOG2E * fmaxf(gqa * gka, gqb * gkb) * 1.02f + bm * LOG2E + 0.1f;
    float s1 = 0.f, s2 = 0.f;
    for (int i = 0; i < 64; ++i) { s1 += p.lq1[i] * p.lk1[i]; s2 += p.lq2[i] * p.lk2[i]; }
    misc[0] = M2; misc[1] = expf(s1) - expf(s2) + 0.2f;
    for (int hd = 0; hd < 4; ++hd) { misc[8 + hd] = p.rel_bias[15 * 12 + 8 + hd] * LOG2E; misc[12 + hd] = (p.rel_bias[31 * 12 + 8 + hd] - p.rel_bias[15 * 12 + 8 + hd]) * LOG2E; }
  }
  __syncthreads();
  const float M2 = misc[0], lam = misc[1];
  {
    float* tabA = (float*)(lds + AL_TABA);
    for (int i = tid; i < 8 * 3 * 132; i += NTHR) {
      int hd = i / 396, rem = i % 396, br = rem / 132, idx = rem % 132;
      int dl = idx - 65; float v = NEG_BIG;
      if (dl >= -64 && dl <= 64 && idx < 131) { int d = (br == 0) ? 16 : (br == 1) ? 4 : 1; v = p.rel_bias[rel_bucket(dl * d) * 12 + hd] * LOG2E - M2; }
      tabA[i] = v;
    }
  }
#ifndef REP_DIFF
#define REP_DIFF 1
#endif
#ifndef REP_DIL
#define REP_DIL 1
#endif
  int cur_hd = -1;
  for (int rep_ = 0; rep_ < REP_DIFF; ++rep_)
  for (int vb = blockIdx.x; vb < 256; vb += gridDim.x) {
    const int xl = vb & 7, rk = vb >> 3;
#pragma unroll 1
    for (int rnd = 0; rnd < 8; ++rnd) {
      int seq_start, S, hd, q0;
      if (rnd < 4) { const int pair = xl + 8 * rnd; hd = pair & 3; S = 4096; seq_start = (pair >> 2) * 4096; q0 = rk * 128; }
      else { const int pair = 8 * xl + 2 * (rnd - 4) + (rk >> 4); hd = pair & 3; S = 2048; seq_start = T_PROMPT + (pair >> 2) * 2048; q0 = (rk & 15) * 128; }
      if (hd != cur_hd) {
        __syncthreads();
        float* tab = (float*)(lds + AL_TAB);
        for (int i = tid; i < 1281; i += NTHR) tab[i] = p.rel_bias[rel_bucket(i - 640) * 12 + 8 + hd] * LOG2E - misc[8 + hd];
        cur_hd = hd;
        __syncthreads();
      }
#ifndef PROBE_VAR
#define PROBE_VAR 0
#endif
      if (rep_ == 0) diff_unit<0>(p, lds, seq_start, S, hd, q0, lam); else diff_unit<PROBE_VAR>(p, lds, seq_start, S, hd, q0, lam);
    }
  }
  __syncthreads();
  const int w = tid >> 6;
  for (int rep_ = 0; rep_ < REP_DIL; ++rep_)
  for (int vb = blockIdx.x; vb < 256; vb += gridDim.x)
#pragma unroll 1
  for (int rnd = 0; rnd < 4; ++rnd) {
    const int xl = vb & 7, rk = vb >> 3;
    int seq_start, S, hd, i0;
    if (rnd < 2) { const int pair = xl * 8 + rnd * 4 + (rk >> 3); hd = pair & 7; S = 4096; seq_start = (pair >> 3) * 4096; i0 = (rk & 7) * 512; }
    else { const int pair = xl * 16 + (rnd - 2) * 8 + (rk >> 2); hd = pair & 7; S = 2048; seq_start = T_PROMPT + (pair >> 3) * 2048; i0 = (rk & 3) * 512; }
    __syncthreads();
#pragma unroll 1
    for (int u2 = 0; u2 < 2; ++u2) dil_wave_item<1>(p, lds, seq_start, S, hd, i0, w + 8 * u2);
    __syncthreads();
#pragma unroll 1
    for (int u2 = 0; u2 < 2; ++u2) dil_wave_item<2>(p, lds, seq_start, S, hd, i0, w + 8 * u2);
  }
}

struct EpiOut {
  static constexpr bool PERM = false, AFTER_DRAIN = false, HEADPERM = false;
  const float* xp; const float* xs; u16* x1;
  __device__ __forceinline__ void operator()(const pg8::f32x4 (&acc)[2][2][4][2], const pg8::Unit& u, int wr, int wc, int fr, int fq) const {
    const int col0 = u.pn * 256 + wc * 32 + 4 * fq;
#pragma unroll
    for (int ai = 0; ai < 2; ++ai)
#pragma unroll
      for (int m = 0; m < 4; ++m) {
        const int t = u.pm * 256 + ai * 128 + wr * 64 + m * 16 + fr;
        const float* xr = ((t < T_PROMPT) ? xp + (size_t)t * DM : xs + (size_t)(t - T_PROMPT) * DM) + col0;
        u16* orow = x1 + (size_t)t * DM + col0;
#pragma unroll
        for (int bj = 0; bj < 2; ++bj)
#pragma unroll
          for (int n = 0; n < 2; ++n) {
            const f32x4 xv = *(const f32x4*)(xr + bj * 128 + n * 16);
            const f32x4 sv_ = xv + acc[ai][bj][m][n];
            u32x2 o; o[0] = pk2(sv_[0], sv_[1]); o[1] = pk2(sv_[2], sv_[3]);
            *(u32x2*)(orow + bj * 128 + n * 16) = o;
          }
      }
  }
};

DI void phase_outproj(const Params& p, unsigned char* lds) {
  pg8::Gemm g{(const u16*)((const unsigned char*)p.out + OUT_MIX), (const u16*)(p.ws + WS_WOUT), T_TOK, 1024, 1024};
  pg8::StaticOrder S; S.init(T_TOK, 1024, (int)gridDim.x, (int)blockIdx.x);
  EpiOut E{p.x_prompt, p.x_sample, (u16*)(p.ws + WS_X1)};
  pg8::gemm_phase<EpiOut, pg8::StaticOrder, true, true>((PG8_LAS unsigned char*)lds, g, S, E);
}

DI void phase_norm2(const Params& p) {
  const int tid = threadIdx.x, lane = tid & 63, w = tid >> 6;
  const u16* x1 = (const u16*)(p.ws + WS_X1);
  u16* hb = (u16*)(p.ws + WS_H);
  for (int it = blockIdx.x; it < T_TOK / 8; it += gridDim.x) {
    int t = it * 8 + w;
    norm_row<true>(x1 + (size_t)t * DM, p.ffn_norm_g, hb + (size_t)t * DM, lane, (float*)(p.ws + WS_MISC + MISC_HAMAX) + t);
  }
}

struct EpiQp {
  static constexpr bool PERM = true, AFTER_DRAIN = false, HEADPERM = false;
  u16* O;
  __device__ __forceinline__ void operator()(const pg8::f32x4 (&acc)[2][2][4][2], const pg8::Unit& u, int wr, int wc, int fr, int fq) const {
    const int col0 = u.pn * 256 + wc * 32 + 8 * fq;
#pragma unroll
    for (int ai = 0; ai < 2; ++ai)
#pragma unroll
      for (int m = 0; m < 4; ++m) {
        const int t = u.pm * 256 + ai * 128 + wr * 64 + m * 16 + fr;
        u16* rowp = O + (size_t)t * 2048 + col0;
#pragma unroll
        for (int bj = 0; bj < 2; ++bj) {
          const f32x4 v0 = acc[ai][bj][m][0], v1 = acc[ai][bj][m][1];
          u32x4 o; o[0] = pk2(v0[0], v0[1]); o[1] = pk2(v0[2], v0[3]); o[2] = pk2(v1[0], v1[1]); o[3] = pk2(v1[2], v1[3]);
          *(u32x4*)(rowp + bj * 128) = o;
        }
      }
  }
};

DI void phase_peer_query(const Params& p, unsigned char* lds) {
  pg8::Gemm g{(const u16*)(p.ws + WS_H), (const u16*)(p.ws + WS_WQ), T_TOK, 2048, 1024};
  pg8::StaticOrder S; S.init(T_TOK, 2048, (int)gridDim.x, (int)blockIdx.x);
  EpiQp E{(u16*)p.out};
  pg8::gemm_phase<EpiQp, pg8::StaticOrder, true, true>((PG8_LAS unsigned char*)lds, g, S, E);
}

DI int f2sort(float f) { const int b = __float_as_int(f); return b ^ ((b >> 31) & 0x7fffffff); }
DI float sort2f(int s) { return __int_as_float(s ^ ((s >> 31) & 0x7fffffff)); }
#define CE_DESC(a, b) do { const int mx_ = max((a), (b)), mn_ = min((a), (b)); (a) = mx_; (b) = mn_; } while (0)
#define CE_ASC(a, b) do { const int mx_ = max((a), (b)), mn_ = min((a), (b)); (a) = mn_; (b) = mx_; } while (0)
template <int OFF> DI void sort16_desc(int (&x)[64]) {
#pragma unroll
  for (int k = 2; k <= 16; k <<= 1)
#pragma unroll
    for (int j = k >> 1; j > 0; j >>= 1)
#pragma unroll
      for (int i = 0; i < 16; ++i) {
        const int l = i ^ j;
        if (l > i) { if ((i & k) == 0) CE_DESC(x[OFF + i], x[OFF + l]); else CE_ASC(x[OFF + i], x[OFF + l]); }
      }
}
template <int A, int B> DI void merge16x(int (&x)[64]) {
#pragma unroll
  for (int i = 0; i < 16; ++i) x[A + i] = max(x[A + i], x[B + 15 - i]);
#pragma unroll
  for (int j = 8; j > 0; j >>= 1)
#pragma unroll
    for (int i = 0; i < 16; ++i) { const int l = i ^ j; if (l > i) CE_DESC(x[A + i], x[A + l]); }
}

DI void pack_hq(unsigned w0, unsigned w1, unsigned w2, unsigned w3, float sc, unsigned& HH, unsigned& LL) {
  const float MAGIC = 12582912.0f + 136.0f;
  const unsigned y0 = __float_as_uint(__builtin_fmaf(__uint_as_float(w0 << 16), sc, MAGIC)), y1 = __float_as_uint(__builtin_fmaf(__uint_as_float(w0 & 0xffff0000u), sc, MAGIC));
  const unsigned y2 = __float_as_uint(__builtin_fmaf(__uint_as_float(w1 << 16), sc, MAGIC)), y3 = __float_as_uint(__builtin_fmaf(__uint_as_float(w1 & 0xffff0000u), sc, MAGIC));
  const unsigned y4 = __float_as_uint(__builtin_fmaf(__uint_as_float(w2 << 16), sc, MAGIC)), y5 = __float_as_uint(__builtin_fmaf(__uint_as_float(w2 & 0xffff0000u), sc, MAGIC));
  const unsigned y6 = __float_as_uint(__builtin_fmaf(__uint_as_float(w3 << 16), sc, MAGIC)), y7 = __float_as_uint(__builtin_fmaf(__uint_as_float(w3 & 0xffff0000u), sc, MAGIC));
  const unsigned W = (y0 & 255u) | ((y1 & 255u) << 8) | ((y2 & 255u) << 16) | (y3 << 24);
  const unsigned X = (y4 & 255u) | ((y5 & 255u) << 8) | ((y6 & 255u) << 16) | (y7 << 24);
  HH = (((W >> 4) & 0x0F0F0F0Fu) | (X & 0xF0F0F0F0u)) ^ 0x88888888u;
  LL = ((W & 0x0F0F0F0Fu) | ((X << 4) & 0xF0F0F0F0u)) ^ 0x88888888u;
}
DI void quantise_h_rows(const Params& p, int t0, int lane) {
  const float* hamax = (const float*)(p.ws + WS_MISC + MISC_HAMAX);
  unsigned char* Hrow = p.ws + WS_H;
#pragma unroll 1
  for (int rr = 0; rr < 32; rr += 4) {
    u32x4 ha[4], hb[4]; float sc[4];
#pragma unroll
    for (int q = 0; q < 4; ++q) {
      const unsigned char* src = Hrow + (size_t)(t0 + rr + q) * 2048 + lane * 32;
      ha[q] = *(const u32x4*)src; hb[q] = *(const u32x4*)(src + 16);
      const float am = hamax[t0 + rr + q];
      sc[q] = (am > 0.f) ? 119.0f / am : 0.f;
    }
#pragma unroll
    for (int q = 0; q < 4; ++q) {
      unsigned h0, l0, h1, l1;
      pack_hq(ha[q][0], ha[q][1], ha[q][2], ha[q][3], sc[q], h0, l0);
      pack_hq(hb[q][0], hb[q][1], hb[q][2], hb[q][3], sc[q], h1, l1);
      u32x2 hi, lo; hi[0] = h0; hi[1] = h1; lo[0] = l0; lo[1] = l1;
      unsigned char* dst = Hrow + (size_t)(t0 + rr + q) * 2048 + (lane >> 4) * 256 + (lane & 15) * 8;
      *(u32x2*)dst = hi; *(u32x2*)(dst + 128) = lo;
    }
  }
}

DI void phase_peer_route(const Params& p, unsigned char* lds) {
  const u16* QP = (const u16*)p.out;
  const u16* SK = (const u16*)(p.ws + WS_SK);
  u16* eidx = (u16*)(p.ws + WS_EIDX);
  float* gg = (float*)(p.ws + WS_G);
  const int tid = threadIdx.x, lane = tid & 63, r32 = lane & 31, h = lane >> 5;
  const int w = __builtin_amdgcn_readfirstlane(tid >> 6);
  unsigned char* SKl = lds;
  float* v2l = (float*)(lds + 65536);
  __syncthreads();
#pragma unroll
  for (int i = 0; i < 8; ++i) {
    const int c = tid + 512 * i; const int zz = c >> 11, row = (c >> 4) & 127, ch = c & 15;
    const u32x4 v = *(const u32x4*)(SK + (size_t)zz * 16384 + row * 128 + ch * 8);
    *(u32x4*)(SKl + zz * 32768 + row * 256 + ((ch ^ (row & 15)) << 4)) = v;
  }
  __syncthreads();
  for (int item = blockIdx.x; item < T_TOK / 256; item += gridDim.x) {
    quantise_h_rows(p, item * 256 + w * 32, lane);
    const int t = item * 256 + w * 32 + r32;
    const u16* qrow = QP + (size_t)t * 2048;
    bf16x8 qf[8];
#pragma unroll
    for (int ks = 0; ks < 8; ++ks) qf[ks] = *(const bf16x8*)(qrow + ks * 16 + h * 8);
#pragma unroll 1
    for (int pp = 0; pp < 8; ++pp) {
      int lists[2][16];
#pragma unroll
      for (int z = 0; z < 2; ++z) {
        const int c16 = pp * 2 + z;
        int x[64];
        {
          f32x16 S2[4];
#pragma unroll
          for (int kb = 0; kb < 4; ++kb)
#pragma unroll
            for (int r = 0; r < 16; ++r) S2[kb][r] = 0.f;
#pragma unroll
          for (int ks = 0; ks < 8; ++ks)
#pragma unroll
            for (int kb = 0; kb < 4; ++kb) {
              const int key = kb * 32 + r32;
              const bf16x8 a = *(const bf16x8*)(SKl + z * 32768 + key * 256 + (((2 * ks + h) ^ (key & 15)) << 4));
              S2[kb] = MFMA32(a, qf[ks], S2[kb]);
            }
          {
            const int cn = (c16 + 1 < 16) ? c16 + 1 : 15;
#pragma unroll
            for (int ks = 0; ks < 8; ++ks) qf[ks] = *(const bf16x8*)(qrow + cn * 128 + ks * 16 + h * 8);
          }
#pragma unroll
          for (int e = 0; e < 64; ++e) {
            const int kidx = 32 * (e >> 4) + (e & 3) + 8 * ((e & 15) >> 2) + 4 * h;
            x[e] = (f2sort(S2[e >> 4][e & 15]) & ~127) | kidx;
          }
        }
        sort16_desc<0>(x); sort16_desc<16>(x); sort16_desc<32>(x); sort16_desc<48>(x);
        merge16x<0, 16>(x); merge16x<32, 48>(x); merge16x<0, 32>(x);
#pragma unroll
        for (int i = 0; i < 16; ++i) x[16 + i] = __shfl_xor(x[i], 32);
        merge16x<0, 16>(x);
#pragma unroll
        for (int i = 0; i < 16; ++i) lists[z][i] = x[i];
      }
      float v1h[8];
#pragma unroll
      for (int i = 0; i < 8; ++i) { const int a0_ = lists[0][i], a1_ = lists[0][8 + i]; v1h[i] = sort2f(a0_ ^ ((a0_ ^ a1_) & -h)); }
#pragma unroll
      for (int i = 0; i < 16; ++i) v2l[i * 512 + tid] = sort2f(lists[1][i]);
      unsigned ptrs = 0u;
      float bestv[16]; int be[16];
#pragma unroll
      for (int rd = 0; rd < 16; ++rd) {
        float best = -3.0e38f, bv1 = 0.f, bv2 = 0.f; int ab = 0;
#pragma unroll
        for (int a = 0; a < 8; ++a) {
          const int b = (int)((ptrs >> (4 * a)) & 15u);
          const float v2 = v2l[b * 512 + tid];
          const float cnd = v1h[a] + v2;
          if (cnd > best) { best = cnd; ab = a; bv1 = v1h[a]; bv2 = v2; }
        }
        const float obest = __shfl_xor(best, 32), obv1 = __shfl_xor(bv1, 32), obv2 = __shfl_xor(bv2, 32);
        const bool mine = h ? (best > obest) : (best >= obest);
        const float wbest = mine ? best : obest, w1 = mine ? bv1 : obv1, w2 = mine ? bv2 : obv2;
        bestv[rd] = wbest; be[rd] = (f2sort(w1) & 127) * 128 + (f2sort(w2) & 127);
        if (mine) ptrs += 1u << (4 * ab);
      }
      if (h == 0) {
        float ex[16]; float sum = 0.f;
#pragma unroll
        for (int rd = 0; rd < 16; ++rd) { ex[rd] = __expf(bestv[rd] - bestv[0]); sum += ex[rd]; }
        const float inv = 1.0f / sum;
        const size_t oo = ((size_t)t * 8 + pp) * 16;
#pragma unroll
        for (int q4 = 0; q4 < 4; ++q4) { f32x4 v = {ex[4 * q4] * inv, ex[4 * q4 + 1] * inv, ex[4 * q4 + 2] * inv, ex[4 * q4 + 3] * inv}; *(f32x4*)(gg + oo + 4 * q4) = v; }
        u32x4 e0, e1;
#pragma unroll
        for (int j = 0; j < 4; ++j) { e0[j] = (unsigned)be[2 * j] | ((unsigned)be[2 * j + 1] << 16); e1[j] = (unsigned)be[8 + 2 * j] | ((unsigned)be[8 + 2 * j + 1] << 16); }
        *(u32x4*)(eidx + oo) = e0; *(u32x4*)(eidx + oo + 8) = e1;
      }
    }
  }
}

typedef float f2_t __attribute__((ext_vector_type(2)));
DI unsigned xcc_id() { return (unsigned)__builtin_amdgcn_s_getreg((3 << 11) | 20) & 7u; }
constexpr int PG_CHUNK_TOK = 64;
constexpr int PG_NCHUNK = T_TOK / PG_CHUNK_TOK;

DI void dec32(const u32x4& r, f2_t (&v)[16]) {
#pragma unroll
  for (int d = 0; d < 4; ++d) {
    v[4 * d + 0] = __builtin_amdgcn_cvt_scalef32_pk_f32_fp4(r[d], 1.0f, 0); v[4 * d + 1] = __builtin_amdgcn_cvt_scalef32_pk_f32_fp4(r[d], 1.0f, 1);
    v[4 * d + 2] = __builtin_amdgcn_cvt_scalef32_pk_f32_fp4(r[d], 1.0f, 2); v[4 * d + 3] = __builtin_amdgcn_cvt_scalef32_pk_f32_fp4(r[d], 1.0f, 3);
  }
}

template <int CTRL> DI float dpp_f(float x) { return __int_as_float(__builtin_amdgcn_update_dpp(0, __float_as_int(x), CTRL, 0xf, 0xf, true)); }
DI int idx16(const u32x4& a, const u32x4& b, int i) { const unsigned wd = (i < 8) ? a[(i & 7) >> 1] : b[(i & 7) >> 1]; return (i & 1) ? (int)(wd >> 16) : (int)(wd & 0xffffu); }
constexpr int PEER_NT = 16;
template <int WHICH>
DI void peer_wave_tokens(const Params& p, int x, int tb, int lane) {
  const unsigned char* TBL = p.ws + (WHICH ? WS_V : WS_U) + (size_t)x * 16384 * 128;
  const u16* Hb = (const u16*)(p.ws + WS_H);
  const u16* eidx = (const u16*)(p.ws + WS_EIDX);
  const u16* w16 = (const u16*)(p.ws + WS_W16);
  const float* x1 = (const float*)(p.ws + WS_X1);
  float* zpart = (float*)(p.ws + WS_ZP);
  const int r = lane >> 3, c = lane & 7;
  u32x4 ei[2][2]; u32x4 wv[2][2]; u32x4 rows[2][16]; u32x4 hsl[2][2];
#define PEER_LOAD_IDX(buf, k) do { const size_t o_ = (size_t)(tb + (k)) * 128 + r * 16; \
    ei[buf][0] = *(const u32x4*)(eidx + o_); ei[buf][1] = *(const u32x4*)(eidx + o_ + 8); \
    if (WHICH) { wv[buf][0] = *(const u32x4*)(w16 + o_); wv[buf][1] = *(const u32x4*)(w16 + o_ + 8); } } while (0)
#define PEER_LOAD_ROWS4(buf, ibuf, g) do { _Pragma("unroll") for (int ii_ = 0; ii_ < 4; ++ii_) { \
      const unsigned off_ = (unsigned)idx16(ei[ibuf][0], ei[ibuf][1], 4 * (g) + ii_) * 128u + (unsigned)c * 16u; \
      rows[buf][4 * (g) + ii_] = *(const u32x4*)(TBL + off_); } } while (0)
#define PEER_LOAD_ROWS(buf, ibuf) do { PEER_LOAD_ROWS4(buf, ibuf, 0); PEER_LOAD_ROWS4(buf, ibuf, 1); PEER_LOAD_ROWS4(buf, ibuf, 2); PEER_LOAD_ROWS4(buf, ibuf, 3); } while (0)
#define PEER_NEXT4(g) do { __builtin_amdgcn_sched_barrier(0); if (k + 1 < PEER_NT) PEER_LOAD_ROWS4((k + 1) & 1, (k + 1) & 1, g); __builtin_amdgcn_sched_barrier(0); } while (0)
#define PEER_LOAD_H(buf, k) do { if (WHICH == 0) { const unsigned char* hq_ = (const unsigned char*)Hb + (size_t)(tb + (k)) * 2048 + x * 256 + c * 16;     \
    hsl[buf][0] = *(const u32x4*)(hq_); hsl[buf][1] = *(const u32x4*)(hq_ + 128); } } while (0)
  PEER_LOAD_IDX(0, 0); PEER_LOAD_IDX(1, 1);
  PEER_LOAD_H(0, 0);
  PEER_LOAD_ROWS(0, 0);
#pragma unroll
  for (int k = 0; k < PEER_NT; ++k) {
    const int t = tb + k;
    u32x4 wcur[2];
    if (WHICH) { wcur[0] = wv[k & 1][0]; wcur[1] = wv[k & 1][1]; }
    if (k + 2 < PEER_NT) PEER_LOAD_IDX(k & 1, k + 2);
    if (k + 1 < PEER_NT) PEER_LOAD_H((k + 1) & 1, k + 1);
    if (WHICH == 0) {
      const u32x4 hh = hsl[k & 1][0], hl = hsl[k & 1][1];
      float sv[16];
#pragma unroll
      for (int i = 0; i < 16; ++i) {
        if ((i & 3) == 0) PEER_NEXT4(i >> 2);
        int ah = __builtin_amdgcn_sdot8((int)rows[k & 1][i][0], (int)hh[0], 0, false);
        int al = __builtin_amdgcn_sdot8((int)rows[k & 1][i][0], (int)hl[0], 0, false);
        ah = __builtin_amdgcn_sdot8((int)rows[k & 1][i][1], (int)hh[1], ah, false);
        al = __builtin_amdgcn_sdot8((int)rows[k & 1][i][1], (int)hl[1], al, false);
        ah = __builtin_amdgcn_sdot8((int)rows[k & 1][i][2], (int)hh[2], ah, false);
        al = __builtin_amdgcn_sdot8((int)rows[k & 1][i][2], (int)hl[2], al, false);
        ah = __builtin_amdgcn_sdot8((int)rows[k & 1][i][3], (int)hh[3], ah, false);
        al = __builtin_amdgcn_sdot8((int)rows[k & 1][i][3], (int)hl[3], al, false);
        int a = ah * 16 + al;
        a += __builtin_amdgcn_update_dpp(0, a, 0xB1, 0xf, 0xf, true);
        a += __builtin_amdgcn_update_dpp(0, a, 0x4E, 0xf, 0xf, true);
        a += __builtin_amdgcn_update_dpp(0, a, 0x141, 0xf, 0xf, true);
        sv[i] = (float)a;
      }
      float o0 = 0.f, o1 = 0.f;
#pragma unroll
      for (int i = 0; i < 8; ++i) { if (c == i) { o0 = sv[i]; o1 = sv[i + 8]; } }
      float* zp = zpart + ((size_t)x * T_TOK + t) * 128 + r * 16;
      zp[c] = o0; zp[c + 8] = o1;
    } else {
      f2_t acc[16];
#pragma unroll
      for (int q = 0; q < 16; ++q) { acc[q][0] = 0.f; acc[q][1] = 0.f; }
#pragma unroll
      for (int i = 0; i < 16; ++i) {
        if ((i & 3) == 0) PEER_NEXT4(i >> 2);
        f2_t v[16]; dec32(rows[k & 1][i], v);
        const unsigned wd_ = wcur[i >> 3][(i & 7) >> 1];
        const float wj = (i & 1) ? __uint_as_float(wd_ & 0xffff0000u) : __uint_as_float(wd_ << 16);
        f2_t ww = {wj, wj};
#pragma unroll
        for (int q = 0; q < 16; ++q) acc[q] = __builtin_elementwise_fma(v[q], ww, acc[q]);
      }
      f2_t b8[8];
      {
        const bool up = (lane & 32) != 0;
#pragma unroll
        for (int q = 0; q < 8; ++q) {
          f2_t keep = up ? acc[8 + q] : acc[q], send = up ? acc[q] : acc[8 + q];
          f2_t got; got[0] = __shfl_xor(send[0], 32); got[1] = __shfl_xor(send[1], 32);
          b8[q] = keep + got;
        }
      }
      f2_t b4[4];
      {
        const bool up = (lane & 16) != 0;
#pragma unroll
        for (int q = 0; q < 4; ++q) {
          f2_t keep = up ? b8[4 + q] : b8[q], send = up ? b8[q] : b8[4 + q];
          f2_t got; got[0] = __shfl_xor(send[0], 16); got[1] = __shfl_xor(send[1], 16);
          b4[q] = keep + got;
        }
      }
      f2_t b2[2];
      {
        const bool up = (lane & 8) != 0;
#pragma unroll
        for (int q = 0; q < 2; ++q) {
          f2_t keep = up ? b4[2 + q] : b4[q], send = up ? b4[q] : b4[2 + q];
          f2_t got; got[0] = dpp_f<0x128>(send[0]); got[1] = dpp_f<0x128>(send[1]);
          b2[q] = keep + got;
        }
      }
      const size_t o = (size_t)t * DM + x * 256 + c * 32 + 4 * r;
      const f32x4 xv = *(const f32x4*)(x1 + o);
      f32x4 res; res[0] = xv[0] + b2[0][0]; res[1] = xv[1] + b2[0][1]; res[2] = xv[2] + b2[1][0]; res[3] = xv[3] + b2[1][1];
      *(f32x4*)(p.out + o) = res;
    }
  }
#undef PEER_LOAD_IDX
#undef PEER_LOAD_H
#undef PEER_LOAD_ROWS
#undef PEER_LOAD_ROWS4
#undef PEER_NEXT4
}

typedef int v8i_t __attribute__((ext_vector_type(8)));
template <int NTOK, int VAR = 0>
DI void peer_tokens_v(const Params& p, unsigned char* ldsw, int t0, int lane) {
  const unsigned char* TBL = p.ws + WS_V;
  const u16* eidx = (const u16*)(p.ws + WS_EIDX);
  const unsigned char* w8 = p.ws + WS_W16;
  const u16* x1 = (const u16*)(p.ws + WS_X1);
  const int j = lane & 31, kg = lane >> 5;
  unsigned M[4];
#pragma unroll
  for (int q = 0; q < 4; ++q) M[q] = (kg == (j >> 4) && ((j & 15) >> 2) == q) ? (0xFFu << (8 * (j & 3))) : 0u;
  u32x4 ei[2][2]; u32x4 wv[2][2]; u32x4 rows[2][16];
#define PV_LOAD_IDX(u) do { const size_t o_ = (size_t)(t0 + ((u) >> 2)) * 128 + 16 * ((u) & 3); \
    ei[(u) & 1][0] = *(const u32x4*)(eidx + o_ + 64 * kg); ei[(u) & 1][1] = *(const u32x4*)(eidx + o_ + 64 * kg + 8); } while (0)
#define PV_LOAD_W(u) do { const size_t o_ = (size_t)(t0 + ((u) >> 2)) * 128 + 16 * ((u) & 3); \
    wv[(u) & 1][0] = *(const u32x4*)(w8 + o_); wv[(u) & 1][1] = *(const u32x4*)(w8 + o_ + 64); } while (0)
#define PV_IDX(ibuf, n) (((n) & 1) ? (ei[ibuf][(n) >> 3][((n) & 7) >> 1] >> 16) : (ei[ibuf][(n) >> 3][((n) & 7) >> 1] & 0xffffu))
#define PV_LOAD_ROWS4(u, g) do { _Pragma("unroll") for (int ii_ = 0; ii_ < 4; ++ii_) { \
      const unsigned off_ = (unsigned)PV_IDX((u) & 1, 4 * (g) + ii_) * 512u + (unsigned)j * 16u; \
      rows[(u) & 1][4 * (g) + ii_] = *(const u32x4*)(TBL + off_); } } while (0)
  constexpr int NU = 4 * NTOK;
  PV_LOAD_IDX(0); PV_LOAD_IDX(1); PV_LOAD_W(0);
  PV_LOAD_ROWS4(0, 0); PV_LOAD_ROWS4(0, 1); PV_LOAD_ROWS4(0, 2); PV_LOAD_ROWS4(0, 3);
  PV_LOAD_ROWS4(1, 0); PV_LOAD_ROWS4(1, 1); PV_LOAD_ROWS4(1, 2); PV_LOAD_ROWS4(1, 3);
  PV_LOAD_IDX(2);
  f32x16 acc; f32x4 xv[4];
  constexpr int XV_AT = 3;
#pragma unroll
  for (int u = 0; u < NU; ++u) {
    const int t = t0 + (u >> 2), c = u & 3;
    if (c == 0) {
#pragma unroll
      for (int r = 0; r < 16; ++r) acc[r] = 0.f;
    }
    if (c == 2 && VAR != 1) {
#pragma unroll
      for (int rq = 0; rq < 2; ++rq) {
        const u16* gsrc_ = x1 + (size_t)t * DM + 512 * rq + 8 * lane;
        unsigned keep_; const unsigned dst_ = (unsigned)__builtin_amdgcn_readfirstlane((int)((unsigned)(uintptr_t)ldsw + 1024u * rq));
        asm volatile("s_mov_b32 %0, m0\n\ts_mov_b32 m0, %2\n\ts_nop 0\n\tglobal_load_lds_dwordx4 %1, off\n\ts_mov_b32 m0, %0" : "=&s"(keep_) : "v"(gsrc_), "s"(dst_) : "memory");
      }
    }
    if (u + 3 < NU) PV_LOAD_IDX(u + 3);
    if (u + 1 < NU) PV_LOAD_W(u + 1);
#pragma unroll
    for (int n = 0; n < 16; ++n) {
      const unsigned wd1 = wv[u & 1][0][n >> 2], wd2 = wv[u & 1][1][n >> 2];
      const unsigned rep1 = __builtin_amdgcn_perm(wd1, wd1, 0x01010101u * (unsigned)(n & 3));
      const unsigned rep2 = __builtin_amdgcn_perm(wd2, wd2, 0x01010101u * (unsigned)(n & 3));
      v8i_t A, B;
#pragma unroll
      for (int q = 0; q < 4; ++q) { A[q] = (int)(rep1 & M[q]); A[4 + q] = (int)(rep2 & M[q]); }
      B[0] = (int)rows[u & 1][n][0]; B[1] = (int)rows[u & 1][n][1]; B[2] = (int)rows[u & 1][n][2]; B[3] = (int)rows[u & 1][n][3];
      B[4] = 0; B[5] = 0; B[6] = 0; B[7] = 0;
      acc = __builtin_amdgcn_mfma_scale_f32_32x32x64_f8f6f4(A, B, acc, 0  , 4  , 0, 0x7F7F7F7F, 0, 0x7F7F7F7F);
      if ((n & 3) == 3) {
        __builtin_amdgcn_sched_barrier(0);
        if (u + 2 < NU) PV_LOAD_ROWS4(u + 2, n >> 2);
        __builtin_amdgcn_sched_barrier(0);
      }
    }
    if (c == 3) {
      if (VAR != 1) {
        static_assert(NTOK == 4, "the vmcnt immediate below is counted for 16-chunk units");
        if (u + 3 < NU) asm volatile("s_waitcnt vmcnt(40)" ::: "memory");
        else asm volatile("s_waitcnt vmcnt(0)" ::: "memory");
#pragma unroll
        for (int rq = 0; rq < 4; ++rq) {
          const u32x2 r_ = *(const u32x2*)(ldsw + 2 * (32 * j + 8 * rq + 4 * kg));
          xv[rq][0] = __uint_as_float(r_[0] << 16); xv[rq][1] = __uint_as_float(r_[0] & 0xffff0000u); xv[rq][2] = __uint_as_float(r_[1] << 16); xv[rq][3] = __uint_as_float(r_[1] & 0xffff0000u);
        }
      }
#pragma unroll
      for (int rq = 0; rq < 4; ++rq) {
        const size_t o = (size_t)t * DM + 32 * j + 8 * rq + 4 * kg;
        f32x4 res;
#pragma unroll
        for (int q = 0; q < 4; ++q) res[q] = (VAR != 1 ? xv[rq][q] : 0.f) + acc[4 * rq + q] * (1.0f / 2048.0f);
        if (VAR != 1 || res[0] == 123456.789f) *(f32x4*)(p.out + o) = res;
      }
    }
  }
#undef PV_LOAD_IDX
#undef PV_LOAD_W
#undef PV_IDX
#undef PV_LOAD_ROWS4
}
DI void peer_act_range(const Params& p, size_t q_lo, size_t q_hi, int lane) {
  const float* zpart = (const float*)(p.ws + WS_ZP);
  const u16* eidx = (const u16*)(p.ws + WS_EIDX);
  float* wg = (float*)(p.ws + WS_G);
  const float* suinv = (const float*)(p.ws + WS_MISC + MISC_SUINV);
  const float* svinv = (const float*)(p.ws + WS_MISC + MISC_SVINV);
  const float* hamax = (const float*)(p.ws + WS_MISC + MISC_HAMAX);
#pragma unroll 4
  for (size_t i4 = q_lo + lane; i4 < q_hi; i4 += 64) {
    const size_t i = i4 * 4;
    f32x4 z = *(const f32x4*)(zpart + i);
#pragma unroll
    for (int x = 1; x < 4; ++x) { const f32x4 zz = *(const f32x4*)(zpart + (size_t)x * T_TOK * 128 + i); z[0] += zz[0]; z[1] += zz[1]; z[2] += zz[2]; z[3] += zz[3]; }
    const u32x2 ee = *(const u32x2*)(eidx + i);
    const f32x4 g4 = *(const f32x4*)(wg + i);
    const float hs = hamax[i >> 7] * (1.0f / 119.0f);
    float wq[4];
#pragma unroll
    for (int q = 0; q < 4; ++q) {
      const int e = (int)((q & 1) ? (ee[q >> 1] >> 16) : (ee[q >> 1] & 0xffffu));
      const float zq = z[q] * suinv[e] * hs;
      const float act = 0.5f * zq * (1.0f + erff(zq * 0.70710678118654752f));
      wq[q] = fminf(fmaxf(g4[q] * act * svinv[e] * 2048.0f, -448.0f), 448.0f);
    }
    int pk = __builtin_amdgcn_cvt_pk_fp8_f32(wq[0], wq[1], 0, false);
    pk = __builtin_amdgcn_cvt_pk_fp8_f32(wq[2], wq[3], pk, true);
    *(unsigned*)(p.ws + WS_W16 + i) = (unsigned)pk;
  }
}

template <int VAR = 0>
DI void phase_peer_v(const Params& p, unsigned char* lds) {
  const int tid = threadIdx.x, lane = tid & 63;
  const int w = __builtin_amdgcn_readfirstlane(tid >> 6);
  const int gw = blockIdx.x * 8 + w, nw = gridDim.x * 8;
  const int per = (T_TOK / 4 + nw - 1) / nw;
  const int u_lo = gw * per, u_hi = (u_lo + per < T_TOK / 4) ? u_lo + per : T_TOK / 4;
  if (u_lo >= u_hi) return;
  if (VAR == 0) {
    peer_act_range(p, (size_t)u_lo * 4 * 32, (size_t)u_hi * 4 * 32, lane);
    asm volatile("s_waitcnt vmcnt(0)" ::: "memory");
    __builtin_amdgcn_fence(__ATOMIC_ACQUIRE, "agent");
    asm volatile("s_waitcnt vmcnt(0)" ::: "memory");
  }
#pragma unroll 1
  for (int u = u_lo; u < u_hi; ++u) peer_tokens_v<4, VAR>(p, lds + w * 4096, u * 4, lane);
}

template <int WHICH>
DI void phase_peer_sliced(const Params& p, unsigned char* lds) {
  const int tid = threadIdx.x, lane = tid & 63, w = tid >> 6;
  const unsigned* rankctr = (const unsigned*)(p.ws + WS_MISC + MISC_QCTR) + 16;
  volatile PG8_LAS unsigned* st = (volatile PG8_LAS unsigned*)(lds + LDS_BARST);
  int myx = (int)st[9], myr = (int)st[8];
  int n[8]; int tot = 0;
#pragma unroll
  for (int j = 0; j < 8; ++j) { n[j] = (int)__hip_atomic_load(rankctr + j, __ATOMIC_RELAXED, __HIP_MEMORY_SCOPE_AGENT); tot += n[j]; }
  if (tot != (int)gridDim.x || st[10] != 1u) {
    myx = blockIdx.x & 7; myr = blockIdx.x >> 3;
#pragma unroll
    for (int j = 0; j < 8; ++j) n[j] = ((int)gridDim.x + 7 - j) >> 3;
  }
#pragma unroll 1
  for (int s = 0; s < 8; ++s) {
    int owner = s;
#pragma unroll
    for (int d = 0; d < 8; ++d) { if (n[owner & 7] == 0) owner = (owner + 1) & 7; }
    owner &= 7;
    if (owner != myx) continue;
    int nblk = 0;
#pragma unroll
    for (int j = 0; j < 8; ++j) nblk = (j == myx) ? n[j] : nblk;
    const int nw = nblk * 8, wr = myr * 8 + w;
    constexpr int NU = T_TOK / 2 / PEER_NT;
    const int u0 = (int)(((long long)wr * NU) / nw) + (s >> 2) * NU, u1 = (int)(((long long)(wr + 1) * NU) / nw) + (s >> 2) * NU;
#pragma unroll 1
    for (int u = u0; u < u1; ++u) peer_wave_tokens<WHICH>(p, s & 3, u * PEER_NT, lane);
  }
}

#define XB_TMO      128
#define XB_XCNT(j)  (256  + 64 * (j))
#define XB_XSUB(j)  (1280 + 64 * (j))
#define XB_XGEN(j)  (2304 + 64 * (j))
#define XB_TOP      3328
#define XB_TOPGEN   3392
#define XCD_BAR_WORDS 3456
#define XB_SPIN_CAP (1u << 18)
#define LAS __attribute__((address_space(3)))

__device__ __forceinline__ unsigned xb_ld(unsigned* p)              { return __hip_atomic_load(p, __ATOMIC_RELAXED, __HIP_MEMORY_SCOPE_AGENT); }
__device__ __forceinline__ unsigned xb_add(unsigned* p, unsigned v) { return __hip_atomic_fetch_add(p, v, __ATOMIC_RELAXED, __HIP_MEMORY_SCOPE_AGENT); }
__device__ __forceinline__ unsigned xb_xcc_id() { return (unsigned)__builtin_amdgcn_s_getreg((3 << 11) | 20) & 0xFu; }
#define XB_SPIN(cond, bar) do { unsigned _sp = 0; while (cond) { __builtin_amdgcn_s_sleep(1); \
    if ((++_sp & 255u) == 0u) { if (xb_ld(&(bar)[XB_TMO])) break; if (_sp > XB_SPIN_CAP) { atomicAdd(&(bar)[XB_TMO], 1u); break; } } } } while (0)

struct XcdBarrier {
    unsigned* bar; unsigned x;
    volatile LAS unsigned* st;
};

__device__ __forceinline__ XcdBarrier xcd_barrier_post(unsigned* bar, volatile LAS unsigned* st) {
    XcdBarrier b; b.bar = bar; b.x = xb_xcc_id(); b.st = st;
    if (threadIdx.x == 0) (void)xb_add(&bar[XB_XCNT(b.x)], 1u);
    return b;
}
__device__ __forceinline__ void xcd_barrier_complete(unsigned* bar, unsigned x, unsigned& nloc, unsigned& nx) {
    const unsigned G = gridDim.x * gridDim.y * gridDim.z;
    unsigned sum, cnt, mine, sp = 0u;
    for (;;) {
        sum = 0u; cnt = 0u; mine = 0u;
#pragma unroll
        for (unsigned j = 0; j < 16; ++j) { const unsigned c = xb_ld(&bar[XB_XCNT(j)]); sum += c; cnt += (c > 0u) ? 1u : 0u; mine = (j == x) ? c : mine; }
        if (sum == G) break;
        __builtin_amdgcn_s_sleep(1);
        if ((++sp & 255u) == 0u) { if (xb_ld(&bar[XB_TMO])) break; if (sp > XB_SPIN_CAP) { atomicAdd(&bar[XB_TMO], 1u); break; } }
    }
    nloc = mine > 0u ? mine : 1u; nx = cnt > 0u ? cnt : 1u;
}

__device__ __forceinline__ void xcd_barrier(const XcdBarrier& b) {
    asm volatile("s_waitcnt vmcnt(0)" ::: "memory");
    __syncthreads();
    if (threadIdx.x == 0) {
        unsigned* bar = b.bar;
        __builtin_amdgcn_s_waitcnt(0);
        unsigned nloc = b.st[0], nx = b.st[1];
        if (nloc == 0u) { xcd_barrier_complete(bar, b.x, nloc, nx); b.st[0] = nloc; b.st[1] = nx; }
        const unsigned old = xb_add(&bar[XB_XSUB(b.x)], 1u);
        const unsigned gen = old / nloc;
        if (old + 1u == (gen + 1u) * nloc) {
            __builtin_amdgcn_fence(__ATOMIC_RELEASE, "agent");
            asm volatile("s_waitcnt vmcnt(0)" ::: "memory");
            const unsigned og = xb_add(&bar[XB_TOP], 1u);
            const unsigned tg = og / nx;
            if (og + 1u == (tg + 1u) * nx) xb_add(&bar[XB_TOPGEN], 1u);
            else XB_SPIN(xb_ld(&bar[XB_TOPGEN]) == tg, bar);
            __builtin_amdgcn_fence(__ATOMIC_ACQUIRE, "agent");
            xb_add(&bar[XB_XGEN(b.x)], 1u);
            asm volatile("s_waitcnt vmcnt(0)" ::: "memory");
        } else {
            XB_SPIN(xb_ld(&bar[XB_XGEN(b.x)]) == gen, bar);
            __builtin_amdgcn_fence(__ATOMIC_ACQUIRE, "agent");
            asm volatile("s_waitcnt vmcnt(0)" ::: "memory");
        }
    }
    __syncthreads();
}


__global__ void __launch_bounds__(NTHR, 2) fwd_kernel(Params p) {
  extern __shared__ __attribute__((aligned(16))) unsigned char lds[];
  cg::grid_group grid = cg::this_grid();
#ifndef ONLY_PH
#define PHON(k) 1
#else
#define PHON(k) ((k) == ONLY_PH)
#endif
#ifndef REPEAT_MASK
#define REPEAT_MASK 0
#endif
#define GSYNC(k) do { if ((k) == 0) { grid.sync(); xbar = xcd_barrier_post((unsigned*)(p.ws + WS_MISC + MISC_BAR), (volatile LAS unsigned*)(lds + LDS_BARST)); \
    if (threadIdx.x == 0) { volatile LAS unsigned* st_ = (volatile LAS unsigned*)(lds + LDS_BARST); const unsigned x_ = xcc_id(); \
      st_[8] = atomicAdd((unsigned*)(p.ws + WS_MISC + MISC_QCTR) + 16 + x_, 1u); st_[9] = x_; st_[10] = 1u; } \
    __syncthreads(); } else xcd_barrier(xbar); } while (0)
#define RUN_PHASE(k, call) do { if (PHON(k) && lo <= (k) && (k) < hi) { call; if ((REPEAT_MASK >> (k)) & 1) { grid.sync(); call; } } if (lo <= (k) && (k) + 1 < hi) GSYNC(k); } while (0)
  const int lo = p.ph_lo, hi = p.ph_hi;
  if (threadIdx.x < 16) ((volatile LAS unsigned*)(lds + LDS_BARST))[threadIdx.x] = 0u;
  __syncthreads();
  XcdBarrier xbar; xbar.bar = (unsigned*)(p.ws + WS_MISC + MISC_BAR); xbar.x = 0; xbar.st = (volatile LAS unsigned*)(lds + LDS_BARST);
  RUN_PHASE(0, phase_prep(p, lds));
  RUN_PHASE(1, phase_proj(p, lds));
  RUN_PHASE(2, phase_attn(p, lds));
  RUN_PHASE(3, phase_outproj(p, lds));
  RUN_PHASE(4, phase_norm2(p));
  RUN_PHASE(5, phase_peer_query(p, lds));
  RUN_PHASE(6, phase_peer_route(p, lds));
  RUN_PHASE(7, phase_peer_sliced<0>(p, lds));
#ifndef PROBE_PEER
#define PROBE_PEER 0
#endif
  if (PROBE_PEER & 1) { xcd_barrier(xbar); phase_peer_sliced<0>(p, lds); xcd_barrier(xbar); }
  RUN_PHASE(9, phase_peer_v<0>(p, lds));
#ifdef PROBE_VAR9
  grid.sync(); phase_peer_v<PROBE_VAR9>(p, lds);
#endif
  if (PROBE_PEER & 2) { xcd_barrier(xbar); phase_peer_v<0>(p, lds); }
}

extern "C" void kernel_launch(void* const* d_in, const int* in_sizes, int n_in, void* d_out, int out_size, void* d_ws, size_t ws_size, hipStream_t stream) {
  static int grid_blocks = 0;
  if (grid_blocks == 0) {
    if (n_in != 20 || ws_size < WS_END || out_size != T_TOK * DM) {
      fprintf(stderr, "kernel_launch: unexpected problem shape (n_in %d, ws %zu, out %d)\n", n_in, ws_size, out_size);
      grid_blocks = -1; return;
    }
    int dev = 0, cus = 0, per_cu = 0;
    hipGetDevice(&dev);
    hipDeviceGetAttribute(&cus, hipDeviceAttributeMultiprocessorCount, dev);
    hipFuncSetAttribute((const void*)fwd_kernel, hipFuncAttributeMaxDynamicSharedMemorySize, LDS_BYTES);
    hipOccupancyMaxActiveBlocksPerMultiprocessor(&per_cu, (const void*)fwd_kernel, NTHR, LDS_BYTES);
    if (per_cu < 1) { fprintf(stderr, "kernel_launch: occupancy query says %d blocks/CU\n", per_cu); per_cu = 1; }
    grid_blocks = cus;
    (void)hipGetLastError();
  }
  if (grid_blocks < 0) return;
  Params p{};
  p.x_prompt = (const float*)d_in[0]; p.x_sample = (const float*)d_in[1]; p.rel_bias = (const float*)d_in[2]; p.attn_norm_g = (const float*)d_in[3];
  p.w_in = (const float*)d_in[4]; p.q_norm_a = (const float*)d_in[5]; p.k_norm_a = (const float*)d_in[6]; p.q_norm_b = (const float*)d_in[7];
  p.k_norm_b = (const float*)d_in[8]; p.lq1 = (const float*)d_in[9]; p.lk1 = (const float*)d_in[10]; p.lq2 = (const float*)d_in[11];
  p.lk2 = (const float*)d_in[12]; p.diff_norm_g = (const float*)d_in[13]; p.w_out = (const float*)d_in[14]; p.ffn_norm_g = (const float*)d_in[15];
  p.peer_w_q = (const float*)d_in[16]; p.peer_sub_keys = (const float*)d_in[17]; p.peer_u = (const float*)d_in[18]; p.peer_v = (const float*)d_in[19];
  p.out = (float*)d_out; p.ws = (unsigned char*)d_ws;
#if FUSED
  p.ph_lo = 0; p.ph_hi = NPHASE;
  void* args[] = {&p};
  hipError_t e = hipLaunchCooperativeKernel((const void*)fwd_kernel, dim3(grid_blocks), dim3(NTHR), args, LDS_BYTES, stream);
  if (e != hipSuccess) fprintf(stderr, "cooperative launch failed: %s (grid %d)\n", hipGetErrorString(e), grid_blocks);
#else
  for (int ph = 0; ph < NPHASE; ++ph) {
    p.ph_lo = ph; p.ph_hi = ph + 1;
    hipLaunchKernelGGL(fwd_kernel, dim3(grid_blocks), dim3(NTHR), LDS_BYTES, stream, p);
  }
#endif
}
```

```cpp
#include <hip/hip_runtime.h>
#include <hip/hip_cooperative_groups.h>
#include <cstdio>
#include <cstdint>
namespace cg = cooperative_groups;

#ifndef FUSED
#define FUSED 1
#endif

typedef unsigned short u16;
typedef __attribute__((ext_vector_type(8))) short bf16x8;
typedef __attribute__((ext_vector_type(4))) short s16x4;
typedef __attribute__((ext_vector_type(16))) float f32x16;
typedef __attribute__((ext_vector_type(4))) float f32x4;
typedef __attribute__((ext_vector_type(4))) unsigned u32x4;
typedef __attribute__((ext_vector_type(2))) unsigned u32x2;
typedef __attribute__((address_space(3))) unsigned char* ldsp_t;

#define DI __device__ __forceinline__
#define MFMA32(a, b, c) __builtin_amdgcn_mfma_f32_32x32x16_bf16((a), (b), (c), 0, 0, 0)

constexpr int DM = 1024;
constexpr int T_TOK = 65536;
constexpr int T_PROMPT = 32768;
constexpr int NTHR = 512;
constexpr int NPHASE = 10;
constexpr float NORM_EPS = 1e-6f;
constexpr float LOG2E = 1.4426950408889634f;
constexpr float C2 = 0.125f * LOG2E;
constexpr float NEG_BIG = -1.0e30f;

constexpr size_t WS_WIN  = 0;
constexpr size_t WS_WOUT = WS_WIN + (size_t)3072 * 1024 * 2;
constexpr size_t WS_WQ   = WS_WOUT + (size_t)1024 * 1024 * 2;
constexpr size_t WS_SK   = WS_WQ + (size_t)2048 * 1024 * 2;
constexpr size_t WS_U    = WS_SK + (size_t)2 * 128 * 128 * 2;
constexpr size_t WS_V    = WS_U + (size_t)16384 * 1024 * 2;
constexpr size_t WS_W16  = WS_V + (size_t)16384 * 1024;
constexpr size_t WS_MISC = WS_V + (size_t)16384 * 1024 * 2;
constexpr size_t MISC_SUINV = 0, MISC_SVINV = 65536, MISC_QCTR = 131072, MISC_BAR = 196608, MISC_HAMAX = 524288;
constexpr size_t WS_R    = WS_MISC + (size_t)1048576;
constexpr size_t R_REGION = (size_t)T_TOK * 512 * 2;
constexpr size_t WS_X1   = WS_R;
constexpr size_t WS_ZP   = WS_R + (size_t)T_TOK * 1024 * 2;
constexpr size_t WS_H    = WS_R + (size_t)T_TOK * 1024 * 4;
constexpr size_t WS_EIDX = WS_R + 6 * R_REGION;
constexpr size_t WS_G    = WS_EIDX + (size_t)T_TOK * 128 * 2;
constexpr size_t WS_END  = WS_G + (size_t)T_TOK * 128 * 4;
static_assert(WS_END <= (size_t)536870912, "workspace map exceeds 512 MiB");
constexpr size_t OUT_N1 = 0, OUT_MIX = 134217728, OUT_TV = 0, OUT_TI = 67108864;

constexpr int LDS_BYTES = 163840;
constexpr int LDS_BARST = 163840 - 256;

struct Params {
  const float* x_prompt; const float* x_sample; const float* rel_bias; const float* attn_norm_g; const float* w_in;
  const float* q_norm_a; const float* k_norm_a; const float* q_norm_b; const float* k_norm_b;
  const float* lq1; const float* lk1; const float* lq2; const float* lk2; const float* diff_norm_g; const float* w_out;
  const float* ffn_norm_g; const float* peer_w_q; const float* peer_sub_keys; const float* peer_u; const float* peer_v;
  float* out; unsigned char* ws; int ph_lo; int ph_hi;
};

DI u16 f2bf(float f) { unsigned u = __float_as_uint(f); u += 0x7fffu + ((u >> 16) & 1u); return (u16)(u >> 16); }
DI float bf2f(u16 b) { return __uint_as_float(((unsigned)b) << 16); }
DI unsigned pk2(float lo, float hi) {
  typedef float f2_t __attribute__((ext_vector_type(2)));
  typedef __bf16 b2_t __attribute__((ext_vector_type(2)));
  f2_t v = {lo, hi}; b2_t b = __builtin_convertvector(v, b2_t); return __builtin_bit_cast(unsigned, b);
}
DI int crow(int reg, int h) { return (reg & 3) + 8 * (reg >> 2) + 4 * h; }
DI float wave_sum(float v) {
#pragma unroll
  for (int o = 32; o > 0; o >>= 1) v += __shfl_xor(v, o);
  return v;
}
DI void seq_of(int t, int& seq_start, int& S, int& s) {
  if (t < T_PROMPT) { S = 4096; seq_start = t & ~4095; s = t & 4095; }
  else { S = 2048; seq_start = t & ~2047; s = t & 2047; }
}
DI const float* x_row(const Params& p, int t) {
  return (t < T_PROMPT) ? p.x_prompt + (size_t)t * DM : p.x_sample + (size_t)(t - T_PROMPT) * DM;
}
DI int rel_bucket(int rel) {
  int n = rel < 0 ? -rel : rel;
  int b;
  if (n < 8) b = n;
  else if (n < 15) b = 8; else if (n < 27) b = 9; else if (n < 50) b = 10; else if (n < 91) b = 11;
  else if (n < 166) b = 12; else if (n < 305) b = 13; else if (n < 559) b = 14; else b = 15;
  return (rel > 0 ? 16 : 0) + b;
}
DI s16x4 tr_read(const unsigned char* p) {
  typedef short v4i16_t __attribute__((ext_vector_type(4)));
  return __builtin_bit_cast(s16x4, __builtin_amdgcn_ds_read_tr16_b64_v4i16((__attribute__((address_space(3))) v4i16_t*)p));
}
DI bf16x8 cat8(s16x4 lo, s16x4 hi) { return __builtin_shufflevector(lo, hi, 0, 1, 2, 3, 4, 5, 6, 7); }

DI void transpose_item(const float* __restrict__ src, int K, int N, u16* __restrict__ dst, int k0, int n0, unsigned char* lds) {
  float* tile = (float*)lds;
  const int tid = threadIdx.x;
#pragma unroll
  for (int i = 0; i < 8; ++i) {
    int idx = tid + 512 * i; int r = idx >> 6, c = idx & 63;
    tile[r * 65 + c] = src[(size_t)(k0 + r) * N + n0 + c];
  }
  __syncthreads();
  {
    int n = tid >> 3, kc = tid & 7;
    u32x4 o;
    o[0] = pk2(tile[(kc * 8 + 0) * 65 + n], tile[(kc * 8 + 1) * 65 + n]);
    o[1] = pk2(tile[(kc * 8 + 2) * 65 + n], tile[(kc * 8 + 3) * 65 + n]);
    o[2] = pk2(tile[(kc * 8 + 4) * 65 + n], tile[(kc * 8 + 5) * 65 + n]);
    o[3] = pk2(tile[(kc * 8 + 6) * 65 + n], tile[(kc * 8 + 7) * 65 + n]);
    *(u32x4*)(dst + (size_t)(n0 + n) * K + k0 + kc * 8) = o;
  }
  __syncthreads();
}

DI void convert_item(const float* __restrict__ src, u16* __restrict__ dst, size_t base) {
  size_t i = base + (size_t)threadIdx.x * 8;
  f32x4 a = *(const f32x4*)(src + i), b = *(const f32x4*)(src + i + 4);
  u32x4 o; o[0] = pk2(a[0], a[1]); o[1] = pk2(a[2], a[3]); o[2] = pk2(b[0], b[1]); o[3] = pk2(b[2], b[3]);
  *(u32x4*)(dst + i) = o;
}

template <bool BF16IN>
DI void norm_load(const void* __restrict__ xr_, int lane, f32x4 (&v)[4]) {
#pragma unroll
  for (int i = 0; i < 4; ++i) {
    if (BF16IN) { const u32x2 r_ = *(const u32x2*)((const u16*)xr_ + lane * 4 + 256 * i); v[i][0] = __uint_as_float(r_[0] << 16); v[i][1] = __uint_as_float(r_[0] & 0xffff0000u); v[i][2] = __uint_as_float(r_[1] << 16); v[i][3] = __uint_as_float(r_[1] & 0xffff0000u); }
    else v[i] = *(const f32x4*)((const float*)xr_ + lane * 4 + 256 * i);
  }
}
DI void norm_finish(const f32x4 (&v)[4], const float* __restrict__ g, u16* __restrict__ orow, int lane, float* amax_out) {
  float ss = 0.f, am = 0.f;
#pragma unroll
  for (int i = 0; i < 4; ++i) ss += v[i][0] * v[i][0] + v[i][1] * v[i][1] + v[i][2] * v[i][2] + v[i][3] * v[i][3];
  ss = wave_sum(ss);
  const float r = __builtin_amdgcn_rsqf(ss * (1.0f / 1024.0f) + NORM_EPS);
#pragma unroll
  for (int i = 0; i < 4; ++i) {
    f32x4 gg = *(const f32x4*)(g + lane * 4 + 256 * i);
    u32x2 o; o[0] = pk2(v[i][0] * r * gg[0], v[i][1] * r * gg[1]); o[1] = pk2(v[i][2] * r * gg[2], v[i][3] * r * gg[3]);
    *(u32x2*)(orow + lane * 4 + 256 * i) = o;
    if (amax_out) {
      am = fmaxf(am, fmaxf(fmaxf(fabsf(__uint_as_float(o[0] << 16)), fabsf(__uint_as_float(o[0] & 0xffff0000u))), fmaxf(fabsf(__uint_as_float(o[1] << 16)), fabsf(__uint_as_float(o[1] & 0xffff0000u)))));
    }
  }
  if (amax_out) {
#pragma unroll
    for (int o = 32; o > 0; o >>= 1) am = fmaxf(am, __shfl_xor(am, o));
    if (lane == 0) *amax_out = am;
  }
}
template <bool BF16IN = false>
DI void norm_row(const void* __restrict__ xr_, const float* __restrict__ g, u16* __restrict__ orow, int lane, float* amax_out = nullptr) {
  f32x4 v[4]; norm_load<BF16IN>(xr_, lane, v); norm_finish(v, g, orow, lane, amax_out);
}
template <bool BF16IN>
DI void norm_row2(const void* xa, const void* xb, const float* __restrict__ g, u16* oa, u16* ob, int lane, float* ama, float* amb) {
  f32x4 va[4], vb[4]; norm_load<BF16IN>(xa, lane, va); norm_load<BF16IN>(xb, lane, vb);
  norm_finish(va, g, oa, lane, ama); norm_finish(vb, g, ob, lane, amb);
}

DI void convert_tables(const Params& p) {
  const int nb = gridDim.x, bid = blockIdx.x, tid = threadIdx.x;
    const int lane_ = tid & 63, w_ = tid >> 6;
    for (int it = bid; it < 2 * 16384 / 8; it += nb) {
      const int row = it * 8 + w_;
      const int tbl = row >> 14, e = row & 16383;
      const float* src = (tbl ? p.peer_v : p.peer_u) + (size_t)e * DM + lane_ * 16;
      f32x4 a0 = *(const f32x4*)(src), a1 = *(const f32x4*)(src + 4), a2 = *(const f32x4*)(src + 8), a3 = *(const f32x4*)(src + 12);
      float am = 0.f;
#pragma unroll
      for (int j = 0; j < 4; ++j) am = fmaxf(am, fmaxf(fmaxf(fabsf(a0[j]), fabsf(a1[j])), fmaxf(fabsf(a2[j]), fabsf(a3[j]))));
#pragma unroll
      for (int o = 32; o > 0; o >>= 1) am = fmaxf(am, __shfl_xor(am, o));
      float isc; u32x2 o;
      if (tbl == 0) {
        const float sc = (am > 0.f) ? 7.0f / am : 0.f; isc = am * (1.0f / 7.0f);
#define Q4(x_) ((unsigned)((int)__builtin_rintf((x_) * sc)) & 15u)
        o[0] = Q4(a0[0]) | (Q4(a0[1]) << 8) | (Q4(a0[2]) << 16) | (Q4(a0[3]) << 24) | (Q4(a1[0]) << 4) | (Q4(a1[1]) << 12) | (Q4(a1[2]) << 20) | (Q4(a1[3]) << 28);
        o[1] = Q4(a2[0]) | (Q4(a2[1]) << 8) | (Q4(a2[2]) << 16) | (Q4(a2[3]) << 24) | (Q4(a3[0]) << 4) | (Q4(a3[1]) << 12) | (Q4(a3[2]) << 20) | (Q4(a3[3]) << 28);
#undef Q4
      } else {
        const float sc = (am > 0.f) ? 6.0f / am : 0.f; isc = am * (1.0f / 6.0f);
        unsigned pk = 0u;
        pk = __builtin_amdgcn_cvt_scalef32_pk_fp4_f32(pk, a0[0] * sc, a0[1] * sc, 1.0f, 0);
        pk = __builtin_amdgcn_cvt_scalef32_pk_fp4_f32(pk, a0[2] * sc, a0[3] * sc, 1.0f, 1);
        pk = __builtin_amdgcn_cvt_scalef32_pk_fp4_f32(pk, a1[0] * sc, a1[1] * sc, 1.0f, 2);
        pk = __builtin_amdgcn_cvt_scalef32_pk_fp4_f32(pk, a1[2] * sc, a1[3] * sc, 1.0f, 3);
        o[0] = pk; pk = 0u;
        pk = __builtin_amdgcn_cvt_scalef32_pk_fp4_f32(pk, a2[0] * sc, a2[1] * sc, 1.0f, 0);
        pk = __builtin_amdgcn_cvt_scalef32_pk_fp4_f32(pk, a2[2] * sc, a2[3] * sc, 1.0f, 1);
        pk = __builtin_amdgcn_cvt_scalef32_pk_fp4_f32(pk, a3[0] * sc, a3[1] * sc, 1.0f, 2);
        pk = __builtin_amdgcn_cvt_scalef32_pk_fp4_f32(pk, a3[2] * sc, a3[3] * sc, 1.0f, 3);
        o[1] = pk;
      }
      unsigned char* dst = tbl ? p.ws + WS_V + (size_t)e * 512 + lane_ * 8
                               : p.ws + WS_U + ((size_t)(lane_ >> 4) * 16384 + e) * 128 + (lane_ & 15) * 8;
      *(u32x2*)dst = o;
      if (lane_ == 0) ((float*)(p.ws + WS_MISC + (tbl ? MISC_SVINV : MISC_SUINV)))[e] = isc;
    }
}

DI void phase_prep(const Params& p, unsigned char* lds) {
  const int nb = gridDim.x, bid = blockIdx.x, tid = threadIdx.x;
  u16* wsb = (u16*)p.ws;
  for (int it = bid; it < 768 + 256 + 512; it += nb) {
    if (it < 768) { int kt = it / 48, nt = it % 48; transpose_item(p.w_in, 1024, 3072, (u16*)(p.ws + WS_WIN), kt * 64, nt * 64, lds); }
    else if (it < 1024) { int j = it - 768; int kt = j / 16, nt = j % 16; transpose_item(p.w_out, 1024, 1024, (u16*)(p.ws + WS_WOUT), kt * 64, nt * 64, lds); }
    else { int j = it - 1024; int kt = j / 32, nt = j % 32; transpose_item(p.peer_w_q, 1024, 2048, (u16*)(p.ws + WS_WQ), kt * 64, nt * 64, lds); }
  }
  for (int it = bid; it < 8; it += nb) convert_item(p.peer_sub_keys, (u16*)(p.ws + WS_SK), (size_t)it * 4096);
  if (bid == 0 && tid < 64) ((unsigned*)(p.ws + WS_MISC + MISC_QCTR))[tid] = 0u;
  if (bid == 0) for (int i = tid; i < 3456; i += NTHR) ((unsigned*)(p.ws + WS_MISC + MISC_BAR))[i] = 0u;
  convert_tables(p);
  const int lane = tid & 63, w = tid >> 6;
  u16* n1 = (u16*)((unsigned char*)p.out + OUT_N1);
  for (int it = bid; it < T_TOK / 16; it += nb) {
    const int t = it * 16 + w, t2 = t + 8;
    norm_row2<false>(x_row(p, t), x_row(p, t2), p.attn_norm_g, n1 + (size_t)t * DM, n1 + (size_t)t2 * DM, lane, nullptr, nullptr);
  }
  (void)wsb;
}

template <int PR, int QR>
DI void gemm_mainloop(const u16* __restrict__ P, const u16* __restrict__ Q, int K, int p0, int q0, unsigned char* lds, f32x16 (&acc)[2][2]) {
  static_assert(PR + QR == 384, "tile");
  constexpr int STAGE = 384 * 128;
  constexpr int WC = QR / 64;
  const int tid = threadIdx.x, lane = tid & 63, r32 = lane & 31, h = lane >> 5;
  const int w = __builtin_amdgcn_readfirstlane(tid >> 6);
  const int wr = w / WC, wc = w % WC;
#pragma unroll
  for (int i = 0; i < 2; ++i)
#pragma unroll
    for (int j = 0; j < 2; ++j)
#pragma unroll
      for (int r = 0; r < 16; ++r) acc[i][j][r] = 0.f;
  u32x4 stg[6];
  const u16* src[6]; int loff[6];
#pragma unroll
  for (int i = 0; i < 6; ++i) {
    int c = tid + 512 * i; int row = c >> 3, kc = c & 7;
    src[i] = (row < PR) ? P + (size_t)(p0 + row) * K + kc * 8 : Q + (size_t)(q0 + row - PR) * K + kc * 8;
    loff[i] = row * 128 + ((kc ^ ((row >> 1) & 7)) << 4);
  }
  const int KT = K / 64;
#pragma unroll
  for (int i = 0; i < 6; ++i) stg[i] = *(const u32x4*)(src[i]);
#pragma unroll
  for (int i = 0; i < 6; ++i) *(u32x4*)(lds + loff[i]) = stg[i];
  __syncthreads();
  int aoff[2], boff[2], asw[2], bsw[2];
#pragma unroll
  for (int i = 0; i < 2; ++i) {
    int ra = wr * 64 + i * 32 + r32; aoff[i] = ra * 128; asw[i] = (ra >> 1) & 7;
    int rb = PR + wc * 64 + i * 32 + r32; boff[i] = rb * 128; bsw[i] = (rb >> 1) & 7;
  }
  for (int kt = 0; kt < KT; ++kt) {
    const int buf = (kt & 1) * STAGE;
    if (kt + 1 < KT) {
#pragma unroll
      for (int i = 0; i < 6; ++i) stg[i] = *(const u32x4*)(src[i] + (kt + 1) * 64);
    }
#pragma unroll
    for (int ks = 0; ks < 4; ++ks) {
      bf16x8 a[2], b[2];
#pragma unroll
      for (int i = 0; i < 2; ++i) {
        a[i] = *(const bf16x8*)(lds + buf + aoff[i] + (((2 * ks + h) ^ asw[i]) << 4));
        b[i] = *(const bf16x8*)(lds + buf + boff[i] + (((2 * ks + h) ^ bsw[i]) << 4));
      }
#pragma unroll
      for (int i = 0; i < 2; ++i)
#pragma unroll
        for (int j = 0; j < 2; ++j) acc[i][j] = MFMA32(a[i], b[j], acc[i][j]);
    }
    if (kt + 1 < KT) {
      const int nbuf = ((kt + 1) & 1) * STAGE;
#pragma unroll
      for (int i = 0; i < 6; ++i) *(u32x4*)(lds + nbuf + loff[i]) = stg[i];
    }
    __syncthreads();
  }
}

namespace pg8 {
#define PG8_LAS __attribute__((address_space(3)))
typedef unsigned short bf16_t;
typedef short bf16x8 __attribute__((ext_vector_type(8)));
typedef float f32x4 __attribute__((ext_vector_type(4)));
typedef unsigned u32x4 __attribute__((ext_vector_type(4)));
constexpr int BM = 256, BK = 64, HALF = 128, HTB = HALF * BK * 2  , STAGE_BYTES = 8 * HTB, NXCD = 8, WGM = 8;

__host__ __device__ __forceinline__ int lds_byte(int r, int c) { const int st = (r >> 4) * 2 + (c >> 5), rr = r & 15, cc = c & 31, ob = rr * 64 + cc * 2; return st * 1024 + (ob ^ (((ob >> 9) & 1) << 5)); }
__host__ __device__ __forceinline__ void stage_rc(int b, int& R, int& C) { const int st = b / 1024, sb = b % 1024, swz = sb ^ (((sb >> 9) & 1) << 5); R = (st >> 1) * 16 + swz / 64; C = (st & 1) * 32 + (swz % 64) / 2; }
__host__ __device__ __forceinline__ int perm32(int rho) { const int n = rho >> 4, i = rho & 15; return 8 * (i >> 2) + 4 * n + (i & 3); }

struct Unit { int pm, pn; };
struct Gemm { const bf16_t* A; const bf16_t* Bt; int M, N, K; };

struct StaticOrder {
    int nM, nN, nwg, G, c;
    __host__ __device__ void init(int M, int N, int G_, int c_) { nM = M / BM; nN = N / BM; nwg = nM * nN; G = G_; c = c_; }
    __host__ __device__ bool next(int i, Unit& u) const {
        const long L = (long)i * G + c; if (L >= nwg) return false;
        int wgid = (int)L; { const int q = nwg / NXCD, r = nwg % NXCD, xcd = wgid % NXCD, off = wgid / NXCD; wgid = (xcd < r ? xcd * (q + 1) : r * (q + 1) + (xcd - r) * q) + off; }
        const int nig = WGM * nN, gid = wgid / nig, fm = gid * WGM, gsz = (nM - fm) < WGM ? (nM - fm) : WGM;
        u.pm = fm + ((wgid % nig) % gsz); u.pn = (wgid % nig) / gsz; return true;
    }
    __device__ __forceinline__ void a_ready(const Unit&) const {}
    __device__ __forceinline__ void done(const Unit&) const {}
};


template <class Epi, class Sched, bool ALIGN_EPI = false, bool SP2 = false>
__device__ __forceinline__ void gemm_phase(PG8_LAS unsigned char* lds, const Gemm g, const Sched& S, const Epi& E) {
    const int tid = threadIdx.x, wid = __builtin_amdgcn_readfirstlane(tid >> 6), lane = tid & 63, wr = wid >> 2, wc = wid & 3, fr = lane & 15, fq = lane >> 4;
    const int K = g.K, nt = K / BK;
    unsigned voffA[2], voffB[2], voffB1[2];
#pragma unroll
    for (int i = 0; i < 2; ++i) { int R, C; stage_rc(tid * 16 + i * 8192, R, C); const int Rb = Epi::PERM ? ((R & ~31) + perm32(R & 31)) : R;
        voffA[i] = (unsigned)(R * K + C) * 2u;
        if (Epi::HEADPERM) { const int Rh = 64 * (R >> 5) + perm32(R & 31); voffB[i] = (unsigned)(Rh * K + C) * 2u; voffB1[i] = (unsigned)((Rh + 32) * K + C) * 2u; }
        else { voffB[i] = (unsigned)(Rb * K + C) * 2u; voffB1[i] = (unsigned)((Rb + HALF) * K + C) * 2u; } }
    const size_t kstep = (size_t)(BK * 2);
    const size_t hstep = (size_t)HALF * K * 2;
    const size_t tstep = 2 * hstep;
    const unsigned ldsw = (unsigned)wid * 1024u;
    const int aoff = lds_byte(wr * 64 + fr, fq * 8), boff = lds_byte(wc * 32 + fr, fq * 8);
#define PG8_SA(b, h) (((b) * 2 + (h)) * HTB)
#define PG8_SB(b, h) ((4 + (b) * 2 + (h)) * HTB)
#define PG8_STAGE(bufoff, gbase, voff) do { _Pragma("unroll") for (int _i = 0; _i < 2; ++_i) \
        __builtin_amdgcn_global_load_lds((const unsigned*)((const char*)(gbase) + (voff)[_i]), (PG8_LAS unsigned*)(lds + (bufoff) + ldsw + _i * 8192), 16, 0, 0); } while (0)
#define PG8_LDA(dst, b, h) do { _Pragma("unroll") for (int m = 0; m < 4; ++m) _Pragma("unroll") for (int k = 0; k < 2; ++k) dst[m][k] = *(const PG8_LAS bf16x8*)(lds + PG8_SA(b, h) + aoff + m * 2048 + k * 1024); } while (0)
#define PG8_LDB(dst, b, h) do { _Pragma("unroll") for (int n = 0; n < 2; ++n) _Pragma("unroll") for (int k = 0; k < 2; ++k) dst[n][k] = *(const PG8_LAS bf16x8*)(lds + PG8_SB(b, h) + boff + n * 2048 + k * 1024); } while (0)
#define PG8_MMA(ai, bj, At, Bt) do { __builtin_amdgcn_s_setprio(1); _Pragma("unroll") for (int m = 0; m < 4; ++m) _Pragma("unroll") for (int n = 0; n < 2; ++n) _Pragma("unroll") for (int k = 0; k < 2; ++k) \
        acc[ai][bj][m][n] = __builtin_amdgcn_mfma_f32_16x16x32_bf16(Bt[n][k], At[m][k], acc[ai][bj][m][n], 0, 0, 0); __builtin_amdgcn_s_setprio(0); } while (0)
#define PG8_WAIT_V(n) asm volatile("s_waitcnt vmcnt(" #n ")" ::: "memory")
#define PG8_WAIT_L(n) asm volatile("s_waitcnt lgkmcnt(" #n ")" ::: "memory")
#define PG8_BAR __builtin_amdgcn_s_barrier()
#define PG8_SCHED __builtin_amdgcn_sched_barrier(0)
    Unit cur, nxt; int ui = 0;
    if (!S.next(0, cur)) return;
    f32x4 acc[2][2][4][2];
#pragma unroll
    for (int a = 0; a < 2; ++a)
#pragma unroll
        for (int b = 0; b < 2; ++b)
#pragma unroll
            for (int m = 0; m < 4; ++m)
#pragma unroll
                for (int n = 0; n < 2; ++n) acc[a][b][m][n] = (f32x4){0.f, 0.f, 0.f, 0.f};
    bf16x8 At[4][2], B0[2][2], B1[2][2];
    const char* cA = (const char*)g.A + (size_t)cur.pm * tstep; const char* cB = (const char*)g.Bt + (size_t)cur.pn * tstep;
    S.a_ready(cur);
    if constexpr (SP2) {
        PG8_STAGE(PG8_SB(0, 0), cB, voffB); PG8_STAGE(PG8_SB(0, 1), cB, voffB1); PG8_STAGE(PG8_SA(0, 0), cA, voffA); PG8_STAGE(PG8_SA(0, 1), cA + hstep, voffA);
        if (wr == 1) PG8_BAR;
        PG8_WAIT_V(2); PG8_BAR;
        PG8_STAGE(PG8_SB(1, 0), cB + kstep, voffB); PG8_STAGE(PG8_SA(1, 0), cA + kstep, voffA); PG8_STAGE(PG8_SB(1, 1), cB + kstep, voffB1);
        PG8_WAIT_V(6); PG8_BAR;
    } else {
        PG8_STAGE(PG8_SB(0, 0), cB, voffB); PG8_STAGE(PG8_SA(0, 0), cA, voffA); PG8_STAGE(PG8_SB(0, 1), cB, voffB1); PG8_STAGE(PG8_SA(0, 1), cA + hstep, voffA);
        if (wr == 1) PG8_BAR;
        PG8_WAIT_V(4); PG8_BAR;
        PG8_STAGE(PG8_SB(1, 0), cB + kstep, voffB); PG8_STAGE(PG8_SA(1, 0), cA + kstep, voffA); PG8_STAGE(PG8_SB(1, 1), cB + kstep, voffB1);
        PG8_WAIT_V(6); PG8_BAR;
    }
    for (;;) {
        const bool has_next = S.next(ui + 1, nxt);
        const char* nA = has_next ? (const char*)g.A + (size_t)nxt.pm * tstep : cA; const char* nB = has_next ? (const char*)g.Bt + (size_t)nxt.pn * tstep : cB;
        for (int t = 0; t < nt; t += 2) {
            const bool last = (t == nt - 2);
            const char* a1 = cA + (size_t)(t + 1) * kstep;
            const char* a2 = last ? nA : cA + (size_t)(t + 2) * kstep; const char* b2 = last ? nB : cB + (size_t)(t + 2) * kstep;
            const char* a3 = a2 + kstep; const char* b3 = b2 + kstep;
            if (last && has_next) S.a_ready(nxt);
            if constexpr (SP2) {
            PG8_LDB(B0, 0, 0); PG8_LDB(B1, 0, 1); PG8_SCHED; PG8_LDA(At, 0, 0); PG8_STAGE(PG8_SA(1, 1), a1 + hstep, voffA);
            PG8_WAIT_V(8); PG8_WAIT_L(0); PG8_BAR; PG8_MMA(0, 0, At, B0); PG8_MMA(0, 1, At, B1); PG8_BAR; PG8_SCHED;
            PG8_LDA(At, 0, 1); PG8_STAGE(PG8_SB(0, 0), b2, voffB); PG8_STAGE(PG8_SB(0, 1), b2, voffB1); PG8_STAGE(PG8_SA(0, 0), a2, voffA);
            PG8_WAIT_V(8); PG8_WAIT_L(0); PG8_BAR; PG8_MMA(1, 0, At, B0); PG8_MMA(1, 1, At, B1); PG8_BAR; PG8_SCHED;
            PG8_LDB(B0, 1, 0); PG8_LDB(B1, 1, 1); PG8_SCHED; PG8_LDA(At, 1, 0); PG8_STAGE(PG8_SA(0, 1), a2 + hstep, voffA);
            PG8_WAIT_V(8); PG8_WAIT_L(0); PG8_BAR; PG8_MMA(0, 0, At, B0); PG8_MMA(0, 1, At, B1); PG8_BAR; PG8_SCHED;
            PG8_LDA(At, 1, 1); PG8_STAGE(PG8_SB(1, 0), b3, voffB); PG8_STAGE(PG8_SB(1, 1), b3, voffB1); PG8_STAGE(PG8_SA(1, 0), a3, voffA);
            PG8_WAIT_V(8); PG8_WAIT_L(0); PG8_BAR; PG8_MMA(1, 0, At, B0); PG8_MMA(1, 1, At, B1); PG8_BAR; PG8_SCHED;
            } else {
            PG8_LDB(B0, 0, 0); PG8_SCHED; PG8_LDA(At, 0, 0); PG8_STAGE(PG8_SA(1, 1), a1 + hstep, voffA);
            PG8_WAIT_L(8); PG8_BAR; PG8_WAIT_L(0); PG8_MMA(0, 0, At, B0); PG8_BAR; PG8_SCHED;
            PG8_LDB(B1, 0, 1); PG8_STAGE(PG8_SB(0, 0), b2, voffB);
            PG8_BAR; PG8_WAIT_L(0); PG8_MMA(0, 1, At, B1); PG8_BAR;
            PG8_LDA(At, 0, 1); PG8_STAGE(PG8_SA(0, 0), a2, voffA);
            PG8_BAR; PG8_WAIT_L(0); PG8_MMA(1, 0, At, B0); PG8_BAR; PG8_SCHED;
            PG8_STAGE(PG8_SB(0, 1), b2, voffB1);
            PG8_WAIT_V(6); PG8_BAR; PG8_MMA(1, 1, At, B1); PG8_BAR;
            PG8_LDB(B0, 1, 0); PG8_SCHED; PG8_LDA(At, 1, 0); PG8_STAGE(PG8_SA(0, 1), a2 + hstep, voffA);
            PG8_WAIT_L(8); PG8_BAR; PG8_WAIT_L(0); PG8_MMA(0, 0, At, B0); PG8_BAR; PG8_SCHED;
            PG8_LDB(B1, 1, 1); PG8_STAGE(PG8_SB(1, 0), b3, voffB);
            PG8_BAR; PG8_WAIT_L(0); PG8_MMA(0, 1, At, B1); PG8_BAR;
            PG8_LDA(At, 1, 1); PG8_STAGE(PG8_SA(1, 0), a3, voffA);
            PG8_BAR; PG8_WAIT_L(0); PG8_MMA(1, 0, At, B0); PG8_BAR; PG8_SCHED;
            PG8_STAGE(PG8_SB(1, 1), b3, voffB1);
            PG8_WAIT_V(6); PG8_BAR; PG8_MMA(1, 1, At, B1); PG8_BAR;
            }
        }
        if constexpr (ALIGN_EPI) { if (wr == 0) PG8_BAR; }
        if constexpr (!Epi::AFTER_DRAIN) { E(acc, cur, wr, wc, fr, fq); S.done(cur); }
        if (!has_next) break;
#pragma unroll
        for (int a = 0; a < 2; ++a)
#pragma unroll
            for (int b = 0; b < 2; ++b)
#pragma unroll
                for (int m = 0; m < 4; ++m)
#pragma unroll
                    for (int n = 0; n < 2; ++n) acc[a][b][m][n] = (f32x4){0.f, 0.f, 0.f, 0.f};
        cur = nxt; cA = nA; cB = nB; ++ui;
        if constexpr (ALIGN_EPI) { if (wr == 1) PG8_BAR; }
    }
    PG8_WAIT_V(0);
    if constexpr (!ALIGN_EPI) { if (wr == 0) PG8_BAR; }
    PG8_BAR;
    if constexpr (Epi::AFTER_DRAIN) { E.fused(acc, cur, wr, wc, fr, fq, lds, wid, lane); S.done(cur); }
#undef PG8_SA
#undef PG8_SB
#undef PG8_STAGE
#undef PG8_LDA
#undef PG8_LDB
#undef PG8_MMA
#undef PG8_WAIT_V
#undef PG8_WAIT_L
#undef PG8_BAR
#undef PG8_SCHED
}
}

struct EpiProj {
  static constexpr bool PERM = true, AFTER_DRAIN = false, HEADPERM = true;
  const float* gqa; const float* gka; const float* gqb; const float* gkb; unsigned char* ws;
  __device__ __forceinline__ void operator()(const pg8::f32x4 (&acc)[2][2][4][2], const pg8::Unit& u, int wr, int wc, int fr, int fq) const {
    const int nbase = u.pn * 256 + wc * 64;
    const int region = nbase >> 9, hw = (nbase & 511) >> 6;
    const float* g = (region == 0) ? gqa : (region == 1) ? gka : (region == 3) ? gqb : gkb;
    const bool normed = (region != 2 && region != 5);
    const float qs = (region == 0 || region == 3) ? C2 : 1.0f;
    u16* dstR = (u16*)(ws + WS_R + (size_t)region * R_REGION);
    f32x4 gv[2][2];
#pragma unroll
    for (int bj = 0; bj < 2; ++bj)
#pragma unroll
      for (int n = 0; n < 2; ++n) gv[bj][n] = normed ? *(const f32x4*)(g + 32 * bj + 8 * fq + 4 * n) : (f32x4){1.f, 1.f, 1.f, 1.f};
#pragma unroll
    for (int ai = 0; ai < 2; ++ai)
#pragma unroll
      for (int m = 0; m < 4; ++m) {
        const int t = u.pm * 256 + ai * 128 + wr * 64 + m * 16 + fr;
        int seq_start, S, sq; seq_of(t, seq_start, S, sq);
        float scale = 1.0f;
        if (normed) {
          float ss = 0.f;
#pragma unroll
          for (int bj = 0; bj < 2; ++bj)
#pragma unroll
            for (int n = 0; n < 2; ++n) { const f32x4 v = acc[ai][bj][m][n]; ss += v[0] * v[0] + v[1] * v[1] + v[2] * v[2] + v[3] * v[3]; }
          ss += __shfl_xor(ss, 16); ss += __shfl_xor(ss, 32);
          scale = __builtin_amdgcn_rsqf(ss * (1.0f / 64.0f) + NORM_EPS) * qs;
        }
        u16* dst;
        if (region != 5) dst = dstR + (size_t)seq_start * 512 + ((size_t)hw * S + sq) * 64;
        else dst = dstR + (size_t)seq_start * 512 + ((size_t)(hw >> 1) * S + sq) * 128 + (hw & 1) * 64;
#pragma unroll
        for (int bj = 0; bj < 2; ++bj) {
          const f32x4 v0 = acc[ai][bj][m][0] * scale * gv[bj][0], v1 = acc[ai][bj][m][1] * scale * gv[bj][1];
          u32x4 o; o[0] = pk2(v0[0], v0[1]); o[1] = pk2(v0[2], v0[3]); o[2] = pk2(v1[0], v1[1]); o[3] = pk2(v1[2], v1[3]);
          *(u32x4*)(dst + 32 * bj + 8 * fq) = o;
        }
      }
  }
};

DI void phase_proj(const Params& p, unsigned char* lds) {
  pg8::Gemm g{(const u16*)((const unsigned char*)p.out + OUT_N1), (const u16*)(p.ws + WS_WIN), T_TOK, 3072, 1024};
  pg8::StaticOrder S; S.init(T_TOK, 3072, (int)gridDim.x, (int)blockIdx.x);
  EpiProj E{p.q_norm_a, p.k_norm_a, p.q_norm_b, p.k_norm_b, p.ws};
  pg8::gemm_phase<EpiProj, pg8::StaticOrder, true, true>((PG8_LAS unsigned char*)lds, g, S, E);
}

constexpr int AL_STAGE = 0;
constexpr int AL_VT    = 0;
constexpr int AL_TAB   = 131072;
constexpr int AL_TABA  = 137216;
constexpr int AL_XL    = 150016;
constexpr int AL_MISC  = 151552;

DI unsigned voff_b(int row, int ch) { return 256u * row + 16u * (ch ^ (((row & 3) << 2) | ((row >> 2) & 3))); }

template <int VAR>
DI void diff_unit(const Params& p, unsigned char* lds, int seq_start, int S, int hd, int q0, float lam) {
  const int tid = threadIdx.x, lane = tid & 63, r32 = lane & 31, h = lane >> 5;
  const int w = __builtin_amdgcn_readfirstlane(tid >> 6);
  const int map = w >> 2, wq = w & 3;
  const u16* QBp = (const u16*)(p.ws + WS_R + 3 * R_REGION);
  const u16* KBp = (const u16*)(p.ws + WS_R + 4 * R_REGION);
  const u16* VBp = (const u16*)(p.ws + WS_R + 5 * R_REGION);
  const int qpos = q0 + wq * 32 + r32;
  const int qlo = q0 + wq * 32;
  const u16* Qp = QBp + (size_t)seq_start * 512 + ((size_t)(hd * 2 + map) * S + qpos) * 64;
  bf16x8 qf[4];
#pragma unroll
  for (int ks = 0; ks < 4; ++ks) qf[ks] = *(const bf16x8*)(Qp + ks * 16 + h * 8);
  const u16* K1g = KBp + (size_t)seq_start * 512 + ((size_t)(hd * 2 + 0) * S) * 64;
  const u16* K2g = KBp + (size_t)seq_start * 512 + ((size_t)(hd * 2 + 1) * S) * 64;
  const u16* Vg = VBp + (size_t)seq_start * 512 + ((size_t)hd * S) * 128;
  const float* tab = (const float*)(lds + AL_TAB);
  const float* misc = (const float*)(lds + AL_MISC);
  const float cAfter = misc[12 + hd];
  f32x16 O[4];
#pragma unroll
  for (int nb = 0; nb < 4; ++nb)
#pragma unroll
    for (int r = 0; r < 16; ++r) O[nb][r] = 0.f;
  float l = 0.f;
  const int kr_ = 8 * w + (lane >> 3), kc_ = (lane & 7) ^ ((kr_ >> 1) & 7);
  const u16* k1src = K1g + (size_t)kr_ * 64 + kc_ * 8;
  const u16* k2src = K2g + (size_t)kr_ * 64 + kc_ * 8;
  const u16* vsrc[2];
#pragma unroll
  for (int i = 0; i < 2; ++i) { const int row = 8 * w + 4 * i + (lane >> 4); const int pc = (lane & 15) ^ (((row & 3) << 2) | ((row >> 2) & 3)); vsrc[i] = Vg + (size_t)row * 128 + pc * 8; }
  const int NKT = S / 64;
  const int i16 = lane & 15, tq = i16 >> 2, tp = i16 & 3, blk = (lane >> 4) & 1;
  int kbase4[4], vbase[4][2];
#pragma unroll
  for (int ks = 0; ks < 4; ++ks) kbase4[ks] = r32 * 128 + (((2 * ks + h) ^ ((r32 >> 1) & 7)) << 4);
#pragma unroll
  for (int nb = 0; nb < 4; ++nb)
#pragma unroll
    for (int hi = 0; hi < 2; ++hi) vbase[nb][hi] = (int)voff_b(4 * h + tq + 8 * hi, 4 * nb + 2 * blk + (tp >> 1)) + 8 * (tp & 1);
#define DU_GLDS(gsrc_, ldsoff_) do { unsigned keep_; const unsigned dst_ = (unsigned)__builtin_amdgcn_readfirstlane((int)(ldsoff_)); \
    asm volatile("s_mov_b32 %0, m0\n\ts_mov_b32 m0, %2\n\ts_nop 0\n\tglobal_load_lds_dwordx4 %1, off\n\ts_mov_b32 m0, %0" : "=&s"(keep_) : "v"(gsrc_), "s"(dst_) : "memory"); } while (0)
#define DU_DMA(kt_, st_) do { const size_t ko_ = (size_t)(kt_) * 64 * 64, vo_ = (size_t)(kt_) * 64 * 128; const unsigned b_ = lds_base + AL_STAGE + (st_) * 32768; \
    DU_GLDS(k1src + ko_, b_ + w * 1024); DU_GLDS(k2src + ko_, b_ + 8192 + w * 1024); \
    DU_GLDS(vsrc[0] + vo_, b_ + 16384 + w * 2048); DU_GLDS(vsrc[1] + vo_, b_ + 16384 + w * 2048 + 1024); } while (0)
  const unsigned lds_base = (unsigned)(uintptr_t)lds;
#define SBAR() __builtin_amdgcn_sched_barrier(0)
#define DU_VRD(slot, f, so_) do { vlo[slot] = tr_read(vp[(f) >> 1][0] + (so_) + ((f) & 1) * 4096); vhi[slot] = tr_read(vp[(f) >> 1][1] + (so_) + ((f) & 1) * 4096); } while (0)
#define DU_SUB(A, B, kq2, kso2_, has_next2_, vso_, knext_, has_next_) do { \
    SBAR(); \
    s16x4 vlo[4], vhi[4]; \
    if (VAR != 2 && VAR != 4) { DU_VRD(0, 0, vso_); DU_VRD(1, 1, vso_); DU_VRD(2, 2, vso_); DU_VRD(3, 3, vso_); } \
    if (has_next_ && VAR != 3 && VAR != 4) { \
      f32x16 z_; _Pragma("unroll") for (int r = 0; r < 16; ++r) z_[r] = 0.f; \
      B = MFMA32(kf[0], qf[0], z_); B = MFMA32(kf[1], qf[1], B); B = MFMA32(kf[2], qf[2], B); B = MFMA32(kf[3], qf[3], B); } \
    float ls = 0.f; \
    _Pragma("unroll") for (int r = 0; r < 16; ++r) ls += A[r]; \
    l += ls; \
    bf16x8 pb[2]; \
    _Pragma("unroll") for (int s2 = 0; s2 < 2; ++s2) { \
      u32x4 pw; pw[0] = pk2(A[8 * s2 + 0], A[8 * s2 + 1]); pw[1] = pk2(A[8 * s2 + 2], A[8 * s2 + 3]); \
      pw[2] = pk2(A[8 * s2 + 4], A[8 * s2 + 5]); pw[3] = pk2(A[8 * s2 + 6], A[8 * s2 + 7]); \
      pb[s2] = __builtin_bit_cast(bf16x8, pw); } \
    SBAR(); \
    if ((has_next2_) && VAR != 3 && VAR != 4) { _Pragma("unroll") for (int ks = 0; ks < 4; ++ks) kf[ks] = *(const bf16x8*)(kq2[ks] + (kso2_)); } \
    if (has_next_) { \
      const int dmin_ = (knext_) - (qlo + 31), dmax_ = (knext_) + 31 - qlo; \
      if (dmin_ < 559) { \
        if (in_after) { in_after = false; _Pragma("unroll") for (int nb = 0; nb < 4; ++nb) _Pragma("unroll") for (int r = 0; r < 16; ++r) O[nb][r] *= fAfter; l *= fAfter; \
                        _Pragma("unroll") for (int s2 = 0; s2 < 2; ++s2) {   \
                          u32x4 pw; pw[0] = pk2(A[8 * s2 + 0] * fAfter, A[8 * s2 + 1] * fAfter); pw[1] = pk2(A[8 * s2 + 2] * fAfter, A[8 * s2 + 3] * fAfter); \
                          pw[2] = pk2(A[8 * s2 + 4] * fAfter, A[8 * s2 + 5] * fAfter); pw[3] = pk2(A[8 * s2 + 6] * fAfter, A[8 * s2 + 7] * fAfter); \
                          pb[s2] = __builtin_bit_cast(bf16x8, pw); } } \
        if (dmax_ > -559) { const int base_ = (knext_) + 4 * h - qpos + 640; \
          _Pragma("unroll") for (int r = 0; r < 16; ++r) B[r] += tab[base_ + (r & 3) + 8 * (r >> 2)]; } } } \
    _Pragma("unroll") for (int f = 0; f < 8; ++f) { \
      if (VAR != 2 && VAR != 4) { O[f >> 1] = MFMA32(cat8(vlo[f & 3], vhi[f & 3]), pb[f & 1], O[f >> 1]); \
      if (f + 4 < 8) DU_VRD(f & 3, f + 4, vso_); } \
      if (VAR != 1 && VAR != 4) { B[2 * f] = __builtin_amdgcn_exp2f(B[2 * f]); B[2 * f + 1] = __builtin_amdgcn_exp2f(B[2 * f + 1]); } } \
  } while (0)
  f32x16 X, Y; bf16x8 kf[4];
  const float fAfter = __builtin_amdgcn_exp2f(cAfter);
  bool in_after = true;
  const int KT1 = NKT - 1;
  DU_DMA(KT1, 0);
  if (NKT > 1) DU_DMA(KT1 - 1, 1);
  if (NKT > 2) DU_DMA(KT1 - 2, 2);
  if (NKT > 2) asm volatile("s_waitcnt vmcnt(8)" ::: "memory"); else asm volatile("s_waitcnt vmcnt(0)" ::: "memory");
  __syncthreads();
  {
    const unsigned char* kb_ = lds + AL_STAGE + map * 8192 + 4096;
    f32x16 z_;
#pragma unroll
    for (int r = 0; r < 16; ++r) z_[r] = 0.f;
    X = MFMA32(*(const bf16x8*)(kb_ + kbase4[0]), qf[0], z_); X = MFMA32(*(const bf16x8*)(kb_ + kbase4[1]), qf[1], X);
    X = MFMA32(*(const bf16x8*)(kb_ + kbase4[2]), qf[2], X); X = MFMA32(*(const bf16x8*)(kb_ + kbase4[3]), qf[3], X);
    const int knext = 64 * KT1 + 32;
    const int dmin_ = knext - (qlo + 31), dmax_ = knext + 31 - qlo;
    if (dmin_ < 559) {
      in_after = false;
      if (dmax_ > -559) { const int base_ = knext + 4 * h - qpos + 640;
#pragma unroll
        for (int r = 0; r < 16; ++r) X[r] += tab[base_ + (r & 3) + 8 * (r >> 2)]; }
    }
#pragma unroll
    for (int r = 0; r < 16; ++r) X[r] = __builtin_amdgcn_exp2f(X[r]);
#pragma unroll
    for (int ks = 0; ks < 4; ++ks) kf[ks] = *(const bf16x8*)(lds + AL_STAGE + map * 8192 + kbase4[ks]);
  }
  if (map == 1) __builtin_amdgcn_s_setprio(1);
  int st_cur = 0, st_nxt = 32768, st_nx2 = 65536, st_free = 98304;
  for (int i = 0; i < NKT; ++i) {
    const int kt = KT1 - i;
    if (i + 2 < NKT) asm volatile("s_waitcnt vmcnt(4)" ::: "memory"); else asm volatile("s_waitcnt vmcnt(0)" ::: "memory");
    __syncthreads();
    if (i + 3 < NKT) DU_DMA(kt - 3, st_free / 32768);
    const unsigned char* knx[4]; const unsigned char* vp[4][2];
#pragma unroll
    for (int ks = 0; ks < 4; ++ks) knx[ks] = lds + AL_STAGE + st_nxt + map * 8192 + kbase4[ks];
#pragma unroll
    for (int nb = 0; nb < 4; ++nb) { vp[nb][0] = lds + AL_STAGE + st_cur + 16384 + vbase[nb][0]; vp[nb][1] = lds + AL_STAGE + st_cur + 16384 + vbase[nb][1]; }
    DU_SUB(X, Y, knx, 4096, (i + 1 < NKT), 8192, 64 * kt, true);
    DU_SUB(Y, X, knx, 0, (i + 1 < NKT), 0, 64 * kt - 32, (i + 1 < NKT));
    { const int t_ = st_cur; st_cur = st_nxt; st_nxt = st_nx2; st_nx2 = st_free; st_free = t_; }
  }
  __builtin_amdgcn_s_setprio(0);
#undef DU_DMA
#undef DU_GLDS
#undef DU_VRD
#undef DU_SUB
#undef SBAR
  if (in_after) {
#pragma unroll
    for (int nb = 0; nb < 4; ++nb)
#pragma unroll
      for (int r = 0; r < 16; ++r) O[nb][r] *= fAfter;
    l *= fAfter;
  }
  if (VAR != 0) {
#pragma unroll
    for (int nb = 0; nb < 4; ++nb) asm volatile("" :: "v"(O[nb]));
    asm volatile("" :: "v"(l), "v"(X), "v"(Y));
    __syncthreads();
    return;
  }
  __syncthreads();
  float ltot = l + __shfl_xor(l, 32);
  float* xbuf = (float*)(lds + AL_STAGE);
  if (map == 1) {
    const float inv = 1.0f / ltot;
#pragma unroll
    for (int nb = 0; nb < 4; ++nb)
#pragma unroll
      for (int r = 0; r < 16; ++r) xbuf[((wq * 64 + nb * 16 + r) << 6) + lane] = O[nb][r] * inv;
  }
  __syncthreads();
  if (map == 0) {
    const float inv = 1.0f / ltot;
    float ss = 0.f;
#pragma unroll
    for (int nb = 0; nb < 4; ++nb)
#pragma unroll
      for (int r = 0; r < 16; ++r) {
        float o = O[nb][r] * inv - lam * xbuf[((wq * 64 + nb * 16 + r) << 6) + lane];
        O[nb][r] = o; ss += o * o;
      }
    ss += __shfl_xor(ss, 32);
    const float rn = __builtin_amdgcn_rsqf(ss * (1.0f / 128.0f) + NORM_EPS) * 0.8f;
    u16* mix = (u16*)((unsigned char*)p.out + OUT_MIX) + (size_t)(seq_start + qpos) * 1024 + 512 + hd * 128;
#pragma unroll
    for (int nb = 0; nb < 4; ++nb)
#pragma unroll
      for (int g4 = 0; g4 < 4; ++g4) {
        const int d0 = 32 * nb + 8 * g4 + 4 * h;
        f32x4 gg = *(const f32x4*)(p.diff_norm_g + d0);
        u32x2 o; o[0] = pk2(O[nb][4 * g4 + 0] * rn * gg[0], O[nb][4 * g4 + 1] * rn * gg[1]);
        o[1] = pk2(O[nb][4 * g4 + 2] * rn * gg[2], O[nb][4 * g4 + 3] * rn * gg[3]);
        *(u32x2*)(mix + d0) = o;
      }
  }
  __syncthreads();
}

constexpr int AL_DPART = 65536;
constexpr int AL_DL    = AL_TAB;
template <int PASS>
DI void dil_wave_item(const Params& p, unsigned char* lds, int seq_start, int S, int hd, int i0, int sel) {
  const int tid = threadIdx.x, lane = tid & 63, r32 = lane & 31, h = lane >> 5;
  const int w = __builtin_amdgcn_readfirstlane(tid >> 6);
  const u16* QAp = (const u16*)(p.ws + WS_R + 0 * R_REGION);
  const u16* KAp = (const u16*)(p.ws + WS_R + 1 * R_REGION);
  const u16* VAp = (const u16*)(p.ws + WS_R + 2 * R_REGION);
  constexpr int QSTR = (PASS == 1) ? 1 : 16;
  constexpr int NTILE = (PASS == 1) ? 5 : 13;
  const int qbase = (PASS == 1) ? i0 + 32 * sel : i0 + sel;
  const int qpos = qbase + QSTR * r32;
  const int tl = qpos - i0;
  const u16* Qp = QAp + (size_t)seq_start * 512 + ((size_t)hd * S + qpos) * 64;
  bf16x8 qf[4];
#pragma unroll
  for (int ks = 0; ks < 4; ++ks) qf[ks] = *(const bf16x8*)(Qp + ks * 16 + h * 8);
  const u16* Kg = KAp + (size_t)seq_start * 512 + ((size_t)hd * S) * 64;
  const u16* Vg = VAp + (size_t)seq_start * 512 + ((size_t)hd * S) * 64;
  unsigned char* vt = lds + AL_VT + w * 8192;
  unsigned char* ktl = vt + 4096;
  const float* tabA = (const float*)(lds + AL_TABA) + hd * 3 * 132;
  unsigned char* dpart = lds + AL_DPART;
  float* dl = (float*)(lds + AL_DL);
  const int psw = ((tl >> 4) ^ tl) & 15;
  f32x16 O[2];
  float l = 0.f;
  if (PASS == 1) {
#pragma unroll
    for (int nb = 0; nb < 2; ++nb)
#pragma unroll
      for (int r = 0; r < 16; ++r) O[nb][r] = 0.f;
  } else {
#pragma unroll
    for (int nb = 0; nb < 2; ++nb)
#pragma unroll
      for (int g4 = 0; g4 < 4; ++g4) {
        const int ch = 8 * nb + 2 * g4 + h;
        const u32x2 v = *(const u32x2*)(dpart + tl * 128 + ((ch ^ psw) << 3));
        O[nb][4 * g4 + 0] = __uint_as_float(v[0] << 16); O[nb][4 * g4 + 1] = __uint_as_float(v[0] & 0xffff0000u);
        O[nb][4 * g4 + 2] = __uint_as_float(v[1] << 16); O[nb][4 * g4 + 3] = __uint_as_float(v[1] & 0xffff0000u);
      }
    if (h == 0) l = dl[tl];
  }
  const int i16 = lane & 15, tq = i16 >> 2, tp = i16 & 3, blk = (lane >> 4) & 1;
  int vrb[2][2];
#pragma unroll
  for (int nb = 0; nb < 2; ++nb)
#pragma unroll
    for (int hi = 0; hi < 2; ++hi) {
      const int R = 4 * h + tq + 8 * hi; const int ch = 4 * nb + 2 * blk + (tp >> 1);
      const int sw = (((R >> 1) & 1) << 2) ^ ((R >> 2) & 3);
      vrb[nb][hi] = R * 128 + ((ch ^ sw) << 4) + 8 * (tp & 1);
    }
  bf16x8 kfb[1][4]; u32x4 vcb[1][4];
  const int lrow = lane >> 3, lch = lane & 7;
#define DL_PARAMS(tau_) \
    const int d_ = (PASS == 1) ? 1 : (((tau_) < 5) ? 16 : 4); const int br_ = (PASS == 1) ? 2 : (((tau_) < 5) ? 0 : 1); \
    const int tt_ = (PASS == 1) ? (tau_) : (((tau_) < 5) ? (tau_) : (tau_) - 5); const int ratio_ = QSTR / d_; \
    const int n0_ = -64 + 32 * tt_;
#define DL_LOAD(buf, tau_) do { DL_PARAMS(tau_) \
    _Pragma("unroll") for (int i4 = 0; i4 < 4; ++i4) { int kpos_ = qbase + d_ * (n0_ + 8 * i4 + lrow); kpos_ = kpos_ < 0 ? 0 : (kpos_ >= S ? S - 1 : kpos_); \
      kfb[buf][i4] = *(const bf16x8*)(Kg + (size_t)kpos_ * 64 + lch * 8); vcb[buf][i4] = *(const u32x4*)(Vg + (size_t)kpos_ * 64 + lch * 8); } (void)br_; (void)ratio_; } while (0)
#define DL_STORE(buf) do { \
    _Pragma("unroll") for (int i4 = 0; i4 < 4; ++i4) { const int row_ = 8 * i4 + lrow; const int sw_ = (((row_ >> 1) & 1) << 2) ^ ((row_ >> 2) & 3); \
      *(u32x4*)(vt + row_ * 128 + ((lch ^ sw_) << 4)) = vcb[buf][i4]; \
      *(bf16x8*)(ktl + row_ * 128 + ((lch ^ ((row_ >> 1) & 7)) << 4)) = kfb[buf][i4]; } } while (0)
#define DL_COMPUTE(buf, tau_) do { DL_PARAMS(tau_) \
    const int kfirst_ = qbase + d_ * n0_, klast_ = qbase + d_ * (n0_ + 31); \
    const int base_ = n0_ + 4 * h - ratio_ * r32; const float* tb_ = tabA + br_ * 132; \
    f32x16 sT; \
    _Pragma("unroll") for (int r = 0; r < 16; ++r) { int dd = base_ + (r & 3) + 8 * (r >> 2); dd = dd < -65 ? -65 : (dd > 65 ? 65 : dd); sT[r] = tb_[dd + 65]; } \
    if (kfirst_ < 0 || klast_ >= S) { _Pragma("unroll") for (int r = 0; r < 16; ++r) { const int kp = qbase + d_ * (n0_ + crow(r, h)); if (kp < 0 || kp >= S) sT[r] = NEG_BIG; } } \
    _Pragma("unroll") for (int ks = 0; ks < 4; ++ks) { const bf16x8 ka_ = *(const bf16x8*)(ktl + r32 * 128 + (((2 * ks + h) ^ ((r32 >> 1) & 7)) << 4)); sT = MFMA32(ka_, qf[ks], sT); } \
    float ls = 0.f; \
    _Pragma("unroll") for (int r = 0; r < 16; ++r) { sT[r] = __builtin_amdgcn_exp2f(sT[r]); ls += sT[r]; } \
    l += ls; \
    bf16x8 pb[2]; \
    _Pragma("unroll") for (int s2 = 0; s2 < 2; ++s2) { \
      u32x4 pw; pw[0] = pk2(sT[8 * s2 + 0], sT[8 * s2 + 1]); pw[1] = pk2(sT[8 * s2 + 2], sT[8 * s2 + 3]); \
      pw[2] = pk2(sT[8 * s2 + 4], sT[8 * s2 + 5]); pw[3] = pk2(sT[8 * s2 + 6], sT[8 * s2 + 7]); \
      pb[s2] = __builtin_bit_cast(bf16x8, pw); } \
    _Pragma("unroll") for (int nb = 0; nb < 2; ++nb) _Pragma("unroll") for (int s2 = 0; s2 < 2; ++s2) { \
        const s16x4 lo = tr_read(vt + vrb[nb][0] + s2 * 2048); const s16x4 hi = tr_read(vt + vrb[nb][1] + s2 * 2048); \
        O[nb] = MFMA32(cat8(lo, hi), pb[s2], O[nb]); } \
  } while (0)
  DL_LOAD(0, 0);
#pragma unroll 1
  for (int tau = 0; tau < NTILE; ++tau) {
    DL_STORE(0);
    { const int tn = (tau + 1 < NTILE) ? tau + 1 : tau; DL_LOAD(0, tn); }
    DL_COMPUTE(0, tau);
  }
#undef DL_PARAMS
#undef DL_LOAD
#undef DL_STORE
#undef DL_COMPUTE
  const float ltot = l + __shfl_xor(l, 32);
  if (PASS == 1) {
#pragma unroll
    for (int nb = 0; nb < 2; ++nb)
#pragma unroll
      for (int g4 = 0; g4 < 4; ++g4) {
        const int ch = 8 * nb + 2 * g4 + h;
        u32x2 o; o[0] = pk2(O[nb][4 * g4 + 0], O[nb][4 * g4 + 1]); o[1] = pk2(O[nb][4 * g4 + 2], O[nb][4 * g4 + 3]);
        *(u32x2*)(dpart + tl * 128 + ((ch ^ psw) << 3)) = o;
      }
    if (h == 0) dl[tl] = ltot;
  } else {
    const float inv = 1.0f / ltot;
    u16* mix = (u16*)((unsigned char*)p.out + OUT_MIX) + (size_t)(seq_start + qpos) * 1024 + hd * 64;
#pragma unroll
    for (int nb = 0; nb < 2; ++nb)
#pragma unroll
      for (int g4 = 0; g4 < 4; ++g4) {
        const int d0 = 32 * nb + 8 * g4 + 4 * h;
        u32x2 o; o[0] = pk2(O[nb][4 * g4 + 0] * inv, O[nb][4 * g4 + 1] * inv); o[1] = pk2(O[nb][4 * g4 + 2] * inv, O[nb][4 * g4 + 3] * inv);
        *(u32x2*)(mix + d0) = o;
      }
  }
}

DI void phase_attn(const Params& p, unsigned char* lds) {
  const int tid = threadIdx.x;
  float* misc = (float*)(lds + AL_MISC);
  if (tid == 0) {
    float gqa = 0.f, gka = 0.f, gqb = 0.f, gkb = 0.f, bm = 0.f;
    for (int i = 0; i < 64; ++i) { gqa = fmaxf(gqa, fabsf(p.q_norm_a[i])); gka = fmaxf(gka, fabsf(p.k_norm_a[i])); gqb = fmaxf(gqb, fabsf(p.q_norm_b[i])); gkb = fmaxf(gkb, fabsf(p.k_norm_b[i])); }
    for (int i = 0; i < 32 * 12; ++i) bm = fmaxf(bm, fabsf(p.rel_bias[i]));
    const float M2 = 8.0f * LOG2E * fmaxf(gqa * gka, gqb * gkb) * 1.02f + bm * LOG2E + 0.1f;
    float s1 = 0.f, s2 = 0.f;
    for (int i = 0; i < 64; ++i) { s1 += p.lq1[i] * p.lk1[i]; s2 += p.lq2[i] * p.lk2[i]; }
    misc[0] = M2; misc[1] = expf(s1) - expf(s2) + 0.2f;
    for (int hd = 0; hd < 4; ++hd) { misc[8 + hd] = p.rel_bias[15 * 12 + 8 + hd] * LOG2E; misc[12 + hd] = (p.rel_bias[31 * 12 + 8 + hd] - p.rel_bias[15 * 12 + 8 + hd]) * LOG2E; }
  }
  __syncthreads();
  const float M2 = misc[0], lam = misc[1];
  {
    float* tabA = (float*)(lds + AL_TABA);
    for (int i = tid; i < 8 * 3 * 132; i += NTHR) {
      int hd = i / 396, rem = i % 396, br = rem / 132, idx = rem % 132;
      int dl = idx - 65; float v = NEG_BIG;
      if (dl >= -64 && dl <= 64 && idx < 131) { int d = (br == 0) ? 16 : (br == 1) ? 4 : 1; v = p.rel_bias[rel_bucket(dl * d) * 12 + hd] * LOG2E - M2; }
      tabA[i] = v;
    }
  }
#ifndef REP_DIFF
#define REP_DIFF 1
#endif
#ifndef REP_DIL
#define REP_DIL 1
#endif
  int cur_hd = -1;
  for (int rep_ = 0; rep_ < REP_DIFF; ++rep_)
  for (int vb = blockIdx.x; vb < 256; vb += gridDim.x) {
    const int xl = vb & 7, rk = vb >> 3;
#pragma unroll 1
    for (int rnd = 0; rnd < 8; ++rnd) {
      int seq_start, S, hd, q0;
      if (rnd < 4) { const int pair = xl + 8 * rnd; hd = pair & 3; S = 4096; seq_start = (pair >> 2) * 4096; q0 = rk * 128; }
      else { const int pair = 8 * xl + 2 * (rnd - 4) + (rk >> 4); hd = pair & 3; S = 2048; seq_start = T_PROMPT + (pair >> 2) * 2048; q0 = (rk & 15) * 128; }
      if (hd != cur_hd) {
        __syncthreads();
        float* tab = (float*)(lds + AL_TAB);
        for (int i = tid; i < 1281; i += NTHR) tab[i] = p.rel_bias[rel_bucket(i - 640) * 12 + 8 + hd] * LOG2E - misc[8 + hd];
        cur_hd = hd;
        __syncthreads();
      }
#ifndef PROBE_VAR
#define PROBE_VAR 0
#endif
      if (rep_ == 0) diff_unit<0>(p, lds, seq_start, S, hd, q0, lam); else diff_unit<PROBE_VAR>(p, lds, seq_start, S, hd, q0, lam);
    }
  }
  __syncthreads();
  const int w = tid >> 6;
  for (int rep_ = 0; rep_ < REP_DIL; ++rep_)
  for (int vb = blockIdx.x; vb < 256; vb += gridDim.x)
#pragma unroll 1
  for (int rnd = 0; rnd < 4; ++rnd) {
    const int xl = vb & 7, rk = vb >> 3;
    int seq_start, S, hd, i0;
    if (rnd < 2) { const int pair = xl * 8 + rnd * 4 + (rk >> 3); hd = pair & 7; S = 4096; seq_start = (pair >> 3) * 4096; i0 = (rk & 7) * 512; }
    else { const int pair = xl * 16 + (rnd - 2) * 8 + (rk >> 2); hd = pair & 7; S = 2048; seq_start = T_PROMPT + (pair >> 3) * 2048; i0 = (rk & 3) * 512; }
    __syncthreads();
#pragma unroll 1
    for (int u2 = 0; u2 < 2; ++u2) dil_wave_item<1>(p, lds, seq_start, S, hd, i0, w + 8 * u2);
    __syncthreads();
#pragma unroll 1
    for (int u2 = 0; u2 < 2; ++u2) dil_wave_item<2>(p, lds, seq_start, S, hd, i0, w + 8 * u2);
  }
}

struct EpiOut {
  static constexpr bool PERM = false, AFTER_DRAIN = false, HEADPERM = false;
  const float* xp; const float* xs; u16* x1;
  __device__ __forceinline__ void operator()(const pg8::f32x4 (&acc)[2][2][4][2], const pg8::Unit& u, int wr, int wc, int fr, int fq) const {
    const int col0 = u.pn * 256 + wc * 32 + 4 * fq;
#pragma unroll
    for (int ai = 0; ai < 2; ++ai)
#pragma unroll
      for (int m = 0; m < 4; ++m) {
        const int t = u.pm * 256 + ai * 128 + wr * 64 + m * 16 + fr;
        const float* xr = ((t < T_PROMPT) ? xp + (size_t)t * DM : xs + (size_t)(t - T_PROMPT) * DM) + col0;
        u16* orow = x1 + (size_t)t * DM + col0;
#pragma unroll
        for (int bj = 0; bj < 2; ++bj)
#pragma unroll
          for (int n = 0; n < 2; ++n) {
            const f32x4 xv = *(const f32x4*)(xr + bj * 128 + n * 16);
            const f32x4 sv_ = xv + acc[ai][bj][m][n];
            u32x2 o; o[0] = pk2(sv_[0], sv_[1]); o[1] = pk2(sv_[2], sv_[3]);
            *(u32x2*)(orow + bj * 128 + n * 16) = o;
          }
      }
  }
};

DI void phase_outproj(const Params& p, unsigned char* lds) {
  pg8::Gemm g{(const u16*)((const unsigned char*)p.out + OUT_MIX), (const u16*)(p.ws + WS_WOUT), T_TOK, 1024, 1024};
  pg8::StaticOrder S; S.init(T_TOK, 1024, (int)gridDim.x, (int)blockIdx.x);
  EpiOut E{p.x_prompt, p.x_sample, (u16*)(p.ws + WS_X1)};
  pg8::gemm_phase<EpiOut, pg8::StaticOrder, true, true>((PG8_LAS unsigned char*)lds, g, S, E);
}

DI void phase_norm2(const Params& p) {
  const int tid = threadIdx.x, lane = tid & 63, w = tid >> 6;
  const u16* x1 = (const u16*)(p.ws + WS_X1);
  u16* hb = (u16*)(p.ws + WS_H);
  float* hamax = (float*)(p.ws + WS_MISC + MISC_HAMAX);
  for (int it = blockIdx.x; it < T_TOK / 16; it += gridDim.x) {
    const int t = it * 16 + w, t2 = t + 8;
    norm_row2<true>(x1 + (size_t)t * DM, x1 + (size_t)t2 * DM, p.ffn_norm_g, hb + (size_t)t * DM, hb + (size_t)t2 * DM, lane, hamax + t, hamax + t2);
  }
}

struct EpiQp {
  static constexpr bool PERM = true, AFTER_DRAIN = false, HEADPERM = false;
  u16* O;
  __device__ __forceinline__ void operator()(const pg8::f32x4 (&acc)[2][2][4][2], const pg8::Unit& u, int wr, int wc, int fr, int fq) const {
    const int col0 = u.pn * 256 + wc * 32 + 8 * fq;
#pragma unroll
    for (int ai = 0; ai < 2; ++ai)
#pragma unroll
      for (int m = 0; m < 4; ++m) {
        const int t = u.pm * 256 + ai * 128 + wr * 64 + m * 16 + fr;
        u16* rowp = O + (size_t)t * 2048 + col0;
#pragma unroll
        for (int bj = 0; bj < 2; ++bj) {
          const f32x4 v0 = acc[ai][bj][m][0], v1 = acc[ai][bj][m][1];
          u32x4 o; o[0] = pk2(v0[0], v0[1]); o[1] = pk2(v0[2], v0[3]); o[2] = pk2(v1[0], v1[1]); o[3] = pk2(v1[2], v1[3]);
          *(u32x4*)(rowp + bj * 128) = o;
        }
      }
  }
};

DI void phase_peer_query(const Params& p, unsigned char* lds) {
  pg8::Gemm g{(const u16*)(p.ws + WS_H), (const u16*)(p.ws + WS_WQ), T_TOK, 2048, 1024};
  pg8::StaticOrder S; S.init(T_TOK, 2048, (int)gridDim.x, (int)blockIdx.x);
  EpiQp E{(u16*)p.out};
  pg8::gemm_phase<EpiQp, pg8::StaticOrder, true, true>((PG8_LAS unsigned char*)lds, g, S, E);
}

DI int f2sort(float f) { const int b = __float_as_int(f); return b ^ ((b >> 31) & 0x7fffffff); }
DI float sort2f(int s) { return __int_as_float(s ^ ((s >> 31) & 0x7fffffff)); }
#define CE_DESC(a, b) do { const int mx_ = max((a), (b)), mn_ = min((a), (b)); (a) = mx_; (b) = mn_; } while (0)
#define CE_ASC(a, b) do { const int mx_ = max((a), (b)), mn_ = min((a), (b)); (a) = mn_; (b) = mx_; } while (0)
template <int OFF> DI void sort16_desc(int (&x)[64]) {
#pragma unroll
  for (int k = 2; k <= 16; k <<= 1)
#pragma unroll
    for (int j = k >> 1; j > 0; j >>= 1)
#pragma unroll
      for (int i = 0; i < 16; ++i) {
        const int l = i ^ j;
        if (l > i) { if ((i & k) == 0) CE_DESC(x[OFF + i], x[OFF + l]); else CE_ASC(x[OFF + i], x[OFF + l]); }
      }
}
template <int A, int B> DI void merge16x(int (&x)[64]) {
#pragma unroll
  for (int i = 0; i < 16; ++i) x[A + i] = max(x[A + i], x[B + 15 - i]);
#pragma unroll
  for (int j = 8; j > 0; j >>= 1)
#pragma unroll
    for (int i = 0; i < 16; ++i) { const int l = i ^ j; if (l > i) CE_DESC(x[A + i], x[A + l]); }
}

DI void pack_hq(unsigned w0, unsigned w1, unsigned w2, unsigned w3, float sc, unsigned& HH, unsigned& LL) {
  const float MAGIC = 12582912.0f + 136.0f;
  const unsigned y0 = __float_as_uint(__builtin_fmaf(__uint_as_float(w0 << 16), sc, MAGIC)), y1 = __float_as_uint(__builtin_fmaf(__uint_as_float(w0 & 0xffff0000u), sc, MAGIC));
  const unsigned y2 = __float_as_uint(__builtin_fmaf(__uint_as_float(w1 << 16), sc, MAGIC)), y3 = __float_as_uint(__builtin_fmaf(__uint_as_float(w1 & 0xffff0000u), sc, MAGIC));
  const unsigned y4 = __float_as_uint(__builtin_fmaf(__uint_as_float(w2 << 16), sc, MAGIC)), y5 = __float_as_uint(__builtin_fmaf(__uint_as_float(w2 & 0xffff0000u), sc, MAGIC));
  const unsigned y6 = __float_as_uint(__builtin_fmaf(__uint_as_float(w3 << 16), sc, MAGIC)), y7 = __float_as_uint(__builtin_fmaf(__uint_as_float(w3 & 0xffff0000u), sc, MAGIC));
  const unsigned W = (y0 & 255u) | ((y1 & 255u) << 8) | ((y2 & 255u) << 16) | (y3 << 24);
  const unsigned X = (y4 & 255u) | ((y5 & 255u) << 8) | ((y6 & 255u) << 16) | (y7 << 24);
  HH = (((W >> 4) & 0x0F0F0F0Fu) | (X & 0xF0F0F0F0u)) ^ 0x88888888u;
  LL = ((W & 0x0F0F0F0Fu) | ((X << 4) & 0xF0F0F0F0u)) ^ 0x88888888u;
}
DI void quantise_h_rows(const Params& p, int t0, int lane) {
  const float* hamax = (const float*)(p.ws + WS_MISC + MISC_HAMAX);
  unsigned char* Hrow = p.ws + WS_H;
#pragma unroll 1
  for (int rr = 0; rr < 32; rr += 4) {
    u32x4 ha[4], hb[4]; float sc[4];
#pragma unroll
    for (int q = 0; q < 4; ++q) {
      const unsigned char* src = Hrow + (size_t)(t0 + rr + q) * 2048 + lane * 32;
      ha[q] = *(const u32x4*)src; hb[q] = *(const u32x4*)(src + 16);
      const float am = hamax[t0 + rr + q];
      sc[q] = (am > 0.f) ? 119.0f / am : 0.f;
    }
#pragma unroll
    for (int q = 0; q < 4; ++q) {
      unsigned h0, l0, h1, l1;
      pack_hq(ha[q][0], ha[q][1], ha[q][2], ha[q][3], sc[q], h0, l0);
      pack_hq(hb[q][0], hb[q][1], hb[q][2], hb[q][3], sc[q], h1, l1);
      u32x2 hi, lo; hi[0] = h0; hi[1] = h1; lo[0] = l0; lo[1] = l1;
      unsigned char* dst = Hrow + (size_t)(t0 + rr + q) * 2048 + (lane >> 4) * 256 + (lane & 15) * 8;
      *(u32x2*)dst = hi; *(u32x2*)(dst + 128) = lo;
    }
  }
}

DI void phase_peer_route(const Params& p, unsigned char* lds) {
  const u16* QP = (const u16*)p.out;
  const u16* SK = (const u16*)(p.ws + WS_SK);
  u16* eidx = (u16*)(p.ws + WS_EIDX);
  float* gg = (float*)(p.ws + WS_G);
  const int tid = threadIdx.x, lane = tid & 63, r32 = lane & 31, h = lane >> 5;
  const int w = __builtin_amdgcn_readfirstlane(tid >> 6);
  unsigned char* SKl = lds;
  float* v2l = (float*)(lds + 65536);
  __syncthreads();
#pragma unroll
  for (int i = 0; i < 8; ++i) {
    const int c = tid + 512 * i; const int zz = c >> 11, row = (c >> 4) & 127, ch = c & 15;
    const u32x4 v = *(const u32x4*)(SK + (size_t)zz * 16384 + row * 128 + ch * 8);
    *(u32x4*)(SKl + zz * 32768 + row * 256 + ((ch ^ (row & 15)) << 4)) = v;
  }
  __syncthreads();
  for (int item = blockIdx.x; item < T_TOK / 256; item += gridDim.x) {
    quantise_h_rows(p, item * 256 + w * 32, lane);
    const int t = item * 256 + w * 32 + r32;
    const u16* qrow = QP + (size_t)t * 2048;
    bf16x8 qf[8];
#pragma unroll
    for (int ks = 0; ks < 8; ++ks) qf[ks] = *(const bf16x8*)(qrow + ks * 16 + h * 8);
#pragma unroll 1
    for (int pp = 0; pp < 8; ++pp) {
      int lists[2][16];
#pragma unroll
      for (int z = 0; z < 2; ++z) {
        const int c16 = pp * 2 + z;
        int x[64];
        {
          f32x16 S2[4];
#pragma unroll
          for (int kb = 0; kb < 4; ++kb)
#pragma unroll
            for (int r = 0; r < 16; ++r) S2[kb][r] = 0.f;
#pragma unroll
          for (int ks = 0; ks < 8; ++ks)
#pragma unroll
            for (int kb = 0; kb < 4; ++kb) {
              const int key = kb * 32 + r32;
              const bf16x8 a = *(const bf16x8*)(SKl + z * 32768 + key * 256 + (((2 * ks + h) ^ (key & 15)) << 4));
              S2[kb] = MFMA32(a, qf[ks], S2[kb]);
            }
          {
            const int cn = (c16 + 1 < 16) ? c16 + 1 : 15;
#pragma unroll
            for (int ks = 0; ks < 8; ++ks) qf[ks] = *(const bf16x8*)(qrow + cn * 128 + ks * 16 + h * 8);
          }
#pragma unroll
          for (int e = 0; e < 64; ++e) {
            const int kidx = 32 * (e >> 4) + (e & 3) + 8 * ((e & 15) >> 2) + 4 * h;
            x[e] = (f2sort(S2[e >> 4][e & 15]) & ~127) | kidx;
          }
        }
        sort16_desc<0>(x); sort16_desc<16>(x); sort16_desc<32>(x); sort16_desc<48>(x);
        merge16x<0, 16>(x); merge16x<32, 48>(x); merge16x<0, 32>(x);
#pragma unroll
        for (int i = 0; i < 16; ++i) x[16 + i] = __shfl_xor(x[i], 32);
        merge16x<0, 16>(x);
#pragma unroll
        for (int i = 0; i < 16; ++i) lists[z][i] = x[i];
      }
      float v1h[8];
#pragma unroll
      for (int i = 0; i < 8; ++i) { const int a0_ = lists[0][i], a1_ = lists[0][8 + i]; v1h[i] = sort2f(a0_ ^ ((a0_ ^ a1_) & -h)); }
#pragma unroll
      for (int i = 0; i < 16; ++i) v2l[i * 512 + tid] = sort2f(lists[1][i]);
      unsigned ptrs = 0u;
      float bestv[16]; int be[16];
#pragma unroll
      for (int rd = 0; rd < 16; ++rd) {
        float best = -3.0e38f, bv1 = 0.f, bv2 = 0.f; int ab = 0;
#pragma unroll
        for (int a = 0; a < 8; ++a) {
          const int b = (int)((ptrs >> (4 * a)) & 15u);
          const float v2 = v2l[b * 512 + tid];
          const float cnd = v1h[a] + v2;
          if (cnd > best) { best = cnd; ab = a; bv1 = v1h[a]; bv2 = v2; }
        }
        const float obest = __shfl_xor(best, 32), obv1 = __shfl_xor(bv1, 32), obv2 = __shfl_xor(bv2, 32);
        const bool mine = h ? (best > obest) : (best >= obest);
        const float wbest = mine ? best : obest, w1 = mine ? bv1 : obv1, w2 = mine ? bv2 : obv2;
        bestv[rd] = wbest; be[rd] = (f2sort(w1) & 127) * 128 + (f2sort(w2) & 127);
        if (mine) ptrs += 1u << (4 * ab);
      }
      if (h == 0) {
        float ex[16]; float sum = 0.f;
#pragma unroll
        for (int rd = 0; rd < 16; ++rd) { ex[rd] = __expf(bestv[rd] - bestv[0]); sum += ex[rd]; }
        const float inv = 1.0f / sum;
        const size_t oo = ((size_t)t * 8 + pp) * 16;
#pragma unroll
        for (int q4 = 0; q4 < 4; ++q4) { f32x4 v = {ex[4 * q4] * inv, ex[4 * q4 + 1] * inv, ex[4 * q4 + 2] * inv, ex[4 * q4 + 3] * inv}; *(f32x4*)(gg + oo + 4 * q4) = v; }
        u32x4 e0, e1;
#pragma unroll
        for (int j = 0; j < 4; ++j) { e0[j] = (unsigned)be[2 * j] | ((unsigned)be[2 * j + 1] << 16); e1[j] = (unsigned)be[8 + 2 * j] | ((unsigned)be[8 + 2 * j + 1] << 16); }
        *(u32x4*)(eidx + oo) = e0; *(u32x4*)(eidx + oo + 8) = e1;
      }
    }
  }
}

typedef float f2_t __attribute__((ext_vector_type(2)));
DI unsigned xcc_id() { return (unsigned)__builtin_amdgcn_s_getreg((3 << 11) | 20) & 7u; }
constexpr int PG_CHUNK_TOK = 64;
constexpr int PG_NCHUNK = T_TOK / PG_CHUNK_TOK;

DI void dec32(const u32x4& r, f2_t (&v)[16]) {
#pragma unroll
  for (int d = 0; d < 4; ++d) {
    v[4 * d + 0] = __builtin_amdgcn_cvt_scalef32_pk_f32_fp4(r[d], 1.0f, 0); v[4 * d + 1] = __builtin_amdgcn_cvt_scalef32_pk_f32_fp4(r[d], 1.0f, 1);
    v[4 * d + 2] = __builtin_amdgcn_cvt_scalef32_pk_f32_fp4(r[d], 1.0f, 2); v[4 * d + 3] = __builtin_amdgcn_cvt_scalef32_pk_f32_fp4(r[d], 1.0f, 3);
  }
}

template <int CTRL> DI float dpp_f(float x) { return __int_as_float(__builtin_amdgcn_update_dpp(0, __float_as_int(x), CTRL, 0xf, 0xf, true)); }
DI int idx16(const u32x4& a, const u32x4& b, int i) { const unsigned wd = (i < 8) ? a[(i & 7) >> 1] : b[(i & 7) >> 1]; return (i & 1) ? (int)(wd >> 16) : (int)(wd & 0xffffu); }
constexpr int PEER_NT = 16;
template <int WHICH>
DI void peer_wave_tokens(const Params& p, int x, int tb, int lane) {
  const unsigned char* TBL = p.ws + (WHICH ? WS_V : WS_U) + (size_t)x * 16384 * 128;
  const u16* Hb = (const u16*)(p.ws + WS_H);
  const u16* eidx = (const u16*)(p.ws + WS_EIDX);
  const u16* w16 = (const u16*)(p.ws + WS_W16);
  const float* x1 = (const float*)(p.ws + WS_X1);
  float* zpart = (float*)(p.ws + WS_ZP);
  const int r = lane >> 3, c = lane & 7;
  u32x4 ei[2][2]; u32x4 wv[2][2]; u32x4 rows[2][16]; u32x4 hsl[2][2];
#define PEER_LOAD_IDX(buf, k) do { const size_t o_ = (size_t)(tb + (k)) * 128 + r * 16; \
    ei[buf][0] = *(const u32x4*)(eidx + o_); ei[buf][1] = *(const u32x4*)(eidx + o_ + 8); \
    if (WHICH) { wv[buf][0] = *(const u32x4*)(w16 + o_); wv[buf][1] = *(const u32x4*)(w16 + o_ + 8); } } while (0)
#define PEER_LOAD_ROWS4(buf, ibuf, g) do { _Pragma("unroll") for (int ii_ = 0; ii_ < 4; ++ii_) { \
      const unsigned off_ = (unsigned)idx16(ei[ibuf][0], ei[ibuf][1], 4 * (g) + ii_) * 128u + (unsigned)c * 16u; \
      rows[buf][4 * (g) + ii_] = *(const u32x4*)(TBL + off_); } } while (0)
#define PEER_LOAD_ROWS(buf, ibuf) do { PEER_LOAD_ROWS4(buf, ibuf, 0); PEER_LOAD_ROWS4(buf, ibuf, 1); PEER_LOAD_ROWS4(buf, ibuf, 2); PEER_LOAD_ROWS4(buf, ibuf, 3); } while (0)
#define PEER_NEXT4(g) do { __builtin_amdgcn_sched_barrier(0); if (k + 1 < PEER_NT) PEER_LOAD_ROWS4((k + 1) & 1, (k + 1) & 1, g); __builtin_amdgcn_sched_barrier(0); } while (0)
#define PEER_LOAD_H(buf, k) do { if (WHICH == 0) { const unsigned char* hq_ = (const unsigned char*)Hb + (size_t)(tb + (k)) * 2048 + x * 256 + c * 16;     \
    hsl[buf][0] = *(const u32x4*)(hq_); hsl[buf][1] = *(const u32x4*)(hq_ + 128); } } while (0)
  PEER_LOAD_IDX(0, 0); PEER_LOAD_IDX(1, 1);
  PEER_LOAD_H(0, 0);
  PEER_LOAD_ROWS(0, 0);
#pragma unroll
  for (int k = 0; k < PEER_NT; ++k) {
    const int t = tb + k;
    u32x4 wcur[2];
    if (WHICH) { wcur[0] = wv[k & 1][0]; wcur[1] = wv[k & 1][1]; }
    if (k + 2 < PEER_NT) PEER_LOAD_IDX(k & 1, k + 2);
    if (k + 1 < PEER_NT) PEER_LOAD_H((k + 1) & 1, k + 1);
    if (WHICH == 0) {
      const u32x4 hh = hsl[k & 1][0], hl = hsl[k & 1][1];
      float sv[16];
#pragma unroll
      for (int i = 0; i < 16; ++i) {
        if ((i & 3) == 0) PEER_NEXT4(i >> 2);
        int ah = __builtin_amdgcn_sdot8((int)rows[k & 1][i][0], (int)hh[0], 0, false);
        int al = __builtin_amdgcn_sdot8((int)rows[k & 1][i][0], (int)hl[0], 0, false);
        ah = __builtin_amdgcn_sdot8((int)rows[k & 1][i][1], (int)hh[1], ah, false);
        al = __builtin_amdgcn_sdot8((int)rows[k & 1][i][1], (int)hl[1], al, false);
        ah = __builtin_amdgcn_sdot8((int)rows[k & 1][i][2], (int)hh[2], ah, false);
        al = __builtin_amdgcn_sdot8((int)rows[k & 1][i][2], (int)hl[2], al, false);
        ah = __builtin_amdgcn_sdot8((int)rows[k & 1][i][3], (int)hh[3], ah, false);
        al = __builtin_amdgcn_sdot8((int)rows[k & 1][i][3], (int)hl[3], al, false);
        int a = ah * 16 + al;
        a += __builtin_amdgcn_update_dpp(0, a, 0xB1, 0xf, 0xf, true);
        a += __builtin_amdgcn_update_dpp(0, a, 0x4E, 0xf, 0xf, true);
        a += __builtin_amdgcn_update_dpp(0, a, 0x141, 0xf, 0xf, true);
        sv[i] = (float)a;
      }
      float o0 = 0.f, o1 = 0.f;
#pragma unroll
      for (int i = 0; i < 8; ++i) { if (c == i) { o0 = sv[i]; o1 = sv[i + 8]; } }
      float* zp = zpart + ((size_t)x * T_TOK + t) * 128 + r * 16;
      zp[c] = o0; zp[c + 8] = o1;
    } else {
      f2_t acc[16];
#pragma unroll
      for (int q = 0; q < 16; ++q) { acc[q][0] = 0.f; acc[q][1] = 0.f; }
#pragma unroll
      for (int i = 0; i < 16; ++i) {
        if ((i & 3) == 0) PEER_NEXT4(i >> 2);
        f2_t v[16]; dec32(rows[k & 1][i], v);
        const unsigned wd_ = wcur[i >> 3][(i & 7) >> 1];
        const float wj = (i & 1) ? __uint_as_float(wd_ & 0xffff0000u) : __uint_as_float(wd_ << 16);
        f2_t ww = {wj, wj};
#pragma unroll
        for (int q = 0; q < 16; ++q) acc[q] = __builtin_elementwise_fma(v[q], ww, acc[q]);
      }
      f2_t b8[8];
      {
        const bool up = (lane & 32) != 0;
#pragma unroll
        for (int q = 0; q < 8; ++q) {
          f2_t keep = up ? acc[8 + q] : acc[q], send = up ? acc[q] : acc[8 + q];
          f2_t got; got[0] = __shfl_xor(send[0], 32); got[1] = __shfl_xor(send[1], 32);
          b8[q] = keep + got;
        }
      }
      f2_t b4[4];
      {
        const bool up = (lane & 16) != 0;
#pragma unroll
        for (int q = 0; q < 4; ++q) {
          f2_t keep = up ? b8[4 + q] : b8[q], send = up ? b8[q] : b8[4 + q];
          f2_t got; got[0] = __shfl_xor(send[0], 16); got[1] = __shfl_xor(send[1], 16);
          b4[q] = keep + got;
        }
      }
      f2_t b2[2];
      {
        const bool up = (lane & 8) != 0;
#pragma unroll
        for (int q = 0; q < 2; ++q) {
          f2_t keep = up ? b4[2 + q] : b4[q], send = up ? b4[q] : b4[2 + q];
          f2_t got; got[0] = dpp_f<0x128>(send[0]); got[1] = dpp_f<0x128>(send[1]);
          b2[q] = keep + got;
        }
      }
      const size_t o = (size_t)t * DM + x * 256 + c * 32 + 4 * r;
      const f32x4 xv = *(const f32x4*)(x1 + o);
      f32x4 res; res[0] = xv[0] + b2[0][0]; res[1] = xv[1] + b2[0][1]; res[2] = xv[2] + b2[1][0]; res[3] = xv[3] + b2[1][1];
      *(f32x4*)(p.out + o) = res;
    }
  }
#undef PEER_LOAD_IDX
#undef PEER_LOAD_H
#undef PEER_LOAD_ROWS
#undef PEER_LOAD_ROWS4
#undef PEER_NEXT4
}

typedef int v8i_t __attribute__((ext_vector_type(8)));
template <int NTOK, int VAR = 0>
DI void peer_tokens_v(const Params& p, unsigned char* ldsw, int t0, int lane) {
  const unsigned char* TBL = p.ws + WS_V;
  const u16* eidx = (const u16*)(p.ws + WS_EIDX);
  const unsigned char* w8 = p.ws + WS_W16;
  const u16* x1 = (const u16*)(p.ws + WS_X1);
  const int j = lane & 31, kg = lane >> 5;
  unsigned M[4];
#pragma unroll
  for (int q = 0; q < 4; ++q) M[q] = (kg == (j >> 4) && ((j & 15) >> 2) == q) ? (0xFFu << (8 * (j & 3))) : 0u;
  u32x4 ei[2][2]; u32x4 wv[2][2]; u32x4 rows[2][16];
#define PV_LOAD_IDX(u) do { const size_t o_ = (size_t)(t0 + ((u) >> 2)) * 128 + 16 * ((u) & 3); \
    ei[(u) & 1][0] = *(const u32x4*)(eidx + o_ + 64 * kg); ei[(u) & 1][1] = *(const u32x4*)(eidx + o_ + 64 * kg + 8); } while (0)
#define PV_LOAD_W(u) do { const size_t o_ = (size_t)(t0 + ((u) >> 2)) * 128 + 16 * ((u) & 3); \
    wv[(u) & 1][0] = *(const u32x4*)(w8 + o_); wv[(u) & 1][1] = *(const u32x4*)(w8 + o_ + 64); } while (0)
#define PV_IDX(ibuf, n) (((n) & 1) ? (ei[ibuf][(n) >> 3][((n) & 7) >> 1] >> 16) : (ei[ibuf][(n) >> 3][((n) & 7) >> 1] & 0xffffu))
#define PV_LOAD_ROWS4(u, g) do { _Pragma("unroll") for (int ii_ = 0; ii_ < 4; ++ii_) { \
      const unsigned off_ = (unsigned)PV_IDX((u) & 1, 4 * (g) + ii_) * 512u + (unsigned)j * 16u; \
      rows[(u) & 1][4 * (g) + ii_] = *(const u32x4*)(TBL + off_); } } while (0)
  constexpr int NU = 4 * NTOK;
  PV_LOAD_IDX(0); PV_LOAD_IDX(1); PV_LOAD_W(0);
  PV_LOAD_ROWS4(0, 0); PV_LOAD_ROWS4(0, 1); PV_LOAD_ROWS4(0, 2); PV_LOAD_ROWS4(0, 3);
  PV_LOAD_ROWS4(1, 0); PV_LOAD_ROWS4(1, 1); PV_LOAD_ROWS4(1, 2); PV_LOAD_ROWS4(1, 3);
  PV_LOAD_IDX(2);
  f32x16 acc; f32x4 xv[4];
  constexpr int XV_AT = 3;
#pragma unroll
  for (int u = 0; u < NU; ++u) {
    const int t = t0 + (u >> 2), c = u & 3;
    if (c == 0) {
#pragma unroll
      for (int r = 0; r < 16; ++r) acc[r] = 0.f;
    }
    if (c == 2 && VAR != 1) {
#pragma unroll
      for (int rq = 0; rq < 2; ++rq) {
        const u16* gsrc_ = x1 + (size_t)t * DM + 512 * rq + 8 * lane;
        unsigned keep_; const unsigned dst_ = (unsigned)__builtin_amdgcn_readfirstlane((int)((unsigned)(uintptr_t)ldsw + 1024u * rq));
        asm volatile("s_mov_b32 %0, m0\n\ts_mov_b32 m0, %2\n\ts_nop 0\n\tglobal_load_lds_dwordx4 %1, off\n\ts_mov_b32 m0, %0" : "=&s"(keep_) : "v"(gsrc_), "s"(dst_) : "memory");
      }
    }
    if (u + 3 < NU) PV_LOAD_IDX(u + 3);
    if (u + 1 < NU) PV_LOAD_W(u + 1);
#pragma unroll
    for (int n = 0; n < 16; ++n) {
      const unsigned wd1 = wv[u & 1][0][n >> 2], wd2 = wv[u & 1][1][n >> 2];
      const unsigned rep1 = __builtin_amdgcn_perm(wd1, wd1, 0x01010101u * (unsigned)(n & 3));
      const unsigned rep2 = __builtin_amdgcn_perm(wd2, wd2, 0x01010101u * (unsigned)(n & 3));
      v8i_t A, B;
#pragma unroll
      for (int q = 0; q < 4; ++q) { A[q] = (int)(rep1 & M[q]); A[4 + q] = (int)(rep2 & M[q]); }
      B[0] = (int)rows[u & 1][n][0]; B[1] = (int)rows[u & 1][n][1]; B[2] = (int)rows[u & 1][n][2]; B[3] = (int)rows[u & 1][n][3];
      B[4] = 0; B[5] = 0; B[6] = 0; B[7] = 0;
      acc = __builtin_amdgcn_mfma_scale_f32_32x32x64_f8f6f4(A, B, acc, 0  , 4  , 0, 0x7F7F7F7F, 0, 0x7F7F7F7F);
      if ((n & 3) == 3) {
        __builtin_amdgcn_sched_barrier(0);
        if (u + 2 < NU) PV_LOAD_ROWS4(u + 2, n >> 2);
        __builtin_amdgcn_sched_barrier(0);
      }
    }
    if (c == 3) {
      if (VAR != 1) {
        static_assert(NTOK == 4, "the vmcnt immediate below is counted for 16-chunk units");
        if (u + 3 < NU) asm volatile("s_waitcnt vmcnt(40)" ::: "memory");
        else asm volatile("s_waitcnt vmcnt(0)" ::: "memory");
#pragma unroll
        for (int rq = 0; rq < 4; ++rq) {
          const u32x2 r_ = *(const u32x2*)(ldsw + 2 * (32 * j + 8 * rq + 4 * kg));
          xv[rq][0] = __uint_as_float(r_[0] << 16); xv[rq][1] = __uint_as_float(r_[0] & 0xffff0000u); xv[rq][2] = __uint_as_float(r_[1] << 16); xv[rq][3] = __uint_as_float(r_[1] & 0xffff0000u);
        }
      }
#pragma unroll
      for (int rq = 0; rq < 4; ++rq) {
        const size_t o = (size_t)t * DM + 32 * j + 8 * rq + 4 * kg;
        f32x4 res;
#pragma unroll
        for (int q = 0; q < 4; ++q) res[q] = (VAR != 1 ? xv[rq][q] : 0.f) + acc[4 * rq + q] * (1.0f / 2048.0f);
        if (VAR != 1 || res[0] == 123456.789f) *(f32x4*)(p.out + o) = res;
      }
    }
  }
#undef PV_LOAD_IDX
#undef PV_LOAD_W
#undef PV_IDX
#undef PV_LOAD_ROWS4
}
DI void peer_act_range(const Params& p, size_t q_lo, size_t q_hi, int lane) {
  const float* zpart = (const float*)(p.ws + WS_ZP);
  const u16* eidx = (const u16*)(p.ws + WS_EIDX);
  float* wg = (float*)(p.ws + WS_G);
  const float* suinv = (const float*)(p.ws + WS_MISC + MISC_SUINV);
  const float* svinv = (const float*)(p.ws + WS_MISC + MISC_SVINV);
  const float* hamax = (const float*)(p.ws + WS_MISC + MISC_HAMAX);
#pragma unroll 4
  for (size_t i4 = q_lo + lane; i4 < q_hi; i4 += 64) {
    const size_t i = i4 * 4;
    f32x4 z = *(const f32x4*)(zpart + i);
#pragma unroll
    for (int x = 1; x < 4; ++x) { const f32x4 zz = *(const f32x4*)(zpart + (size_t)x * T_TOK * 128 + i); z[0] += zz[0]; z[1] += zz[1]; z[2] += zz[2]; z[3] += zz[3]; }
    const u32x2 ee = *(const u32x2*)(eidx + i);
    const f32x4 g4 = *(const f32x4*)(wg + i);
    const float hs = hamax[i >> 7] * (1.0f / 119.0f);
    float wq[4];
#pragma unroll
    for (int q = 0; q < 4; ++q) {
      const int e = (int)((q & 1) ? (ee[q >> 1] >> 16) : (ee[q >> 1] & 0xffffu));
      const float zq = z[q] * suinv[e] * hs;
      const float act = 0.5f * zq * (1.0f + erff(zq * 0.70710678118654752f));
      wq[q] = fminf(fmaxf(g4[q] * act * svinv[e] * 2048.0f, -448.0f), 448.0f);
    }
    int pk = __builtin_amdgcn_cvt_pk_fp8_f32(wq[0], wq[1], 0, false);
    pk = __builtin_amdgcn_cvt_pk_fp8_f32(wq[2], wq[3], pk, true);
    *(unsigned*)(p.ws + WS_W16 + i) = (unsigned)pk;
  }
}

template <int VAR = 0>
DI void phase_peer_v(const Params& p, unsigned char* lds) {
  const int tid = threadIdx.x, lane = tid & 63;
  const int w = __builtin_amdgcn_readfirstlane(tid >> 6);
  const int gw = blockIdx.x * 8 + w, nw = gridDim.x * 8;
  const int per = (T_TOK / 4 + nw - 1) / nw;
  const int u_lo = gw * per, u_hi = (u_lo + per < T_TOK / 4) ? u_lo + per : T_TOK / 4;
  if (u_lo >= u_hi) return;
  if (VAR == 0) {
    peer_act_range(p, (size_t)u_lo * 4 * 32, (size_t)u_hi * 4 * 32, lane);
    asm volatile("s_waitcnt vmcnt(0)" ::: "memory");
    __builtin_amdgcn_fence(__ATOMIC_ACQUIRE, "agent");
    asm volatile("s_waitcnt vmcnt(0)" ::: "memory");
  }
#pragma unroll 1
  for (int u = u_lo; u < u_hi; ++u) peer_tokens_v<4, VAR>(p, lds + w * 4096, u * 4, lane);
}

template <int WHICH>
DI void phase_peer_sliced(const Params& p, unsigned char* lds) {
  const int tid = threadIdx.x, lane = tid & 63, w = tid >> 6;
  const unsigned* rankctr = (const unsigned*)(p.ws + WS_MISC + MISC_QCTR) + 16;
  volatile PG8_LAS unsigned* st = (volatile PG8_LAS unsigned*)(lds + LDS_BARST);
  int myx = (int)st[9], myr = (int)st[8];
  int n[8]; int tot = 0;
#pragma unroll
  for (int j = 0; j < 8; ++j) { n[j] = (int)__hip_atomic_load(rankctr + j, __ATOMIC_RELAXED, __HIP_MEMORY_SCOPE_AGENT); tot += n[j]; }
  if (tot != (int)gridDim.x || st[10] != 1u) {
    myx = blockIdx.x & 7; myr = blockIdx.x >> 3;
#pragma unroll
    for (int j = 0; j < 8; ++j) n[j] = ((int)gridDim.x + 7 - j) >> 3;
  }
#pragma unroll 1
  for (int s = 0; s < 8; ++s) {
    int owner = s;
#pragma unroll
    for (int d = 0; d < 8; ++d) { if (n[owner & 7] == 0) owner = (owner + 1) & 7; }
    owner &= 7;
    if (owner != myx) continue;
    int nblk = 0;
#pragma unroll
    for (int j = 0; j < 8; ++j) nblk = (j == myx) ? n[j] : nblk;
    const int nw = nblk * 8, wr = myr * 8 + w;
    constexpr int NU = T_TOK / 2 / PEER_NT;
    const int u0 = (int)(((long long)wr * NU) / nw) + (s >> 2) * NU, u1 = (int)(((long long)(wr + 1) * NU) / nw) + (s >> 2) * NU;
#pragma unroll 1
    for (int u = u0; u < u1; ++u) peer_wave_tokens<WHICH>(p, s & 3, u * PEER_NT, lane);
  }
}

#define XB_TMO      128
#define XB_XCNT(j)  (256  + 64 * (j))
#define XB_XSUB(j)  (1280 + 64 * (j))
#define XB_XGEN(j)  (2304 + 64 * (j))
#define XB_TOP      3328
#define XB_TOPGEN   3392
#define XCD_BAR_WORDS 3456
#define XB_SPIN_CAP (1u << 18)
#define LAS __attribute__((address_space(3)))

__device__ __forceinline__ unsigned xb_ld(unsigned* p)              { return __hip_atomic_load(p, __ATOMIC_RELAXED, __HIP_MEMORY_SCOPE_AGENT); }
__device__ __forceinline__ unsigned xb_add(unsigned* p, unsigned v) { return __hip_atomic_fetch_add(p, v, __ATOMIC_RELAXED, __HIP_MEMORY_SCOPE_AGENT); }
__device__ __forceinline__ unsigned xb_xcc_id() { return (unsigned)__builtin_amdgcn_s_getreg((3 << 11) | 20) & 0xFu; }
#define XB_SPIN(cond, bar) do { unsigned _sp = 0; while (cond) { __builtin_amdgcn_s_sleep(1); \
    if ((++_sp & 255u) == 0u) { if (xb_ld(&(bar)[XB_TMO])) break; if (_sp > XB_SPIN_CAP) { atomicAdd(&(bar)[XB_TMO], 1u); break; } } } } while (0)

struct XcdBarrier {
    unsigned* bar; unsigned x;
    volatile LAS unsigned* st;
};

__device__ __forceinline__ XcdBarrier xcd_barrier_post(unsigned* bar, volatile LAS unsigned* st) {
    XcdBarrier b; b.bar = bar; b.x = xb_xcc_id(); b.st = st;
    if (threadIdx.x == 0) (void)xb_add(&bar[XB_XCNT(b.x)], 1u);
    return b;
}
__device__ __forceinline__ void xcd_barrier_complete(unsigned* bar, unsigned x, unsigned& nloc, unsigned& nx) {
    const unsigned G = gridDim.x * gridDim.y * gridDim.z;
    unsigned sum, cnt, mine, sp = 0u;
    for (;;) {
        sum = 0u; cnt = 0u; mine = 0u;
#pragma unroll
        for (unsigned j = 0; j < 16; ++j) { const unsigned c = xb_ld(&bar[XB_XCNT(j)]); sum += c; cnt += (c > 0u) ? 1u : 0u; mine = (j == x) ? c : mine; }
        if (sum == G) break;
        __builtin_amdgcn_s_sleep(1);
        if ((++sp & 255u) == 0u) { if (xb_ld(&bar[XB_TMO])) break; if (sp > XB_SPIN_CAP) { atomicAdd(&bar[XB_TMO], 1u); break; } }
    }
    nloc = mine > 0u ? mine : 1u; nx = cnt > 0u ? cnt : 1u;
}

__device__ __forceinline__ void xcd_barrier(const XcdBarrier& b) {
    asm volatile("s_waitcnt vmcnt(0)" ::: "memory");
    __syncthreads();
    if (threadIdx.x == 0) {
        unsigned* bar = b.bar;
        __builtin_amdgcn_s_waitcnt(0);
        unsigned nloc = b.st[0], nx = b.st[1];
        if (nloc == 0u) { xcd_barrier_complete(bar, b.x, nloc, nx); b.st[0] = nloc; b.st[1] = nx; }
        const unsigned old = xb_add(&bar[XB_XSUB(b.x)], 1u);
        const unsigned gen = old / nloc;
        if (old + 1u == (gen + 1u) * nloc) {
            __builtin_amdgcn_fence(__ATOMIC_RELEASE, "agent");
            asm volatile("s_waitcnt vmcnt(0)" ::: "memory");
            const unsigned og = xb_add(&bar[XB_TOP], 1u);
            const unsigned tg = og / nx;
            if (og + 1u == (tg + 1u) * nx) xb_add(&bar[XB_TOPGEN], 1u);
            else XB_SPIN(xb_ld(&bar[XB_TOPGEN]) == tg, bar);
            __builtin_amdgcn_fence(__ATOMIC_ACQUIRE, "agent");
            xb_add(&bar[XB_XGEN(b.x)], 1u);
            asm volatile("s_waitcnt vmcnt(0)" ::: "memory");
        } else {
            XB_SPIN(xb_ld(&bar[XB_XGEN(b.x)]) == gen, bar);
            __builtin_amdgcn_fence(__ATOMIC_ACQUIRE, "agent");
            asm volatile("s_waitcnt vmcnt(0)" ::: "memory");
        }
    }
    __syncthreads();
}


__global__ void __launch_bounds__(NTHR, 2) fwd_kernel(Params p) {
  extern __shared__ __attribute__((aligned(16))) unsigned char lds[];
  cg::grid_group grid = cg::this_grid();
#ifndef ONLY_PH
#define PHON(k) 1
#else
#define PHON(k) ((k) == ONLY_PH)
#endif
#ifndef REPEAT_MASK
#define REPEAT_MASK 0
#endif
#define GSYNC(k) do { if ((k) == 0) { grid.sync(); xbar = xcd_barrier_post((unsigned*)(p.ws + WS_MISC + MISC_BAR), (volatile LAS unsigned*)(lds + LDS_BARST)); \
    if (threadIdx.x == 0) { volatile LAS unsigned* st_ = (volatile LAS unsigned*)(lds + LDS_BARST); const unsigned x_ = xcc_id(); \
      st_[8] = atomicAdd((unsigned*)(p.ws + WS_MISC + MISC_QCTR) + 16 + x_, 1u); st_[9] = x_; st_[10] = 1u; } \
    __syncthreads(); } else xcd_barrier(xbar); } while (0)
#define RUN_PHASE(k, call) do { if (PHON(k) && lo <= (k) && (k) < hi) { call; if ((REPEAT_MASK >> (k)) & 1) { grid.sync(); call; } } if (lo <= (k) && (k) + 1 < hi) GSYNC(k); } while (0)
  const int lo = p.ph_lo, hi = p.ph_hi;
  if (threadIdx.x < 16) ((volatile LAS unsigned*)(lds + LDS_BARST))[threadIdx.x] = 0u;
  __syncthreads();
  XcdBarrier xbar; xbar.bar = (unsigned*)(p.ws + WS_MISC + MISC_BAR); xbar.x = 0; xbar.st = (volatile LAS unsigned*)(lds + LDS_BARST);
  RUN_PHASE(0, phase_prep(p, lds));
  RUN_PHASE(1, phase_proj(p, lds));
  RUN_PHASE(2, phase_attn(p, lds));
  RUN_PHASE(3, phase_outproj(p, lds));
  RUN_PHASE(4, phase_norm2(p));
  RUN_PHASE(5, phase_peer_query(p, lds));
  RUN_PHASE(6, phase_peer_route(p, lds));
  RUN_PHASE(7, phase_peer_sliced<0>(p, lds));
#ifndef PROBE_PEER
#define PROBE_PEER 0
#endif
  if (PROBE_PEER & 1) { xcd_barrier(xbar); phase_peer_sliced<0>(p, lds); xcd_barrier(xbar); }
  RUN_PHASE(9, phase_peer_v<0>(p, lds));
#ifdef PROBE_VAR9
  grid.sync(); phase_peer_v<PROBE_VAR9>(p, lds);
#endif
  if (PROBE_PEER & 2) { xcd_barrier(xbar); phase_peer_v<0>(p, lds); }
}

extern "C" void kernel_launch(void* const* d_in, const int* in_sizes, int n_in, void* d_out, int out_size, void* d_ws, size_t ws_size, hipStream_t stream) {
  static int grid_blocks = 0;
  if (grid_blocks == 0) {
    if (n_in != 20 || ws_size < WS_END || out_size != T_TOK * DM) {
      fprintf(stderr, "kernel_launch: unexpected problem shape (n_in %d, ws %zu, out %d)\n", n_in, ws_size, out_size);
      grid_blocks = -1; return;
    }
    int dev = 0, cus = 0, per_cu = 0;
    hipGetDevice(&dev);
    hipDeviceGetAttribute(&cus, hipDeviceAttributeMultiprocessorCount, dev);
    hipFuncSetAttribute((const void*)fwd_kernel, hipFuncAttributeMaxDynamicSharedMemorySize, LDS_BYTES);
    hipOccupancyMaxActiveBlocksPerMultiprocessor(&per_cu, (const void*)fwd_kernel, NTHR, LDS_BYTES);
    if (per_cu < 1) { fprintf(stderr, "kernel_launch: occupancy query says %d blocks/CU\n", per_cu); per_cu = 1; }
    grid_blocks = cus;
    (void)hipGetLastError();
  }
  if (grid_blocks < 0) return;
  Params p{};
  p.x_prompt = (const float*)d_in[0]; p.x_sample = (const float*)d_in[1]; p.rel_bias = (const float*)d_in[2]; p.attn_norm_g = (const float*)d_in[3];
  p.w_in = (const float*)d_in[4]; p.q_norm_a = (const float*)d_in[5]; p.k_norm_a = (const float*)d_in[6]; p.q_norm_b = (const float*)d_in[7];
  p.k_norm_b = (const float*)d_in[8]; p.lq1 = (const float*)d_in[9]; p.lk1 = (const float*)d_in[10]; p.lq2 = (const float*)d_in[11];
  p.lk2 = (const float*)d_in[12]; p.diff_norm_g = (const float*)d_in[13]; p.w_out = (const float*)d_in[14]; p.ffn_norm_g = (const float*)d_in[15];
  p.peer_w_q = (const float*)d_in[16]; p.peer_sub_keys = (const float*)d_in[17]; p.peer_u = (const float*)d_in[18]; p.peer_v = (const float*)d_in[19];
  p.out = (float*)d_out; p.ws = (unsigned char*)d_ws;
#if FUSED
  p.ph_lo = 0; p.ph_hi = NPHASE;
  void* args[] = {&p};
  hipError_t e = hipLaunchCooperativeKernel((const void*)fwd_kernel, dim3(grid_blocks), dim3(NTHR), args, LDS_BYTES, stream);
  if (e != hipSuccess) fprintf(stderr, "cooperative launch failed: %s (grid %d)\n", hipGetErrorString(e), grid_blocks);
#else
  for (int ph = 0; ph < NPHASE; ++ph) {
    p.ph_lo = ph; p.ph_hi = ph + 1;
    hipLaunchKernelGGL(fwd_kernel, dim3(grid_blocks), dim3(NTHR), LDS_BYTES, stream, p);
  }
#endif
}
```

```cpp
#include <hip/hip_runtime.h>
#include <hip/hip_cooperative_groups.h>
#include <cstdio>
#include <cstdint>
namespace cg = cooperative_groups;

#ifndef FUSED
#define FUSED 1
#endif

typedef unsigned short u16;
typedef __attribute__((ext_vector_type(8))) short bf16x8;
typedef __attribute__((ext_vector_type(4))) short s16x4;
typedef __attribute__((ext_vector_type(16))) float f32x16;
typedef __attribute__((ext_vector_type(4))) float f32x4;
typedef __attribute__((ext_vector_type(4))) unsigned u32x4;
typedef __attribute__((ext_vector_type(2))) unsigned u32x2;
typedef __attribute__((address_space(3))) unsigned char* ldsp_t;

#define DI __device__ __forceinline__
#define MFMA32(a, b, c) __builtin_amdgcn_mfma_f32_32x32x16_bf16((a), (b), (c), 0, 0, 0)

constexpr int DM = 1024;
constexpr int T_TOK = 65536;
constexpr int T_PROMPT = 32768;
constexpr int NTHR = 512;
constexpr int NPHASE = 10;
constexpr float NORM_EPS = 1e-6f;
constexpr float LOG2E = 1.4426950408889634f;
constexpr float C2 = 0.125f * LOG2E;
constexpr float NEG_BIG = -1.0e30f;

constexpr size_t WS_WIN  = 0;
constexpr size_t WS_WOUT = WS_WIN + (size_t)3072 * 1024 * 2;
constexpr size_t WS_WQ   = WS_WOUT + (size_t)1024 * 1024 * 2;
constexpr size_t WS_SK   = WS_WQ + (size_t)2048 * 1024 * 2;
constexpr size_t WS_U    = WS_SK + (size_t)2 * 128 * 128 * 2;
constexpr size_t WS_V    = WS_U + (size_t)16384 * 1024 * 2;
constexpr size_t WS_W16  = WS_V + (size_t)16384 * 1024;
constexpr size_t WS_MISC = WS_V + (size_t)16384 * 1024 * 2;
constexpr size_t MISC_SUINV = 0, MISC_SVINV = 65536, MISC_QCTR = 131072, MISC_BAR = 196608, MISC_HAMAX = 524288;
constexpr size_t WS_R    = WS_MISC + (size_t)1048576;
constexpr size_t R_REGION = (size_t)T_TOK * 512 * 2;
constexpr size_t WS_X1   = WS_R;
constexpr size_t WS_ZP   = WS_R + (size_t)T_TOK * 1024 * 2;
constexpr size_t WS_H    = WS_R + (size_t)T_TOK * 1024 * 4;
constexpr size_t WS_EIDX = WS_R + 6 * R_REGION;
constexpr size_t WS_G    = WS_EIDX + (size_t)T_TOK * 128 * 2;
constexpr size_t WS_END  = WS_G + (size_t)T_TOK * 128 * 4;
static_assert(WS_END <= (size_t)536870912, "workspace map exceeds 512 MiB");
constexpr size_t OUT_N1 = 0, OUT_MIX = 134217728, OUT_TV = 0, OUT_TI = 67108864;

constexpr int LDS_BYTES = 163840;
constexpr int LDS_BARST = 163840 - 256;

struct Params {
  const float* x_prompt; const float* x_sample; const float* rel_bias; const float* attn_norm_g; const float* w_in;
  const float* q_norm_a; const float* k_norm_a; const float* q_norm_b; const float* k_norm_b;
  const float* lq1; const float* lk1; const float* lq2; const float* lk2; const float* diff_norm_g; const float* w_out;
  const float* ffn_norm_g; const float* peer_w_q; const float* peer_sub_keys; const float* peer_u; const float* peer_v;
  float* out; unsigned char* ws; int ph_lo; int ph_hi;
};

DI u16 f2bf(float f) { unsigned u = __float_as_uint(f); u += 0x7fffu + ((u >> 16) & 1u); return (u16)(u >> 16); }
DI float bf2f(u16 b) { return __uint_as_float(((unsigned)b) << 16); }
DI unsigned pk2(float lo, float hi) {
  typedef float f2_t __attribute__((ext_vector_type(2)));
  typedef __bf16 b2_t __attribute__((ext_vector_type(2)));
  f2_t v = {lo, hi}; b2_t b = __builtin_convertvector(v, b2_t); return __builtin_bit_cast(unsigned, b);
}
DI int crow(int reg, int h) { return (reg & 3) + 8 * (reg >> 2) + 4 * h; }
DI float wave_sum(float v) {
#pragma unroll
  for (int o = 32; o > 0; o >>= 1) v += __shfl_xor(v, o);
  return v;
}
DI void seq_of(int t, int& seq_start, int& S, int& s) {
  if (t < T_PROMPT) { S = 4096; seq_start = t & ~4095; s = t & 4095; }
  else { S = 2048; seq_start = t & ~2047; s = t & 2047; }
}
DI const float* x_row(const Params& p, int t) {
  return (t < T_PROMPT) ? p.x_prompt + (size_t)t * DM : p.x_sample + (size_t)(t - T_PROMPT) * DM;
}
DI int rel_bucket(int rel) {
  int n = rel < 0 ? -rel : rel;
  int b;
  if (n < 8) b = n;
  else if (n < 15) b = 8; else if (n < 27) b = 9; else if (n < 50) b = 10; else if (n < 91) b = 11;
  else if (n < 166) b = 12; else if (n < 305) b = 13; else if (n < 559) b = 14; else b = 15;
  return (rel > 0 ? 16 : 0) + b;
}
DI s16x4 tr_read(const unsigned char* p) {
  typedef short v4i16_t __attribute__((ext_vector_type(4)));
  return __builtin_bit_cast(s16x4, __builtin_amdgcn_ds_read_tr16_b64_v4i16((__attribute__((address_space(3))) v4i16_t*)p));
}
DI bf16x8 cat8(s16x4 lo, s16x4 hi) { return __builtin_shufflevector(lo, hi, 0, 1, 2, 3, 4, 5, 6, 7); }

DI void transpose_item(const float* __restrict__ src, int K, int N, u16* __restrict__ dst, int k0, int n0, unsigned char* lds) {
  float* tile = (float*)lds;
  const int tid = threadIdx.x;
#pragma unroll
  for (int i = 0; i < 8; ++i) {
    int idx = tid + 512 * i; int r = idx >> 6, c = idx & 63;
    tile[r * 65 + c] = src[(size_t)(k0 + r) * N + n0 + c];
  }
  __syncthreads();
  {
    int n = tid >> 3, kc = tid & 7;
    u32x4 o;
    o[0] = pk2(tile[(kc * 8 + 0) * 65 + n], tile[(kc * 8 + 1) * 65 + n]);
    o[1] = pk2(tile[(kc * 8 + 2) * 65 + n], tile[(kc * 8 + 3) * 65 + n]);
    o[2] = pk2(tile[(kc * 8 + 4) * 65 + n], tile[(kc * 8 + 5) * 65 + n]);
    o[3] = pk2(tile[(kc * 8 + 6) * 65 + n], tile[(kc * 8 + 7) * 65 + n]);
    *(u32x4*)(dst + (size_t)(n0 + n) * K + k0 + kc * 8) = o;
  }
  __syncthreads();
}

DI void convert_item(const float* __restrict__ src, u16* __restrict__ dst, size_t base) {
  size_t i = base + (size_t)threadIdx.x * 8;
  f32x4 a = *(const f32x4*)(src + i), b = *(const f32x4*)(src + i + 4);
  u32x4 o; o[0] = pk2(a[0], a[1]); o[1] = pk2(a[2], a[3]); o[2] = pk2(b[0], b[1]); o[3] = pk2(b[2], b[3]);
  *(u32x4*)(dst + i) = o;
}

template <bool BF16IN>
DI void norm_load(const void* __restrict__ xr_, int lane, f32x4 (&v)[4]) {
#pragma unroll
  for (int i = 0; i < 4; ++i) {
    if (BF16IN) { const u32x2 r_ = *(const u32x2*)((const u16*)xr_ + lane * 4 + 256 * i); v[i][0] = __uint_as_float(r_[0] << 16); v[i][1] = __uint_as_float(r_[0] & 0xffff0000u); v[i][2] = __uint_as_float(r_[1] << 16); v[i][3] = __uint_as_float(r_[1] & 0xffff0000u); }
    else v[i] = *(const f32x4*)((const float*)xr_ + lane * 4 + 256 * i);
  }
}
DI void norm_finish(const f32x4 (&v)[4], const float* __restrict__ g, u16* __restrict__ orow, int lane, float* amax_out) {
  float ss = 0.f, am = 0.f;
#pragma unroll
  for (int i = 0; i < 4; ++i) ss += v[i][0] * v[i][0] + v[i][1] * v[i][1] + v[i][2] * v[i][2] + v[i][3] * v[i][3];
  ss = wave_sum(ss);
  const float r = __builtin_amdgcn_rsqf(ss * (1.0f / 1024.0f) + NORM_EPS);
#pragma unroll
  for (int i = 0; i < 4; ++i) {
    f32x4 gg = *(const f32x4*)(g + lane * 4 + 256 * i);
    u32x2 o; o[0] = pk2(v[i][0] * r * gg[0], v[i][1] * r * gg[1]); o[1] = pk2(v[i][2] * r * gg[2], v[i][3] * r * gg[3]);
    *(u32x2*)(orow + lane * 4 + 256 * i) = o;
    if (amax_out) {
      am = fmaxf(am, fmaxf(fmaxf(fabsf(__uint_as_float(o[0] << 16)), fabsf(__uint_as_float(o[0] & 0xffff0000u))), fmaxf(fabsf(__uint_as_float(o[1] << 16)), fabsf(__uint_as_float(o[1] & 0xffff0000u)))));
    }
  }
  if (amax_out) {
#pragma unroll
    for (int o = 32; o > 0; o >>= 1) am = fmaxf(am, __shfl_xor(am, o));
    if (lane == 0) *amax_out = am;
  }
}
template <bool BF16IN = false>
DI void norm_row(const void* __restrict__ xr_, const float* __restrict__ g, u16* __restrict__ orow, int lane, float* amax_out = nullptr) {
  f32x4 v[4]; norm_load<BF16IN>(xr_, lane, v); norm_finish(v, g, orow, lane, amax_out);
}
template <bool BF16IN>
DI void norm_row2(const void* xa, const void* xb, const float* __restrict__ g, u16* oa, u16* ob, int lane, float* ama, float* amb) {
  f32x4 va[4], vb[4]; norm_load<BF16IN>(xa, lane, va); norm_load<BF16IN>(xb, lane, vb);
  norm_finish(va, g, oa, lane, ama); norm_finish(vb, g, ob, lane, amb);
}

DI void convert_row(const Params& p, int row, int lane_, const f32x4& a0, const f32x4& a1, const f32x4& a2, const f32x4& a3) {
      const int tbl = row >> 14, e = row & 16383;
      float am = 0.f;
#pragma unroll
      for (int j = 0; j < 4; ++j) am = fmaxf(am, fmaxf(fmaxf(fabsf(a0[j]), fabsf(a1[j])), fmaxf(fabsf(a2[j]), fabsf(a3[j]))));
#pragma unroll
      for (int o = 32; o > 0; o >>= 1) am = fmaxf(am, __shfl_xor(am, o));
      float isc; u32x2 o;
      if (tbl == 0) {
        const float sc = (am > 0.f) ? 7.0f / am : 0.f; isc = am * (1.0f / 7.0f);
#define Q4(x_) ((unsigned)((int)__builtin_rintf((x_) * sc)) & 15u)
        o[0] = Q4(a0[0]) | (Q4(a0[1]) << 8) | (Q4(a0[2]) << 16) | (Q4(a0[3]) << 24) | (Q4(a1[0]) << 4) | (Q4(a1[1]) << 12) | (Q4(a1[2]) << 20) | (Q4(a1[3]) << 28);
        o[1] = Q4(a2[0]) | (Q4(a2[1]) << 8) | (Q4(a2[2]) << 16) | (Q4(a2[3]) << 24) | (Q4(a3[0]) << 4) | (Q4(a3[1]) << 12) | (Q4(a3[2]) << 20) | (Q4(a3[3]) << 28);
#undef Q4
      } else {
        const float sc = (am > 0.f) ? 6.0f / am : 0.f; isc = am * (1.0f / 6.0f);
        unsigned pk = 0u;
        pk = __builtin_amdgcn_cvt_scalef32_pk_fp4_f32(pk, a0[0] * sc, a0[1] * sc, 1.0f, 0);
        pk = __builtin_amdgcn_cvt_scalef32_pk_fp4_f32(pk, a0[2] * sc, a0[3] * sc, 1.0f, 1);
        pk = __builtin_amdgcn_cvt_scalef32_pk_fp4_f32(pk, a1[0] * sc, a1[1] * sc, 1.0f, 2);
        pk = __builtin_amdgcn_cvt_scalef32_pk_fp4_f32(pk, a1[2] * sc, a1[3] * sc, 1.0f, 3);
        o[0] = pk; pk = 0u;
        pk = __builtin_amdgcn_cvt_scalef32_pk_fp4_f32(pk, a2[0] * sc, a2[1] * sc, 1.0f, 0);
        pk = __builtin_amdgcn_cvt_scalef32_pk_fp4_f32(pk, a2[2] * sc, a2[3] * sc, 1.0f, 1);
        pk = __builtin_amdgcn_cvt_scalef32_pk_fp4_f32(pk, a3[0] * sc, a3[1] * sc, 1.0f, 2);
        pk = __builtin_amdgcn_cvt_scalef32_pk_fp4_f32(pk, a3[2] * sc, a3[3] * sc, 1.0f, 3);
        o[1] = pk;
      }
      unsigned char* dst = tbl ? p.ws + WS_V + (size_t)e * 512 + lane_ * 8
                               : p.ws + WS_U + ((size_t)(lane_ >> 4) * 16384 + e) * 128 + (lane_ & 15) * 8;
      *(u32x2*)dst = o;
      if (lane_ == 0) ((float*)(p.ws + WS_MISC + (tbl ? MISC_SVINV : MISC_SUINV)))[e] = isc;
}
DI void convert_tables(const Params& p) {
  const int nb = gridDim.x, bid = blockIdx.x, tid = threadIdx.x;
  const int lane_ = tid & 63, w_ = tid >> 6;
  for (int it = bid; it < 2 * 16384 / 16; it += nb) {
    const int rowa = it * 16 + w_, rowb = rowa + 8;
    const float* sa = ((rowa >> 14) ? p.peer_v : p.peer_u) + (size_t)(rowa & 16383) * DM + lane_ * 16;
    const float* sb = ((rowb >> 14) ? p.peer_v : p.peer_u) + (size_t)(rowb & 16383) * DM + lane_ * 16;
    const f32x4 a0 = *(const f32x4*)(sa), a1 = *(const f32x4*)(sa + 4), a2 = *(const f32x4*)(sa + 8), a3 = *(const f32x4*)(sa + 12);
    const f32x4 b0 = *(const f32x4*)(sb), b1 = *(const f32x4*)(sb + 4), b2 = *(const f32x4*)(sb + 8), b3 = *(const f32x4*)(sb + 12);
    convert_row(p, rowa, lane_, a0, a1, a2, a3);
    convert_row(p, rowb, lane_, b0, b1, b2, b3);
  }
}

DI void phase_prep(const Params& p, unsigned char* lds) {
  const int nb = gridDim.x, bid = blockIdx.x, tid = threadIdx.x;
  u16* wsb = (u16*)p.ws;
  for (int it = bid; it < 768 + 256 + 512; it += nb) {
    if (it < 768) { int kt = it / 48, nt = it % 48; transpose_item(p.w_in, 1024, 3072, (u16*)(p.ws + WS_WIN), kt * 64, nt * 64, lds); }
    else if (it < 1024) { int j = it - 768; int kt = j / 16, nt = j % 16; transpose_item(p.w_out, 1024, 1024, (u16*)(p.ws + WS_WOUT), kt * 64, nt * 64, lds); }
    else { int j = it - 1024; int kt = j / 32, nt = j % 32; transpose_item(p.peer_w_q, 1024, 2048, (u16*)(p.ws + WS_WQ), kt * 64, nt * 64, lds); }
  }
  for (int it = bid; it < 8; it += nb) convert_item(p.peer_sub_keys, (u16*)(p.ws + WS_SK), (size_t)it * 4096);
  if (bid == 0 && tid < 64) ((unsigned*)(p.ws + WS_MISC + MISC_QCTR))[tid] = 0u;
  if (bid == 0) for (int i = tid; i < 3456; i += NTHR) ((unsigned*)(p.ws + WS_MISC + MISC_BAR))[i] = 0u;
  convert_tables(p);
  const int lane = tid & 63, w = tid >> 6;
  u16* n1 = (u16*)((unsigned char*)p.out + OUT_N1);
  for (int it = bid; it < T_TOK / 16; it += nb) {
    const int t = it * 16 + w, t2 = t + 8;
    norm_row2<false>(x_row(p, t), x_row(p, t2), p.attn_norm_g, n1 + (size_t)t * DM, n1 + (size_t)t2 * DM, lane, nullptr, nullptr);
  }
  (void)wsb;
}

template <int PR, int QR>
DI void gemm_mainloop(const u16* __restrict__ P, const u16* __restrict__ Q, int K, int p0, int q0, unsigned char* lds, f32x16 (&acc)[2][2]) {
  static_assert(PR + QR == 384, "tile");
  constexpr int STAGE = 384 * 128;
  constexpr int WC = QR / 64;
  const int tid = threadIdx.x, lane = tid & 63, r32 = lane & 31, h = lane >> 5;
  const int w = __builtin_amdgcn_readfirstlane(tid >> 6);
  const int wr = w / WC, wc = w % WC;
#pragma unroll
  for (int i = 0; i < 2; ++i)
#pragma unroll
    for (int j = 0; j < 2; ++j)
#pragma unroll
      for (int r = 0; r < 16; ++r) acc[i][j][r] = 0.f;
  u32x4 stg[6];
  const u16* src[6]; int loff[6];
#pragma unroll
  for (int i = 0; i < 6; ++i) {
    int c = tid + 512 * i; int row = c >> 3, kc = c & 7;
    src[i] = (row < PR) ? P + (size_t)(p0 + row) * K + kc * 8 : Q + (size_t)(q0 + row - PR) * K + kc * 8;
    loff[i] = row * 128 + ((kc ^ ((row >> 1) & 7)) << 4);
  }
  const int KT = K / 64;
#pragma unroll
  for (int i = 0; i < 6; ++i) stg[i] = *(const u32x4*)(src[i]);
#pragma unroll
  for (int i = 0; i < 6; ++i) *(u32x4*)(lds + loff[i]) = stg[i];
  __syncthreads();
  int aoff[2], boff[2], asw[2], bsw[2];
#pragma unroll
  for (int i = 0; i < 2; ++i) {
    int ra = wr * 64 + i * 32 + r32; aoff[i] = ra * 128; asw[i] = (ra >> 1) & 7;
    int rb = PR + wc * 64 + i * 32 + r32; boff[i] = rb * 128; bsw[i] = (rb >> 1) & 7;
  }
  for (int kt = 0; kt < KT; ++kt) {
    const int buf = (kt & 1) * STAGE;
    if (kt + 1 < KT) {
#pragma unroll
      for (int i = 0; i < 6; ++i) stg[i] = *(const u32x4*)(src[i] + (kt + 1) * 64);
    }
#pragma unroll
    for (int ks = 0; ks < 4; ++ks) {
      bf16x8 a[2], b[2];
#pragma unroll
      for (int i = 0; i < 2; ++i) {
        a[i] = *(const bf16x8*)(lds + buf + aoff[i] + (((2 * ks + h) ^ asw[i]) << 4));
        b[i] = *(const bf16x8*)(lds + buf + boff[i] + (((2 * ks + h) ^ bsw[i]) << 4));
      }
#pragma unroll
      for (int i = 0; i < 2; ++i)
#pragma unroll
        for (int j = 0; j < 2; ++j) acc[i][j] = MFMA32(a[i], b[j], acc[i][j]);
    }
    if (kt + 1 < KT) {
      const int nbuf = ((kt + 1) & 1) * STAGE;
#pragma unroll
      for (int i = 0; i < 6; ++i) *(u32x4*)(lds + nbuf + loff[i]) = stg[i];
    }
    __syncthreads();
  }
}

namespace pg8 {
#define PG8_LAS __attribute__((address_space(3)))
typedef unsigned short bf16_t;
typedef short bf16x8 __attribute__((ext_vector_type(8)));
typedef float f32x4 __attribute__((ext_vector_type(4)));
typedef unsigned u32x4 __attribute__((ext_vector_type(4)));
constexpr int BM = 256, BK = 64, HALF = 128, HTB = HALF * BK * 2  , STAGE_BYTES = 8 * HTB, NXCD = 8, WGM = 8;

__host__ __device__ __forceinline__ int lds_byte(int r, int c) { const int st = (r >> 4) * 2 + (c >> 5), rr = r & 15, cc = c & 31, ob = rr * 64 + cc * 2; return st * 1024 + (ob ^ (((ob >> 9) & 1) << 5)); }
__host__ __device__ __forceinline__ void stage_rc(int b, int& R, int& C) { const int st = b / 1024, sb = b % 1024, swz = sb ^ (((sb >> 9) & 1) << 5); R = (st >> 1) * 16 + swz / 64; C = (st & 1) * 32 + (swz % 64) / 2; }
__host__ __device__ __forceinline__ int perm32(int rho) { const int n = rho >> 4, i = rho & 15; return 8 * (i >> 2) + 4 * n + (i & 3); }

struct Unit { int pm, pn; };
struct Gemm { const bf16_t* A; const bf16_t* Bt; int M, N, K; };

struct StaticOrder {
    int nM, nN, nwg, G, c;
    __host__ __device__ void init(int M, int N, int G_, int c_) { nM = M / BM; nN = N / BM; nwg = nM * nN; G = G_; c = c_; }
    __host__ __device__ bool next(int i, Unit& u) const {
        const long L = (long)i * G + c; if (L >= nwg) return false;
        int wgid = (int)L; { const int q = nwg / NXCD, r = nwg % NXCD, xcd = wgid % NXCD, off = wgid / NXCD; wgid = (xcd < r ? xcd * (q + 1) : r * (q + 1) + (xcd - r) * q) + off; }
        const int nig = WGM * nN, gid = wgid / nig, fm = gid * WGM, gsz = (nM - fm) < WGM ? (nM - fm) : WGM;
        u.pm = fm + ((wgid % nig) % gsz); u.pn = (wgid % nig) / gsz; return true;
    }
    __device__ __forceinline__ void a_ready(const Unit&) const {}
    __device__ __forceinline__ void done(const Unit&) const {}
};


template <class Epi, class Sched, bool ALIGN_EPI = false, bool SP2 = false>
__device__ __forceinline__ void gemm_phase(PG8_LAS unsigned char* lds, const Gemm g, const Sched& S, const Epi& E) {
    const int tid = threadIdx.x, wid = __builtin_amdgcn_readfirstlane(tid >> 6), lane = tid & 63, wr = wid >> 2, wc = wid & 3, fr = lane & 15, fq = lane >> 4;
    const int K = g.K, nt = K / BK;
    unsigned voffA[2], voffB[2], voffB1[2];
#pragma unroll
    for (int i = 0; i < 2; ++i) { int R, C; stage_rc(tid * 16 + i * 8192, R, C); const int Rb = Epi::PERM ? ((R & ~31) + perm32(R & 31)) : R;
        voffA[i] = (unsigned)(R * K + C) * 2u;
        if (Epi::HEADPERM) { const int Rh = 64 * (R >> 5) + perm32(R & 31); voffB[i] = (unsigned)(Rh * K + C) * 2u; voffB1[i] = (unsigned)((Rh + 32) * K + C) * 2u; }
        else { voffB[i] = (unsigned)(Rb * K + C) * 2u; voffB1[i] = (unsigned)((Rb + HALF) * K + C) * 2u; } }
    const size_t kstep = (size_t)(BK * 2);
    const size_t hstep = (size_t)HALF * K * 2;
    const size_t tstep = 2 * hstep;
    const unsigned ldsw = (unsigned)wid * 1024u;
    const int aoff = lds_byte(wr * 64 + fr, fq * 8), boff = lds_byte(wc * 32 + fr, fq * 8);
#define PG8_SA(b, h) (((b) * 2 + (h)) * HTB)
#define PG8_SB(b, h) ((4 + (b) * 2 + (h)) * HTB)
#define PG8_STAGE(bufoff, gbase, voff) do { _Pragma("unroll") for (int _i = 0; _i < 2; ++_i) \
        __builtin_amdgcn_global_load_lds((const unsigned*)((const char*)(gbase) + (voff)[_i]), (PG8_LAS unsigned*)(lds + (bufoff) + ldsw + _i * 8192), 16, 0, 0); } while (0)
#define PG8_LDA(dst, b, h) do { _Pragma("unroll") for (int m = 0; m < 4; ++m) _Pragma("unroll") for (int k = 0; k < 2; ++k) dst[m][k] = *(const PG8_LAS bf16x8*)(lds + PG8_SA(b, h) + aoff + m * 2048 + k * 1024); } while (0)
#define PG8_LDB(dst, b, h) do { _Pragma("unroll") for (int n = 0; n < 2; ++n) _Pragma("unroll") for (int k = 0; k < 2; ++k) dst[n][k] = *(const PG8_LAS bf16x8*)(lds + PG8_SB(b, h) + boff + n * 2048 + k * 1024); } while (0)
#define PG8_MMA(ai, bj, At, Bt) do { __builtin_amdgcn_s_setprio(1); _Pragma("unroll") for (int m = 0; m < 4; ++m) _Pragma("unroll") for (int n = 0; n < 2; ++n) _Pragma("unroll") for (int k = 0; k < 2; ++k) \
        acc[ai][bj][m][n] = __builtin_amdgcn_mfma_f32_16x16x32_bf16(Bt[n][k], At[m][k], acc[ai][bj][m][n], 0, 0, 0); __builtin_amdgcn_s_setprio(0); } while (0)
#define PG8_WAIT_V(n) asm volatile("s_waitcnt vmcnt(" #n ")" ::: "memory")
#define PG8_WAIT_L(n) asm volatile("s_waitcnt lgkmcnt(" #n ")" ::: "memory")
#define PG8_BAR __builtin_amdgcn_s_barrier()
#define PG8_SCHED __builtin_amdgcn_sched_barrier(0)
    Unit cur, nxt; int ui = 0;
    if (!S.next(0, cur)) return;
    f32x4 acc[2][2][4][2];
#pragma unroll
    for (int a = 0; a < 2; ++a)
#pragma unroll
        for (int b = 0; b < 2; ++b)
#pragma unroll
            for (int m = 0; m < 4; ++m)
#pragma unroll
                for (int n = 0; n < 2; ++n) acc[a][b][m][n] = (f32x4){0.f, 0.f, 0.f, 0.f};
    bf16x8 At[4][2], B0[2][2], B1[2][2];
    const char* cA = (const char*)g.A + (size_t)cur.pm * tstep; const char* cB = (const char*)g.Bt + (size_t)cur.pn * tstep;
    S.a_ready(cur);
    if constexpr (SP2) {
        PG8_STAGE(PG8_SB(0, 0), cB, voffB); PG8_STAGE(PG8_SB(0, 1), cB, voffB1); PG8_STAGE(PG8_SA(0, 0), cA, voffA); PG8_STAGE(PG8_SA(0, 1), cA + hstep, voffA);
        if (wr == 1) PG8_BAR;
        PG8_WAIT_V(2); PG8_BAR;
        PG8_STAGE(PG8_SB(1, 0), cB + kstep, voffB); PG8_STAGE(PG8_SA(1, 0), cA + kstep, voffA); PG8_STAGE(PG8_SB(1, 1), cB + kstep, voffB1);
        PG8_WAIT_V(6); PG8_BAR;
    } else {
        PG8_STAGE(PG8_SB(0, 0), cB, voffB); PG8_STAGE(PG8_SA(0, 0), cA, voffA); PG8_STAGE(PG8_SB(0, 1), cB, voffB1); PG8_STAGE(PG8_SA(0, 1), cA + hstep, voffA);
        if (wr == 1) PG8_BAR;
        PG8_WAIT_V(4); PG8_BAR;
        PG8_STAGE(PG8_SB(1, 0), cB + kstep, voffB); PG8_STAGE(PG8_SA(1, 0), cA + kstep, voffA); PG8_STAGE(PG8_SB(1, 1), cB + kstep, voffB1);
        PG8_WAIT_V(6); PG8_BAR;
    }
    for (;;) {
        const bool has_next = S.next(ui + 1, nxt);
        const char* nA = has_next ? (const char*)g.A + (size_t)nxt.pm * tstep : cA; const char* nB = has_next ? (const char*)g.Bt + (size_t)nxt.pn * tstep : cB;
        for (int t = 0; t < nt; t += 2) {
            const bool last = (t == nt - 2);
            const char* a1 = cA + (size_t)(t + 1) * kstep;
            const char* a2 = last ? nA : cA + (size_t)(t + 2) * kstep; const char* b2 = last ? nB : cB + (size_t)(t + 2) * kstep;
            const char* a3 = a2 + kstep; const char* b3 = b2 + kstep;
            if (last && has_next) S.a_ready(nxt);
            if constexpr (SP2) {
            PG8_LDB(B0, 0, 0); PG8_LDB(B1, 0, 1); PG8_SCHED; PG8_LDA(At, 0, 0); PG8_STAGE(PG8_SA(1, 1), a1 + hstep, voffA);
            PG8_WAIT_V(8); PG8_WAIT_L(0); PG8_BAR; PG8_MMA(0, 0, At, B0); PG8_MMA(0, 1, At, B1); PG8_BAR; PG8_SCHED;
            PG8_LDA(At, 0, 1); PG8_STAGE(PG8_SB(0, 0), b2, voffB); PG8_STAGE(PG8_SB(0, 1), b2, voffB1); PG8_STAGE(PG8_SA(0, 0), a2, voffA);
            PG8_WAIT_V(8); PG8_WAIT_L(0); PG8_BAR; PG8_MMA(1, 0, At, B0); PG8_MMA(1, 1, At, B1); PG8_BAR; PG8_SCHED;
            PG8_LDB(B0, 1, 0); PG8_LDB(B1, 1, 1); PG8_SCHED; PG8_LDA(At, 1, 0); PG8_STAGE(PG8_SA(0, 1), a2 + hstep, voffA);
            PG8_WAIT_V(8); PG8_WAIT_L(0); PG8_BAR; PG8_MMA(0, 0, At, B0); PG8_MMA(0, 1, At, B1); PG8_BAR; PG8_SCHED;
            PG8_LDA(At, 1, 1); PG8_STAGE(PG8_SB(1, 0), b3, voffB); PG8_STAGE(PG8_SB(1, 1), b3, voffB1); PG8_STAGE(PG8_SA(1, 0), a3, voffA);
            PG8_WAIT_V(8); PG8_WAIT_L(0); PG8_BAR; PG8_MMA(1, 0, At, B0); PG8_MMA(1, 1, At, B1); PG8_BAR; PG8_SCHED;
            } else {
            PG8_LDB(B0, 0, 0); PG8_SCHED; PG8_LDA(At, 0, 0); PG8_STAGE(PG8_SA(1, 1), a1 + hstep, voffA);
            PG8_WAIT_L(8); PG8_BAR; PG8_WAIT_L(0); PG8_MMA(0, 0, At, B0); PG8_BAR; PG8_SCHED;
            PG8_LDB(B1, 0, 1); PG8_STAGE(PG8_SB(0, 0), b2, voffB);
            PG8_BAR; PG8_WAIT_L(0); PG8_MMA(0, 1, At, B1); PG8_BAR;
            PG8_LDA(At, 0, 1); PG8_STAGE(PG8_SA(0, 0), a2, voffA);
            PG8_BAR; PG8_WAIT_L(0); PG8_MMA(1, 0, At, B0); PG8_BAR; PG8_SCHED;
            PG8_STAGE(PG8_SB(0, 1), b2, voffB1);
            PG8_WAIT_V(6); PG8_BAR; PG8_MMA(1, 1, At, B1); PG8_BAR;
            PG8_LDB(B0, 1, 0); PG8_SCHED; PG8_LDA(At, 1, 0); PG8_STAGE(PG8_SA(0, 1), a2 + hstep, voffA);
            PG8_WAIT_L(8); PG8_BAR; PG8_WAIT_L(0); PG8_MMA(0, 0, At, B0); PG8_BAR; PG8_SCHED;
            PG8_LDB(B1, 1, 1); PG8_STAGE(PG8_SB(1, 0), b3, voffB);
            PG8_BAR; PG8_WAIT_L(0); PG8_MMA(0, 1, At, B1); PG8_BAR;
            PG8_LDA(At, 1, 1); PG8_STAGE(PG8_SA(1, 0), a3, voffA);
            PG8_BAR; PG8_WAIT_L(0); PG8_MMA(1, 0, At, B0); PG8_BAR; PG8_SCHED;
            PG8_STAGE(PG8_SB(1, 1), b3, voffB1);
            PG8_WAIT_V(6); PG8_BAR; PG8_MMA(1, 1, At, B1); PG8_BAR;
            }
        }
        if constexpr (ALIGN_EPI) { if (wr == 0) PG8_BAR; }
        if constexpr (!Epi::AFTER_DRAIN) { E(acc, cur, wr, wc, fr, fq); S.done(cur); }
        if (!has_next) break;
#pragma unroll
        for (int a = 0; a < 2; ++a)
#pragma unroll
            for (int b = 0; b < 2; ++b)
#pragma unroll
                for (int m = 0; m < 4; ++m)
#pragma unroll
                    for (int n = 0; n < 2; ++n) acc[a][b][m][n] = (f32x4){0.f, 0.f, 0.f, 0.f};
        cur = nxt; cA = nA; cB = nB; ++ui;
        if constexpr (ALIGN_EPI) { if (wr == 1) PG8_BAR; }
    }
    PG8_WAIT_V(0);
    if constexpr (!ALIGN_EPI) { if (wr == 0) PG8_BAR; }
    PG8_BAR;
    if constexpr (Epi::AFTER_DRAIN) { E.fused(acc, cur, wr, wc, fr, fq, lds, wid, lane); S.done(cur); }
#undef PG8_SA
#undef PG8_SB
#undef PG8_STAGE
#undef PG8_LDA
#undef PG8_LDB
#undef PG8_MMA
#undef PG8_WAIT_V
#undef PG8_WAIT_L
#undef PG8_BAR
#undef PG8_SCHED
}
}

struct EpiProj {
  static constexpr bool PERM = true, AFTER_DRAIN = false, HEADPERM = true;
  const float* gqa; const float* gka; const float* gqb; const float* gkb; unsigned char* ws;
  __device__ __forceinline__ void operator()(const pg8::f32x4 (&acc)[2][2][4][2], const pg8::Unit& u, int wr, int wc, int fr, int fq) const {
    const int nbase = u.pn * 256 + wc * 64;
    const int region = nbase >> 9, hw = (nbase & 511) >> 6;
    const float* g = (region == 0) ? gqa : (region == 1) ? gka : (region == 3) ? gqb : gkb;
    const bool normed = (region != 2 && region != 5);
    const float qs = (region == 0 || region == 3) ? C2 : 1.0f;
    u16* dstR = (u16*)(ws + WS_R + (size_t)region * R_REGION);
    f32x4 gv[2][2];
#pragma unroll
    for (int bj = 0; bj < 2; ++bj)
#pragma unroll
      for (int n = 0; n < 2; ++n) gv[bj][n] = normed ? *(const f32x4*)(g + 32 * bj + 8 * fq + 4 * n) : (f32x4){1.f, 1.f, 1.f, 1.f};
#pragma unroll
    for (int ai = 0; ai < 2; ++ai)
#pragma unroll
      for (int m = 0; m < 4; ++m) {
        const int t = u.pm * 256 + ai * 128 + wr * 64 + m * 16 + fr;
        int seq_start, S, sq; seq_of(t, seq_start, S, sq);
        float scale = 1.0f;
        if (normed) {
          float ss = 0.f;
#pragma unroll
          for (int bj = 0; bj < 2; ++bj)
#pragma unroll
            for (int n = 0; n < 2; ++n) { const f32x4 v = acc[ai][bj][m][n]; ss += v[0] * v[0] + v[1] * v[1] + v[2] * v[2] + v[3] * v[3]; }
          ss += __shfl_xor(ss, 16); ss += __shfl_xor(ss, 32);
          scale = __builtin_amdgcn_rsqf(ss * (1.0f / 64.0f) + NORM_EPS) * qs;
        }
        u16* dst;
        if (region != 5) dst = dstR + (size_t)seq_start * 512 + ((size_t)hw * S + sq) * 64;
        else dst = dstR + (size_t)seq_start * 512 + ((size_t)(hw >> 1) * S + sq) * 128 + (hw & 1) * 64;
#pragma unroll
        for (int bj = 0; bj < 2; ++bj) {
          const f32x4 v0 = acc[ai][bj][m][0] * scale * gv[bj][0], v1 = acc[ai][bj][m][1] * scale * gv[bj][1];
          u32x4 o; o[0] = pk2(v0[0], v0[1]); o[1] = pk2(v0[2], v0[3]); o[2] = pk2(v1[0], v1[1]); o[3] = pk2(v1[2], v1[3]);
          *(u32x4*)(dst + 32 * bj + 8 * fq) = o;
        }
      }
  }
};

DI void phase_proj(const Params& p, unsigned char* lds) {
  pg8::Gemm g{(const u16*)((const unsigned char*)p.out + OUT_N1), (const u16*)(p.ws + WS_WIN), T_TOK, 3072, 1024};
  pg8::StaticOrder S; S.init(T_TOK, 3072, (int)gridDim.x, (int)blockIdx.x);
  EpiProj E{p.q_norm_a, p.k_norm_a, p.q_norm_b, p.k_norm_b, p.ws};
  pg8::gemm_phase<EpiProj, pg8::StaticOrder, true, true>((PG8_LAS unsigned char*)lds, g, S, E);
}

constexpr int AL_STAGE = 0;
constexpr int AL_VT    = 0;
constexpr int AL_TAB   = 131072;
constexpr int AL_TABA  = 137216;
constexpr int AL_XL    = 150016;
constexpr int AL_MISC  = 151552;

DI unsigned voff_b(int row, int ch) { return 256u * row + 16u * (ch ^ (((row & 3) << 2) | ((row >> 2) & 3))); }

template <int VAR>
DI void diff_unit(const Params& p, unsigned char* lds, int seq_start, int S, int hd, int q0, float lam) {
  const int tid = threadIdx.x, lane = tid & 63, r32 = lane & 31, h = lane >> 5;
  const int w = __builtin_amdgcn_readfirstlane(tid >> 6);
  const int map = w >> 2, wq = w & 3;
  const u16* QBp = (const u16*)(p.ws + WS_R + 3 * R_REGION);
  const u16* KBp = (const u16*)(p.ws + WS_R + 4 * R_REGION);
  const u16* VBp = (const u16*)(p.ws + WS_R + 5 * R_REGION);
  const int qpos = q0 + wq * 32 + r32;
  const int qlo = q0 + wq * 32;
  const u16* Qp = QBp + (size_t)seq_start * 512 + ((size_t)(hd * 2 + map) * S + qpos) * 64;
  bf16x8 qf[4];
#pragma unroll
  for (int ks = 0; ks < 4; ++ks) qf[ks] = *(const bf16x8*)(Qp + ks * 16 + h * 8);
  const u16* K1g = KBp + (size_t)seq_start * 512 + ((size_t)(hd * 2 + 0) * S) * 64;
  const u16* K2g = KBp + (size_t)seq_start * 512 + ((size_t)(hd * 2 + 1) * S) * 64;
  const u16* Vg = VBp + (size_t)seq_start * 512 + ((size_t)hd * S) * 128;
  const float* tab = (const float*)(lds + AL_TAB);
  const float* misc = (const float*)(lds + AL_MISC);
  const float cAfter = misc[12 + hd];
  f32x16 O[4];
#pragma unroll
  for (int nb = 0; nb < 4; ++nb)
#pragma unroll
    for (int r = 0; r < 16; ++r) O[nb][r] = 0.f;
  float l = 0.f;
  const int kr_ = 8 * w + (lane >> 3), kc_ = (lane & 7) ^ ((kr_ >> 1) & 7);
  const u16* k1src = K1g + (size_t)kr_ * 64 + kc_ * 8;
  const u16* k2src = K2g + (size_t)kr_ * 64 + kc_ * 8;
  const u16* vsrc[2];
#pragma unroll
  for (int i = 0; i < 2; ++i) { const int row = 8 * w + 4 * i + (lane >> 4); const int pc = (lane & 15) ^ (((row & 3) << 2) | ((row >> 2) & 3)); vsrc[i] = Vg + (size_t)row * 128 + pc * 8; }
  const int NKT = S / 64;
  const int i16 = lane & 15, tq = i16 >> 2, tp = i16 & 3, blk = (lane >> 4) & 1;
  int kbase4[4], vbase[4][2];
#pragma unroll
  for (int ks = 0; ks < 4; ++ks) kbase4[ks] = r32 * 128 + (((2 * ks + h) ^ ((r32 >> 1) & 7)) << 4);
#pragma unroll
  for (int nb = 0; nb < 4; ++nb)
#pragma unroll
    for (int hi = 0; hi < 2; ++hi) vbase[nb][hi] = (int)voff_b(4 * h + tq + 8 * hi, 4 * nb + 2 * blk + (tp >> 1)) + 8 * (tp & 1);
#define DU_GLDS(gsrc_, ldsoff_) do { unsigned keep_; const unsigned dst_ = (unsigned)__builtin_amdgcn_readfirstlane((int)(ldsoff_)); \
    asm volatile("s_mov_b32 %0, m0\n\ts_mov_b32 m0, %2\n\ts_nop 0\n\tglobal_load_lds_dwordx4 %1, off\n\ts_mov_b32 m0, %0" : "=&s"(keep_) : "v"(gsrc_), "s"(dst_) : "memory"); } while (0)
#define DU_DMA(kt_, st_) do { const size_t ko_ = (size_t)(kt_) * 64 * 64, vo_ = (size_t)(kt_) * 64 * 128; const unsigned b_ = lds_base + AL_STAGE + (st_) * 32768; \
    DU_GLDS(k1src + ko_, b_ + w * 1024); DU_GLDS(k2src + ko_, b_ + 8192 + w * 1024); \
    DU_GLDS(vsrc[0] + vo_, b_ + 16384 + w * 2048); DU_GLDS(vsrc[1] + vo_, b_ + 16384 + w * 2048 + 1024); } while (0)
  const unsigned lds_base = (unsigned)(uintptr_t)lds;
#define SBAR() __builtin_amdgcn_sched_barrier(0)
#define DU_VRD(slot, f, so_) do { vlo[slot] = tr_read(vp[(f) >> 1][0] + (so_) + ((f) & 1) * 4096); vhi[slot] = tr_read(vp[(f) >> 1][1] + (so_) + ((f) & 1) * 4096); } while (0)
#define DU_SUB(A, B, kq2, kso2_, has_next2_, vso_, knext_, has_next_) do { \
    SBAR(); \
    s16x4 vlo[4], vhi[4]; \
    if (VAR != 2 && VAR != 4) { DU_VRD(0, 0, vso_); DU_VRD(1, 1, vso_); DU_VRD(2, 2, vso_); DU_VRD(3, 3, vso_); } \
    if (has_next_ && VAR != 3 && VAR != 4) { \
      f32x16 z_; _Pragma("unroll") for (int r = 0; r < 16; ++r) z_[r] = 0.f; \
      B = MFMA32(kf[0], qf[0], z_); B = MFMA32(kf[1], qf[1], B); B = MFMA32(kf[2], qf[2], B); B = MFMA32(kf[3], qf[3], B); } \
    float ls = 0.f; \
    _Pragma("unroll") for (int r = 0; r < 16; ++r) ls += A[r]; \
    l += ls; \
    bf16x8 pb[2]; \
    _Pragma("unroll") for (int s2 = 0; s2 < 2; ++s2) { \
      u32x4 pw; pw[0] = pk2(A[8 * s2 + 0], A[8 * s2 + 1]); pw[1] = pk2(A[8 * s2 + 2], A[8 * s2 + 3]); \
      pw[2] = pk2(A[8 * s2 + 4], A[8 * s2 + 5]); pw[3] = pk2(A[8 * s2 + 6], A[8 * s2 + 7]); \
      pb[s2] = __builtin_bit_cast(bf16x8, pw); } \
    SBAR(); \
    if ((has_next2_) && VAR != 3 && VAR != 4) { _Pragma("unroll") for (int ks = 0; ks < 4; ++ks) kf[ks] = *(const bf16x8*)(kq2[ks] + (kso2_)); } \
    if (has_next_) { \
      const int dmin_ = (knext_) - (qlo + 31), dmax_ = (knext_) + 31 - qlo; \
      if (dmin_ < 559) { \
        if (in_after) { in_after = false; _Pragma("unroll") for (int nb = 0; nb < 4; ++nb) _Pragma("unroll") for (int r = 0; r < 16; ++r) O[nb][r] *= fAfter; l *= fAfter; \
                        _Pragma("unroll") for (int s2 = 0; s2 < 2; ++s2) {   \
                          u32x4 pw; pw[0] = pk2(A[8 * s2 + 0] * fAfter, A[8 * s2 + 1] * fAfter); pw[1] = pk2(A[8 * s2 + 2] * fAfter, A[8 * s2 + 3] * fAfter); \
                          pw[2] = pk2(A[8 * s2 + 4] * fAfter, A[8 * s2 + 5] * fAfter); pw[3] = pk2(A[8 * s2 + 6] * fAfter, A[8 * s2 + 7] * fAfter); \
                          pb[s2] = __builtin_bit_cast(bf16x8, pw); } } \
        if (dmax_ > -559) { const int base_ = (knext_) + 4 * h - qpos + 640; \
          _Pragma("unroll") for (int r = 0; r < 16; ++r) B[r] += tab[base_ + (r & 3) + 8 * (r >> 2)]; } } } \
    _Pragma("unroll") for (int f = 0; f < 8; ++f) { \
      if (VAR != 2 && VAR != 4) { O[f >> 1] = MFMA32(cat8(vlo[f & 3], vhi[f & 3]), pb[f & 1], O[f >> 1]); \
      if (f + 4 < 8) DU_VRD(f & 3, f + 4, vso_); } \
      if (VAR != 1 && VAR != 4) { B[2 * f] = __builtin_amdgcn_exp2f(B[2 * f]); B[2 * f + 1] = __builtin_amdgcn_exp2f(B[2 * f + 1]); } } \
  } while (0)
  f32x16 X, Y; bf16x8 kf[4];
  const float fAfter = __builtin_amdgcn_exp2f(cAfter);
  bool in_after = true;
  const int KT1 = NKT - 1;
  DU_DMA(KT1, 0);
  if (NKT > 1) DU_DMA(KT1 - 1, 1);
  if (NKT > 2) DU_DMA(KT1 - 2, 2);
  if (NKT > 2) asm volatile("s_waitcnt vmcnt(8)" ::: "memory"); else asm volatile("s_waitcnt vmcnt(0)" ::: "memory");
  __syncthreads();
  {
    const unsigned char* kb_ = lds + AL_STAGE + map * 8192 + 4096;
    f32x16 z_;
#pragma unroll
    for (int r = 0; r < 16; ++r) z_[r] = 0.f;
    X = MFMA32(*(const bf16x8*)(kb_ + kbase4[0]), qf[0], z_); X = MFMA32(*(const bf16x8*)(kb_ + kbase4[1]), qf[1], X);
    X = MFMA32(*(const bf16x8*)(kb_ + kbase4[2]), qf[2], X); X = MFMA32(*(const bf16x8*)(kb_ + kbase4[3]), qf[3], X);
    const int knext = 64 * KT1 + 32;
    const int dmin_ = knext - (qlo + 31), dmax_ = knext + 31 - qlo;
    if (dmin_ < 559) {
      in_after = false;
      if (dmax_ > -559) { const int base_ = knext + 4 * h - qpos + 640;
#pragma unroll
        for (int r = 0; r < 16; ++r) X[r] += tab[base_ + (r & 3) + 8 * (r >> 2)]; }
    }
#pragma unroll
    for (int r = 0; r < 16; ++r) X[r] = __builtin_amdgcn_exp2f(X[r]);
#pragma unroll
    for (int ks = 0; ks < 4; ++ks) kf[ks] = *(const bf16x8*)(lds + AL_STAGE + map * 8192 + kbase4[ks]);
  }
  if (map == 1) __builtin_amdgcn_s_setprio(1);
  int st_cur = 0, st_nxt = 32768, st_nx2 = 65536, st_free = 98304;
  for (int i = 0; i < NKT; ++i) {
    const int kt = KT1 - i;
    if (i + 2 < NKT) asm volatile("s_waitcnt vmcnt(4)" ::: "memory"); else asm volatile("s_waitcnt vmcnt(0)" ::: "memory");
    __syncthreads();
    if (i + 3 < NKT) DU_DMA(kt - 3, st_free / 32768);
    const unsigned char* knx[4]; const unsigned char* vp[4][2];
#pragma unroll
    for (int ks = 0; ks < 4; ++ks) knx[ks] = lds + AL_STAGE + st_nxt + map * 8192 + kbase4[ks];
#pragma unroll
    for (int nb = 0; nb < 4; ++nb) { vp[nb][0] = lds + AL_STAGE + st_cur + 16384 + vbase[nb][0]; vp[nb][1] = lds + AL_STAGE + st_cur + 16384 + vbase[nb][1]; }
    DU_SUB(X, Y, knx, 4096, (i + 1 < NKT), 8192, 64 * kt, true);
    DU_SUB(Y, X, knx, 0, (i + 1 < NKT), 0, 64 * kt - 32, (i + 1 < NKT));
    { const int t_ = st_cur; st_cur = st_nxt; st_nxt = st_nx2; st_nx2 = st_free; st_free = t_; }
  }
  __builtin_amdgcn_s_setprio(0);
#undef DU_DMA
#undef DU_GLDS
#undef DU_VRD
#undef DU_SUB
#undef SBAR
  if (in_after) {
#pragma unroll
    for (int nb = 0; nb < 4; ++nb)
#pragma unroll
      for (int r = 0; r < 16; ++r) O[nb][r] *= fAfter;
    l *= fAfter;
  }
  if (VAR != 0) {
#pragma unroll
    for (int nb = 0; nb < 4; ++nb) asm volatile("" :: "v"(O[nb]));
    asm volatile("" :: "v"(l), "v"(X), "v"(Y));
    __syncthreads();
    return;
  }
  __syncthreads();
  float ltot = l + __shfl_xor(l, 32);
  float* xbuf = (float*)(lds + AL_STAGE);
  if (map == 1) {
    const float inv = 1.0f / ltot;
#pragma unroll
    for (int nb = 0; nb < 4; ++nb)
#pragma unroll
      for (int r = 0; r < 16; ++r) xbuf[((wq * 64 + nb * 16 + r) << 6) + lane] = O[nb][r] * inv;
  }
  __syncthreads();
  if (map == 0) {
    const float inv = 1.0f / ltot;
    float ss = 0.f;
#pragma unroll
    for (int nb = 0; nb < 4; ++nb)
#pragma unroll
      for (int r = 0; r < 16; ++r) {
        float o = O[nb][r] * inv - lam * xbuf[((wq * 64 + nb * 16 + r) << 6) + lane];
        O[nb][r] = o; ss += o * o;
      }
    ss += __shfl_xor(ss, 32);
    const float rn = __builtin_amdgcn_rsqf(ss * (1.0f / 128.0f) + NORM_EPS) * 0.8f;
    u16* mix = (u16*)((unsigned char*)p.out + OUT_MIX) + (size_t)(seq_start + qpos) * 1024 + 512 + hd * 128;
#pragma unroll
    for (int nb = 0; nb < 4; ++nb)
#pragma unroll
      for (int g4 = 0; g4 < 4; ++g4) {
        const int d0 = 32 * nb + 8 * g4 + 4 * h;
        f32x4 gg = *(const f32x4*)(p.diff_norm_g + d0);
        u32x2 o; o[0] = pk2(O[nb][4 * g4 + 0] * rn * gg[0], O[nb][4 * g4 + 1] * rn * gg[1]);
        o[1] = pk2(O[nb][4 * g4 + 2] * rn * gg[2], O[nb][4 * g4 + 3] * rn * gg[3]);
        *(u32x2*)(mix + d0) = o;
      }
  }
  __syncthreads();
}

constexpr int AL_DPART = 65536;
constexpr int AL_DL    = AL_TAB;
template <int PASS>
DI void dil_wave_item(const Params& p, unsigned char* lds, int seq_start, int S, int hd, int i0, int sel) {
  const int tid = threadIdx.x, lane = tid & 63, r32 = lane & 31, h = lane >> 5;
  const int w = __builtin_amdgcn_readfirstlane(tid >> 6);
  const u16* QAp = (const u16*)(p.ws + WS_R + 0 * R_REGION);
  const u16* KAp = (const u16*)(p.ws + WS_R + 1 * R_REGION);
  const u16* VAp = (const u16*)(p.ws + WS_R + 2 * R_REGION);
  constexpr int QSTR = (PASS == 1) ? 1 : 16;
  constexpr int NTILE = (PASS == 1) ? 5 : 13;
  const int qbase = (PASS == 1) ? i0 + 32 * sel : i0 + sel;
  const int qpos = qbase + QSTR * r32;
  const int tl = qpos - i0;
  const u16* Qp = QAp + (size_t)seq_start * 512 + ((size_t)hd * S + qpos) * 64;
  bf16x8 qf[4];
#pragma unroll
  for (int ks = 0; ks < 4; ++ks) qf[ks] = *(const bf16x8*)(Qp + ks * 16 + h * 8);
  const u16* Kg = KAp + (size_t)seq_start * 512 + ((size_t)hd * S) * 64;
  const u16* Vg = VAp + (size_t)seq_start * 512 + ((size_t)hd * S) * 64;
  unsigned char* vt = lds + AL_VT + w * 8192;
  unsigned char* ktl = vt + 4096;
  const float* tabA = (const float*)(lds + AL_TABA) + hd * 3 * 132;
  unsigned char* dpart = lds + AL_DPART;
  float* dl = (float*)(lds + AL_DL);
  const int psw = ((tl >> 4) ^ tl) & 15;
  f32x16 O[2];
  float l = 0.f;
  if (PASS == 1) {
#pragma unroll
    for (int nb = 0; nb < 2; ++nb)
#pragma unroll
      for (int r = 0; r < 16; ++r) O[nb][r] = 0.f;
  } else {
#pragma unroll
    for (int nb = 0; nb < 2; ++nb)
#pragma unroll
      for (int g4 = 0; g4 < 4; ++g4) {
        const int ch = 8 * nb + 2 * g4 + h;
        const u32x2 v = *(const u32x2*)(dpart + tl * 128 + ((ch ^ psw) << 3));
        O[nb][4 * g4 + 0] = __uint_as_float(v[0] << 16); O[nb][4 * g4 + 1] = __uint_as_float(v[0] & 0xffff0000u);
        O[nb][4 * g4 + 2] = __uint_as_float(v[1] << 16); O[nb][4 * g4 + 3] = __uint_as_float(v[1] & 0xffff0000u);
      }
    if (h == 0) l = dl[tl];
  }
  const int i16 = lane & 15, tq = i16 >> 2, tp = i16 & 3, blk = (lane >> 4) & 1;
  int vrb[2][2];
#pragma unroll
  for (int nb = 0; nb < 2; ++nb)
#pragma unroll
    for (int hi = 0; hi < 2; ++hi) {
      const int R = 4 * h + tq + 8 * hi; const int ch = 4 * nb + 2 * blk + (tp >> 1);
      const int sw = (((R >> 1) & 1) << 2) ^ ((R >> 2) & 3);
      vrb[nb][hi] = R * 128 + ((ch ^ sw) << 4) + 8 * (tp & 1);
    }
  bf16x8 kfb[1][4]; u32x4 vcb[1][4];
  const int lrow = lane >> 3, lch = lane & 7;
#define DL_PARAMS(tau_) \
    const int d_ = (PASS == 1) ? 1 : (((tau_) < 5) ? 16 : 4); const int br_ = (PASS == 1) ? 2 : (((tau_) < 5) ? 0 : 1); \
    const int tt_ = (PASS == 1) ? (tau_) : (((tau_) < 5) ? (tau_) : (tau_) - 5); const int ratio_ = QSTR / d_; \
    const int n0_ = -64 + 32 * tt_;
#define DL_LOAD(buf, tau_) do { DL_PARAMS(tau_) \
    _Pragma("unroll") for (int i4 = 0; i4 < 4; ++i4) { int kpos_ = qbase + d_ * (n0_ + 8 * i4 + lrow); kpos_ = kpos_ < 0 ? 0 : (kpos_ >= S ? S - 1 : kpos_); \
      kfb[buf][i4] = *(const bf16x8*)(Kg + (size_t)kpos_ * 64 + lch * 8); vcb[buf][i4] = *(const u32x4*)(Vg + (size_t)kpos_ * 64 + lch * 8); } (void)br_; (void)ratio_; } while (0)
#define DL_STORE(buf) do { \
    _Pragma("unroll") for (int i4 = 0; i4 < 4; ++i4) { const int row_ = 8 * i4 + lrow; const int sw_ = (((row_ >> 1) & 1) << 2) ^ ((row_ >> 2) & 3); \
      *(u32x4*)(vt + row_ * 128 + ((lch ^ sw_) << 4)) = vcb[buf][i4]; \
      *(bf16x8*)(ktl + row_ * 128 + ((lch ^ ((row_ >> 1) & 7)) << 4)) = kfb[buf][i4]; } } while (0)
#define DL_COMPUTE(buf, tau_) do { DL_PARAMS(tau_) \
    const int kfirst_ = qbase + d_ * n0_, klast_ = qbase + d_ * (n0_ + 31); \
    const int base_ = n0_ + 4 * h - ratio_ * r32; const float* tb_ = tabA + br_ * 132; \
    f32x16 sT; \
    _Pragma("unroll") for (int r = 0; r < 16; ++r) { int dd = base_ + (r & 3) + 8 * (r >> 2); dd = dd < -65 ? -65 : (dd > 65 ? 65 : dd); sT[r] = tb_[dd + 65]; } \
    if (kfirst_ < 0 || klast_ >= S) { _Pragma("unroll") for (int r = 0; r < 16; ++r) { const int kp = qbase + d_ * (n0_ + crow(r, h)); if (kp < 0 || kp >= S) sT[r] = NEG_BIG; } } \
    _Pragma("unroll") for (int ks = 0; ks < 4; ++ks) { const bf16x8 ka_ = *(const bf16x8*)(ktl + r32 * 128 + (((2 * ks + h) ^ ((r32 >> 1) & 7)) << 4)); sT = MFMA32(ka_, qf[ks], sT); } \
    float ls = 0.f; \
    _Pragma("unroll") for (int r = 0; r < 16; ++r) { sT[r] = __builtin_amdgcn_exp2f(sT[r]); ls += sT[r]; } \
    l += ls; \
    bf16x8 pb[2]; \
    _Pragma("unroll") for (int s2 = 0; s2 < 2; ++s2) { \
      u32x4 pw; pw[0] = pk2(sT[8 * s2 + 0], sT[8 * s2 + 1]); pw[1] = pk2(sT[8 * s2 + 2], sT[8 * s2 + 3]); \
      pw[2] = pk2(sT[8 * s2 + 4], sT[8 * s2 + 5]); pw[3] = pk2(sT[8 * s2 + 6], sT[8 * s2 + 7]); \
      pb[s2] = __builtin_bit_cast(bf16x8, pw); } \
    _Pragma("unroll") for (int nb = 0; nb < 2; ++nb) _Pragma("unroll") for (int s2 = 0; s2 < 2; ++s2) { \
        const s16x4 lo = tr_read(vt + vrb[nb][0] + s2 * 2048); const s16x4 hi = tr_read(vt + vrb[nb][1] + s2 * 2048); \
        O[nb] = MFMA32(cat8(lo, hi), pb[s2], O[nb]); } \
  } while (0)
  DL_LOAD(0, 0);
#pragma unroll 1
  for (int tau = 0; tau < NTILE; ++tau) {
    DL_STORE(0);
    { const int tn = (tau + 1 < NTILE) ? tau + 1 : tau; DL_LOAD(0, tn); }
    DL_COMPUTE(0, tau);
  }
#undef DL_PARAMS
#undef DL_LOAD
#undef DL_STORE
#undef DL_COMPUTE
  const float ltot = l + __shfl_xor(l, 32);
  if (PASS == 1) {
#pragma unroll
    for (int nb = 0; nb < 2; ++nb)
#pragma unroll
      for (int g4 = 0; g4 < 4; ++g4) {
        const int ch = 8 * nb + 2 * g4 + h;
        u32x2 o; o[0] = pk2(O[nb][4 * g4 + 0], O[nb][4 * g4 + 1]); o[1] = pk2(O[nb][4 * g4 + 2], O[nb][4 * g4 + 3]);
        *(u32x2*)(dpart + tl * 128 + ((ch ^ psw) << 3)) = o;
      }
    if (h == 0) dl[tl] = ltot;
  } else {
    const float inv = 1.0f / ltot;
    u16* mix = (u16*)((unsigned char*)p.out + OUT_MIX) + (size_t)(seq_start + qpos) * 1024 + hd * 64;
#pragma unroll
    for (int nb = 0; nb < 2; ++nb)
#pragma unroll
      for (int g4 = 0; g4 < 4; ++g4) {
        const int d0 = 32 * nb + 8 * g4 + 4 * h;
        u32x2 o; o[0] = pk2(O[nb][4 * g4 + 0] * inv, O[nb][4 * g4 + 1] * inv); o[1] = pk2(O[nb][4 * g4 + 2] * inv, O[nb][4 * g4 + 3] * inv);
        *(u32x2*)(mix + d0) = o;
      }
  }
}

DI void phase_attn(const Params& p, unsigned char* lds) {
  const int tid = threadIdx.x;
  float* misc = (float*)(lds + AL_MISC);
  if (tid == 0) {
    float gqa = 0.f, gka = 0.f, gqb = 0.f, gkb = 0.f, bm = 0.f;
    for (int i = 0; i < 64; ++i) { gqa = fmaxf(gqa, fabsf(p.q_norm_a[i])); gka = fmaxf(gka, fabsf(p.k_norm_a[i])); gqb = fmaxf(gqb, fabsf(p.q_norm_b[i])); gkb = fmaxf(gkb, fabsf(p.k_norm_b[i])); }
    for (int i = 0; i < 32 * 12; ++i) bm = fmaxf(bm, fabsf(p.rel_bias[i]));
    const float M2 = 8.0f * LOG2E * fmaxf(gqa * gka, gqb * gkb) * 1.02f + bm * LOG2E + 0.1f;
    float s1 = 0.f, s2 = 0.f;
    for (int i = 0; i < 64; ++i) { s1 += p.lq1[i] * p.lk1[i]; s2 += p.lq2[i] * p.lk2[i]; }
    misc[0] = M2; misc[1] = expf(s1) - expf(s2) + 0.2f;
    for (int hd = 0; hd < 4; ++hd) { misc[8 + hd] = p.rel_bias[15 * 12 + 8 + hd] * LOG2E; misc[12 + hd] = (p.rel_bias[31 * 12 + 8 + hd] - p.rel_bias[15 * 12 + 8 + hd]) * LOG2E; }
  }
  __syncthreads();
  const float M2 = misc[0], lam = misc[1];
  {
    float* tabA = (float*)(lds + AL_TABA);
    for (int i = tid; i < 8 * 3 * 132; i += NTHR) {
      int hd = i / 396, rem = i % 396, br = rem / 132, idx = rem % 132;
      int dl = idx - 65; float v = NEG_BIG;
      if (dl >= -64 && dl <= 64 && idx < 131) { int d = (br == 0) ? 16 : (br == 1) ? 4 : 1; v = p.rel_bias[rel_bucket(dl * d) * 12 + hd] * LOG2E - M2; }
      tabA[i] = v;
    }
  }
#ifndef REP_DIFF
#define REP_DIFF 1
#endif
#ifndef REP_DIL
#define REP_DIL 1
#endif
  int cur_hd = -1;
  for (int rep_ = 0; rep_ < REP_DIFF; ++rep_)
  for (int vb = blockIdx.x; vb < 256; vb += gridDim.x) {
    const int xl = vb & 7, rk = vb >> 3;
#pragma unroll 1
    for (int rnd = 0; rnd < 8; ++rnd) {
      int seq_start, S, hd, q0;
      if (rnd < 4) { const int pair = xl + 8 * rnd; hd = pair & 3; S = 4096; seq_start = (pair >> 2) * 4096; q0 = rk * 128; }
      else { const int pair = 8 * xl + 2 * (rnd - 4) + (rk >> 4); hd = pair & 3; S = 2048; seq_start = T_PROMPT + (pair >> 2) * 2048; q0 = (rk & 15) * 128; }
      if (hd != cur_hd) {
        __syncthreads();
        float* tab = (float*)(lds + AL_TAB);
        for (int i = tid; i < 1281; i += NTHR) tab[i] = p.rel_bias[rel_bucket(i - 640) * 12 + 8 + hd] * LOG2E - misc[8 + hd];
        cur_hd = hd;
        __syncthreads();
      }
#ifndef PROBE_VAR
#define PROBE_VAR 0
#endif
      if (rep_ == 0) diff_unit<0>(p, lds, seq_start, S, hd, q0, lam); else diff_unit<PROBE_VAR>(p, lds, seq_start, S, hd, q0, lam);
    }
  }
  __syncthreads();
  const int w = tid >> 6;
  for (int rep_ = 0; rep_ < REP_DIL; ++rep_)
  for (int vb = blockIdx.x; vb < 256; vb += gridDim.x)
#pragma unroll 1
  for (int rnd = 0; rnd < 4; ++rnd) {
    const int xl = vb & 7, rk = vb >> 3;
    int seq_start, S, hd, i0;
    if (rnd < 2) { const int pair = xl * 8 + rnd * 4 + (rk >> 3); hd = pair & 7; S = 4096; seq_start = (pair >> 3) * 4096; i0 = (rk & 7) * 512; }
    else { const int pair = xl * 16 + (rnd - 2) * 8 + (rk >> 2); hd = pair & 7; S = 2048; seq_start = T_PROMPT + (pair >> 3) * 2048; i0 = (rk & 3) * 512; }
    __syncthreads();
#pragma unroll 1
    for (int u2 = 0; u2 < 2; ++u2) dil_wave_item<1>(p, lds, seq_start, S, hd, i0, w + 8 * u2);
    __syncthreads();
#pragma unroll 1
    for (int u2 = 0; u2 < 2; ++u2) dil_wave_item<2>(p, lds, seq_start, S, hd, i0, w + 8 * u2);
  }
}

struct EpiOut {
  static constexpr bool PERM = false, AFTER_DRAIN = false, HEADPERM = false;
  const float* xp; const float* xs; u16* x1;
  __device__ __forceinline__ void operator()(const pg8::f32x4 (&acc)[2][2][4][2], const pg8::Unit& u, int wr, int wc, int fr, int fq) const {
    const int col0 = u.pn * 256 + wc * 32 + 4 * fq;
#pragma unroll
    for (int ai = 0; ai < 2; ++ai)
#pragma unroll
      for (int m = 0; m < 4; ++m) {
        const int t = u.pm * 256 + ai * 128 + wr * 64 + m * 16 + fr;
        const float* xr = ((t < T_PROMPT) ? xp + (size_t)t * DM : xs + (size_t)(t - T_PROMPT) * DM) + col0;
        u16* orow = x1 + (size_t)t * DM + col0;
#pragma unroll
        for (int bj = 0; bj < 2; ++bj)
#pragma unroll
          for (int n = 0; n < 2; ++n) {
            const f32x4 xv = *(const f32x4*)(xr + bj * 128 + n * 16);
            const f32x4 sv_ = xv + acc[ai][bj][m][n];
            u32x2 o; o[0] = pk2(sv_[0], sv_[1]); o[1] = pk2(sv_[2], sv_[3]);
            *(u32x2*)(orow + bj * 128 + n * 16) = o;
          }
      }
  }
};

DI void phase_outproj(const Params& p, unsigned char* lds) {
  pg8::Gemm g{(const u16*)((const unsigned char*)p.out + OUT_MIX), (const u16*)(p.ws + WS_WOUT), T_TOK, 1024, 1024};
  pg8::StaticOrder S; S.init(T_TOK, 1024, (int)gridDim.x, (int)blockIdx.x);
  EpiOut E{p.x_prompt, p.x_sample, (u16*)(p.ws + WS_X1)};
  pg8::gemm_phase<EpiOut, pg8::StaticOrder, true, true>((PG8_LAS unsigned char*)lds, g, S, E);
}

DI void phase_norm2(const Params& p) {
  const int tid = threadIdx.x, lane = tid & 63, w = tid >> 6;
  const u16* x1 = (const u16*)(p.ws + WS_X1);
  u16* hb = (u16*)(p.ws + WS_H);
  float* hamax = (float*)(p.ws + WS_MISC + MISC_HAMAX);
  for (int it = blockIdx.x; it < T_TOK / 16; it += gridDim.x) {
    const int t = it * 16 + w, t2 = t + 8;
    norm_row2<true>(x1 + (size_t)t * DM, x1 + (size_t)t2 * DM, p.ffn_norm_g, hb + (size_t)t * DM, hb + (size_t)t2 * DM, lane, hamax + t, hamax + t2);
  }
}

struct EpiQp {
  static constexpr bool PERM = true, AFTER_DRAIN = false, HEADPERM = false;
  u16* O;
  __device__ __forceinline__ void operator()(const pg8::f32x4 (&acc)[2][2][4][2], const pg8::Unit& u, int wr, int wc, int fr, int fq) const {
    const int col0 = u.pn * 256 + wc * 32 + 8 * fq;
#pragma unroll
    for (int ai = 0; ai < 2; ++ai)
#pragma unroll
      for (int m = 0; m < 4; ++m) {
        const int t = u.pm * 256 + ai * 128 + wr * 64 + m * 16 + fr;
        u16* rowp = O + (size_t)t * 2048 + col0;
#pragma unroll
        for (int bj = 0; bj < 2; ++bj) {
          const f32x4 v0 = acc[ai][bj][m][0], v1 = acc[ai][bj][m][1];
          u32x4 o; o[0] = pk2(v0[0], v0[1]); o[1] = pk2(v0[2], v0[3]); o[2] = pk2(v1[0], v1[1]); o[3] = pk2(v1[2], v1[3]);
          *(u32x4*)(rowp + bj * 128) = o;
        }
      }
  }
};

DI void phase_peer_query(const Params& p, unsigned char* lds) {
  pg8::Gemm g{(const u16*)(p.ws + WS_H), (const u16*)(p.ws + WS_WQ), T_TOK, 2048, 1024};
  pg8::StaticOrder S; S.init(T_TOK, 2048, (int)gridDim.x, (int)blockIdx.x);
  EpiQp E{(u16*)p.out};
  pg8::gemm_phase<EpiQp, pg8::StaticOrder, true, true>((PG8_LAS unsigned char*)lds, g, S, E);
}

DI int f2sort(float f) { const int b = __float_as_int(f); return b ^ ((b >> 31) & 0x7fffffff); }
DI float sort2f(int s) { return __int_as_float(s ^ ((s >> 31) & 0x7fffffff)); }
#define CE_DESC(a, b) do { const int mx_ = max((a), (b)), mn_ = min((a), (b)); (a) = mx_; (b) = mn_; } while (0)
#define CE_ASC(a, b) do { const int mx_ = max((a), (b)), mn_ = min((a), (b)); (a) = mn_; (b) = mx_; } while (0)
template <int OFF> DI void sort16_desc(int (&x)[64]) {
#pragma unroll
  for (int k = 2; k <= 16; k <<= 1)
#pragma unroll
    for (int j = k >> 1; j > 0; j >>= 1)
#pragma unroll
      for (int i = 0; i < 16; ++i) {
        const int l = i ^ j;
        if (l > i) { if ((i & k) == 0) CE_DESC(x[OFF + i], x[OFF + l]); else CE_ASC(x[OFF + i], x[OFF + l]); }
      }
}
template <int A, int B> DI void merge16x(int (&x)[64]) {
#pragma unroll
  for (int i = 0; i < 16; ++i) x[A + i] = max(x[A + i], x[B + 15 - i]);
#pragma unroll
  for (int j = 8; j > 0; j >>= 1)
#pragma unroll
    for (int i = 0; i < 16; ++i) { const int l = i ^ j; if (l > i) CE_DESC(x[A + i], x[A + l]); }
}

DI void pack_hq(unsigned w0, unsigned w1, unsigned w2, unsigned w3, float sc, unsigned& HH, unsigned& LL) {
  const float MAGIC = 12582912.0f + 136.0f;
  const unsigned y0 = __float_as_uint(__builtin_fmaf(__uint_as_float(w0 << 16), sc, MAGIC)), y1 = __float_as_uint(__builtin_fmaf(__uint_as_float(w0 & 0xffff0000u), sc, MAGIC));
  const unsigned y2 = __float_as_uint(__builtin_fmaf(__uint_as_float(w1 << 16), sc, MAGIC)), y3 = __float_as_uint(__builtin_fmaf(__uint_as_float(w1 & 0xffff0000u), sc, MAGIC));
  const unsigned y4 = __float_as_uint(__builtin_fmaf(__uint_as_float(w2 << 16), sc, MAGIC)), y5 = __float_as_uint(__builtin_fmaf(__uint_as_float(w2 & 0xffff0000u), sc, MAGIC));
  const unsigned y6 = __float_as_uint(__builtin_fmaf(__uint_as_float(w3 << 16), sc, MAGIC)), y7 = __float_as_uint(__builtin_fmaf(__uint_as_float(w3 & 0xffff0000u), sc, MAGIC));
  const unsigned W = (y0 & 255u) | ((y1 & 255u) << 8) | ((y2 & 255u) << 16) | (y3 << 24);
  const unsigned X = (y4 & 255u) | ((y5 & 255u) << 8) | ((y6 & 255u) << 16) | (y7 << 24);
  HH = (((W >> 4) & 0x0F0F0F0Fu) | (X & 0xF0F0F0F0u)) ^ 0x88888888u;
  LL = ((W & 0x0F0F0F0Fu) | ((X << 4) & 0xF0F0F0F0u)) ^ 0x88888888u;
}
DI void quantise_h_rows(const Params& p, int t0, int lane) {
  const float* hamax = (const float*)(p.ws + WS_MISC + MISC_HAMAX);
  unsigned char* Hrow = p.ws + WS_H;
#pragma unroll 1
  for (int rr = 0; rr < 32; rr += 4) {
    u32x4 ha[4], hb[4]; float sc[4];
#pragma unroll
    for (int q = 0; q < 4; ++q) {
      const unsigned char* src = Hrow + (size_t)(t0 + rr + q) * 2048 + lane * 32;
      ha[q] = *(const u32x4*)src; hb[q] = *(const u32x4*)(src + 16);
      const float am = hamax[t0 + rr + q];
      sc[q] = (am > 0.f) ? 119.0f / am : 0.f;
    }
#pragma unroll
    for (int q = 0; q < 4; ++q) {
      unsigned h0, l0, h1, l1;
      pack_hq(ha[q][0], ha[q][1], ha[q][2], ha[q][3], sc[q], h0, l0);
      pack_hq(hb[q][0], hb[q][1], hb[q][2], hb[q][3], sc[q], h1, l1);
      u32x2 hi, lo; hi[0] = h0; hi[1] = h1; lo[0] = l0; lo[1] = l1;
      unsigned char* dst = Hrow + (size_t)(t0 + rr + q) * 2048 + (lane >> 4) * 256 + (lane & 15) * 8;
      *(u32x2*)dst = hi; *(u32x2*)(dst + 128) = lo;
    }
  }
}

DI void phase_peer_route(const Params& p, unsigned char* lds) {
  const u16* QP = (const u16*)p.out;
  const u16* SK = (const u16*)(p.ws + WS_SK);
  u16* eidx = (u16*)(p.ws + WS_EIDX);
  float* gg = (float*)(p.ws + WS_G);
  const int tid = threadIdx.x, lane = tid & 63, r32 = lane & 31, h = lane >> 5;
  const int w = __builtin_amdgcn_readfirstlane(tid >> 6);
  unsigned char* SKl = lds;
  float* v2l = (float*)(lds + 65536);
  __syncthreads();
#pragma unroll
  for (int i = 0; i < 8; ++i) {
    const int c = tid + 512 * i; const int zz = c >> 11, row = (c >> 4) & 127, ch = c & 15;
    const u32x4 v = *(const u32x4*)(SK + (size_t)zz * 16384 + row * 128 + ch * 8);
    *(u32x4*)(SKl + zz * 32768 + row * 256 + ((ch ^ (row & 15)) << 4)) = v;
  }
  __syncthreads();
  for (int item = blockIdx.x; item < T_TOK / 256; item += gridDim.x) {
    quantise_h_rows(p, item * 256 + w * 32, lane);
    const int t = item * 256 + w * 32 + r32;
    const u16* qrow = QP + (size_t)t * 2048;
    bf16x8 qf[8];
#pragma unroll
    for (int ks = 0; ks < 8; ++ks) qf[ks] = *(const bf16x8*)(qrow + ks * 16 + h * 8);
#pragma unroll 1
    for (int pp = 0; pp < 8; ++pp) {
      int lists[2][16];
#pragma unroll
      for (int z = 0; z < 2; ++z) {
        const int c16 = pp * 2 + z;
        int x[64];
        {
          f32x16 S2[4];
#pragma unroll
          for (int kb = 0; kb < 4; ++kb)
#pragma unroll
            for (int r = 0; r < 16; ++r) S2[kb][r] = 0.f;
#pragma unroll
          for (int ks = 0; ks < 8; ++ks)
#pragma unroll
            for (int kb = 0; kb < 4; ++kb) {
              const int key = kb * 32 + r32;
              const bf16x8 a = *(const bf16x8*)(SKl + z * 32768 + key * 256 + (((2 * ks + h) ^ (key & 15)) << 4));
              S2[kb] = MFMA32(a, qf[ks], S2[kb]);
            }
          {
            const int cn = (c16 + 1 < 16) ? c16 + 1 : 15;
#pragma unroll
            for (int ks = 0; ks < 8; ++ks) qf[ks] = *(const bf16x8*)(qrow + cn * 128 + ks * 16 + h * 8);
          }
#pragma unroll
          for (int e = 0; e < 64; ++e) {
            const int kidx = 32 * (e >> 4) + (e & 3) + 8 * ((e & 15) >> 2) + 4 * h;
            x[e] = (f2sort(S2[e >> 4][e & 15]) & ~127) | kidx;
          }
        }
        sort16_desc<0>(x); sort16_desc<16>(x); sort16_desc<32>(x); sort16_desc<48>(x);
        merge16x<0, 16>(x); merge16x<32, 48>(x); merge16x<0, 32>(x);
#pragma unroll
        for (int i = 0; i < 16; ++i) x[16 + i] = __shfl_xor(x[i], 32);
        merge16x<0, 16>(x);
#pragma unroll
        for (int i = 0; i < 16; ++i) lists[z][i] = x[i];
      }
      float v1h[8];
#pragma unroll
      for (int i = 0; i < 8; ++i) { const int a0_ = lists[0][i], a1_ = lists[0][8 + i]; v1h[i] = sort2f(a0_ ^ ((a0_ ^ a1_) & -h)); }
#pragma unroll
      for (int i = 0; i < 16; ++i) v2l[i * 512 + tid] = sort2f(lists[1][i]);
      unsigned ptrs = 0u;
      float bestv[16]; int be[16];
#pragma unroll
      for (int rd = 0; rd < 16; ++rd) {
        float best = -3.0e38f, bv1 = 0.f, bv2 = 0.f; int ab = 0;
#pragma unroll
        for (int a = 0; a < 8; ++a) {
          const int b = (int)((ptrs >> (4 * a)) & 15u);
          const float v2 = v2l[b * 512 + tid];
          const float cnd = v1h[a] + v2;
          if (cnd > best) { best = cnd; ab = a; bv1 = v1h[a]; bv2 = v2; }
        }
        const float obest = __shfl_xor(best, 32), obv1 = __shfl_xor(bv1, 32), obv2 = __shfl_xor(bv2, 32);
        const bool mine = h ? (best > obest) : (best >= obest);
        const float wbest = mine ? best : obest, w1 = mine ? bv1 : obv1, w2 = mine ? bv2 : obv2;
        bestv[rd] = wbest; be[rd] = (f2sort(w1) & 127) * 128 + (f2sort(w2) & 127);
        if (mine) ptrs += 1u << (4 * ab);
      }
      if (h == 0) {
        float ex[16]; float sum = 0.f;
#pragma unroll
        for (int rd = 0; rd < 16; ++rd) { ex[rd] = __expf(bestv[rd] - bestv[0]); sum += ex[rd]; }
        const float inv = 1.0f / sum;
        const size_t oo = ((size_t)t * 8 + pp) * 16;
#pragma unroll
        for (int q4 = 0; q4 < 4; ++q4) { f32x4 v = {ex[4 * q4] * inv, ex[4 * q4 + 1] * inv, ex[4 * q4 + 2] * inv, ex[4 * q4 + 3] * inv}; *(f32x4*)(gg + oo + 4 * q4) = v; }
        u32x4 e0, e1;
#pragma unroll
        for (int j = 0; j < 4; ++j) { e0[j] = (unsigned)be[2 * j] | ((unsigned)be[2 * j + 1] << 16); e1[j] = (unsigned)be[8 + 2 * j] | ((unsigned)be[8 + 2 * j + 1] << 16); }
        *(u32x4*)(eidx + oo) = e0; *(u32x4*)(eidx + oo + 8) = e1;
      }
    }
  }
}

typedef float f2_t __attribute__((ext_vector_type(2)));
DI unsigned xcc_id() { return (unsigned)__builtin_amdgcn_s_getreg((3 << 11) | 20) & 7u; }
constexpr int PG_CHUNK_TOK = 64;
constexpr int PG_NCHUNK = T_TOK / PG_CHUNK_TOK;

DI void dec32(const u32x4& r, f2_t (&v)[16]) {
#pragma unroll
  for (int d = 0; d < 4; ++d) {
    v[4 * d + 0] = __builtin_amdgcn_cvt_scalef32_pk_f32_fp4(r[d], 1.0f, 0); v[4 * d + 1] = __builtin_amdgcn_cvt_scalef32_pk_f32_fp4(r[d], 1.0f, 1);
    v[4 * d + 2] = __builtin_amdgcn_cvt_scalef32_pk_f32_fp4(r[d], 1.0f, 2); v[4 * d + 3] = __builtin_amdgcn_cvt_scalef32_pk_f32_fp4(r[d], 1.0f, 3);
  }
}

template <int CTRL> DI float dpp_f(float x) { return __int_as_float(__builtin_amdgcn_update_dpp(0, __float_as_int(x), CTRL, 0xf, 0xf, true)); }
DI int idx16(const u32x4& a, const u32x4& b, int i) { const unsigned wd = (i < 8) ? a[(i & 7) >> 1] : b[(i & 7) >> 1]; return (i & 1) ? (int)(wd >> 16) : (int)(wd & 0xffffu); }
constexpr int PEER_NT = 16;
template <int WHICH>
DI void peer_wave_tokens(const Params& p, int x, int tb, int lane) {
  const unsigned char* TBL = p.ws + (WHICH ? WS_V : WS_U) + (size_t)x * 16384 * 128;
  const u16* Hb = (const u16*)(p.ws + WS_H);
  const u16* eidx = (const u16*)(p.ws + WS_EIDX);
  const u16* w16 = (const u16*)(p.ws + WS_W16);
  const float* x1 = (const float*)(p.ws + WS_X1);
  float* zpart = (float*)(p.ws + WS_ZP);
  const int r = lane >> 3, c = lane & 7;
  u32x4 ei[2][2]; u32x4 wv[2][2]; u32x4 rows[2][16]; u32x4 hsl[2][2];
#define PEER_LOAD_IDX(buf, k) do { const size_t o_ = (size_t)(tb + (k)) * 128 + r * 16; \
    ei[buf][0] = *(const u32x4*)(eidx + o_); ei[buf][1] = *(const u32x4*)(eidx + o_ + 8); \
    if (WHICH) { wv[buf][0] = *(const u32x4*)(w16 + o_); wv[buf][1] = *(const u32x4*)(w16 + o_ + 8); } } while (0)
#define PEER_LOAD_ROWS4(buf, ibuf, g) do { _Pragma("unroll") for (int ii_ = 0; ii_ < 4; ++ii_) { \
      const unsigned off_ = (unsigned)idx16(ei[ibuf][0], ei[ibuf][1], 4 * (g) + ii_) * 128u + (unsigned)c * 16u; \
      rows[buf][4 * (g) + ii_] = *(const u32x4*)(TBL + off_); } } while (0)
#define PEER_LOAD_ROWS(buf, ibuf) do { PEER_LOAD_ROWS4(buf, ibuf, 0); PEER_LOAD_ROWS4(buf, ibuf, 1); PEER_LOAD_ROWS4(buf, ibuf, 2); PEER_LOAD_ROWS4(buf, ibuf, 3); } while (0)
#define PEER_NEXT4(g) do { __builtin_amdgcn_sched_barrier(0); if (k + 1 < PEER_NT) PEER_LOAD_ROWS4((k + 1) & 1, (k + 1) & 1, g); __builtin_amdgcn_sched_barrier(0); } while (0)
#define PEER_LOAD_H(buf, k) do { if (WHICH == 0) { const unsigned char* hq_ = (const unsigned char*)Hb + (size_t)(tb + (k)) * 2048 + x * 256 + c * 16;     \
    hsl[buf][0] = *(const u32x4*)(hq_); hsl[buf][1] = *(const u32x4*)(hq_ + 128); } } while (0)
  PEER_LOAD_IDX(0, 0); PEER_LOAD_IDX(1, 1);
  PEER_LOAD_H(0, 0);
  PEER_LOAD_ROWS(0, 0);
#pragma unroll
  for (int k = 0; k < PEER_NT; ++k) {
    const int t = tb + k;
    u32x4 wcur[2];
    if (WHICH) { wcur[0] = wv[k & 1][0]; wcur[1] = wv[k & 1][1]; }
    if (k + 2 < PEER_NT) PEER_LOAD_IDX(k & 1, k + 2);
    if (k + 1 < PEER_NT) PEER_LOAD_H((k + 1) & 1, k + 1);
    if (WHICH == 0) {
      const u32x4 hh = hsl[k & 1][0], hl = hsl[k & 1][1];
      float sv[16];
#pragma unroll
      for (int i = 0; i < 16; ++i) {
        if ((i & 3) == 0) PEER_NEXT4(i >> 2);
        int ah = __builtin_amdgcn_sdot8((int)rows[k & 1][i][0], (int)hh[0], 0, false);
        int al = __builtin_amdgcn_sdot8((int)rows[k & 1][i][0], (int)hl[0], 0, false);
        ah = __builtin_amdgcn_sdot8((int)rows[k & 1][i][1], (int)hh[1], ah, false);
        al = __builtin_amdgcn_sdot8((int)rows[k & 1][i][1], (int)hl[1], al, false);
        ah = __builtin_amdgcn_sdot8((int)rows[k & 1][i][2], (int)hh[2], ah, false);
        al = __builtin_amdgcn_sdot8((int)rows[k & 1][i][2], (int)hl[2], al, false);
        ah = __builtin_amdgcn_sdot8((int)rows[k & 1][i][3], (int)hh[3], ah, false);
        al = __builtin_amdgcn_sdot8((int)rows[k & 1][i][3], (int)hl[3], al, false);
        int a = ah * 16 + al;
        a += __builtin_amdgcn_update_dpp(0, a, 0xB1, 0xf, 0xf, true);
        a += __builtin_amdgcn_update_dpp(0, a, 0x4E, 0xf, 0xf, true);
        a += __builtin_amdgcn_update_dpp(0, a, 0x141, 0xf, 0xf, true);
        sv[i] = (float)a;
      }
      float o0 = 0.f, o1 = 0.f;
#pragma unroll
      for (int i = 0; i < 8; ++i) { if (c == i) { o0 = sv[i]; o1 = sv[i + 8]; } }
      float* zp = zpart + ((size_t)x * T_TOK + t) * 128 + r * 16;
      zp[c] = o0; zp[c + 8] = o1;
    } else {
      f2_t acc[16];
#pragma unroll
      for (int q = 0; q < 16; ++q) { acc[q][0] = 0.f; acc[q][1] = 0.f; }
#pragma unroll
      for (int i = 0; i < 16; ++i) {
        if ((i & 3) == 0) PEER_NEXT4(i >> 2);
        f2_t v[16]; dec32(rows[k & 1][i], v);
        const unsigned wd_ = wcur[i >> 3][(i & 7) >> 1];
        const float wj = (i & 1) ? __uint_as_float(wd_ & 0xffff0000u) : __uint_as_float(wd_ << 16);
        f2_t ww = {wj, wj};
#pragma unroll
        for (int q = 0; q < 16; ++q) acc[q] = __builtin_elementwise_fma(v[q], ww, acc[q]);
      }
      f2_t b8[8];
      {
        const bool up = (lane & 32) != 0;
#pragma unroll
        for (int q = 0; q < 8; ++q) {
          f2_t keep = up ? acc[8 + q] : acc[q], send = up ? acc[q] : acc[8 + q];
          f2_t got; got[0] = __shfl_xor(send[0], 32); got[1] = __shfl_xor(send[1], 32);
          b8[q] = keep + got;
        }
      }
      f2_t b4[4];
      {
        const bool up = (lane & 16) != 0;
#pragma unroll
        for (int q = 0; q < 4; ++q) {
          f2_t keep = up ? b8[4 + q] : b8[q], send = up ? b8[q] : b8[4 + q];
          f2_t got; got[0] = __shfl_xor(send[0], 16); got[1] = __shfl_xor(send[1], 16);
          b4[q] = keep + got;
        }
      }
      f2_t b2[2];
      {
        const bool up = (lane & 8) != 0;
#pragma unroll
        for (int q = 0; q < 2; ++q) {
          f2_t keep = up ? b4[2 + q] : b4[q], send = up ? b4[q] : b4[2 + q];
          f2_t got; got[0] = dpp_f<0x128>(send[0]); got[1] = dpp_f<0x128>(send[1]);
          b2[q] = keep + got;
        }
      }
      const size_t o = (size_t)t * DM + x * 256 + c * 32 + 4 * r;
      const f32x4 xv = *(const f32x4*)(x1 + o);
      f32x4 res; res[0] = xv[0] + b2[0][0]; res[1] = xv[1] + b2[0][1]; res[2] = xv[2] + b2[1][0]; res[3] = xv[3] + b2[1][1];
      *(f32x4*)(p.out + o) = res;
    }
  }
#undef PEER_LOAD_IDX
#undef PEER_LOAD_H
#undef PEER_LOAD_ROWS
#undef PEER_LOAD_ROWS4
#undef PEER_NEXT4
}

typedef int v8i_t __attribute__((ext_vector_type(8)));
template <int NTOK, int VAR = 0>
DI void peer_tokens_v(const Params& p, unsigned char* ldsw, int t0, int lane) {
  const unsigned char* TBL = p.ws + WS_V;
  const u16* eidx = (const u16*)(p.ws + WS_EIDX);
  const unsigned char* w8 = p.ws + WS_W16;
  const u16* x1 = (const u16*)(p.ws + WS_X1);
  const int j = lane & 31, kg = lane >> 5;
  unsigned M[4];
#pragma unroll
  for (int q = 0; q < 4; ++q) M[q] = (kg == (j >> 4) && ((j & 15) >> 2) == q) ? (0xFFu << (8 * (j & 3))) : 0u;
  u32x4 ei[2][2]; u32x4 wv[2][2]; u32x4 rows[2][16];
#define PV_LOAD_IDX(u) do { const size_t o_ = (size_t)(t0 + ((u) >> 2)) * 128 + 16 * ((u) & 3); \
    ei[(u) & 1][0] = *(const u32x4*)(eidx + o_ + 64 * kg); ei[(u) & 1][1] = *(const u32x4*)(eidx + o_ + 64 * kg + 8); } while (0)
#define PV_LOAD_W(u) do { const size_t o_ = (size_t)(t0 + ((u) >> 2)) * 128 + 16 * ((u) & 3); \
    wv[(u) & 1][0] = *(const u32x4*)(w8 + o_); wv[(u) & 1][1] = *(const u32x4*)(w8 + o_ + 64); } while (0)
#define PV_IDX(ibuf, n) (((n) & 1) ? (ei[ibuf][(n) >> 3][((n) & 7) >> 1] >> 16) : (ei[ibuf][(n) >> 3][((n) & 7) >> 1] & 0xffffu))
#define PV_LOAD_ROWS4(u, g) do { _Pragma("unroll") for (int ii_ = 0; ii_ < 4; ++ii_) { \
      const unsigned off_ = (unsigned)PV_IDX((u) & 1, 4 * (g) + ii_) * 512u + (unsigned)j * 16u; \
      rows[(u) & 1][4 * (g) + ii_] = *(const u32x4*)(TBL + off_); } } while (0)
  constexpr int NU = 4 * NTOK;
  PV_LOAD_IDX(0); PV_LOAD_IDX(1); PV_LOAD_W(0);
  PV_LOAD_ROWS4(0, 0); PV_LOAD_ROWS4(0, 1); PV_LOAD_ROWS4(0, 2); PV_LOAD_ROWS4(0, 3);
  PV_LOAD_ROWS4(1, 0); PV_LOAD_ROWS4(1, 1); PV_LOAD_ROWS4(1, 2); PV_LOAD_ROWS4(1, 3);
  PV_LOAD_IDX(2);
  f32x16 acc; f32x4 xv[4];
  constexpr int XV_AT = 3;
#pragma unroll
  for (int u = 0; u < NU; ++u) {
    const int t = t0 + (u >> 2), c = u & 3;
    if (c == 0) {
#pragma unroll
      for (int r = 0; r < 16; ++r) acc[r] = 0.f;
    }
    if (c == 2 && VAR != 1) {
#pragma unroll
      for (int rq = 0; rq < 2; ++rq) {
        const u16* gsrc_ = x1 + (size_t)t * DM + 512 * rq + 8 * lane;
        unsigned keep_; const unsigned dst_ = (unsigned)__builtin_amdgcn_readfirstlane((int)((unsigned)(uintptr_t)ldsw + 1024u * rq));
        asm volatile("s_mov_b32 %0, m0\n\ts_mov_b32 m0, %2\n\ts_nop 0\n\tglobal_load_lds_dwordx4 %1, off\n\ts_mov_b32 m0, %0" : "=&s"(keep_) : "v"(gsrc_), "s"(dst_) : "memory");
      }
    }
    if (u + 3 < NU) PV_LOAD_IDX(u + 3);
    if (u + 1 < NU) PV_LOAD_W(u + 1);
#pragma unroll
    for (int n = 0; n < 16; ++n) {
      const unsigned wd1 = wv[u & 1][0][n >> 2], wd2 = wv[u & 1][1][n >> 2];
      const unsigned rep1 = __builtin_amdgcn_perm(wd1, wd1, 0x01010101u * (unsigned)(n & 3));
      const unsigned rep2 = __builtin_amdgcn_perm(wd2, wd2, 0x01010101u * (unsigned)(n & 3));
      v8i_t A, B;
#pragma unroll
      for (int q = 0; q < 4; ++q) { A[q] = (int)(rep1 & M[q]); A[4 + q] = (int)(rep2 & M[q]); }
      B[0] = (int)rows[u & 1][n][0]; B[1] = (int)rows[u & 1][n][1]; B[2] = (int)rows[u & 1][n][2]; B[3] = (int)rows[u & 1][n][3];
      B[4] = 0; B[5] = 0; B[6] = 0; B[7] = 0;
      acc = __builtin_amdgcn_mfma_scale_f32_32x32x64_f8f6f4(A, B, acc, 0  , 4  , 0, 0x7F7F7F7F, 0, 0x7F7F7F7F);
      if ((n & 3) == 3) {
        __builtin_amdgcn_sched_barrier(0);
        if (u + 2 < NU) PV_LOAD_ROWS4(u + 2, n >> 2);
        __builtin_amdgcn_sched_barrier(0);
      }
    }
    if (c == 3) {
      if (VAR != 1) {
        static_assert(NTOK == 4, "the vmcnt immediate below is counted for 16-chunk units");
        if (u + 3 < NU) asm volatile("s_waitcnt vmcnt(40)" ::: "memory");
        else asm volatile("s_waitcnt vmcnt(0)" ::: "memory");
#pragma unroll
        for (int rq = 0; rq < 4; ++rq) {
          const u32x2 r_ = *(const u32x2*)(ldsw + 2 * (32 * j + 8 * rq + 4 * kg));
          xv[rq][0] = __uint_as_float(r_[0] << 16); xv[rq][1] = __uint_as_float(r_[0] & 0xffff0000u); xv[rq][2] = __uint_as_float(r_[1] << 16); xv[rq][3] = __uint_as_float(r_[1] & 0xffff0000u);
        }
      }
#pragma unroll
      for (int rq = 0; rq < 4; ++rq) {
        const size_t o = (size_t)t * DM + 32 * j + 8 * rq + 4 * kg;
        f32x4 res;
#pragma unroll
        for (int q = 0; q < 4; ++q) res[q] = (VAR != 1 ? xv[rq][q] : 0.f) + acc[4 * rq + q] * (1.0f / 2048.0f);
        if (VAR != 1 || res[0] == 123456.789f) *(f32x4*)(p.out + o) = res;
      }
    }
  }
#undef PV_LOAD_IDX
#undef PV_LOAD_W
#undef PV_IDX
#undef PV_LOAD_ROWS4
}
DI void peer_act_range(const Params& p, size_t q_lo, size_t q_hi, int lane) {
  const float* zpart = (const float*)(p.ws + WS_ZP);
  const u16* eidx = (const u16*)(p.ws + WS_EIDX);
  float* wg = (float*)(p.ws + WS_G);
  const float* suinv = (const float*)(p.ws + WS_MISC + MISC_SUINV);
  const float* svinv = (const float*)(p.ws + WS_MISC + MISC_SVINV);
  const float* hamax = (const float*)(p.ws + WS_MISC + MISC_HAMAX);
#pragma unroll 4
  for (size_t i4 = q_lo + lane; i4 < q_hi; i4 += 64) {
    const size_t i = i4 * 4;
    f32x4 z = *(const f32x4*)(zpart + i);
#pragma unroll
    for (int x = 1; x < 4; ++x) { const f32x4 zz = *(const f32x4*)(zpart + (size_t)x * T_TOK * 128 + i); z[0] += zz[0]; z[1] += zz[1]; z[2] += zz[2]; z[3] += zz[3]; }
    const u32x2 ee = *(const u32x2*)(eidx + i);
    const f32x4 g4 = *(const f32x4*)(wg + i);
    const float hs = hamax[i >> 7] * (1.0f / 119.0f);
    float wq[4];
#pragma unroll
    for (int q = 0; q < 4; ++q) {
      const int e = (int)((q & 1) ? (ee[q >> 1] >> 16) : (ee[q >> 1] & 0xffffu));
      const float zq = z[q] * suinv[e] * hs;
      const float act = 0.5f * zq * (1.0f + erff(zq * 0.70710678118654752f));
      wq[q] = fminf(fmaxf(g4[q] * act * svinv[e] * 2048.0f, -448.0f), 448.0f);
    }
    int pk = __builtin_amdgcn_cvt_pk_fp8_f32(wq[0], wq[1], 0, false);
    pk = __builtin_amdgcn_cvt_pk_fp8_f32(wq[2], wq[3], pk, true);
    *(unsigned*)(p.ws + WS_W16 + i) = (unsigned)pk;
  }
}

template <int VAR = 0>
DI void phase_peer_v(const Params& p, unsigned char* lds) {
  const int tid = threadIdx.x, lane = tid & 63;
  const int w = __builtin_amdgcn_readfirstlane(tid >> 6);
  const int gw = blockIdx.x * 8 + w, nw = gridDim.x * 8;
  const int per = (T_TOK / 4 + nw - 1) / nw;
  const int u_lo = gw * per, u_hi = (u_lo + per < T_TOK / 4) ? u_lo + per : T_TOK / 4;
  if (u_lo >= u_hi) return;
  if (VAR == 0) {
    peer_act_range(p, (size_t)u_lo * 4 * 32, (size_t)u_hi * 4 * 32, lane);
    asm volatile("s_waitcnt vmcnt(0)" ::: "memory");
    __builtin_amdgcn_fence(__ATOMIC_ACQUIRE, "agent");
    asm volatile("s_waitcnt vmcnt(0)" ::: "memory");
  }
#pragma unroll 1
  for (int u = u_lo; u < u_hi; ++u) peer_tokens_v<4, VAR>(p, lds + w * 4096, u * 4, lane);
}

template <int WHICH>
DI void phase_peer_sliced(const Params& p, unsigned char* lds) {
  const int tid = threadIdx.x, lane = tid & 63, w = tid >> 6;
  const unsigned* rankctr = (const unsigned*)(p.ws + WS_MISC + MISC_QCTR) + 16;
  volatile PG8_LAS unsigned* st = (volatile PG8_LAS unsigned*)(lds + LDS_BARST);
  int myx = (int)st[9], myr = (int)st[8];
  int n[8]; int tot = 0;
#pragma unroll
  for (int j = 0; j < 8; ++j) { n[j] = (int)__hip_atomic_load(rankctr + j, __ATOMIC_RELAXED, __HIP_MEMORY_SCOPE_AGENT); tot += n[j]; }
  if (tot != (int)gridDim.x || st[10] != 1u) {
    myx = blockIdx.x & 7; myr = blockIdx.x >> 3;
#pragma unroll
    for (int j = 0; j < 8; ++j) n[j] = ((int)gridDim.x + 7 - j) >> 3;
  }
#pragma unroll 1
  for (int s = 0; s < 8; ++s) {
    int owner = s;
#pragma unroll
    for (int d = 0; d < 8; ++d) { if (n[owner & 7] == 0) owner = (owner + 1) & 7; }
    owner &= 7;
    if (owner != myx) continue;
    int nblk = 0;
#pragma unroll
    for (int j = 0; j < 8; ++j) nblk = (j == myx) ? n[j] : nblk;
    const int nw = nblk * 8, wr = myr * 8 + w;
    constexpr int NU = T_TOK / 2 / PEER_NT;
    const int u0 = (int)(((long long)wr * NU) / nw) + (s >> 2) * NU, u1 = (int)(((long long)(wr + 1) * NU) / nw) + (s >> 2) * NU;
#pragma unroll 1
    for (int u = u0; u < u1; ++u) peer_wave_tokens<WHICH>(p, s & 3, u * PEER_NT, lane);
  }
}

#define XB_TMO      128
#define XB_XCNT(j)  (256  + 64 * (j))
#define XB_XSUB(j)  (1280 + 64 * (j))
#define XB_XGEN(j)  (2304 + 64 * (j))
#define XB_TOP      3328
#define XB_TOPGEN   3392
#define XCD_BAR_WORDS 3456
#define XB_SPIN_CAP (1u << 18)
#define LAS __attribute__((address_space(3)))

__device__ __forceinline__ unsigned xb_ld(unsigned* p)              { return __hip_atomic_load(p, __ATOMIC_RELAXED, __HIP_MEMORY_SCOPE_AGENT); }
__device__ __forceinline__ unsigned xb_add(unsigned* p, unsigned v) { return __hip_atomic_fetch_add(p, v, __ATOMIC_RELAXED, __HIP_MEMORY_SCOPE_AGENT); }
__device__ __forceinline__ unsigned xb_xcc_id() { return (unsigned)__builtin_amdgcn_s_getreg((3 << 11) | 20) & 0xFu; }
#define XB_SPIN(cond, bar) do { unsigned _sp = 0; while (cond) { __builtin_amdgcn_s_sleep(1); \
    if ((++_sp & 255u) == 0u) { if (xb_ld(&(bar)[XB_TMO])) break; if (_sp > XB_SPIN_CAP) { atomicAdd(&(bar)[XB_TMO], 1u); break; } } } } while (0)

struct XcdBarrier {
    unsigned* bar; unsigned x;
    volatile LAS unsigned* st;
};

__device__ __forceinline__ XcdBarrier xcd_barrier_post(unsigned* bar, volatile LAS unsigned* st) {
    XcdBarrier b; b.bar = bar; b.x = xb_xcc_id(); b.st = st;
    if (threadIdx.x == 0) (void)xb_add(&bar[XB_XCNT(b.x)], 1u);
    return b;
}
__device__ __forceinline__ void xcd_barrier_complete(unsigned* bar, unsigned x, unsigned& nloc, unsigned& nx) {
    const unsigned G = gridDim.x * gridDim.y * gridDim.z;
    unsigned sum, cnt, mine, sp = 0u;
    for (;;) {
        sum = 0u; cnt = 0u; mine = 0u;
#pragma unroll
        for (unsigned j = 0; j < 16; ++j) { const unsigned c = xb_ld(&bar[XB_XCNT(j)]); sum += c; cnt += (c > 0u) ? 1u : 0u; mine = (j == x) ? c : mine; }
        if (sum == G) break;
        __builtin_amdgcn_s_sleep(1);
        if ((++sp & 255u) == 0u) { if (xb_ld(&bar[XB_TMO])) break; if (sp > XB_SPIN_CAP) { atomicAdd(&bar[XB_TMO], 1u); break; } }
    }
    nloc = mine > 0u ? mine : 1u; nx = cnt > 0u ? cnt : 1u;
}

__device__ __forceinline__ void xcd_barrier(const XcdBarrier& b) {
    asm volatile("s_waitcnt vmcnt(0)" ::: "memory");
    __syncthreads();
    if (threadIdx.x == 0) {
        unsigned* bar = b.bar;
        __builtin_amdgcn_s_waitcnt(0);
        unsigned nloc = b.st[0], nx = b.st[1];
        if (nloc == 0u) { xcd_barrier_complete(bar, b.x, nloc, nx); b.st[0] = nloc; b.st[1] = nx; }
        const unsigned old = xb_add(&bar[XB_XSUB(b.x)], 1u);
        const unsigned gen = old / nloc;
        if (old + 1u == (gen + 1u) * nloc) {
            __builtin_amdgcn_fence(__ATOMIC_RELEASE, "agent");
            asm volatile("s_waitcnt vmcnt(0)" ::: "memory");
            const unsigned og = xb_add(&bar[XB_TOP], 1u);
            const unsigned tg = og / nx;
            if (og + 1u == (tg + 1u) * nx) xb_add(&bar[XB_TOPGEN], 1u);
            else XB_SPIN(xb_ld(&bar[XB_TOPGEN]) == tg, bar);
            __builtin_amdgcn_fence(__ATOMIC_ACQUIRE, "agent");
            xb_add(&bar[XB_XGEN(b.x)], 1u);
            asm volatile("s_waitcnt vmcnt(0)" ::: "memory");
        } else {
            XB_SPIN(xb_ld(&bar[XB_XGEN(b.x)]) == gen, bar);
            __builtin_amdgcn_fence(__ATOMIC_ACQUIRE, "agent");
            asm volatile("s_waitcnt vmcnt(0)" ::: "memory");
        }
    }
    __syncthreads();
}


__global__ void __launch_bounds__(NTHR, 2) fwd_kernel(Params p) {
  extern __shared__ __attribute__((aligned(16))) unsigned char lds[];
  cg::grid_group grid = cg::this_grid();
#ifndef ONLY_PH
#define PHON(k) 1
#else
#define PHON(k) ((k) == ONLY_PH)
#endif
#ifndef REPEAT_MASK
#define REPEAT_MASK 0
#endif
#define GSYNC(k) do { if ((k) == 0) { grid.sync(); xbar = xcd_barrier_post((unsigned*)(p.ws + WS_MISC + MISC_BAR), (volatile LAS unsigned*)(lds + LDS_BARST)); \
    if (threadIdx.x == 0) { volatile LAS unsigned* st_ = (volatile LAS unsigned*)(lds + LDS_BARST); const unsigned x_ = xcc_id(); \
      st_[8] = atomicAdd((unsigned*)(p.ws + WS_MISC + MISC_QCTR) + 16 + x_, 1u); st_[9] = x_; st_[10] = 1u; } \
    __syncthreads(); } else xcd_barrier(xbar); } while (0)
#define RUN_PHASE(k, call) do { if (PHON(k) && lo <= (k) && (k) < hi) { call; if ((REPEAT_MASK >> (k)) & 1) { grid.sync(); call; } } if (lo <= (k) && (k) + 1 < hi) GSYNC(k); } while (0)
  const int lo = p.ph_lo, hi = p.ph_hi;
  if (threadIdx.x < 16) ((volatile LAS unsigned*)(lds + LDS_BARST))[threadIdx.x] = 0u;
  __syncthreads();
  XcdBarrier xbar; xbar.bar = (unsigned*)(p.ws + WS_MISC + MISC_BAR); xbar.x = 0; xbar.st = (volatile LAS unsigned*)(lds + LDS_BARST);
  RUN_PHASE(0, phase_prep(p, lds));
  RUN_PHASE(1, phase_proj(p, lds));
  RUN_PHASE(2, phase_attn(p, lds));
  RUN_PHASE(3, phase_outproj(p, lds));
  RUN_PHASE(4, phase_norm2(p));
  RUN_PHASE(5, phase_peer_query(p, lds));
  RUN_PHASE(6, phase_peer_route(p, lds));
  RUN_PHASE(7, phase_peer_sliced<0>(p, lds));
#ifndef PROBE_PEER
#define PROBE_PEER 0
#endif
  if (PROBE_PEER & 1) { xcd_barrier(xbar); phase_peer_sliced<0>(p, lds); xcd_barrier(xbar); }
  RUN_PHASE(9, phase_peer_v<0>(p, lds));
#ifdef PROBE_VAR9
  grid.sync(); phase_peer_v<PROBE_VAR9>(p, lds);
#endif
  if (PROBE_PEER & 2) { xcd_barrier(xbar); phase_peer_v<0>(p, lds); }
}

extern "C" void kernel_launch(void* const* d_in, const int* in_sizes, int n_in, void* d_out, int out_size, void* d_ws, size_t ws_size, hipStream_t stream) {
  static int grid_blocks = 0;
  if (grid_blocks == 0) {
    if (n_in != 20 || ws_size < WS_END || out_size != T_TOK * DM) {
      fprintf(stderr, "kernel_launch: unexpected problem shape (n_in %d, ws %zu, out %d)\n", n_in, ws_size, out_size);
      grid_blocks = -1; return;
    }
    int dev = 0, cus = 0, per_cu = 0;
    hipGetDevice(&dev);
    hipDeviceGetAttribute(&cus, hipDeviceAttributeMultiprocessorCount, dev);
    hipFuncSetAttribute((const void*)fwd_kernel, hipFuncAttributeMaxDynamicSharedMemorySize, LDS_BYTES);
    hipOccupancyMaxActiveBlocksPerMultiprocessor(&per_cu, (const void*)fwd_kernel, NTHR, LDS_BYTES);
    if (per_cu < 1) { fprintf(stderr, "kernel_launch: occupancy query says %d blocks/CU\n", per_cu); per_cu = 1; }
    grid_blocks = cus;
    (void)hipGetLastError();
  }
  if (grid_blocks < 0) return;
  Params p{};
  p.x_prompt = (const float*)d_in[0]; p.x_sample = (const float*)d_in[1]; p.rel_bias = (const float*)d_in[2]; p.attn_norm_g = (const float*)d_in[3];
  p.w_in = (const float*)d_in[4]; p.q_norm_a = (const float*)d_in[5]; p.k_norm_a = (const float*)d_in[6]; p.q_norm_b = (const float*)d_in[7];
  p.k_norm_b = (const float*)d_in[8]; p.lq1 = (const float*)d_in[9]; p.lk1 = (const float*)d_in[10]; p.lq2 = (const float*)d_in[11];
  p.lk2 = (const float*)d_in[12]; p.diff_norm_g = (const float*)d_in[13]; p.w_out = (const float*)d_in[14]; p.ffn_norm_g = (const float*)d_in[15];
  p.peer_w_q = (const float*)d_in[16]; p.peer_sub_keys = (const float*)d_in[17]; p.peer_u = (const float*)d_in[18]; p.peer_v = (const float*)d_in[19];
  p.out = (float*)d_out; p.ws = (unsigned char*)d_ws;
#if FUSED
  p.ph_lo = 0; p.ph_hi = NPHASE;
  void* args[] = {&p};
  hipError_t e = hipLaunchCooperativeKernel((const void*)fwd_kernel, dim3(grid_blocks), dim3(NTHR), args, LDS_BYTES, stream);
  if (e != hipSuccess) fprintf(stderr, "cooperative launch failed: %s (grid %d)\n", hipGetErrorString(e), grid_blocks);
#else
  for (int ph = 0; ph < NPHASE; ++ph) {
    p.ph_lo = ph; p.ph_hi = ph + 1;
    hipLaunchKernelGGL(fwd_kernel, dim3(grid_blocks), dim3(NTHR), LDS_BYTES, stream, p);
  }
#endif
}
```

```cpp
#include <hip/hip_runtime.h>
#include <hip/hip_cooperative_groups.h>
#include <cstdio>
#include <cstdint>
namespace cg = cooperative_groups;

#ifndef FUSED
#define FUSED 1
#endif

typedef unsigned short u16;
typedef __attribute__((ext_vector_type(8))) short bf16x8;
typedef __attribute__((ext_vector_type(4))) short s16x4;
typedef __attribute__((ext_vector_type(16))) float f32x16;
typedef __attribute__((ext_vector_type(4))) float f32x4;
typedef __attribute__((ext_vector_type(4))) unsigned u32x4;
typedef __attribute__((ext_vector_type(2))) unsigned u32x2;
typedef __attribute__((address_space(3))) unsigned char* ldsp_t;

#define DI __device__ __forceinline__
#define MFMA32(a, b, c) __builtin_amdgcn_mfma_f32_32x32x16_bf16((a), (b), (c), 0, 0, 0)

constexpr int DM = 1024;
constexpr int T_TOK = 65536;
constexpr int T_PROMPT = 32768;
constexpr int NTHR = 512;
constexpr int NPHASE = 10;
constexpr float NORM_EPS = 1e-6f;
constexpr float LOG2E = 1.4426950408889634f;
constexpr float C2 = 0.125f * LOG2E;
constexpr float NEG_BIG = -1.0e30f;

constexpr size_t WS_WIN  = 0;
constexpr size_t WS_WOUT = WS_WIN + (size_t)3072 * 1024 * 2;
constexpr size_t WS_WQ   = WS_WOUT + (size_t)1024 * 1024 * 2;
constexpr size_t WS_SK   = WS_WQ + (size_t)2048 * 1024 * 2;
constexpr size_t WS_U    = WS_SK + (size_t)2 * 128 * 128 * 2;
constexpr size_t WS_V    = WS_U + (size_t)16384 * 1024 * 2;
constexpr size_t WS_W16  = WS_V + (size_t)16384 * 1024;
constexpr size_t WS_MISC = WS_V + (size_t)16384 * 1024 * 2;
constexpr size_t MISC_SUINV = 0, MISC_SVINV = 65536, MISC_QCTR = 131072, MISC_BAR = 196608, MISC_HAMAX = 524288;
constexpr size_t WS_R    = WS_MISC + (size_t)1048576;
constexpr size_t R_REGION = (size_t)T_TOK * 512 * 2;
constexpr size_t WS_X1   = WS_R;
constexpr size_t WS_ZP   = WS_R + (size_t)T_TOK * 1024 * 2;
constexpr size_t WS_H    = WS_R + (size_t)T_TOK * 1024 * 4;
constexpr size_t WS_EIDX = WS_R + 6 * R_REGION;
constexpr size_t WS_G    = WS_EIDX + (size_t)T_TOK * 128 * 2;
constexpr size_t WS_END  = WS_G + (size_t)T_TOK * 128 * 4;
static_assert(WS_END <= (size_t)536870912, "workspace map exceeds 512 MiB");
constexpr size_t OUT_N1 = 0, OUT_MIX = 134217728, OUT_TV = 0, OUT_TI = 67108864;

constexpr int LDS_BYTES = 163840;
constexpr int LDS_BARST = 163840 - 256;

struct Params {
  const float* x_prompt; const float* x_sample; const float* rel_bias; const float* attn_norm_g; const float* w_in;
  const float* q_norm_a; const float* k_norm_a; const float* q_norm_b; const float* k_norm_b;
  const float* lq1; const float* lk1; const float* lq2; const float* lk2; const float* diff_norm_g; const float* w_out;
  const float* ffn_norm_g; const float* peer_w_q; const float* peer_sub_keys; const float* peer_u; const float* peer_v;
  float* out; unsigned char* ws; int ph_lo; int ph_hi;
};

DI u16 f2bf(float f) { unsigned u = __float_as_uint(f); u += 0x7fffu + ((u >> 16) & 1u); return (u16)(u >> 16); }
DI float bf2f(u16 b) { return __uint_as_float(((unsigned)b) << 16); }
DI unsigned pk2(float lo, float hi) {
  typedef float f2_t __attribute__((ext_vector_type(2)));
  typedef __bf16 b2_t __attribute__((ext_vector_type(2)));
  f2_t v = {lo, hi}; b2_t b = __builtin_convertvector(v, b2_t); return __builtin_bit_cast(unsigned, b);
}
DI int crow(int reg, int h) { return (reg & 3) + 8 * (reg >> 2) + 4 * h; }
DI float wave_sum(float v) {
#pragma unroll
  for (int o = 32; o > 0; o >>= 1) v += __shfl_xor(v, o);
  return v;
}
DI void seq_of(int t, int& seq_start, int& S, int& s) {
  if (t < T_PROMPT) { S = 4096; seq_start = t & ~4095; s = t & 4095; }
  else { S = 2048; seq_start = t & ~2047; s = t & 2047; }
}
DI const float* x_row(const Params& p, int t) {
  return (t < T_PROMPT) ? p.x_prompt + (size_t)t * DM : p.x_sample + (size_t)(t - T_PROMPT) * DM;
}
DI int rel_bucket(int rel) {
  int n = rel < 0 ? -rel : rel;
  int b;
  if (n < 8) b = n;
  else if (n < 15) b = 8; else if (n < 27) b = 9; else if (n < 50) b = 10; else if (n < 91) b = 11;
  else if (n < 166) b = 12; else if (n < 305) b = 13; else if (n < 559) b = 14; else b = 15;
  return (rel > 0 ? 16 : 0) + b;
}
DI s16x4 tr_read(const unsigned char* p) {
  typedef short v4i16_t __attribute__((ext_vector_type(4)));
  return __builtin_bit_cast(s16x4, __builtin_amdgcn_ds_read_tr16_b64_v4i16((__attribute__((address_space(3))) v4i16_t*)p));
}
DI bf16x8 cat8(s16x4 lo, s16x4 hi) { return __builtin_shufflevector(lo, hi, 0, 1, 2, 3, 4, 5, 6, 7); }

DI void transpose_item(const float* __restrict__ src, int K, int N, u16* __restrict__ dst, int k0, int n0, unsigned char* lds) {
  float* tile = (float*)lds;
  const int tid = threadIdx.x;
#pragma unroll
  for (int i = 0; i < 8; ++i) {
    int idx = tid + 512 * i; int r = idx >> 6, c = idx & 63;
    tile[r * 65 + c] = src[(size_t)(k0 + r) * N + n0 + c];
  }
  __syncthreads();
  {
    int n = tid >> 3, kc = tid & 7;
    u32x4 o;
    o[0] = pk2(tile[(kc * 8 + 0) * 65 + n], tile[(kc * 8 + 1) * 65 + n]);
    o[1] = pk2(tile[(kc * 8 + 2) * 65 + n], tile[(kc * 8 + 3) * 65 + n]);
    o[2] = pk2(tile[(kc * 8 + 4) * 65 + n], tile[(kc * 8 + 5) * 65 + n]);
    o[3] = pk2(tile[(kc * 8 + 6) * 65 + n], tile[(kc * 8 + 7) * 65 + n]);
    *(u32x4*)(dst + (size_t)(n0 + n) * K + k0 + kc * 8) = o;
  }
  __syncthreads();
}

DI void convert_item(const float* __restrict__ src, u16* __restrict__ dst, size_t base) {
  size_t i = base + (size_t)threadIdx.x * 8;
  f32x4 a = *(const f32x4*)(src + i), b = *(const f32x4*)(src + i + 4);
  u32x4 o; o[0] = pk2(a[0], a[1]); o[1] = pk2(a[2], a[3]); o[2] = pk2(b[0], b[1]); o[3] = pk2(b[2], b[3]);
  *(u32x4*)(dst + i) = o;
}

template <bool BF16IN>
DI void norm_load(const void* __restrict__ xr_, int lane, f32x4 (&v)[4]) {
#pragma unroll
  for (int i = 0; i < 4; ++i) {
    if (BF16IN) { const u32x2 r_ = *(const u32x2*)((const u16*)xr_ + lane * 4 + 256 * i); v[i][0] = __uint_as_float(r_[0] << 16); v[i][1] = __uint_as_float(r_[0] & 0xffff0000u); v[i][2] = __uint_as_float(r_[1] << 16); v[i][3] = __uint_as_float(r_[1] & 0xffff0000u); }
    else v[i] = *(const f32x4*)((const float*)xr_ + lane * 4 + 256 * i);
  }
}
DI void norm_finish(const f32x4 (&v)[4], const float* __restrict__ g, u16* __restrict__ orow, int lane, float* amax_out) {
  float ss = 0.f, am = 0.f;
#pragma unroll
  for (int i = 0; i < 4; ++i) ss += v[i][0] * v[i][0] + v[i][1] * v[i][1] + v[i][2] * v[i][2] + v[i][3] * v[i][3];
  ss = wave_sum(ss);
  const float r = __builtin_amdgcn_rsqf(ss * (1.0f / 1024.0f) + NORM_EPS);
#pragma unroll
  for (int i = 0; i < 4; ++i) {
    f32x4 gg = *(const f32x4*)(g + lane * 4 + 256 * i);
    u32x2 o; o[0] = pk2(v[i][0] * r * gg[0], v[i][1] * r * gg[1]); o[1] = pk2(v[i][2] * r * gg[2], v[i][3] * r * gg[3]);
    *(u32x2*)(orow + lane * 4 + 256 * i) = o;
    if (amax_out) {
      am = fmaxf(am, fmaxf(fmaxf(fabsf(__uint_as_float(o[0] << 16)), fabsf(__uint_as_float(o[0] & 0xffff0000u))), fmaxf(fabsf(__uint_as_float(o[1] << 16)), fabsf(__uint_as_float(o[1] & 0xffff0000u)))));
    }
  }
  if (amax_out) {
#pragma unroll
    for (int o = 32; o > 0; o >>= 1) am = fmaxf(am, __shfl_xor(am, o));
    if (lane == 0) *amax_out = am;
  }
}
template <bool BF16IN = false>
DI void norm_row(const void* __restrict__ xr_, const float* __restrict__ g, u16* __restrict__ orow, int lane, float* amax_out = nullptr) {
  f32x4 v[4]; norm_load<BF16IN>(xr_, lane, v); norm_finish(v, g, orow, lane, amax_out);
}
template <bool BF16IN>
DI void norm_row2(const void* xa, const void* xb, const float* __restrict__ g, u16* oa, u16* ob, int lane, float* ama, float* amb) {
  f32x4 va[4], vb[4]; norm_load<BF16IN>(xa, lane, va); norm_load<BF16IN>(xb, lane, vb);
  norm_finish(va, g, oa, lane, ama); norm_finish(vb, g, ob, lane, amb);
}

DI void convert_row(const Params& p, int row, int lane_, const f32x4& a0, const f32x4& a1, const f32x4& a2, const f32x4& a3) {
      const int tbl = row >> 14, e = row & 16383;
      float am = 0.f;
#pragma unroll
      for (int j = 0; j < 4; ++j) am = fmaxf(am, fmaxf(fmaxf(fabsf(a0[j]), fabsf(a1[j])), fmaxf(fabsf(a2[j]), fabsf(a3[j]))));
#pragma unroll
      for (int o = 32; o > 0; o >>= 1) am = fmaxf(am, __shfl_xor(am, o));
      float isc; u32x2 o;
      if (tbl == 0) {
        const float sc = (am > 0.f) ? 7.0f / am : 0.f; isc = am * (1.0f / 7.0f);
#define Q4(x_) ((unsigned)((int)__builtin_rintf((x_) * sc)) & 15u)
        o[0] = Q4(a0[0]) | (Q4(a0[1]) << 8) | (Q4(a0[2]) << 16) | (Q4(a0[3]) << 24) | (Q4(a1[0]) << 4) | (Q4(a1[1]) << 12) | (Q4(a1[2]) << 20) | (Q4(a1[3]) << 28);
        o[1] = Q4(a2[0]) | (Q4(a2[1]) << 8) | (Q4(a2[2]) << 16) | (Q4(a2[3]) << 24) | (Q4(a3[0]) << 4) | (Q4(a3[1]) << 12) | (Q4(a3[2]) << 20) | (Q4(a3[3]) << 28);
#undef Q4
      } else {
        const float sc = (am > 0.f) ? 6.0f / am : 0.f; isc = am * (1.0f / 6.0f);
        unsigned pk = 0u;
        pk = __builtin_amdgcn_cvt_scalef32_pk_fp4_f32(pk, a0[0] * sc, a0[1] * sc, 1.0f, 0);
        pk = __builtin_amdgcn_cvt_scalef32_pk_fp4_f32(pk, a0[2] * sc, a0[3] * sc, 1.0f, 1);
        pk = __builtin_amdgcn_cvt_scalef32_pk_fp4_f32(pk, a1[0] * sc, a1[1] * sc, 1.0f, 2);
        pk = __builtin_amdgcn_cvt_scalef32_pk_fp4_f32(pk, a1[2] * sc, a1[3] * sc, 1.0f, 3);
        o[0] = pk; pk = 0u;
        pk = __builtin_amdgcn_cvt_scalef32_pk_fp4_f32(pk, a2[0] * sc, a2[1] * sc, 1.0f, 0);
        pk = __builtin_amdgcn_cvt_scalef32_pk_fp4_f32(pk, a2[2] * sc, a2[3] * sc, 1.0f, 1);
        pk = __builtin_amdgcn_cvt_scalef32_pk_fp4_f32(pk, a3[0] * sc, a3[1] * sc, 1.0f, 2);
        pk = __builtin_amdgcn_cvt_scalef32_pk_fp4_f32(pk, a3[2] * sc, a3[3] * sc, 1.0f, 3);
        o[1] = pk;
      }
      unsigned char* dst = p.ws + (tbl ? WS_V : WS_U) + ((size_t)(lane_ >> 4) * 16384 + e) * 128 + (lane_ & 15) * 8;
      *(u32x2*)dst = o;
      if (lane_ == 0) ((float*)(p.ws + WS_MISC + (tbl ? MISC_SVINV : MISC_SUINV)))[e] = isc;
}
DI void convert_tables(const Params& p) {
  const int nb = gridDim.x, bid = blockIdx.x, tid = threadIdx.x;
  const int lane_ = tid & 63, w_ = tid >> 6;
  for (int it = bid; it < 2 * 16384 / 16; it += nb) {
    const int rowa = it * 16 + w_, rowb = rowa + 8;
    const float* sa = ((rowa >> 14) ? p.peer_v : p.peer_u) + (size_t)(rowa & 16383) * DM + lane_ * 16;
    const float* sb = ((rowb >> 14) ? p.peer_v : p.peer_u) + (size_t)(rowb & 16383) * DM + lane_ * 16;
    const f32x4 a0 = *(const f32x4*)(sa), a1 = *(const f32x4*)(sa + 4), a2 = *(const f32x4*)(sa + 8), a3 = *(const f32x4*)(sa + 12);
    const f32x4 b0 = *(const f32x4*)(sb), b1 = *(const f32x4*)(sb + 4), b2 = *(const f32x4*)(sb + 8), b3 = *(const f32x4*)(sb + 12);
    convert_row(p, rowa, lane_, a0, a1, a2, a3);
    convert_row(p, rowb, lane_, b0, b1, b2, b3);
  }
}

DI void phase_prep(const Params& p, unsigned char* lds) {
  const int nb = gridDim.x, bid = blockIdx.x, tid = threadIdx.x;
  u16* wsb = (u16*)p.ws;
  for (int it = bid; it < 768 + 256 + 512; it += nb) {
    if (it < 768) { int kt = it / 48, nt = it % 48; transpose_item(p.w_in, 1024, 3072, (u16*)(p.ws + WS_WIN), kt * 64, nt * 64, lds); }
    else if (it < 1024) { int j = it - 768; int kt = j / 16, nt = j % 16; transpose_item(p.w_out, 1024, 1024, (u16*)(p.ws + WS_WOUT), kt * 64, nt * 64, lds); }
    else { int j = it - 1024; int kt = j / 32, nt = j % 32; transpose_item(p.peer_w_q, 1024, 2048, (u16*)(p.ws + WS_WQ), kt * 64, nt * 64, lds); }
  }
  for (int it = bid; it < 8; it += nb) convert_item(p.peer_sub_keys, (u16*)(p.ws + WS_SK), (size_t)it * 4096);
  if (bid == 0 && tid < 64) ((unsigned*)(p.ws + WS_MISC + MISC_QCTR))[tid] = 0u;
  if (bid == 0) for (int i = tid; i < 3456; i += NTHR) ((unsigned*)(p.ws + WS_MISC + MISC_BAR))[i] = 0u;
  convert_tables(p);
  const int lane = tid & 63, w = tid >> 6;
  u16* n1 = (u16*)((unsigned char*)p.out + OUT_N1);
  for (int it = bid; it < T_TOK / 16; it += nb) {
    const int t = it * 16 + w, t2 = t + 8;
    norm_row2<false>(x_row(p, t), x_row(p, t2), p.attn_norm_g, n1 + (size_t)t * DM, n1 + (size_t)t2 * DM, lane, nullptr, nullptr);
  }
  (void)wsb;
}

template <int PR, int QR>
DI void gemm_mainloop(const u16* __restrict__ P, const u16* __restrict__ Q, int K, int p0, int q0, unsigned char* lds, f32x16 (&acc)[2][2]) {
  static_assert(PR + QR == 384, "tile");
  constexpr int STAGE = 384 * 128;
  constexpr int WC = QR / 64;
  const int tid = threadIdx.x, lane = tid & 63, r32 = lane & 31, h = lane >> 5;
  const int w = __builtin_amdgcn_readfirstlane(tid >> 6);
  const int wr = w / WC, wc = w % WC;
#pragma unroll
  for (int i = 0; i < 2; ++i)
#pragma unroll
    for (int j = 0; j < 2; ++j)
#pragma unroll
      for (int r = 0; r < 16; ++r) acc[i][j][r] = 0.f;
  u32x4 stg[6];
  const u16* src[6]; int loff[6];
#pragma unroll
  for (int i = 0; i < 6; ++i) {
    int c = tid + 512 * i; int row = c >> 3, kc = c & 7;
    src[i] = (row < PR) ? P + (size_t)(p0 + row) * K + kc * 8 : Q + (size_t)(q0 + row - PR) * K + kc * 8;
    loff[i] = row * 128 + ((kc ^ ((row >> 1) & 7)) << 4);
  }
  const int KT = K / 64;
#pragma unroll
  for (int i = 0; i < 6; ++i) stg[i] = *(const u32x4*)(src[i]);
#pragma unroll
  for (int i = 0; i < 6; ++i) *(u32x4*)(lds + loff[i]) = stg[i];
  __syncthreads();
  int aoff[2], boff[2], asw[2], bsw[2];
#pragma unroll
  for (int i = 0; i < 2; ++i) {
    int ra = wr * 64 + i * 32 + r32; aoff[i] = ra * 128; asw[i] = (ra >> 1) & 7;
    int rb = PR + wc * 64 + i * 32 + r32; boff[i] = rb * 128; bsw[i] = (rb >> 1) & 7;
  }
  for (int kt = 0; kt < KT; ++kt) {
    const int buf = (kt & 1) * STAGE;
    if (kt + 1 < KT) {
#pragma unroll
      for (int i = 0; i < 6; ++i) stg[i] = *(const u32x4*)(src[i] + (kt + 1) * 64);
    }
#pragma unroll
    for (int ks = 0; ks < 4; ++ks) {
      bf16x8 a[2], b[2];
#pragma unroll
      for (int i = 0; i < 2; ++i) {
        a[i] = *(const bf16x8*)(lds + buf + aoff[i] + (((2 * ks + h) ^ asw[i]) << 4));
        b[i] = *(const bf16x8*)(lds + buf + boff[i] + (((2 * ks + h) ^ bsw[i]) << 4));
      }
#pragma unroll
      for (int i = 0; i < 2; ++i)
#pragma unroll
        for (int j = 0; j < 2; ++j) acc[i][j] = MFMA32(a[i], b[j], acc[i][j]);
    }
    if (kt + 1 < KT) {
      const int nbuf = ((kt + 1) & 1) * STAGE;
#pragma unroll
      for (int i = 0; i < 6; ++i) *(u32x4*)(lds + nbuf + loff[i]) = stg[i];
    }
    __syncthreads();
  }
}

namespace pg8 {
#define PG8_LAS __attribute__((address_space(3)))
typedef unsigned short bf16_t;
typedef short bf16x8 __attribute__((ext_vector_type(8)));
typedef float f32x4 __attribute__((ext_vector_type(4)));
typedef unsigned u32x4 __attribute__((ext_vector_type(4)));
constexpr int BM = 256, BK = 64, HALF = 128, HTB = HALF * BK * 2  , STAGE_BYTES = 8 * HTB, NXCD = 8, WGM = 8;

__host__ __device__ __forceinline__ int lds_byte(int r, int c) { const int st = (r >> 4) * 2 + (c >> 5), rr = r & 15, cc = c & 31, ob = rr * 64 + cc * 2; return st * 1024 + (ob ^ (((ob >> 9) & 1) << 5)); }
__host__ __device__ __forceinline__ void stage_rc(int b, int& R, int& C) { const int st = b / 1024, sb = b % 1024, swz = sb ^ (((sb >> 9) & 1) << 5); R = (st >> 1) * 16 + swz / 64; C = (st & 1) * 32 + (swz % 64) / 2; }
__host__ __device__ __forceinline__ int perm32(int rho) { const int n = rho >> 4, i = rho & 15; return 8 * (i >> 2) + 4 * n + (i & 3); }

struct Unit { int pm, pn; };
struct Gemm { const bf16_t* A; const bf16_t* Bt; int M, N, K; };

struct StaticOrder {
    int nM, nN, nwg, G, c;
    __host__ __device__ void init(int M, int N, int G_, int c_) { nM = M / BM; nN = N / BM; nwg = nM * nN; G = G_; c = c_; }
    __host__ __device__ bool next(int i, Unit& u) const {
        const long L = (long)i * G + c; if (L >= nwg) return false;
        int wgid = (int)L; { const int q = nwg / NXCD, r = nwg % NXCD, xcd = wgid % NXCD, off = wgid / NXCD; wgid = (xcd < r ? xcd * (q + 1) : r * (q + 1) + (xcd - r) * q) + off; }
        const int nig = WGM * nN, gid = wgid / nig, fm = gid * WGM, gsz = (nM - fm) < WGM ? (nM - fm) : WGM;
        u.pm = fm + ((wgid % nig) % gsz); u.pn = (wgid % nig) / gsz; return true;
    }
    __device__ __forceinline__ void a_ready(const Unit&) const {}
    __device__ __forceinline__ void done(const Unit&) const {}
};


template <class Epi, class Sched, bool ALIGN_EPI = false, bool SP2 = false>
__device__ __forceinline__ void gemm_phase(PG8_LAS unsigned char* lds, const Gemm g, const Sched& S, const Epi& E) {
    const int tid = threadIdx.x, wid = __builtin_amdgcn_readfirstlane(tid >> 6), lane = tid & 63, wr = wid >> 2, wc = wid & 3, fr = lane & 15, fq = lane >> 4;
    const int K = g.K, nt = K / BK;
    unsigned voffA[2], voffB[2], voffB1[2];
#pragma unroll
    for (int i = 0; i < 2; ++i) { int R, C; stage_rc(tid * 16 + i * 8192, R, C); const int Rb = Epi::PERM ? ((R & ~31) + perm32(R & 31)) : R;
        voffA[i] = (unsigned)(R * K + C) * 2u;
        if (Epi::HEADPERM) { const int Rh = 64 * (R >> 5) + perm32(R & 31); voffB[i] = (unsigned)(Rh * K + C) * 2u; voffB1[i] = (unsigned)((Rh + 32) * K + C) * 2u; }
        else { voffB[i] = (unsigned)(Rb * K + C) * 2u; voffB1[i] = (unsigned)((Rb + HALF) * K + C) * 2u; } }
    const size_t kstep = (size_t)(BK * 2);
    const size_t hstep = (size_t)HALF * K * 2;
    const size_t tstep = 2 * hstep;
    const unsigned ldsw = (unsigned)wid * 1024u;
    const int aoff = lds_byte(wr * 64 + fr, fq * 8), boff = lds_byte(wc * 32 + fr, fq * 8);
#define PG8_SA(b, h) (((b) * 2 + (h)) * HTB)
#define PG8_SB(b, h) ((4 + (b) * 2 + (h)) * HTB)
#define PG8_STAGE(bufoff, gbase, voff) do { _Pragma("unroll") for (int _i = 0; _i < 2; ++_i) \
        __builtin_amdgcn_global_load_lds((const unsigned*)((const char*)(gbase) + (voff)[_i]), (PG8_LAS unsigned*)(lds + (bufoff) + ldsw + _i * 8192), 16, 0, 0); } while (0)
#define PG8_LDA(dst, b, h) do { _Pragma("unroll") for (int m = 0; m < 4; ++m) _Pragma("unroll") for (int k = 0; k < 2; ++k) dst[m][k] = *(const PG8_LAS bf16x8*)(lds + PG8_SA(b, h) + aoff + m * 2048 + k * 1024); } while (0)
#define PG8_LDB(dst, b, h) do { _Pragma("unroll") for (int n = 0; n < 2; ++n) _Pragma("unroll") for (int k = 0; k < 2; ++k) dst[n][k] = *(const PG8_LAS bf16x8*)(lds + PG8_SB(b, h) + boff + n * 2048 + k * 1024); } while (0)
#define PG8_MMA(ai, bj, At, Bt) do { __builtin_amdgcn_s_setprio(1); _Pragma("unroll") for (int m = 0; m < 4; ++m) _Pragma("unroll") for (int n = 0; n < 2; ++n) _Pragma("unroll") for (int k = 0; k < 2; ++k) \
        acc[ai][bj][m][n] = __builtin_amdgcn_mfma_f32_16x16x32_bf16(Bt[n][k], At[m][k], acc[ai][bj][m][n], 0, 0, 0); __builtin_amdgcn_s_setprio(0); } while (0)
#define PG8_WAIT_V(n) asm volatile("s_waitcnt vmcnt(" #n ")" ::: "memory")
#define PG8_WAIT_L(n) asm volatile("s_waitcnt lgkmcnt(" #n ")" ::: "memory")
#define PG8_BAR __builtin_amdgcn_s_barrier()
#define PG8_SCHED __builtin_amdgcn_sched_barrier(0)
    Unit cur, nxt; int ui = 0;
    if (!S.next(0, cur)) return;
    f32x4 acc[2][2][4][2];
#pragma unroll
    for (int a = 0; a < 2; ++a)
#pragma unroll
        for (int b = 0; b < 2; ++b)
#pragma unroll
            for (int m = 0; m < 4; ++m)
#pragma unroll
                for (int n = 0; n < 2; ++n) acc[a][b][m][n] = (f32x4){0.f, 0.f, 0.f, 0.f};
    bf16x8 At[4][2], B0[2][2], B1[2][2];
    const char* cA = (const char*)g.A + (size_t)cur.pm * tstep; const char* cB = (const char*)g.Bt + (size_t)cur.pn * tstep;
    S.a_ready(cur);
    if constexpr (SP2) {
        PG8_STAGE(PG8_SB(0, 0), cB, voffB); PG8_STAGE(PG8_SB(0, 1), cB, voffB1); PG8_STAGE(PG8_SA(0, 0), cA, voffA); PG8_STAGE(PG8_SA(0, 1), cA + hstep, voffA);
        if (wr == 1) PG8_BAR;
        PG8_WAIT_V(2); PG8_BAR;
        PG8_STAGE(PG8_SB(1, 0), cB + kstep, voffB); PG8_STAGE(PG8_SA(1, 0), cA + kstep, voffA); PG8_STAGE(PG8_SB(1, 1), cB + kstep, voffB1);
        PG8_WAIT_V(6); PG8_BAR;
    } else {
        PG8_STAGE(PG8_SB(0, 0), cB, voffB); PG8_STAGE(PG8_SA(0, 0), cA, voffA); PG8_STAGE(PG8_SB(0, 1), cB, voffB1); PG8_STAGE(PG8_SA(0, 1), cA + hstep, voffA);
        if (wr == 1) PG8_BAR;
        PG8_WAIT_V(4); PG8_BAR;
        PG8_STAGE(PG8_SB(1, 0), cB + kstep, voffB); PG8_STAGE(PG8_SA(1, 0), cA + kstep, voffA); PG8_STAGE(PG8_SB(1, 1), cB + kstep, voffB1);
        PG8_WAIT_V(6); PG8_BAR;
    }
    for (;;) {
        const bool has_next = S.next(ui + 1, nxt);
        const char* nA = has_next ? (const char*)g.A + (size_t)nxt.pm * tstep : cA; const char* nB = has_next ? (const char*)g.Bt + (size_t)nxt.pn * tstep : cB;
        for (int t = 0; t < nt; t += 2) {
            const bool last = (t == nt - 2);
            const char* a1 = cA + (size_t)(t + 1) * kstep;
            const char* a2 = last ? nA : cA + (size_t)(t + 2) * kstep; const char* b2 = last ? nB : cB + (size_t)(t + 2) * kstep;
            const char* a3 = a2 + kstep; const char* b3 = b2 + kstep;
            if (last && has_next) S.a_ready(nxt);
            if constexpr (SP2) {
            PG8_LDB(B0, 0, 0); PG8_LDB(B1, 0, 1); PG8_SCHED; PG8_LDA(At, 0, 0); PG8_STAGE(PG8_SA(1, 1), a1 + hstep, voffA);
            PG8_WAIT_V(8); PG8_WAIT_L(0); PG8_BAR; PG8_MMA(0, 0, At, B0); PG8_MMA(0, 1, At, B1); PG8_BAR; PG8_SCHED;
            PG8_LDA(At, 0, 1); PG8_STAGE(PG8_SB(0, 0), b2, voffB); PG8_STAGE(PG8_SB(0, 1), b2, voffB1); PG8_STAGE(PG8_SA(0, 0), a2, voffA);
            PG8_WAIT_V(8); PG8_WAIT_L(0); PG8_BAR; PG8_MMA(1, 0, At, B0); PG8_MMA(1, 1, At, B1); PG8_BAR; PG8_SCHED;
            PG8_LDB(B0, 1, 0); PG8_LDB(B1, 1, 1); PG8_SCHED; PG8_LDA(At, 1, 0); PG8_STAGE(PG8_SA(0, 1), a2 + hstep, voffA);
            PG8_WAIT_V(8); PG8_WAIT_L(0); PG8_BAR; PG8_MMA(0, 0, At, B0); PG8_MMA(0, 1, At, B1); PG8_BAR; PG8_SCHED;
            PG8_LDA(At, 1, 1); PG8_STAGE(PG8_SB(1, 0), b3, voffB); PG8_STAGE(PG8_SB(1, 1), b3, voffB1); PG8_STAGE(PG8_SA(1, 0), a3, voffA);
            PG8_WAIT_V(8); PG8_WAIT_L(0); PG8_BAR; PG8_MMA(1, 0, At, B0); PG8_MMA(1, 1, At, B1); PG8_BAR; PG8_SCHED;
            } else {
            PG8_LDB(B0, 0, 0); PG8_SCHED; PG8_LDA(At, 0, 0); PG8_STAGE(PG8_SA(1, 1), a1 + hstep, voffA);
            PG8_WAIT_L(8); PG8_BAR; PG8_WAIT_L(0); PG8_MMA(0, 0, At, B0); PG8_BAR; PG8_SCHED;
            PG8_LDB(B1, 0, 1); PG8_STAGE(PG8_SB(0, 0), b2, voffB);
            PG8_BAR; PG8_WAIT_L(0); PG8_MMA(0, 1, At, B1); PG8_BAR;
            PG8_LDA(At, 0, 1); PG8_STAGE(PG8_SA(0, 0), a2, voffA);
            PG8_BAR; PG8_WAIT_L(0); PG8_MMA(1, 0, At, B0); PG8_BAR; PG8_SCHED;
            PG8_STAGE(PG8_SB(0, 1), b2, voffB1);
            PG8_WAIT_V(6); PG8_BAR; PG8_MMA(1, 1, At, B1); PG8_BAR;
            PG8_LDB(B0, 1, 0); PG8_SCHED; PG8_LDA(At, 1, 0); PG8_STAGE(PG8_SA(0, 1), a2 + hstep, voffA);
            PG8_WAIT_L(8); PG8_BAR; PG8_WAIT_L(0); PG8_MMA(0, 0, At, B0); PG8_BAR; PG8_SCHED;
            PG8_LDB(B1, 1, 1); PG8_STAGE(PG8_SB(1, 0), b3, voffB);
            PG8_BAR; PG8_WAIT_L(0); PG8_MMA(0, 1, At, B1); PG8_BAR;
            PG8_LDA(At, 1, 1); PG8_STAGE(PG8_SA(1, 0), a3, voffA);
            PG8_BAR; PG8_WAIT_L(0); PG8_MMA(1, 0, At, B0); PG8_BAR; PG8_SCHED;
            PG8_STAGE(PG8_SB(1, 1), b3, voffB1);
            PG8_WAIT_V(6); PG8_BAR; PG8_MMA(1, 1, At, B1); PG8_BAR;
            }
        }
        if constexpr (ALIGN_EPI) { if (wr == 0) PG8_BAR; }
        if constexpr (!Epi::AFTER_DRAIN) { E(acc, cur, wr, wc, fr, fq); S.done(cur); }
        if (!has_next) break;
#pragma unroll
        for (int a = 0; a < 2; ++a)
#pragma unroll
            for (int b = 0; b < 2; ++b)
#pragma unroll
                for (int m = 0; m < 4; ++m)
#pragma unroll
                    for (int n = 0; n < 2; ++n) acc[a][b][m][n] = (f32x4){0.f, 0.f, 0.f, 0.f};
        cur = nxt; cA = nA; cB = nB; ++ui;
        if constexpr (ALIGN_EPI) { if (wr == 1) PG8_BAR; }
    }
    PG8_WAIT_V(0);
    if constexpr (!ALIGN_EPI) { if (wr == 0) PG8_BAR; }
    PG8_BAR;
    if constexpr (Epi::AFTER_DRAIN) { E.fused(acc, cur, wr, wc, fr, fq, lds, wid, lane); S.done(cur); }
#undef PG8_SA
#undef PG8_SB
#undef PG8_STAGE
#undef PG8_LDA
#undef PG8_LDB
#undef PG8_MMA
#undef PG8_WAIT_V
#undef PG8_WAIT_L
#undef PG8_BAR
#undef PG8_SCHED
}
}

struct EpiProj {
  static constexpr bool PERM = true, AFTER_DRAIN = false, HEADPERM = true;
  const float* gqa; const float* gka; const float* gqb; const float* gkb; unsigned char* ws;
  __device__ __forceinline__ void operator()(const pg8::f32x4 (&acc)[2][2][4][2], const pg8::Unit& u, int wr, int wc, int fr, int fq) const {
    const int nbase = u.pn * 256 + wc * 64;
    const int region = nbase >> 9, hw = (nbase & 511) >> 6;
    const float* g = (region == 0) ? gqa : (region == 1) ? gka : (region == 3) ? gqb : gkb;
    const bool normed = (region != 2 && region != 5);
    const float qs = (region == 0 || region == 3) ? C2 : 1.0f;
    u16* dstR = (u16*)(ws + WS_R + (size_t)region * R_REGION);
    f32x4 gv[2][2];
#pragma unroll
    for (int bj = 0; bj < 2; ++bj)
#pragma unroll
      for (int n = 0; n < 2; ++n) gv[bj][n] = normed ? *(const f32x4*)(g + 32 * bj + 8 * fq + 4 * n) : (f32x4){1.f, 1.f, 1.f, 1.f};
#pragma unroll
    for (int ai = 0; ai < 2; ++ai)
#pragma unroll
      for (int m = 0; m < 4; ++m) {
        const int t = u.pm * 256 + ai * 128 + wr * 64 + m * 16 + fr;
        int seq_start, S, sq; seq_of(t, seq_start, S, sq);
        float scale = 1.0f;
        if (normed) {
          float ss = 0.f;
#pragma unroll
          for (int bj = 0; bj < 2; ++bj)
#pragma unroll
            for (int n = 0; n < 2; ++n) { const f32x4 v = acc[ai][bj][m][n]; ss += v[0] * v[0] + v[1] * v[1] + v[2] * v[2] + v[3] * v[3]; }
          ss += __shfl_xor(ss, 16); ss += __shfl_xor(ss, 32);
          scale = __builtin_amdgcn_rsqf(ss * (1.0f / 64.0f) + NORM_EPS) * qs;
        }
        u16* dst;
        if (region != 5) dst = dstR + (size_t)seq_start * 512 + ((size_t)hw * S + sq) * 64;
        else dst = dstR + (size_t)seq_start * 512 + ((size_t)(hw >> 1) * S + sq) * 128 + (hw & 1) * 64;
#pragma unroll
        for (int bj = 0; bj < 2; ++bj) {
          const f32x4 v0 = acc[ai][bj][m][0] * scale * gv[bj][0], v1 = acc[ai][bj][m][1] * scale * gv[bj][1];
          u32x4 o; o[0] = pk2(v0[0], v0[1]); o[1] = pk2(v0[2], v0[3]); o[2] = pk2(v1[0], v1[1]); o[3] = pk2(v1[2], v1[3]);
          *(u32x4*)(dst + 32 * bj + 8 * fq) = o;
        }
      }
  }
};

DI void phase_proj(const Params& p, unsigned char* lds) {
  pg8::Gemm g{(const u16*)((const unsigned char*)p.out + OUT_N1), (const u16*)(p.ws + WS_WIN), T_TOK, 3072, 1024};
  pg8::StaticOrder S; S.init(T_TOK, 3072, (int)gridDim.x, (int)blockIdx.x);
  EpiProj E{p.q_norm_a, p.k_norm_a, p.q_norm_b, p.k_norm_b, p.ws};
  pg8::gemm_phase<EpiProj, pg8::StaticOrder, true, true>((PG8_LAS unsigned char*)lds, g, S, E);
}

constexpr int AL_STAGE = 0;
constexpr int AL_VT    = 0;
constexpr int AL_TAB   = 131072;
constexpr int AL_TABA  = 137216;
constexpr int AL_XL    = 150016;
constexpr int AL_MISC  = 151552;

DI unsigned voff_b(int row, int ch) { return 256u * row + 16u * (ch ^ (((row & 3) << 2) | ((row >> 2) & 3))); }

template <int VAR>
DI void diff_unit(const Params& p, unsigned char* lds, int seq_start, int S, int hd, int q0, float lam) {
  const int tid = threadIdx.x, lane = tid & 63, r32 = lane & 31, h = lane >> 5;
  const int w = __builtin_amdgcn_readfirstlane(tid >> 6);
  const int map = w >> 2, wq = w & 3;
  const u16* QBp = (const u16*)(p.ws + WS_R + 3 * R_REGION);
  const u16* KBp = (const u16*)(p.ws + WS_R + 4 * R_REGION);
  const u16* VBp = (const u16*)(p.ws + WS_R + 5 * R_REGION);
  const int qpos = q0 + wq * 32 + r32;
  const int qlo = q0 + wq * 32;
  const u16* Qp = QBp + (size_t)seq_start * 512 + ((size_t)(hd * 2 + map) * S + qpos) * 64;
  bf16x8 qf[4];
#pragma unroll
  for (int ks = 0; ks < 4; ++ks) qf[ks] = *(const bf16x8*)(Qp + ks * 16 + h * 8);
  const u16* K1g = KBp + (size_t)seq_start * 512 + ((size_t)(hd * 2 + 0) * S) * 64;
  const u16* K2g = KBp + (size_t)seq_start * 512 + ((size_t)(hd * 2 + 1) * S) * 64;
  const u16* Vg = VBp + (size_t)seq_start * 512 + ((size_t)hd * S) * 128;
  const float* tab = (const float*)(lds + AL_TAB);
  const float* misc = (const float*)(lds + AL_MISC);
  const float cAfter = misc[12 + hd];
  f32x16 O[4];
#pragma unroll
  for (int nb = 0; nb < 4; ++nb)
#pragma unroll
    for (int r = 0; r < 16; ++r) O[nb][r] = 0.f;
  float l = 0.f;
  const int kr_ = 8 * w + (lane >> 3), kc_ = (lane & 7) ^ ((kr_ >> 1) & 7);
  const u16* k1src = K1g + (size_t)kr_ * 64 + kc_ * 8;
  const u16* k2src = K2g + (size_t)kr_ * 64 + kc_ * 8;
  const u16* vsrc[2];
#pragma unroll
  for (int i = 0; i < 2; ++i) { const int row = 8 * w + 4 * i + (lane >> 4); const int pc = (lane & 15) ^ (((row & 3) << 2) | ((row >> 2) & 3)); vsrc[i] = Vg + (size_t)row * 128 + pc * 8; }
  const int NKT = S / 64;
  const int i16 = lane & 15, tq = i16 >> 2, tp = i16 & 3, blk = (lane >> 4) & 1;
  int kbase4[4], vbase[4][2];
#pragma unroll
  for (int ks = 0; ks < 4; ++ks) kbase4[ks] = r32 * 128 + (((2 * ks + h) ^ ((r32 >> 1) & 7)) << 4);
#pragma unroll
  for (int nb = 0; nb < 4; ++nb)
#pragma unroll
    for (int hi = 0; hi < 2; ++hi) vbase[nb][hi] = (int)voff_b(4 * h + tq + 8 * hi, 4 * nb + 2 * blk + (tp >> 1)) + 8 * (tp & 1);
#define DU_GLDS(gsrc_, ldsoff_) do { unsigned keep_; const unsigned dst_ = (unsigned)__builtin_amdgcn_readfirstlane((int)(ldsoff_)); \
    asm volatile("s_mov_b32 %0, m0\n\ts_mov_b32 m0, %2\n\ts_nop 0\n\tglobal_load_lds_dwordx4 %1, off\n\ts_mov_b32 m0, %0" : "=&s"(keep_) : "v"(gsrc_), "s"(dst_) : "memory"); } while (0)
#define DU_DMA(kt_, st_) do { const size_t ko_ = (size_t)(kt_) * 64 * 64, vo_ = (size_t)(kt_) * 64 * 128; const unsigned b_ = lds_base + AL_STAGE + (st_) * 32768; \
    DU_GLDS(k1src + ko_, b_ + w * 1024); DU_GLDS(k2src + ko_, b_ + 8192 + w * 1024); \
    DU_GLDS(vsrc[0] + vo_, b_ + 16384 + w * 2048); DU_GLDS(vsrc[1] + vo_, b_ + 16384 + w * 2048 + 1024); } while (0)
  const unsigned lds_base = (unsigned)(uintptr_t)lds;
#define SBAR() __builtin_amdgcn_sched_barrier(0)
#define DU_VRD(slot, f, so_) do { vlo[slot] = tr_read(vp[(f) >> 1][0] + (so_) + ((f) & 1) * 4096); vhi[slot] = tr_read(vp[(f) >> 1][1] + (so_) + ((f) & 1) * 4096); } while (0)
#define DU_SUB(A, B, kq2, kso2_, has_next2_, vso_, knext_, has_next_) do { \
    SBAR(); \
    s16x4 vlo[4], vhi[4]; \
    if (VAR != 2 && VAR != 4) { DU_VRD(0, 0, vso_); DU_VRD(1, 1, vso_); DU_VRD(2, 2, vso_); DU_VRD(3, 3, vso_); } \
    if (has_next_ && VAR != 3 && VAR != 4) { \
      f32x16 z_; _Pragma("unroll") for (int r = 0; r < 16; ++r) z_[r] = 0.f; \
      B = MFMA32(kf[0], qf[0], z_); B = MFMA32(kf[1], qf[1], B); B = MFMA32(kf[2], qf[2], B); B = MFMA32(kf[3], qf[3], B); } \
    float ls = 0.f; \
    _Pragma("unroll") for (int r = 0; r < 16; ++r) ls += A[r]; \
    l += ls; \
    bf16x8 pb[2]; \
    _Pragma("unroll") for (int s2 = 0; s2 < 2; ++s2) { \
      u32x4 pw; pw[0] = pk2(A[8 * s2 + 0], A[8 * s2 + 1]); pw[1] = pk2(A[8 * s2 + 2], A[8 * s2 + 3]); \
      pw[2] = pk2(A[8 * s2 + 4], A[8 * s2 + 5]); pw[3] = pk2(A[8 * s2 + 6], A[8 * s2 + 7]); \
      pb[s2] = __builtin_bit_cast(bf16x8, pw); } \
    SBAR(); \
    if ((has_next2_) && VAR != 3 && VAR != 4) { _Pragma("unroll") for (int ks = 0; ks < 4; ++ks) kf[ks] = *(const bf16x8*)(kq2[ks] + (kso2_)); } \
    if (has_next_) { \
      const int dmin_ = (knext_) - (qlo + 31), dmax_ = (knext_) + 31 - qlo; \
      if (dmin_ < 559) { \
        if (in_after) { in_after = false; _Pragma("unroll") for (int nb = 0; nb < 4; ++nb) _Pragma("unroll") for (int r = 0; r < 16; ++r) O[nb][r] *= fAfter; l *= fAfter; \
                        _Pragma("unroll") for (int s2 = 0; s2 < 2; ++s2) {   \
                          u32x4 pw; pw[0] = pk2(A[8 * s2 + 0] * fAfter, A[8 * s2 + 1] * fAfter); pw[1] = pk2(A[8 * s2 + 2] * fAfter, A[8 * s2 + 3] * fAfter); \
                          pw[2] = pk2(A[8 * s2 + 4] * fAfter, A[8 * s2 + 5] * fAfter); pw[3] = pk2(A[8 * s2 + 6] * fAfter, A[8 * s2 + 7] * fAfter); \
                          pb[s2] = __builtin_bit_cast(bf16x8, pw); } } \
        if (dmax_ > -559) { const int base_ = (knext_) + 4 * h - qpos + 640; \
          _Pragma("unroll") for (int r = 0; r < 16; ++r) B[r] += tab[base_ + (r & 3) + 8 * (r >> 2)]; } } } \
    _Pragma("unroll") for (int f = 0; f < 8; ++f) { \
      if (VAR != 2 && VAR != 4) { O[f >> 1] = MFMA32(cat8(vlo[f & 3], vhi[f & 3]), pb[f & 1], O[f >> 1]); \
      if (f + 4 < 8) DU_VRD(f & 3, f + 4, vso_); } \
      if (VAR != 1 && VAR != 4) { B[2 * f] = __builtin_amdgcn_exp2f(B[2 * f]); B[2 * f + 1] = __builtin_amdgcn_exp2f(B[2 * f + 1]); } } \
  } while (0)
  f32x16 X, Y; bf16x8 kf[4];
  const float fAfter = __builtin_amdgcn_exp2f(cAfter);
  bool in_after = true;
  const int KT1 = NKT - 1;
  DU_DMA(KT1, 0);
  if (NKT > 1) DU_DMA(KT1 - 1, 1);
  if (NKT > 2) DU_DMA(KT1 - 2, 2);
  if (NKT > 2) asm volatile("s_waitcnt vmcnt(8)" ::: "memory"); else asm volatile("s_waitcnt vmcnt(0)" ::: "memory");
  __syncthreads();
  {
    const unsigned char* kb_ = lds + AL_STAGE + map * 8192 + 4096;
    f32x16 z_;
#pragma unroll
    for (int r = 0; r < 16; ++r) z_[r] = 0.f;
    X = MFMA32(*(const bf16x8*)(kb_ + kbase4[0]), qf[0], z_); X = MFMA32(*(const bf16x8*)(kb_ + kbase4[1]), qf[1], X);
    X = MFMA32(*(const bf16x8*)(kb_ + kbase4[2]), qf[2], X); X = MFMA32(*(const bf16x8*)(kb_ + kbase4[3]), qf[3], X);
    const int knext = 64 * KT1 + 32;
    const int dmin_ = knext - (qlo + 31), dmax_ = knext + 31 - qlo;
    if (dmin_ < 559) {
      in_after = false;
      if (dmax_ > -559) { const int base_ = knext + 4 * h - qpos + 640;
#pragma unroll
        for (int r = 0; r < 16; ++r) X[r] += tab[base_ + (r & 3) + 8 * (r >> 2)]; }
    }
#pragma unroll
    for (int r = 0; r < 16; ++r) X[r] = __builtin_amdgcn_exp2f(X[r]);
#pragma unroll
    for (int ks = 0; ks < 4; ++ks) kf[ks] = *(const bf16x8*)(lds + AL_STAGE + map * 8192 + kbase4[ks]);
  }
  if (map == 1) __builtin_amdgcn_s_setprio(1);
  int st_cur = 0, st_nxt = 32768, st_nx2 = 65536, st_free = 98304;
  for (int i = 0; i < NKT; ++i) {
    const int kt = KT1 - i;
    if (i + 2 < NKT) asm volatile("s_waitcnt vmcnt(4)" ::: "memory"); else asm volatile("s_waitcnt vmcnt(0)" ::: "memory");
    __syncthreads();
    if (i + 3 < NKT) DU_DMA(kt - 3, st_free / 32768);
    const unsigned char* knx[4]; const unsigned char* vp[4][2];
#pragma unroll
    for (int ks = 0; ks < 4; ++ks) knx[ks] = lds + AL_STAGE + st_nxt + map * 8192 + kbase4[ks];
#pragma unroll
    for (int nb = 0; nb < 4; ++nb) { vp[nb][0] = lds + AL_STAGE + st_cur + 16384 + vbase[nb][0]; vp[nb][1] = lds + AL_STAGE + st_cur + 16384 + vbase[nb][1]; }
    DU_SUB(X, Y, knx, 4096, (i + 1 < NKT), 8192, 64 * kt, true);
    DU_SUB(Y, X, knx, 0, (i + 1 < NKT), 0, 64 * kt - 32, (i + 1 < NKT));
    { const int t_ = st_cur; st_cur = st_nxt; st_nxt = st_nx2; st_nx2 = st_free; st_free = t_; }
  }
  __builtin_amdgcn_s_setprio(0);
#undef DU_DMA
#undef DU_GLDS
#undef DU_VRD
#undef DU_SUB
#undef SBAR
  if (in_after) {
#pragma unroll
    for (int nb = 0; nb < 4; ++nb)
#pragma unroll
      for (int r = 0; r < 16; ++r) O[nb][r] *= fAfter;
    l *= fAfter;
  }
  if (VAR != 0) {
#pragma unroll
    for (int nb = 0; nb < 4; ++nb) asm volatile("" :: "v"(O[nb]));
    asm volatile("" :: "v"(l), "v"(X), "v"(Y));
    __syncthreads();
    return;
  }
  __syncthreads();
  float ltot = l + __shfl_xor(l, 32);
  float* xbuf = (float*)(lds + AL_STAGE);
  if (map == 1) {
    const float inv = 1.0f / ltot;
#pragma unroll
    for (int nb = 0; nb < 4; ++nb)
#pragma unroll
      for (int r = 0; r < 16; ++r) xbuf[((wq * 64 + nb * 16 + r) << 6) + lane] = O[nb][r] * inv;
  }
  __syncthreads();
  if (map == 0) {
    const float inv = 1.0f / ltot;
    float ss = 0.f;
#pragma unroll
    for (int nb = 0; nb < 4; ++nb)
#pragma unroll
      for (int r = 0; r < 16; ++r) {
        float o = O[nb][r] * inv - lam * xbuf[((wq * 64 + nb * 16 + r) << 6) + lane];
        O[nb][r] = o; ss += o * o;
      }
    ss += __shfl_xor(ss, 32);
    const float rn = __builtin_amdgcn_rsqf(ss * (1.0f / 128.0f) + NORM_EPS) * 0.8f;
    u16* mix = (u16*)((unsigned char*)p.out + OUT_MIX) + (size_t)(seq_start + qpos) * 1024 + 512 + hd * 128;
#pragma unroll
    for (int nb = 0; nb < 4; ++nb)
#pragma unroll
      for (int g4 = 0; g4 < 4; ++g4) {
        const int d0 = 32 * nb + 8 * g4 + 4 * h;
        f32x4 gg = *(const f32x4*)(p.diff_norm_g + d0);
        u32x2 o; o[0] = pk2(O[nb][4 * g4 + 0] * rn * gg[0], O[nb][4 * g4 + 1] * rn * gg[1]);
        o[1] = pk2(O[nb][4 * g4 + 2] * rn * gg[2], O[nb][4 * g4 + 3] * rn * gg[3]);
        *(u32x2*)(mix + d0) = o;
      }
  }
  __syncthreads();
}

constexpr int AL_DPART = 65536;
constexpr int AL_DL    = AL_TAB;
template <int PASS>
DI void dil_wave_item(const Params& p, unsigned char* lds, int seq_start, int S, int hd, int i0, int sel) {
  const int tid = threadIdx.x, lane = tid & 63, r32 = lane & 31, h = lane >> 5;
  const int w = __builtin_amdgcn_readfirstlane(tid >> 6);
  const u16* QAp = (const u16*)(p.ws + WS_R + 0 * R_REGION);
  const u16* KAp = (const u16*)(p.ws + WS_R + 1 * R_REGION);
  const u16* VAp = (const u16*)(p.ws + WS_R + 2 * R_REGION);
  constexpr int QSTR = (PASS == 1) ? 1 : 16;
  constexpr int NTILE = (PASS == 1) ? 5 : 13;
  const int qbase = (PASS == 1) ? i0 + 32 * sel : i0 + sel;
  const int qpos = qbase + QSTR * r32;
  const int tl = qpos - i0;
  const u16* Qp = QAp + (size_t)seq_start * 512 + ((size_t)hd * S + qpos) * 64;
  bf16x8 qf[4];
#pragma unroll
  for (int ks = 0; ks < 4; ++ks) qf[ks] = *(const bf16x8*)(Qp + ks * 16 + h * 8);
  const u16* Kg = KAp + (size_t)seq_start * 512 + ((size_t)hd * S) * 64;
  const u16* Vg = VAp + (size_t)seq_start * 512 + ((size_t)hd * S) * 64;
  unsigned char* vt = lds + AL_VT + w * 8192;
  unsigned char* ktl = vt + 4096;
  const float* tabA = (const float*)(lds + AL_TABA) + hd * 3 * 132;
  unsigned char* dpart = lds + AL_DPART;
  float* dl = (float*)(lds + AL_DL);
  const int psw = ((tl >> 4) ^ tl) & 15;
  f32x16 O[2];
  float l = 0.f;
  if (PASS == 1) {
#pragma unroll
    for (int nb = 0; nb < 2; ++nb)
#pragma unroll
      for (int r = 0; r < 16; ++r) O[nb][r] = 0.f;
  } else {
#pragma unroll
    for (int nb = 0; nb < 2; ++nb)
#pragma unroll
      for (int g4 = 0; g4 < 4; ++g4) {
        const int ch = 8 * nb + 2 * g4 + h;
        const u32x2 v = *(const u32x2*)(dpart + tl * 128 + ((ch ^ psw) << 3));
        O[nb][4 * g4 + 0] = __uint_as_float(v[0] << 16); O[nb][4 * g4 + 1] = __uint_as_float(v[0] & 0xffff0000u);
        O[nb][4 * g4 + 2] = __uint_as_float(v[1] << 16); O[nb][4 * g4 + 3] = __uint_as_float(v[1] & 0xffff0000u);
      }
    if (h == 0) l = dl[tl];
  }
  const int i16 = lane & 15, tq = i16 >> 2, tp = i16 & 3, blk = (lane >> 4) & 1;
  int vrb[2][2];
#pragma unroll
  for (int nb = 0; nb < 2; ++nb)
#pragma unroll
    for (int hi = 0; hi < 2; ++hi) {
      const int R = 4 * h + tq + 8 * hi; const int ch = 4 * nb + 2 * blk + (tp >> 1);
      const int sw = (((R >> 1) & 1) << 2) ^ ((R >> 2) & 3);
      vrb[nb][hi] = R * 128 + ((ch ^ sw) << 4) + 8 * (tp & 1);
    }
  bf16x8 kfb[1][4]; u32x4 vcb[1][4];
  const int lrow = lane >> 3, lch = lane & 7;
#define DL_PARAMS(tau_) \
    const int d_ = (PASS == 1) ? 1 : (((tau_) < 5) ? 16 : 4); const int br_ = (PASS == 1) ? 2 : (((tau_) < 5) ? 0 : 1); \
    const int tt_ = (PASS == 1) ? (tau_) : (((tau_) < 5) ? (tau_) : (tau_) - 5); const int ratio_ = QSTR / d_; \
    const int n0_ = -64 + 32 * tt_;
#define DL_LOAD(buf, tau_) do { DL_PARAMS(tau_) \
    _Pragma("unroll") for (int i4 = 0; i4 < 4; ++i4) { int kpos_ = qbase + d_ * (n0_ + 8 * i4 + lrow); kpos_ = kpos_ < 0 ? 0 : (kpos_ >= S ? S - 1 : kpos_); \
      kfb[buf][i4] = *(const bf16x8*)(Kg + (size_t)kpos_ * 64 + lch * 8); vcb[buf][i4] = *(const u32x4*)(Vg + (size_t)kpos_ * 64 + lch * 8); } (void)br_; (void)ratio_; } while (0)
#define DL_STORE(buf) do { \
    _Pragma("unroll") for (int i4 = 0; i4 < 4; ++i4) { const int row_ = 8 * i4 + lrow; const int sw_ = (((row_ >> 1) & 1) << 2) ^ ((row_ >> 2) & 3); \
      *(u32x4*)(vt + row_ * 128 + ((lch ^ sw_) << 4)) = vcb[buf][i4]; \
      *(bf16x8*)(ktl + row_ * 128 + ((lch ^ ((row_ >> 1) & 7)) << 4)) = kfb[buf][i4]; } } while (0)
#define DL_COMPUTE(buf, tau_) do { DL_PARAMS(tau_) \
    const int kfirst_ = qbase + d_ * n0_, klast_ = qbase + d_ * (n0_ + 31); \
    const int base_ = n0_ + 4 * h - ratio_ * r32; const float* tb_ = tabA + br_ * 132; \
    f32x16 sT; \
    _Pragma("unroll") for (int r = 0; r < 16; ++r) { int dd = base_ + (r & 3) + 8 * (r >> 2); dd = dd < -65 ? -65 : (dd > 65 ? 65 : dd); sT[r] = tb_[dd + 65]; } \
    if (kfirst_ < 0 || klast_ >= S) { _Pragma("unroll") for (int r = 0; r < 16; ++r) { const int kp = qbase + d_ * (n0_ + crow(r, h)); if (kp < 0 || kp >= S) sT[r] = NEG_BIG; } } \
    _Pragma("unroll") for (int ks = 0; ks < 4; ++ks) { const bf16x8 ka_ = *(const bf16x8*)(ktl + r32 * 128 + (((2 * ks + h) ^ ((r32 >> 1) & 7)) << 4)); sT = MFMA32(ka_, qf[ks], sT); } \
    float ls = 0.f; \
    _Pragma("unroll") for (int r = 0; r < 16; ++r) { sT[r] = __builtin_amdgcn_exp2f(sT[r]); ls += sT[r]; } \
    l += ls; \
    bf16x8 pb[2]; \
    _Pragma("unroll") for (int s2 = 0; s2 < 2; ++s2) { \
      u32x4 pw; pw[0] = pk2(sT[8 * s2 + 0], sT[8 * s2 + 1]); pw[1] = pk2(sT[8 * s2 + 2], sT[8 * s2 + 3]); \
      pw[2] = pk2(sT[8 * s2 + 4], sT[8 * s2 + 5]); pw[3] = pk2(sT[8 * s2 + 6], sT[8 * s2 + 7]); \
      pb[s2] = __builtin_bit_cast(bf16x8, pw); } \
    _Pragma("unroll") for (int nb = 0; nb < 2; ++nb) _Pragma("unroll") for (int s2 = 0; s2 < 2; ++s2) { \
        const s16x4 lo = tr_read(vt + vrb[nb][0] + s2 * 2048); const s16x4 hi = tr_read(vt + vrb[nb][1] + s2 * 2048); \
        O[nb] = MFMA32(cat8(lo, hi), pb[s2], O[nb]); } \
  } while (0)
  DL_LOAD(0, 0);
#pragma unroll 1
  for (int tau = 0; tau < NTILE; ++tau) {
    DL_STORE(0);
    { const int tn = (tau + 1 < NTILE) ? tau + 1 : tau; DL_LOAD(0, tn); }
    DL_COMPUTE(0, tau);
  }
#undef DL_PARAMS
#undef DL_LOAD
#undef DL_STORE
#undef DL_COMPUTE
  const float ltot = l + __shfl_xor(l, 32);
  if (PASS == 1) {
#pragma unroll
    for (int nb = 0; nb < 2; ++nb)
#pragma unroll
      for (int g4 = 0; g4 < 4; ++g4) {
        const int ch = 8 * nb + 2 * g4 + h;
        u32x2 o; o[0] = pk2(O[nb][4 * g4 + 0], O[nb][4 * g4 + 1]); o[1] = pk2(O[nb][4 * g4 + 2], O[nb][4 * g4 + 3]);
        *(u32x2*)(dpart + tl * 128 + ((ch ^ psw) << 3)) = o;
      }
    if (h == 0) dl[tl] = ltot;
  } else {
    const float inv = 1.0f / ltot;
    u16* mix = (u16*)((unsigned char*)p.out + OUT_MIX) + (size_t)(seq_start + qpos) * 1024 + hd * 64;
#pragma unroll
    for (int nb = 0; nb < 2; ++nb)
#pragma unroll
      for (int g4 = 0; g4 < 4; ++g4) {
        const int d0 = 32 * nb + 8 * g4 + 4 * h;
        u32x2 o; o[0] = pk2(O[nb][4 * g4 + 0] * inv, O[nb][4 * g4 + 1] * inv); o[1] = pk2(O[nb][4 * g4 + 2] * inv, O[nb][4 * g4 + 3] * inv);
        *(u32x2*)(mix + d0) = o;
      }
  }
}

DI void phase_attn(const Params& p, unsigned char* lds) {
  const int tid = threadIdx.x;
  float* misc = (float*)(lds + AL_MISC);
  if (tid == 0) {
    float gqa = 0.f, gka = 0.f, gqb = 0.f, gkb = 0.f, bm = 0.f;
    for (int i = 0; i < 64; ++i) { gqa = fmaxf(gqa, fabsf(p.q_norm_a[i])); gka = fmaxf(gka, fabsf(p.k_norm_a[i])); gqb = fmaxf(gqb, fabsf(p.q_norm_b[i])); gkb = fmaxf(gkb, fabsf(p.k_norm_b[i])); }
    for (int i = 0; i < 32 * 12; ++i) bm = fmaxf(bm, fabsf(p.rel_bias[i]));
    const float M2 = 8.0f * LOG2E * fmaxf(gqa * gka, gqb * gkb) * 1.02f + bm * LOG2E + 0.1f;
    float s1 = 0.f, s2 = 0.f;
    for (int i = 0; i < 64; ++i) { s1 += p.lq1[i] * p.lk1[i]; s2 += p.lq2[i] * p.lk2[i]; }
    misc[0] = M2; misc[1] = expf(s1) - expf(s2) + 0.2f;
    for (int hd = 0; hd < 4; ++hd) { misc[8 + hd] = p.rel_bias[15 * 12 + 8 + hd] * LOG2E; misc[12 + hd] = (p.rel_bias[31 * 12 + 8 + hd] - p.rel_bias[15 * 12 + 8 + hd]) * LOG2E; }
  }
  __syncthreads();
  const float M2 = misc[0], lam = misc[1];
  {
    float* tabA = (float*)(lds + AL_TABA);
    for (int i = tid; i < 8 * 3 * 132; i += NTHR) {
      int hd = i / 396, rem = i % 396, br = rem / 132, idx = rem % 132;
      int dl = idx - 65; float v = NEG_BIG;
      if (dl >= -64 && dl <= 64 && idx < 131) { int d = (br == 0) ? 16 : (br == 1) ? 4 : 1; v = p.rel_bias[rel_bucket(dl * d) * 12 + hd] * LOG2E - M2; }
      tabA[i] = v;
    }
  }
#ifndef REP_DIFF
#define REP_DIFF 1
#endif
#ifndef REP_DIL
#define REP_DIL 1
#endif
  int cur_hd = -1;
  for (int rep_ = 0; rep_ < REP_DIFF; ++rep_)
  for (int vb = blockIdx.x; vb < 256; vb += gridDim.x) {
    const int xl = vb & 7, rk = vb >> 3;
#pragma unroll 1
    for (int rnd = 0; rnd < 8; ++rnd) {
      int seq_start, S, hd, q0;
      if (rnd < 4) { const int pair = xl + 8 * rnd; hd = pair & 3; S = 4096; seq_start = (pair >> 2) * 4096; q0 = rk * 128; }
      else { const int pair = 8 * xl + 2 * (rnd - 4) + (rk >> 4); hd = pair & 3; S = 2048; seq_start = T_PROMPT + (pair >> 2) * 2048; q0 = (rk & 15) * 128; }
      if (hd != cur_hd) {
        __syncthreads();
        float* tab = (float*)(lds + AL_TAB);
        for (int i = tid; i < 1281; i += NTHR) tab[i] = p.rel_bias[rel_bucket(i - 640) * 12 + 8 + hd] * LOG2E - misc[8 + hd];
        cur_hd = hd;
        __syncthreads();
      }
#ifndef PROBE_VAR
#define PROBE_VAR 0
#endif
      if (rep_ == 0) diff_unit<0>(p, lds, seq_start, S, hd, q0, lam); else diff_unit<PROBE_VAR>(p, lds, seq_start, S, hd, q0, lam);
    }
  }
  __syncthreads();
  const int w = tid >> 6;
  for (int rep_ = 0; rep_ < REP_DIL; ++rep_)
  for (int vb = blockIdx.x; vb < 256; vb += gridDim.x)
#pragma unroll 1
  for (int rnd = 0; rnd < 4; ++rnd) {
    const int xl = vb & 7, rk = vb >> 3;
    int seq_start, S, hd, i0;
    if (rnd < 2) { const int pair = xl * 8 + rnd * 4 + (rk >> 3); hd = pair & 7; S = 4096; seq_start = (pair >> 3) * 4096; i0 = (rk & 7) * 512; }
    else { const int pair = xl * 16 + (rnd - 2) * 8 + (rk >> 2); hd = pair & 7; S = 2048; seq_start = T_PROMPT + (pair >> 3) * 2048; i0 = (rk & 3) * 512; }
    __syncthreads();
#pragma unroll 1
    for (int u2 = 0; u2 < 2; ++u2) dil_wave_item<1>(p, lds, seq_start, S, hd, i0, w + 8 * u2);
    __syncthreads();
#pragma unroll 1
    for (int u2 = 0; u2 < 2; ++u2) dil_wave_item<2>(p, lds, seq_start, S, hd, i0, w + 8 * u2);
  }
}

struct EpiOut {
  static constexpr bool PERM = false, AFTER_DRAIN = false, HEADPERM = false;
  const float* xp; const float* xs; u16* x1;
  __device__ __forceinline__ void operator()(const pg8::f32x4 (&acc)[2][2][4][2], const pg8::Unit& u, int wr, int wc, int fr, int fq) const {
    const int col0 = u.pn * 256 + wc * 32 + 4 * fq;
#pragma unroll
    for (int ai = 0; ai < 2; ++ai)
#pragma unroll
      for (int m = 0; m < 4; ++m) {
        const int t = u.pm * 256 + ai * 128 + wr * 64 + m * 16 + fr;
        const float* xr = ((t < T_PROMPT) ? xp + (size_t)t * DM : xs + (size_t)(t - T_PROMPT) * DM) + col0;
        u16* orow = x1 + (size_t)t * DM + col0;
#pragma unroll
        for (int bj = 0; bj < 2; ++bj)
#pragma unroll
          for (int n = 0; n < 2; ++n) {
            const f32x4 xv = *(const f32x4*)(xr + bj * 128 + n * 16);
            const f32x4 sv_ = xv + acc[ai][bj][m][n];
            u32x2 o; o[0] = pk2(sv_[0], sv_[1]); o[1] = pk2(sv_[2], sv_[3]);
            *(u32x2*)(orow + bj * 128 + n * 16) = o;
          }
      }
  }
};

DI void phase_outproj(const Params& p, unsigned char* lds) {
  pg8::Gemm g{(const u16*)((const unsigned char*)p.out + OUT_MIX), (const u16*)(p.ws + WS_WOUT), T_TOK, 1024, 1024};
  pg8::StaticOrder S; S.init(T_TOK, 1024, (int)gridDim.x, (int)blockIdx.x);
  EpiOut E{p.x_prompt, p.x_sample, (u16*)(p.ws + WS_X1)};
  pg8::gemm_phase<EpiOut, pg8::StaticOrder, true, true>((PG8_LAS unsigned char*)lds, g, S, E);
}

DI void phase_norm2(const Params& p) {
  const int tid = threadIdx.x, lane = tid & 63, w = tid >> 6;
  const u16* x1 = (const u16*)(p.ws + WS_X1);
  u16* hb = (u16*)(p.ws + WS_H);
  float* hamax = (float*)(p.ws + WS_MISC + MISC_HAMAX);
  for (int it = blockIdx.x; it < T_TOK / 16; it += gridDim.x) {
    const int t = it * 16 + w, t2 = t + 8;
    norm_row2<true>(x1 + (size_t)t * DM, x1 + (size_t)t2 * DM, p.ffn_norm_g, hb + (size_t)t * DM, hb + (size_t)t2 * DM, lane, hamax + t, hamax + t2);
  }
}

struct EpiQp {
  static constexpr bool PERM = true, AFTER_DRAIN = false, HEADPERM = false;
  u16* O;
  __device__ __forceinline__ void operator()(const pg8::f32x4 (&acc)[2][2][4][2], const pg8::Unit& u, int wr, int wc, int fr, int fq) const {
    const int col0 = u.pn * 256 + wc * 32 + 8 * fq;
#pragma unroll
    for (int ai = 0; ai < 2; ++ai)
#pragma unroll
      for (int m = 0; m < 4; ++m) {
        const int t = u.pm * 256 + ai * 128 + wr * 64 + m * 16 + fr;
        u16* rowp = O + (size_t)t * 2048 + col0;
#pragma unroll
        for (int bj = 0; bj < 2; ++bj) {
          const f32x4 v0 = acc[ai][bj][m][0], v1 = acc[ai][bj][m][1];
          u32x4 o; o[0] = pk2(v0[0], v0[1]); o[1] = pk2(v0[2], v0[3]); o[2] = pk2(v1[0], v1[1]); o[3] = pk2(v1[2], v1[3]);
          *(u32x4*)(rowp + bj * 128) = o;
        }
      }
  }
};

DI void phase_peer_query(const Params& p, unsigned char* lds) {
  pg8::Gemm g{(const u16*)(p.ws + WS_H), (const u16*)(p.ws + WS_WQ), T_TOK, 2048, 1024};
  pg8::StaticOrder S; S.init(T_TOK, 2048, (int)gridDim.x, (int)blockIdx.x);
  EpiQp E{(u16*)p.out};
  pg8::gemm_phase<EpiQp, pg8::StaticOrder, true, true>((PG8_LAS unsigned char*)lds, g, S, E);
}

DI int f2sort(float f) { const int b = __float_as_int(f); return b ^ ((b >> 31) & 0x7fffffff); }
DI float sort2f(int s) { return __int_as_float(s ^ ((s >> 31) & 0x7fffffff)); }
#define CE_DESC(a, b) do { const int mx_ = max((a), (b)), mn_ = min((a), (b)); (a) = mx_; (b) = mn_; } while (0)
#define CE_ASC(a, b) do { const int mx_ = max((a), (b)), mn_ = min((a), (b)); (a) = mn_; (b) = mx_; } while (0)
template <int OFF> DI void sort16_desc(int (&x)[64]) {
#pragma unroll
  for (int k = 2; k <= 16; k <<= 1)
#pragma unroll
    for (int j = k >> 1; j > 0; j >>= 1)
#pragma unroll
      for (int i = 0; i < 16; ++i) {
        const int l = i ^ j;
        if (l > i) { if ((i & k) == 0) CE_DESC(x[OFF + i], x[OFF + l]); else CE_ASC(x[OFF + i], x[OFF + l]); }
      }
}
template <int A, int B> DI void merge16x(int (&x)[64]) {
#pragma unroll
  for (int i = 0; i < 16; ++i) x[A + i] = max(x[A + i], x[B + 15 - i]);
#pragma unroll
  for (int j = 8; j > 0; j >>= 1)
#pragma unroll
    for (int i = 0; i < 16; ++i) { const int l = i ^ j; if (l > i) CE_DESC(x[A + i], x[A + l]); }
}

DI void pack_hq(unsigned w0, unsigned w1, unsigned w2, unsigned w3, float sc, unsigned& HH, unsigned& LL) {
  const float MAGIC = 12582912.0f + 136.0f;
  const unsigned y0 = __float_as_uint(__builtin_fmaf(__uint_as_float(w0 << 16), sc, MAGIC)), y1 = __float_as_uint(__builtin_fmaf(__uint_as_float(w0 & 0xffff0000u), sc, MAGIC));
  const unsigned y2 = __float_as_uint(__builtin_fmaf(__uint_as_float(w1 << 16), sc, MAGIC)), y3 = __float_as_uint(__builtin_fmaf(__uint_as_float(w1 & 0xffff0000u), sc, MAGIC));
  const unsigned y4 = __float_as_uint(__builtin_fmaf(__uint_as_float(w2 << 16), sc, MAGIC)), y5 = __float_as_uint(__builtin_fmaf(__uint_as_float(w2 & 0xffff0000u), sc, MAGIC));
  const unsigned y6 = __float_as_uint(__builtin_fmaf(__uint_as_float(w3 << 16), sc, MAGIC)), y7 = __float_as_uint(__builtin_fmaf(__uint_as_float(w3 & 0xffff0000u), sc, MAGIC));
  const unsigned W = (y0 & 255u) | ((y1 & 255u) << 8) | ((y2 & 255u) << 16) | (y3 << 24);
  const unsigned X = (y4 & 255u) | ((y5 & 255u) << 8) | ((y6 & 255u) << 16) | (y7 << 24);
  HH = (((W >> 4) & 0x0F0F0F0Fu) | (X & 0xF0F0F0F0u)) ^ 0x88888888u;
  LL = ((W & 0x0F0F0F0Fu) | ((X << 4) & 0xF0F0F0F0u)) ^ 0x88888888u;
}
DI void quantise_h_rows(const Params& p, int t0, int lane) {
  const float* hamax = (const float*)(p.ws + WS_MISC + MISC_HAMAX);
  unsigned char* Hrow = p.ws + WS_H;
#pragma unroll 1
  for (int rr = 0; rr < 32; rr += 4) {
    u32x4 ha[4], hb[4]; float sc[4];
#pragma unroll
    for (int q = 0; q < 4; ++q) {
      const unsigned char* src = Hrow + (size_t)(t0 + rr + q) * 2048 + lane * 32;
      ha[q] = *(const u32x4*)src; hb[q] = *(const u32x4*)(src + 16);
      const float am = hamax[t0 + rr + q];
      sc[q] = (am > 0.f) ? 119.0f / am : 0.f;
    }
#pragma unroll
    for (int q = 0; q < 4; ++q) {
      unsigned h0, l0, h1, l1;
      pack_hq(ha[q][0], ha[q][1], ha[q][2], ha[q][3], sc[q], h0, l0);
      pack_hq(hb[q][0], hb[q][1], hb[q][2], hb[q][3], sc[q], h1, l1);
      u32x2 hi, lo; hi[0] = h0; hi[1] = h1; lo[0] = l0; lo[1] = l1;
      unsigned char* dst = Hrow + (size_t)(t0 + rr + q) * 2048 + (lane >> 4) * 256 + (lane & 15) * 8;
      *(u32x2*)dst = hi; *(u32x2*)(dst + 128) = lo;
    }
  }
}

DI void phase_peer_route(const Params& p, unsigned char* lds) {
  const u16* QP = (const u16*)p.out;
  const u16* SK = (const u16*)(p.ws + WS_SK);
  u16* eidx = (u16*)(p.ws + WS_EIDX);
  float* gg = (float*)(p.ws + WS_G);
  const int tid = threadIdx.x, lane = tid & 63, r32 = lane & 31, h = lane >> 5;
  const int w = __builtin_amdgcn_readfirstlane(tid >> 6);
  unsigned char* SKl = lds;
  float* v2l = (float*)(lds + 65536);
  __syncthreads();
#pragma unroll
  for (int i = 0; i < 8; ++i) {
    const int c = tid + 512 * i; const int zz = c >> 11, row = (c >> 4) & 127, ch = c & 15;
    const u32x4 v = *(const u32x4*)(SK + (size_t)zz * 16384 + row * 128 + ch * 8);
    *(u32x4*)(SKl + zz * 32768 + row * 256 + ((ch ^ (row & 15)) << 4)) = v;
  }
  __syncthreads();
  for (int item = blockIdx.x; item < T_TOK / 256; item += gridDim.x) {
    quantise_h_rows(p, item * 256 + w * 32, lane);
    const int t = item * 256 + w * 32 + r32;
    const u16* qrow = QP + (size_t)t * 2048;
    bf16x8 qf[8];
#pragma unroll
    for (int ks = 0; ks < 8; ++ks) qf[ks] = *(const bf16x8*)(qrow + ks * 16 + h * 8);
#pragma unroll 1
    for (int pp = 0; pp < 8; ++pp) {
      int lists[2][16];
#pragma unroll
      for (int z = 0; z < 2; ++z) {
        const int c16 = pp * 2 + z;
        int x[64];
        {
          f32x16 S2[4];
#pragma unroll
          for (int kb = 0; kb < 4; ++kb)
#pragma unroll
            for (int r = 0; r < 16; ++r) S2[kb][r] = 0.f;
#pragma unroll
          for (int ks = 0; ks < 8; ++ks)
#pragma unroll
            for (int kb = 0; kb < 4; ++kb) {
              const int key = kb * 32 + r32;
              const bf16x8 a = *(const bf16x8*)(SKl + z * 32768 + key * 256 + (((2 * ks + h) ^ (key & 15)) << 4));
              S2[kb] = MFMA32(a, qf[ks], S2[kb]);
            }
          {
            const int cn = (c16 + 1 < 16) ? c16 + 1 : 15;
#pragma unroll
            for (int ks = 0; ks < 8; ++ks) qf[ks] = *(const bf16x8*)(qrow + cn * 128 + ks * 16 + h * 8);
          }
#pragma unroll
          for (int e = 0; e < 64; ++e) {
            const int kidx = 32 * (e >> 4) + (e & 3) + 8 * ((e & 15) >> 2) + 4 * h;
            x[e] = (f2sort(S2[e >> 4][e & 15]) & ~127) | kidx;
          }
        }
        sort16_desc<0>(x); sort16_desc<16>(x); sort16_desc<32>(x); sort16_desc<48>(x);
        merge16x<0, 16>(x); merge16x<32, 48>(x); merge16x<0, 32>(x);
#pragma unroll
        for (int i = 0; i < 16; ++i) x[16 + i] = __shfl_xor(x[i], 32);
        merge16x<0, 16>(x);
#pragma unroll
        for (int i = 0; i < 16; ++i) lists[z][i] = x[i];
      }
      float v1h[8];
#pragma unroll
      for (int i = 0; i < 8; ++i) { const int a0_ = lists[0][i], a1_ = lists[0][8 + i]; v1h[i] = sort2f(a0_ ^ ((a0_ ^ a1_) & -h)); }
#pragma unroll
      for (int i = 0; i < 16; ++i) v2l[i * 512 + tid] = sort2f(lists[1][i]);
      unsigned ptrs = 0u;
      float bestv[16]; int be[16];
#pragma unroll
      for (int rd = 0; rd < 16; ++rd) {
        float best = -3.0e38f, bv1 = 0.f, bv2 = 0.f; int ab = 0;
#pragma unroll
        for (int a = 0; a < 8; ++a) {
          const int b = (int)((ptrs >> (4 * a)) & 15u);
          const float v2 = v2l[b * 512 + tid];
          const float cnd = v1h[a] + v2;
          if (cnd > best) { best = cnd; ab = a; bv1 = v1h[a]; bv2 = v2; }
        }
        const float obest = __shfl_xor(best, 32), obv1 = __shfl_xor(bv1, 32), obv2 = __shfl_xor(bv2, 32);
        const bool mine = h ? (best > obest) : (best >= obest);
        const float wbest = mine ? best : obest, w1 = mine ? bv1 : obv1, w2 = mine ? bv2 : obv2;
        bestv[rd] = wbest; be[rd] = (f2sort(w1) & 127) * 128 + (f2sort(w2) & 127);
        if (mine) ptrs += 1u << (4 * ab);
      }
      if (h == 0) {
        float ex[16]; float sum = 0.f;
#pragma unroll
        for (int rd = 0; rd < 16; ++rd) { ex[rd] = __expf(bestv[rd] - bestv[0]); sum += ex[rd]; }
        const float inv = 1.0f / sum;
        const size_t oo = ((size_t)t * 8 + pp) * 16;
#pragma unroll
        for (int q4 = 0; q4 < 4; ++q4) { f32x4 v = {ex[4 * q4] * inv, ex[4 * q4 + 1] * inv, ex[4 * q4 + 2] * inv, ex[4 * q4 + 3] * inv}; *(f32x4*)(gg + oo + 4 * q4) = v; }
        u32x4 e0, e1;
#pragma unroll
        for (int j = 0; j < 4; ++j) { e0[j] = (unsigned)be[2 * j] | ((unsigned)be[2 * j + 1] << 16); e1[j] = (unsigned)be[8 + 2 * j] | ((unsigned)be[8 + 2 * j + 1] << 16); }
        *(u32x4*)(eidx + oo) = e0; *(u32x4*)(eidx + oo + 8) = e1;
      }
    }
  }
}

typedef float f2_t __attribute__((ext_vector_type(2)));
DI unsigned xcc_id() { return (unsigned)__builtin_amdgcn_s_getreg((3 << 11) | 20) & 7u; }
constexpr int PG_CHUNK_TOK = 64;
constexpr int PG_NCHUNK = T_TOK / PG_CHUNK_TOK;

DI void dec32(const u32x4& r, f2_t (&v)[16]) {
#pragma unroll
  for (int d = 0; d < 4; ++d) {
    v[4 * d + 0] = __builtin_amdgcn_cvt_scalef32_pk_f32_fp4(r[d], 1.0f, 0); v[4 * d + 1] = __builtin_amdgcn_cvt_scalef32_pk_f32_fp4(r[d], 1.0f, 1);
    v[4 * d + 2] = __builtin_amdgcn_cvt_scalef32_pk_f32_fp4(r[d], 1.0f, 2); v[4 * d + 3] = __builtin_amdgcn_cvt_scalef32_pk_f32_fp4(r[d], 1.0f, 3);
  }
}

template <int CTRL> DI float dpp_f(float x) { return __int_as_float(__builtin_amdgcn_update_dpp(0, __float_as_int(x), CTRL, 0xf, 0xf, true)); }
DI int idx16(const u32x4& a, const u32x4& b, int i) { const unsigned wd = (i < 8) ? a[(i & 7) >> 1] : b[(i & 7) >> 1]; return (i & 1) ? (int)(wd >> 16) : (int)(wd & 0xffffu); }
constexpr int PEER_NT = 16;
template <int WHICH>
DI void peer_wave_tokens(const Params& p, int x, int tb, int lane) {
  const unsigned char* TBL = p.ws + (WHICH ? WS_V : WS_U) + (size_t)x * 16384 * 128;
  const u16* Hb = (const u16*)(p.ws + WS_H);
  const u16* eidx = (const u16*)(p.ws + WS_EIDX);
  const u16* w16 = (const u16*)(p.ws + WS_W16);
  const float* x1 = (const float*)(p.ws + WS_X1);
  float* zpart = (float*)(p.ws + WS_ZP);
  const int r = lane >> 3, c = lane & 7;
  u32x4 ei[2][2]; u32x4 wv[2][2]; u32x4 rows[2][16]; u32x4 hsl[2][2];
#define PEER_LOAD_IDX(buf, k) do { const size_t o_ = (size_t)(tb + (k)) * 128 + r * 16; \
    ei[buf][0] = *(const u32x4*)(eidx + o_); ei[buf][1] = *(const u32x4*)(eidx + o_ + 8); \
    if (WHICH) { wv[buf][0] = *(const u32x4*)(w16 + o_); wv[buf][1] = *(const u32x4*)(w16 + o_ + 8); } } while (0)
#define PEER_LOAD_ROWS4(buf, ibuf, g) do { _Pragma("unroll") for (int ii_ = 0; ii_ < 4; ++ii_) { \
      const unsigned off_ = (unsigned)idx16(ei[ibuf][0], ei[ibuf][1], 4 * (g) + ii_) * 128u + (unsigned)c * 16u; \
      rows[buf][4 * (g) + ii_] = *(const u32x4*)(TBL + off_); } } while (0)
#define PEER_LOAD_ROWS(buf, ibuf) do { PEER_LOAD_ROWS4(buf, ibuf, 0); PEER_LOAD_ROWS4(buf, ibuf, 1); PEER_LOAD_ROWS4(buf, ibuf, 2); PEER_LOAD_ROWS4(buf, ibuf, 3); } while (0)
#define PEER_NEXT4(g) do { __builtin_amdgcn_sched_barrier(0); if (k + 1 < PEER_NT) PEER_LOAD_ROWS4((k + 1) & 1, (k + 1) & 1, g); __builtin_amdgcn_sched_barrier(0); } while (0)
#define PEER_LOAD_H(buf, k) do { if (WHICH == 0) { const unsigned char* hq_ = (const unsigned char*)Hb + (size_t)(tb + (k)) * 2048 + x * 256 + c * 16;     \
    hsl[buf][0] = *(const u32x4*)(hq_); hsl[buf][1] = *(const u32x4*)(hq_ + 128); } } while (0)
  PEER_LOAD_IDX(0, 0); PEER_LOAD_IDX(1, 1);
  PEER_LOAD_H(0, 0);
  PEER_LOAD_ROWS(0, 0);
#pragma unroll
  for (int k = 0; k < PEER_NT; ++k) {
    const int t = tb + k;
    u32x4 wcur[2];
    if (WHICH) { wcur[0] = wv[k & 1][0]; wcur[1] = wv[k & 1][1]; }
    if (k + 2 < PEER_NT) PEER_LOAD_IDX(k & 1, k + 2);
    if (k + 1 < PEER_NT) PEER_LOAD_H((k + 1) & 1, k + 1);
    if (WHICH == 0) {
      const u32x4 hh = hsl[k & 1][0], hl = hsl[k & 1][1];
      float sv[16];
#pragma unroll
      for (int i = 0; i < 16; ++i) {
        if ((i & 3) == 0) PEER_NEXT4(i >> 2);
        int ah = __builtin_amdgcn_sdot8((int)rows[k & 1][i][0], (int)hh[0], 0, false);
        int al = __builtin_amdgcn_sdot8((int)rows[k & 1][i][0], (int)hl[0], 0, false);
        ah = __builtin_amdgcn_sdot8((int)rows[k & 1][i][1], (int)hh[1], ah, false);
        al = __builtin_amdgcn_sdot8((int)rows[k & 1][i][1], (int)hl[1], al, false);
        ah = __builtin_amdgcn_sdot8((int)rows[k & 1][i][2], (int)hh[2], ah, false);
        al = __builtin_amdgcn_sdot8((int)rows[k & 1][i][2], (int)hl[2], al, false);
        ah = __builtin_amdgcn_sdot8((int)rows[k & 1][i][3], (int)hh[3], ah, false);
        al = __builtin_amdgcn_sdot8((int)rows[k & 1][i][3], (int)hl[3], al, false);
        int a = ah * 16 + al;
        a += __builtin_amdgcn_update_dpp(0, a, 0xB1, 0xf, 0xf, true);
        a += __builtin_amdgcn_update_dpp(0, a, 0x4E, 0xf, 0xf, true);
        a += __builtin_amdgcn_update_dpp(0, a, 0x141, 0xf, 0xf, true);
        sv[i] = (float)a;
      }
      float o0 = 0.f, o1 = 0.f;
#pragma unroll
      for (int i = 0; i < 8; ++i) { if (c == i) { o0 = sv[i]; o1 = sv[i + 8]; } }
      float* zp = zpart + ((size_t)x * T_TOK + t) * 128 + r * 16;
      zp[c] = o0; zp[c + 8] = o1;
    } else {
      f2_t acc[16];
#pragma unroll
      for (int q = 0; q < 16; ++q) { acc[q][0] = 0.f; acc[q][1] = 0.f; }
#pragma unroll
      for (int i = 0; i < 16; ++i) {
        if ((i & 3) == 0) PEER_NEXT4(i >> 2);
        f2_t v[16]; dec32(rows[k & 1][i], v);
        const unsigned wd_ = wcur[i >> 3][(i & 7) >> 1];
        const float wj = (i & 1) ? __uint_as_float(wd_ & 0xffff0000u) : __uint_as_float(wd_ << 16);
        f2_t ww = {wj, wj};
#pragma unroll
        for (int q = 0; q < 16; ++q) acc[q] = __builtin_elementwise_fma(v[q], ww, acc[q]);
      }
      f2_t b8[8];
      {
        const bool up = (lane & 32) != 0;
#pragma unroll
        for (int q = 0; q < 8; ++q) {
          f2_t keep = up ? acc[8 + q] : acc[q], send = up ? acc[q] : acc[8 + q];
          f2_t got; got[0] = __shfl_xor(send[0], 32); got[1] = __shfl_xor(send[1], 32);
          b8[q] = keep + got;
        }
      }
      f2_t b4[4];
      {
        const bool up = (lane & 16) != 0;
#pragma unroll
        for (int q = 0; q < 4; ++q) {
          f2_t keep = up ? b8[4 + q] : b8[q], send = up ? b8[q] : b8[4 + q];
          f2_t got; got[0] = __shfl_xor(send[0], 16); got[1] = __shfl_xor(send[1], 16);
          b4[q] = keep + got;
        }
      }
      f2_t b2[2];
      {
        const bool up = (lane & 8) != 0;
#pragma unroll
        for (int q = 0; q < 2; ++q) {
          f2_t keep = up ? b4[2 + q] : b4[q], send = up ? b4[q] : b4[2 + q];
          f2_t got; got[0] = dpp_f<0x128>(send[0]); got[1] = dpp_f<0x128>(send[1]);
          b2[q] = keep + got;
        }
      }
      const size_t o = (size_t)t * DM + x * 256 + c * 32 + 4 * r;
      const f32x4 xv = *(const f32x4*)(x1 + o);
      f32x4 res; res[0] = xv[0] + b2[0][0]; res[1] = xv[1] + b2[0][1]; res[2] = xv[2] + b2[1][0]; res[3] = xv[3] + b2[1][1];
      *(f32x4*)(p.out + o) = res;
    }
  }
#undef PEER_LOAD_IDX
#undef PEER_LOAD_H
#undef PEER_LOAD_ROWS
#undef PEER_LOAD_ROWS4
#undef PEER_NEXT4
}

typedef int v8i_t __attribute__((ext_vector_type(8)));
template <int NTOK, int VAR = 0>
DI void peer_tokens_v(const Params& p, unsigned char* ldsw, int t0, int lane) {
  const unsigned char* TBL = p.ws + WS_V;
  const u16* eidx = (const u16*)(p.ws + WS_EIDX);
  const unsigned char* w8 = p.ws + WS_W16;
  const u16* x1 = (const u16*)(p.ws + WS_X1);
  const int j = lane & 31, kg = lane >> 5;
  unsigned M[4];
#pragma unroll
  for (int q = 0; q < 4; ++q) M[q] = (kg == (j >> 4) && ((j & 15) >> 2) == q) ? (0xFFu << (8 * (j & 3))) : 0u;
  u32x4 ei[2][2]; u32x4 wv[2][2]; u32x4 rows[2][16];
#define PV_LOAD_IDX(u) do { const size_t o_ = (size_t)(t0 + ((u) >> 2)) * 128 + 16 * ((u) & 3); \
    ei[(u) & 1][0] = *(const u32x4*)(eidx + o_ + 64 * kg); ei[(u) & 1][1] = *(const u32x4*)(eidx + o_ + 64 * kg + 8); } while (0)
#define PV_LOAD_W(u) do { const size_t o_ = (size_t)(t0 + ((u) >> 2)) * 128 + 16 * ((u) & 3); \
    wv[(u) & 1][0] = *(const u32x4*)(w8 + o_); wv[(u) & 1][1] = *(const u32x4*)(w8 + o_ + 64); } while (0)
#define PV_IDX(ibuf, n) (((n) & 1) ? (ei[ibuf][(n) >> 3][((n) & 7) >> 1] >> 16) : (ei[ibuf][(n) >> 3][((n) & 7) >> 1] & 0xffffu))
#define PV_LOAD_ROWS4(u, g) do { _Pragma("unroll") for (int ii_ = 0; ii_ < 4; ++ii_) { \
      const unsigned off_ = (unsigned)PV_IDX((u) & 1, 4 * (g) + ii_) * 512u + (unsigned)j * 16u; \
      rows[(u) & 1][4 * (g) + ii_] = *(const u32x4*)(TBL + off_); } } while (0)
  constexpr int NU = 4 * NTOK;
  PV_LOAD_IDX(0); PV_LOAD_IDX(1); PV_LOAD_W(0);
  PV_LOAD_ROWS4(0, 0); PV_LOAD_ROWS4(0, 1); PV_LOAD_ROWS4(0, 2); PV_LOAD_ROWS4(0, 3);
  PV_LOAD_ROWS4(1, 0); PV_LOAD_ROWS4(1, 1); PV_LOAD_ROWS4(1, 2); PV_LOAD_ROWS4(1, 3);
  PV_LOAD_IDX(2);
  f32x16 acc; f32x4 xv[4];
  constexpr int XV_AT = 3;
#pragma unroll
  for (int u = 0; u < NU; ++u) {
    const int t = t0 + (u >> 2), c = u & 3;
    if (c == 0) {
#pragma unroll
      for (int r = 0; r < 16; ++r) acc[r] = 0.f;
    }
    if (c == 2 && VAR != 1) {
#pragma unroll
      for (int rq = 0; rq < 2; ++rq) {
        const u16* gsrc_ = x1 + (size_t)t * DM + 512 * rq + 8 * lane;
        unsigned keep_; const unsigned dst_ = (unsigned)__builtin_amdgcn_readfirstlane((int)((unsigned)(uintptr_t)ldsw + 1024u * rq));
        asm volatile("s_mov_b32 %0, m0\n\ts_mov_b32 m0, %2\n\ts_nop 0\n\tglobal_load_lds_dwordx4 %1, off\n\ts_mov_b32 m0, %0" : "=&s"(keep_) : "v"(gsrc_), "s"(dst_) : "memory");
      }
    }
    if (u + 3 < NU) PV_LOAD_IDX(u + 3);
    if (u + 1 < NU) PV_LOAD_W(u + 1);
#pragma unroll
    for (int n = 0; n < 16; ++n) {
      const unsigned wd1 = wv[u & 1][0][n >> 2], wd2 = wv[u & 1][1][n >> 2];
      const unsigned rep1 = __builtin_amdgcn_perm(wd1, wd1, 0x01010101u * (unsigned)(n & 3));
      const unsigned rep2 = __builtin_amdgcn_perm(wd2, wd2, 0x01010101u * (unsigned)(n & 3));
      v8i_t A, B;
#pragma unroll
      for (int q = 0; q < 4; ++q) { A[q] = (int)(rep1 & M[q]); A[4 + q] = (int)(rep2 & M[q]); }
      B[0] = (int)rows[u & 1][n][0]; B[1] = (int)rows[u & 1][n][1]; B[2] = (int)rows[u & 1][n][2]; B[3] = (int)rows[u & 1][n][3];
      B[4] = 0; B[5] = 0; B[6] = 0; B[7] = 0;
      acc = __builtin_amdgcn_mfma_scale_f32_32x32x64_f8f6f4(A, B, acc, 0  , 4  , 0, 0x7F7F7F7F, 0, 0x7F7F7F7F);
      if ((n & 3) == 3) {
        __builtin_amdgcn_sched_barrier(0);
        if (u + 2 < NU) PV_LOAD_ROWS4(u + 2, n >> 2);
        __builtin_amdgcn_sched_barrier(0);
      }
    }
    if (c == 3) {
      if (VAR != 1) {
        static_assert(NTOK == 4, "the vmcnt immediate below is counted for 16-chunk units");
        if (u + 3 < NU) asm volatile("s_waitcnt vmcnt(40)" ::: "memory");
        else asm volatile("s_waitcnt vmcnt(0)" ::: "memory");
#pragma unroll
        for (int rq = 0; rq < 4; ++rq) {
          const u32x2 r_ = *(const u32x2*)(ldsw + 2 * (32 * j + 8 * rq + 4 * kg));
          xv[rq][0] = __uint_as_float(r_[0] << 16); xv[rq][1] = __uint_as_float(r_[0] & 0xffff0000u); xv[rq][2] = __uint_as_float(r_[1] << 16); xv[rq][3] = __uint_as_float(r_[1] & 0xffff0000u);
        }
      }
#pragma unroll
      for (int rq = 0; rq < 4; ++rq) {
        const size_t o = (size_t)t * DM + 32 * j + 8 * rq + 4 * kg;
        f32x4 res;
#pragma unroll
        for (int q = 0; q < 4; ++q) res[q] = (VAR != 1 ? xv[rq][q] : 0.f) + acc[4 * rq + q] * (1.0f / 2048.0f);
        if (VAR != 1 || res[0] == 123456.789f) *(f32x4*)(p.out + o) = res;
      }
    }
  }
#undef PV_LOAD_IDX
#undef PV_LOAD_W
#undef PV_IDX
#undef PV_LOAD_ROWS4
}
DI void peer_act_range(const Params& p, size_t q_lo, size_t q_hi, int lane) {
  const float* zpart = (const float*)(p.ws + WS_ZP);
  const u16* eidx = (const u16*)(p.ws + WS_EIDX);
  float* wg = (float*)(p.ws + WS_G);
  const float* suinv = (const float*)(p.ws + WS_MISC + MISC_SUINV);
  const float* svinv = (const float*)(p.ws + WS_MISC + MISC_SVINV);
  const float* hamax = (const float*)(p.ws + WS_MISC + MISC_HAMAX);
#pragma unroll 4
  for (size_t i4 = q_lo + lane; i4 < q_hi; i4 += 64) {
    const size_t i = i4 * 4;
    f32x4 z = *(const f32x4*)(zpart + i);
#pragma unroll
    for (int x = 1; x < 4; ++x) { const f32x4 zz = *(const f32x4*)(zpart + (size_t)x * T_TOK * 128 + i); z[0] += zz[0]; z[1] += zz[1]; z[2] += zz[2]; z[3] += zz[3]; }
    const u32x2 ee = *(const u32x2*)(eidx + i);
    const f32x4 g4 = *(const f32x4*)(wg + i);
    const float hs = hamax[i >> 7] * (1.0f / 119.0f);
    float wq[4];
#pragma unroll
    for (int q = 0; q < 4; ++q) {
      const int e = (int)((q & 1) ? (ee[q >> 1] >> 16) : (ee[q >> 1] & 0xffffu));
      const float zq = z[q] * suinv[e] * hs;
      const float act = 0.5f * zq * (1.0f + erff(zq * 0.70710678118654752f));
      wq[q] = fminf(fmaxf(g4[q] * act * svinv[e] * 2048.0f, -448.0f), 448.0f);
    }
    int pk = __builtin_amdgcn_cvt_pk_fp8_f32(wq[0], wq[1], 0, false);
    pk = __builtin_amdgcn_cvt_pk_fp8_f32(wq[2], wq[3], pk, true);
    *(unsigned*)(p.ws + WS_W16 + i) = (unsigned)pk;
  }
}

template <int VAR = 0>
DI void phase_peer_v(const Params& p, unsigned char* lds) {
  const int tid = threadIdx.x, lane = tid & 63;
  const int w = __builtin_amdgcn_readfirstlane(tid >> 6);
  const int gw = blockIdx.x * 8 + w, nw = gridDim.x * 8;
  const int per = (T_TOK / 4 + nw - 1) / nw;
  const int u_lo = gw * per, u_hi = (u_lo + per < T_TOK / 4) ? u_lo + per : T_TOK / 4;
  if (u_lo >= u_hi) return;
  if (VAR == 0) {
    peer_act_range(p, (size_t)u_lo * 4 * 32, (size_t)u_hi * 4 * 32, lane);
    asm volatile("s_waitcnt vmcnt(0)" ::: "memory");
    __builtin_amdgcn_fence(__ATOMIC_ACQUIRE, "agent");
    asm volatile("s_waitcnt vmcnt(0)" ::: "memory");
  }
#pragma unroll 1
  for (int u = u_lo; u < u_hi; ++u) peer_tokens_v<4, VAR>(p, lds + w * 4096, u * 4, lane);
}

DI unsigned peer_wword(float w) {
  const unsigned b = __float_as_uint(w);
  const unsigned sgn = (b >> 31) ? 0x88000000u : 0u;
  const unsigned E = (b >> 23) & 255u, f = (b >> 7) & 0xffffu;
  if (E < 8u || E > 250u) return 0u;
  unsigned s1, s2;
  if (f < 6144u)       { s1 = E;      s2 = 0u; }
  else if (f < 18432u) { s1 = E;      s2 = E - 3u; }
  else if (f < 28672u) { s1 = E;      s2 = E - 2u; }
  else if (f < 40960u) { s1 = 0u;     s2 = E; }
  else if (f < 57344u) { s1 = E;      s2 = E - 1u; }
  else                 { s1 = E + 1u; s2 = 0u; }
  return s1 | (s2 << 8) | sgn;
}
DI void phase_peer_act(const Params& p) {
  const float* zpart = (const float*)(p.ws + WS_ZP);
  const u16* eidx = (const u16*)(p.ws + WS_EIDX);
  float* wg = (float*)(p.ws + WS_G);
  const float* suinv = (const float*)(p.ws + WS_MISC + MISC_SUINV);
  const float* svinv = (const float*)(p.ws + WS_MISC + MISC_SVINV);
  const float* hamax = (const float*)(p.ws + WS_MISC + MISC_HAMAX);
  for (size_t i4 = (size_t)blockIdx.x * NTHR + threadIdx.x; i4 < (size_t)T_TOK * 32; i4 += (size_t)gridDim.x * NTHR) {
    const size_t i = i4 * 4;
    f32x4 z = *(const f32x4*)(zpart + i);
#pragma unroll
    for (int x = 1; x < 4; ++x) { const f32x4 zz = *(const f32x4*)(zpart + (size_t)x * T_TOK * 128 + i); z[0] += zz[0]; z[1] += zz[1]; z[2] += zz[2]; z[3] += zz[3]; }
    const u32x2 ee = *(const u32x2*)(eidx + i);
    const f32x4 g4 = *(const f32x4*)(wg + i);
    const float hs = hamax[i >> 7] * (1.0f / 119.0f);
    u32x4 o;
#pragma unroll
    for (int q = 0; q < 4; ++q) {
      const int e = (int)((q & 1) ? (ee[q >> 1] >> 16) : (ee[q >> 1] & 0xffffu));
      const float zq = z[q] * suinv[e] * hs;
      const float act = 0.5f * zq * (1.0f + erff(zq * 0.70710678118654752f));
      o[q] = peer_wword(g4[q] * act * svinv[e]);
    }
    *(u32x4*)(wg + i) = o;
  }
}

DI void peer_wave_tokens_s9(const Params& p, int x, int tb, int lane) {
  const unsigned char* TBL = p.ws + WS_V + (size_t)x * 16384 * 128;
  const u16* eidx = (const u16*)(p.ws + WS_EIDX);
  const unsigned* wwp = (const unsigned*)(p.ws + WS_G);
  const u16* x1 = (const u16*)(p.ws + WS_X1);
  const int r = lane >> 3, c = lane & 7, j = lane & 15, g = lane >> 4, je = j >> 3;
  v8i_t A0, A1, A0h, A1h;
#pragma unroll
  for (int q = 0; q < 8; ++q) {
    A0[q] = (q == (j >> 3)) ? (int)(0x2u << (4 * (j & 7))) : 0;
    A1[q] = (q == 2 + (j >> 3)) ? (int)(0x2u << (4 * (j & 7))) : 0;
    A0h[q] = (q == (j >> 3)) ? (int)(0x3u << (4 * (j & 7))) : 0;
    A1h[q] = (q == 2 + (j >> 3)) ? (int)(0x3u << (4 * (j & 7))) : 0;
  }
  u32x4 ei[2][2]; u32x4 wq[2][4]; u32x4 rows[2][16];
#define S9_LOAD_IDX(buf, k) do { const size_t o_ = (size_t)(tb + (k)) * 128 + r * 16; \
    ei[buf][0] = *(const u32x4*)(eidx + o_); ei[buf][1] = *(const u32x4*)(eidx + o_ + 8); \
    wq[buf][0] = *(const u32x4*)(wwp + o_); wq[buf][1] = *(const u32x4*)(wwp + o_ + 4); wq[buf][2] = *(const u32x4*)(wwp + o_ + 8); wq[buf][3] = *(const u32x4*)(wwp + o_ + 12); } while (0)
#define S9_LOAD_ROWS4(buf, ibuf, gg) do { _Pragma("unroll") for (int ii_ = 0; ii_ < 4; ++ii_) { \
      const unsigned off_ = (unsigned)idx16(ei[ibuf][0], ei[ibuf][1], 4 * (gg) + ii_) * 128u + (unsigned)c * 16u; \
      rows[buf][4 * (gg) + ii_] = *(const u32x4*)(TBL + off_); } } while (0)
  S9_LOAD_IDX(0, 0); S9_LOAD_IDX(1, 1);
  S9_LOAD_ROWS4(0, 0, 0); S9_LOAD_ROWS4(0, 0, 1); S9_LOAD_ROWS4(0, 0, 2); S9_LOAD_ROWS4(0, 0, 3);
#pragma unroll
  for (int k = 0; k < PEER_NT; ++k) {
    const int t = tb + k;
    u32x4 wcur[4];
#pragma unroll
    for (int q = 0; q < 4; ++q) wcur[q] = wq[k & 1][q];
    if (k + 2 < PEER_NT) S9_LOAD_IDX(k & 1, k + 2);
    const size_t o = (size_t)t * DM + x * 256 + 32 * c + 16 * je + 4 * g;
    const u32x2 xr = *(const u32x2*)(x1 + o);
    f32x4 acc[2][2];
#pragma unroll
    for (int a = 0; a < 2; ++a)
#pragma unroll
      for (int b = 0; b < 2; ++b) acc[a][b] = (f32x4){0.f, 0.f, 0.f, 0.f};
#pragma unroll
    for (int n = 0; n < 16; ++n) {
      if ((n & 3) == 0) { __builtin_amdgcn_sched_barrier(0); if (k + 1 < PEER_NT) S9_LOAD_ROWS4((k + 1) & 1, (k + 1) & 1, n >> 2); __builtin_amdgcn_sched_barrier(0); }
      const unsigned word = wcur[n >> 2][n & 3];
      const unsigned sm = __builtin_amdgcn_perm(word, word, 0x03030303u);
      v8i_t B;
      B[0] = (int)(rows[k & 1][n][0] ^ sm); B[1] = (int)(rows[k & 1][n][1] ^ sm); B[2] = (int)(rows[k & 1][n][2] ^ sm); B[3] = (int)(rows[k & 1][n][3] ^ sm);
      B[4] = 0; B[5] = 0; B[6] = 0; B[7] = 0;
      acc[0][0] = __builtin_amdgcn_mfma_scale_f32_16x16x128_f8f6f4(A0, B, acc[0][0], 4, 4, 0, 0x7F7F7F7F, 0, (int)word);
      acc[1][0] = __builtin_amdgcn_mfma_scale_f32_16x16x128_f8f6f4(A1, B, acc[1][0], 4, 4, 0, 0x7F7F7F7F, 0, (int)word);
      acc[0][1] = __builtin_amdgcn_mfma_scale_f32_16x16x128_f8f6f4(A0h, B, acc[0][1], 4, 4, 0, 0x7F7F7F7F, 1, (int)word);
      acc[1][1] = __builtin_amdgcn_mfma_scale_f32_16x16x128_f8f6f4(A1h, B, acc[1][1], 4, 4, 0, 0x7F7F7F7F, 1, (int)word);
    }
    const f32x4 tot0 = acc[0][0] + acc[0][1], tot1 = acc[1][0] + acc[1][1];
    f32x4 res;
#pragma unroll
    for (int q = 0; q < 4; ++q) {
      const float keep = je ? tot1[q] : tot0[q], send = je ? tot0[q] : tot1[q];
      const float xq = (q & 1) ? __uint_as_float(xr[q >> 1] & 0xffff0000u) : __uint_as_float(xr[q >> 1] << 16);
      res[q] = xq + keep + dpp_f<0x128>(send);
    }
    *(f32x4*)(p.out + o) = res;
  }
#undef S9_LOAD_IDX
#undef S9_LOAD_ROWS4
}

template <int WHICH>
DI void phase_peer_sliced(const Params& p, unsigned char* lds) {
  const int tid = threadIdx.x, lane = tid & 63, w = tid >> 6;
  const unsigned* rankctr = (const unsigned*)(p.ws + WS_MISC + MISC_QCTR) + 16;
  volatile PG8_LAS unsigned* st = (volatile PG8_LAS unsigned*)(lds + LDS_BARST);
  int myx = (int)st[9], myr = (int)st[8];
  int n[8]; int tot = 0;
#pragma unroll
  for (int j = 0; j < 8; ++j) { n[j] = (int)__hip_atomic_load(rankctr + j, __ATOMIC_RELAXED, __HIP_MEMORY_SCOPE_AGENT); tot += n[j]; }
  if (tot != (int)gridDim.x || st[10] != 1u) {
    myx = blockIdx.x & 7; myr = blockIdx.x >> 3;
#pragma unroll
    for (int j = 0; j < 8; ++j) n[j] = ((int)gridDim.x + 7 - j) >> 3;
  }
#pragma unroll 1
  for (int s = 0; s < 8; ++s) {
    int owner = s;
#pragma unroll
    for (int d = 0; d < 8; ++d) { if (n[owner & 7] == 0) owner = (owner + 1) & 7; }
    owner &= 7;
    if (owner != myx) continue;
    int nblk = 0;
#pragma unroll
    for (int j = 0; j < 8; ++j) nblk = (j == myx) ? n[j] : nblk;
    const int nw = nblk * 8, wr = myr * 8 + w;
    constexpr int NU = T_TOK / 2 / PEER_NT;
    const int u0 = (int)(((long long)wr * NU) / nw) + (s >> 2) * NU, u1 = (int)(((long long)(wr + 1) * NU) / nw) + (s >> 2) * NU;
#pragma unroll 1
    for (int u = u0; u < u1; ++u) {
      if (WHICH == 0) peer_wave_tokens<0>(p, s & 3, u * PEER_NT, lane);
      else peer_wave_tokens_s9(p, s & 3, u * PEER_NT, lane);
    }
  }
}

#define XB_TMO      128
#define XB_XCNT(j)  (256  + 64 * (j))
#define XB_XSUB(j)  (1280 + 64 * (j))
#define XB_XGEN(j)  (2304 + 64 * (j))
#define XB_TOP      3328
#define XB_TOPGEN   3392
#define XCD_BAR_WORDS 3456
#define XB_SPIN_CAP (1u << 18)
#define LAS __attribute__((address_space(3)))

__device__ __forceinline__ unsigned xb_ld(unsigned* p)              { return __hip_atomic_load(p, __ATOMIC_RELAXED, __HIP_MEMORY_SCOPE_AGENT); }
__device__ __forceinline__ unsigned xb_add(unsigned* p, unsigned v) { return __hip_atomic_fetch_add(p, v, __ATOMIC_RELAXED, __HIP_MEMORY_SCOPE_AGENT); }
__device__ __forceinline__ unsigned xb_xcc_id() { return (unsigned)__builtin_amdgcn_s_getreg((3 << 11) | 20) & 0xFu; }
#define XB_SPIN(cond, bar) do { unsigned _sp = 0; while (cond) { __builtin_amdgcn_s_sleep(1); \
    if ((++_sp & 255u) == 0u) { if (xb_ld(&(bar)[XB_TMO])) break; if (_sp > XB_SPIN_CAP) { atomicAdd(&(bar)[XB_TMO], 1u); break; } } } } while (0)

struct XcdBarrier {
    unsigned* bar; unsigned x;
    volatile LAS unsigned* st;
};

__device__ __forceinline__ XcdBarrier xcd_barrier_post(unsigned* bar, volatile LAS unsigned* st) {
    XcdBarrier b; b.bar = bar; b.x = xb_xcc_id(); b.st = st;
    if (threadIdx.x == 0) (void)xb_add(&bar[XB_XCNT(b.x)], 1u);
    return b;
}
__device__ __forceinline__ void xcd_barrier_complete(unsigned* bar, unsigned x, unsigned& nloc, unsigned& nx) {
    const unsigned G = gridDim.x * gridDim.y * gridDim.z;
    unsigned sum, cnt, mine, sp = 0u;
    for (;;) {
        sum = 0u; cnt = 0u; mine = 0u;
#pragma unroll
        for (unsigned j = 0; j < 16; ++j) { const unsigned c = xb_ld(&bar[XB_XCNT(j)]); sum += c; cnt += (c > 0u) ? 1u : 0u; mine = (j == x) ? c : mine; }
        if (sum == G) break;
        __builtin_amdgcn_s_sleep(1);
        if ((++sp & 255u) == 0u) { if (xb_ld(&bar[XB_TMO])) break; if (sp > XB_SPIN_CAP) { atomicAdd(&bar[XB_TMO], 1u); break; } }
    }
    nloc = mine > 0u ? mine : 1u; nx = cnt > 0u ? cnt : 1u;
}

__device__ __forceinline__ void xcd_barrier(const XcdBarrier& b) {
    asm volatile("s_waitcnt vmcnt(0)" ::: "memory");
    __syncthreads();
    if (threadIdx.x == 0) {
        unsigned* bar = b.bar;
        __builtin_amdgcn_s_waitcnt(0);
        unsigned nloc = b.st[0], nx = b.st[1];
        if (nloc == 0u) { xcd_barrier_complete(bar, b.x, nloc, nx); b.st[0] = nloc; b.st[1] = nx; }
        const unsigned old = xb_add(&bar[XB_XSUB(b.x)], 1u);
        const unsigned gen = old / nloc;
        if (old + 1u == (gen + 1u) * nloc) {
            __builtin_amdgcn_fence(__ATOMIC_RELEASE, "agent");
            asm volatile("s_waitcnt vmcnt(0)" ::: "memory");
            const unsigned og = xb_add(&bar[XB_TOP], 1u);
            const unsigned tg = og / nx;
            if (og + 1u == (tg + 1u) * nx) xb_add(&bar[XB_TOPGEN], 1u);
            else XB_SPIN(xb_ld(&bar[XB_TOPGEN]) == tg, bar);
            __builtin_amdgcn_fence(__ATOMIC_ACQUIRE, "agent");
            xb_add(&bar[XB_XGEN(b.x)], 1u);
            asm volatile("s_waitcnt vmcnt(0)" ::: "memory");
        } else {
            XB_SPIN(xb_ld(&bar[XB_XGEN(b.x)]) == gen, bar);
            __builtin_amdgcn_fence(__ATOMIC_ACQUIRE, "agent");
            asm volatile("s_waitcnt vmcnt(0)" ::: "memory");
        }
    }
    __syncthreads();
}


__global__ void __launch_bounds__(NTHR, 2) fwd_kernel(Params p) {
  extern __shared__ __attribute__((aligned(16))) unsigned char lds[];
  cg::grid_group grid = cg::this_grid();
#ifndef ONLY_PH
#define PHON(k) 1
#else
#define PHON(k) ((k) == ONLY_PH)
#endif
#ifndef REPEAT_MASK
#define REPEAT_MASK 0
#endif
#define GSYNC(k) do { if ((k) == 0) { grid.sync(); xbar = xcd_barrier_post((unsigned*)(p.ws + WS_MISC + MISC_BAR), (volatile LAS unsigned*)(lds + LDS_BARST)); \
    if (threadIdx.x == 0) { volatile LAS unsigned* st_ = (volatile LAS unsigned*)(lds + LDS_BARST); const unsigned x_ = xcc_id(); \
      st_[8] = atomicAdd((unsigned*)(p.ws + WS_MISC + MISC_QCTR) + 16 + x_, 1u); st_[9] = x_; st_[10] = 1u; } \
    __syncthreads(); } else xcd_barrier(xbar); } while (0)
#define RUN_PHASE(k, call) do { if (PHON(k) && lo <= (k) && (k) < hi) { call; if ((REPEAT_MASK >> (k)) & 1) { grid.sync(); call; } } if (lo <= (k) && (k) + 1 < hi) GSYNC(k); } while (0)
  const int lo = p.ph_lo, hi = p.ph_hi;
  if (threadIdx.x < 16) ((volatile LAS unsigned*)(lds + LDS_BARST))[threadIdx.x] = 0u;
  __syncthreads();
  XcdBarrier xbar; xbar.bar = (unsigned*)(p.ws + WS_MISC + MISC_BAR); xbar.x = 0; xbar.st = (volatile LAS unsigned*)(lds + LDS_BARST);
  RUN_PHASE(0, phase_prep(p, lds));
  RUN_PHASE(1, phase_proj(p, lds));
  RUN_PHASE(2, phase_attn(p, lds));
  RUN_PHASE(3, phase_outproj(p, lds));
  RUN_PHASE(4, phase_norm2(p));
  RUN_PHASE(5, phase_peer_query(p, lds));
  RUN_PHASE(6, phase_peer_route(p, lds));
  RUN_PHASE(7, phase_peer_sliced<0>(p, lds));
#ifndef PROBE_PEER
#define PROBE_PEER 0
#endif
  if (PROBE_PEER & 1) { xcd_barrier(xbar); phase_peer_sliced<0>(p, lds); xcd_barrier(xbar); }
  RUN_PHASE(8, phase_peer_act(p));
  RUN_PHASE(9, phase_peer_sliced<1>(p, lds));
  if (PROBE_PEER & 2) { xcd_barrier(xbar); phase_peer_sliced<1>(p, lds); }
}

extern "C" void kernel_launch(void* const* d_in, const int* in_sizes, int n_in, void* d_out, int out_size, void* d_ws, size_t ws_size, hipStream_t stream) {
  static int grid_blocks = 0;
  if (grid_blocks == 0) {
    if (n_in != 20 || ws_size < WS_END || out_size != T_TOK * DM) {
      fprintf(stderr, "kernel_launch: unexpected problem shape (n_in %d, ws %zu, out %d)\n", n_in, ws_size, out_size);
      grid_blocks = -1; return;
    }
    int dev = 0, cus = 0, per_cu = 0;
    hipGetDevice(&dev);
    hipDeviceGetAttribute(&cus, hipDeviceAttributeMultiprocessorCount, dev);
    hipFuncSetAttribute((const void*)fwd_kernel, hipFuncAttributeMaxDynamicSharedMemorySize, LDS_BYTES);
    hipOccupancyMaxActiveBlocksPerMultiprocessor(&per_cu, (const void*)fwd_kernel, NTHR, LDS_BYTES);
    if (per_cu < 1) { fprintf(stderr, "kernel_launch: occupancy query says %d blocks/CU\n", per_cu); per_cu = 1; }
    grid_blocks = cus;
    (void)hipGetLastError();
  }
  if (grid_blocks < 0) return;
  Params p{};
  p.x_prompt = (const float*)d_in[0]; p.x_sample = (const float*)d_in[1]; p.rel_bias = (const float*)d_in[2]; p.attn_norm_g = (const float*)d_in[3];
  p.w_in = (const float*)d_in[4]; p.q_norm_a = (const float*)d_in[5]; p.k_norm_a = (const float*)d_in[6]; p.q_norm_b = (const float*)d_in[7];
  p.k_norm_b = (const float*)d_in[8]; p.lq1 = (const float*)d_in[9]; p.lk1 = (const float*)d_in[10]; p.lq2 = (const float*)d_in[11];
  p.lk2 = (const float*)d_in[12]; p.diff_norm_g = (const float*)d_in[13]; p.w_out = (const float*)d_in[14]; p.ffn_norm_g = (const float*)d_in[15];
  p.peer_w_q = (const float*)d_in[16]; p.peer_sub_keys = (const float*)d_in[17]; p.peer_u = (const float*)d_in[18]; p.peer_v = (const float*)d_in[19];
  p.out = (float*)d_out; p.ws = (unsigned char*)d_ws;
#if FUSED
  p.ph_lo = 0; p.ph_hi = NPHASE;
  void* args[] = {&p};
  hipError_t e = hipLaunchCooperativeKernel((const void*)fwd_kernel, dim3(grid_blocks), dim3(NTHR), args, LDS_BYTES, stream);
  if (e != hipSuccess) fprintf(stderr, "cooperative launch failed: %s (grid %d)\n", hipGetErrorString(e), grid_blocks);
#else
  for (int ph = 0; ph < NPHASE; ++ph) {
    p.ph_lo = ph; p.ph_hi = ph + 1;
    hipLaunchKernelGGL(fwd_kernel, dim3(grid_blocks), dim3(NTHR), LDS_BYTES, stream, p);
  }
#endif
}
```

```cpp
#include <hip/hip_runtime.h>
#include <hip/hip_cooperative_groups.h>
#include <cstdio>
#include <cstdint>
namespace cg = cooperative_groups;

#ifndef FUSED
#define FUSED 1
#endif

typedef unsigned short u16;
typedef __attribute__((ext_vector_type(8))) short bf16x8;
typedef __attribute__((ext_vector_type(4))) short s16x4;
typedef __attribute__((ext_vector_type(16))) float f32x16;
typedef __attribute__((ext_vector_type(4))) float f32x4;
typedef __attribute__((ext_vector_type(4))) unsigned u32x4;
typedef __attribute__((ext_vector_type(2))) unsigned u32x2;
typedef __attribute__((address_space(3))) unsigned char* ldsp_t;

#define DI __device__ __forceinline__
#define MFMA32(a, b, c) __builtin_amdgcn_mfma_f32_32x32x16_bf16((a), (b), (c), 0, 0, 0)

constexpr int DM = 1024;
constexpr int T_TOK = 65536;
constexpr int T_PROMPT = 32768;
constexpr int NTHR = 512;
constexpr int NPHASE = 10;
constexpr float NORM_EPS = 1e-6f;
constexpr float LOG2E = 1.4426950408889634f;
constexpr float C2 = 0.125f * LOG2E;
constexpr float NEG_BIG = -1.0e30f;

constexpr size_t WS_WIN  = 0;
constexpr size_t WS_WOUT = WS_WIN + (size_t)3072 * 1024 * 2;
constexpr size_t WS_WQ   = WS_WOUT + (size_t)1024 * 1024 * 2;
constexpr size_t WS_SK   = WS_WQ + (size_t)2048 * 1024 * 2;
constexpr size_t WS_U    = WS_SK + (size_t)2 * 128 * 128 * 2;
constexpr size_t WS_V    = WS_U + (size_t)16384 * 1024 * 2;
constexpr size_t WS_W16  = WS_V + (size_t)16384 * 1024;
constexpr size_t WS_MISC = WS_V + (size_t)16384 * 1024 * 2;
constexpr size_t MISC_SUINV = 0, MISC_SVINV = 65536, MISC_QCTR = 131072, MISC_BAR = 196608, MISC_HAMAX = 524288, MISC_R2 = 786432;
constexpr size_t WS_R    = WS_MISC + (size_t)1048576;
constexpr size_t R_REGION = (size_t)T_TOK * 512 * 2;
constexpr size_t WS_X1   = WS_R;
constexpr size_t WS_ZP   = WS_R + (size_t)T_TOK * 1024 * 2;
constexpr size_t WS_H    = WS_R + (size_t)T_TOK * 1024 * 4;
constexpr size_t WS_EIDX = WS_R + 6 * R_REGION;
constexpr size_t WS_G    = WS_EIDX + (size_t)T_TOK * 128 * 2;
constexpr size_t WS_END  = WS_G + (size_t)T_TOK * 128 * 4;
static_assert(WS_END <= (size_t)536870912, "workspace map exceeds 512 MiB");
constexpr size_t OUT_N1 = 0, OUT_MIX = 134217728, OUT_TV = 0, OUT_TI = 67108864;

constexpr int LDS_BYTES = 163840;
constexpr int LDS_BARST = 163840 - 256;

struct Params {
  const float* x_prompt; const float* x_sample; const float* rel_bias; const float* attn_norm_g; const float* w_in;
  const float* q_norm_a; const float* k_norm_a; const float* q_norm_b; const float* k_norm_b;
  const float* lq1; const float* lk1; const float* lq2; const float* lk2; const float* diff_norm_g; const float* w_out;
  const float* ffn_norm_g; const float* peer_w_q; const float* peer_sub_keys; const float* peer_u; const float* peer_v;
  float* out; unsigned char* ws; int ph_lo; int ph_hi;
};

DI u16 f2bf(float f) { unsigned u = __float_as_uint(f); u += 0x7fffu + ((u >> 16) & 1u); return (u16)(u >> 16); }
DI float bf2f(u16 b) { return __uint_as_float(((unsigned)b) << 16); }
DI unsigned pk2(float lo, float hi) {
  typedef float f2_t __attribute__((ext_vector_type(2)));
  typedef __bf16 b2_t __attribute__((ext_vector_type(2)));
  f2_t v = {lo, hi}; b2_t b = __builtin_convertvector(v, b2_t); return __builtin_bit_cast(unsigned, b);
}
DI int crow(int reg, int h) { return (reg & 3) + 8 * (reg >> 2) + 4 * h; }
DI float wave_sum(float v) {
#pragma unroll
  for (int o = 32; o > 0; o >>= 1) v += __shfl_xor(v, o);
  return v;
}
DI void seq_of(int t, int& seq_start, int& S, int& s) {
  if (t < T_PROMPT) { S = 4096; seq_start = t & ~4095; s = t & 4095; }
  else { S = 2048; seq_start = t & ~2047; s = t & 2047; }
}
DI const float* x_row(const Params& p, int t) {
  return (t < T_PROMPT) ? p.x_prompt + (size_t)t * DM : p.x_sample + (size_t)(t - T_PROMPT) * DM;
}
DI int rel_bucket(int rel) {
  int n = rel < 0 ? -rel : rel;
  int b;
  if (n < 8) b = n;
  else if (n < 15) b = 8; else if (n < 27) b = 9; else if (n < 50) b = 10; else if (n < 91) b = 11;
  else if (n < 166) b = 12; else if (n < 305) b = 13; else if (n < 559) b = 14; else b = 15;
  return (rel > 0 ? 16 : 0) + b;
}
DI s16x4 tr_read(const unsigned char* p) {
  typedef short v4i16_t __attribute__((ext_vector_type(4)));
  return __builtin_bit_cast(s16x4, __builtin_amdgcn_ds_read_tr16_b64_v4i16((__attribute__((address_space(3))) v4i16_t*)p));
}
DI bf16x8 cat8(s16x4 lo, s16x4 hi) { return __builtin_shufflevector(lo, hi, 0, 1, 2, 3, 4, 5, 6, 7); }

DI void transpose_item(const float* __restrict__ src, int K, int N, u16* __restrict__ dst, int k0, int n0, unsigned char* lds, const float* __restrict__ gk = nullptr) {
  float* tile = (float*)lds;
  const int tid = threadIdx.x;
#pragma unroll
  for (int i = 0; i < 8; ++i) {
    int idx = tid + 512 * i; int r = idx >> 6, c = idx & 63;
    tile[r * 65 + c] = src[(size_t)(k0 + r) * N + n0 + c] * (gk ? gk[k0 + r] : 1.0f);
  }
  __syncthreads();
  {
    int n = tid >> 3, kc = tid & 7;
    u32x4 o;
    o[0] = pk2(tile[(kc * 8 + 0) * 65 + n], tile[(kc * 8 + 1) * 65 + n]);
    o[1] = pk2(tile[(kc * 8 + 2) * 65 + n], tile[(kc * 8 + 3) * 65 + n]);
    o[2] = pk2(tile[(kc * 8 + 4) * 65 + n], tile[(kc * 8 + 5) * 65 + n]);
    o[3] = pk2(tile[(kc * 8 + 6) * 65 + n], tile[(kc * 8 + 7) * 65 + n]);
    *(u32x4*)(dst + (size_t)(n0 + n) * K + k0 + kc * 8) = o;
  }
  __syncthreads();
}

DI void convert_item(const float* __restrict__ src, u16* __restrict__ dst, size_t base) {
  size_t i = base + (size_t)threadIdx.x * 8;
  f32x4 a = *(const f32x4*)(src + i), b = *(const f32x4*)(src + i + 4);
  u32x4 o; o[0] = pk2(a[0], a[1]); o[1] = pk2(a[2], a[3]); o[2] = pk2(b[0], b[1]); o[3] = pk2(b[2], b[3]);
  *(u32x4*)(dst + i) = o;
}

template <bool BF16IN>
DI void norm_load(const void* __restrict__ xr_, int lane, f32x4 (&v)[4]) {
#pragma unroll
  for (int i = 0; i < 4; ++i) {
    if (BF16IN) { const u32x2 r_ = *(const u32x2*)((const u16*)xr_ + lane * 4 + 256 * i); v[i][0] = __uint_as_float(r_[0] << 16); v[i][1] = __uint_as_float(r_[0] & 0xffff0000u); v[i][2] = __uint_as_float(r_[1] << 16); v[i][3] = __uint_as_float(r_[1] & 0xffff0000u); }
    else v[i] = *(const f32x4*)((const float*)xr_ + lane * 4 + 256 * i);
  }
}
DI void norm_finish(const f32x4 (&v)[4], const float* __restrict__ g, u16* __restrict__ orow, int lane, float* amax_out) {
  float ss = 0.f, am = 0.f;
#pragma unroll
  for (int i = 0; i < 4; ++i) ss += v[i][0] * v[i][0] + v[i][1] * v[i][1] + v[i][2] * v[i][2] + v[i][3] * v[i][3];
  ss = wave_sum(ss);
  const float r = __builtin_amdgcn_rsqf(ss * (1.0f / 1024.0f) + NORM_EPS);
#pragma unroll
  for (int i = 0; i < 4; ++i) {
    f32x4 gg = *(const f32x4*)(g + lane * 4 + 256 * i);
    u32x2 o; o[0] = pk2(v[i][0] * r * gg[0], v[i][1] * r * gg[1]); o[1] = pk2(v[i][2] * r * gg[2], v[i][3] * r * gg[3]);
    *(u32x2*)(orow + lane * 4 + 256 * i) = o;
    if (amax_out) {
      am = fmaxf(am, fmaxf(fmaxf(fabsf(__uint_as_float(o[0] << 16)), fabsf(__uint_as_float(o[0] & 0xffff0000u))), fmaxf(fabsf(__uint_as_float(o[1] << 16)), fabsf(__uint_as_float(o[1] & 0xffff0000u)))));
    }
  }
  if (amax_out) {
#pragma unroll
    for (int o = 32; o > 0; o >>= 1) am = fmaxf(am, __shfl_xor(am, o));
    if (lane == 0) *amax_out = am;
  }
}
template <bool BF16IN = false>
DI void norm_row(const void* __restrict__ xr_, const float* __restrict__ g, u16* __restrict__ orow, int lane, float* amax_out = nullptr) {
  f32x4 v[4]; norm_load<BF16IN>(xr_, lane, v); norm_finish(v, g, orow, lane, amax_out);
}
template <bool BF16IN>
DI void norm_row2(const void* xa, const void* xb, const float* __restrict__ g, u16* oa, u16* ob, int lane, float* ama, float* amb) {
  f32x4 va[4], vb[4]; norm_load<BF16IN>(xa, lane, va); norm_load<BF16IN>(xb, lane, vb);
  norm_finish(va, g, oa, lane, ama); norm_finish(vb, g, ob, lane, amb);
}

DI void convert_row(const Params& p, int row, int lane_, const f32x4& a0, const f32x4& a1, const f32x4& a2, const f32x4& a3) {
      const int tbl = row >> 14, e = row & 16383;
      float am = 0.f;
#pragma unroll
      for (int j = 0; j < 4; ++j) am = fmaxf(am, fmaxf(fmaxf(fabsf(a0[j]), fabsf(a1[j])), fmaxf(fabsf(a2[j]), fabsf(a3[j]))));
#pragma unroll
      for (int o = 32; o > 0; o >>= 1) am = fmaxf(am, __shfl_xor(am, o));
      float isc; u32x2 o;
      if (tbl == 0) {
        const float sc = (am > 0.f) ? 7.0f / am : 0.f; isc = am * (1.0f / 7.0f);
#define Q4(x_) ((unsigned)((int)__builtin_rintf((x_) * sc)) & 15u)
        o[0] = Q4(a0[0]) | (Q4(a0[1]) << 8) | (Q4(a0[2]) << 16) | (Q4(a0[3]) << 24) | (Q4(a1[0]) << 4) | (Q4(a1[1]) << 12) | (Q4(a1[2]) << 20) | (Q4(a1[3]) << 28);
        o[1] = Q4(a2[0]) | (Q4(a2[1]) << 8) | (Q4(a2[2]) << 16) | (Q4(a2[3]) << 24) | (Q4(a3[0]) << 4) | (Q4(a3[1]) << 12) | (Q4(a3[2]) << 20) | (Q4(a3[3]) << 28);
#undef Q4
      } else {
        const float sc = (am > 0.f) ? 6.0f / am : 0.f; isc = am * (1.0f / 6.0f);
        unsigned pk = 0u;
        pk = __builtin_amdgcn_cvt_scalef32_pk_fp4_f32(pk, a0[0] * sc, a0[1] * sc, 1.0f, 0);
        pk = __builtin_amdgcn_cvt_scalef32_pk_fp4_f32(pk, a0[2] * sc, a0[3] * sc, 1.0f, 1);
        pk = __builtin_amdgcn_cvt_scalef32_pk_fp4_f32(pk, a1[0] * sc, a1[1] * sc, 1.0f, 2);
        pk = __builtin_amdgcn_cvt_scalef32_pk_fp4_f32(pk, a1[2] * sc, a1[3] * sc, 1.0f, 3);
        o[0] = pk; pk = 0u;
        pk = __builtin_amdgcn_cvt_scalef32_pk_fp4_f32(pk, a2[0] * sc, a2[1] * sc, 1.0f, 0);
        pk = __builtin_amdgcn_cvt_scalef32_pk_fp4_f32(pk, a2[2] * sc, a2[3] * sc, 1.0f, 1);
        pk = __builtin_amdgcn_cvt_scalef32_pk_fp4_f32(pk, a3[0] * sc, a3[1] * sc, 1.0f, 2);
        pk = __builtin_amdgcn_cvt_scalef32_pk_fp4_f32(pk, a3[2] * sc, a3[3] * sc, 1.0f, 3);
        o[1] = pk;
      }
      unsigned char* dst = p.ws + (tbl ? WS_V : WS_U) + ((size_t)(lane_ >> 4) * 16384 + e) * 128 + (lane_ & 15) * 8;
      *(u32x2*)dst = o;
      if (lane_ == 0) ((float*)(p.ws + WS_MISC + (tbl ? MISC_SVINV : MISC_SUINV)))[e] = isc;
}
DI void convert_tables(const Params& p) {
  const int nb = gridDim.x, bid = blockIdx.x, tid = threadIdx.x;
  const int lane_ = tid & 63, w_ = tid >> 6;
  for (int it = bid; it < 2 * 16384 / 16; it += nb) {
    const int rowa = it * 16 + w_, rowb = rowa + 8;
    const float* sa = ((rowa >> 14) ? p.peer_v : p.peer_u) + (size_t)(rowa & 16383) * DM + lane_ * 16;
    const float* sb = ((rowb >> 14) ? p.peer_v : p.peer_u) + (size_t)(rowb & 16383) * DM + lane_ * 16;
    const f32x4 a0 = *(const f32x4*)(sa), a1 = *(const f32x4*)(sa + 4), a2 = *(const f32x4*)(sa + 8), a3 = *(const f32x4*)(sa + 12);
    const f32x4 b0 = *(const f32x4*)(sb), b1 = *(const f32x4*)(sb + 4), b2 = *(const f32x4*)(sb + 8), b3 = *(const f32x4*)(sb + 12);
    convert_row(p, rowa, lane_, a0, a1, a2, a3);
    convert_row(p, rowb, lane_, b0, b1, b2, b3);
  }
}

DI void phase_prep(const Params& p, unsigned char* lds) {
  const int nb = gridDim.x, bid = blockIdx.x, tid = threadIdx.x;
  u16* wsb = (u16*)p.ws;
  for (int it = bid; it < 768 + 256 + 512; it += nb) {
    if (it < 768) { int kt = it / 48, nt = it % 48; transpose_item(p.w_in, 1024, 3072, (u16*)(p.ws + WS_WIN), kt * 64, nt * 64, lds); }
    else if (it < 1024) { int j = it - 768; int kt = j / 16, nt = j % 16; transpose_item(p.w_out, 1024, 1024, (u16*)(p.ws + WS_WOUT), kt * 64, nt * 64, lds); }
    else { int j = it - 1024; int kt = j / 32, nt = j % 32; transpose_item(p.peer_w_q, 1024, 2048, (u16*)(p.ws + WS_WQ), kt * 64, nt * 64, lds, p.ffn_norm_g); }
  }
  for (int it = bid; it < 8; it += nb) convert_item(p.peer_sub_keys, (u16*)(p.ws + WS_SK), (size_t)it * 4096);
  if (bid == 0 && tid < 64) ((unsigned*)(p.ws + WS_MISC + MISC_QCTR))[tid] = 0u;
  if (bid == 0) for (int i = tid; i < 3456; i += NTHR) ((unsigned*)(p.ws + WS_MISC + MISC_BAR))[i] = 0u;
  convert_tables(p);
  const int lane = tid & 63, w = tid >> 6;
  u16* n1 = (u16*)((unsigned char*)p.out + OUT_N1);
  for (int it = bid; it < T_TOK / 16; it += nb) {
    const int t = it * 16 + w, t2 = t + 8;
    norm_row2<false>(x_row(p, t), x_row(p, t2), p.attn_norm_g, n1 + (size_t)t * DM, n1 + (size_t)t2 * DM, lane, nullptr, nullptr);
  }
  (void)wsb;
}

template <int PR, int QR>
DI void gemm_mainloop(const u16* __restrict__ P, const u16* __restrict__ Q, int K, int p0, int q0, unsigned char* lds, f32x16 (&acc)[2][2]) {
  static_assert(PR + QR == 384, "tile");
  constexpr int STAGE = 384 * 128;
  constexpr int WC = QR / 64;
  const int tid = threadIdx.x, lane = tid & 63, r32 = lane & 31, h = lane >> 5;
  const int w = __builtin_amdgcn_readfirstlane(tid >> 6);
  const int wr = w / WC, wc = w % WC;
#pragma unroll
  for (int i = 0; i < 2; ++i)
#pragma unroll
    for (int j = 0; j < 2; ++j)
#pragma unroll
      for (int r = 0; r < 16; ++r) acc[i][j][r] = 0.f;
  u32x4 stg[6];
  const u16* src[6]; int loff[6];
#pragma unroll
  for (int i = 0; i < 6; ++i) {
    int c = tid + 512 * i; int row = c >> 3, kc = c & 7;
    src[i] = (row < PR) ? P + (size_t)(p0 + row) * K + kc * 8 : Q + (size_t)(q0 + row - PR) * K + kc * 8;
    loff[i] = row * 128 + ((kc ^ ((row >> 1) & 7)) << 4);
  }
  const int KT = K / 64;
#pragma unroll
  for (int i = 0; i < 6; ++i) stg[i] = *(const u32x4*)(src[i]);
#pragma unroll
  for (int i = 0; i < 6; ++i) *(u32x4*)(lds + loff[i]) = stg[i];
  __syncthreads();
  int aoff[2], boff[2], asw[2], bsw[2];
#pragma unroll
  for (int i = 0; i < 2; ++i) {
    int ra = wr * 64 + i * 32 + r32; aoff[i] = ra * 128; asw[i] = (ra >> 1) & 7;
    int rb = PR + wc * 64 + i * 32 + r32; boff[i] = rb * 128; bsw[i] = (rb >> 1) & 7;
  }
  for (int kt = 0; kt < KT; ++kt) {
    const int buf = (kt & 1) * STAGE;
    if (kt + 1 < KT) {
#pragma unroll
      for (int i = 0; i < 6; ++i) stg[i] = *(const u32x4*)(src[i] + (kt + 1) * 64);
    }
#pragma unroll
    for (int ks = 0; ks < 4; ++ks) {
      bf16x8 a[2], b[2];
#pragma unroll
      for (int i = 0; i < 2; ++i) {
        a[i] = *(const bf16x8*)(lds + buf + aoff[i] + (((2 * ks + h) ^ asw[i]) << 4));
        b[i] = *(const bf16x8*)(lds + buf + boff[i] + (((2 * ks + h) ^ bsw[i]) << 4));
      }
#pragma unroll
      for (int i = 0; i < 2; ++i)
#pragma unroll
        for (int j = 0; j < 2; ++j) acc[i][j] = MFMA32(a[i], b[j], acc[i][j]);
    }
    if (kt + 1 < KT) {
      const int nbuf = ((kt + 1) & 1) * STAGE;
#pragma unroll
      for (int i = 0; i < 6; ++i) *(u32x4*)(lds + nbuf + loff[i]) = stg[i];
    }
    __syncthreads();
  }
}

namespace pg8 {
#define PG8_LAS __attribute__((address_space(3)))
typedef unsigned short bf16_t;
typedef short bf16x8 __attribute__((ext_vector_type(8)));
typedef float f32x4 __attribute__((ext_vector_type(4)));
typedef unsigned u32x4 __attribute__((ext_vector_type(4)));
constexpr int BM = 256, BK = 64, HALF = 128, HTB = HALF * BK * 2  , STAGE_BYTES = 8 * HTB, NXCD = 8, WGM = 8;

__host__ __device__ __forceinline__ int lds_byte(int r, int c) { const int st = (r >> 4) * 2 + (c >> 5), rr = r & 15, cc = c & 31, ob = rr * 64 + cc * 2; return st * 1024 + (ob ^ (((ob >> 9) & 1) << 5)); }
__host__ __device__ __forceinline__ void stage_rc(int b, int& R, int& C) { const int st = b / 1024, sb = b % 1024, swz = sb ^ (((sb >> 9) & 1) << 5); R = (st >> 1) * 16 + swz / 64; C = (st & 1) * 32 + (swz % 64) / 2; }
__host__ __device__ __forceinline__ int perm32(int rho) { const int n = rho >> 4, i = rho & 15; return 8 * (i >> 2) + 4 * n + (i & 3); }

struct Unit { int pm, pn; };
struct Gemm { const bf16_t* A; const bf16_t* Bt; int M, N, K; };

struct StaticOrder {
    int nM, nN, nwg, G, c;
    __host__ __device__ void init(int M, int N, int G_, int c_) { nM = M / BM; nN = N / BM; nwg = nM * nN; G = G_; c = c_; }
    __host__ __device__ bool next(int i, Unit& u) const {
        const long L = (long)i * G + c; if (L >= nwg) return false;
        int wgid = (int)L; { const int q = nwg / NXCD, r = nwg % NXCD, xcd = wgid % NXCD, off = wgid / NXCD; wgid = (xcd < r ? xcd * (q + 1) : r * (q + 1) + (xcd - r) * q) + off; }
        const int nig = WGM * nN, gid = wgid / nig, fm = gid * WGM, gsz = (nM - fm) < WGM ? (nM - fm) : WGM;
        u.pm = fm + ((wgid % nig) % gsz); u.pn = (wgid % nig) / gsz; return true;
    }
    __device__ __forceinline__ void a_ready(const Unit&) const {}
    __device__ __forceinline__ void done(const Unit&) const {}
};


template <class Epi, class Sched, bool ALIGN_EPI = false, bool SP2 = false>
__device__ __forceinline__ void gemm_phase(PG8_LAS unsigned char* lds, const Gemm g, const Sched& S, const Epi& E) {
    const int tid = threadIdx.x, wid = __builtin_amdgcn_readfirstlane(tid >> 6), lane = tid & 63, wr = wid >> 2, wc = wid & 3, fr = lane & 15, fq = lane >> 4;
    const int K = g.K, nt = K / BK;
    unsigned voffA[2], voffB[2], voffB1[2];
#pragma unroll
    for (int i = 0; i < 2; ++i) { int R, C; stage_rc(tid * 16 + i * 8192, R, C); const int Rb = Epi::PERM ? ((R & ~31) + perm32(R & 31)) : R;
        voffA[i] = (unsigned)(R * K + C) * 2u;
        if (Epi::HEADPERM) { const int Rh = 64 * (R >> 5) + perm32(R & 31); voffB[i] = (unsigned)(Rh * K + C) * 2u; voffB1[i] = (unsigned)((Rh + 32) * K + C) * 2u; }
        else { voffB[i] = (unsigned)(Rb * K + C) * 2u; voffB1[i] = (unsigned)((Rb + HALF) * K + C) * 2u; } }
    const size_t kstep = (size_t)(BK * 2);
    const size_t hstep = (size_t)HALF * K * 2;
    const size_t tstep = 2 * hstep;
    const unsigned ldsw = (unsigned)wid * 1024u;
    const int aoff = lds_byte(wr * 64 + fr, fq * 8), boff = lds_byte(wc * 32 + fr, fq * 8);
#define PG8_SA(b, h) (((b) * 2 + (h)) * HTB)
#define PG8_SB(b, h) ((4 + (b) * 2 + (h)) * HTB)
#define PG8_STAGE(bufoff, gbase, voff) do { _Pragma("unroll") for (int _i = 0; _i < 2; ++_i) \
        __builtin_amdgcn_global_load_lds((const unsigned*)((const char*)(gbase) + (voff)[_i]), (PG8_LAS unsigned*)(lds + (bufoff) + ldsw + _i * 8192), 16, 0, 0); } while (0)
#define PG8_LDA(dst, b, h) do { _Pragma("unroll") for (int m = 0; m < 4; ++m) _Pragma("unroll") for (int k = 0; k < 2; ++k) dst[m][k] = *(const PG8_LAS bf16x8*)(lds + PG8_SA(b, h) + aoff + m * 2048 + k * 1024); } while (0)
#define PG8_LDB(dst, b, h) do { _Pragma("unroll") for (int n = 0; n < 2; ++n) _Pragma("unroll") for (int k = 0; k < 2; ++k) dst[n][k] = *(const PG8_LAS bf16x8*)(lds + PG8_SB(b, h) + boff + n * 2048 + k * 1024); } while (0)
#define PG8_MMA(ai, bj, At, Bt) do { __builtin_amdgcn_s_setprio(1); _Pragma("unroll") for (int m = 0; m < 4; ++m) _Pragma("unroll") for (int n = 0; n < 2; ++n) _Pragma("unroll") for (int k = 0; k < 2; ++k) \
        acc[ai][bj][m][n] = __builtin_amdgcn_mfma_f32_16x16x32_bf16(Bt[n][k], At[m][k], acc[ai][bj][m][n], 0, 0, 0); __builtin_amdgcn_s_setprio(0); } while (0)
#define PG8_WAIT_V(n) asm volatile("s_waitcnt vmcnt(" #n ")" ::: "memory")
#define PG8_WAIT_L(n) asm volatile("s_waitcnt lgkmcnt(" #n ")" ::: "memory")
#define PG8_BAR __builtin_amdgcn_s_barrier()
#define PG8_SCHED __builtin_amdgcn_sched_barrier(0)
    Unit cur, nxt; int ui = 0;
    if (!S.next(0, cur)) return;
    f32x4 acc[2][2][4][2];
#pragma unroll
    for (int a = 0; a < 2; ++a)
#pragma unroll
        for (int b = 0; b < 2; ++b)
#pragma unroll
            for (int m = 0; m < 4; ++m)
#pragma unroll
                for (int n = 0; n < 2; ++n) acc[a][b][m][n] = (f32x4){0.f, 0.f, 0.f, 0.f};
    bf16x8 At[4][2], B0[2][2], B1[2][2];
    const char* cA = (const char*)g.A + (size_t)cur.pm * tstep; const char* cB = (const char*)g.Bt + (size_t)cur.pn * tstep;
    S.a_ready(cur);
    if constexpr (SP2) {
        PG8_STAGE(PG8_SB(0, 0), cB, voffB); PG8_STAGE(PG8_SB(0, 1), cB, voffB1); PG8_STAGE(PG8_SA(0, 0), cA, voffA); PG8_STAGE(PG8_SA(0, 1), cA + hstep, voffA);
        if (wr == 1) PG8_BAR;
        PG8_WAIT_V(2); PG8_BAR;
        PG8_STAGE(PG8_SB(1, 0), cB + kstep, voffB); PG8_STAGE(PG8_SA(1, 0), cA + kstep, voffA); PG8_STAGE(PG8_SB(1, 1), cB + kstep, voffB1);
        PG8_WAIT_V(6); PG8_BAR;
    } else {
        PG8_STAGE(PG8_SB(0, 0), cB, voffB); PG8_STAGE(PG8_SA(0, 0), cA, voffA); PG8_STAGE(PG8_SB(0, 1), cB, voffB1); PG8_STAGE(PG8_SA(0, 1), cA + hstep, voffA);
        if (wr == 1) PG8_BAR;
        PG8_WAIT_V(4); PG8_BAR;
        PG8_STAGE(PG8_SB(1, 0), cB + kstep, voffB); PG8_STAGE(PG8_SA(1, 0), cA + kstep, voffA); PG8_STAGE(PG8_SB(1, 1), cB + kstep, voffB1);
        PG8_WAIT_V(6); PG8_BAR;
    }
    for (;;) {
        const bool has_next = S.next(ui + 1, nxt);
        const char* nA = has_next ? (const char*)g.A + (size_t)nxt.pm * tstep : cA; const char* nB = has_next ? (const char*)g.Bt + (size_t)nxt.pn * tstep : cB;
        for (int t = 0; t < nt; t += 2) {
            const bool last = (t == nt - 2);
            const char* a1 = cA + (size_t)(t + 1) * kstep;
            const char* a2 = last ? nA : cA + (size_t)(t + 2) * kstep; const char* b2 = last ? nB : cB + (size_t)(t + 2) * kstep;
            const char* a3 = a2 + kstep; const char* b3 = b2 + kstep;
            if (last && has_next) S.a_ready(nxt);
            if constexpr (SP2) {
            PG8_LDB(B0, 0, 0); PG8_LDB(B1, 0, 1); PG8_SCHED; PG8_LDA(At, 0, 0); PG8_STAGE(PG8_SA(1, 1), a1 + hstep, voffA);
            PG8_WAIT_V(8); PG8_WAIT_L(0); PG8_BAR; PG8_MMA(0, 0, At, B0); PG8_MMA(0, 1, At, B1); PG8_BAR; PG8_SCHED;
            PG8_LDA(At, 0, 1); PG8_STAGE(PG8_SB(0, 0), b2, voffB); PG8_STAGE(PG8_SB(0, 1), b2, voffB1); PG8_STAGE(PG8_SA(0, 0), a2, voffA);
            PG8_WAIT_V(8); PG8_WAIT_L(0); PG8_BAR; PG8_MMA(1, 0, At, B0); PG8_MMA(1, 1, At, B1); PG8_BAR; PG8_SCHED;
            PG8_LDB(B0, 1, 0); PG8_LDB(B1, 1, 1); PG8_SCHED; PG8_LDA(At, 1, 0); PG8_STAGE(PG8_SA(0, 1), a2 + hstep, voffA);
            PG8_WAIT_V(8); PG8_WAIT_L(0); PG8_BAR; PG8_MMA(0, 0, At, B0); PG8_MMA(0, 1, At, B1); PG8_BAR; PG8_SCHED;
            PG8_LDA(At, 1, 1); PG8_STAGE(PG8_SB(1, 0), b3, voffB); PG8_STAGE(PG8_SB(1, 1), b3, voffB1); PG8_STAGE(PG8_SA(1, 0), a3, voffA);
            PG8_WAIT_V(8); PG8_WAIT_L(0); PG8_BAR; PG8_MMA(1, 0, At, B0); PG8_MMA(1, 1, At, B1); PG8_BAR; PG8_SCHED;
            } else {
            PG8_LDB(B0, 0, 0); PG8_SCHED; PG8_LDA(At, 0, 0); PG8_STAGE(PG8_SA(1, 1), a1 + hstep, voffA);
            PG8_WAIT_L(8); PG8_BAR; PG8_WAIT_L(0); PG8_MMA(0, 0, At, B0); PG8_BAR; PG8_SCHED;
            PG8_LDB(B1, 0, 1); PG8_STAGE(PG8_SB(0, 0), b2, voffB);
            PG8_BAR; PG8_WAIT_L(0); PG8_MMA(0, 1, At, B1); PG8_BAR;
            PG8_LDA(At, 0, 1); PG8_STAGE(PG8_SA(0, 0), a2, voffA);
            PG8_BAR; PG8_WAIT_L(0); PG8_MMA(1, 0, At, B0); PG8_BAR; PG8_SCHED;
            PG8_STAGE(PG8_SB(0, 1), b2, voffB1);
            PG8_WAIT_V(6); PG8_BAR; PG8_MMA(1, 1, At, B1); PG8_BAR;
            PG8_LDB(B0, 1, 0); PG8_SCHED; PG8_LDA(At, 1, 0); PG8_STAGE(PG8_SA(0, 1), a2 + hstep, voffA);
            PG8_WAIT_L(8); PG8_BAR; PG8_WAIT_L(0); PG8_MMA(0, 0, At, B0); PG8_BAR; PG8_SCHED;
            PG8_LDB(B1, 1, 1); PG8_STAGE(PG8_SB(1, 0), b3, voffB);
            PG8_BAR; PG8_WAIT_L(0); PG8_MMA(0, 1, At, B1); PG8_BAR;
            PG8_LDA(At, 1, 1); PG8_STAGE(PG8_SA(1, 0), a3, voffA);
            PG8_BAR; PG8_WAIT_L(0); PG8_MMA(1, 0, At, B0); PG8_BAR; PG8_SCHED;
            PG8_STAGE(PG8_SB(1, 1), b3, voffB1);
            PG8_WAIT_V(6); PG8_BAR; PG8_MMA(1, 1, At, B1); PG8_BAR;
            }
        }
        if constexpr (ALIGN_EPI) { if (wr == 0) PG8_BAR; }
        if constexpr (!Epi::AFTER_DRAIN) { E(acc, cur, wr, wc, fr, fq); S.done(cur); }
        if (!has_next) break;
#pragma unroll
        for (int a = 0; a < 2; ++a)
#pragma unroll
            for (int b = 0; b < 2; ++b)
#pragma unroll
                for (int m = 0; m < 4; ++m)
#pragma unroll
                    for (int n = 0; n < 2; ++n) acc[a][b][m][n] = (f32x4){0.f, 0.f, 0.f, 0.f};
        cur = nxt; cA = nA; cB = nB; ++ui;
        if constexpr (ALIGN_EPI) { if (wr == 1) PG8_BAR; }
    }
    PG8_WAIT_V(0);
    if constexpr (!ALIGN_EPI) { if (wr == 0) PG8_BAR; }
    PG8_BAR;
    if constexpr (Epi::AFTER_DRAIN) { E.fused(acc, cur, wr, wc, fr, fq, lds, wid, lane); S.done(cur); }
#undef PG8_SA
#undef PG8_SB
#undef PG8_STAGE
#undef PG8_LDA
#undef PG8_LDB
#undef PG8_MMA
#undef PG8_WAIT_V
#undef PG8_WAIT_L
#undef PG8_BAR
#undef PG8_SCHED
}
}

struct EpiProj {
  static constexpr bool PERM = true, AFTER_DRAIN = false, HEADPERM = true;
  const float* gqa; const float* gka; const float* gqb; const float* gkb; unsigned char* ws;
  __device__ __forceinline__ void operator()(const pg8::f32x4 (&acc)[2][2][4][2], const pg8::Unit& u, int wr, int wc, int fr, int fq) const {
    const int nbase = u.pn * 256 + wc * 64;
    const int region = nbase >> 9, hw = (nbase & 511) >> 6;
    const float* g = (region == 0) ? gqa : (region == 1) ? gka : (region == 3) ? gqb : gkb;
    const bool normed = (region != 2 && region != 5);
    const float qs = (region == 0 || region == 3) ? C2 : 1.0f;
    u16* dstR = (u16*)(ws + WS_R + (size_t)region * R_REGION);
    f32x4 gv[2][2];
#pragma unroll
    for (int bj = 0; bj < 2; ++bj)
#pragma unroll
      for (int n = 0; n < 2; ++n) gv[bj][n] = normed ? *(const f32x4*)(g + 32 * bj + 8 * fq + 4 * n) : (f32x4){1.f, 1.f, 1.f, 1.f};
#pragma unroll
    for (int ai = 0; ai < 2; ++ai)
#pragma unroll
      for (int m = 0; m < 4; ++m) {
        const int t = u.pm * 256 + ai * 128 + wr * 64 + m * 16 + fr;
        int seq_start, S, sq; seq_of(t, seq_start, S, sq);
        float scale = 1.0f;
        if (normed) {
          float ss = 0.f;
#pragma unroll
          for (int bj = 0; bj < 2; ++bj)
#pragma unroll
            for (int n = 0; n < 2; ++n) { const f32x4 v = acc[ai][bj][m][n]; ss += v[0] * v[0] + v[1] * v[1] + v[2] * v[2] + v[3] * v[3]; }
          ss += __shfl_xor(ss, 16); ss += __shfl_xor(ss, 32);
          scale = __builtin_amdgcn_rsqf(ss * (1.0f / 64.0f) + NORM_EPS) * qs;
        }
        u16* dst;
        if (region != 5) dst = dstR + (size_t)seq_start * 512 + ((size_t)hw * S + sq) * 64;
        else dst = dstR + (size_t)seq_start * 512 + ((size_t)(hw >> 1) * S + sq) * 128 + (hw & 1) * 64;
#pragma unroll
        for (int bj = 0; bj < 2; ++bj) {
          const f32x4 v0 = acc[ai][bj][m][0] * scale * gv[bj][0], v1 = acc[ai][bj][m][1] * scale * gv[bj][1];
          u32x4 o; o[0] = pk2(v0[0], v0[1]); o[1] = pk2(v0[2], v0[3]); o[2] = pk2(v1[0], v1[1]); o[3] = pk2(v1[2], v1[3]);
          *(u32x4*)(dst + 32 * bj + 8 * fq) = o;
        }
      }
  }
};

DI void phase_proj(const Params& p, unsigned char* lds) {
  pg8::Gemm g{(const u16*)((const unsigned char*)p.out + OUT_N1), (const u16*)(p.ws + WS_WIN), T_TOK, 3072, 1024};
  pg8::StaticOrder S; S.init(T_TOK, 3072, (int)gridDim.x, (int)blockIdx.x);
  EpiProj E{p.q_norm_a, p.k_norm_a, p.q_norm_b, p.k_norm_b, p.ws};
  pg8::gemm_phase<EpiProj, pg8::StaticOrder, true, true>((PG8_LAS unsigned char*)lds, g, S, E);
}

constexpr int AL_STAGE = 0;
constexpr int AL_VT    = 0;
constexpr int AL_TAB   = 131072;
constexpr int AL_TABA  = 137216;
constexpr int AL_XL    = 150016;
constexpr int AL_MISC  = 151552;

DI unsigned voff_b(int row, int ch) { return 256u * row + 16u * (ch ^ (((row & 3) << 2) | ((row >> 2) & 3))); }

template <int VAR>
DI void diff_unit(const Params& p, unsigned char* lds, int seq_start, int S, int hd, int q0, float lam) {
  const int tid = threadIdx.x, lane = tid & 63, r32 = lane & 31, h = lane >> 5;
  const int w = __builtin_amdgcn_readfirstlane(tid >> 6);
  const int map = w >> 2, wq = w & 3;
  const u16* QBp = (const u16*)(p.ws + WS_R + 3 * R_REGION);
  const u16* KBp = (const u16*)(p.ws + WS_R + 4 * R_REGION);
  const u16* VBp = (const u16*)(p.ws + WS_R + 5 * R_REGION);
  const int qpos = q0 + wq * 32 + r32;
  const int qlo = q0 + wq * 32;
  const u16* Qp = QBp + (size_t)seq_start * 512 + ((size_t)(hd * 2 + map) * S + qpos) * 64;
  bf16x8 qf[4];
#pragma unroll
  for (int ks = 0; ks < 4; ++ks) qf[ks] = *(const bf16x8*)(Qp + ks * 16 + h * 8);
  const u16* K1g = KBp + (size_t)seq_start * 512 + ((size_t)(hd * 2 + 0) * S) * 64;
  const u16* K2g = KBp + (size_t)seq_start * 512 + ((size_t)(hd * 2 + 1) * S) * 64;
  const u16* Vg = VBp + (size_t)seq_start * 512 + ((size_t)hd * S) * 128;
  const float* tab = (const float*)(lds + AL_TAB);
  const float* misc = (const float*)(lds + AL_MISC);
  const float cAfter = misc[12 + hd];
  f32x16 O[4];
#pragma unroll
  for (int nb = 0; nb < 4; ++nb)
#pragma unroll
    for (int r = 0; r < 16; ++r) O[nb][r] = 0.f;
  float l = 0.f;
  const int kr_ = 8 * w + (lane >> 3), kc_ = (lane & 7) ^ ((kr_ >> 1) & 7);
  const u16* k1src = K1g + (size_t)kr_ * 64 + kc_ * 8;
  const u16* k2src = K2g + (size_t)kr_ * 64 + kc_ * 8;
  const u16* vsrc[2];
#pragma unroll
  for (int i = 0; i < 2; ++i) { const int row = 8 * w + 4 * i + (lane >> 4); const int pc = (lane & 15) ^ (((row & 3) << 2) | ((row >> 2) & 3)); vsrc[i] = Vg + (size_t)row * 128 + pc * 8; }
  const int NKT = S / 64;
  const int i16 = lane & 15, tq = i16 >> 2, tp = i16 & 3, blk = (lane >> 4) & 1;
  int kbase4[4], vbase[4][2];
#pragma unroll
  for (int ks = 0; ks < 4; ++ks) kbase4[ks] = r32 * 128 + (((2 * ks + h) ^ ((r32 >> 1) & 7)) << 4);
#pragma unroll
  for (int nb = 0; nb < 4; ++nb)
#pragma unroll
    for (int hi = 0; hi < 2; ++hi) vbase[nb][hi] = (int)voff_b(4 * h + tq + 8 * hi, 4 * nb + 2 * blk + (tp >> 1)) + 8 * (tp & 1);
#define DU_GLDS(gsrc_, ldsoff_) do { unsigned keep_; const unsigned dst_ = (unsigned)__builtin_amdgcn_readfirstlane((int)(ldsoff_)); \
    asm volatile("s_mov_b32 %0, m0\n\ts_mov_b32 m0, %2\n\ts_nop 0\n\tglobal_load_lds_dwordx4 %1, off\n\ts_mov_b32 m0, %0" : "=&s"(keep_) : "v"(gsrc_), "s"(dst_) : "memory"); } while (0)
#define DU_DMA(kt_, st_) do { const size_t ko_ = (size_t)(kt_) * 64 * 64, vo_ = (size_t)(kt_) * 64 * 128; const unsigned b_ = lds_base + AL_STAGE + (st_) * 32768; \
    DU_GLDS(k1src + ko_, b_ + w * 1024); DU_GLDS(k2src + ko_, b_ + 8192 + w * 1024); \
    DU_GLDS(vsrc[0] + vo_, b_ + 16384 + w * 2048); DU_GLDS(vsrc[1] + vo_, b_ + 16384 + w * 2048 + 1024); } while (0)
  const unsigned lds_base = (unsigned)(uintptr_t)lds;
#define SBAR() __builtin_amdgcn_sched_barrier(0)
#define DU_VRD(slot, f, so_) do { vlo[slot] = tr_read(vp[(f) >> 1][0] + (so_) + ((f) & 1) * 4096); vhi[slot] = tr_read(vp[(f) >> 1][1] + (so_) + ((f) & 1) * 4096); } while (0)
#define DU_SUB(A, B, kq2, kso2_, has_next2_, vso_, knext_, has_next_) do { \
    SBAR(); \
    s16x4 vlo[4], vhi[4]; \
    if (VAR != 2 && VAR != 4) { DU_VRD(0, 0, vso_); DU_VRD(1, 1, vso_); DU_VRD(2, 2, vso_); DU_VRD(3, 3, vso_); } \
    if (has_next_ && VAR != 3 && VAR != 4) { \
      f32x16 z_; _Pragma("unroll") for (int r = 0; r < 16; ++r) z_[r] = 0.f; \
      B = MFMA32(kf[0], qf[0], z_); B = MFMA32(kf[1], qf[1], B); B = MFMA32(kf[2], qf[2], B); B = MFMA32(kf[3], qf[3], B); } \
    float ls = 0.f; \
    _Pragma("unroll") for (int r = 0; r < 16; ++r) ls += A[r]; \
    l += ls; \
    bf16x8 pb[2]; \
    _Pragma("unroll") for (int s2 = 0; s2 < 2; ++s2) { \
      u32x4 pw; pw[0] = pk2(A[8 * s2 + 0], A[8 * s2 + 1]); pw[1] = pk2(A[8 * s2 + 2], A[8 * s2 + 3]); \
      pw[2] = pk2(A[8 * s2 + 4], A[8 * s2 + 5]); pw[3] = pk2(A[8 * s2 + 6], A[8 * s2 + 7]); \
      pb[s2] = __builtin_bit_cast(bf16x8, pw); } \
    SBAR(); \
    if ((has_next2_) && VAR != 3 && VAR != 4) { _Pragma("unroll") for (int ks = 0; ks < 4; ++ks) kf[ks] = *(const bf16x8*)(kq2[ks] + (kso2_)); } \
    if (has_next_) { \
      const int dmin_ = (knext_) - (qlo + 31), dmax_ = (knext_) + 31 - qlo; \
      if (dmin_ < 559) { \
        if (in_after) { in_after = false; _Pragma("unroll") for (int nb = 0; nb < 4; ++nb) _Pragma("unroll") for (int r = 0; r < 16; ++r) O[nb][r] *= fAfter; l *= fAfter; \
                        _Pragma("unroll") for (int s2 = 0; s2 < 2; ++s2) {   \
                          u32x4 pw; pw[0] = pk2(A[8 * s2 + 0] * fAfter, A[8 * s2 + 1] * fAfter); pw[1] = pk2(A[8 * s2 + 2] * fAfter, A[8 * s2 + 3] * fAfter); \
                          pw[2] = pk2(A[8 * s2 + 4] * fAfter, A[8 * s2 + 5] * fAfter); pw[3] = pk2(A[8 * s2 + 6] * fAfter, A[8 * s2 + 7] * fAfter); \
                          pb[s2] = __builtin_bit_cast(bf16x8, pw); } } \
        if (dmax_ > -559) { const int base_ = (knext_) + 4 * h - qpos + 640; \
          _Pragma("unroll") for (int r = 0; r < 16; ++r) B[r] += tab[base_ + (r & 3) + 8 * (r >> 2)]; } } } \
    _Pragma("unroll") for (int f = 0; f < 8; ++f) { \
      if (VAR != 2 && VAR != 4) { O[f >> 1] = MFMA32(cat8(vlo[f & 3], vhi[f & 3]), pb[f & 1], O[f >> 1]); \
      if (f + 4 < 8) DU_VRD(f & 3, f + 4, vso_); } \
      if (VAR != 1 && VAR != 4) { B[2 * f] = __builtin_amdgcn_exp2f(B[2 * f]); B[2 * f + 1] = __builtin_amdgcn_exp2f(B[2 * f + 1]); } } \
  } while (0)
  f32x16 X, Y; bf16x8 kf[4];
  const float fAfter = __builtin_amdgcn_exp2f(cAfter);
  bool in_after = true;
  const int KT1 = NKT - 1;
  DU_DMA(KT1, 0);
  if (NKT > 1) DU_DMA(KT1 - 1, 1);
  if (NKT > 2) DU_DMA(KT1 - 2, 2);
  if (NKT > 2) asm volatile("s_waitcnt vmcnt(8)" ::: "memory"); else asm volatile("s_waitcnt vmcnt(0)" ::: "memory");
  __syncthreads();
  {
    const unsigned char* kb_ = lds + AL_STAGE + map * 8192 + 4096;
    f32x16 z_;
#pragma unroll
    for (int r = 0; r < 16; ++r) z_[r] = 0.f;
    X = MFMA32(*(const bf16x8*)(kb_ + kbase4[0]), qf[0], z_); X = MFMA32(*(const bf16x8*)(kb_ + kbase4[1]), qf[1], X);
    X = MFMA32(*(const bf16x8*)(kb_ + kbase4[2]), qf[2], X); X = MFMA32(*(const bf16x8*)(kb_ + kbase4[3]), qf[3], X);
    const int knext = 64 * KT1 + 32;
    const int dmin_ = knext - (qlo + 31), dmax_ = knext + 31 - qlo;
    if (dmin_ < 559) {
      in_after = false;
      if (dmax_ > -559) { const int base_ = knext + 4 * h - qpos + 640;
#pragma unroll
        for (int r = 0; r < 16; ++r) X[r] += tab[base_ + (r & 3) + 8 * (r >> 2)]; }
    }
#pragma unroll
    for (int r = 0; r < 16; ++r) X[r] = __builtin_amdgcn_exp2f(X[r]);
#pragma unroll
    for (int ks = 0; ks < 4; ++ks) kf[ks] = *(const bf16x8*)(lds + AL_STAGE + map * 8192 + kbase4[ks]);
  }
  if (map == 1) __builtin_amdgcn_s_setprio(1);
  int st_cur = 0, st_nxt = 32768, st_nx2 = 65536, st_free = 98304;
  for (int i = 0; i < NKT; ++i) {
    const int kt = KT1 - i;
    if (i + 2 < NKT) asm volatile("s_waitcnt vmcnt(4)" ::: "memory"); else asm volatile("s_waitcnt vmcnt(0)" ::: "memory");
    __syncthreads();
    if (i + 3 < NKT) DU_DMA(kt - 3, st_free / 32768);
    const unsigned char* knx[4]; const unsigned char* vp[4][2];
#pragma unroll
    for (int ks = 0; ks < 4; ++ks) knx[ks] = lds + AL_STAGE + st_nxt + map * 8192 + kbase4[ks];
#pragma unroll
    for (int nb = 0; nb < 4; ++nb) { vp[nb][0] = lds + AL_STAGE + st_cur + 16384 + vbase[nb][0]; vp[nb][1] = lds + AL_STAGE + st_cur + 16384 + vbase[nb][1]; }
    DU_SUB(X, Y, knx, 4096, (i + 1 < NKT), 8192, 64 * kt, true);
    DU_SUB(Y, X, knx, 0, (i + 1 < NKT), 0, 64 * kt - 32, (i + 1 < NKT));
    { const int t_ = st_cur; st_cur = st_nxt; st_nxt = st_nx2; st_nx2 = st_free; st_free = t_; }
  }
  __builtin_amdgcn_s_setprio(0);
#undef DU_DMA
#undef DU_GLDS
#undef DU_VRD
#undef DU_SUB
#undef SBAR
  if (in_after) {
#pragma unroll
    for (int nb = 0; nb < 4; ++nb)
#pragma unroll
      for (int r = 0; r < 16; ++r) O[nb][r] *= fAfter;
    l *= fAfter;
  }
  if (VAR != 0) {
#pragma unroll
    for (int nb = 0; nb < 4; ++nb) asm volatile("" :: "v"(O[nb]));
    asm volatile("" :: "v"(l), "v"(X), "v"(Y));
    __syncthreads();
    return;
  }
  __syncthreads();
  float ltot = l + __shfl_xor(l, 32);
  float* xbuf = (float*)(lds + AL_STAGE);
  if (map == 1) {
    const float inv = 1.0f / ltot;
#pragma unroll
    for (int nb = 0; nb < 4; ++nb)
#pragma unroll
      for (int r = 0; r < 16; ++r) xbuf[((wq * 64 + nb * 16 + r) << 6) + lane] = O[nb][r] * inv;
  }
  __syncthreads();
  if (map == 0) {
    const float inv = 1.0f / ltot;
    float ss = 0.f;
#pragma unroll
    for (int nb = 0; nb < 4; ++nb)
#pragma unroll
      for (int r = 0; r < 16; ++r) {
        float o = O[nb][r] * inv - lam * xbuf[((wq * 64 + nb * 16 + r) << 6) + lane];
        O[nb][r] = o; ss += o * o;
      }
    ss += __shfl_xor(ss, 32);
    const float rn = __builtin_amdgcn_rsqf(ss * (1.0f / 128.0f) + NORM_EPS) * 0.8f;
    u16* mix = (u16*)((unsigned char*)p.out + OUT_MIX) + (size_t)(seq_start + qpos) * 1024 + 512 + hd * 128;
#pragma unroll
    for (int nb = 0; nb < 4; ++nb)
#pragma unroll
      for (int g4 = 0; g4 < 4; ++g4) {
        const int d0 = 32 * nb + 8 * g4 + 4 * h;
        f32x4 gg = *(const f32x4*)(p.diff_norm_g + d0);
        u32x2 o; o[0] = pk2(O[nb][4 * g4 + 0] * rn * gg[0], O[nb][4 * g4 + 1] * rn * gg[1]);
        o[1] = pk2(O[nb][4 * g4 + 2] * rn * gg[2], O[nb][4 * g4 + 3] * rn * gg[3]);
        *(u32x2*)(mix + d0) = o;
      }
  }
  __syncthreads();
}

constexpr int AL_DPART = 65536;
constexpr int AL_DL    = AL_TAB;
template <int PASS>
DI void dil_wave_item(const Params& p, unsigned char* lds, int seq_start, int S, int hd, int i0, int sel) {
  const int tid = threadIdx.x, lane = tid & 63, r32 = lane & 31, h = lane >> 5;
  const int w = __builtin_amdgcn_readfirstlane(tid >> 6);
  const u16* QAp = (const u16*)(p.ws + WS_R + 0 * R_REGION);
  const u16* KAp = (const u16*)(p.ws + WS_R + 1 * R_REGION);
  const u16* VAp = (const u16*)(p.ws + WS_R + 2 * R_REGION);
  constexpr int QSTR = (PASS == 1) ? 1 : 16;
  constexpr int NTILE = (PASS == 1) ? 5 : 13;
  const int qbase = (PASS == 1) ? i0 + 32 * sel : i0 + sel;
  const int qpos = qbase + QSTR * r32;
  const int tl = qpos - i0;
  const u16* Qp = QAp + (size_t)seq_start * 512 + ((size_t)hd * S + qpos) * 64;
  bf16x8 qf[4];
#pragma unroll
  for (int ks = 0; ks < 4; ++ks) qf[ks] = *(const bf16x8*)(Qp + ks * 16 + h * 8);
  const u16* Kg = KAp + (size_t)seq_start * 512 + ((size_t)hd * S) * 64;
  const u16* Vg = VAp + (size_t)seq_start * 512 + ((size_t)hd * S) * 64;
  unsigned char* vt = lds + AL_VT + w * 8192;
  unsigned char* ktl = vt + 4096;
  const float* tabA = (const float*)(lds + AL_TABA) + hd * 3 * 132;
  unsigned char* dpart = lds + AL_DPART;
  float* dl = (float*)(lds + AL_DL);
  const int psw = ((tl >> 4) ^ tl) & 15;
  f32x16 O[2];
  float l = 0.f;
  if (PASS == 1) {
#pragma unroll
    for (int nb = 0; nb < 2; ++nb)
#pragma unroll
      for (int r = 0; r < 16; ++r) O[nb][r] = 0.f;
  } else {
#pragma unroll
    for (int nb = 0; nb < 2; ++nb)
#pragma unroll
      for (int g4 = 0; g4 < 4; ++g4) {
        const int ch = 8 * nb + 2 * g4 + h;
        const u32x2 v = *(const u32x2*)(dpart + tl * 128 + ((ch ^ psw) << 3));
        O[nb][4 * g4 + 0] = __uint_as_float(v[0] << 16); O[nb][4 * g4 + 1] = __uint_as_float(v[0] & 0xffff0000u);
        O[nb][4 * g4 + 2] = __uint_as_float(v[1] << 16); O[nb][4 * g4 + 3] = __uint_as_float(v[1] & 0xffff0000u);
      }
    if (h == 0) l = dl[tl];
  }
  const int i16 = lane & 15, tq = i16 >> 2, tp = i16 & 3, blk = (lane >> 4) & 1;
  int vrb[2][2];
#pragma unroll
  for (int nb = 0; nb < 2; ++nb)
#pragma unroll
    for (int hi = 0; hi < 2; ++hi) {
      const int R = 4 * h + tq + 8 * hi; const int ch = 4 * nb + 2 * blk + (tp >> 1);
      const int sw = (((R >> 1) & 1) << 2) ^ ((R >> 2) & 3);
      vrb[nb][hi] = R * 128 + ((ch ^ sw) << 4) + 8 * (tp & 1);
    }
  bf16x8 kfb[1][4]; u32x4 vcb[1][4];
  const int lrow = lane >> 3, lch = lane & 7;
#define DL_PARAMS(tau_) \
    const int d_ = (PASS == 1) ? 1 : (((tau_) < 5) ? 16 : 4); const int br_ = (PASS == 1) ? 2 : (((tau_) < 5) ? 0 : 1); \
    const int tt_ = (PASS == 1) ? (tau_) : (((tau_) < 5) ? (tau_) : (tau_) - 5); const int ratio_ = QSTR / d_; \
    const int n0_ = -64 + 32 * tt_;
#define DL_LOAD(buf, tau_) do { DL_PARAMS(tau_) \
    _Pragma("unroll") for (int i4 = 0; i4 < 4; ++i4) { int kpos_ = qbase + d_ * (n0_ + 8 * i4 + lrow); kpos_ = kpos_ < 0 ? 0 : (kpos_ >= S ? S - 1 : kpos_); \
      kfb[buf][i4] = *(const bf16x8*)(Kg + (size_t)kpos_ * 64 + lch * 8); vcb[buf][i4] = *(const u32x4*)(Vg + (size_t)kpos_ * 64 + lch * 8); } (void)br_; (void)ratio_; } while (0)
#define DL_STORE(buf) do { \
    _Pragma("unroll") for (int i4 = 0; i4 < 4; ++i4) { const int row_ = 8 * i4 + lrow; const int sw_ = (((row_ >> 1) & 1) << 2) ^ ((row_ >> 2) & 3); \
      *(u32x4*)(vt + row_ * 128 + ((lch ^ sw_) << 4)) = vcb[buf][i4]; \
      *(bf16x8*)(ktl + row_ * 128 + ((lch ^ ((row_ >> 1) & 7)) << 4)) = kfb[buf][i4]; } } while (0)
#define DL_COMPUTE(buf, tau_) do { DL_PARAMS(tau_) \
    const int kfirst_ = qbase + d_ * n0_, klast_ = qbase + d_ * (n0_ + 31); \
    const int base_ = n0_ + 4 * h - ratio_ * r32; const float* tb_ = tabA + br_ * 132; \
    f32x16 sT; \
    _Pragma("unroll") for (int r = 0; r < 16; ++r) { int dd = base_ + (r & 3) + 8 * (r >> 2); dd = dd < -65 ? -65 : (dd > 65 ? 65 : dd); sT[r] = tb_[dd + 65]; } \
    if (kfirst_ < 0 || klast_ >= S) { _Pragma("unroll") for (int r = 0; r < 16; ++r) { const int kp = qbase + d_ * (n0_ + crow(r, h)); if (kp < 0 || kp >= S) sT[r] = NEG_BIG; } } \
    _Pragma("unroll") for (int ks = 0; ks < 4; ++ks) { const bf16x8 ka_ = *(const bf16x8*)(ktl + r32 * 128 + (((2 * ks + h) ^ ((r32 >> 1) & 7)) << 4)); sT = MFMA32(ka_, qf[ks], sT); } \
    float ls = 0.f; \
    _Pragma("unroll") for (int r = 0; r < 16; ++r) { sT[r] = __builtin_amdgcn_exp2f(sT[r]); ls += sT[r]; } \
    l += ls; \
    bf16x8 pb[2]; \
    _Pragma("unroll") for (int s2 = 0; s2 < 2; ++s2) { \
      u32x4 pw; pw[0] = pk2(sT[8 * s2 + 0], sT[8 * s2 + 1]); pw[1] = pk2(sT[8 * s2 + 2], sT[8 * s2 + 3]); \
      pw[2] = pk2(sT[8 * s2 + 4], sT[8 * s2 + 5]); pw[3] = pk2(sT[8 * s2 + 6], sT[8 * s2 + 7]); \
      pb[s2] = __builtin_bit_cast(bf16x8, pw); } \
    _Pragma("unroll") for (int nb = 0; nb < 2; ++nb) _Pragma("unroll") for (int s2 = 0; s2 < 2; ++s2) { \
        const s16x4 lo = tr_read(vt + vrb[nb][0] + s2 * 2048); const s16x4 hi = tr_read(vt + vrb[nb][1] + s2 * 2048); \
        O[nb] = MFMA32(cat8(lo, hi), pb[s2], O[nb]); } \
  } while (0)
  DL_LOAD(0, 0);
#pragma unroll 1
  for (int tau = 0; tau < NTILE; ++tau) {
    DL_STORE(0);
    { const int tn = (tau + 1 < NTILE) ? tau + 1 : tau; DL_LOAD(0, tn); }
    DL_COMPUTE(0, tau);
  }
#undef DL_PARAMS
#undef DL_LOAD
#undef DL_STORE
#undef DL_COMPUTE
  const float ltot = l + __shfl_xor(l, 32);
  if (PASS == 1) {
#pragma unroll
    for (int nb = 0; nb < 2; ++nb)
#pragma unroll
      for (int g4 = 0; g4 < 4; ++g4) {
        const int ch = 8 * nb + 2 * g4 + h;
        u32x2 o; o[0] = pk2(O[nb][4 * g4 + 0], O[nb][4 * g4 + 1]); o[1] = pk2(O[nb][4 * g4 + 2], O[nb][4 * g4 + 3]);
        *(u32x2*)(dpart + tl * 128 + ((ch ^ psw) << 3)) = o;
      }
    if (h == 0) dl[tl] = ltot;
  } else {
    const float inv = 1.0f / ltot;
    u16* mix = (u16*)((unsigned char*)p.out + OUT_MIX) + (size_t)(seq_start + qpos) * 1024 + hd * 64;
#pragma unroll
    for (int nb = 0; nb < 2; ++nb)
#pragma unroll
      for (int g4 = 0; g4 < 4; ++g4) {
        const int d0 = 32 * nb + 8 * g4 + 4 * h;
        u32x2 o; o[0] = pk2(O[nb][4 * g4 + 0] * inv, O[nb][4 * g4 + 1] * inv); o[1] = pk2(O[nb][4 * g4 + 2] * inv, O[nb][4 * g4 + 3] * inv);
        *(u32x2*)(mix + d0) = o;
      }
  }
}

DI void phase_attn(const Params& p, unsigned char* lds) {
  const int tid = threadIdx.x;
  float* misc = (float*)(lds + AL_MISC);
  if (tid == 0) {
    float gqa = 0.f, gka = 0.f, gqb = 0.f, gkb = 0.f, bm = 0.f;
    for (int i = 0; i < 64; ++i) { gqa = fmaxf(gqa, fabsf(p.q_norm_a[i])); gka = fmaxf(gka, fabsf(p.k_norm_a[i])); gqb = fmaxf(gqb, fabsf(p.q_norm_b[i])); gkb = fmaxf(gkb, fabsf(p.k_norm_b[i])); }
    for (int i = 0; i < 32 * 12; ++i) bm = fmaxf(bm, fabsf(p.rel_bias[i]));
    const float M2 = 8.0f * LOG2E * fmaxf(gqa * gka, gqb * gkb) * 1.02f + bm * LOG2E + 0.1f;
    float s1 = 0.f, s2 = 0.f;
    for (int i = 0; i < 64; ++i) { s1 += p.lq1[i] * p.lk1[i]; s2 += p.lq2[i] * p.lk2[i]; }
    misc[0] = M2; misc[1] = expf(s1) - expf(s2) + 0.2f;
    for (int hd = 0; hd < 4; ++hd) { misc[8 + hd] = p.rel_bias[15 * 12 + 8 + hd] * LOG2E; misc[12 + hd] = (p.rel_bias[31 * 12 + 8 + hd] - p.rel_bias[15 * 12 + 8 + hd]) * LOG2E; }
  }
  __syncthreads();
  const float M2 = misc[0], lam = misc[1];
  {
    float* tabA = (float*)(lds + AL_TABA);
    for (int i = tid; i < 8 * 3 * 132; i += NTHR) {
      int hd = i / 396, rem = i % 396, br = rem / 132, idx = rem % 132;
      int dl = idx - 65; float v = NEG_BIG;
      if (dl >= -64 && dl <= 64 && idx < 131) { int d = (br == 0) ? 16 : (br == 1) ? 4 : 1; v = p.rel_bias[rel_bucket(dl * d) * 12 + hd] * LOG2E - M2; }
      tabA[i] = v;
    }
  }
#ifndef REP_DIFF
#define REP_DIFF 1
#endif
#ifndef REP_DIL
#define REP_DIL 1
#endif
  int cur_hd = -1;
  for (int rep_ = 0; rep_ < REP_DIFF; ++rep_)
  for (int vb = blockIdx.x; vb < 256; vb += gridDim.x) {
    const int xl = vb & 7, rk = vb >> 3;
#pragma unroll 1
    for (int rnd = 0; rnd < 8; ++rnd) {
      int seq_start, S, hd, q0;
      if (rnd < 4) { const int pair = xl + 8 * rnd; hd = pair & 3; S = 4096; seq_start = (pair >> 2) * 4096; q0 = rk * 128; }
      else { const int pair = 8 * xl + 2 * (rnd - 4) + (rk >> 4); hd = pair & 3; S = 2048; seq_start = T_PROMPT + (pair >> 2) * 2048; q0 = (rk & 15) * 128; }
      if (hd != cur_hd) {
        __syncthreads();
        float* tab = (float*)(lds + AL_TAB);
        for (int i = tid; i < 1281; i += NTHR) tab[i] = p.rel_bias[rel_bucket(i - 640) * 12 + 8 + hd] * LOG2E - misc[8 + hd];
        cur_hd = hd;
        __syncthreads();
      }
#ifndef PROBE_VAR
#define PROBE_VAR 0
#endif
      if (rep_ == 0) diff_unit<0>(p, lds, seq_start, S, hd, q0, lam); else diff_unit<PROBE_VAR>(p, lds, seq_start, S, hd, q0, lam);
    }
  }
  __syncthreads();
  const int w = tid >> 6;
  for (int rep_ = 0; rep_ < REP_DIL; ++rep_)
  for (int vb = blockIdx.x; vb < 256; vb += gridDim.x)
#pragma unroll 1
  for (int rnd = 0; rnd < 4; ++rnd) {
    const int xl = vb & 7, rk = vb >> 3;
    int seq_start, S, hd, i0;
    if (rnd < 2) { const int pair = xl * 8 + rnd * 4 + (rk >> 3); hd = pair & 7; S = 4096; seq_start = (pair >> 3) * 4096; i0 = (rk & 7) * 512; }
    else { const int pair = xl * 16 + (rnd - 2) * 8 + (rk >> 2); hd = pair & 7; S = 2048; seq_start = T_PROMPT + (pair >> 3) * 2048; i0 = (rk & 3) * 512; }
    __syncthreads();
#pragma unroll 1
    for (int u2 = 0; u2 < 2; ++u2) dil_wave_item<1>(p, lds, seq_start, S, hd, i0, w + 8 * u2);
    __syncthreads();
#pragma unroll 1
    for (int u2 = 0; u2 < 2; ++u2) dil_wave_item<2>(p, lds, seq_start, S, hd, i0, w + 8 * u2);
  }
}

struct EpiOut {
  static constexpr bool PERM = false, AFTER_DRAIN = false, HEADPERM = false;
  const float* xp; const float* xs; u16* x1;
  __device__ __forceinline__ void operator()(const pg8::f32x4 (&acc)[2][2][4][2], const pg8::Unit& u, int wr, int wc, int fr, int fq) const {
    const int col0 = u.pn * 256 + wc * 32 + 4 * fq;
#pragma unroll
    for (int ai = 0; ai < 2; ++ai) {
      f32x4 xv[4][2][2];
#pragma unroll
      for (int m = 0; m < 4; ++m) {
        const int t = u.pm * 256 + ai * 128 + wr * 64 + m * 16 + fr;
        const float* xr = ((t < T_PROMPT) ? xp + (size_t)t * DM : xs + (size_t)(t - T_PROMPT) * DM) + col0;
#pragma unroll
        for (int bj = 0; bj < 2; ++bj)
#pragma unroll
          for (int n = 0; n < 2; ++n) xv[m][bj][n] = *(const f32x4*)(xr + bj * 128 + n * 16);
      }
#pragma unroll
      for (int m = 0; m < 4; ++m) {
        const int t = u.pm * 256 + ai * 128 + wr * 64 + m * 16 + fr;
        u16* orow = x1 + (size_t)t * DM + col0;
#pragma unroll
        for (int bj = 0; bj < 2; ++bj)
#pragma unroll
          for (int n = 0; n < 2; ++n) {
            const f32x4 sv_ = xv[m][bj][n] + acc[ai][bj][m][n];
            u32x2 o; o[0] = pk2(sv_[0], sv_[1]); o[1] = pk2(sv_[2], sv_[3]);
            *(u32x2*)(orow + bj * 128 + n * 16) = o;
          }
      }
    }
  }
};

DI void phase_outproj(const Params& p, unsigned char* lds) {
  pg8::Gemm g{(const u16*)((const unsigned char*)p.out + OUT_MIX), (const u16*)(p.ws + WS_WOUT), T_TOK, 1024, 1024};
  pg8::StaticOrder S; S.init(T_TOK, 1024, (int)gridDim.x, (int)blockIdx.x);
  EpiOut E{p.x_prompt, p.x_sample, (u16*)(p.ws + WS_X1)};
  pg8::gemm_phase<EpiOut, pg8::StaticOrder, true, true>((PG8_LAS unsigned char*)lds, g, S, E);
}

struct EpiQp {
  static constexpr bool PERM = true, AFTER_DRAIN = false, HEADPERM = false;
  u16* O; const float* r2;
  __device__ __forceinline__ void operator()(const pg8::f32x4 (&acc)[2][2][4][2], const pg8::Unit& u, int wr, int wc, int fr, int fq) const {
    const int col0 = u.pn * 256 + wc * 32 + 8 * fq;
    float rrv[2][4];
#pragma unroll
    for (int ai = 0; ai < 2; ++ai)
#pragma unroll
      for (int m = 0; m < 4; ++m) rrv[ai][m] = r2[u.pm * 256 + ai * 128 + wr * 64 + m * 16 + fr];
#pragma unroll
    for (int ai = 0; ai < 2; ++ai)
#pragma unroll
      for (int m = 0; m < 4; ++m) {
        const int t = u.pm * 256 + ai * 128 + wr * 64 + m * 16 + fr;
        u16* rowp = O + (size_t)t * 2048 + col0;
        const float rr = rrv[ai][m];
#pragma unroll
        for (int bj = 0; bj < 2; ++bj) {
          const f32x4 v0 = acc[ai][bj][m][0] * rr, v1 = acc[ai][bj][m][1] * rr;
          u32x4 o; o[0] = pk2(v0[0], v0[1]); o[1] = pk2(v0[2], v0[3]); o[2] = pk2(v1[0], v1[1]); o[3] = pk2(v1[2], v1[3]);
          *(u32x4*)(rowp + bj * 128) = o;
        }
      }
  }
};

DI void phase_peer_query(const Params& p, unsigned char* lds) {
  pg8::Gemm g{(const u16*)(p.ws + WS_X1), (const u16*)(p.ws + WS_WQ), T_TOK, 2048, 1024};
  pg8::StaticOrder S; S.init(T_TOK, 2048, (int)gridDim.x, (int)blockIdx.x);
  EpiQp E{(u16*)p.out, (const float*)(p.ws + WS_MISC + MISC_R2)};
  pg8::gemm_phase<EpiQp, pg8::StaticOrder, true, true>((PG8_LAS unsigned char*)lds, g, S, E);
}

DI int f2sort(float f) { const int b = __float_as_int(f); return b ^ ((b >> 31) & 0x7fffffff); }
DI float sort2f(int s) { return __int_as_float(s ^ ((s >> 31) & 0x7fffffff)); }
#define CE_DESC(a, b) do { const int mx_ = max((a), (b)), mn_ = min((a), (b)); (a) = mx_; (b) = mn_; } while (0)
#define CE_ASC(a, b) do { const int mx_ = max((a), (b)), mn_ = min((a), (b)); (a) = mn_; (b) = mx_; } while (0)
template <int OFF> DI void sort16_desc(int (&x)[64]) {
#pragma unroll
  for (int k = 2; k <= 16; k <<= 1)
#pragma unroll
    for (int j = k >> 1; j > 0; j >>= 1)
#pragma unroll
      for (int i = 0; i < 16; ++i) {
        const int l = i ^ j;
        if (l > i) { if ((i & k) == 0) CE_DESC(x[OFF + i], x[OFF + l]); else CE_ASC(x[OFF + i], x[OFF + l]); }
      }
}
template <int A, int B> DI void merge16x(int (&x)[64]) {
#pragma unroll
  for (int i = 0; i < 16; ++i) x[A + i] = max(x[A + i], x[B + 15 - i]);
#pragma unroll
  for (int j = 8; j > 0; j >>= 1)
#pragma unroll
    for (int i = 0; i < 16; ++i) { const int l = i ^ j; if (l > i) CE_DESC(x[A + i], x[A + l]); }
}

DI void pack_hq(unsigned w0, unsigned w1, unsigned w2, unsigned w3, float sc, unsigned& HH, unsigned& LL) {
  const float MAGIC = 12582912.0f + 136.0f;
  const unsigned y0 = __float_as_uint(__builtin_fmaf(__uint_as_float(w0 << 16), sc, MAGIC)), y1 = __float_as_uint(__builtin_fmaf(__uint_as_float(w0 & 0xffff0000u), sc, MAGIC));
  const unsigned y2 = __float_as_uint(__builtin_fmaf(__uint_as_float(w1 << 16), sc, MAGIC)), y3 = __float_as_uint(__builtin_fmaf(__uint_as_float(w1 & 0xffff0000u), sc, MAGIC));
  const unsigned y4 = __float_as_uint(__builtin_fmaf(__uint_as_float(w2 << 16), sc, MAGIC)), y5 = __float_as_uint(__builtin_fmaf(__uint_as_float(w2 & 0xffff0000u), sc, MAGIC));
  const unsigned y6 = __float_as_uint(__builtin_fmaf(__uint_as_float(w3 << 16), sc, MAGIC)), y7 = __float_as_uint(__builtin_fmaf(__uint_as_float(w3 & 0xffff0000u), sc, MAGIC));
  const unsigned W = (y0 & 255u) | ((y1 & 255u) << 8) | ((y2 & 255u) << 16) | (y3 << 24);
  const unsigned X = (y4 & 255u) | ((y5 & 255u) << 8) | ((y6 & 255u) << 16) | (y7 << 24);
  HH = (((W >> 4) & 0x0F0F0F0Fu) | (X & 0xF0F0F0F0u)) ^ 0x88888888u;
  LL = ((W & 0x0F0F0F0Fu) | ((X << 4) & 0xF0F0F0F0u)) ^ 0x88888888u;
}
DI void quantise_h_rows(const Params& p, int t0, int lane) {
  const float* hamax = (const float*)(p.ws + WS_MISC + MISC_HAMAX);
  unsigned char* Hrow = p.ws + WS_H;
#pragma unroll 1
  for (int rr = 0; rr < 32; rr += 4) {
    u32x4 ha[4], hb[4]; float sc[4];
#pragma unroll
    for (int q = 0; q < 4; ++q) {
      const unsigned char* src = Hrow + (size_t)(t0 + rr + q) * 2048 + lane * 32;
      ha[q] = *(const u32x4*)src; hb[q] = *(const u32x4*)(src + 16);
      const float am = hamax[t0 + rr + q];
      sc[q] = (am > 0.f) ? 119.0f / am : 0.f;
    }
#pragma unroll
    for (int q = 0; q < 4; ++q) {
      unsigned h0, l0, h1, l1;
      pack_hq(ha[q][0], ha[q][1], ha[q][2], ha[q][3], sc[q], h0, l0);
      pack_hq(hb[q][0], hb[q][1], hb[q][2], hb[q][3], sc[q], h1, l1);
      u32x2 hi, lo; hi[0] = h0; hi[1] = h1; lo[0] = l0; lo[1] = l1;
      unsigned char* dst = Hrow + (size_t)(t0 + rr + q) * 2048 + (lane >> 4) * 256 + (lane & 15) * 8;
      *(u32x2*)dst = hi; *(u32x2*)(dst + 128) = lo;
    }
  }
}

DI void norm2_finish(const u32x4& a, const u32x4& b, const float* __restrict__ g, unsigned char* __restrict__ hq, int lane, float* r2out, float* amout) {
  float v[16];
#pragma unroll
  for (int q = 0; q < 4; ++q) { v[2 * q] = __uint_as_float(a[q] << 16); v[2 * q + 1] = __uint_as_float(a[q] & 0xffff0000u); v[8 + 2 * q] = __uint_as_float(b[q] << 16); v[8 + 2 * q + 1] = __uint_as_float(b[q] & 0xffff0000u); }
  float ss = 0.f;
#pragma unroll
  for (int q = 0; q < 16; ++q) ss += v[q] * v[q];
  ss = wave_sum(ss);
  const float r = __builtin_amdgcn_rsqf(ss * (1.0f / 1024.0f) + NORM_EPS);
  unsigned hw[8]; float am = 0.f;
#pragma unroll
  for (int q4 = 0; q4 < 4; ++q4) {
    const f32x4 gg = *(const f32x4*)(g + lane * 16 + 4 * q4);
    hw[2 * q4] = pk2(v[4 * q4] * r * gg[0], v[4 * q4 + 1] * r * gg[1]); hw[2 * q4 + 1] = pk2(v[4 * q4 + 2] * r * gg[2], v[4 * q4 + 3] * r * gg[3]);
    am = fmaxf(am, fmaxf(fmaxf(fabsf(__uint_as_float(hw[2 * q4] << 16)), fabsf(__uint_as_float(hw[2 * q4] & 0xffff0000u))), fmaxf(fabsf(__uint_as_float(hw[2 * q4 + 1] << 16)), fabsf(__uint_as_float(hw[2 * q4 + 1] & 0xffff0000u)))));
  }
#pragma unroll
  for (int o = 32; o > 0; o >>= 1) am = fmaxf(am, __shfl_xor(am, o));
  const float sc = (am > 0.f) ? 119.0f / am : 0.f;
  unsigned h0, l0, h1, l1;
  pack_hq(hw[0], hw[1], hw[2], hw[3], sc, h0, l0);
  pack_hq(hw[4], hw[5], hw[6], hw[7], sc, h1, l1);
  u32x2 hi, lo; hi[0] = h0; hi[1] = h1; lo[0] = l0; lo[1] = l1;
  unsigned char* dst = hq + (lane >> 4) * 256 + (lane & 15) * 8;
  *(u32x2*)dst = hi; *(u32x2*)(dst + 128) = lo;
  if (lane == 0) { *r2out = r; *amout = am; }
}
DI void phase_norm2(const Params& p) {
  const int tid = threadIdx.x, lane = tid & 63, w = tid >> 6;
  const u16* x1 = (const u16*)(p.ws + WS_X1);
  unsigned char* hq = p.ws + WS_H;
  float* hamax = (float*)(p.ws + WS_MISC + MISC_HAMAX);
  float* r2 = (float*)(p.ws + WS_MISC + MISC_R2);
  for (int it = blockIdx.x; it < T_TOK / 16; it += gridDim.x) {
    const int t = it * 16 + w, t2 = t + 8;
    const u16* xa = x1 + (size_t)t * DM + lane * 16; const u16* xb = x1 + (size_t)t2 * DM + lane * 16;
    const u32x4 a0 = *(const u32x4*)xa, a1 = *(const u32x4*)(xa + 8), b0 = *(const u32x4*)xb, b1 = *(const u32x4*)(xb + 8);
    norm2_finish(a0, a1, p.ffn_norm_g, hq + (size_t)t * 2048, lane, r2 + t, hamax + t);
    norm2_finish(b0, b1, p.ffn_norm_g, hq + (size_t)t2 * 2048, lane, r2 + t2, hamax + t2);
  }
}

DI void phase_peer_route(const Params& p, unsigned char* lds) {
  const u16* QP = (const u16*)p.out;
  const u16* SK = (const u16*)(p.ws + WS_SK);
  u16* eidx = (u16*)(p.ws + WS_EIDX);
  float* gg = (float*)(p.ws + WS_G);
  const int tid = threadIdx.x, lane = tid & 63, r32 = lane & 31, h = lane >> 5;
  const int w = __builtin_amdgcn_readfirstlane(tid >> 6);
  unsigned char* SKl = lds;
  float* v2l = (float*)(lds + 65536);
  __syncthreads();
#pragma unroll
  for (int i = 0; i < 8; ++i) {
    const int c = tid + 512 * i; const int zz = c >> 11, row = (c >> 4) & 127, ch = c & 15;
    const u32x4 v = *(const u32x4*)(SK + (size_t)zz * 16384 + row * 128 + ch * 8);
    *(u32x4*)(SKl + zz * 32768 + row * 256 + ((ch ^ (row & 15)) << 4)) = v;
  }
  __syncthreads();
  for (int item = blockIdx.x; item < T_TOK / 256; item += gridDim.x) {
    const int t = item * 256 + w * 32 + r32;
    const u16* qrow = QP + (size_t)t * 2048;
    bf16x8 qf[8];
#pragma unroll
    for (int ks = 0; ks < 8; ++ks) qf[ks] = *(const bf16x8*)(qrow + ks * 16 + h * 8);
#pragma unroll 1
    for (int pp = 0; pp < 8; ++pp) {
      int lists[2][16];
#pragma unroll
      for (int z = 0; z < 2; ++z) {
        const int c16 = pp * 2 + z;
        int x[64];
        {
          f32x16 S2[4];
#pragma unroll
          for (int kb = 0; kb < 4; ++kb)
#pragma unroll
            for (int r = 0; r < 16; ++r) S2[kb][r] = 0.f;
#pragma unroll
          for (int ks = 0; ks < 8; ++ks)
#pragma unroll
            for (int kb = 0; kb < 4; ++kb) {
              const int key = kb * 32 + r32;
              const bf16x8 a = *(const bf16x8*)(SKl + z * 32768 + key * 256 + (((2 * ks + h) ^ (key & 15)) << 4));
              S2[kb] = MFMA32(a, qf[ks], S2[kb]);
            }
          {
            const int cn = (c16 + 1 < 16) ? c16 + 1 : 15;
#pragma unroll
            for (int ks = 0; ks < 8; ++ks) qf[ks] = *(const bf16x8*)(qrow + cn * 128 + ks * 16 + h * 8);
          }
#pragma unroll
          for (int e = 0; e < 64; ++e) {
            const int kidx = 32 * (e >> 4) + (e & 3) + 8 * ((e & 15) >> 2) + 4 * h;
            x[e] = (f2sort(S2[e >> 4][e & 15]) & ~127) | kidx;
          }
        }
        sort16_desc<0>(x); sort16_desc<16>(x); sort16_desc<32>(x); sort16_desc<48>(x);
        merge16x<0, 16>(x); merge16x<32, 48>(x); merge16x<0, 32>(x);
#pragma unroll
        for (int i = 0; i < 16; ++i) x[16 + i] = __shfl_xor(x[i], 32);
        merge16x<0, 16>(x);
#pragma unroll
        for (int i = 0; i < 16; ++i) lists[z][i] = x[i];
      }
      float v1h[8];
#pragma unroll
      for (int i = 0; i < 8; ++i) { const int a0_ = lists[0][i], a1_ = lists[0][8 + i]; v1h[i] = sort2f(a0_ ^ ((a0_ ^ a1_) & -h)); }
#pragma unroll
      for (int i = 0; i < 16; ++i) v2l[i * 512 + tid] = sort2f(lists[1][i]);
      unsigned ptrs = 0u;
      float bestv[16]; int be[16];
#pragma unroll
      for (int rd = 0; rd < 16; ++rd) {
        float best = -3.0e38f, bv1 = 0.f, bv2 = 0.f; int ab = 0;
#pragma unroll
        for (int a = 0; a < 8; ++a) {
          const int b = (int)((ptrs >> (4 * a)) & 15u);
          const float v2 = v2l[b * 512 + tid];
          const float cnd = v1h[a] + v2;
          if (cnd > best) { best = cnd; ab = a; bv1 = v1h[a]; bv2 = v2; }
        }
        const float obest = __shfl_xor(best, 32), obv1 = __shfl_xor(bv1, 32), obv2 = __shfl_xor(bv2, 32);
        const bool mine = h ? (best > obest) : (best >= obest);
        const float wbest = mine ? best : obest, w1 = mine ? bv1 : obv1, w2 = mine ? bv2 : obv2;
        bestv[rd] = wbest; be[rd] = (f2sort(w1) & 127) * 128 + (f2sort(w2) & 127);
        if (mine) ptrs += 1u << (4 * ab);
      }
      if (h == 0) {
        float ex[16]; float sum = 0.f;
#pragma unroll
        for (int rd = 0; rd < 16; ++rd) { ex[rd] = __expf(bestv[rd] - bestv[0]); sum += ex[rd]; }
        const float inv = 1.0f / sum;
        const size_t oo = ((size_t)t * 8 + pp) * 16;
#pragma unroll
        for (int q4 = 0; q4 < 4; ++q4) { f32x4 v = {ex[4 * q4] * inv, ex[4 * q4 + 1] * inv, ex[4 * q4 + 2] * inv, ex[4 * q4 + 3] * inv}; *(f32x4*)(gg + oo + 4 * q4) = v; }
        u32x4 e0, e1;
#pragma unroll
        for (int j = 0; j < 4; ++j) { e0[j] = (unsigned)be[2 * j] | ((unsigned)be[2 * j + 1] << 16); e1[j] = (unsigned)be[8 + 2 * j] | ((unsigned)be[8 + 2 * j + 1] << 16); }
        *(u32x4*)(eidx + oo) = e0; *(u32x4*)(eidx + oo + 8) = e1;
      }
    }
  }
}

typedef float f2_t __attribute__((ext_vector_type(2)));
DI unsigned xcc_id() { return (unsigned)__builtin_amdgcn_s_getreg((3 << 11) | 20) & 7u; }
constexpr int PG_CHUNK_TOK = 64;
constexpr int PG_NCHUNK = T_TOK / PG_CHUNK_TOK;

DI void dec32(const u32x4& r, f2_t (&v)[16]) {
#pragma unroll
  for (int d = 0; d < 4; ++d) {
    v[4 * d + 0] = __builtin_amdgcn_cvt_scalef32_pk_f32_fp4(r[d], 1.0f, 0); v[4 * d + 1] = __builtin_amdgcn_cvt_scalef32_pk_f32_fp4(r[d], 1.0f, 1);
    v[4 * d + 2] = __builtin_amdgcn_cvt_scalef32_pk_f32_fp4(r[d], 1.0f, 2); v[4 * d + 3] = __builtin_amdgcn_cvt_scalef32_pk_f32_fp4(r[d], 1.0f, 3);
  }
}

template <int CTRL> DI float dpp_f(float x) { return __int_as_float(__builtin_amdgcn_update_dpp(0, __float_as_int(x), CTRL, 0xf, 0xf, true)); }
DI int idx16(const u32x4& a, const u32x4& b, int i) { const unsigned wd = (i < 8) ? a[(i & 7) >> 1] : b[(i & 7) >> 1]; return (i & 1) ? (int)(wd >> 16) : (int)(wd & 0xffffu); }
constexpr int PEER_NT = 16;
template <int WHICH>
DI void peer_wave_tokens(const Params& p, int x, int tb, int lane) {
  const unsigned char* TBL = p.ws + (WHICH ? WS_V : WS_U) + (size_t)x * 16384 * 128;
  const u16* Hb = (const u16*)(p.ws + WS_H);
  const u16* eidx = (const u16*)(p.ws + WS_EIDX);
  const u16* w16 = (const u16*)(p.ws + WS_W16);
  const float* x1 = (const float*)(p.ws + WS_X1);
  float* zpart = (float*)(p.ws + WS_ZP);
  const int r = lane >> 3, c = lane & 7;
  u32x4 ei[2][2]; u32x4 wv[2][2]; u32x4 rows[2][16]; u32x4 hsl[2][2];
#define PEER_LOAD_IDX(buf, k) do { const size_t o_ = (size_t)(tb + (k)) * 128 + r * 16; \
    ei[buf][0] = *(const u32x4*)(eidx + o_); ei[buf][1] = *(const u32x4*)(eidx + o_ + 8); \
    if (WHICH) { wv[buf][0] = *(const u32x4*)(w16 + o_); wv[buf][1] = *(const u32x4*)(w16 + o_ + 8); } } while (0)
#define PEER_LOAD_ROWS4(buf, ibuf, g) do { _Pragma("unroll") for (int ii_ = 0; ii_ < 4; ++ii_) { \
      const unsigned off_ = (unsigned)idx16(ei[ibuf][0], ei[ibuf][1], 4 * (g) + ii_) * 128u + (unsigned)c * 16u; \
      rows[buf][4 * (g) + ii_] = *(const u32x4*)(TBL + off_); } } while (0)
#define PEER_LOAD_ROWS(buf, ibuf) do { PEER_LOAD_ROWS4(buf, ibuf, 0); PEER_LOAD_ROWS4(buf, ibuf, 1); PEER_LOAD_ROWS4(buf, ibuf, 2); PEER_LOAD_ROWS4(buf, ibuf, 3); } while (0)
#define PEER_NEXT4(g) do { __builtin_amdgcn_sched_barrier(0); if (k + 1 < PEER_NT) PEER_LOAD_ROWS4((k + 1) & 1, (k + 1) & 1, g); __builtin_amdgcn_sched_barrier(0); } while (0)
#define PEER_LOAD_H(buf, k) do { if (WHICH == 0) { const unsigned char* hq_ = (const unsigned char*)Hb + (size_t)(tb + (k)) * 2048 + x * 256 + c * 16;     \
    hsl[buf][0] = *(const u32x4*)(hq_); hsl[buf][1] = *(const u32x4*)(hq_ + 128); } } while (0)
  PEER_LOAD_IDX(0, 0); PEER_LOAD_IDX(1, 1);
  PEER_LOAD_H(0, 0);
  PEER_LOAD_ROWS(0, 0);
#pragma unroll
  for (int k = 0; k < PEER_NT; ++k) {
    const int t = tb + k;
    u32x4 wcur[2];
    if (WHICH) { wcur[0] = wv[k & 1][0]; wcur[1] = wv[k & 1][1]; }
    if (k + 2 < PEER_NT) PEER_LOAD_IDX(k & 1, k + 2);
    if (k + 1 < PEER_NT) PEER_LOAD_H((k + 1) & 1, k + 1);
    if (WHICH == 0) {
      const u32x4 hh = hsl[k & 1][0], hl = hsl[k & 1][1];
      float sv[16];
#pragma unroll
      for (int i = 0; i < 16; ++i) {
        if ((i & 3) == 0) PEER_NEXT4(i >> 2);
        int ah = __builtin_amdgcn_sdot8((int)rows[k & 1][i][0], (int)hh[0], 0, false);
        int al = __builtin_amdgcn_sdot8((int)rows[k & 1][i][0], (int)hl[0], 0, false);
        ah = __builtin_amdgcn_sdot8((int)rows[k & 1][i][1], (int)hh[1], ah, false);
        al = __builtin_amdgcn_sdot8((int)rows[k & 1][i][1], (int)hl[1], al, false);
        ah = __builtin_amdgcn_sdot8((int)rows[k & 1][i][2], (int)hh[2], ah, false);
        al = __builtin_amdgcn_sdot8((int)rows[k & 1][i][2], (int)hl[2], al, false);
        ah = __builtin_amdgcn_sdot8((int)rows[k & 1][i][3], (int)hh[3], ah, false);
        al = __builtin_amdgcn_sdot8((int)rows[k & 1][i][3], (int)hl[3], al, false);
        int a = ah * 16 + al;
        a += __builtin_amdgcn_update_dpp(0, a, 0xB1, 0xf, 0xf, true);
        a += __builtin_amdgcn_update_dpp(0, a, 0x4E, 0xf, 0xf, true);
        a += __builtin_amdgcn_update_dpp(0, a, 0x141, 0xf, 0xf, true);
        sv[i] = (float)a;
      }
      float o0 = 0.f, o1 = 0.f;
#pragma unroll
      for (int i = 0; i < 8; ++i) { if (c == i) { o0 = sv[i]; o1 = sv[i + 8]; } }
      float* zp = zpart + ((size_t)x * T_TOK + t) * 128 + r * 16;
      zp[c] = o0; zp[c + 8] = o1;
    } else {
      f2_t acc[16];
#pragma unroll
      for (int q = 0; q < 16; ++q) { acc[q][0] = 0.f; acc[q][1] = 0.f; }
#pragma unroll
      for (int i = 0; i < 16; ++i) {
        if ((i & 3) == 0) PEER_NEXT4(i >> 2);
        f2_t v[16]; dec32(rows[k & 1][i], v);
        const unsigned wd_ = wcur[i >> 3][(i & 7) >> 1];
        const float wj = (i & 1) ? __uint_as_float(wd_ & 0xffff0000u) : __uint_as_float(wd_ << 16);
        f2_t ww = {wj, wj};
#pragma unroll
        for (int q = 0; q < 16; ++q) acc[q] = __builtin_elementwise_fma(v[q], ww, acc[q]);
      }
      f2_t b8[8];
      {
        const bool up = (lane & 32) != 0;
#pragma unroll
        for (int q = 0; q < 8; ++q) {
          f2_t keep = up ? acc[8 + q] : acc[q], send = up ? acc[q] : acc[8 + q];
          f2_t got; got[0] = __shfl_xor(send[0], 32); got[1] = __shfl_xor(send[1], 32);
          b8[q] = keep + got;
        }
      }
      f2_t b4[4];
      {
        const bool up = (lane & 16) != 0;
#pragma unroll
        for (int q = 0; q < 4; ++q) {
          f2_t keep = up ? b8[4 + q] : b8[q], send = up ? b8[q] : b8[4 + q];
          f2_t got; got[0] = __shfl_xor(send[0], 16); got[1] = __shfl_xor(send[1], 16);
          b4[q] = keep + got;
        }
      }
      f2_t b2[2];
      {
        const bool up = (lane & 8) != 0;
#pragma unroll
        for (int q = 0; q < 2; ++q) {
          f2_t keep = up ? b4[2 + q] : b4[q], send = up ? b4[q] : b4[2 + q];
          f2_t got; got[0] = dpp_f<0x128>(send[0]); got[1] = dpp_f<0x128>(send[1]);
          b2[q] = keep + got;
        }
      }
      const size_t o = (size_t)t * DM + x * 256 + c * 32 + 4 * r;
      const f32x4 xv = *(const f32x4*)(x1 + o);
      f32x4 res; res[0] = xv[0] + b2[0][0]; res[1] = xv[1] + b2[0][1]; res[2] = xv[2] + b2[1][0]; res[3] = xv[3] + b2[1][1];
      *(f32x4*)(p.out + o) = res;
    }
  }
#undef PEER_LOAD_IDX
#undef PEER_LOAD_H
#undef PEER_LOAD_ROWS
#undef PEER_LOAD_ROWS4
#undef PEER_NEXT4
}

typedef int v8i_t __attribute__((ext_vector_type(8)));
template <int NTOK, int VAR = 0>
DI void peer_tokens_v(const Params& p, unsigned char* ldsw, int t0, int lane) {
  const unsigned char* TBL = p.ws + WS_V;
  const u16* eidx = (const u16*)(p.ws + WS_EIDX);
  const unsigned char* w8 = p.ws + WS_W16;
  const u16* x1 = (const u16*)(p.ws + WS_X1);
  const int j = lane & 31, kg = lane >> 5;
  unsigned M[4];
#pragma unroll
  for (int q = 0; q < 4; ++q) M[q] = (kg == (j >> 4) && ((j & 15) >> 2) == q) ? (0xFFu << (8 * (j & 3))) : 0u;
  u32x4 ei[2][2]; u32x4 wv[2][2]; u32x4 rows[2][16];
#define PV_LOAD_IDX(u) do { const size_t o_ = (size_t)(t0 + ((u) >> 2)) * 128 + 16 * ((u) & 3); \
    ei[(u) & 1][0] = *(const u32x4*)(eidx + o_ + 64 * kg); ei[(u) & 1][1] = *(const u32x4*)(eidx + o_ + 64 * kg + 8); } while (0)
#define PV_LOAD_W(u) do { const size_t o_ = (size_t)(t0 + ((u) >> 2)) * 128 + 16 * ((u) & 3); \
    wv[(u) & 1][0] = *(const u32x4*)(w8 + o_); wv[(u) & 1][1] = *(const u32x4*)(w8 + o_ + 64); } while (0)
#define PV_IDX(ibuf, n) (((n) & 1) ? (ei[ibuf][(n) >> 3][((n) & 7) >> 1] >> 16) : (ei[ibuf][(n) >> 3][((n) & 7) >> 1] & 0xffffu))
#define PV_LOAD_ROWS4(u, g) do { _Pragma("unroll") for (int ii_ = 0; ii_ < 4; ++ii_) { \
      const unsigned off_ = (unsigned)PV_IDX((u) & 1, 4 * (g) + ii_) * 512u + (unsigned)j * 16u; \
      rows[(u) & 1][4 * (g) + ii_] = *(const u32x4*)(TBL + off_); } } while (0)
  constexpr int NU = 4 * NTOK;
  PV_LOAD_IDX(0); PV_LOAD_IDX(1); PV_LOAD_W(0);
  PV_LOAD_ROWS4(0, 0); PV_LOAD_ROWS4(0, 1); PV_LOAD_ROWS4(0, 2); PV_LOAD_ROWS4(0, 3);
  PV_LOAD_ROWS4(1, 0); PV_LOAD_ROWS4(1, 1); PV_LOAD_ROWS4(1, 2); PV_LOAD_ROWS4(1, 3);
  PV_LOAD_IDX(2);
  f32x16 acc; f32x4 xv[4];
  constexpr int XV_AT = 3;
#pragma unroll
  for (int u = 0; u < NU; ++u) {
    const int t = t0 + (u >> 2), c = u & 3;
    if (c == 0) {
#pragma unroll
      for (int r = 0; r < 16; ++r) acc[r] = 0.f;
    }
    if (c == 2 && VAR != 1) {
#pragma unroll
      for (int rq = 0; rq < 2; ++rq) {
        const u16* gsrc_ = x1 + (size_t)t * DM + 512 * rq + 8 * lane;
        unsigned keep_; const unsigned dst_ = (unsigned)__builtin_amdgcn_readfirstlane((int)((unsigned)(uintptr_t)ldsw + 1024u * rq));
        asm volatile("s_mov_b32 %0, m0\n\ts_mov_b32 m0, %2\n\ts_nop 0\n\tglobal_load_lds_dwordx4 %1, off\n\ts_mov_b32 m0, %0" : "=&s"(keep_) : "v"(gsrc_), "s"(dst_) : "memory");
      }
    }
    if (u + 3 < NU) PV_LOAD_IDX(u + 3);
    if (u + 1 < NU) PV_LOAD_W(u + 1);
#pragma unroll
    for (int n = 0; n < 16; ++n) {
      const unsigned wd1 = wv[u & 1][0][n >> 2], wd2 = wv[u & 1][1][n >> 2];
      const unsigned rep1 = __builtin_amdgcn_perm(wd1, wd1, 0x01010101u * (unsigned)(n & 3));
      const unsigned rep2 = __builtin_amdgcn_perm(wd2, wd2, 0x01010101u * (unsigned)(n & 3));
      v8i_t A, B;
#pragma unroll
      for (int q = 0; q < 4; ++q) { A[q] = (int)(rep1 & M[q]); A[4 + q] = (int)(rep2 & M[q]); }
      B[0] = (int)rows[u & 1][n][0]; B[1] = (int)rows[u & 1][n][1]; B[2] = (int)rows[u & 1][n][2]; B[3] = (int)rows[u & 1][n][3];
      B[4] = 0; B[5] = 0; B[6] = 0; B[7] = 0;
      acc = __builtin_amdgcn_mfma_scale_f32_32x32x64_f8f6f4(A, B, acc, 0  , 4  , 0, 0x7F7F7F7F, 0, 0x7F7F7F7F);
      if ((n & 3) == 3) {
        __builtin_amdgcn_sched_barrier(0);
        if (u + 2 < NU) PV_LOAD_ROWS4(u + 2, n >> 2);
        __builtin_amdgcn_sched_barrier(0);
      }
    }
    if (c == 3) {
      if (VAR != 1) {
        static_assert(NTOK == 4, "the vmcnt immediate below is counted for 16-chunk units");
        if (u + 3 < NU) asm volatile("s_waitcnt vmcnt(40)" ::: "memory");
        else asm volatile("s_waitcnt vmcnt(0)" ::: "memory");
#pragma unroll
        for (int rq = 0; rq < 4; ++rq) {
          const u32x2 r_ = *(const u32x2*)(ldsw + 2 * (32 * j + 8 * rq + 4 * kg));
          xv[rq][0] = __uint_as_float(r_[0] << 16); xv[rq][1] = __uint_as_float(r_[0] & 0xffff0000u); xv[rq][2] = __uint_as_float(r_[1] << 16); xv[rq][3] = __uint_as_float(r_[1] & 0xffff0000u);
        }
      }
#pragma unroll
      for (int rq = 0; rq < 4; ++rq) {
        const size_t o = (size_t)t * DM + 32 * j + 8 * rq + 4 * kg;
        f32x4 res;
#pragma unroll
        for (int q = 0; q < 4; ++q) res[q] = (VAR != 1 ? xv[rq][q] : 0.f) + acc[4 * rq + q] * (1.0f / 2048.0f);
        if (VAR != 1 || res[0] == 123456.789f) *(f32x4*)(p.out + o) = res;
      }
    }
  }
#undef PV_LOAD_IDX
#undef PV_LOAD_W
#undef PV_IDX
#undef PV_LOAD_ROWS4
}
DI void peer_act_range(const Params& p, size_t q_lo, size_t q_hi, int lane) {
  const float* zpart = (const float*)(p.ws + WS_ZP);
  const u16* eidx = (const u16*)(p.ws + WS_EIDX);
  float* wg = (float*)(p.ws + WS_G);
  const float* suinv = (const float*)(p.ws + WS_MISC + MISC_SUINV);
  const float* svinv = (const float*)(p.ws + WS_MISC + MISC_SVINV);
  const float* hamax = (const float*)(p.ws + WS_MISC + MISC_HAMAX);
#pragma unroll 4
  for (size_t i4 = q_lo + lane; i4 < q_hi; i4 += 64) {
    const size_t i = i4 * 4;
    f32x4 z = *(const f32x4*)(zpart + i);
#pragma unroll
    for (int x = 1; x < 4; ++x) { const f32x4 zz = *(const f32x4*)(zpart + (size_t)x * T_TOK * 128 + i); z[0] += zz[0]; z[1] += zz[1]; z[2] += zz[2]; z[3] += zz[3]; }
    const u32x2 ee = *(const u32x2*)(eidx + i);
    const f32x4 g4 = *(const f32x4*)(wg + i);
    const float hs = hamax[i >> 7] * (1.0f / 119.0f);
    float wq[4];
#pragma unroll
    for (int q = 0; q < 4; ++q) {
      const int e = (int)((q & 1) ? (ee[q >> 1] >> 16) : (ee[q >> 1] & 0xffffu));
      const float zq = z[q] * suinv[e] * hs;
      const float act = 0.5f * zq * (1.0f + erff(zq * 0.70710678118654752f));
      wq[q] = fminf(fmaxf(g4[q] * act * svinv[e] * 2048.0f, -448.0f), 448.0f);
    }
    int pk = __builtin_amdgcn_cvt_pk_fp8_f32(wq[0], wq[1], 0, false);
    pk = __builtin_amdgcn_cvt_pk_fp8_f32(wq[2], wq[3], pk, true);
    *(unsigned*)(p.ws + WS_W16 + i) = (unsigned)pk;
  }
}

template <int VAR = 0>
DI void phase_peer_v(const Params& p, unsigned char* lds) {
  const int tid = threadIdx.x, lane = tid & 63;
  const int w = __builtin_amdgcn_readfirstlane(tid >> 6);
  const int gw = blockIdx.x * 8 + w, nw = gridDim.x * 8;
  const int per = (T_TOK / 4 + nw - 1) / nw;
  const int u_lo = gw * per, u_hi = (u_lo + per < T_TOK / 4) ? u_lo + per : T_TOK / 4;
  if (u_lo >= u_hi) return;
  if (VAR == 0) {
    peer_act_range(p, (size_t)u_lo * 4 * 32, (size_t)u_hi * 4 * 32, lane);
    asm volatile("s_waitcnt vmcnt(0)" ::: "memory");
    __builtin_amdgcn_fence(__ATOMIC_ACQUIRE, "agent");
    asm volatile("s_waitcnt vmcnt(0)" ::: "memory");
  }
#pragma unroll 1
  for (int u = u_lo; u < u_hi; ++u) peer_tokens_v<4, VAR>(p, lds + w * 4096, u * 4, lane);
}

DI void peer_wave_tokens_u7(const Params& p, int x, int tb, int lane) {
  const unsigned char* TBL = p.ws + WS_U + (size_t)x * 16384 * 128;
  const unsigned char* Hq = p.ws + WS_H;
  const u16* eidx = (const u16*)(p.ws + WS_EIDX);
  float* zpart = (float*)(p.ws + WS_ZP);
  const int r = lane >> 3, c = lane & 7;
  u32x4 ei[2][2]; u32x4 rows[2][16]; u32x4 hsl[2][2];
#define U7_LOAD_IDX(k) do { const size_t o_ = (size_t)(tb + (k)) * 128 + r * 16; \
    ei[(k) & 1][0] = *(const u32x4*)(eidx + o_); ei[(k) & 1][1] = *(const u32x4*)(eidx + o_ + 8); } while (0)
#define U7_LOAD_H(k) do { const unsigned char* hq_ = Hq + (size_t)(tb + (k)) * 2048 + x * 256 + c * 16; \
    hsl[(k) & 1][0] = *(const u32x4*)(hq_); hsl[(k) & 1][1] = *(const u32x4*)(hq_ + 128); } while (0)
#define U7_LOAD_ROWS4(k, gg) do { _Pragma("unroll") for (int ii_ = 0; ii_ < 4; ++ii_) { \
      const unsigned off_ = (unsigned)idx16(ei[(k) & 1][0], ei[(k) & 1][1], 4 * (gg) + ii_) * 128u + (unsigned)c * 16u; \
      rows[(k) & 1][4 * (gg) + ii_] = *(const u32x4*)(TBL + off_); } } while (0)
  U7_LOAD_IDX(0); U7_LOAD_IDX(1); U7_LOAD_H(0);
  U7_LOAD_ROWS4(0, 0); U7_LOAD_ROWS4(0, 1); U7_LOAD_ROWS4(0, 2); U7_LOAD_ROWS4(0, 3);
  U7_LOAD_ROWS4(1, 0); U7_LOAD_ROWS4(1, 1); U7_LOAD_ROWS4(1, 2); U7_LOAD_ROWS4(1, 3);
  U7_LOAD_IDX(2);
#pragma unroll
  for (int k = 0; k < PEER_NT; ++k) {
    const int t = tb + k;
    if (k + 3 < PEER_NT) U7_LOAD_IDX(k + 3);
    if (k + 1 < PEER_NT) U7_LOAD_H(k + 1);
    const u32x4 hh = hsl[k & 1][0], hl = hsl[k & 1][1];
    float sv[16];
#pragma unroll
    for (int i = 0; i < 16; ++i) {
      int ah = __builtin_amdgcn_sdot8((int)rows[k & 1][i][0], (int)hh[0], 0, false);
      int al = __builtin_amdgcn_sdot8((int)rows[k & 1][i][0], (int)hl[0], 0, false);
      ah = __builtin_amdgcn_sdot8((int)rows[k & 1][i][1], (int)hh[1], ah, false);
      al = __builtin_amdgcn_sdot8((int)rows[k & 1][i][1], (int)hl[1], al, false);
      ah = __builtin_amdgcn_sdot8((int)rows[k & 1][i][2], (int)hh[2], ah, false);
      al = __builtin_amdgcn_sdot8((int)rows[k & 1][i][2], (int)hl[2], al, false);
      ah = __builtin_amdgcn_sdot8((int)rows[k & 1][i][3], (int)hh[3], ah, false);
      al = __builtin_amdgcn_sdot8((int)rows[k & 1][i][3], (int)hl[3], al, false);
      int a = ah * 16 + al;
      a += __builtin_amdgcn_update_dpp(0, a, 0xB1, 0xf, 0xf, true);
      a += __builtin_amdgcn_update_dpp(0, a, 0x4E, 0xf, 0xf, true);
      a += __builtin_amdgcn_update_dpp(0, a, 0x141, 0xf, 0xf, true);
      sv[i] = (float)a;
      if ((i & 3) == 3) {
        __builtin_amdgcn_sched_barrier(0);
        if (k + 2 < PEER_NT) U7_LOAD_ROWS4(k + 2, i >> 2);
        __builtin_amdgcn_sched_barrier(0);
      }
    }
    float o0 = 0.f, o1 = 0.f;
#pragma unroll
    for (int i = 0; i < 8; ++i) { if (c == i) { o0 = sv[i]; o1 = sv[i + 8]; } }
    float* zp = zpart + ((size_t)x * T_TOK + t) * 128 + r * 16;
    zp[c] = o0; zp[c + 8] = o1;
  }
#undef U7_LOAD_IDX
#undef U7_LOAD_H
#undef U7_LOAD_ROWS4
}

DI unsigned peer_wword(float w) {
  const unsigned b = __float_as_uint(w);
  const unsigned sgn = (b >> 31) ? 0x88000000u : 0u;
  const unsigned E = (b >> 23) & 255u, f = (b >> 7) & 0xffffu;
  if (E < 8u || E > 250u) return 0u;
  unsigned s1, s2;
  if (f < 6144u)       { s1 = E;      s2 = 0u; }
  else if (f < 18432u) { s1 = E;      s2 = E - 3u; }
  else if (f < 28672u) { s1 = E;      s2 = E - 2u; }
  else if (f < 40960u) { s1 = 0u;     s2 = E; }
  else if (f < 57344u) { s1 = E;      s2 = E - 1u; }
  else                 { s1 = E + 1u; s2 = 0u; }
  return s1 | (s2 << 8) | sgn;
}
DI void phase_peer_act(const Params& p) {
  const float* zpart = (const float*)(p.ws + WS_ZP);
  const u16* eidx = (const u16*)(p.ws + WS_EIDX);
  float* wg = (float*)(p.ws + WS_G);
  const float* suinv = (const float*)(p.ws + WS_MISC + MISC_SUINV);
  const float* svinv = (const float*)(p.ws + WS_MISC + MISC_SVINV);
  const float* hamax = (const float*)(p.ws + WS_MISC + MISC_HAMAX);
  for (size_t i4 = (size_t)blockIdx.x * NTHR + threadIdx.x; i4 < (size_t)T_TOK * 32; i4 += (size_t)gridDim.x * NTHR) {
    const size_t i = i4 * 4;
    f32x4 z = *(const f32x4*)(zpart + i);
#pragma unroll
    for (int x = 1; x < 4; ++x) { const f32x4 zz = *(const f32x4*)(zpart + (size_t)x * T_TOK * 128 + i); z[0] += zz[0]; z[1] += zz[1]; z[2] += zz[2]; z[3] += zz[3]; }
    const u32x2 ee = *(const u32x2*)(eidx + i);
    const f32x4 g4 = *(const f32x4*)(wg + i);
    const float hs = hamax[i >> 7] * (1.0f / 119.0f);
    u32x4 o;
#pragma unroll
    for (int q = 0; q < 4; ++q) {
      const int e = (int)((q & 1) ? (ee[q >> 1] >> 16) : (ee[q >> 1] & 0xffffu));
      const float zq = z[q] * suinv[e] * hs;
      const float act = 0.5f * zq * (1.0f + erff(zq * 0.70710678118654752f));
      o[q] = peer_wword(g4[q] * act * svinv[e]);
    }
    *(u32x4*)(wg + i) = o;
  }
}

DI void peer_wave_tokens_s9(const Params& p, int x, int tb, int lane) {
  const unsigned char* TBL = p.ws + WS_V + (size_t)x * 16384 * 128;
  const u16* eidx = (const u16*)(p.ws + WS_EIDX);
  const unsigned* wwp = (const unsigned*)(p.ws + WS_G);
  const u16* x1 = (const u16*)(p.ws + WS_X1);
  const int r = lane >> 3, c = lane & 7, j = lane & 15, g = lane >> 4, je = j >> 3;
  v8i_t A0, A1, A0h, A1h;
#pragma unroll
  for (int q = 0; q < 8; ++q) {
    A0[q] = (q == (j >> 3)) ? (int)(0x2u << (4 * (j & 7))) : 0;
    A1[q] = (q == 2 + (j >> 3)) ? (int)(0x2u << (4 * (j & 7))) : 0;
    A0h[q] = (q == (j >> 3)) ? (int)(0x3u << (4 * (j & 7))) : 0;
    A1h[q] = (q == 2 + (j >> 3)) ? (int)(0x3u << (4 * (j & 7))) : 0;
  }
  u32x4 ei[2][2]; u32x4 wq[2][4]; u32x4 rows[2][16];
#define S9_LOAD_IDX(buf, k) do { const size_t o_ = (size_t)(tb + (k)) * 128 + r * 16; \
    ei[buf][0] = *(const u32x4*)(eidx + o_); ei[buf][1] = *(const u32x4*)(eidx + o_ + 8); \
    wq[buf][0] = *(const u32x4*)(wwp + o_); wq[buf][1] = *(const u32x4*)(wwp + o_ + 4); wq[buf][2] = *(const u32x4*)(wwp + o_ + 8); wq[buf][3] = *(const u32x4*)(wwp + o_ + 12); } while (0)
#define S9_LOAD_ROWS4(buf, ibuf, gg) do { _Pragma("unroll") for (int ii_ = 0; ii_ < 4; ++ii_) { \
      const unsigned off_ = (unsigned)idx16(ei[ibuf][0], ei[ibuf][1], 4 * (gg) + ii_) * 128u + (unsigned)c * 16u; \
      rows[buf][4 * (gg) + ii_] = *(const u32x4*)(TBL + off_); } } while (0)
  S9_LOAD_IDX(0, 0); S9_LOAD_IDX(1, 1);
  S9_LOAD_ROWS4(0, 0, 0); S9_LOAD_ROWS4(0, 0, 1); S9_LOAD_ROWS4(0, 0, 2); S9_LOAD_ROWS4(0, 0, 3);
#pragma unroll
  for (int k = 0; k < PEER_NT; ++k) {
    const int t = tb + k;
    u32x4 wcur[4];
#pragma unroll
    for (int q = 0; q < 4; ++q) wcur[q] = wq[k & 1][q];
    if (k + 2 < PEER_NT) S9_LOAD_IDX(k & 1, k + 2);
    const size_t o = (size_t)t * DM + x * 256 + 32 * c + 16 * je + 4 * g;
    const u32x2 xr = *(const u32x2*)(x1 + o);
    f32x4 acc[2][2];
#pragma unroll
    for (int a = 0; a < 2; ++a)
#pragma unroll
      for (int b = 0; b < 2; ++b) acc[a][b] = (f32x4){0.f, 0.f, 0.f, 0.f};
#pragma unroll
    for (int n = 0; n < 16; ++n) {
      if ((n & 3) == 0) { __builtin_amdgcn_sched_barrier(0); if (k + 1 < PEER_NT) S9_LOAD_ROWS4((k + 1) & 1, (k + 1) & 1, n >> 2); __builtin_amdgcn_sched_barrier(0); }
      const unsigned word = wcur[n >> 2][n & 3];
      const unsigned sm = __builtin_amdgcn_perm(word, word, 0x03030303u);
      v8i_t B;
      B[0] = (int)(rows[k & 1][n][0] ^ sm); B[1] = (int)(rows[k & 1][n][1] ^ sm); B[2] = (int)(rows[k & 1][n][2] ^ sm); B[3] = (int)(rows[k & 1][n][3] ^ sm);
      B[4] = 0; B[5] = 0; B[6] = 0; B[7] = 0;
      acc[0][0] = __builtin_amdgcn_mfma_scale_f32_16x16x128_f8f6f4(A0, B, acc[0][0], 4, 4, 0, 0x7F7F7F7F, 0, (int)word);
      acc[1][0] = __builtin_amdgcn_mfma_scale_f32_16x16x128_f8f6f4(A1, B, acc[1][0], 4, 4, 0, 0x7F7F7F7F, 0, (int)word);
      acc[0][1] = __builtin_amdgcn_mfma_scale_f32_16x16x128_f8f6f4(A0h, B, acc[0][1], 4, 4, 0, 0x7F7F7F7F, 1, (int)word);
      acc[1][1] = __builtin_amdgcn_mfma_scale_f32_16x16x128_f8f6f4(A1h, B, acc[1][1], 4, 4, 0, 0x7F7F7F7F, 1, (int)word);
    }
    const f32x4 tot0 = acc[0][0] + acc[0][1], tot1 = acc[1][0] + acc[1][1];
    f32x4 res;
#pragma unroll
    for (int q = 0; q < 4; ++q) {
      const float keep = je ? tot1[q] : tot0[q], send = je ? tot0[q] : tot1[q];
      const float xq = (q & 1) ? __uint_as_float(xr[q >> 1] & 0xffff0000u) : __uint_as_float(xr[q >> 1] << 16);
      res[q] = xq + keep + dpp_f<0x128>(send);
    }
    *(f32x4*)(p.out + o) = res;
  }
#undef S9_LOAD_IDX
#undef S9_LOAD_ROWS4
}

template <int WHICH>
DI void phase_peer_sliced(const Params& p, unsigned char* lds) {
  const int tid = threadIdx.x, lane = tid & 63, w = tid >> 6;
  const unsigned* rankctr = (const unsigned*)(p.ws + WS_MISC + MISC_QCTR) + 16;
  volatile PG8_LAS unsigned* st = (volatile PG8_LAS unsigned*)(lds + LDS_BARST);
  int myx = (int)st[9], myr = (int)st[8];
  int n[8]; int tot = 0;
#pragma unroll
  for (int j = 0; j < 8; ++j) { n[j] = (int)__hip_atomic_load(rankctr + j, __ATOMIC_RELAXED, __HIP_MEMORY_SCOPE_AGENT); tot += n[j]; }
  if (tot != (int)gridDim.x || st[10] != 1u) {
    myx = blockIdx.x & 7; myr = blockIdx.x >> 3;
#pragma unroll
    for (int j = 0; j < 8; ++j) n[j] = ((int)gridDim.x + 7 - j) >> 3;
  }
#pragma unroll 1
  for (int s = 0; s < 8; ++s) {
    int owner = s;
#pragma unroll
    for (int d = 0; d < 8; ++d) { if (n[owner & 7] == 0) owner = (owner + 1) & 7; }
    owner &= 7;
    if (owner != myx) continue;
    int nblk = 0;
#pragma unroll
    for (int j = 0; j < 8; ++j) nblk = (j == myx) ? n[j] : nblk;
    const int nw = nblk * 8, wr = myr * 8 + w;
    constexpr int NU = T_TOK / 2 / PEER_NT;
    const int u0 = (int)(((long long)wr * NU) / nw) + (s >> 2) * NU, u1 = (int)(((long long)(wr + 1) * NU) / nw) + (s >> 2) * NU;
#pragma unroll 1
    for (int u = u0; u < u1; ++u) {
      if (WHICH == 0) peer_wave_tokens_u7(p, s & 3, u * PEER_NT, lane);
      else peer_wave_tokens_s9(p, s & 3, u * PEER_NT, lane);
    }
  }
}

#define XB_TMO      128
#define XB_XCNT(j)  (256  + 64 * (j))
#define XB_XSUB(j)  (1280 + 64 * (j))
#define XB_XGEN(j)  (2304 + 64 * (j))
#define XB_TOP      3328
#define XB_TOPGEN   3392
#define XCD_BAR_WORDS 3456
#define XB_SPIN_CAP (1u << 18)
#define LAS __attribute__((address_space(3)))

__device__ __forceinline__ unsigned xb_ld(unsigned* p)              { return __hip_atomic_load(p, __ATOMIC_RELAXED, __HIP_MEMORY_SCOPE_AGENT); }
__device__ __forceinline__ unsigned xb_add(unsigned* p, unsigned v) { return __hip_atomic_fetch_add(p, v, __ATOMIC_RELAXED, __HIP_MEMORY_SCOPE_AGENT); }
__device__ __forceinline__ unsigned xb_xcc_id() { return (unsigned)__builtin_amdgcn_s_getreg((3 << 11) | 20) & 0xFu; }
#define XB_SPIN(cond, bar) do { unsigned _sp = 0; while (cond) { __builtin_amdgcn_s_sleep(1); \
    if ((++_sp & 255u) == 0u) { if (xb_ld(&(bar)[XB_TMO])) break; if (_sp > XB_SPIN_CAP) { atomicAdd(&(bar)[XB_TMO], 1u); break; } } } } while (0)

struct XcdBarrier {
    unsigned* bar; unsigned x;
    volatile LAS unsigned* st;
};

__device__ __forceinline__ XcdBarrier xcd_barrier_post(unsigned* bar, volatile LAS unsigned* st) {
    XcdBarrier b; b.bar = bar; b.x = xb_xcc_id(); b.st = st;
    if (threadIdx.x == 0) (void)xb_add(&bar[XB_XCNT(b.x)], 1u);
    return b;
}
__device__ __forceinline__ void xcd_barrier_complete(unsigned* bar, unsigned x, unsigned& nloc, unsigned& nx) {
    const unsigned G = gridDim.x * gridDim.y * gridDim.z;
    unsigned sum, cnt, mine, sp = 0u;
    for (;;) {
        sum = 0u; cnt = 0u; mine = 0u;
#pragma unroll
        for (unsigned j = 0; j < 16; ++j) { const unsigned c = xb_ld(&bar[XB_XCNT(j)]); sum += c; cnt += (c > 0u) ? 1u : 0u; mine = (j == x) ? c : mine; }
        if (sum == G) break;
        __builtin_amdgcn_s_sleep(1);
        if ((++sp & 255u) == 0u) { if (xb_ld(&bar[XB_TMO])) break; if (sp > XB_SPIN_CAP) { atomicAdd(&bar[XB_TMO], 1u); break; } }
    }
    nloc = mine > 0u ? mine : 1u; nx = cnt > 0u ? cnt : 1u;
}

__device__ __forceinline__ void xcd_barrier(const XcdBarrier& b) {
    asm volatile("s_waitcnt vmcnt(0)" ::: "memory");
    __syncthreads();
    if (threadIdx.x == 0) {
        unsigned* bar = b.bar;
        __builtin_amdgcn_s_waitcnt(0);
        unsigned nloc = b.st[0], nx = b.st[1];
        if (nloc == 0u) { xcd_barrier_complete(bar, b.x, nloc, nx); b.st[0] = nloc; b.st[1] = nx; }
        const unsigned old = xb_add(&bar[XB_XSUB(b.x)], 1u);
        const unsigned gen = old / nloc;
        if (old + 1u == (gen + 1u) * nloc) {
            __builtin_amdgcn_fence(__ATOMIC_RELEASE, "agent");
            asm volatile("s_waitcnt vmcnt(0)" ::: "memory");
            const unsigned og = xb_add(&bar[XB_TOP], 1u);
            const unsigned tg = og / nx;
            if (og + 1u == (tg + 1u) * nx) xb_add(&bar[XB_TOPGEN], 1u);
            else XB_SPIN(xb_ld(&bar[XB_TOPGEN]) == tg, bar);
            __builtin_amdgcn_fence(__ATOMIC_ACQUIRE, "agent");
            xb_add(&bar[XB_XGEN(b.x)], 1u);
            asm volatile("s_waitcnt vmcnt(0)" ::: "memory");
        } else {
            XB_SPIN(xb_ld(&bar[XB_XGEN(b.x)]) == gen, bar);
            __builtin_amdgcn_fence(__ATOMIC_ACQUIRE, "agent");
            asm volatile("s_waitcnt vmcnt(0)" ::: "memory");
        }
    }
    __syncthreads();
}


__global__ void __launch_bounds__(NTHR, 2) fwd_kernel(Params p) {
  extern __shared__ __attribute__((aligned(16))) unsigned char lds[];
  cg::grid_group grid = cg::this_grid();
#ifndef ONLY_PH
#define PHON(k) 1
#else
#define PHON(k) ((k) == ONLY_PH)
#endif
#ifndef REPEAT_MASK
#define REPEAT_MASK 0
#endif
#define GSYNC(k) do { if ((k) == 0) { grid.sync(); xbar = xcd_barrier_post((unsigned*)(p.ws + WS_MISC + MISC_BAR), (volatile LAS unsigned*)(lds + LDS_BARST)); \
    if (threadIdx.x == 0) { volatile LAS unsigned* st_ = (volatile LAS unsigned*)(lds + LDS_BARST); const unsigned x_ = xcc_id(); \
      st_[8] = atomicAdd((unsigned*)(p.ws + WS_MISC + MISC_QCTR) + 16 + x_, 1u); st_[9] = x_; st_[10] = 1u; } \
    __syncthreads(); } else xcd_barrier(xbar); } while (0)
#define RUN_PHASE(k, call) do { if (PHON(k) && lo <= (k) && (k) < hi) { call; if ((REPEAT_MASK >> (k)) & 1) { grid.sync(); call; } } if (lo <= (k) && (k) + 1 < hi) GSYNC(k); } while (0)
  const int lo = p.ph_lo, hi = p.ph_hi;
  if (threadIdx.x < 16) ((volatile LAS unsigned*)(lds + LDS_BARST))[threadIdx.x] = 0u;
  __syncthreads();
  XcdBarrier xbar; xbar.bar = (unsigned*)(p.ws + WS_MISC + MISC_BAR); xbar.x = 0; xbar.st = (volatile LAS unsigned*)(lds + LDS_BARST);
  RUN_PHASE(0, phase_prep(p, lds));
  RUN_PHASE(1, phase_proj(p, lds));
  RUN_PHASE(2, phase_attn(p, lds));
  RUN_PHASE(3, phase_outproj(p, lds));
  RUN_PHASE(4, phase_norm2(p));
  RUN_PHASE(5, phase_peer_query(p, lds));
  RUN_PHASE(6, phase_peer_route(p, lds));
  RUN_PHASE(7, phase_peer_sliced<0>(p, lds));
#ifndef PROBE_PEER
#define PROBE_PEER 0
#endif
  if (PROBE_PEER & 1) { xcd_barrier(xbar); phase_peer_sliced<0>(p, lds); xcd_barrier(xbar); }
  RUN_PHASE(8, phase_peer_act(p));
  RUN_PHASE(9, phase_peer_sliced<1>(p, lds));
  if (PROBE_PEER & 2) { xcd_barrier(xbar); phase_peer_sliced<1>(p, lds); }
}

extern "C" void kernel_launch(void* const* d_in, const int* in_sizes, int n_in, void* d_out, int out_size, void* d_ws, size_t ws_size, hipStream_t stream) {
  static int grid_blocks = 0;
  if (grid_blocks == 0) {
    if (n_in != 20 || ws_size < WS_END || out_size != T_TOK * DM) {
      fprintf(stderr, "kernel_launch: unexpected problem shape (n_in %d, ws %zu, out %d)\n", n_in, ws_size, out_size);
      grid_blocks = -1; return;
    }
    int dev = 0, cus = 0, per_cu = 0;
    hipGetDevice(&dev);
    hipDeviceGetAttribute(&cus, hipDeviceAttributeMultiprocessorCount, dev);
    hipFuncSetAttribute((const void*)fwd_kernel, hipFuncAttributeMaxDynamicSharedMemorySize, LDS_BYTES);
    hipOccupancyMaxActiveBlocksPerMultiprocessor(&per_cu, (const void*)fwd_kernel, NTHR, LDS_BYTES);
    if (per_cu < 1) { fprintf(stderr, "kernel_launch: occupancy query says %d blocks/CU\n", per_cu); per_cu = 1; }
    grid_blocks = cus;
    (void)hipGetLastError();
  }
  if (grid_blocks < 0) return;
  Params p{};
  p.x_prompt = (const float*)d_in[0]; p.x_sample = (const float*)d_in[1]; p.rel_bias = (const float*)d_in[2]; p.attn_norm_g = (const float*)d_in[3];
  p.w_in = (const float*)d_in[4]; p.q_norm_a = (const float*)d_in[5]; p.k_norm_a = (const float*)d_in[6]; p.q_norm_b = (const float*)d_in[7];
  p.k_norm_b = (const float*)d_in[8]; p.lq1 = (const float*)d_in[9]; p.lk1 = (const float*)d_in[10]; p.lq2 = (const float*)d_in[11];
  p.lk2 = (const float*)d_in[12]; p.diff_norm_g = (const float*)d_in[13]; p.w_out = (const float*)d_in[14]; p.ffn_norm_g = (const float*)d_in[15];
  p.peer_w_q = (const float*)d_in[16]; p.peer_sub_keys = (const float*)d_in[17]; p.peer_u = (const float*)d_in[18]; p.peer_v = (const float*)d_in[19];
  p.out = (float*)d_out; p.ws = (unsigned char*)d_ws;
#if FUSED
  p.ph_lo = 0; p.ph_hi = NPHASE;
  void* args[] = {&p};
  hipError_t e = hipLaunchCooperativeKernel((const void*)fwd_kernel, dim3(grid_blocks), dim3(NTHR), args, LDS_BYTES, stream);
  if (e != hipSuccess) fprintf(stderr, "cooperative launch failed: %s (grid %d)\n", hipGetErrorString(e), grid_blocks);
#else
  for (int ph = 0; ph < NPHASE; ++ph) {
    p.ph_lo = ph; p.ph_hi = ph + 1;
    hipLaunchKernelGGL(fwd_kernel, dim3(grid_blocks), dim3(NTHR), LDS_BYTES, stream, p);
  }
#endif
}
```
